# Optimizing an MI355X kernel written in HIP

```python
import jax
import jax.numpy as jnp
from jax import lax
import numpy as np


D_MODEL = 1024
BATCH = 8
SEQ = 4096
DEPTH = 2

CHUNK = 64
Q_BLOCK = 128
D_PLE = 256
D_FF = 4 * D_MODEL
NORM_EPS = 1e-6

MLA_HEADS = 4
MLA_NOPE = 128
MLA_ROPE = 64
MLA_V = 128
MLA_Q_RANK = 256
MLA_KV_RANK = 128
ROPE_THETA = 10000.0

RW_HEADS = 8
RW_HEAD = 64
RW_DIM = RW_HEADS * RW_HEAD
RW_DECAY_LORA = 64
RW_AAA_LORA = 64
RW_GATE_LORA = 128
RW_LN_EPS = 64e-5

CA_HEADS = 8
CA_HEAD = 64
CA_DIM = CA_HEADS * CA_HEAD
CA_LEFT_CHUNKS = 8
CA_BAND = (CA_LEFT_CHUNKS + 1) * CHUNK
REL_MIN = -(CHUNK - 1)
REL_MAX = 256
REL_SIZE = REL_MAX - REL_MIN + 1

N_BRANCH = 3
BRANCH_DIM = 512
MIX_DIM = MLA_HEADS * MLA_V + RW_DIM + CA_DIM

MLA_COLS = MLA_Q_RANK + MLA_KV_RANK + MLA_ROPE
RW_COLS = 3 * RW_DIM + RW_DECAY_LORA + RW_AAA_LORA + RW_GATE_LORA
CA_COLS = 3 * CA_DIM
GATE_COLS = N_BRANCH * D_MODEL
IN_COLS = MLA_COLS + RW_COLS + CA_COLS + GATE_COLS
IN_SPLITS = (MLA_COLS, MLA_COLS + RW_COLS, MLA_COLS + RW_COLS + CA_COLS)
RW_SPLITS = (RW_DIM, 2 * RW_DIM, 3 * RW_DIM, 3 * RW_DIM + RW_DECAY_LORA,
             3 * RW_DIM + RW_DECAY_LORA + RW_AAA_LORA)

kernel_name = 'hybrid_mla_rwkv7_chunkattn_stream_block'

F32 = jnp.float32


def rms_norm(x, g):
    xf = x.astype(F32)
    y = xf * lax.rsqrt(jnp.mean(xf * xf, axis=-1, keepdims=True) + NORM_EPS)
    return (y * g.astype(F32)).astype(x.dtype)


def rope(x, positions):
    half = x.shape[-1] // 2
    inv_freq = 1.0 / (ROPE_THETA ** (jnp.arange(half, dtype=F32) / half))
    ang = positions.astype(F32)[..., None] * inv_freq
    ang = ang.reshape(ang.shape[:2] + (1,) * (x.ndim - 3) + (half,))
    cos, sin = jnp.cos(ang), jnp.sin(ang)
    x1 = x[..., :half].astype(F32)
    x2 = x[..., half:].astype(F32)
    return jnp.concatenate([x1 * cos - x2 * sin, x2 * cos + x1 * sin], axis=-1).astype(x.dtype)


def chunk_causal_attention(q, k, v):
    b, s, h, dk = q.shape
    n_blk = s // Q_BLOCK
    scale = dk ** -0.5
    key_chunk = jnp.arange(s) // CHUNK
    q_blocks = q.reshape(b, n_blk, Q_BLOCK, h, dk).transpose(1, 0, 2, 3, 4)

    def one_block(args):
        qb, blk = args
        sc = jnp.einsum('bqhd,bkhd->bhqk', qb, k, preferred_element_type=F32) * scale
        q_chunk = (blk * Q_BLOCK + jnp.arange(Q_BLOCK)) // CHUNK
        sc = jnp.where(key_chunk[None, :] <= q_chunk[:, None], sc, -jnp.inf)
        pr = jax.nn.softmax(sc, axis=-1).astype(v.dtype)
        return jnp.einsum('bhqk,bkhd->bqhd', pr, v)

    out = lax.map(one_block, (q_blocks, jnp.arange(n_blk)))
    return out.transpose(1, 0, 2, 3, 4).reshape(b, s, h, v.shape[-1])


def mla_branch(z, positions, q_norm_g, kv_norm_g, w_uq, w_ukv):
    b, s, _ = z.shape
    z_q, z_kv, z_kr = jnp.split(z, [MLA_Q_RANK, MLA_Q_RANK + MLA_KV_RANK], axis=-1)
    q = (rms_norm(z_q, q_norm_g) @ w_uq).reshape(b, s, MLA_HEADS, MLA_NOPE + MLA_ROPE)
    q = jnp.concatenate([q[..., :MLA_NOPE], rope(q[..., MLA_NOPE:], positions)], axis=-1)
    kv = (rms_norm(z_kv, kv_norm_g) @ w_ukv).reshape(b, s, MLA_HEADS, MLA_NOPE + MLA_V)
    k_rope = jnp.broadcast_to(rope(z_kr, positions)[:, :, None, :], (b, s, MLA_HEADS, MLA_ROPE))
    k = jnp.concatenate([kv[..., :MLA_NOPE], k_rope], axis=-1)
    o = chunk_causal_attention(q, k, kv[..., MLA_NOPE:])
    return o.reshape(b, s, MLA_HEADS * MLA_V)


def token_shift(z, mu):
    prev = jnp.pad(z, ((0, 0), (1, 0), (0, 0)))[:, :-1]
    return z + (prev - z) * mu


def wkv7_scan(r, w, k, v, kk, a):
    b, s, h, n = r.shape

    def step(state, inp):
        r_t, w_t, k_t, v_t, kk_t, a_t = inp
        sa = jnp.einsum('bhvk,bhk->bhv', state, -kk_t)
        state = (state * w_t[:, :, None, :] + sa[..., None] * (kk_t * a_t)[:, :, None, :]
                 + v_t[..., None] * k_t[:, :, None, :])
        return state, jnp.einsum('bhvk,bhk->bhv', state, r_t)

    xs = tuple(t.astype(F32).transpose(1, 0, 2, 3) for t in (r, w, k, v, kk, a))
    _, ys = lax.scan(step, jnp.zeros((b, h, n, n), F32), xs)
    return ys.transpose(1, 0, 2, 3)


def rwkv7_branch(z, mu, w0, w_up, a0, a_up, g_up, k_k, k_a, r_k, ln_w, ln_b):
    b, s, _ = z.shape
    r, k, v, xw, xa, xg = jnp.split(token_shift(z, mu), RW_SPLITS, axis=-1)
    w_log = -jax.nn.softplus(-(w0 + jnp.tanh(xw) @ w_up).astype(F32)) - 0.5
    decay = jnp.exp(-jnp.exp(w_log))
    a = jax.nn.sigmoid(a0 + xa @ a_up)
    g = jax.nn.sigmoid(xg) @ g_up
    heads = lambda t: t.reshape(b, s, RW_HEADS, RW_HEAD)
    kk = heads(k * k_k).astype(F32)
    kk = kk * lax.rsqrt(jnp.maximum(jnp.sum(kk * kk, axis=-1, keepdims=True), 1e-24))
    k = k * (1.0 + (a - 1.0) * k_a)
    y = wkv7_scan(heads(r), heads(decay), heads(k), heads(v), kk, heads(a))
    mean = jnp.mean(y, axis=-1, keepdims=True)
    var = jnp.mean(jnp.square(y - mean), axis=-1, keepdims=True)
    yn = ((y - mean) * lax.rsqrt(var + RW_LN_EPS)).reshape(b, s, RW_DIM)
    yn = yn * ln_w.astype(F32) + ln_b.astype(F32)
    bonus = jnp.sum(heads(r * k).astype(F32) * r_k.astype(F32), axis=-1, keepdims=True) * heads(v).astype(F32)
    out = (yn + bonus.reshape(b, s, RW_DIM)) * g.astype(F32)
    return out.astype(z.dtype)


def chunk_band_attention(z, rel_bias):
    b, s, _ = z.shape
    q, k, v = [t.reshape(b, s, CA_HEADS, CA_HEAD) for t in jnp.split(z, [CA_DIM, 2 * CA_DIM], axis=-1)]
    n_chunks = s // CHUNK
    pad = CA_LEFT_CHUNKS * CHUNK
    kp = jnp.pad(k, ((0, 0), (pad, 0), (0, 0), (0, 0)))
    vp = jnp.pad(v, ((0, 0), (pad, 0), (0, 0), (0, 0)))
    band = jnp.arange(CA_BAND)
    dist = pad + jnp.arange(CHUNK)[:, None] - band[None, :]
    rel_idx = jnp.clip(dist, REL_MIN, REL_MAX) - REL_MIN
    bias = rel_bias.astype(F32)[rel_idx].transpose(2, 0, 1)
    q_chunks = q.reshape(b, n_chunks, CHUNK, CA_HEADS, CA_HEAD).transpose(1, 0, 2, 3, 4)
    scale = CA_HEAD ** -0.5

    def one_chunk(args):
        qc, c = args
        kb = lax.dynamic_slice_in_dim(kp, c * CHUNK, CA_BAND, axis=1)
        vb = lax.dynamic_slice_in_dim(vp, c * CHUNK, CA_BAND, axis=1)
        sc = jnp.einsum('bqhd,bkhd->bhqk', qc, kb, preferred_element_type=F32) * scale + bias
        valid = band >= (CA_LEFT_CHUNKS - c) * CHUNK
        sc = jnp.where(valid, sc, -jnp.inf)
        pr = jax.nn.softmax(sc, axis=-1).astype(vb.dtype)
        return jnp.einsum('bhqk,bkhd->bqhd', pr, vb)

    out = lax.map(one_chunk, (q_chunks, jnp.arange(n_chunks)))
    return out.transpose(1, 0, 2, 3, 4).reshape(b, s, CA_DIM)


def setup_inputs(seed: int = 0) -> dict:
    key = jax.random.key(seed)
    ks = iter(jax.random.split(key, 40))

    def nrm(shape, scale):
        return scale * jax.random.normal(next(ks), shape, F32)

    def gain(shape):
        return 1.0 + nrm(shape, 0.05)

    L = DEPTH
    x = nrm((BATCH, SEQ, D_MODEL), 1.0)
    p = nrm((L, BATCH, SEQ, D_PLE), 1.0)
    offsets = jax.random.randint(next(ks), (BATCH,), 0, 1024, dtype=jnp.int32) * CHUNK
    positions = offsets[:, None] + jnp.arange(SEQ, dtype=jnp.int32)[None, :]
    return {
        'x': x,
        'p': p,
        'positions': positions,
        'pre_mix_g': gain((L, D_MODEL)),
        'w_in': nrm((L, D_MODEL, IN_COLS), D_MODEL ** -0.5),
        'mla_q_norm_g': gain((L, MLA_Q_RANK)),
        'mla_kv_norm_g': gain((L, MLA_KV_RANK)),
        'mla_w_uq': nrm((L, MLA_Q_RANK, MLA_HEADS * (MLA_NOPE + MLA_ROPE)), MLA_Q_RANK ** -0.5),
        'mla_w_ukv': nrm((L, MLA_KV_RANK, MLA_HEADS * (MLA_NOPE + MLA_V)), MLA_KV_RANK ** -0.5),
        'rw_mu': jax.random.uniform(next(ks), (L, RW_COLS), F32),
        'rw_w0': jax.random.uniform(next(ks), (L, RW_DIM), F32, -4.0, 0.0),
        'rw_w_up': nrm((L, RW_DECAY_LORA, RW_DIM), 0.1),
        'rw_a0': nrm((L, RW_DIM), 0.5),
        'rw_a_up': nrm((L, RW_AAA_LORA, RW_DIM), 0.1),
        'rw_g_up': nrm((L, RW_GATE_LORA, RW_DIM), RW_GATE_LORA ** -0.5),
        'rw_k_k': 0.85 + nrm((L, RW_DIM), 0.05),
        'rw_k_a': 1.0 + nrm((L, RW_DIM), 0.05),
        'rw_r_k': nrm((L, RW_HEADS, RW_HEAD), 0.1),
        'rw_ln_w': gain((L, RW_DIM)),
        'rw_ln_b': nrm((L, RW_DIM), 0.02),
        'ca_rel_bias': nrm((L, REL_SIZE, CA_HEADS), 0.5),
        'w_branch': nrm((L, MIX_DIM, D_MODEL), BRANCH_DIM ** -0.5),
        'w_out': nrm((L, D_MODEL, D_MODEL), D_MODEL ** -0.5),
        'post_mix_g': gain((L, D_MODEL)),
        'pre_ff_g': gain((L, D_MODEL)),
        'w_ff1': nrm((L, D_MODEL, D_FF), D_MODEL ** -0.5),
        'w_ff2': nrm((L, D_FF, D_MODEL), D_FF ** -0.5),
        'post_ff_g': gain((L, D_MODEL)),
        'w_ple_gate': nrm((L, D_MODEL, D_MODEL), D_MODEL ** -0.5),
        'w_ple_proj': nrm((L, D_PLE, D_MODEL), D_PLE ** -0.5),
    }


def reference(x, p, positions, pre_mix_g, w_in, mla_q_norm_g, mla_kv_norm_g, mla_w_uq, mla_w_ukv,
              rw_mu, rw_w0, rw_w_up, rw_a0, rw_a_up, rw_g_up, rw_k_k, rw_k_a, rw_r_k, rw_ln_w, rw_ln_b,
              ca_rel_bias, w_branch, w_out, post_mix_g, pre_ff_g, w_ff1, w_ff2, post_ff_g,
              w_ple_gate, w_ple_proj):
    b, s, _ = x.shape
    h = x
    for i in range(DEPTH):
        u = rms_norm(h, pre_mix_g[i])
        z = u @ w_in[i]
        z_mla, z_rw, z_ca, z_gate = jnp.split(z, IN_SPLITS, axis=-1)
        o_mla = mla_branch(z_mla, positions, mla_q_norm_g[i], mla_kv_norm_g[i], mla_w_uq[i], mla_w_ukv[i])
        o_rw = rwkv7_branch(z_rw, rw_mu[i], rw_w0[i], rw_w_up[i], rw_a0[i], rw_a_up[i], rw_g_up[i],
                            rw_k_k[i], rw_k_a[i], rw_r_k[i], rw_ln_w[i], rw_ln_b[i])
        o_ca = chunk_band_attention(z_ca, ca_rel_bias[i])
        branches = jnp.stack([o_mla, o_rw, o_ca], axis=2)
        y = jnp.einsum('bsnc,ncd->bsnd', branches, w_branch[i].reshape(N_BRANCH, BRANCH_DIM, D_MODEL))
        gates = jax.nn.sigmoid(z_gate).reshape(b, s, N_BRANCH, D_MODEL)
        merged = jnp.sum(gates * y, axis=2)
        h = h + rms_norm(merged @ w_out[i], post_mix_g[i])
        f = rms_norm(h, pre_ff_g[i])
        f = jnp.square(jax.nn.relu(f @ w_ff1[i])) @ w_ff2[i]
        h = h + rms_norm(f, post_ff_g[i])
        h = h + jax.nn.sigmoid(h @ w_ple_gate[i]) * (p[i] @ w_ple_proj[i])
    return h
```

```cpp
#include <hip/hip_runtime.h>
#include <cstdio>
#include <cstdint>
#include <cmath>

constexpr int D_MODEL = 1024, BATCH = 8, SEQ = 4096, DEPTH = 2, CHUNK = 64, D_PLE = 256, D_FF = 4096;
constexpr int MLA_HEADS = 4, MLA_NOPE = 128, MLA_ROPE = 64, MLA_V = 128, MLA_Q_RANK = 256, MLA_KV_RANK = 128;
constexpr int RW_HEADS = 8, RW_HEAD = 64, RW_DIM = 512, RW_DECAY_LORA = 64, RW_AAA_LORA = 64, RW_GATE_LORA = 128;
constexpr int CA_HEADS = 8, CA_HEAD = 64, CA_DIM = 512, CA_LEFT = 8, CA_BAND = 576, REL_MIN = -63, REL_MAX = 256, REL_SIZE = 320;
constexpr int MLA_COLS = 448, RW_COLS = 1792, CA_COLS = 1536, GATE_COLS = 3072, IN_COLS = 6848;
constexpr int MIX_DIM = 1536;
constexpr float NORM_EPS = 1e-6f, RW_LN_EPS = 64e-5f;
constexpr int T_ALL = BATCH * SEQ;

__device__ const double ROPE_INV_FREQ[32] = {1, 0.74989420933245587, 0.56234132519034907, 0.42169650342858223, 0.31622776601683794, 0.23713737056616552, 0.17782794100389229, 0.1333521432163324, 0.10000000000000001, 0.074989420933245579, 0.056234132519034911, 0.042169650342858224, 0.031622776601683791, 0.023713737056616554, 0.017782794100389229, 0.013335214321633241, 0.01, 0.0074989420933245579, 0.005623413251903491, 0.0042169650342858229, 0.0031622776601683794, 0.0023713737056616554, 0.0017782794100389228, 0.0013335214321633241, 0.001, 0.00074989420933245586, 0.0005623413251903491, 0.00042169650342858224, 0.00031622776601683794, 0.00023713737056616554, 0.00017782794100389227, 0.0001333521432163324};

__device__ __forceinline__ void sincos_d(double a, float& s, float& c) {
    const double n = rint(a * 0.63661977236758134308);
    double r = fma(-n, 1.5707963267948966192, a);
    r = fma(-n, 6.123233995736766036e-17, r);
    const double r2 = r * r;
    double sp = -7.6471637318198164759e-13;
    sp = fma(sp, r2, 1.6059043836821614599e-10);
    sp = fma(sp, r2, -2.5052108385441718775e-08);
    sp = fma(sp, r2, 2.7557319223985890653e-06);
    sp = fma(sp, r2, -1.9841269841269841270e-04);
    sp = fma(sp, r2, 8.3333333333333333333e-03);
    sp = fma(sp, r2, -1.6666666666666666667e-01);
    const double sn = fma(sp * r2, r, r);
    double cp = 4.7794773323873852974e-14;
    cp = fma(cp, r2, -1.1470745597729724714e-11);
    cp = fma(cp, r2, 2.0876756987868098979e-09);
    cp = fma(cp, r2, -2.7557319223985890653e-07);
    cp = fma(cp, r2, 2.4801587301587301587e-05);
    cp = fma(cp, r2, -1.3888888888888888889e-03);
    cp = fma(cp, r2, 4.1666666666666666667e-02);
    cp = fma(cp, r2, -0.5);
    const double cs = fma(cp, r2, 1.0);
    const long long q = (long long)n & 3LL;
    double so, co;
    if (q == 0) { so = sn; co = cs; } else if (q == 1) { so = cs; co = -sn; } else if (q == 2) { so = -sn; co = -cs; } else { so = -cs; co = sn; }
    s = (float)so; c = (float)co;
}
__device__ __forceinline__ float sigmoidf_(float x) { return 1.0f / (1.0f + __expf(-x)); }

__global__ void k_copy(const float* __restrict__ a, float* __restrict__ o, size_t n4) {
    for (size_t i = blockIdx.x * (size_t)blockDim.x + threadIdx.x; i < n4; i += (size_t)gridDim.x * blockDim.x) ((float4*)o)[i] = ((const float4*)a)[i];
}
__global__ void k_copy2d(const float* __restrict__ a, int lda, float* __restrict__ o, int ldo, int cols, int rows) {
    for (int i = blockIdx.x * blockDim.x + threadIdx.x; i < rows * cols; i += gridDim.x * blockDim.x) { const int r = i / cols, c = i % cols; o[(size_t)r * ldo + c] = a[(size_t)r * lda + c]; }
}
__global__ void k_rmsnorm(const float* in, int ldi, const float* __restrict__ g, float* out, int ldo, int D, int rows, const float* res) {
    const int wave = (blockIdx.x * blockDim.x + threadIdx.x) >> 6, lane = threadIdx.x & 63, nw = (gridDim.x * blockDim.x) >> 6;
    for (int r = wave; r < rows; r += nw) {
        const float* x = in + (size_t)r * ldi; float s = 0.f;
        for (int c = lane; c < D; c += 64) { const float v = x[c]; s += v * v; }
        for (int o = 32; o; o >>= 1) s += __shfl_xor(s, o);
        const float rs = rsqrtf(s / (float)D + NORM_EPS);
        float* y = out + (size_t)r * ldo;
        for (int c = lane; c < D; c += 64) { float v = x[c] * rs * g[c]; if (res) v += res[(size_t)r * ldo + c]; y[c] = v; }
    }
}
template <int ACT>
__global__ void __launch_bounds__(256) k_gemm(const float* __restrict__ A, int lda, const float* __restrict__ B, int ldb, float* __restrict__ C, int ldc, int M, int N, int K) {
    __shared__ float As[16][132]; __shared__ float Bs[16][68];
    const int tid = threadIdx.x, tx = tid & 15, ty = tid >> 4;
    const int m0 = blockIdx.y * 128, n0 = blockIdx.x * 64;
    float acc[8][4];
#pragma unroll
    for (int i = 0; i < 8; ++i)
#pragma unroll
        for (int j = 0; j < 4; ++j) acc[i][j] = 0.f;
    for (int k0 = 0; k0 < K; k0 += 16) {
#pragma unroll
        for (int i = 0; i < 8; ++i) { const int e = tid + i * 256, r = e >> 4, c = e & 15; As[c][r] = A[(size_t)(m0 + r) * lda + k0 + c]; }
#pragma unroll
        for (int i = 0; i < 4; ++i) { const int e = tid + i * 256, r = e >> 6, c = e & 63; Bs[r][c] = B[(size_t)(k0 + r) * ldb + n0 + c]; }
        __syncthreads();
#pragma unroll
        for (int k = 0; k < 16; ++k) {
            float a[8], b[4];
#pragma unroll
            for (int i = 0; i < 8; ++i) a[i] = As[k][ty * 8 + i];
#pragma unroll
            for (int j = 0; j < 4; ++j) b[j] = Bs[k][tx * 4 + j];
#pragma unroll
            for (int i = 0; i < 8; ++i)
#pragma unroll
                for (int j = 0; j < 4; ++j) acc[i][j] = fmaf(a[i], b[j], acc[i][j]);
        }
        __syncthreads();
    }
#pragma unroll
    for (int i = 0; i < 8; ++i)
#pragma unroll
        for (int j = 0; j < 4; ++j) {
            float v = acc[i][j];
            if (ACT == 1) { v = v > 0.f ? v * v : 0.f; }
            if (ACT == 2) { v = sigmoidf_(v); }
            C[(size_t)(m0 + ty * 8 + i) * ldc + n0 + tx * 4 + j] = v;
        }
}
__global__ void k_rope(float* __restrict__ buf, int ld, int col0, int hstride, int nheads, const int* __restrict__ pos, int rows) {
    const int n = rows * nheads * 32;
    for (int i = blockIdx.x * blockDim.x + threadIdx.x; i < n; i += gridDim.x * blockDim.x) {
        const int j = i & 31, h = (i >> 5) % nheads, r = i / (32 * nheads);
        float s, c; sincos_d((double)pos[r] * ROPE_INV_FREQ[j], s, c);
        float* p = buf + (size_t)r * ld + col0 + h * hstride;
        const float x1 = p[j], x2 = p[j + 32];
        p[j] = x1 * c - x2 * s; p[j + 32] = x2 * c + x1 * s;
    }
}
__global__ void __launch_bounds__(128) k_mla_attn(const float* __restrict__ Q, const float* __restrict__ KV, const float* __restrict__ KR, float* __restrict__ O) {
    __shared__ float sc[2][SEQ]; __shared__ float qs[2][192];
    const int w = threadIdx.x >> 6, lane = threadIdx.x & 63;
    const int item = blockIdx.x * 2 + w; const int t = item >> 2, h = item & 3;
    const int nk = ((t >> 6) + 1) << 6;
    for (int d = lane; d < 192; d += 64) qs[w][d] = Q[(size_t)t * 768 + h * 192 + d];
    __syncthreads();
    const float scale = 0.07216878364870322f;
    float mx = -INFINITY;
    for (int k = lane; k < nk; k += 64) {
        const float4* kn = (const float4*)(KV + (size_t)k * 1024 + h * 256); const float4* kr = (const float4*)(KR + (size_t)k * 64);
        float s = 0.f;
#pragma unroll 8
        for (int d = 0; d < 32; ++d) { const float4 v = kn[d]; s += v.x * qs[w][4 * d] + v.y * qs[w][4 * d + 1] + v.z * qs[w][4 * d + 2] + v.w * qs[w][4 * d + 3]; }
#pragma unroll 8
        for (int d = 0; d < 16; ++d) { const float4 v = kr[d]; s += v.x * qs[w][128 + 4 * d] + v.y * qs[w][129 + 4 * d] + v.z * qs[w][130 + 4 * d] + v.w * qs[w][131 + 4 * d]; }
        s *= scale; sc[w][k] = s; mx = fmaxf(mx, s);
    }
    for (int o = 32; o; o >>= 1) mx = fmaxf(mx, __shfl_xor(mx, o));
    float sum = 0.f;
    for (int k = lane; k < nk; k += 64) { const float p = __expf(sc[w][k] - mx); sc[w][k] = p; sum += p; }
    for (int o = 32; o; o >>= 1) sum += __shfl_xor(sum, o);
    __syncthreads();
    float o0 = 0.f, o1 = 0.f;
    for (int k = 0; k < nk; ++k) { const float p = sc[w][k]; const float* v = KV + (size_t)k * 1024 + h * 256 + 128; o0 = fmaf(p, v[lane], o0); o1 = fmaf(p, v[lane + 64], o1); }
    const float inv = 1.f / sum;
    O[(size_t)t * 512 + h * 128 + lane] = o0 * inv; O[(size_t)t * 512 + h * 128 + 64 + lane] = o1 * inv;
}
__global__ void __launch_bounds__(256) k_band_attn(const float* __restrict__ Z, int ld, const float* __restrict__ bias, float* __restrict__ O) {
    __shared__ float sc[4][CA_BAND]; __shared__ float qs[4][64];
    const int w = threadIdx.x >> 6, lane = threadIdx.x & 63;
    const int item = blockIdx.x * 4 + w; const int t = item >> 3, h = item & 7;
    const int c = t >> 6; const int k0 = (c - CA_LEFT) * 64;
    qs[w][lane] = Z[(size_t)t * ld + h * 64 + lane];
    __syncthreads();
    float mx = -INFINITY;
    for (int j = lane; j < CA_BAND; j += 64) {
        const int kp = k0 + j; float s = -INFINITY;
        if (kp >= 0) {
            const float4* kv = (const float4*)(Z + (size_t)kp * ld + 512 + h * 64); s = 0.f;
#pragma unroll
            for (int d = 0; d < 16; ++d) { const float4 v = kv[d]; s += v.x * qs[w][4 * d] + v.y * qs[w][4 * d + 1] + v.z * qs[w][4 * d + 2] + v.w * qs[w][4 * d + 3]; }
            int dist = t - kp; dist = dist < REL_MIN ? REL_MIN : (dist > REL_MAX ? REL_MAX : dist);
            s = s * 0.125f + bias[(dist - REL_MIN) * 8 + h];
        }
        sc[w][j] = s; mx = fmaxf(mx, s);
    }
    for (int o = 32; o; o >>= 1) mx = fmaxf(mx, __shfl_xor(mx, o));
    float sum = 0.f;
    for (int j = lane; j < CA_BAND; j += 64) { const float p = __expf(sc[w][j] - mx); sc[w][j] = p; sum += p; }
    for (int o = 32; o; o >>= 1) sum += __shfl_xor(sum, o);
    __syncthreads();
    float o0 = 0.f;
    for (int j = 0; j < CA_BAND; ++j) { const int kp = k0 + j; if (kp < 0) continue; o0 = fmaf(sc[w][j], Z[(size_t)kp * ld + 1024 + h * 64 + lane], o0); }
    O[(size_t)t * 512 + h * 64 + lane] = o0 / sum;
}
__global__ void k_tokenshift(const float* __restrict__ Z, int ld, const float* __restrict__ mu, float* __restrict__ ZS) {
    const int n = SEQ * RW_COLS;
    for (int i = blockIdx.x * blockDim.x + threadIdx.x; i < n; i += gridDim.x * blockDim.x) {
        const int t = i / RW_COLS, c = i % RW_COLS;
        const float z = Z[(size_t)t * ld + c], pv = t > 0 ? Z[(size_t)(t - 1) * ld + c] : 0.f;
        float v = z + (pv - z) * mu[c];
        if (c >= 1536 && c < 1600) v = tanhf(v);
        if (c >= 1664) v = sigmoidf_(v);
        ZS[i] = v;
    }
}
__global__ void k_rw_prep(const float* __restrict__ ZS, const float* __restrict__ TW, const float* __restrict__ TA, const float* __restrict__ w0, const float* __restrict__ a0,
                          const float* __restrict__ k_k, const float* __restrict__ k_a, float* __restrict__ DEC, float* __restrict__ AA, float* __restrict__ KK, float* __restrict__ KM) {
    const int wave = (blockIdx.x * blockDim.x + threadIdx.x) >> 6, lane = threadIdx.x & 63, nw = (gridDim.x * blockDim.x) >> 6;
    for (int it = wave; it < SEQ * RW_HEADS; it += nw) {
        const int t = it >> 3, h = it & 7, c = h * 64 + lane; const size_t o = (size_t)t * 512 + c;
        const float x = -(w0[c] + TW[o]);
        const float sp = (x > 0.f ? x : 0.f) + log1pf(__expf(-fabsf(x)));
        const float wlog = -sp - 0.5f;
        DEC[o] = __expf(-__expf(wlog));
        const float a = sigmoidf_(a0[c] + TA[o]); AA[o] = a;
        const float k = ZS[(size_t)t * RW_COLS + 512 + c];
        const float kk = k * k_k[c]; float s = kk * kk;
        for (int q = 32; q; q >>= 1) s += __shfl_xor(s, q);
        KK[o] = kk * rsqrtf(fmaxf(s, 1e-24f));
        KM[o] = k * (1.f + (a - 1.f) * k_a[c]);
    }
}
__global__ void __launch_bounds__(64) k_rw_scan(const float* __restrict__ ZS, const float* __restrict__ DEC, const float* __restrict__ AA, const float* __restrict__ KK, const float* __restrict__ KM, float* __restrict__ Y) {
    __shared__ float sh[5][64];
    const int h = blockIdx.x, lane = threadIdx.x;
    float S[64];
#pragma unroll
    for (int k = 0; k < 64; ++k) S[k] = 0.f;
    for (int t = 0; t < SEQ; ++t) {
        const size_t o = (size_t)t * 512 + h * 64 + lane;
        sh[0][lane] = ZS[(size_t)t * RW_COLS + h * 64 + lane];
        sh[1][lane] = DEC[o]; sh[2][lane] = KM[o]; const float kkv = KK[o]; sh[3][lane] = kkv; sh[4][lane] = kkv * AA[o];
        const float vv = ZS[(size_t)t * RW_COLS + 1024 + h * 64 + lane];
        __syncthreads();
        float sa = 0.f;
#pragma unroll
        for (int k = 0; k < 64; ++k) sa = fmaf(S[k], -sh[3][k], sa);
        float y = 0.f;
#pragma unroll
        for (int k = 0; k < 64; ++k) { S[k] = fmaf(S[k], sh[1][k], fmaf(sa, sh[4][k], vv * sh[2][k])); y = fmaf(S[k], sh[0][k], y); }
        Y[o] = y;
        __syncthreads();
    }
}
__global__ void k_rw_out(const float* __restrict__ ZS, const float* __restrict__ KM, const float* __restrict__ Y, const float* __restrict__ G, const float* __restrict__ r_k, const float* __restrict__ ln_w, const float* __restrict__ ln_b, float* __restrict__ O) {
    const int wave = (blockIdx.x * blockDim.x + threadIdx.x) >> 6, lane = threadIdx.x & 63, nw = (gridDim.x * blockDim.x) >> 6;
    for (int it = wave; it < SEQ * RW_HEADS; it += nw) {
        const int t = it >> 3, h = it & 7, c = h * 64 + lane; const size_t o = (size_t)t * 512 + c;
        const float y = Y[o]; float s = y;
        for (int q = 32; q; q >>= 1) s += __shfl_xor(s, q);
        const float mean = s * (1.f / 64.f); const float d = y - mean; float v = d * d;
        for (int q = 32; q; q >>= 1) v += __shfl_xor(v, q);
        const float yn = d * rsqrtf(v * (1.f / 64.f) + RW_LN_EPS) * ln_w[c] + ln_b[c];
        const float r = ZS[(size_t)t * RW_COLS + c], vv = ZS[(size_t)t * RW_COLS + 1024 + c];
        float b = r * KM[o] * r_k[c];
        for (int q = 32; q; q >>= 1) b += __shfl_xor(b, q);
        O[o] = (yn + b * vv) * G[o];
    }
}
__global__ void k_merge(const float* __restrict__ Z, int ld, const float* __restrict__ Y3, float* __restrict__ M) {
    const int n = SEQ * D_MODEL;
    for (int i = blockIdx.x * blockDim.x + threadIdx.x; i < n; i += gridDim.x * blockDim.x) {
        const int t = i >> 10, d = i & 1023; float s = 0.f;
#pragma unroll
        for (int b = 0; b < 3; ++b) s += sigmoidf_(Z[(size_t)t * ld + 3776 + b * 1024 + d]) * Y3[(size_t)b * SEQ * D_MODEL + i];
        M[i] = s;
    }
}
__global__ void k_ple(float* __restrict__ h, const float* __restrict__ gate, const float* __restrict__ proj) {
    const int n = SEQ * D_MODEL;
    for (int i = blockIdx.x * blockDim.x + threadIdx.x; i < n; i += gridDim.x * blockDim.x) h[i] += gate[i] * proj[i];
}

template <int ACT>
static void gemm(hipStream_t st, const float* A, int lda, const float* B, int ldb, float* C, int ldc, int M, int N, int K) {
    hipLaunchKernelGGL(k_gemm<ACT>, dim3(N / 64, M / 128), dim3(256), 0, st, A, lda, B, ldb, C, ldc, M, N, K);
}

extern "C" void kernel_launch(void* const* d_in, const int* in_sizes, int n_in, void* d_out, int out_size, void* d_ws, size_t ws_size, hipStream_t stream) {
    const float* x = (const float*)d_in[0]; const float* p = (const float*)d_in[1]; const int* positions = (const int*)d_in[2];
    const float* pre_mix_g = (const float*)d_in[3]; const float* w_in = (const float*)d_in[4]; const float* q_norm_g = (const float*)d_in[5]; const float* kv_norm_g = (const float*)d_in[6];
    const float* w_uq = (const float*)d_in[7]; const float* w_ukv = (const float*)d_in[8]; const float* rw_mu = (const float*)d_in[9]; const float* rw_w0 = (const float*)d_in[10];
    const float* rw_w_up = (const float*)d_in[11]; const float* rw_a0 = (const float*)d_in[12]; const float* rw_a_up = (const float*)d_in[13]; const float* rw_g_up = (const float*)d_in[14];
    const float* rw_k_k = (const float*)d_in[15]; const float* rw_k_a = (const float*)d_in[16]; const float* rw_r_k = (const float*)d_in[17]; const float* rw_ln_w = (const float*)d_in[18];
    const float* rw_ln_b = (const float*)d_in[19]; const float* ca_rel_bias = (const float*)d_in[20]; const float* w_branch = (const float*)d_in[21]; const float* w_out = (const float*)d_in[22];
    const float* post_mix_g = (const float*)d_in[23]; const float* pre_ff_g = (const float*)d_in[24]; const float* w_ff1 = (const float*)d_in[25]; const float* w_ff2 = (const float*)d_in[26];
    const float* post_ff_g = (const float*)d_in[27]; const float* w_ple_gate = (const float*)d_in[28]; const float* w_ple_proj = (const float*)d_in[29];
    float* h = (float*)d_out;
    float* ws = (float*)d_ws; size_t off = 0;
    auto take = [&](size_t n) { float* r = ws + off; off += n; return r; };
    const size_t S = SEQ;
    float* Z = take(S * IN_COLS); float* U = take(S * 1024); float* QN = take(S * 256); float* KVN = take(S * 128);
    float* Q = take(S * 768); float* KV = take(S * 1024); float* KR = take(S * 64); float* OBR = take(S * 1536);
    float* ZS = take(S * RW_COLS); float* TW = take(S * 512); float* TA = take(S * 512); float* G = take(S * 512);
    float* DEC = take(S * 512); float* AA = take(S * 512); float* KK = take(S * 512); float* KM = take(S * 512); float* Y = take(S * 512);
    float* Y3 = take(S * 3072); float* MER = take(S * 1024); float* M2 = take(S * 1024);
    if (off * 4 > ws_size) { fprintf(stderr, "ws too small: need %zu have %zu\n", off * 4, ws_size); return; }
    float* F1 = Z; float* HID = Z + S * 1024; float* F3 = Z + S * 5120; float* GATE = Y3; float* PROJ = Y3 + S * 1024;

    hipLaunchKernelGGL(k_copy, dim3(2048), dim3(256), 0, stream, x, h, (size_t)T_ALL * D_MODEL / 4);
    for (int l = 0; l < DEPTH; ++l) {
        const float* Win = w_in + (size_t)l * D_MODEL * IN_COLS;
        for (int b = 0; b < BATCH; ++b) {
            float* hb = h + (size_t)b * S * D_MODEL; const int* pos = positions + b * SEQ;
            hipLaunchKernelGGL(k_rmsnorm, dim3(512), dim3(256), 0, stream, hb, D_MODEL, pre_mix_g + l * D_MODEL, U, D_MODEL, D_MODEL, SEQ, (const float*)nullptr);
            gemm<0>(stream, U, D_MODEL, Win, IN_COLS, Z, IN_COLS, SEQ, IN_COLS, D_MODEL);
            hipLaunchKernelGGL(k_rmsnorm, dim3(512), dim3(256), 0, stream, Z, IN_COLS, q_norm_g + l * 256, QN, 256, 256, SEQ, (const float*)nullptr);
            hipLaunchKernelGGL(k_rmsnorm, dim3(512), dim3(256), 0, stream, Z + 256, IN_COLS, kv_norm_g + l * 128, KVN, 128, 128, SEQ, (const float*)nullptr);
            gemm<0>(stream, QN, 256, w_uq + (size_t)l * 256 * 768, 768, Q, 768, SEQ, 768, 256);
            gemm<0>(stream, KVN, 128, w_ukv + (size_t)l * 128 * 1024, 1024, KV, 1024, SEQ, 1024, 128);
            hipLaunchKernelGGL(k_rope, dim3(512), dim3(256), 0, stream, Q, 768, 128, 192, 4, pos, SEQ);
            hipLaunchKernelGGL(k_copy2d, dim3(256), dim3(256), 0, stream, Z + 384, IN_COLS, KR, 64, 64, SEQ);
            hipLaunchKernelGGL(k_rope, dim3(512), dim3(256), 0, stream, KR, 64, 0, 0, 1, pos, SEQ);
            hipLaunchKernelGGL(k_mla_attn, dim3(SEQ * 2), dim3(128), 0, stream, Q, KV, KR, OBR);
            hipLaunchKernelGGL(k_tokenshift, dim3(2048), dim3(256), 0, stream, Z + MLA_COLS, IN_COLS, rw_mu + l * RW_COLS, ZS);
            gemm<0>(stream, ZS + 1536, RW_COLS, rw_w_up + (size_t)l * 64 * 512, 512, TW, 512, SEQ, 512, 64);
            gemm<0>(stream, ZS + 1600, RW_COLS, rw_a_up + (size_t)l * 64 * 512, 512, TA, 512, SEQ, 512, 64);
            gemm<0>(stream, ZS + 1664, RW_COLS, rw_g_up + (size_t)l * 128 * 512, 512, G, 512, SEQ, 512, 128);
            hipLaunchKernelGGL(k_rw_prep, dim3(1024), dim3(256), 0, stream, ZS, TW, TA, rw_w0 + l * 512, rw_a0 + l * 512, rw_k_k + l * 512, rw_k_a + l * 512, DEC, AA, KK, KM);
            hipLaunchKernelGGL(k_rw_scan, dim3(RW_HEADS), dim3(64), 0, stream, ZS, DEC, AA, KK, KM, Y);
            hipLaunchKernelGGL(k_rw_out, dim3(1024), dim3(256), 0, stream, ZS, KM, Y, G, rw_r_k + l * 512, rw_ln_w + l * 512, rw_ln_b + l * 512, OBR + S * 512);
            hipLaunchKernelGGL(k_band_attn, dim3(SEQ * 2), dim3(256), 0, stream, Z + MLA_COLS + RW_COLS, IN_COLS, ca_rel_bias + (size_t)l * REL_SIZE * 8, OBR + 2 * S * 512);
            for (int n = 0; n < 3; ++n) gemm<0>(stream, OBR + n * S * 512, 512, w_branch + ((size_t)l * MIX_DIM + n * 512) * D_MODEL, D_MODEL, Y3 + n * S * 1024, D_MODEL, SEQ, D_MODEL, 512);
            hipLaunchKernelGGL(k_merge, dim3(2048), dim3(256), 0, stream, Z, IN_COLS, Y3, MER);
            gemm<0>(stream, MER, D_MODEL, w_out + (size_t)l * D_MODEL * D_MODEL, D_MODEL, M2, D_MODEL, SEQ, D_MODEL, D_MODEL);
            hipLaunchKernelGGL(k_rmsnorm, dim3(512), dim3(256), 0, stream, M2, D_MODEL, post_mix_g + l * D_MODEL, hb, D_MODEL, D_MODEL, SEQ, (const float*)hb);
            hipLaunchKernelGGL(k_rmsnorm, dim3(512), dim3(256), 0, stream, hb, D_MODEL, pre_ff_g + l * D_MODEL, F1, D_MODEL, D_MODEL, SEQ, (const float*)nullptr);
            gemm<1>(stream, F1, D_MODEL, w_ff1 + (size_t)l * D_MODEL * D_FF, D_FF, HID, D_FF, SEQ, D_FF, D_MODEL);
            gemm<0>(stream, HID, D_FF, w_ff2 + (size_t)l * D_FF * D_MODEL, D_MODEL, F3, D_MODEL, SEQ, D_MODEL, D_FF);
            hipLaunchKernelGGL(k_rmsnorm, dim3(512), dim3(256), 0, stream, F3, D_MODEL, post_ff_g + l * D_MODEL, hb, D_MODEL, D_MODEL, SEQ, (const float*)hb);
            gemm<2>(stream, hb, D_MODEL, w_ple_gate + (size_t)l * D_MODEL * D_MODEL, D_MODEL, GATE, D_MODEL, SEQ, D_MODEL, D_MODEL);
            gemm<0>(stream, p + ((size_t)l * BATCH + b) * S * D_PLE, D_PLE, w_ple_proj + (size_t)l * D_PLE * D_MODEL, D_MODEL, PROJ, D_MODEL, SEQ, D_MODEL, D_PLE);
            hipLaunchKernelGGL(k_ple, dim3(2048), dim3(256), 0, stream, hb, GATE, PROJ);
        }
    }
}
```

```cpp
#include <hip/hip_runtime.h>
#include <cstdio>
#include <cstdint>
#include <cmath>
namespace pg8 {
#define PG8_LAS __attribute__((address_space(3)))
typedef unsigned short bf16_t;
typedef short bf16x8 __attribute__((ext_vector_type(8)));
typedef float f32x4 __attribute__((ext_vector_type(4)));
typedef unsigned u32x4 __attribute__((ext_vector_type(4)));
constexpr int BM = 256, BK = 64, HALF = 128, HTB = HALF * BK * 2  , STAGE_BYTES = 8 * HTB, NXCD = 8, WGM = 8;

__host__ __device__ __forceinline__ int lds_byte(int r, int c) { const int st = (r >> 4) * 2 + (c >> 5), rr = r & 15, cc = c & 31, ob = rr * 64 + cc * 2; return st * 1024 + (ob ^ (((ob >> 9) & 1) << 5)); }
__host__ __device__ __forceinline__ void stage_rc(int b, int& R, int& C) { const int st = b / 1024, sb = b % 1024, swz = sb ^ (((sb >> 9) & 1) << 5); R = (st >> 1) * 16 + swz / 64; C = (st & 1) * 32 + (swz % 64) / 2; }
__host__ __device__ __forceinline__ int perm32(int rho) { const int n = rho >> 4, i = rho & 15; return 8 * (i >> 2) + 4 * n + (i & 3); }

struct Unit { int pm, pn; };
struct Gemm { const bf16_t* A; const bf16_t* Bt; int M, N, K; };

struct StaticOrder {
    int nM, nN, nwg, G, c;
    __host__ __device__ void init(int M, int N, int G_, int c_) { nM = M / BM; nN = N / BM; nwg = nM * nN; G = G_; c = c_; }
    __host__ __device__ bool next(int i, Unit& u) const {
        const long L = (long)i * G + c; if (L >= nwg) return false;
        int wgid = (int)L; { const int q = nwg / NXCD, r = nwg % NXCD, xcd = wgid % NXCD, off = wgid / NXCD; wgid = (xcd < r ? xcd * (q + 1) : r * (q + 1) + (xcd - r) * q) + off; }
        const int nig = WGM * nN, gid = wgid / nig, fm = gid * WGM, gsz = (nM - fm) < WGM ? (nM - fm) : WGM;
        u.pm = fm + ((wgid % nig) % gsz); u.pn = (wgid % nig) / gsz; return true;
    }
    __device__ __forceinline__ void a_ready(const Unit&) const {}
    __device__ __forceinline__ void done(const Unit&) const {}
};

__device__ __forceinline__ unsigned cvt_pk_bf16(float lo, float hi) { unsigned r; asm volatile("v_cvt_pk_bf16_f32 %0, %1, %2" : "=v"(r) : "v"(lo), "v"(hi)); return r; }
typedef float f32x2 __attribute__((ext_vector_type(2)));
__device__ __forceinline__ f32x2 gelu_pk(f32x2 v) {
    const f32x2 av = __builtin_elementwise_abs(v), d = av * 0.2316418882f + 1.0f;
    f32x2 t; t.x = __builtin_amdgcn_rcpf(d.x); t.y = __builtin_amdgcn_rcpf(d.y);
    f32x2 q = t * 0.5307027145f + (-0.7265760135f); q = q * t + 0.7107068705f; q = q * t + (-0.142248368f); q = q * t + 0.127414796f; q = q * t;
    const f32x2 s = (v * v) * (-0.72134752044f);
    f32x2 e; e.x = __builtin_amdgcn_exp2f(s.x); e.y = __builtin_amdgcn_exp2f(s.y);
    const f32x2 m = v * (q * e), r = v - m;
    f32x2 o; o.x = v.x < 0.f ? m.x : r.x; o.y = v.y < 0.f ? m.y : r.y; return o;
}

template <int ACT  > struct EpiBf16 {
    static constexpr bool PERM = true, AFTER_DRAIN = false; static_assert(ACT == 0 || ACT == 1, "EpiBf16: ACT is 0 (none) or 1 (gelu_pk)");
    bf16_t* O; int ldc; const float* bias; int split_cols; size_t split_stride; float scale0;
    __device__ __forceinline__ void operator()(const f32x4 (&acc)[2][2][4][2], const Unit& u, int wr, int wc, int fr, int fq) const {
        const int row0 = u.pm * BM + wr * 64 + fr; int colt = u.pn * BM; bf16_t* base = O;
        float sc = 1.f; if (split_cols) { const int t = colt / split_cols; base += (size_t)t * split_stride; colt -= t * split_cols; if (t == 0) sc = scale0; }
        const int col0 = colt + wc * 32 + 8 * fq, bcol0 = u.pn * BM + wc * 32 + 8 * fq;
        f32x4 bv[2][2];
#pragma unroll
        for (int bj = 0; bj < 2; ++bj)
#pragma unroll
            for (int n = 0; n < 2; ++n) bv[bj][n] = bias ? *(const f32x4*)(bias + bcol0 + bj * HALF + 4 * n) : (f32x4){0.f, 0.f, 0.f, 0.f};
#pragma unroll
        for (int ai = 0; ai < 2; ++ai)
#pragma unroll
            for (int m = 0; m < 4; ++m) { bf16_t* rowp = base + (size_t)(row0 + ai * HALF + m * 16) * ldc + col0;
#pragma unroll
                for (int bj = 0; bj < 2; ++bj) { f32x4 v0 = acc[ai][bj][m][0] + bv[bj][0], v1 = acc[ai][bj][m][1] + bv[bj][1];
                    if (ACT == 1) { f32x2 a = gelu_pk((f32x2){v0[0], v0[1]}), b = gelu_pk((f32x2){v0[2], v0[3]}), c = gelu_pk((f32x2){v1[0], v1[1]}), d = gelu_pk((f32x2){v1[2], v1[3]});
                        v0 = (f32x4){a.x, a.y, b.x, b.y}; v1 = (f32x4){c.x, c.y, d.x, d.y}; }
                    v0 = v0 * sc; v1 = v1 * sc; u32x4 w; w.x = cvt_pk_bf16(v0[0], v0[1]); w.y = cvt_pk_bf16(v0[2], v0[3]); w.z = cvt_pk_bf16(v1[0], v1[1]); w.w = cvt_pk_bf16(v1[2], v1[3]);
                    *(u32x4*)(rowp + bj * HALF) = w; } }
    }
};
__device__ __forceinline__ float bf2f(unsigned short b) { return __uint_as_float((unsigned)b << 16); }
__device__ __forceinline__ float sigm(float x) { return __builtin_amdgcn_rcpf(1.0f + __builtin_amdgcn_exp2f(-1.4426950408889634f * x)); }
__device__ __forceinline__ void unpack8(const u32x4 w, float (&f)[8]) {
    f[0] = __uint_as_float(w.x << 16); f[1] = __uint_as_float(w.x & 0xffff0000u); f[2] = __uint_as_float(w.y << 16); f[3] = __uint_as_float(w.y & 0xffff0000u);
    f[4] = __uint_as_float(w.z << 16); f[5] = __uint_as_float(w.z & 0xffff0000u); f[6] = __uint_as_float(w.w << 16); f[7] = __uint_as_float(w.w & 0xffff0000u);
}
template <int ACT> struct EpiRoute {
    static constexpr bool PERM = true, AFTER_DRAIN = false;
    bf16_t* O0; int ld0; int nt0; float sc0;
    bf16_t* O1; int ld1; int nts1; float sc1;
    __device__ __forceinline__ void operator()(const f32x4 (&acc)[2][2][4][2], const Unit& u, int wr, int wc, int fr, int fq) const {
        const int row0 = u.pm * BM + wr * 64 + fr;
        bf16_t* base; int ld, colt; float sc = 1.f;
        if (u.pn < nt0) { base = O0; ld = ld0; colt = u.pn * BM; sc = sc0; } else { base = O1; ld = ld1; colt = (u.pn - nt0) * BM; if (u.pn - nt0 < nts1) sc = sc1; }
        const int col0 = colt + wc * 32 + 8 * fq;
#pragma unroll
        for (int ai = 0; ai < 2; ++ai)
#pragma unroll
            for (int m = 0; m < 4; ++m) { bf16_t* rowp = base + (size_t)(row0 + ai * HALF + m * 16) * ld + col0;
#pragma unroll
                for (int bj = 0; bj < 2; ++bj) { f32x4 v0 = acc[ai][bj][m][0], v1 = acc[ai][bj][m][1];
                    if (ACT == 1) { for (int e = 0; e < 4; ++e) { v0[e] = sigm(v0[e]); v1[e] = sigm(v1[e]); } }
                    if (ACT == 2) { for (int e = 0; e < 4; ++e) { const float a = fmaxf(v0[e], 0.f), b = fmaxf(v1[e], 0.f); v0[e] = a * a; v1[e] = b * b; } }
                    v0 = v0 * sc; v1 = v1 * sc; u32x4 w; w.x = cvt_pk_bf16(v0[0], v0[1]); w.y = cvt_pk_bf16(v0[2], v0[3]); w.z = cvt_pk_bf16(v1[0], v1[1]); w.w = cvt_pk_bf16(v1[2], v1[3]);
                    *(u32x4*)(rowp + bj * HALF) = w; } }
    }
};
struct EpiQRope {
    static constexpr bool PERM = true, AFTER_DRAIN = false;
    bf16_t* O; const float* rope; float sc;
    __device__ __forceinline__ void operator()(const f32x4 (&acc)[2][2][4][2], const Unit& u, int wr, int wc, int fr, int fq) const {
        const int row0 = u.pm * BM + wr * 64 + fr; const int col0 = u.pn * BM + wc * 32 + 8 * fq;
#pragma unroll
        for (int ai = 0; ai < 2; ++ai)
#pragma unroll
            for (int m = 0; m < 4; ++m) { const int row = row0 + ai * HALF + m * 16;
#pragma unroll
                for (int bj = 0; bj < 2; ++bj) { const int cg = col0 + bj * HALF; const int cm = cg % 192; f32x4 v0 = acc[ai][bj][m][0], v1 = acc[ai][bj][m][1];
                    if (cm >= 128) { const int j0 = (cm - 128) >> 1; const f32x4* rp = (const f32x4*)(rope + ((size_t)row * 32 + j0) * 2); const f32x4 a = rp[0], b = rp[1];
                        f32x4 r0, r1;
                        r0[0] = v0[0] * a[0] - v0[1] * a[1]; r0[1] = v0[1] * a[0] + v0[0] * a[1]; r0[2] = v0[2] * a[2] - v0[3] * a[3]; r0[3] = v0[3] * a[2] + v0[2] * a[3];
                        r1[0] = v1[0] * b[0] - v1[1] * b[1]; r1[1] = v1[1] * b[0] + v1[0] * b[1]; r1[2] = v1[2] * b[2] - v1[3] * b[3]; r1[3] = v1[3] * b[2] + v1[2] * b[3];
                        v0 = r0; v1 = r1; }
                    v0 = v0 * sc; v1 = v1 * sc; u32x4 w; w.x = cvt_pk_bf16(v0[0], v0[1]); w.y = cvt_pk_bf16(v0[2], v0[3]); w.z = cvt_pk_bf16(v1[0], v1[1]); w.w = cvt_pk_bf16(v1[2], v1[3]);
                    *(u32x4*)(O + (size_t)row * 768 + cg) = w; } }
    }
};
template <int NI> struct EpiMerge {
    static constexpr bool PERM = true, AFTER_DRAIN = false;
    bf16_t* MG; const bf16_t* GT;
    __device__ __forceinline__ void operator()(const f32x4 (&acc)[2][2][4][2], const Unit& u, int wr, int wc, int fr, int fq) const {
        const int row0 = u.pm * BM + wr * 64 + fr; const int col0 = u.pn * BM + wc * 32 + 8 * fq;
#pragma unroll
        for (int ai = 0; ai < 2; ++ai)
#pragma unroll
            for (int m = 0; m < 4; ++m) { const int row = row0 + ai * HALF + m * 16;
#pragma unroll
                for (int bj = 0; bj < 2; ++bj) { const int c = col0 + bj * HALF; const f32x4 v0 = acc[ai][bj][m][0], v1 = acc[ai][bj][m][1];
                    float g[8]; unpack8(*(const u32x4*)(GT + (size_t)row * 3072 + NI * 1024 + c), g);
                    for (int e = 0; e < 8; ++e) g[e] = sigm(g[e]);
                    float o[8];
                    if (NI > 0) unpack8(*(const u32x4*)(MG + (size_t)row * 1024 + c), o); else { for (int e = 0; e < 8; ++e) o[e] = 0.f; }
                    for (int e = 0; e < 4; ++e) { o[e] += g[e] * v0[e]; o[4 + e] += g[4 + e] * v1[e]; }
                    u32x4 w; w.x = cvt_pk_bf16(o[0], o[1]); w.y = cvt_pk_bf16(o[2], o[3]); w.z = cvt_pk_bf16(o[4], o[5]); w.w = cvt_pk_bf16(o[6], o[7]);
                    *(u32x4*)(MG + (size_t)row * 1024 + c) = w; } }
    }
};
struct EpiPle {
    static constexpr bool PERM = true, AFTER_DRAIN = false;
    float* H; const bf16_t* PP;
    __device__ __forceinline__ void operator()(const f32x4 (&acc)[2][2][4][2], const Unit& u, int wr, int wc, int fr, int fq) const {
        const int row0 = u.pm * BM + wr * 64 + fr; const int col0 = u.pn * BM + wc * 32 + 8 * fq;
#pragma unroll
        for (int ai = 0; ai < 2; ++ai)
#pragma unroll
            for (int m = 0; m < 4; ++m) { const int row = row0 + ai * HALF + m * 16;
#pragma unroll
                for (int bj = 0; bj < 2; ++bj) { const int c = col0 + bj * HALF; const f32x4 v0 = acc[ai][bj][m][0], v1 = acc[ai][bj][m][1];
                    float p[8]; unpack8(*(const u32x4*)(PP + (size_t)row * 1024 + c), p);
                    f32x4* hp = (f32x4*)(H + (size_t)row * 1024 + c); f32x4 h0 = hp[0], h1 = hp[1];
                    for (int e = 0; e < 4; ++e) { h0[e] += sigm(v0[e]) * p[e]; h1[e] += sigm(v1[e]) * p[4 + e]; }
                    hp[0] = h0; hp[1] = h1; } }
    }
};
template <class Epi, class Sched, bool ALIGN_EPI = false, bool SP2 = false>
__device__ __forceinline__ void gemm_phase(PG8_LAS unsigned char* lds, const Gemm g, const Sched& S, const Epi& E) {
    int tid_ = threadIdx.x; asm volatile("" : "+v"(tid_));
    const int tid = tid_, wid = __builtin_amdgcn_readfirstlane(tid >> 6), lane = tid & 63, wr = wid >> 2, wc = wid & 3, fr = lane & 15, fq = lane >> 4;
    const int K = g.K, nt = K / BK;
    unsigned voffA[2], voffB[2];
#pragma unroll
    for (int i = 0; i < 2; ++i) { int R, C; stage_rc(tid * 16 + i * 8192, R, C); const int Rb = Epi::PERM ? ((R & ~31) + perm32(R & 31)) : R;
        voffA[i] = (unsigned)(R * K + C) * 2u; voffB[i] = (unsigned)(Rb * K + C) * 2u; }
    const size_t kstep = (size_t)(BK * 2);
    const size_t hstep = (size_t)HALF * K * 2;
    const size_t tstep = 2 * hstep;
    const unsigned ldsw = (unsigned)wid * 1024u;
    const int aoff = lds_byte(wr * 64 + fr, fq * 8), boff = lds_byte(wc * 32 + fr, fq * 8);
#define PG8_SA(b, h) (((b) * 2 + (h)) * HTB)
#define PG8_SB(b, h) ((4 + (b) * 2 + (h)) * HTB)
#define PG8_STAGE(bufoff, gbase, voff) do { _Pragma("unroll") for (int _i = 0; _i < 2; ++_i) \
        __builtin_amdgcn_global_load_lds((const unsigned*)((const char*)(gbase) + (voff)[_i]), (PG8_LAS unsigned*)(lds + (bufoff) + ldsw + _i * 8192), 16, 0, 0); } while (0)
#define PG8_LDA(dst, b, h) do { _Pragma("unroll") for (int m = 0; m < 4; ++m) _Pragma("unroll") for (int k = 0; k < 2; ++k) dst[m][k] = *(const PG8_LAS bf16x8*)(lds + PG8_SA(b, h) + aoff + m * 2048 + k * 1024); } while (0)
#define PG8_LDB(dst, b, h) do { _Pragma("unroll") for (int n = 0; n < 2; ++n) _Pragma("unroll") for (int k = 0; k < 2; ++k) dst[n][k] = *(const PG8_LAS bf16x8*)(lds + PG8_SB(b, h) + boff + n * 2048 + k * 1024); } while (0)
#define PG8_MMA(ai, bj, At, Bt) do { __builtin_amdgcn_s_setprio(1); _Pragma("unroll") for (int m = 0; m < 4; ++m) _Pragma("unroll") for (int n = 0; n < 2; ++n) _Pragma("unroll") for (int k = 0; k < 2; ++k) \
        acc[ai][bj][m][n] = __builtin_amdgcn_mfma_f32_16x16x32_bf16(Bt[n][k], At[m][k], acc[ai][bj][m][n], 0, 0, 0); __builtin_amdgcn_s_setprio(0); } while (0)
#define PG8_WAIT_V(n) asm volatile("s_waitcnt vmcnt(" #n ")" ::: "memory")
#define PG8_WAIT_L(n) asm volatile("s_waitcnt lgkmcnt(" #n ")" ::: "memory")
#define PG8_BAR __builtin_amdgcn_s_barrier()
#define PG8_SCHED __builtin_amdgcn_sched_barrier(0)
    Unit cur, nxt; int ui = 0;
    if (!S.next(0, cur)) return;
    f32x4 acc[2][2][4][2];
#pragma unroll
    for (int a = 0; a < 2; ++a)
#pragma unroll
        for (int b = 0; b < 2; ++b)
#pragma unroll
            for (int m = 0; m < 4; ++m)
#pragma unroll
                for (int n = 0; n < 2; ++n) acc[a][b][m][n] = (f32x4){0.f, 0.f, 0.f, 0.f};
    bf16x8 At[4][2], B0[2][2], B1[2][2];
    const char* cA = (const char*)g.A + (size_t)cur.pm * tstep; const char* cB = (const char*)g.Bt + (size_t)cur.pn * tstep;
    S.a_ready(cur);
    if constexpr (SP2) {
        PG8_STAGE(PG8_SB(0, 0), cB, voffB); PG8_STAGE(PG8_SB(0, 1), cB + hstep, voffB); PG8_STAGE(PG8_SA(0, 0), cA, voffA); PG8_STAGE(PG8_SA(0, 1), cA + hstep, voffA);
        if (wr == 1) PG8_BAR;
        PG8_WAIT_V(2); PG8_BAR;
        PG8_STAGE(PG8_SB(1, 0), cB + kstep, voffB); PG8_STAGE(PG8_SA(1, 0), cA + kstep, voffA); PG8_STAGE(PG8_SB(1, 1), cB + hstep + kstep, voffB);
        PG8_WAIT_V(6); PG8_BAR;
    } else {
        PG8_STAGE(PG8_SB(0, 0), cB, voffB); PG8_STAGE(PG8_SA(0, 0), cA, voffA); PG8_STAGE(PG8_SB(0, 1), cB + hstep, voffB); PG8_STAGE(PG8_SA(0, 1), cA + hstep, voffA);
        if (wr == 1) PG8_BAR;
        PG8_WAIT_V(4); PG8_BAR;
        PG8_STAGE(PG8_SB(1, 0), cB + kstep, voffB); PG8_STAGE(PG8_SA(1, 0), cA + kstep, voffA); PG8_STAGE(PG8_SB(1, 1), cB + hstep + kstep, voffB);
        PG8_WAIT_V(6); PG8_BAR;
    }
    for (;;) {
        const bool has_next = S.next(ui + 1, nxt);
        const char* nA = has_next ? (const char*)g.A + (size_t)nxt.pm * tstep : cA; const char* nB = has_next ? (const char*)g.Bt + (size_t)nxt.pn * tstep : cB;
        for (int t = 0; t < nt; t += 2) {
            const bool last = (t == nt - 2);
            const char* a1 = cA + (size_t)(t + 1) * kstep;
            const char* a2 = last ? nA : cA + (size_t)(t + 2) * kstep; const char* b2 = last ? nB : cB + (size_t)(t + 2) * kstep;
            const char* a3 = a2 + kstep; const char* b3 = b2 + kstep;
            if (last && has_next) S.a_ready(nxt);
            if constexpr (SP2) {
            PG8_LDB(B0, 0, 0); PG8_LDB(B1, 0, 1); PG8_SCHED; PG8_LDA(At, 0, 0); PG8_STAGE(PG8_SA(1, 1), a1 + hstep, voffA);
            PG8_WAIT_V(8); PG8_WAIT_L(0); PG8_BAR; PG8_MMA(0, 0, At, B0); PG8_MMA(0, 1, At, B1); PG8_BAR; PG8_SCHED;
            PG8_LDA(At, 0, 1); PG8_STAGE(PG8_SB(0, 0), b2, voffB); PG8_STAGE(PG8_SB(0, 1), b2 + hstep, voffB); PG8_STAGE(PG8_SA(0, 0), a2, voffA);
            PG8_WAIT_V(8); PG8_WAIT_L(0); PG8_BAR; PG8_MMA(1, 0, At, B0); PG8_MMA(1, 1, At, B1); PG8_BAR; PG8_SCHED;
            PG8_LDB(B0, 1, 0); PG8_LDB(B1, 1, 1); PG8_SCHED; PG8_LDA(At, 1, 0); PG8_STAGE(PG8_SA(0, 1), a2 + hstep, voffA);
            PG8_WAIT_V(8); PG8_WAIT_L(0); PG8_BAR; PG8_MMA(0, 0, At, B0); PG8_MMA(0, 1, At, B1); PG8_BAR; PG8_SCHED;
            PG8_LDA(At, 1, 1); PG8_STAGE(PG8_SB(1, 0), b3, voffB); PG8_STAGE(PG8_SB(1, 1), b3 + hstep, voffB); PG8_STAGE(PG8_SA(1, 0), a3, voffA);
            PG8_WAIT_V(8); PG8_WAIT_L(0); PG8_BAR; PG8_MMA(1, 0, At, B0); PG8_MMA(1, 1, At, B1); PG8_BAR; PG8_SCHED;
            } else {
            PG8_LDB(B0, 0, 0); PG8_SCHED; PG8_LDA(At, 0, 0); PG8_STAGE(PG8_SA(1, 1), a1 + hstep, voffA);
            PG8_WAIT_L(8); PG8_BAR; PG8_WAIT_L(0); PG8_MMA(0, 0, At, B0); PG8_BAR; PG8_SCHED;
            PG8_LDB(B1, 0, 1); PG8_STAGE(PG8_SB(0, 0), b2, voffB);
            PG8_BAR; PG8_WAIT_L(0); PG8_MMA(0, 1, At, B1); PG8_BAR;
            PG8_LDA(At, 0, 1); PG8_STAGE(PG8_SA(0, 0), a2, voffA);
            PG8_BAR; PG8_WAIT_L(0); PG8_MMA(1, 0, At, B0); PG8_BAR; PG8_SCHED;
            PG8_STAGE(PG8_SB(0, 1), b2 + hstep, voffB);
            PG8_WAIT_V(6); PG8_BAR; PG8_MMA(1, 1, At, B1); PG8_BAR;
            PG8_LDB(B0, 1, 0); PG8_SCHED; PG8_LDA(At, 1, 0); PG8_STAGE(PG8_SA(0, 1), a2 + hstep, voffA);
            PG8_WAIT_L(8); PG8_BAR; PG8_WAIT_L(0); PG8_MMA(0, 0, At, B0); PG8_BAR; PG8_SCHED;
            PG8_LDB(B1, 1, 1); PG8_STAGE(PG8_SB(1, 0), b3, voffB);
            PG8_BAR; PG8_WAIT_L(0); PG8_MMA(0, 1, At, B1); PG8_BAR;
            PG8_LDA(At, 1, 1); PG8_STAGE(PG8_SA(1, 0), a3, voffA);
            PG8_BAR; PG8_WAIT_L(0); PG8_MMA(1, 0, At, B0); PG8_BAR; PG8_SCHED;
            PG8_STAGE(PG8_SB(1, 1), b3 + hstep, voffB);
            PG8_WAIT_V(6); PG8_BAR; PG8_MMA(1, 1, At, B1); PG8_BAR;
            }
        }
        if constexpr (ALIGN_EPI) { if (wr == 0) PG8_BAR; }
        if constexpr (!Epi::AFTER_DRAIN) { int t2_ = threadIdx.x; asm volatile("" : "+v"(t2_)); const int l2_ = t2_ & 63, w2_ = __builtin_amdgcn_readfirstlane(t2_ >> 6);
            E(acc, cur, w2_ >> 2, w2_ & 3, l2_ & 15, l2_ >> 4); S.done(cur); }
        if (!has_next) break;
#pragma unroll
        for (int a = 0; a < 2; ++a)
#pragma unroll
            for (int b = 0; b < 2; ++b)
#pragma unroll
                for (int m = 0; m < 4; ++m)
#pragma unroll
                    for (int n = 0; n < 2; ++n) acc[a][b][m][n] = (f32x4){0.f, 0.f, 0.f, 0.f};
        cur = nxt; cA = nA; cB = nB; ++ui;
        if constexpr (ALIGN_EPI) { if (wr == 1) PG8_BAR; }
    }
    PG8_WAIT_V(0);
    if constexpr (!ALIGN_EPI) { if (wr == 0) PG8_BAR; }
    PG8_BAR;
    if constexpr (Epi::AFTER_DRAIN) { E.fused(acc, cur, wr, wc, fr, fq, lds, wid, lane); S.done(cur); }
#undef PG8_SA
#undef PG8_SB
#undef PG8_STAGE
#undef PG8_LDA
#undef PG8_LDB
#undef PG8_MMA
#undef PG8_WAIT_V
#undef PG8_WAIT_L
#undef PG8_BAR
#undef PG8_SCHED
}
}
constexpr int NWAVES = 8;
constexpr int D = 1024, BATCH = 8, SEQ = 4096, T = BATCH * SEQ, DEPTH = 2, FF = 4096, DPLE = 256;
constexpr int IN_COLS = 6848, RW_COLS = 1792;
constexpr float NORM_EPS = 1e-6f, RW_LN_EPS = 64e-5f;
constexpr float LOG2E = 1.4426950408889634f;
constexpr float MLA_QSCALE = 0.07216878364870322f * LOG2E;
constexpr float CA_QSCALE = 0.125f * LOG2E;
constexpr size_t MiB = 1u << 20;
constexpr size_t WS_CTL = 0, CTL_ZERO_BYTES = 1 * MiB;
constexpr size_t WS_ROPE = 1 * MiB;
constexpr size_t WS_W = 9 * MiB;
constexpr size_t W_IN = WS_W, W_Q = W_IN + (size_t)6912 * 1024 * 2, W_LORA = W_Q + (size_t)768 * 256 * 2, W_B = W_LORA + (size_t)1536 * 256 * 2,
                 W_OUT = W_B + (size_t)3 * 1024 * 512 * 2, W_1 = W_OUT + (size_t)1024 * 1024 * 2, W_2 = W_1 + (size_t)4096 * 1024 * 2, W_G = W_2 + (size_t)4096 * 1024 * 2,
                 W_P = W_G + (size_t)1024 * 1024 * 2, W_END = W_P + (size_t)1024 * 256 * 2;
constexpr size_t WS_U = 49 * MiB;
constexpr size_t WS_OA = 113 * MiB, WS_OC = 145 * MiB, WS_ORW = 177 * MiB;
constexpr size_t WS_X = 209 * MiB, WS_END = 465 * MiB;
static_assert(W_END <= WS_U, "weights fit");
constexpr size_t X_ZC = WS_X, X_QN = X_ZC + (size_t)T * 1536 * 2, X_QP = X_QN + (size_t)T * 256 * 2, X_KV = X_QP + (size_t)T * 768 * 2;
constexpr size_t X_ZR = WS_X, X_LA = X_ZR + (size_t)T * 1792 * 2, X_LO = X_LA + (size_t)T * 256 * 2;
constexpr size_t X_GT = WS_X, X_MG = X_GT + (size_t)T * 3072 * 2;
constexpr size_t X_HID = WS_X, X_PB = WS_X, X_PP = X_PB + (size_t)T * 256 * 2;
static_assert(X_KV + (size_t)T * 192 * 2 <= WS_END && X_LO + (size_t)T * 1536 * 2 <= WS_END && X_MG + (size_t)T * 1024 * 2 <= WS_END && X_HID + (size_t)T * 4096 * 2 <= WS_END, "X map");
constexpr int CW_TMO = 0, CW_BAR = 4096;
constexpr int RING_OFF = 0, RING_BYTES = 131072;
constexpr int LDSCTL_OFF = RING_BYTES, MISC_OFF = LDSCTL_OFF + 320;
constexpr int LDS_BYTES = 147456;

#define GAS __attribute__((address_space(1)))
#define LAS __attribute__((address_space(3)))
typedef unsigned short bf16;
typedef unsigned v4u __attribute__((ext_vector_type(4)));
typedef unsigned v2u __attribute__((ext_vector_type(2)));
typedef float f32x4 __attribute__((ext_vector_type(4)));
typedef float f32x16 __attribute__((ext_vector_type(16)));
typedef short bf16x8 __attribute__((ext_vector_type(8)));
typedef short s16x4 __attribute__((ext_vector_type(4)));
#define LDS_WAIT() asm volatile("s_waitcnt lgkmcnt(0)" ::: "memory")
#define VM_WAIT() asm volatile("s_waitcnt vmcnt(0)" ::: "memory")
__device__ __forceinline__ unsigned f2bf(float f) { unsigned u = __builtin_bit_cast(unsigned, f); return (u + 0x7fffu + ((u >> 16) & 1u)) >> 16; }
__device__ __forceinline__ unsigned pk2(float lo, float hi) { return f2bf(lo) | (f2bf(hi) << 16); }
__device__ __forceinline__ float bfl(unsigned w) { return __uint_as_float(w << 16); }
__device__ __forceinline__ float bfh(unsigned w) { return __uint_as_float(w & 0xffff0000u); }
__device__ __forceinline__ float sigmoidf_(float x) { return 1.0f / (1.0f + __expf(-x)); }
__device__ __forceinline__ float shfl_xor_f(float v, int o, int lane) { return __int_as_float(__builtin_amdgcn_ds_bpermute((lane ^ o) << 2, __float_as_int(v))); }
__device__ __forceinline__ float wave_sum(float v, int lane) {
#pragma unroll
    for (int o = 1; o < 64; o <<= 1) v += shfl_xor_f(v, o, lane);
    return v;
}
__device__ __forceinline__ unsigned char* opq(unsigned char* p) { asm volatile("" : "+s"(p)); return p; }
__device__ __forceinline__ float fsig(float x) { return __builtin_amdgcn_rcpf(1.0f + __builtin_amdgcn_exp2f(-LOG2E * x)); }
#define XB_TMO      128
#define XB_XCNT(j)  (256  + 64 * (j))
#define XB_XSUB(j)  (1280 + 64 * (j))
#define XB_XGEN(j)  (2304 + 64 * (j))
#define XB_TOP      3328
#define XB_TOPGEN   3392
#define XCD_BAR_WORDS 3456
#define XB_SPIN_CAP (1u << 25)

__device__ __forceinline__ unsigned xb_ld(unsigned* p)              { return __hip_atomic_load(p, __ATOMIC_RELAXED, __HIP_MEMORY_SCOPE_AGENT); }
__device__ __forceinline__ unsigned xb_add(unsigned* p, unsigned v) { return __hip_atomic_fetch_add(p, v, __ATOMIC_RELAXED, __HIP_MEMORY_SCOPE_AGENT); }
__device__ __forceinline__ unsigned xb_xcc_id() { return (unsigned)__builtin_amdgcn_s_getreg((3 << 11) | 20) & 0xFu; }
#define XB_SPIN(cond, bar) do { unsigned _sp = 0; while (cond) { __builtin_amdgcn_s_sleep(1); \
    if ((++_sp & 255u) == 0u) { if (xb_ld(&(bar)[XB_TMO])) break; if (_sp > XB_SPIN_CAP) { atomicAdd(&(bar)[XB_TMO], 1u); break; } } } } while (0)

struct XcdBarrier {
    unsigned* bar; unsigned x;
    volatile LAS unsigned* st;
};

__device__ __forceinline__ XcdBarrier xcd_barrier_post(unsigned* bar, volatile LAS unsigned* st) {
    XcdBarrier b; b.bar = bar; b.x = xb_xcc_id(); b.st = st;
    if (threadIdx.x == 0) (void)xb_add(&bar[XB_XCNT(b.x)], 1u);
    return b;
}
__device__ __forceinline__ void xcd_barrier_complete(unsigned* bar, unsigned x, unsigned& nloc, unsigned& nx) {
    const unsigned G = gridDim.x * gridDim.y * gridDim.z;
    unsigned sum, cnt, mine, sp = 0u;
    for (;;) {
        sum = 0u; cnt = 0u; mine = 0u;
#pragma unroll
        for (unsigned j = 0; j < 16; ++j) { const unsigned c = xb_ld(&bar[XB_XCNT(j)]); sum += c; cnt += (c > 0u) ? 1u : 0u; mine = (j == x) ? c : mine; }
        if (sum == G) break;
        __builtin_amdgcn_s_sleep(1);
        if ((++sp & 255u) == 0u) { if (xb_ld(&bar[XB_TMO])) break; if (sp > XB_SPIN_CAP) { atomicAdd(&bar[XB_TMO], 1u); break; } }
    }
    nloc = mine > 0u ? mine : 1u; nx = cnt > 0u ? cnt : 1u;
}

__device__ __forceinline__ void xcd_barrier(const XcdBarrier& b) {
    asm volatile("s_waitcnt vmcnt(0)" ::: "memory");
    __syncthreads();
    if (threadIdx.x == 0) {
        unsigned* bar = b.bar;
        __builtin_amdgcn_s_waitcnt(0);
        unsigned nloc = b.st[0], nx = b.st[1];
        if (nloc == 0u) { xcd_barrier_complete(bar, b.x, nloc, nx); b.st[0] = nloc; b.st[1] = nx; }
        const unsigned old = xb_add(&bar[XB_XSUB(b.x)], 1u);
        const unsigned gen = old / nloc;
        if (old + 1u == (gen + 1u) * nloc) {
            __builtin_amdgcn_fence(__ATOMIC_RELEASE, "agent");
            asm volatile("s_waitcnt vmcnt(0)" ::: "memory");
            const unsigned og = xb_add(&bar[XB_TOP], 1u);
            const unsigned tg = og / nx;
            if (og + 1u == (tg + 1u) * nx) xb_add(&bar[XB_TOPGEN], 1u);
            else XB_SPIN(xb_ld(&bar[XB_TOPGEN]) == tg, bar);
            __builtin_amdgcn_fence(__ATOMIC_ACQUIRE, "agent");
            xb_add(&bar[XB_XGEN(b.x)], 1u);
            asm volatile("s_waitcnt vmcnt(0)" ::: "memory");
        } else {
            XB_SPIN(xb_ld(&bar[XB_XGEN(b.x)]) == gen, bar);
            __builtin_amdgcn_fence(__ATOMIC_ACQUIRE, "agent");
            asm volatile("s_waitcnt vmcnt(0)" ::: "memory");
        }
    }
    __syncthreads();
}
namespace att {
__device__ __forceinline__ int crow(int r, int hi) { return (r & 3) + 8 * (r >> 2) + 4 * hi; }
__device__ __forceinline__ unsigned cvtpk(float lo, float hi) { unsigned r; asm volatile("v_cvt_pk_bf16_f32 %0, %1, %2" : "=v"(r) : "v"(lo), "v"(hi)); return r; }
typedef short v4i16_t __attribute__((ext_vector_type(4)));
__device__ __forceinline__ s16x4 vtr(const LAS unsigned char* p) { return __builtin_bit_cast(s16x4, __builtin_amdgcn_ds_read_tr16_b64_v4i16((LAS v4i16_t*)p)); }
__device__ __forceinline__ float softmax_tile(f32x16& p0, f32x16& p1, float& m_reg, float& l_reg, bf16x8& pa0, bf16x8& pa1, bf16x8& pa2, bf16x8& pa3) {
    float pmax = p0[0];
#pragma unroll
    for (int r = 1; r < 16; ++r) pmax = fmaxf(pmax, p0[r]);
#pragma unroll
    for (int r = 0; r < 16; ++r) pmax = fmaxf(pmax, p1[r]);
    { auto rr = __builtin_amdgcn_permlane32_swap(__float_as_uint(pmax), __float_as_uint(pmax), false, false); pmax = fmaxf(__uint_as_float(rr[0]), __uint_as_float(rr[1])); }
    float alpha = 1.f;
    if (!__all(pmax - m_reg <= 8.f)) { const float mn = fmaxf(m_reg, pmax); alpha = __builtin_amdgcn_exp2f(m_reg - mn); m_reg = mn; }
    float ps = 0.f;
#pragma unroll
    for (int r = 0; r < 16; ++r) { p0[r] = __builtin_amdgcn_exp2f(p0[r] - m_reg); ps += p0[r]; }
#pragma unroll
    for (int r = 0; r < 16; ++r) { p1[r] = __builtin_amdgcn_exp2f(p1[r] - m_reg); ps += p1[r]; }
    { auto rr = __builtin_amdgcn_permlane32_swap(__float_as_uint(ps), __float_as_uint(ps), false, false); ps = __uint_as_float(rr[0]) + __uint_as_float(rr[1]); }
    l_reg = l_reg * alpha + ps;
#define PK4(P, BASE, OUT) do { unsigned a0 = cvtpk(P[BASE + 0], P[BASE + 1]), a1 = cvtpk(P[BASE + 2], P[BASE + 3]);   \
    unsigned b0 = cvtpk(P[BASE + 4], P[BASE + 5]), b1 = cvtpk(P[BASE + 6], P[BASE + 7]);                              \
    auto r0 = __builtin_amdgcn_permlane32_swap(a0, b0, false, false); auto r1 = __builtin_amdgcn_permlane32_swap(a1, b1, false, false); \
    v4u w = {r0[0], r1[0], r0[1], r1[1]}; OUT = __builtin_bit_cast(bf16x8, w); } while (0)
    PK4(p0, 0, pa0); PK4(p0, 8, pa1); PK4(p1, 0, pa2); PK4(p1, 8, pa3);
#undef PK4
    return alpha;
}
constexpr int MLA_KSTR = 400;
constexpr int MLA_KBUF = 64 * MLA_KSTR;
constexpr int ATT_SCR = 2 * MLA_KBUF;
__device__ __forceinline__ void mla_unit(LAS unsigned char* lds, const bf16* __restrict__ QP, const bf16* __restrict__ KV, bf16* __restrict__ OA, int b, int c) {
    int tid_ = threadIdx.x; asm volatile("" : "+v"(tid_));
    const int tid = tid_, lane = tid & 63, wid = __builtin_amdgcn_readfirstlane(tid >> 6), r32 = lane & 31, hi = lane >> 5;
    const int h = wid >> 1; const size_t qrow0 = (size_t)b * SEQ + c * 64 + (wid & 1) * 32;
    bf16x8 qr[12];
    { const bf16* qp = QP + (qrow0 + r32) * 768 + h * 192 + hi * 8;
#pragma unroll
      for (int d0 = 0; d0 < 12; ++d0) qr[d0] = *(const bf16x8*)(qp + d0 * 16); }
    float m_reg = -1e30f, l_reg = 0.f; f32x16 o[4];
#pragma unroll
    for (int d = 0; d < 4; ++d)
#pragma unroll
        for (int r = 0; r < 16; ++r) o[d][r] = 0.f;
    LAS float* scr = (LAS float*)(lds + ATT_SCR) + wid * 64;
    const bf16* kvb = KV + (size_t)b * SEQ * 192;
    int skey[3], sch[3];
#pragma unroll
    for (int i = 0; i < 3; ++i) { const int id = tid + 512 * i; skey[i] = id / 24; sch[i] = id % 24; }
    v4u st[3];
    const int NT = c + 1;
#pragma unroll
    for (int i = 0; i < 3; ++i) st[i] = *(const v4u*)(kvb + (size_t)skey[i] * 192 + sch[i] * 8);
#pragma unroll
    for (int i = 0; i < 3; ++i) *(LAS v4u*)(lds + skey[i] * MLA_KSTR + sch[i] * 16) = st[i];
    __syncthreads();
    const int troff = (((lane & 15) >> 2) + 8 * hi) * MLA_KSTR + (16 * ((lane >> 4) & 1) + 4 * (lane & 3)) * 2;
    for (int j = 0; j < NT; ++j) {
        const int buf = j & 1;
        if (j + 1 < NT) {
#pragma unroll
            for (int i = 0; i < 3; ++i) st[i] = *(const v4u*)(kvb + (size_t)(64 * (j + 1) + skey[i]) * 192 + sch[i] * 8);
        }
        const LAS unsigned char* kt = lds + buf * MLA_KBUF;
        f32x16 p0, p1;
#pragma unroll
        for (int r = 0; r < 16; ++r) { p0[r] = 0.f; p1[r] = 0.f; }
        { const LAS unsigned char* kb = kt + r32 * MLA_KSTR + hi * 16;
#pragma unroll
          for (int d0 = 0; d0 < 12; ++d0) { const bf16x8 a0 = *(const LAS bf16x8*)(kb + d0 * 32); const bf16x8 a1 = *(const LAS bf16x8*)(kb + 32 * MLA_KSTR + d0 * 32);
              p0 = __builtin_amdgcn_mfma_f32_32x32x16_bf16(a0, qr[d0], p0, 0, 0, 0); p1 = __builtin_amdgcn_mfma_f32_32x32x16_bf16(a1, qr[d0], p1, 0, 0, 0); } }
        bf16x8 pa0, pa1, pa2, pa3;
        const float alpha = softmax_tile(p0, p1, m_reg, l_reg, pa0, pa1, pa2, pa3);
        if (__any(alpha < 1.f)) { if (hi == 0) scr[r32] = alpha; LDS_WAIT();
#pragma unroll
            for (int r = 0; r < 16; ++r) { const float a = scr[crow(r, hi)];
#pragma unroll
                for (int d = 0; d < 4; ++d) o[d][r] *= a; } }
        const LAS unsigned char* vb = kt + troff;
#pragma unroll
        for (int d0 = 0; d0 < 4; ++d0) {
            s16x4 lo[4], hh[4];
#pragma unroll
            for (int ks = 0; ks < 4; ++ks) { lo[ks] = vtr(vb + (16 * ks) * MLA_KSTR + d0 * 64); hh[ks] = vtr(vb + (16 * ks + 4) * MLA_KSTR + d0 * 64); }
#define PK(k) (bf16x8){lo[k][0], lo[k][1], lo[k][2], lo[k][3], hh[k][0], hh[k][1], hh[k][2], hh[k][3]}
            o[d0] = __builtin_amdgcn_mfma_f32_32x32x16_bf16(pa0, PK(0), o[d0], 0, 0, 0);
            o[d0] = __builtin_amdgcn_mfma_f32_32x32x16_bf16(pa1, PK(1), o[d0], 0, 0, 0);
            o[d0] = __builtin_amdgcn_mfma_f32_32x32x16_bf16(pa2, PK(2), o[d0], 0, 0, 0);
            o[d0] = __builtin_amdgcn_mfma_f32_32x32x16_bf16(pa3, PK(3), o[d0], 0, 0, 0);
#undef PK
        }
        if (j + 1 < NT) {
#pragma unroll
            for (int i = 0; i < 3; ++i) *(LAS v4u*)(lds + (buf ^ 1) * MLA_KBUF + skey[i] * MLA_KSTR + sch[i] * 16) = st[i];
        }
        __syncthreads();
    }
    if (hi == 0) scr[r32] = l_reg; LDS_WAIT();
    bf16* ob = OA + qrow0 * 512 + h * 128 + r32;
#pragma unroll
    for (int r = 0; r < 16; ++r) { const int orow = crow(r, hi); const float rl = __builtin_amdgcn_rcpf(scr[orow]);
#pragma unroll
        for (int d0 = 0; d0 < 4; ++d0) ob[(size_t)orow * 512 + d0 * 32] = (bf16)f2bf(o[d0][r] * rl); }
    __syncthreads();
}
constexpr int CA_KSTR = 144;
constexpr int CA_TBUF = 64 * CA_KSTR;
constexpr int CA_BIAS = ATT_SCR + 8 * 256;
__device__ __forceinline__ void band_unit(LAS unsigned char* lds, const bf16* __restrict__ ZC, const float* __restrict__ relb, bf16* __restrict__ OC, int b, int h, int g) {
    int tid_ = threadIdx.x; asm volatile("" : "+v"(tid_));
    const int tid = tid_, lane = tid & 63, wid = __builtin_amdgcn_readfirstlane(tid >> 6), r32 = lane & 31, hi = lane >> 5;
    const int cw = 4 * g + (wid >> 1); const size_t qrow0 = (size_t)b * SEQ + cw * 64 + (wid & 1) * 32;
    LAS float* bias = (LAS float*)(lds + CA_BIAS);
    if (tid < 320) bias[tid] = relb[tid * 8 + h] * LOG2E;
    bf16x8 qr[4];
    { const bf16* qp = ZC + (qrow0 + r32) * 1536 + h * 64 + hi * 8;
#pragma unroll
      for (int d0 = 0; d0 < 4; ++d0) qr[d0] = *(const bf16x8*)(qp + d0 * 16); }
    float m_reg = -1e30f, l_reg = 0.f; f32x16 o[2];
#pragma unroll
    for (int d = 0; d < 2; ++d)
#pragma unroll
        for (int r = 0; r < 16; ++r) o[d][r] = 0.f;
    LAS float* scr = (LAS float*)(lds + ATT_SCR) + wid * 64;
    const int kc0 = (4 * g - 8) < 0 ? 0 : (4 * g - 8), kc1 = 4 * g + 3;
    const bf16* kbase = ZC + (size_t)b * SEQ * 1536 + 512 + h * 64; const bf16* vbase = kbase + 512;
    const int skey = tid >> 3, sch = tid & 7;
    v4u stk, stv;
    stk = *(const v4u*)(kbase + (size_t)(64 * kc0 + skey) * 1536 + sch * 8); stv = *(const v4u*)(vbase + (size_t)(64 * kc0 + skey) * 1536 + sch * 8);
    *(LAS v4u*)(lds + skey * CA_KSTR + sch * 16) = stk; *(LAS v4u*)(lds + CA_TBUF + skey * CA_KSTR + sch * 16) = stv;
    __syncthreads();
    const int troff = (((lane & 15) >> 2) + 8 * hi) * CA_KSTR + (16 * ((lane >> 4) & 1) + 4 * (lane & 3)) * 2;
    const int qin = (wid & 1) * 32 + r32;
    for (int kc = kc0; kc <= kc1; ++kc) {
        const int buf = (kc - kc0) & 1;
        if (kc < kc1) { stk = *(const v4u*)(kbase + (size_t)(64 * (kc + 1) + skey) * 1536 + sch * 8); stv = *(const v4u*)(vbase + (size_t)(64 * (kc + 1) + skey) * 1536 + sch * 8); }
        if (kc >= cw - 8 && kc <= cw) {
            const LAS unsigned char* kt = lds + buf * 2 * CA_TBUF;
            f32x16 p0, p1;
            const int dbase = (cw - kc) * 64 + qin + 63;
#pragma unroll
            for (int r = 0; r < 16; ++r) { int i0 = dbase - crow(r, hi), i1 = i0 - 32; i0 = i0 > 319 ? 319 : i0; i1 = i1 > 319 ? 319 : i1; p0[r] = bias[i0]; p1[r] = bias[i1]; }
            { const LAS unsigned char* kb = kt + r32 * CA_KSTR + hi * 16;
#pragma unroll
              for (int d0 = 0; d0 < 4; ++d0) { const bf16x8 a0 = *(const LAS bf16x8*)(kb + d0 * 32); const bf16x8 a1 = *(const LAS bf16x8*)(kb + 32 * CA_KSTR + d0 * 32);
                  p0 = __builtin_amdgcn_mfma_f32_32x32x16_bf16(a0, qr[d0], p0, 0, 0, 0); p1 = __builtin_amdgcn_mfma_f32_32x32x16_bf16(a1, qr[d0], p1, 0, 0, 0); } }
            bf16x8 pa0, pa1, pa2, pa3;
            const float alpha = softmax_tile(p0, p1, m_reg, l_reg, pa0, pa1, pa2, pa3);
            if (__any(alpha < 1.f)) { if (hi == 0) scr[r32] = alpha; LDS_WAIT();
#pragma unroll
                for (int r = 0; r < 16; ++r) { const float a = scr[crow(r, hi)]; o[0][r] *= a; o[1][r] *= a; } }
            const LAS unsigned char* vb = kt + CA_TBUF + troff;
#pragma unroll
            for (int d0 = 0; d0 < 2; ++d0) {
                s16x4 lo[4], hh[4];
#pragma unroll
                for (int ks = 0; ks < 4; ++ks) { lo[ks] = vtr(vb + (16 * ks) * CA_KSTR + d0 * 64); hh[ks] = vtr(vb + (16 * ks + 4) * CA_KSTR + d0 * 64); }
#define PK(k) (bf16x8){lo[k][0], lo[k][1], lo[k][2], lo[k][3], hh[k][0], hh[k][1], hh[k][2], hh[k][3]}
                o[d0] = __builtin_amdgcn_mfma_f32_32x32x16_bf16(pa0, PK(0), o[d0], 0, 0, 0);
                o[d0] = __builtin_amdgcn_mfma_f32_32x32x16_bf16(pa1, PK(1), o[d0], 0, 0, 0);
                o[d0] = __builtin_amdgcn_mfma_f32_32x32x16_bf16(pa2, PK(2), o[d0], 0, 0, 0);
                o[d0] = __builtin_amdgcn_mfma_f32_32x32x16_bf16(pa3, PK(3), o[d0], 0, 0, 0);
#undef PK
            }
        }
        if (kc < kc1) { *(LAS v4u*)(lds + (buf ^ 1) * 2 * CA_TBUF + skey * CA_KSTR + sch * 16) = stk; *(LAS v4u*)(lds + (buf ^ 1) * 2 * CA_TBUF + CA_TBUF + skey * CA_KSTR + sch * 16) = stv; }
        __syncthreads();
    }
    if (hi == 0) scr[r32] = l_reg; LDS_WAIT();
    bf16* ob = OC + qrow0 * 512 + h * 64 + r32;
#pragma unroll
    for (int r = 0; r < 16; ++r) { const int orow = crow(r, hi); const float rl = __builtin_amdgcn_rcpf(scr[orow]);
        ob[(size_t)orow * 512] = (bf16)f2bf(o[0][r] * rl); ob[(size_t)orow * 512 + 32] = (bf16)f2bf(o[1][r] * rl); }
    __syncthreads();
}
}
struct Args { const float* in[30]; float* out; unsigned char* ws; int start; int stop; };
#define KAS __attribute__((address_space(4)))
__device__ __forceinline__ const KAS unsigned char* kbase() { const KAS unsigned char* p = (const KAS unsigned char*)__builtin_amdgcn_kernarg_segment_ptr(); asm volatile("" : "+s"(p)); return p; }
__device__ __forceinline__ const float* kin(int i) { return *(const float* const KAS*)(kbase() + 8 * i); }
__device__ __forceinline__ float* kout() { return *(float* const KAS*)(kbase() + 240); }
__device__ __forceinline__ unsigned char* kws() { return *(unsigned char* const KAS*)(kbase() + 248); }
__device__ __forceinline__ int kstart() { return *(const int KAS*)(kbase() + 256); }
__device__ __forceinline__ int kstop() { return *(const int KAS*)(kbase() + 260); }
struct Frame { LAS unsigned char* lds; int tid, lane, wave, G, gw, NGW; };
__device__ __forceinline__ Frame make_frame(LAS unsigned char* lds) {
    Frame F; int tid = threadIdx.x; asm volatile("" : "+v"(tid)); int bx = blockIdx.x; asm volatile("" : "+s"(bx)); int G = gridDim.x; asm volatile("" : "+s"(G));
    F.lds = lds; F.tid = tid; F.lane = tid & 63; F.wave = __builtin_amdgcn_readfirstlane(tid >> 6); F.G = G; F.gw = bx * NWAVES + F.wave; F.NGW = G * NWAVES; return F;
}

__device__ const double ROPE_INV_FREQ[32] = {1, 0.74989420933245587, 0.56234132519034907, 0.42169650342858223, 0.31622776601683794, 0.23713737056616552, 0.17782794100389229, 0.1333521432163324, 0.10000000000000001, 0.074989420933245579, 0.056234132519034911, 0.042169650342858224, 0.031622776601683791, 0.023713737056616554, 0.017782794100389229, 0.013335214321633241, 0.01, 0.0074989420933245579, 0.005623413251903491, 0.0042169650342858229, 0.0031622776601683794, 0.0023713737056616554, 0.0017782794100389228, 0.0013335214321633241, 0.001, 0.00074989420933245586, 0.0005623413251903491, 0.00042169650342858224, 0.00031622776601683794, 0.00023713737056616554, 0.00017782794100389227, 0.0001333521432163324};
__device__ __forceinline__ void sincos_d(double a, float& s, float& c) {
    const double n = rint(a * 0.63661977236758134308);
    double r = fma(-n, 1.5707963267948966192, a); r = fma(-n, 6.123233995736766036e-17, r);
    const double r2 = r * r;
    double sp = -7.6471637318198164759e-13; sp = fma(sp, r2, 1.6059043836821614599e-10); sp = fma(sp, r2, -2.5052108385441718775e-08); sp = fma(sp, r2, 2.7557319223985890653e-06);
    sp = fma(sp, r2, -1.9841269841269841270e-04); sp = fma(sp, r2, 8.3333333333333333333e-03); sp = fma(sp, r2, -1.6666666666666666667e-01);
    const double sn = fma(sp * r2, r, r);
    double cp = 4.7794773323873852974e-14; cp = fma(cp, r2, -1.1470745597729724714e-11); cp = fma(cp, r2, 2.0876756987868098979e-09); cp = fma(cp, r2, -2.7557319223985890653e-07);
    cp = fma(cp, r2, 2.4801587301587301587e-05); cp = fma(cp, r2, -1.3888888888888888889e-03); cp = fma(cp, r2, 4.1666666666666666667e-02); cp = fma(cp, r2, -0.5);
    const double cs = fma(cp, r2, 1.0);
    const long long q = (long long)n & 3LL; double so, co;
    if (q == 0) { so = sn; co = cs; } else if (q == 1) { so = cs; co = -sn; } else if (q == 2) { so = -sn; co = -cs; } else { so = -cs; co = sn; }
    s = (float)so; c = (float)co;
}
__device__ __forceinline__ void transpose_item(const float* W, int ldw, int col0, int nblk, bf16* WT, int ldt, int row0, LAS float* scr, int item, int lane) {
    const int kb = item / nblk, nb = item % nblk, k0 = 64 * kb, n0 = 32 * nb;
#pragma unroll 8
    for (int i = 0; i < 32; ++i) { const int kk = 2 * i + (lane >> 5); scr[kk * 33 + (lane & 31)] = W[(size_t)(k0 + kk) * ldw + col0 + n0 + (lane & 31)]; }
    LDS_WAIT(); asm volatile("" ::: "memory");
    const int c = lane & 7;
#pragma unroll
    for (int j = 0; j < 4; ++j) { const int n = (lane >> 3) + 8 * j; const LAS float* s = scr + (8 * c) * 33 + n;
        v4u o; o.x = pk2(s[0 * 33], s[1 * 33]); o.y = pk2(s[2 * 33], s[3 * 33]); o.z = pk2(s[4 * 33], s[5 * 33]); o.w = pk2(s[6 * 33], s[7 * 33]);
        *(GAS v4u*)(WT + (size_t)(row0 + n0 + n) * ldt + k0 + 8 * c) = o; }
    LDS_WAIT(); asm volatile("" ::: "memory");
}
__device__ __forceinline__ void rope_table(LAS unsigned char* lds_) {
    const Frame F = make_frame(lds_); const int gt = F.gw * 64 + F.lane, NTH = F.NGW * 64;
    const int* pos = (const int*)kin(2); float* rope = (float*)(kws() + WS_ROPE);
    for (int i = gt; i < T * 32; i += NTH) { float s, c; sincos_d((double)pos[i >> 5] * ROPE_INV_FREQ[i & 31], s, c); rope[2 * (size_t)i] = c; rope[2 * (size_t)i + 1] = s; }
}
__device__ __forceinline__ void p0_prologue(LAS unsigned char* lds_, const Args& A, int l) {
    const Frame F = make_frame(lds_);
    LAS float* scr = (LAS float*)(F.lds + RING_OFF + F.wave * 16384);
    constexpr int I1 = 16 * 14, I2 = 16 * 48, I3 = 16 * 56, I4 = 16 * 96, I5 = 8 * 32, I6 = 8 * 32, I7 = 16 * 32, I8 = 16 * 128, I9 = 64 * 32, I10 = 16 * 32, I11 = 4 * 32;
    constexpr int NITEMS = I1 + I2 + I3 + I4 + I5 + I6 + I7 + I8 + I9 + I10 + I11;
#define WIN_ (kin(4) + (size_t)l * 1024 * IN_COLS)
#define WBR_ (kin(21) + (size_t)l * 1536 * 1024)
    for (int it = F.gw; it < NITEMS; it += F.NGW) {
        int r = it;
        if (r < I1) { transpose_item(WIN_, IN_COLS, 0, 14, (bf16*)(kws() + W_IN), 1024, 0, scr, r, F.lane); continue; } r -= I1;
        if (r < I2) { transpose_item(WIN_, IN_COLS, 2240, 48, (bf16*)(kws() + W_IN), 1024, 512, scr, r, F.lane); continue; } r -= I2;
        if (r < I3) { transpose_item(WIN_, IN_COLS, 448, 56, (bf16*)(kws() + W_IN), 1024, 2048, scr, r, F.lane); continue; } r -= I3;
        if (r < I4) { transpose_item(WIN_, IN_COLS, 3776, 96, (bf16*)(kws() + W_IN), 1024, 3840, scr, r, F.lane); continue; } r -= I4;
        if (r < I5) { transpose_item(WBR_ + (size_t)512 * 1024, 1024, 0, 32, (bf16*)(kws() + W_B) + (size_t)1024 * 512, 512, 0, scr, r, F.lane); continue; } r -= I5;
        if (r < I6) { transpose_item(WBR_ + (size_t)1024 * 1024, 1024, 0, 32, (bf16*)(kws() + W_B) + (size_t)2 * 1024 * 512, 512, 0, scr, r, F.lane); continue; } r -= I6;
        if (r < I7) { transpose_item(kin(22) + (size_t)l * 1024 * 1024, 1024, 0, 32, (bf16*)(kws() + W_OUT), 1024, 0, scr, r, F.lane); continue; } r -= I7;
        if (r < I8) { transpose_item(kin(25) + (size_t)l * 1024 * 4096, 4096, 0, 128, (bf16*)(kws() + W_1), 1024, 0, scr, r, F.lane); continue; } r -= I8;
        if (r < I9) { transpose_item(kin(26) + (size_t)l * 4096 * 1024, 1024, 0, 32, (bf16*)(kws() + W_2), 4096, 0, scr, r, F.lane); continue; } r -= I9;
        if (r < I10) { transpose_item(kin(28) + (size_t)l * 1024 * 1024, 1024, 0, 32, (bf16*)(kws() + W_G), 1024, 0, scr, r, F.lane); continue; } r -= I10;
        transpose_item(kin(29) + (size_t)l * 256 * 1024, 1024, 0, 32, (bf16*)(kws() + W_P), 256, 0, scr, r, F.lane);
    }
    const int gt = F.gw * 64 + F.lane, NTH = F.NGW * 64;
    { bf16* WinT = (bf16*)(kws() + W_IN); for (int i = gt; i < 64 * 1024; i += NTH) WinT[(size_t)448 * 1024 + i] = 0; }
    { const float* w_uq = kin(7) + (size_t)l * 256 * 768; const float* w_ukv = kin(8) + (size_t)l * 128 * 1024; bf16* WqT = (bf16*)(kws() + W_Q);
      for (int i = gt; i < 768 * 256; i += NTH) {
        const int n = i >> 8, kq = i & 255, h = n / 192, ii = n % 192; float s;
        if (ii < 128) { s = 0.f; const float* a = w_uq + (size_t)kq * 768 + h * 192; const float* b = w_ukv + (size_t)ii * 1024 + h * 256;
            for (int nn = 0; nn < 128; ++nn) s = fmaf(a[nn], b[nn], s); }
        else { const int jj = ii - 128, j = jj >> 1; s = w_uq[(size_t)kq * 768 + h * 192 + 128 + ((jj & 1) ? j + 32 : j)]; }
        WqT[i] = (bf16)f2bf(s);
      } }
    { const float* w_ukv = kin(8) + (size_t)l * 128 * 1024; const float* w_br = WBR_; bf16* WbT = (bf16*)(kws() + W_B);
      for (int i = gt; i < 512 * 1024; i += NTH) {
        const int dd = i & 1023, hl = i >> 10, h = hl >> 7, lat = hl & 127; float s = 0.f;
        const float* a = w_ukv + (size_t)lat * 1024 + h * 256 + 128; const float* b = w_br + (size_t)(h * 128) * 1024 + dd;
        for (int v = 0; v < 128; ++v) s = fmaf(a[v], b[(size_t)v * 1024], s);
        WbT[(size_t)dd * 512 + hl] = (bf16)f2bf(s);
      } }
    { const float* w_up = kin(11) + (size_t)l * 64 * 512; const float* a_up = kin(13) + (size_t)l * 64 * 512; const float* g_up = kin(14) + (size_t)l * 128 * 512; bf16* WloT = (bf16*)(kws() + W_LORA);
      for (int i = gt; i < 1536 * 256; i += NTH) {
        const int n = i >> 8, k = i & 255, blk = n >> 9, nn = n & 511; float s = 0.f;
        if (blk == 0) { if (k < 64) s = w_up[(size_t)k * 512 + nn]; } else if (blk == 1) { if (k >= 64 && k < 128) s = a_up[(size_t)(k - 64) * 512 + nn]; } else { if (k >= 128) s = g_up[(size_t)(k - 128) * 512 + nn]; }
        WloT[i] = (bf16)f2bf(s);
      } }
#undef WIN_
#undef WBR_
    unsigned char* ws = kws();
    const float* src = (l == 0) ? kin(0) : kout(); const float* g = kin(3) + l * 1024; bf16* U = (bf16*)(ws + WS_U);
    f32x4 gv[4];
#pragma unroll
    for (int j = 0; j < 4; ++j) gv[j] = *(const f32x4*)(g + 4 * F.lane + 256 * j);
    for (int m = F.gw; m < T; m += F.NGW) {
        const f32x4* xr = (const f32x4*)(src + (size_t)m * D) + F.lane; f32x4 v[4]; float s = 0.f;
#pragma unroll
        for (int j = 0; j < 4; ++j) { v[j] = xr[64 * j]; s += (v[j].x * v[j].x + v[j].y * v[j].y) + (v[j].z * v[j].z + v[j].w * v[j].w); }
        if (l == 0) { f32x4* ho = (f32x4*)(kout() + (size_t)m * D) + F.lane;
#pragma unroll
            for (int j = 0; j < 4; ++j) ho[64 * j] = v[j]; }
        const float rs = rsqrtf(wave_sum(s, F.lane) * (1.f / D) + NORM_EPS);
        v2u* o8 = (v2u*)(U + (size_t)m * D) + F.lane;
#pragma unroll
        for (int j = 0; j < 4; ++j) { const f32x4 y = v[j] * rs * gv[j]; v2u w; w.x = pk2(y.x, y.y); w.y = pk2(y.z, y.w); o8[64 * j] = w; }
    }
}
__device__ __forceinline__ void p2_mla_prep(LAS unsigned char* lds_, const Args& A, int l) {
    const Frame F = make_frame(lds_);
    const bf16* ZM = (const bf16*)(kws() + WS_OA); bf16* QN = (bf16*)(kws() + X_QN); bf16* KV = (bf16*)(kws() + X_KV); const float* rope = (const float*)(kws() + WS_ROPE);
    const f32x4 gq = *(const f32x4*)(kin(5) + l * 256 + 4 * F.lane); const float gk0 = kin(6)[l * 128 + 2 * F.lane], gk1 = kin(6)[l * 128 + 2 * F.lane + 1];
    for (int t = F.gw; t < T; t += F.NGW) {
        const bf16* z = ZM + (size_t)t * 512;
        const v2u wq = *(const v2u*)(z + 4 * F.lane); const unsigned wk = *(const unsigned*)(z + 256 + 2 * F.lane); const float kr = bfl((unsigned)z[384 + F.lane]);
        const float q0 = bfl(wq.x), q1 = bfh(wq.x), q2 = bfl(wq.y), q3 = bfh(wq.y), k0 = bfl(wk), k1 = bfh(wk);
        const float rq = rsqrtf(wave_sum(q0 * q0 + q1 * q1 + q2 * q2 + q3 * q3, F.lane) * (1.f / 256.f) + NORM_EPS);
        const float rk = rsqrtf(wave_sum(k0 * k0 + k1 * k1, F.lane) * (1.f / 128.f) + NORM_EPS);
        v2u o; o.x = pk2(q0 * rq * gq.x, q1 * rq * gq.y); o.y = pk2(q2 * rq * gq.z, q3 * rq * gq.w);
        *(v2u*)(QN + (size_t)t * 256 + 4 * F.lane) = o;
        *(unsigned*)(KV + (size_t)t * 192 + 2 * F.lane) = pk2(k0 * rk * gk0, k1 * rk * gk1);
        const float other = shfl_xor_f(kr, 32, F.lane);
        if (F.lane < 32) { const float c = rope[((size_t)t * 32 + F.lane) * 2], s = rope[((size_t)t * 32 + F.lane) * 2 + 1];
            *(unsigned*)(KV + (size_t)t * 192 + 128 + 2 * F.lane) = pk2(kr * c - other * s, other * c + kr * s); }
    }
}
__device__ __forceinline__ void p6_rw_prep(LAS unsigned char* lds_, const Args& A, int l) {
    const Frame F = make_frame(lds_);
    const bf16* ZR = (const bf16*)(kws() + X_ZR); bf16* LA = (bf16*)(kws() + X_LA);
    const f32x4 mu = *(const f32x4*)(kin(9) + l * RW_COLS + 1536 + 4 * F.lane);
    for (int t = F.gw; t < T; t += F.NGW) {
        const v2u wc = *(const v2u*)(ZR + (size_t)t * 1792 + 1536 + 4 * F.lane); v2u wp; wp.x = 0u; wp.y = 0u;
        if ((t & (SEQ - 1)) != 0) wp = *(const v2u*)(ZR + (size_t)(t - 1) * 1792 + 1536 + 4 * F.lane);
        float z[4] = {bfl(wc.x), bfh(wc.x), bfl(wc.y), bfh(wc.y)}; const float p[4] = {bfl(wp.x), bfh(wp.x), bfl(wp.y), bfh(wp.y)}; const float m[4] = {mu.x, mu.y, mu.z, mu.w};
#pragma unroll
        for (int e = 0; e < 4; ++e) { float v = z[e] + (p[e] - z[e]) * m[e]; if (F.lane < 16) v = 1.f - 2.f * __builtin_amdgcn_rcpf(1.f + __builtin_amdgcn_exp2f(2.f * LOG2E * v)); else if (F.lane >= 32) v = fsig(v); z[e] = v; }
        v2u o; o.x = pk2(z[0], z[1]); o.y = pk2(z[2], z[3]); *(v2u*)(LA + (size_t)t * 256 + 4 * F.lane) = o;
    }
}
__device__ __forceinline__ void p8_rw_scan(LAS unsigned char* lds_, const Args& A, int l, int seq) {
    const Frame F = make_frame(lds_);
    const int b = seq >> 3, h = seq & 7, lane = F.lane, c = h * 64 + lane;
    const bf16* ZR = (const bf16*)(kws() + X_ZR) + (size_t)b * SEQ * 1792 + c; const bf16* LO = (const bf16*)(kws() + X_LO) + (size_t)b * SEQ * 1536 + c;
    bf16* ORW = (bf16*)(kws() + WS_ORW) + (size_t)b * SEQ * 512 + c;
    const float mu_r = kin(9)[l * RW_COLS + c], mu_k = kin(9)[l * RW_COLS + 512 + c], mu_v = kin(9)[l * RW_COLS + 1024 + c];
    const float w0 = kin(10)[l * 512 + c], a0 = kin(12)[l * 512 + c], k_k = kin(15)[l * 512 + c], k_a = kin(16)[l * 512 + c], r_k = kin(17)[l * 512 + c];
    const float ln_w = kin(18)[l * 512 + c], ln_b = kin(19)[l * 512 + c];
    LAS float* sh = (LAS float*)(F.lds + RING_OFF);
    float S[64];
#pragma unroll
    for (int k = 0; k < 64; ++k) S[k] = 0.f;
    float pr = 0.f, pk = 0.f, pv = 0.f;
    float nr = bfl((unsigned)ZR[0]), nk = bfl((unsigned)ZR[512]), nv = bfl((unsigned)ZR[1024]), ntw = bfl((unsigned)LO[0]), nta = bfl((unsigned)LO[512]), ng = bfl((unsigned)LO[1024]);
    for (int t = 0; t < SEQ; ++t) {
        const float cr = nr, ck = nk, cv = nv, tw = ntw, ta = nta, gg = ng;
        if (t + 1 < SEQ) { const bf16* z = ZR + (size_t)(t + 1) * 1792; const bf16* o = LO + (size_t)(t + 1) * 1536;
            nr = bfl((unsigned)z[0]); nk = bfl((unsigned)z[512]); nv = bfl((unsigned)z[1024]); ntw = bfl((unsigned)o[0]); nta = bfl((unsigned)o[512]); ng = bfl((unsigned)o[1024]); }
        const float r = cr + (pr - cr) * mu_r, k = ck + (pk - ck) * mu_k, v = cv + (pv - cv) * mu_v; pr = cr; pk = ck; pv = cv;
        const float x = -(w0 + tw); const float sp = fmaxf(x, 0.f) + 0.6931471805599453f * __builtin_amdgcn_logf(1.f + __builtin_amdgcn_exp2f(-LOG2E * fabsf(x)));
        const float dec = __builtin_amdgcn_exp2f(-LOG2E * __builtin_amdgcn_exp2f(LOG2E * (-sp - 0.5f)));
        const float a = fsig(a0 + ta);
        float kk = k * k_k; kk = kk * rsqrtf(fmaxf(wave_sum(kk * kk, lane), 1e-24f));
        const float km = k * (1.f + (a - 1.f) * k_a);
        sh[lane] = r; sh[64 + lane] = dec; sh[128 + lane] = km; sh[192 + lane] = kk; sh[256 + lane] = kk * a;
        LDS_WAIT(); asm volatile("" ::: "memory");
        float sa = 0.f;
#pragma unroll
        for (int q0 = 0; q0 < 64; q0 += 16) {
#pragma unroll
            for (int q = q0; q < q0 + 16; ++q) sa = fmaf(S[q], -sh[192 + q], sa);
            asm volatile("" ::: "memory"); }
        float y = 0.f;
#pragma unroll
        for (int q0 = 0; q0 < 64; q0 += 8) {
#pragma unroll
            for (int q = q0; q < q0 + 8; ++q) { S[q] = fmaf(S[q], sh[64 + q], fmaf(sa, sh[256 + q], v * sh[128 + q])); y = fmaf(S[q], sh[q], y); }
            asm volatile("" ::: "memory"); }
        LDS_WAIT(); asm volatile("" ::: "memory");
        const float mean = wave_sum(y, lane) * (1.f / 64.f); const float dy = y - mean; const float var = wave_sum(dy * dy, lane) * (1.f / 64.f);
        const float yn = dy * rsqrtf(var + RW_LN_EPS) * ln_w + ln_b;
        const float bonus = wave_sum(r * km * r_k, lane) * v;
        ORW[(size_t)t * 512] = (bf16)f2bf((yn + bonus) * gg);
    }
}
template <int MODE>
__device__ __forceinline__ void rowpass(LAS unsigned char* lds_, const Args& A, const bf16* M, const float* g1, const float* g2, const float* pl) {
    const Frame F = make_frame(lds_);
    bf16* U = (bf16*)(kws() + WS_U); bf16* PB = (bf16*)(kws() + X_PB);
    f32x4 g1v[4], g2v[4];
#pragma unroll
    for (int j = 0; j < 4; ++j) { g1v[j] = *(const f32x4*)(g1 + 4 * F.lane + 256 * j); if (MODE == 0) g2v[j] = *(const f32x4*)(g2 + 4 * F.lane + 256 * j); }
    for (int m = F.gw; m < T; m += F.NGW) {
        const v2u* mr = (const v2u*)(M + (size_t)m * D) + F.lane; f32x4* hr = (f32x4*)(kout() + (size_t)m * D) + F.lane;
        f32x4 x[4], hv[4]; float s = 0.f;
#pragma unroll
        for (int j = 0; j < 4; ++j) { const v2u w = mr[64 * j]; x[j] = (f32x4){bfl(w.x), bfh(w.x), bfl(w.y), bfh(w.y)}; hv[j] = hr[64 * j]; s += (x[j].x * x[j].x + x[j].y * x[j].y) + (x[j].z * x[j].z + x[j].w * x[j].w); }
        const float rs = rsqrtf(wave_sum(s, F.lane) * (1.f / D) + NORM_EPS); float s2 = 0.f;
#pragma unroll
        for (int j = 0; j < 4; ++j) { hv[j] = hv[j] + x[j] * rs * g1v[j]; hr[64 * j] = hv[j]; s2 += (hv[j].x * hv[j].x + hv[j].y * hv[j].y) + (hv[j].z * hv[j].z + hv[j].w * hv[j].w); }
        v2u* o8 = (v2u*)(U + (size_t)m * D) + F.lane;
        if (MODE == 0) { const float rs2 = rsqrtf(wave_sum(s2, F.lane) * (1.f / D) + NORM_EPS);
#pragma unroll
            for (int j = 0; j < 4; ++j) { const f32x4 y = hv[j] * rs2 * g2v[j]; v2u w; w.x = pk2(y.x, y.y); w.y = pk2(y.z, y.w); o8[64 * j] = w; } }
        else {
#pragma unroll
            for (int j = 0; j < 4; ++j) { v2u w; w.x = pk2(hv[j].x, hv[j].y); w.y = pk2(hv[j].z, hv[j].w); o8[64 * j] = w; }
            const f32x4 pv = *((const f32x4*)(pl + (size_t)m * DPLE) + F.lane); v2u w; w.x = pk2(pv.x, pv.y); w.y = pk2(pv.z, pv.w); *((v2u*)(PB + (size_t)m * DPLE) + F.lane) = w; }
    }
}
#if defined(DBG_NAIVE_ATTN)
__device__ __forceinline__ void naive_mla(LAS unsigned char* lds_, const bf16* QP, const bf16* KV, bf16* OA) {
    const Frame F = make_frame(lds_); LAS float* sc = (LAS float*)(F.lds + F.wave * 16384);
    for (int item = F.gw; item < T * 4; item += F.NGW) {
        const int t = item >> 2, h = item & 3, b = t / SEQ, tl = t % SEQ, nk = ((tl >> 6) + 1) << 6;
        const bf16* q = QP + (size_t)t * 768 + h * 192; const bf16* kb = KV + (size_t)b * SEQ * 192;
        float mx = -1e30f;
        for (int k = F.lane; k < nk; k += 64) { float s = 0.f; const bf16* kr = kb + (size_t)k * 192;
            for (int d = 0; d < 192; ++d) s += bfl((unsigned)q[d]) * bfl((unsigned)kr[d]);
            sc[k] = s; mx = fmaxf(mx, s); }
        for (int o = 1; o < 64; o <<= 1) mx = fmaxf(mx, shfl_xor_f(mx, o, F.lane));
        float sum = 0.f;
        for (int k = F.lane; k < nk; k += 64) { const float p = exp2f(sc[k] - mx); sc[k] = p; sum += p; }
        sum = wave_sum(sum, F.lane);
        LDS_WAIT(); asm volatile("" ::: "memory");
        float o0 = 0.f, o1 = 0.f;
        for (int k = 0; k < nk; ++k) { const float p = sc[k]; o0 += p * bfl((unsigned)kb[(size_t)k * 192 + F.lane]); o1 += p * bfl((unsigned)kb[(size_t)k * 192 + 64 + F.lane]); }
        OA[(size_t)t * 512 + h * 128 + F.lane] = (bf16)f2bf(o0 / sum); OA[(size_t)t * 512 + h * 128 + 64 + F.lane] = (bf16)f2bf(o1 / sum);
        LDS_WAIT(); asm volatile("" ::: "memory");
    }
}
__device__ __forceinline__ void naive_band(LAS unsigned char* lds_, const bf16* ZC, const float* relb, bf16* OC) {
    const Frame F = make_frame(lds_); LAS float* sc = (LAS float*)(F.lds + F.wave * 16384);
    for (int item = F.gw; item < T * 8; item += F.NGW) {
        const int t = item >> 3, h = item & 7, b = t / SEQ, tl = t % SEQ, c = tl >> 6, k0 = (c - 8) * 64;
        const bf16* q = ZC + (size_t)t * 1536 + h * 64; const bf16* zb = ZC + (size_t)b * SEQ * 1536;
        float mx = -1e30f;
        for (int j = F.lane; j < 576; j += 64) { const int kp = k0 + j; float s = -1e30f;
            if (kp >= 0) { s = 0.f; const bf16* kr = zb + (size_t)kp * 1536 + 512 + h * 64; for (int d = 0; d < 64; ++d) s += bfl((unsigned)q[d]) * bfl((unsigned)kr[d]);
                int dist = tl - kp; dist = dist < -63 ? -63 : (dist > 256 ? 256 : dist); s += relb[(dist + 63) * 8 + h] * LOG2E; }
            sc[j] = s; mx = fmaxf(mx, s); }
        for (int o = 1; o < 64; o <<= 1) mx = fmaxf(mx, shfl_xor_f(mx, o, F.lane));
        float sum = 0.f;
        for (int j = F.lane; j < 576; j += 64) { const float p = (k0 + j >= 0) ? exp2f(sc[j] - mx) : 0.f; sc[j] = p; sum += p; }
        sum = wave_sum(sum, F.lane);
        LDS_WAIT(); asm volatile("" ::: "memory");
        float o0 = 0.f;
        for (int j = 0; j < 576; ++j) { const int kp = k0 + j; if (kp >= 0) o0 += sc[j] * bfl((unsigned)zb[(size_t)kp * 1536 + 1024 + h * 64 + F.lane]); }
        OC[(size_t)t * 512 + h * 64 + F.lane] = (bf16)f2bf(o0 / sum);
        LDS_WAIT(); asm volatile("" ::: "memory");
    }
}
#endif
__global__ void __launch_bounds__(NWAVES * 64, 2) mk_fwd(Args args) {
    extern __shared__ __attribute__((aligned(16))) unsigned char lds[];
    LAS unsigned char* const L = (LAS unsigned char*)lds;
    for (int u = threadIdx.x; u < (LDS_BYTES - LDSCTL_OFF) / 4; u += NWAVES * 64) ((LAS unsigned*)(L + LDSCTL_OFF))[u] = 0u;
    __syncthreads();
    XcdBarrier bar = xcd_barrier_post((unsigned*)(kws() + WS_CTL) + CW_BAR, (volatile LAS unsigned*)(L + MISC_OFF) + 8);
#define GRID_BAR() xcd_barrier(bar)
#if defined(DBG_BISECT)
#define IN(k) (l > 0 || ((k) >= kstart() && (k) <= kstop()) || ((k) == 9 && kstop() == 99))
#define LAYER_END() do { if (kstop() < 100) return; } while (0)
#else
#define IN(k) true
#define LAYER_END() do { } while (0)
#endif
#define PTRS() unsigned char* ws = opq(kws()); \
    bf16* U = (bf16*)(ws + WS_U); bf16* OA = (bf16*)(ws + WS_OA); bf16* OC = (bf16*)(ws + WS_OC); bf16* ORW = (bf16*)(ws + WS_ORW); \
    bf16* WinT = (bf16*)(ws + W_IN); bf16* WqT = (bf16*)(ws + W_Q); bf16* WloT = (bf16*)(ws + W_LORA); bf16* WbT = (bf16*)(ws + W_B); bf16* WoT = (bf16*)(ws + W_OUT); \
    bf16* W1T = (bf16*)(ws + W_1); bf16* W2T = (bf16*)(ws + W_2); bf16* WgT = (bf16*)(ws + W_G); bf16* WpT = (bf16*)(ws + W_P); \
    bf16* ZC = (bf16*)(ws + X_ZC); bf16* QN = (bf16*)(ws + X_QN); bf16* QP = (bf16*)(ws + X_QP); bf16* KV = (bf16*)(ws + X_KV); \
    bf16* ZR = (bf16*)(ws + X_ZR); bf16* LA = (bf16*)(ws + X_LA); bf16* LO = (bf16*)(ws + X_LO); \
    bf16* GT = (bf16*)(ws + X_GT); bf16* MG = (bf16*)(ws + X_MG); bf16* HID = (bf16*)(ws + X_HID); bf16* PB = (bf16*)(ws + X_PB); bf16* PP = (bf16*)(ws + X_PP); bf16* M2 = OA; \
    (void)U; (void)OA; (void)OC; (void)ORW; (void)WinT; (void)WqT; (void)WloT; (void)WbT; (void)WoT; (void)W1T; (void)W2T; (void)WgT; (void)WpT; (void)ZC; (void)QN; (void)QP; (void)KV; (void)ZR; (void)LA; (void)LO; (void)GT; (void)MG; (void)HID; (void)PB; (void)PP; (void)M2;
    typedef pg8::StaticOrder SO;
#define GEMM(EPI, Aptr, Bptr, N_, K_, Eobj) do { int bx_ = blockIdx.x; asm volatile("" : "+s"(bx_)); int G_ = gridDim.x; asm volatile("" : "+s"(G_)); pg8::Gemm g_{Aptr, Bptr, T, N_, K_}; SO S_; S_.init(T, N_, G_, bx_); pg8::gemm_phase<EPI, SO, true, true>(L + RING_OFF, g_, S_, Eobj); } while (0)

    rope_table(L);
    for (int l = 0; l < DEPTH; ++l) {
        if (IN(0)) {
        p0_prologue(L, args, l); GRID_BAR();
        }
        if (IN(1)) {
        { PTRS(); pg8::EpiRoute<0> E{OA, 512, 2, 1.f, ZC, 1536, 2, CA_QSCALE}; GEMM(pg8::EpiRoute<0>, U, WinT, 2048, 1024, E); } GRID_BAR();
        }
        if (IN(2)) {
        p2_mla_prep(L, args, l); GRID_BAR();
        }
        if (IN(3)) {
        { PTRS(); pg8::EpiQRope E{QP, (const float*)(ws + WS_ROPE), MLA_QSCALE}; GEMM(pg8::EpiQRope, QN, WqT, 768, 256, E); } GRID_BAR();
        }
        if (IN(4)) {
#if defined(DBG_NAIVE_ATTN)
        { PTRS(); naive_mla(L, QP, KV, OA); naive_band(L, ZC, kin(20) + (size_t)l * 320 * 8, OC); }
#else
        { PTRS(); int bx = blockIdx.x; asm volatile("" : "+s"(bx)); const int G = gridDim.x; for (int u = bx; u < 1280; u += G) {
            if (u < 256) { const int b = u >> 5, cc = u & 31; att::mla_unit(L + RING_OFF, QP, KV, OA, b, 63 - cc); att::mla_unit(L + RING_OFF, QP, KV, OA, b, cc); }
            else { const int bi = u - 256; att::band_unit(L + RING_OFF, ZC, kin(20) + (size_t)l * 320 * 8, OC, bi >> 7, (bi >> 4) & 7, bi & 15); }
        } }
#endif
        GRID_BAR();
        }
        if (IN(5)) {
        { PTRS(); pg8::EpiRoute<0> E{ZR, 1792, 7, 1.f, ZR, 1792, 0, 1.f}; GEMM(pg8::EpiRoute<0>, U, WinT + (size_t)2048 * 1024, 1792, 1024, E); } GRID_BAR();
        }
        if (IN(6)) {
        p6_rw_prep(L, args, l); GRID_BAR();
        }
        if (IN(7)) {
        { PTRS(); pg8::EpiRoute<0> E{LO, 1536, 6, 1.f, LO, 1536, 0, 1.f}; GEMM(pg8::EpiRoute<0>, LA, WloT, 1536, 256, E); } GRID_BAR();
        }
        if (IN(8)) {
#if !defined(DBG_BISECT)
        if (blockIdx.x < 64 && threadIdx.x < 64) p8_rw_scan(L, args, l, (int)blockIdx.x);
#endif
        GRID_BAR();
        }
        if (IN(9)) {
#if defined(DBG_BISECT)
        if (kstop() == 99) { PTRS(); pg8::EpiRoute<0> E{GT, 3072, 12, 1.f, GT, 3072, 0, 1.f}; GEMM(pg8::EpiRoute<0>, U, WinT + (size_t)3840 * 1024, 3072, 1024, E); GRID_BAR(); return; }
#endif
        { PTRS(); pg8::EpiRoute<0> E{GT, 3072, 12, 1.f, GT, 3072, 0, 1.f}; GEMM(pg8::EpiRoute<0>, U, WinT + (size_t)3840 * 1024, 3072, 1024, E); } GRID_BAR();
        }
        if (IN(10)) {
        { PTRS(); pg8::EpiMerge<0> E0{MG, GT}; GEMM(pg8::EpiMerge<0>, OA, WbT, 1024, 512, E0);
          pg8::EpiMerge<1> E1{MG, GT}; GEMM(pg8::EpiMerge<1>, ORW, WbT + (size_t)1024 * 512, 1024, 512, E1);
          pg8::EpiMerge<2> E2{MG, GT}; GEMM(pg8::EpiMerge<2>, OC, WbT + (size_t)2 * 1024 * 512, 1024, 512, E2); } GRID_BAR();
        }
        if (IN(11)) {
        { PTRS(); pg8::EpiRoute<0> E{M2, 1024, 4, 1.f, M2, 1024, 0, 1.f}; GEMM(pg8::EpiRoute<0>, MG, WoT, 1024, 1024, E); } GRID_BAR();
        }
        if (IN(12)) {
        { PTRS(); rowpass<0>(L, args, M2, kin(23) + l * 1024, kin(24) + l * 1024, nullptr); } GRID_BAR();
        }
        if (IN(13)) {
        { PTRS(); pg8::EpiRoute<2> E{HID, 4096, 16, 1.f, HID, 4096, 0, 1.f}; GEMM(pg8::EpiRoute<2>, U, W1T, 4096, 1024, E); } GRID_BAR();
        }
        if (IN(14)) {
        { PTRS(); pg8::EpiRoute<0> E{M2, 1024, 4, 1.f, M2, 1024, 0, 1.f}; GEMM(pg8::EpiRoute<0>, HID, W2T, 1024, 4096, E); } GRID_BAR();
        }
        if (IN(15)) {
        { PTRS(); rowpass<1>(L, args, M2, kin(27) + l * 1024, nullptr, kin(1) + (size_t)l * T * DPLE); } GRID_BAR();
        }
        if (IN(16)) {
        { PTRS(); pg8::EpiRoute<0> E{PP, 1024, 4, 1.f, PP, 1024, 0, 1.f}; GEMM(pg8::EpiRoute<0>, PB, WpT, 1024, 256, E); } GRID_BAR();
        }
        if (IN(17)) {
        { PTRS(); pg8::EpiPle E{kout(), PP}; GEMM(pg8::EpiPle, U, WgT, 1024, 1024, E); }

        if (l + 1 < DEPTH) GRID_BAR();
        }
        LAYER_END();
    }
}

#if !defined(DBG_BISECT)
extern "C" void kernel_launch(void* const* d_in, const int* in_sizes, int n_in, void* d_out, int out_size, void* d_ws, size_t ws_size, hipStream_t stream) {
    static int grid = 0;
    if (grid == 0) {
        if (n_in != 30 || out_size != T * D || ws_size < WS_END) { fprintf(stderr, "kernel_launch: unexpected shapes (n_in %d out %d ws %zu, need ws >= %zu)\n", n_in, out_size, ws_size, (size_t)WS_END); grid = -1; return; }
        int dev = 0, cus = 0, per_cu = 0;
        if (hipGetDevice(&dev) != hipSuccess || hipDeviceGetAttribute(&cus, hipDeviceAttributeMultiprocessorCount, dev) != hipSuccess) { grid = -1; return; }
        if (hipFuncSetAttribute((const void*)mk_fwd, hipFuncAttributeMaxDynamicSharedMemorySize, LDS_BYTES) != hipSuccess) { fprintf(stderr, "kernel_launch: hipFuncSetAttribute failed\n"); grid = -1; return; }
        if (hipOccupancyMaxActiveBlocksPerMultiprocessor(&per_cu, (const void*)mk_fwd, NWAVES * 64, LDS_BYTES) != hipSuccess || per_cu < 1) { fprintf(stderr, "kernel_launch: occupancy query says %d\n", per_cu); }
        (void)hipGetLastError();
        grid = cus;
    }
    if (grid < 0) return;
    if (hipMemsetAsync((char*)d_ws + WS_CTL, 0, CTL_ZERO_BYTES, stream) != hipSuccess) return;
    Args a{};
    for (int i = 0; i < 30; ++i) a.in[i] = (const float*)d_in[i];
    a.out = (float*)d_out; a.ws = (unsigned char*)d_ws; a.start = 0; a.stop = 1000;
    hipLaunchKernelGGL(mk_fwd, dim3(grid), dim3(NWAVES * 64), LDS_BYTES, stream, a);
}
#endif
#if defined(DBG_BISECT)
namespace n0 {
constexpr int D_MODEL = 1024, BATCH = 8, SEQ = 4096, DEPTH = 2, CHUNK = 64, D_PLE = 256, D_FF = 4096;
constexpr int MLA_HEADS = 4, MLA_NOPE = 128, MLA_ROPE = 64, MLA_V = 128, MLA_Q_RANK = 256, MLA_KV_RANK = 128;
constexpr int RW_HEADS = 8, RW_HEAD = 64, RW_DIM = 512, RW_DECAY_LORA = 64, RW_AAA_LORA = 64, RW_GATE_LORA = 128;
constexpr int CA_HEADS = 8, CA_HEAD = 64, CA_DIM = 512, CA_LEFT = 8, CA_BAND = 576, REL_MIN = -63, REL_MAX = 256, REL_SIZE = 320;
constexpr int MLA_COLS = 448, RW_COLS = 1792, CA_COLS = 1536, GATE_COLS = 3072, IN_COLS = 6848;
constexpr int MIX_DIM = 1536;
constexpr float NORM_EPS = 1e-6f, RW_LN_EPS = 64e-5f;
constexpr int T_ALL = BATCH * SEQ;

__device__ const double ROPE_INV_FREQ[32] = {1, 0.74989420933245587, 0.56234132519034907, 0.42169650342858223, 0.31622776601683794, 0.23713737056616552, 0.17782794100389229, 0.1333521432163324, 0.10000000000000001, 0.074989420933245579, 0.056234132519034911, 0.042169650342858224, 0.031622776601683791, 0.023713737056616554, 0.017782794100389229, 0.013335214321633241, 0.01, 0.0074989420933245579, 0.005623413251903491, 0.0042169650342858229, 0.0031622776601683794, 0.0023713737056616554, 0.0017782794100389228, 0.0013335214321633241, 0.001, 0.00074989420933245586, 0.0005623413251903491, 0.00042169650342858224, 0.00031622776601683794, 0.00023713737056616554, 0.00017782794100389227, 0.0001333521432163324};

__device__ __forceinline__ void sincos_d(double a, float& s, float& c) {
    const double n = rint(a * 0.63661977236758134308);
    double r = fma(-n, 1.5707963267948966192, a);
    r = fma(-n, 6.123233995736766036e-17, r);
    const double r2 = r * r;
    double sp = -7.6471637318198164759e-13;
    sp = fma(sp, r2, 1.6059043836821614599e-10);
    sp = fma(sp, r2, -2.5052108385441718775e-08);
    sp = fma(sp, r2, 2.7557319223985890653e-06);
    sp = fma(sp, r2, -1.9841269841269841270e-04);
    sp = fma(sp, r2, 8.3333333333333333333e-03);
    sp = fma(sp, r2, -1.6666666666666666667e-01);
    const double sn = fma(sp * r2, r, r);
    double cp = 4.7794773323873852974e-14;
    cp = fma(cp, r2, -1.1470745597729724714e-11);
    cp = fma(cp, r2, 2.0876756987868098979e-09);
    cp = fma(cp, r2, -2.7557319223985890653e-07);
    cp = fma(cp, r2, 2.4801587301587301587e-05);
    cp = fma(cp, r2, -1.3888888888888888889e-03);
    cp = fma(cp, r2, 4.1666666666666666667e-02);
    cp = fma(cp, r2, -0.5);
    const double cs = fma(cp, r2, 1.0);
    const long long q = (long long)n & 3LL;
    double so, co;
    if (q == 0) { so = sn; co = cs; } else if (q == 1) { so = cs; co = -sn; } else if (q == 2) { so = -sn; co = -cs; } else { so = -cs; co = sn; }
    s = (float)so; c = (float)co;
}
__device__ __forceinline__ float sigmoidf_(float x) { return 1.0f / (1.0f + __expf(-x)); }

__global__ void k_copy(const float* __restrict__ a, float* __restrict__ o, size_t n4) {
    for (size_t i = blockIdx.x * (size_t)blockDim.x + threadIdx.x; i < n4; i += (size_t)gridDim.x * blockDim.x) ((float4*)o)[i] = ((const float4*)a)[i];
}
__global__ void k_copy2d(const float* __restrict__ a, int lda, float* __restrict__ o, int ldo, int cols, int rows) {
    for (int i = blockIdx.x * blockDim.x + threadIdx.x; i < rows * cols; i += gridDim.x * blockDim.x) { const int r = i / cols, c = i % cols; o[(size_t)r * ldo + c] = a[(size_t)r * lda + c]; }
}
__global__ void k_rmsnorm(const float* in, int ldi, const float* __restrict__ g, float* out, int ldo, int D, int rows, const float* res) {
    const int wave = (blockIdx.x * blockDim.x + threadIdx.x) >> 6, lane = threadIdx.x & 63, nw = (gridDim.x * blockDim.x) >> 6;
    for (int r = wave; r < rows; r += nw) {
        const float* x = in + (size_t)r * ldi; float s = 0.f;
        for (int c = lane; c < D; c += 64) { const float v = x[c]; s += v * v; }
        for (int o = 32; o; o >>= 1) s += __shfl_xor(s, o);
        const float rs = rsqrtf(s / (float)D + NORM_EPS);
        float* y = out + (size_t)r * ldo;
        for (int c = lane; c < D; c += 64) { float v = x[c] * rs * g[c]; if (res) v += res[(size_t)r * ldo + c]; y[c] = v; }
    }
}
template <int ACT>
__global__ void __launch_bounds__(256) k_gemm(const float* __restrict__ A, int lda, const float* __restrict__ B, int ldb, float* __restrict__ C, int ldc, int M, int N, int K) {
    __shared__ float As[16][132]; __shared__ float Bs[16][68];
    const int tid = threadIdx.x, tx = tid & 15, ty = tid >> 4;
    const int m0 = blockIdx.y * 128, n0 = blockIdx.x * 64;
    float acc[8][4];
#pragma unroll
    for (int i = 0; i < 8; ++i)
#pragma unroll
        for (int j = 0; j < 4; ++j) acc[i][j] = 0.f;
    for (int k0 = 0; k0 < K; k0 += 16) {
#pragma unroll
        for (int i = 0; i < 8; ++i) { const int e = tid + i * 256, r = e >> 4, c = e & 15; As[c][r] = A[(size_t)(m0 + r) * lda + k0 + c]; }
#pragma unroll
        for (int i = 0; i < 4; ++i) { const int e = tid + i * 256, r = e >> 6, c = e & 63; Bs[r][c] = B[(size_t)(k0 + r) * ldb + n0 + c]; }
        __syncthreads();
#pragma unroll
        for (int k = 0; k < 16; ++k) {
            float a[8], b[4];
#pragma unroll
            for (int i = 0; i < 8; ++i) a[i] = As[k][ty * 8 + i];
#pragma unroll
            for (int j = 0; j < 4; ++j) b[j] = Bs[k][tx * 4 + j];
#pragma unroll
            for (int i = 0; i < 8; ++i)
#pragma unroll
                for (int j = 0; j < 4; ++j) acc[i][j] = fmaf(a[i], b[j], acc[i][j]);
        }
        __syncthreads();
    }
#pragma unroll
    for (int i = 0; i < 8; ++i)
#pragma unroll
        for (int j = 0; j < 4; ++j) {
            float v = acc[i][j];
            if (ACT == 1) { v = v > 0.f ? v * v : 0.f; }
            if (ACT == 2) { v = sigmoidf_(v); }
            C[(size_t)(m0 + ty * 8 + i) * ldc + n0 + tx * 4 + j] = v;
        }
}
__global__ void k_rope(float* __restrict__ buf, int ld, int col0, int hstride, int nheads, const int* __restrict__ pos, int rows) {
    const int n = rows * nheads * 32;
    for (int i = blockIdx.x * blockDim.x + threadIdx.x; i < n; i += gridDim.x * blockDim.x) {
        const int j = i & 31, h = (i >> 5) % nheads, r = i / (32 * nheads);
        float s, c; sincos_d((double)pos[r] * ROPE_INV_FREQ[j], s, c);
        float* p = buf + (size_t)r * ld + col0 + h * hstride;
        const float x1 = p[j], x2 = p[j + 32];
        p[j] = x1 * c - x2 * s; p[j + 32] = x2 * c + x1 * s;
    }
}
__global__ void __launch_bounds__(128) k_mla_attn(const float* __restrict__ Q, const float* __restrict__ KV, const float* __restrict__ KR, float* __restrict__ O) {
    __shared__ float sc[2][SEQ]; __shared__ float qs[2][192];
    const int w = threadIdx.x >> 6, lane = threadIdx.x & 63;
    const int item = blockIdx.x * 2 + w; const int t = item >> 2, h = item & 3;
    const int nk = ((t >> 6) + 1) << 6;
    for (int d = lane; d < 192; d += 64) qs[w][d] = Q[(size_t)t * 768 + h * 192 + d];
    __syncthreads();
    const float scale = 0.07216878364870322f;
    float mx = -INFINITY;
    for (int k = lane; k < nk; k += 64) {
        const float4* kn = (const float4*)(KV + (size_t)k * 1024 + h * 256); const float4* kr = (const float4*)(KR + (size_t)k * 64);
        float s = 0.f;
#pragma unroll 8
        for (int d = 0; d < 32; ++d) { const float4 v = kn[d]; s += v.x * qs[w][4 * d] + v.y * qs[w][4 * d + 1] + v.z * qs[w][4 * d + 2] + v.w * qs[w][4 * d + 3]; }
#pragma unroll 8
        for (int d = 0; d < 16; ++d) { const float4 v = kr[d]; s += v.x * qs[w][128 + 4 * d] + v.y * qs[w][129 + 4 * d] + v.z * qs[w][130 + 4 * d] + v.w * qs[w][131 + 4 * d]; }
        s *= scale; sc[w][k] = s; mx = fmaxf(mx, s);
    }
    for (int o = 32; o; o >>= 1) mx = fmaxf(mx, __shfl_xor(mx, o));
    float sum = 0.f;
    for (int k = lane; k < nk; k += 64) { const float p = __expf(sc[w][k] - mx); sc[w][k] = p; sum += p; }
    for (int o = 32; o; o >>= 1) sum += __shfl_xor(sum, o);
    __syncthreads();
    float o0 = 0.f, o1 = 0.f;
    for (int k = 0; k < nk; ++k) { const float p = sc[w][k]; const float* v = KV + (size_t)k * 1024 + h * 256 + 128; o0 = fmaf(p, v[lane], o0); o1 = fmaf(p, v[lane + 64], o1); }
    const float inv = 1.f / sum;
    O[(size_t)t * 512 + h * 128 + lane] = o0 * inv; O[(size_t)t * 512 + h * 128 + 64 + lane] = o1 * inv;
}
__global__ void __launch_bounds__(256) k_band_attn(const float* __restrict__ Z, int ld, const float* __restrict__ bias, float* __restrict__ O) {
    __shared__ float sc[4][CA_BAND]; __shared__ float qs[4][64];
    const int w = threadIdx.x >> 6, lane = threadIdx.x & 63;
    const int item = blockIdx.x * 4 + w; const int t = item >> 3, h = item & 7;
    const int c = t >> 6; const int k0 = (c - CA_LEFT) * 64;
    qs[w][lane] = Z[(size_t)t * ld + h * 64 + lane];
    __syncthreads();
    float mx = -INFINITY;
    for (int j = lane; j < CA_BAND; j += 64) {
        const int kp = k0 + j; float s = -INFINITY;
        if (kp >= 0) {
            const float4* kv = (const float4*)(Z + (size_t)kp * ld + 512 + h * 64); s = 0.f;
#pragma unroll
            for (int d = 0; d < 16; ++d) { const float4 v = kv[d]; s += v.x * qs[w][4 * d] + v.y * qs[w][4 * d + 1] + v.z * qs[w][4 * d + 2] + v.w * qs[w][4 * d + 3]; }
            int dist = t - kp; dist = dist < REL_MIN ? REL_MIN : (dist > REL_MAX ? REL_MAX : dist);
            s = s * 0.125f + bias[(dist - REL_MIN) * 8 + h];
        }
        sc[w][j] = s; mx = fmaxf(mx, s);
    }
    for (int o = 32; o; o >>= 1) mx = fmaxf(mx, __shfl_xor(mx, o));
    float sum = 0.f;
    for (int j = lane; j < CA_BAND; j += 64) { const float p = __expf(sc[w][j] - mx); sc[w][j] = p; sum += p; }
    for (int o = 32; o; o >>= 1) sum += __shfl_xor(sum, o);
    __syncthreads();
    float o0 = 0.f;
    for (int j = 0; j < CA_BAND; ++j) { const int kp = k0 + j; if (kp < 0) continue; o0 = fmaf(sc[w][j], Z[(size_t)kp * ld + 1024 + h * 64 + lane], o0); }
    O[(size_t)t * 512 + h * 64 + lane] = o0 / sum;
}
__global__ void k_tokenshift(const float* __restrict__ Z, int ld, const float* __restrict__ mu, float* __restrict__ ZS) {
    const int n = SEQ * RW_COLS;
    for (int i = blockIdx.x * blockDim.x + threadIdx.x; i < n; i += gridDim.x * blockDim.x) {
        const int t = i / RW_COLS, c = i % RW_COLS;
        const float z = Z[(size_t)t * ld + c], pv = t > 0 ? Z[(size_t)(t - 1) * ld + c] : 0.f;
        float v = z + (pv - z) * mu[c];
        if (c >= 1536 && c < 1600) v = tanhf(v);
        if (c >= 1664) v = sigmoidf_(v);
        ZS[i] = v;
    }
}
__global__ void k_rw_prep(const float* __restrict__ ZS, const float* __restrict__ TW, const float* __restrict__ TA, const float* __restrict__ w0, const float* __restrict__ a0,
                          const float* __restrict__ k_k, const float* __restrict__ k_a, float* __restrict__ DEC, float* __restrict__ AA, float* __restrict__ KK, float* __restrict__ KM) {
    const int wave = (blockIdx.x * blockDim.x + threadIdx.x) >> 6, lane = threadIdx.x & 63, nw = (gridDim.x * blockDim.x) >> 6;
    for (int it = wave; it < SEQ * RW_HEADS; it += nw) {
        const int t = it >> 3, h = it & 7, c = h * 64 + lane; const size_t o = (size_t)t * 512 + c;
        const float x = -(w0[c] + TW[o]);
        const float sp = (x > 0.f ? x : 0.f) + log1pf(__expf(-fabsf(x)));
        const float wlog = -sp - 0.5f;
        DEC[o] = __expf(-__expf(wlog));
        const float a = sigmoidf_(a0[c] + TA[o]); AA[o] = a;
        const float k = ZS[(size_t)t * RW_COLS + 512 + c];
        const float kk = k * k_k[c]; float s = kk * kk;
        for (int q = 32; q; q >>= 1) s += __shfl_xor(s, q);
        KK[o] = kk * rsqrtf(fmaxf(s, 1e-24f));
        KM[o] = k * (1.f + (a - 1.f) * k_a[c]);
    }
}
__global__ void __launch_bounds__(64) k_rw_scan(const float* __restrict__ ZS, const float* __restrict__ DEC, const float* __restrict__ AA, const float* __restrict__ KK, const float* __restrict__ KM, float* __restrict__ Y) {
    __shared__ float sh[5][64];
    const int h = blockIdx.x, lane = threadIdx.x;
    float S[64];
#pragma unroll
    for (int k = 0; k < 64; ++k) S[k] = 0.f;
    for (int t = 0; t < SEQ; ++t) {
        const size_t o = (size_t)t * 512 + h * 64 + lane;
        sh[0][lane] = ZS[(size_t)t * RW_COLS + h * 64 + lane];
        sh[1][lane] = DEC[o]; sh[2][lane] = KM[o]; const float kkv = KK[o]; sh[3][lane] = kkv; sh[4][lane] = kkv * AA[o];
        const float vv = ZS[(size_t)t * RW_COLS + 1024 + h * 64 + lane];
        __syncthreads();
        float sa = 0.f;
#pragma unroll
        for (int k = 0; k < 64; ++k) sa = fmaf(S[k], -sh[3][k], sa);
        float y = 0.f;
#pragma unroll
        for (int k = 0; k < 64; ++k) { S[k] = fmaf(S[k], sh[1][k], fmaf(sa, sh[4][k], vv * sh[2][k])); y = fmaf(S[k], sh[0][k], y); }
        Y[o] = y;
        __syncthreads();
    }
}
__global__ void k_rw_out(const float* __restrict__ ZS, const float* __restrict__ KM, const float* __restrict__ Y, const float* __restrict__ G, const float* __restrict__ r_k, const float* __restrict__ ln_w, const float* __restrict__ ln_b, float* __restrict__ O) {
    const int wave = (blockIdx.x * blockDim.x + threadIdx.x) >> 6, lane = threadIdx.x & 63, nw = (gridDim.x * blockDim.x) >> 6;
    for (int it = wave; it < SEQ * RW_HEADS; it += nw) {
        const int t = it >> 3, h = it & 7, c = h * 64 + lane; const size_t o = (size_t)t * 512 + c;
        const float y = Y[o]; float s = y;
        for (int q = 32; q; q >>= 1) s += __shfl_xor(s, q);
        const float mean = s * (1.f / 64.f); const float d = y - mean; float v = d * d;
        for (int q = 32; q; q >>= 1) v += __shfl_xor(v, q);
        const float yn = d * rsqrtf(v * (1.f / 64.f) + RW_LN_EPS) * ln_w[c] + ln_b[c];
        const float r = ZS[(size_t)t * RW_COLS + c], vv = ZS[(size_t)t * RW_COLS + 1024 + c];
        float b = r * KM[o] * r_k[c];
        for (int q = 32; q; q >>= 1) b += __shfl_xor(b, q);
        O[o] = (yn + b * vv) * G[o];
    }
}
__global__ void k_merge(const float* __restrict__ Z, int ld, const float* __restrict__ Y3, float* __restrict__ M) {
    const int n = SEQ * D_MODEL;
    for (int i = blockIdx.x * blockDim.x + threadIdx.x; i < n; i += gridDim.x * blockDim.x) {
        const int t = i >> 10, d = i & 1023; float s = 0.f;
#pragma unroll
        for (int b = 0; b < 3; ++b) s += sigmoidf_(Z[(size_t)t * ld + 3776 + b * 1024 + d]) * Y3[(size_t)b * SEQ * D_MODEL + i];
        M[i] = s;
    }
}
__global__ void k_ple(float* __restrict__ h, const float* __restrict__ gate, const float* __restrict__ proj) {
    const int n = SEQ * D_MODEL;
    for (int i = blockIdx.x * blockDim.x + threadIdx.x; i < n; i += gridDim.x * blockDim.x) h[i] += gate[i] * proj[i];
}


}
#endif
#if defined(DBG_BISECT)
__device__ const int FP_ROWS[16] = {0, 1, 31, 32, 63, 64, 100, 255, 256, 257, 1023, 1024, 2048, 3000, 4094, 4095};
__global__ void fp_copy(const float* src, int ld, int col0, int ncols, float* dst, int dld, int dcol0) {
    const int ri = blockIdx.x; for (int c = threadIdx.x; c < ncols; c += blockDim.x) dst[(size_t)ri * dld + dcol0 + c] = src[(size_t)FP_ROWS[ri] * ld + col0 + c];
}
__global__ void fp_cmp(unsigned id, const void* mk, int is_bf16, int ld, int col0, int ncols, const float* ref, int mode, unsigned* code) {
    const int ri = blockIdx.x, row = FP_ROWS[ri]; __shared__ float s_num[256], s_den[256];
    float num = 0.f, den = 0.f;
    for (int c = threadIdx.x; c < ncols; c += 256) {
        float r = ref[(size_t)ri * ncols + c];
        if (mode == 1 && c < 512) r *= CA_QSCALE;
        if (mode == 3) r = 1.f / (1.f + expf(-r));
        if (mode == 2) { const int j = c >> 1, s = c & 1; r = ref[(size_t)ri * ncols + (s ? j + 32 : j)]; }
        const size_t idx = (size_t)row * ld + col0 + c;
        const float m = is_bf16 ? __uint_as_float((unsigned)((const unsigned short*)mk)[idx] << 16) : ((const float*)mk)[idx];
        num += (m - r) * (m - r); den += r * r;
    }
    s_num[threadIdx.x] = num; s_den[threadIdx.x] = den; __syncthreads();
    for (int o = 128; o; o >>= 1) { if ((int)threadIdx.x < o) { s_num[threadIdx.x] += s_num[threadIdx.x + o]; s_den[threadIdx.x] += s_den[threadIdx.x + o]; } __syncthreads(); }
    if (threadIdx.x == 0 && !(s_num[0] <= 1e-3f * s_den[0] + 1e-12f)) atomicMin(code, id);
}
__global__ void w_cmp(unsigned id, const unsigned short* WT, int ldt, int row0, const float* W, int ldw, int col0, int ncols, int K, unsigned* code) {
    for (size_t i = blockIdx.x * (size_t)blockDim.x + threadIdx.x; i < (size_t)ncols * K; i += (size_t)gridDim.x * blockDim.x) {
        const int n = (int)(i / K), kk = (int)(i % K); const unsigned short got = WT[(size_t)(row0 + n) * ldt + kk];
        const float w = W[(size_t)kk * ldw + col0 + n]; unsigned u = __float_as_uint(w); const unsigned short want = (unsigned short)((u + 0x7fffu + ((u >> 16) & 1u)) >> 16);
        if (got != want) atomicMin(code, id);
    }
}
__global__ void fp_emit(float* out, const unsigned* code) { if (threadIdx.x == 0 && blockIdx.x == 0) { const unsigned c = *code; if (c < 999u) out[0] = 100.f * (float)c; } }
__global__ void fp_init(unsigned* code) { if (threadIdx.x == 0 && blockIdx.x == 0) *code = 999u; }
__global__ void __launch_bounds__(64) dbg_scan(Args args, int l) { extern __shared__ __attribute__((aligned(16))) unsigned char lds[]; p8_rw_scan((LAS unsigned char*)lds, args, l, (int)blockIdx.x); }
template <int ACT> static void n0gemm(hipStream_t st, const float* A, int lda, const float* B, int ldb, float* C, int ldc, int M, int N, int K) {
    hipLaunchKernelGGL(n0::k_gemm<ACT>, dim3(N / 64, M / 128), dim3(256), 0, st, A, lda, B, ldb, C, ldc, M, N, K);
}
extern "C" void kernel_launch(void* const* d_in, const int* in_sizes, int n_in, void* d_out, int out_size, void* d_ws, size_t ws_size, hipStream_t stream) {
    static int grid = 0;
    if (grid == 0) {
        if (ws_size < 470 * MiB) { fprintf(stderr, "ws too small for the bisect build\n"); grid = -1; return; }
        if (hipFuncSetAttribute((const void*)mk_fwd, hipFuncAttributeMaxDynamicSharedMemorySize, LDS_BYTES) != hipSuccess) { grid = -1; return; }
        grid = 256;
    }
    if (grid < 0) return;
    using namespace n0;
    const float* x = (const float*)d_in[0]; const float* p = (const float*)d_in[1]; const int* positions = (const int*)d_in[2];
    const float* pre_mix_g = (const float*)d_in[3]; const float* w_in = (const float*)d_in[4]; const float* q_norm_g = (const float*)d_in[5]; const float* kv_norm_g = (const float*)d_in[6];
    const float* w_uq = (const float*)d_in[7]; const float* w_ukv = (const float*)d_in[8]; const float* rw_mu = (const float*)d_in[9]; const float* rw_w0 = (const float*)d_in[10];
    const float* rw_w_up = (const float*)d_in[11]; const float* rw_a0 = (const float*)d_in[12]; const float* rw_a_up = (const float*)d_in[13]; const float* rw_g_up = (const float*)d_in[14];
    const float* rw_k_k = (const float*)d_in[15]; const float* rw_k_a = (const float*)d_in[16]; const float* rw_r_k = (const float*)d_in[17]; const float* rw_ln_w = (const float*)d_in[18];
    const float* rw_ln_b = (const float*)d_in[19]; const float* ca_rel_bias = (const float*)d_in[20]; const float* w_branch = (const float*)d_in[21]; const float* w_out = (const float*)d_in[22];
    const float* post_mix_g = (const float*)d_in[23]; const float* pre_ff_g = (const float*)d_in[24]; const float* w_ff1 = (const float*)d_in[25]; const float* w_ff2 = (const float*)d_in[26];
    const float* post_ff_g = (const float*)d_in[27]; const float* w_ple_gate = (const float*)d_in[28]; const float* w_ple_proj = (const float*)d_in[29];
    float* hb = (float*)d_out;
    float* ws = (float*)d_ws; size_t off = 0;
    auto take = [&](size_t n) { float* r = ws + off; off += n; return r; };
    const size_t S = n0::SEQ;
    float* Z = take(S * 6848); float* U = take(S * 1024); float* QN = take(S * 256); float* KVN = take(S * 128);
    float* Q = take(S * 768); float* KV = take(S * 1024); float* KR = take(S * 64); float* OBR = take(S * 1536);
    float* ZS = take(S * 1792); float* TW = take(S * 512); float* TA = take(S * 512); float* G = take(S * 512);
    float* DEC = take(S * 512); float* AA = take(S * 512); float* KK = take(S * 512); float* KM = take(S * 512); float* Y = take(S * 512);
    float* Y3 = take(S * 3072); float* MER = take(S * 1024); float* M2 = take(S * 1024);
    float* F1 = Z; float* HID = Z + S * 1024; float* F3 = Z + S * 5120; float* GATE = Y3; float* PROJ = Y3 + S * 1024;
    unsigned* code = (unsigned*)((char*)d_ws + 466 * MiB); float* FP = (float*)((char*)d_ws + 466 * MiB + 256);
    size_t fo = 0; auto slot = [&](size_t ncols) { float* r = FP + fo; fo += 16 * ncols; return r; };
    float* f_U = slot(1024); float* f_ZM = slot(448); float* f_ZC = slot(1536); float* f_QN = slot(256); float* f_KVN = slot(128); float* f_KR = slot(64); float* f_OCA = slot(512);
    float* f_ZR = slot(1792); float* f_LO = slot(1536); float* f_ORW = slot(512); float* f_GT = slot(3072); float* f_MER = slot(1024); float* f_M2 = slot(1024); float* f_HM = slot(1024);
    float* f_F1 = slot(1024); float* f_HID = slot(4096); float* f_F3 = slot(1024); float* f_HF = slot(1024); float* f_PROJ = slot(1024); float* f_HP = slot(1024);
#define FPC(src, ld, c0, nc, dst) hipLaunchKernelGGL(fp_copy, dim3(16), dim3(256), 0, stream, (const float*)(src), (int)(ld), (int)(c0), (int)(nc), dst, (int)(nc), 0)
#define FPC2(src, ld, c0, nc, dst, dld, dc0) hipLaunchKernelGGL(fp_copy, dim3(16), dim3(256), 0, stream, (const float*)(src), (int)(ld), (int)(c0), (int)(nc), dst, (int)(dld), (int)(dc0))
    hipLaunchKernelGGL(fp_init, dim3(1), dim3(64), 0, stream, code);
    hipLaunchKernelGGL(k_copy, dim3(2048), dim3(256), 0, stream, x, hb, (size_t)S * 1024 / 4);
    {   const int l = 0; const int* pos = positions;
        hipLaunchKernelGGL(k_rmsnorm, dim3(512), dim3(256), 0, stream, hb, 1024, pre_mix_g, U, 1024, 1024, (int)S, (const float*)nullptr); FPC(U, 1024, 0, 1024, f_U);
        n0gemm<0>(stream, U, 1024, w_in, 6848, Z, 6848, S, 6848, 1024);
        FPC(Z, 6848, 0, 448, f_ZM); FPC(Z, 6848, 2240, 1536, f_ZC); FPC(Z, 6848, 448, 1792, f_ZR); FPC(Z, 6848, 3776, 3072, f_GT);
        hipLaunchKernelGGL(k_rmsnorm, dim3(512), dim3(256), 0, stream, Z, 6848, q_norm_g, QN, 256, 256, (int)S, (const float*)nullptr); FPC(QN, 256, 0, 256, f_QN);
        hipLaunchKernelGGL(k_rmsnorm, dim3(512), dim3(256), 0, stream, Z + 256, 6848, kv_norm_g, KVN, 128, 128, (int)S, (const float*)nullptr); FPC(KVN, 128, 0, 128, f_KVN);
        n0gemm<0>(stream, QN, 256, w_uq, 768, Q, 768, S, 768, 256);
        n0gemm<0>(stream, KVN, 128, w_ukv, 1024, KV, 1024, S, 1024, 128);
        hipLaunchKernelGGL(k_rope, dim3(512), dim3(256), 0, stream, Q, 768, 128, 192, 4, pos, (int)S);
        hipLaunchKernelGGL(k_copy2d, dim3(256), dim3(256), 0, stream, Z + 384, 6848, KR, 64, 64, (int)S);
        hipLaunchKernelGGL(k_rope, dim3(512), dim3(256), 0, stream, KR, 64, 0, 0, 1, pos, (int)S); FPC(KR, 64, 0, 64, f_KR);
        hipLaunchKernelGGL(k_mla_attn, dim3(S * 2), dim3(128), 0, stream, Q, KV, KR, OBR);
        hipLaunchKernelGGL(k_tokenshift, dim3(2048), dim3(256), 0, stream, Z + 448, 6848, rw_mu, ZS);
        n0gemm<0>(stream, ZS + 1536, 1792, rw_w_up, 512, TW, 512, S, 512, 64);
        n0gemm<0>(stream, ZS + 1600, 1792, rw_a_up, 512, TA, 512, S, 512, 64);
        n0gemm<0>(stream, ZS + 1664, 1792, rw_g_up, 512, G, 512, S, 512, 128);
        FPC2(TW, 512, 0, 512, f_LO, 1536, 0); FPC2(TA, 512, 0, 512, f_LO, 1536, 512); FPC2(G, 512, 0, 512, f_LO, 1536, 1024);
        hipLaunchKernelGGL(k_rw_prep, dim3(1024), dim3(256), 0, stream, ZS, TW, TA, rw_w0, rw_a0, rw_k_k, rw_k_a, DEC, AA, KK, KM);
        hipLaunchKernelGGL(k_rw_scan, dim3(8), dim3(64), 0, stream, ZS, DEC, AA, KK, KM, Y);
        hipLaunchKernelGGL(k_rw_out, dim3(1024), dim3(256), 0, stream, ZS, KM, Y, G, rw_r_k, rw_ln_w, rw_ln_b, OBR + S * 512); FPC(OBR + S * 512, 512, 0, 512, f_ORW);
        hipLaunchKernelGGL(k_band_attn, dim3(S * 2), dim3(256), 0, stream, Z + 2240, 6848, ca_rel_bias, OBR + 2 * S * 512); FPC(OBR + 2 * S * 512, 512, 0, 512, f_OCA);
        for (int n = 0; n < 3; ++n) n0gemm<0>(stream, OBR + n * S * 512, 512, w_branch + (size_t)n * 512 * 1024, 1024, Y3 + n * S * 1024, 1024, S, 1024, 512);
        hipLaunchKernelGGL(k_merge, dim3(2048), dim3(256), 0, stream, Z, 6848, Y3, MER); FPC(MER, 1024, 0, 1024, f_MER);
        n0gemm<0>(stream, MER, 1024, w_out, 1024, M2, 1024, S, 1024, 1024); FPC(M2, 1024, 0, 1024, f_M2);
        hipLaunchKernelGGL(k_rmsnorm, dim3(512), dim3(256), 0, stream, M2, 1024, post_mix_g, hb, 1024, 1024, (int)S, (const float*)hb); FPC(hb, 1024, 0, 1024, f_HM);
        hipLaunchKernelGGL(k_rmsnorm, dim3(512), dim3(256), 0, stream, hb, 1024, pre_ff_g, F1, 1024, 1024, (int)S, (const float*)nullptr); FPC(F1, 1024, 0, 1024, f_F1);
        n0gemm<1>(stream, F1, 1024, w_ff1, 4096, HID, 4096, S, 4096, 1024); FPC(HID, 4096, 0, 4096, f_HID);
        n0gemm<0>(stream, HID, 4096, w_ff2, 1024, F3, 1024, S, 1024, 4096); FPC(F3, 1024, 0, 1024, f_F3);
        hipLaunchKernelGGL(k_rmsnorm, dim3(512), dim3(256), 0, stream, F3, 1024, post_ff_g, hb, 1024, 1024, (int)S, (const float*)hb); FPC(hb, 1024, 0, 1024, f_HF);
        n0gemm<2>(stream, hb, 1024, w_ple_gate, 1024, GATE, 1024, S, 1024, 1024);
        n0gemm<0>(stream, p, 256, w_ple_proj, 1024, PROJ, 1024, S, 1024, 256); FPC(PROJ, 1024, 0, 1024, f_PROJ);
        hipLaunchKernelGGL(k_ple, dim3(2048), dim3(256), 0, stream, hb, GATE, PROJ); FPC(hb, 1024, 0, 1024, f_HP);
        (void)l;
    }
    Args a{};
    for (int i = 0; i < 30; ++i) a.in[i] = (const float*)d_in[i];
    a.out = (float*)d_out; a.ws = (unsigned char*)d_ws;
    unsigned char* w8 = (unsigned char*)d_ws;
#define RUNR(s0, s1) do { (void)hipMemsetAsync((char*)d_ws + WS_CTL, 0, CTL_ZERO_BYTES, stream); a.start = (s0); a.stop = (s1); hipLaunchKernelGGL(mk_fwd, dim3(grid), dim3(NWAVES * 64), LDS_BYTES, stream, a); } while (0)
#define RUN(stopph) do { if ((stopph) < 8) RUNR(0, (stopph)); else { RUNR(0, 7); hipLaunchKernelGGL(dbg_scan, dim3(64), dim3(64), 1280, stream, a, 0); if ((stopph) > 8) RUNR(9, (stopph)); } } while (0)
#define CMP(id, ptr, isbf, ld, c0, nc, ref, mode) hipLaunchKernelGGL(fp_cmp, dim3(16), dim3(256), 0, stream, (unsigned)(id), (const void*)(ptr), (int)(isbf), (int)(ld), (int)(c0), (int)(nc), (const float*)(ref), (int)(mode), code)
    RUN(0);  CMP(1, w8 + WS_U, 1, 1024, 0, 1024, f_U, 0);
    RUN(1);  CMP(2, w8 + WS_OA, 1, 512, 0, 448, f_ZM, 0); CMP(3, w8 + X_ZC, 1, 1536, 0, 1536, f_ZC, 1);
    RUN(2);  CMP(4, w8 + X_QN, 1, 256, 0, 256, f_QN, 0); CMP(5, w8 + X_KV, 1, 192, 0, 128, f_KVN, 0); CMP(6, w8 + X_KV, 1, 192, 128, 64, f_KR, 2);
    RUN(4);  CMP(7, w8 + WS_OC, 1, 512, 0, 512, f_OCA, 0);
    RUN(5);  CMP(9, w8 + X_ZR, 1, 1792, 0, 1792, f_ZR, 0);
    RUN(7);  CMP(10, w8 + X_LO, 1, 1536, 0, 1536, f_LO, 0);
    RUN(8);  CMP(11, w8 + WS_ORW, 1, 512, 0, 512, f_ORW, 0);
    hipLaunchKernelGGL(w_cmp, dim3(1024), dim3(256), 0, stream, 30u, (const unsigned short*)(w8 + W_IN), 1024, 3840, w_in, 6848, 3776, 3072, 1024, code);
    hipLaunchKernelGGL(w_cmp, dim3(1024), dim3(256), 0, stream, 29u, (const unsigned short*)(w8 + W_IN), 1024, 2048, w_in, 6848, 448, 1792, 1024, code);
    RUNR(9, 99); CMP(31, w8 + X_GT, 1, 3072, 0, 3072, f_GT, 0);
    RUN(9);  CMP(52, w8 + X_GT, 1, 3072, 0, 3072, f_GT, 0);
    RUN(10); CMP(53, w8 + X_MG, 1, 1024, 0, 1024, f_MER, 0);
    RUN(11); CMP(54, w8 + WS_OA, 1, 1024, 0, 1024, f_M2, 0);
    RUN(12); CMP(55, d_out, 0, 1024, 0, 1024, f_HM, 0); CMP(56, w8 + WS_U, 1, 1024, 0, 1024, f_F1, 0);
    RUN(13); CMP(57, w8 + X_HID, 1, 4096, 0, 4096, f_HID, 0);
    RUN(14); CMP(58, w8 + WS_OA, 1, 1024, 0, 1024, f_F3, 0);
    RUN(15); CMP(59, d_out, 0, 1024, 0, 1024, f_HF, 0);
    RUN(16); CMP(60, w8 + X_PP, 1, 1024, 0, 1024, f_PROJ, 0);
    RUN(17); CMP(61, d_out, 0, 1024, 0, 1024, f_HP, 0);
    RUN(17);
    hipLaunchKernelGGL(fp_emit, dim3(1), dim3(64), 0, stream, (float*)d_out, (const unsigned*)code);
}
#endif
```

```cpp
#include <hip/hip_runtime.h>
#include <cstdio>
#include <cstdint>
#include <cmath>
namespace pg8 {
#define PG8_LAS __attribute__((address_space(3)))
typedef unsigned short bf16_t;
typedef short bf16x8 __attribute__((ext_vector_type(8)));
typedef float f32x4 __attribute__((ext_vector_type(4)));
typedef unsigned u32x4 __attribute__((ext_vector_type(4)));
constexpr int BM = 256, BK = 64, HALF = 128, HTB = HALF * BK * 2  , STAGE_BYTES = 8 * HTB, NXCD = 8, WGM = 8;

__host__ __device__ __forceinline__ int lds_byte(int r, int c) { const int st = (r >> 4) * 2 + (c >> 5), rr = r & 15, cc = c & 31, ob = rr * 64 + cc * 2; return st * 1024 + (ob ^ (((ob >> 9) & 1) << 5)); }
__host__ __device__ __forceinline__ void stage_rc(int b, int& R, int& C) { const int st = b / 1024, sb = b % 1024, swz = sb ^ (((sb >> 9) & 1) << 5); R = (st >> 1) * 16 + swz / 64; C = (st & 1) * 32 + (swz % 64) / 2; }
__host__ __device__ __forceinline__ int perm32(int rho) { const int n = rho >> 4, i = rho & 15; return 8 * (i >> 2) + 4 * n + (i & 3); }

struct Unit { int pm, pn; };
struct Gemm { const bf16_t* A; const bf16_t* Bt; int M, N, K; };

struct StaticOrder {
    int nM, nN, nwg, G, c;
    __host__ __device__ void init(int M, int N, int G_, int c_) { nM = M / BM; nN = N / BM; nwg = nM * nN; G = G_; c = c_; }
    __host__ __device__ bool next(int i, Unit& u) const {
        const long L = (long)i * G + c; if (L >= nwg) return false;
        int wgid = (int)L; { const int q = nwg / NXCD, r = nwg % NXCD, xcd = wgid % NXCD, off = wgid / NXCD; wgid = (xcd < r ? xcd * (q + 1) : r * (q + 1) + (xcd - r) * q) + off; }
        const int nig = WGM * nN, gid = wgid / nig, fm = gid * WGM, gsz = (nM - fm) < WGM ? (nM - fm) : WGM;
        u.pm = fm + ((wgid % nig) % gsz); u.pn = (wgid % nig) / gsz; return true;
    }
    __device__ __forceinline__ void a_ready(const Unit&) const {}
    __device__ __forceinline__ void done(const Unit&) const {}
};

__device__ __forceinline__ unsigned cvt_pk_bf16(float lo, float hi) { unsigned r; asm volatile("v_cvt_pk_bf16_f32 %0, %1, %2" : "=v"(r) : "v"(lo), "v"(hi)); return r; }
typedef float f32x2 __attribute__((ext_vector_type(2)));
__device__ __forceinline__ f32x2 gelu_pk(f32x2 v) {
    const f32x2 av = __builtin_elementwise_abs(v), d = av * 0.2316418882f + 1.0f;
    f32x2 t; t.x = __builtin_amdgcn_rcpf(d.x); t.y = __builtin_amdgcn_rcpf(d.y);
    f32x2 q = t * 0.5307027145f + (-0.7265760135f); q = q * t + 0.7107068705f; q = q * t + (-0.142248368f); q = q * t + 0.127414796f; q = q * t;
    const f32x2 s = (v * v) * (-0.72134752044f);
    f32x2 e; e.x = __builtin_amdgcn_exp2f(s.x); e.y = __builtin_amdgcn_exp2f(s.y);
    const f32x2 m = v * (q * e), r = v - m;
    f32x2 o; o.x = v.x < 0.f ? m.x : r.x; o.y = v.y < 0.f ? m.y : r.y; return o;
}

template <int ACT  > struct EpiBf16 {
    static constexpr bool PERM = true, AFTER_DRAIN = false; static_assert(ACT == 0 || ACT == 1, "EpiBf16: ACT is 0 (none) or 1 (gelu_pk)");
    bf16_t* O; int ldc; const float* bias; int split_cols; size_t split_stride; float scale0;
    __device__ __forceinline__ void operator()(const f32x4 (&acc)[2][2][4][2], const Unit& u, int wr, int wc, int fr, int fq) const {
        const int row0 = u.pm * BM + wr * 64 + fr; int colt = u.pn * BM; bf16_t* base = O;
        float sc = 1.f; if (split_cols) { const int t = colt / split_cols; base += (size_t)t * split_stride; colt -= t * split_cols; if (t == 0) sc = scale0; }
        const int col0 = colt + wc * 32 + 8 * fq, bcol0 = u.pn * BM + wc * 32 + 8 * fq;
        f32x4 bv[2][2];
#pragma unroll
        for (int bj = 0; bj < 2; ++bj)
#pragma unroll
            for (int n = 0; n < 2; ++n) bv[bj][n] = bias ? *(const f32x4*)(bias + bcol0 + bj * HALF + 4 * n) : (f32x4){0.f, 0.f, 0.f, 0.f};
#pragma unroll
        for (int ai = 0; ai < 2; ++ai)
#pragma unroll
            for (int m = 0; m < 4; ++m) { bf16_t* rowp = base + (size_t)(row0 + ai * HALF + m * 16) * ldc + col0;
#pragma unroll
                for (int bj = 0; bj < 2; ++bj) { f32x4 v0 = acc[ai][bj][m][0] + bv[bj][0], v1 = acc[ai][bj][m][1] + bv[bj][1];
                    if (ACT == 1) { f32x2 a = gelu_pk((f32x2){v0[0], v0[1]}), b = gelu_pk((f32x2){v0[2], v0[3]}), c = gelu_pk((f32x2){v1[0], v1[1]}), d = gelu_pk((f32x2){v1[2], v1[3]});
                        v0 = (f32x4){a.x, a.y, b.x, b.y}; v1 = (f32x4){c.x, c.y, d.x, d.y}; }
                    v0 = v0 * sc; v1 = v1 * sc; u32x4 w; w.x = cvt_pk_bf16(v0[0], v0[1]); w.y = cvt_pk_bf16(v0[2], v0[3]); w.z = cvt_pk_bf16(v1[0], v1[1]); w.w = cvt_pk_bf16(v1[2], v1[3]);
                    *(u32x4*)(rowp + bj * HALF) = w; } }
    }
};
__device__ __forceinline__ float bf2f(unsigned short b) { return __uint_as_float((unsigned)b << 16); }
__device__ __forceinline__ float sigm(float x) { return __builtin_amdgcn_rcpf(1.0f + __builtin_amdgcn_exp2f(-1.4426950408889634f * x)); }
__device__ __forceinline__ void unpack8(const u32x4 w, float (&f)[8]) {
    f[0] = __uint_as_float(w.x << 16); f[1] = __uint_as_float(w.x & 0xffff0000u); f[2] = __uint_as_float(w.y << 16); f[3] = __uint_as_float(w.y & 0xffff0000u);
    f[4] = __uint_as_float(w.z << 16); f[5] = __uint_as_float(w.z & 0xffff0000u); f[6] = __uint_as_float(w.w << 16); f[7] = __uint_as_float(w.w & 0xffff0000u);
}
template <int ACT> struct EpiRoute {
    static constexpr bool PERM = true, AFTER_DRAIN = false;
    bf16_t* O0; int ld0; int nt0; float sc0;
    bf16_t* O1; int ld1; int nts1; float sc1;
    __device__ __forceinline__ void operator()(const f32x4 (&acc)[2][2][4][2], const Unit& u, int wr, int wc, int fr, int fq) const {
        const int row0 = u.pm * BM + wr * 64 + fr;
        bf16_t* base; int ld, colt; float sc = 1.f;
        if (u.pn < nt0) { base = O0; ld = ld0; colt = u.pn * BM; sc = sc0; } else { base = O1; ld = ld1; colt = (u.pn - nt0) * BM; if (u.pn - nt0 < nts1) sc = sc1; }
        const int col0 = colt + wc * 32 + 8 * fq;
#pragma unroll
        for (int ai = 0; ai < 2; ++ai)
#pragma unroll
            for (int m = 0; m < 4; ++m) { bf16_t* rowp = base + (size_t)(row0 + ai * HALF + m * 16) * ld + col0;
#pragma unroll
                for (int bj = 0; bj < 2; ++bj) { f32x4 v0 = acc[ai][bj][m][0], v1 = acc[ai][bj][m][1];
                    if (ACT == 1) { for (int e = 0; e < 4; ++e) { v0[e] = sigm(v0[e]); v1[e] = sigm(v1[e]); } }
                    if (ACT == 2) { for (int e = 0; e < 4; ++e) { const float a = fmaxf(v0[e], 0.f), b = fmaxf(v1[e], 0.f); v0[e] = a * a; v1[e] = b * b; } }
                    v0 = v0 * sc; v1 = v1 * sc; u32x4 w; w.x = cvt_pk_bf16(v0[0], v0[1]); w.y = cvt_pk_bf16(v0[2], v0[3]); w.z = cvt_pk_bf16(v1[0], v1[1]); w.w = cvt_pk_bf16(v1[2], v1[3]);
                    *(u32x4*)(rowp + bj * HALF) = w; } }
    }
};
struct EpiQRope {
    static constexpr bool PERM = true, AFTER_DRAIN = false;
    bf16_t* O; const float* rope; float sc;
    __device__ __forceinline__ void operator()(const f32x4 (&acc)[2][2][4][2], const Unit& u, int wr, int wc, int fr, int fq) const {
        const int row0 = u.pm * BM + wr * 64 + fr; const int col0 = u.pn * BM + wc * 32 + 8 * fq;
#pragma unroll
        for (int ai = 0; ai < 2; ++ai)
#pragma unroll
            for (int m = 0; m < 4; ++m) { const int row = row0 + ai * HALF + m * 16;
#pragma unroll
                for (int bj = 0; bj < 2; ++bj) { const int cg = col0 + bj * HALF; const int cm = cg % 192; f32x4 v0 = acc[ai][bj][m][0], v1 = acc[ai][bj][m][1];
                    if (cm >= 128) { const int j0 = (cm - 128) >> 1; const f32x4* rp = (const f32x4*)(rope + ((size_t)row * 32 + j0) * 2); const f32x4 a = rp[0], b = rp[1];
                        f32x4 r0, r1;
                        r0[0] = v0[0] * a[0] - v0[1] * a[1]; r0[1] = v0[1] * a[0] + v0[0] * a[1]; r0[2] = v0[2] * a[2] - v0[3] * a[3]; r0[3] = v0[3] * a[2] + v0[2] * a[3];
                        r1[0] = v1[0] * b[0] - v1[1] * b[1]; r1[1] = v1[1] * b[0] + v1[0] * b[1]; r1[2] = v1[2] * b[2] - v1[3] * b[3]; r1[3] = v1[3] * b[2] + v1[2] * b[3];
                        v0 = r0; v1 = r1; }
                    v0 = v0 * sc; v1 = v1 * sc; u32x4 w; w.x = cvt_pk_bf16(v0[0], v0[1]); w.y = cvt_pk_bf16(v0[2], v0[3]); w.z = cvt_pk_bf16(v1[0], v1[1]); w.w = cvt_pk_bf16(v1[2], v1[3]);
                    *(u32x4*)(O + (size_t)row * 768 + cg) = w; } }
    }
};
template <int NI> struct EpiMerge {
    static constexpr bool PERM = true, AFTER_DRAIN = false;
    bf16_t* MG; const bf16_t* GT;
    __device__ __forceinline__ void operator()(const f32x4 (&acc)[2][2][4][2], const Unit& u, int wr, int wc, int fr, int fq) const {
        const int row0 = u.pm * BM + wr * 64 + fr; const int col0 = u.pn * BM + wc * 32 + 8 * fq;
#pragma unroll
        for (int ai = 0; ai < 2; ++ai)
#pragma unroll
            for (int m = 0; m < 4; ++m) { const int row = row0 + ai * HALF + m * 16;
#pragma unroll
                for (int bj = 0; bj < 2; ++bj) { const int c = col0 + bj * HALF; const f32x4 v0 = acc[ai][bj][m][0], v1 = acc[ai][bj][m][1];
                    float g[8]; unpack8(*(const u32x4*)(GT + (size_t)row * 3072 + NI * 1024 + c), g);
                    for (int e = 0; e < 8; ++e) g[e] = sigm(g[e]);
                    float o[8];
                    if (NI > 0) unpack8(*(const u32x4*)(MG + (size_t)row * 1024 + c), o); else { for (int e = 0; e < 8; ++e) o[e] = 0.f; }
                    for (int e = 0; e < 4; ++e) { o[e] += g[e] * v0[e]; o[4 + e] += g[4 + e] * v1[e]; }
                    u32x4 w; w.x = cvt_pk_bf16(o[0], o[1]); w.y = cvt_pk_bf16(o[2], o[3]); w.z = cvt_pk_bf16(o[4], o[5]); w.w = cvt_pk_bf16(o[6], o[7]);
                    *(u32x4*)(MG + (size_t)row * 1024 + c) = w; } }
    }
};
struct EpiPle {
    static constexpr bool PERM = true, AFTER_DRAIN = false;
    float* H; const bf16_t* PP;
    __device__ __forceinline__ void operator()(const f32x4 (&acc)[2][2][4][2], const Unit& u, int wr, int wc, int fr, int fq) const {
        const int row0 = u.pm * BM + wr * 64 + fr; const int col0 = u.pn * BM + wc * 32 + 8 * fq;
#pragma unroll
        for (int ai = 0; ai < 2; ++ai)
#pragma unroll
            for (int m = 0; m < 4; ++m) { const int row = row0 + ai * HALF + m * 16;
#pragma unroll
                for (int bj = 0; bj < 2; ++bj) { const int c = col0 + bj * HALF; const f32x4 v0 = acc[ai][bj][m][0], v1 = acc[ai][bj][m][1];
                    float p[8]; unpack8(*(const u32x4*)(PP + (size_t)row * 1024 + c), p);
                    f32x4* hp = (f32x4*)(H + (size_t)row * 1024 + c); f32x4 h0 = hp[0], h1 = hp[1];
                    for (int e = 0; e < 4; ++e) { h0[e] += sigm(v0[e]) * p[e]; h1[e] += sigm(v1[e]) * p[4 + e]; }
                    hp[0] = h0; hp[1] = h1; } }
    }
};
template <class Epi, class Sched, bool ALIGN_EPI = false, bool SP2 = false>
__device__ __forceinline__ void gemm_phase(PG8_LAS unsigned char* lds, const Gemm g, const Sched& S, const Epi& E) {
    int tid_ = threadIdx.x; asm volatile("" : "+v"(tid_));
    const int tid = tid_, wid = __builtin_amdgcn_readfirstlane(tid >> 6), lane = tid & 63, wr = wid >> 2, wc = wid & 3, fr = lane & 15, fq = lane >> 4;
    const int K = g.K, nt = K / BK;
    unsigned voffA[2], voffB[2];
#pragma unroll
    for (int i = 0; i < 2; ++i) { int R, C; stage_rc(tid * 16 + i * 8192, R, C); const int Rb = Epi::PERM ? ((R & ~31) + perm32(R & 31)) : R;
        voffA[i] = (unsigned)(R * K + C) * 2u; voffB[i] = (unsigned)(Rb * K + C) * 2u; }
    const size_t kstep = (size_t)(BK * 2);
    const size_t hstep = (size_t)HALF * K * 2;
    const size_t tstep = 2 * hstep;
    const unsigned ldsw = (unsigned)wid * 1024u;
    const int aoff = lds_byte(wr * 64 + fr, fq * 8), boff = lds_byte(wc * 32 + fr, fq * 8);
#define PG8_SA(b, h) (((b) * 2 + (h)) * HTB)
#define PG8_SB(b, h) ((4 + (b) * 2 + (h)) * HTB)
#define PG8_STAGE(bufoff, gbase, voff) do { _Pragma("unroll") for (int _i = 0; _i < 2; ++_i) \
        __builtin_amdgcn_global_load_lds((const unsigned*)((const char*)(gbase) + (voff)[_i]), (PG8_LAS unsigned*)(lds + (bufoff) + ldsw + _i * 8192), 16, 0, 0); } while (0)
#define PG8_LDA(dst, b, h) do { _Pragma("unroll") for (int m = 0; m < 4; ++m) _Pragma("unroll") for (int k = 0; k < 2; ++k) dst[m][k] = *(const PG8_LAS bf16x8*)(lds + PG8_SA(b, h) + aoff + m * 2048 + k * 1024); } while (0)
#define PG8_LDB(dst, b, h) do { _Pragma("unroll") for (int n = 0; n < 2; ++n) _Pragma("unroll") for (int k = 0; k < 2; ++k) dst[n][k] = *(const PG8_LAS bf16x8*)(lds + PG8_SB(b, h) + boff + n * 2048 + k * 1024); } while (0)
#define PG8_MMA(ai, bj, At, Bt) do { __builtin_amdgcn_s_setprio(1); _Pragma("unroll") for (int m = 0; m < 4; ++m) _Pragma("unroll") for (int n = 0; n < 2; ++n) _Pragma("unroll") for (int k = 0; k < 2; ++k) \
        acc[ai][bj][m][n] = __builtin_amdgcn_mfma_f32_16x16x32_bf16(Bt[n][k], At[m][k], acc[ai][bj][m][n], 0, 0, 0); __builtin_amdgcn_s_setprio(0); } while (0)
#define PG8_WAIT_V(n) asm volatile("s_waitcnt vmcnt(" #n ")" ::: "memory")
#define PG8_WAIT_L(n) asm volatile("s_waitcnt lgkmcnt(" #n ")" ::: "memory")
#define PG8_BAR __builtin_amdgcn_s_barrier()
#define PG8_SCHED __builtin_amdgcn_sched_barrier(0)
    Unit cur, nxt; int ui = 0;
    if (!S.next(0, cur)) return;
    f32x4 acc[2][2][4][2];
#pragma unroll
    for (int a = 0; a < 2; ++a)
#pragma unroll
        for (int b = 0; b < 2; ++b)
#pragma unroll
            for (int m = 0; m < 4; ++m)
#pragma unroll
                for (int n = 0; n < 2; ++n) acc[a][b][m][n] = (f32x4){0.f, 0.f, 0.f, 0.f};
    bf16x8 At[4][2], B0[2][2], B1[2][2];
    const char* cA = (const char*)g.A + (size_t)cur.pm * tstep; const char* cB = (const char*)g.Bt + (size_t)cur.pn * tstep;
    S.a_ready(cur);
    if constexpr (SP2) {
        PG8_STAGE(PG8_SB(0, 0), cB, voffB); PG8_STAGE(PG8_SB(0, 1), cB + hstep, voffB); PG8_STAGE(PG8_SA(0, 0), cA, voffA); PG8_STAGE(PG8_SA(0, 1), cA + hstep, voffA);
        if (wr == 1) PG8_BAR;
        PG8_WAIT_V(2); PG8_BAR;
        PG8_STAGE(PG8_SB(1, 0), cB + kstep, voffB); PG8_STAGE(PG8_SA(1, 0), cA + kstep, voffA); PG8_STAGE(PG8_SB(1, 1), cB + hstep + kstep, voffB);
        PG8_WAIT_V(6); PG8_BAR;
    } else {
        PG8_STAGE(PG8_SB(0, 0), cB, voffB); PG8_STAGE(PG8_SA(0, 0), cA, voffA); PG8_STAGE(PG8_SB(0, 1), cB + hstep, voffB); PG8_STAGE(PG8_SA(0, 1), cA + hstep, voffA);
        if (wr == 1) PG8_BAR;
        PG8_WAIT_V(4); PG8_BAR;
        PG8_STAGE(PG8_SB(1, 0), cB + kstep, voffB); PG8_STAGE(PG8_SA(1, 0), cA + kstep, voffA); PG8_STAGE(PG8_SB(1, 1), cB + hstep + kstep, voffB);
        PG8_WAIT_V(6); PG8_BAR;
    }
    for (;;) {
        const bool has_next = S.next(ui + 1, nxt);
        const char* nA = has_next ? (const char*)g.A + (size_t)nxt.pm * tstep : cA; const char* nB = has_next ? (const char*)g.Bt + (size_t)nxt.pn * tstep : cB;
        for (int t = 0; t < nt; t += 2) {
            const bool last = (t == nt - 2);
            const char* a1 = cA + (size_t)(t + 1) * kstep;
            const char* a2 = last ? nA : cA + (size_t)(t + 2) * kstep; const char* b2 = last ? nB : cB + (size_t)(t + 2) * kstep;
            const char* a3 = a2 + kstep; const char* b3 = b2 + kstep;
            if (last && has_next) S.a_ready(nxt);
            if constexpr (SP2) {
            PG8_LDB(B0, 0, 0); PG8_LDB(B1, 0, 1); PG8_SCHED; PG8_LDA(At, 0, 0); PG8_STAGE(PG8_SA(1, 1), a1 + hstep, voffA);
            PG8_WAIT_V(8); PG8_WAIT_L(0); PG8_BAR; PG8_MMA(0, 0, At, B0); PG8_MMA(0, 1, At, B1); PG8_BAR; PG8_SCHED;
            PG8_LDA(At, 0, 1); PG8_STAGE(PG8_SB(0, 0), b2, voffB); PG8_STAGE(PG8_SB(0, 1), b2 + hstep, voffB); PG8_STAGE(PG8_SA(0, 0), a2, voffA);
            PG8_WAIT_V(8); PG8_WAIT_L(0); PG8_BAR; PG8_MMA(1, 0, At, B0); PG8_MMA(1, 1, At, B1); PG8_BAR; PG8_SCHED;
            PG8_LDB(B0, 1, 0); PG8_LDB(B1, 1, 1); PG8_SCHED; PG8_LDA(At, 1, 0); PG8_STAGE(PG8_SA(0, 1), a2 + hstep, voffA);
            PG8_WAIT_V(8); PG8_WAIT_L(0); PG8_BAR; PG8_MMA(0, 0, At, B0); PG8_MMA(0, 1, At, B1); PG8_BAR; PG8_SCHED;
            PG8_LDA(At, 1, 1); PG8_STAGE(PG8_SB(1, 0), b3, voffB); PG8_STAGE(PG8_SB(1, 1), b3 + hstep, voffB); PG8_STAGE(PG8_SA(1, 0), a3, voffA);
            PG8_WAIT_V(8); PG8_WAIT_L(0); PG8_BAR; PG8_MMA(1, 0, At, B0); PG8_MMA(1, 1, At, B1); PG8_BAR; PG8_SCHED;
            } else {
            PG8_LDB(B0, 0, 0); PG8_SCHED; PG8_LDA(At, 0, 0); PG8_STAGE(PG8_SA(1, 1), a1 + hstep, voffA);
            PG8_WAIT_L(8); PG8_BAR; PG8_WAIT_L(0); PG8_MMA(0, 0, At, B0); PG8_BAR; PG8_SCHED;
            PG8_LDB(B1, 0, 1); PG8_STAGE(PG8_SB(0, 0), b2, voffB);
            PG8_BAR; PG8_WAIT_L(0); PG8_MMA(0, 1, At, B1); PG8_BAR;
            PG8_LDA(At, 0, 1); PG8_STAGE(PG8_SA(0, 0), a2, voffA);
            PG8_BAR; PG8_WAIT_L(0); PG8_MMA(1, 0, At, B0); PG8_BAR; PG8_SCHED;
            PG8_STAGE(PG8_SB(0, 1), b2 + hstep, voffB);
            PG8_WAIT_V(6); PG8_BAR; PG8_MMA(1, 1, At, B1); PG8_BAR;
            PG8_LDB(B0, 1, 0); PG8_SCHED; PG8_LDA(At, 1, 0); PG8_STAGE(PG8_SA(0, 1), a2 + hstep, voffA);
            PG8_WAIT_L(8); PG8_BAR; PG8_WAIT_L(0); PG8_MMA(0, 0, At, B0); PG8_BAR; PG8_SCHED;
            PG8_LDB(B1, 1, 1); PG8_STAGE(PG8_SB(1, 0), b3, voffB);
            PG8_BAR; PG8_WAIT_L(0); PG8_MMA(0, 1, At, B1); PG8_BAR;
            PG8_LDA(At, 1, 1); PG8_STAGE(PG8_SA(1, 0), a3, voffA);
            PG8_BAR; PG8_WAIT_L(0); PG8_MMA(1, 0, At, B0); PG8_BAR; PG8_SCHED;
            PG8_STAGE(PG8_SB(1, 1), b3 + hstep, voffB);
            PG8_WAIT_V(6); PG8_BAR; PG8_MMA(1, 1, At, B1); PG8_BAR;
            }
        }
        if constexpr (ALIGN_EPI) { if (wr == 0) PG8_BAR; }
        if constexpr (!Epi::AFTER_DRAIN) { int t2_ = threadIdx.x; asm volatile("" : "+v"(t2_)); const int l2_ = t2_ & 63, w2_ = __builtin_amdgcn_readfirstlane(t2_ >> 6);
            E(acc, cur, w2_ >> 2, w2_ & 3, l2_ & 15, l2_ >> 4); S.done(cur); }
        if (!has_next) break;
#pragma unroll
        for (int a = 0; a < 2; ++a)
#pragma unroll
            for (int b = 0; b < 2; ++b)
#pragma unroll
                for (int m = 0; m < 4; ++m)
#pragma unroll
                    for (int n = 0; n < 2; ++n) acc[a][b][m][n] = (f32x4){0.f, 0.f, 0.f, 0.f};
        cur = nxt; cA = nA; cB = nB; ++ui;
        if constexpr (ALIGN_EPI) { if (wr == 1) PG8_BAR; }
    }
    PG8_WAIT_V(0);
    if constexpr (!ALIGN_EPI) { if (wr == 0) PG8_BAR; }
    PG8_BAR;
    if constexpr (Epi::AFTER_DRAIN) { E.fused(acc, cur, wr, wc, fr, fq, lds, wid, lane); S.done(cur); }
#undef PG8_SA
#undef PG8_SB
#undef PG8_STAGE
#undef PG8_LDA
#undef PG8_LDB
#undef PG8_MMA
#undef PG8_WAIT_V
#undef PG8_WAIT_L
#undef PG8_BAR
#undef PG8_SCHED
}
}
constexpr int NWAVES = 8;
constexpr int D = 1024, BATCH = 8, SEQ = 4096, T = BATCH * SEQ, DEPTH = 2, FF = 4096, DPLE = 256;
constexpr int IN_COLS = 6848, RW_COLS = 1792;
constexpr float NORM_EPS = 1e-6f, RW_LN_EPS = 64e-5f;
constexpr float LOG2E = 1.4426950408889634f;
constexpr float MLA_QSCALE = 0.07216878364870322f * LOG2E;
constexpr float CA_QSCALE = 0.125f * LOG2E;
constexpr size_t MiB = 1u << 20;
constexpr size_t WS_CTL = 0, CTL_ZERO_BYTES = 1 * MiB;
constexpr size_t WS_ROPE = 1 * MiB;
constexpr size_t WS_W = 9 * MiB;
constexpr size_t W_IN = WS_W, W_Q = W_IN + (size_t)6912 * 1024 * 2, W_LORA = W_Q + (size_t)768 * 256 * 2, W_B = W_LORA + (size_t)1536 * 256 * 2,
                 W_OUT = W_B + (size_t)3 * 1024 * 512 * 2, W_1 = W_OUT + (size_t)1024 * 1024 * 2, W_2 = W_1 + (size_t)4096 * 1024 * 2, W_G = W_2 + (size_t)4096 * 1024 * 2,
                 W_P = W_G + (size_t)1024 * 1024 * 2, W_END = W_P + (size_t)1024 * 256 * 2;
constexpr size_t WS_U = 49 * MiB;
constexpr size_t WS_OA = 113 * MiB, WS_OC = 145 * MiB, WS_ORW = 177 * MiB;
constexpr size_t WS_X = 209 * MiB, WS_END = 465 * MiB;
static_assert(W_END <= WS_U, "weights fit");
constexpr size_t X_ZC = WS_X, X_QN = X_ZC + (size_t)T * 1536 * 2, X_QP = X_QN + (size_t)T * 256 * 2, X_KV = X_QP + (size_t)T * 768 * 2;
constexpr size_t X_ZR = WS_X, X_LA = X_ZR + (size_t)T * 1792 * 2, X_LO = X_LA + (size_t)T * 256 * 2;
constexpr size_t X_GT = WS_X, X_MG = X_GT + (size_t)T * 3072 * 2;
constexpr size_t X_HID = WS_X, X_PB = WS_X, X_PP = X_PB + (size_t)T * 256 * 2;
static_assert(X_KV + (size_t)T * 192 * 2 <= WS_END && X_LO + (size_t)T * 1536 * 2 <= WS_END && X_MG + (size_t)T * 1024 * 2 <= WS_END && X_HID + (size_t)T * 4096 * 2 <= WS_END, "X map");
constexpr int CW_TMO = 0, CW_BAR = 4096;
constexpr int RING_OFF = 0, RING_BYTES = 131072;
constexpr int LDSCTL_OFF = RING_BYTES, MISC_OFF = LDSCTL_OFF + 320;
constexpr int LDS_BYTES = 147456;

#define GAS __attribute__((address_space(1)))
#define LAS __attribute__((address_space(3)))
typedef unsigned short bf16;
typedef unsigned v4u __attribute__((ext_vector_type(4)));
typedef unsigned v2u __attribute__((ext_vector_type(2)));
typedef float f32x4 __attribute__((ext_vector_type(4)));
typedef float f32x16 __attribute__((ext_vector_type(16)));
typedef short bf16x8 __attribute__((ext_vector_type(8)));
typedef short s16x4 __attribute__((ext_vector_type(4)));
#define LDS_WAIT() asm volatile("s_waitcnt lgkmcnt(0)" ::: "memory")
#define VM_WAIT() asm volatile("s_waitcnt vmcnt(0)" ::: "memory")
__device__ __forceinline__ unsigned f2bf(float f) { unsigned u = __builtin_bit_cast(unsigned, f); return (u + 0x7fffu + ((u >> 16) & 1u)) >> 16; }
__device__ __forceinline__ unsigned pk2(float lo, float hi) { return f2bf(lo) | (f2bf(hi) << 16); }
__device__ __forceinline__ float bfl(unsigned w) { return __uint_as_float(w << 16); }
__device__ __forceinline__ float bfh(unsigned w) { return __uint_as_float(w & 0xffff0000u); }
__device__ __forceinline__ float sigmoidf_(float x) { return 1.0f / (1.0f + __expf(-x)); }
__device__ __forceinline__ float shfl_xor_f(float v, int o, int lane) { return __int_as_float(__builtin_amdgcn_ds_bpermute((lane ^ o) << 2, __float_as_int(v))); }
__device__ __forceinline__ float wave_sum(float v, int lane) {
#pragma unroll
    for (int o = 1; o < 64; o <<= 1) v += shfl_xor_f(v, o, lane);
    return v;
}
__device__ __forceinline__ unsigned char* opq(unsigned char* p) { asm volatile("" : "+s"(p)); return p; }
__device__ __forceinline__ float fsig(float x) { return __builtin_amdgcn_rcpf(1.0f + __builtin_amdgcn_exp2f(-LOG2E * x)); }
#define XB_TMO      128
#define XB_XCNT(j)  (256  + 64 * (j))
#define XB_XSUB(j)  (1280 + 64 * (j))
#define XB_XGEN(j)  (2304 + 64 * (j))
#define XB_TOP      3328
#define XB_TOPGEN   3392
#define XCD_BAR_WORDS 3456
#define XB_SPIN_CAP (1u << 25)

__device__ __forceinline__ unsigned xb_ld(unsigned* p)              { return __hip_atomic_load(p, __ATOMIC_RELAXED, __HIP_MEMORY_SCOPE_AGENT); }
__device__ __forceinline__ unsigned xb_add(unsigned* p, unsigned v) { return __hip_atomic_fetch_add(p, v, __ATOMIC_RELAXED, __HIP_MEMORY_SCOPE_AGENT); }
__device__ __forceinline__ unsigned xb_xcc_id() { return (unsigned)__builtin_amdgcn_s_getreg((3 << 11) | 20) & 0xFu; }
#define XB_SPIN(cond, bar) do { unsigned _sp = 0; while (cond) { __builtin_amdgcn_s_sleep(1); \
    if ((++_sp & 255u) == 0u) { if (xb_ld(&(bar)[XB_TMO])) break; if (_sp > XB_SPIN_CAP) { atomicAdd(&(bar)[XB_TMO], 1u); break; } } } } while (0)

struct XcdBarrier {
    unsigned* bar; unsigned x;
    volatile LAS unsigned* st;
};

__device__ __forceinline__ XcdBarrier xcd_barrier_post(unsigned* bar, volatile LAS unsigned* st) {
    XcdBarrier b; b.bar = bar; b.x = xb_xcc_id(); b.st = st;
    if (threadIdx.x == 0) (void)xb_add(&bar[XB_XCNT(b.x)], 1u);
    return b;
}
__device__ __forceinline__ void xcd_barrier_complete(unsigned* bar, unsigned x, unsigned& nloc, unsigned& nx) {
    const unsigned G = gridDim.x * gridDim.y * gridDim.z;
    unsigned sum, cnt, mine, sp = 0u;
    for (;;) {
        sum = 0u; cnt = 0u; mine = 0u;
#pragma unroll
        for (unsigned j = 0; j < 16; ++j) { const unsigned c = xb_ld(&bar[XB_XCNT(j)]); sum += c; cnt += (c > 0u) ? 1u : 0u; mine = (j == x) ? c : mine; }
        if (sum == G) break;
        __builtin_amdgcn_s_sleep(1);
        if ((++sp & 255u) == 0u) { if (xb_ld(&bar[XB_TMO])) break; if (sp > XB_SPIN_CAP) { atomicAdd(&bar[XB_TMO], 1u); break; } }
    }
    nloc = mine > 0u ? mine : 1u; nx = cnt > 0u ? cnt : 1u;
}

__device__ __forceinline__ void xcd_barrier(const XcdBarrier& b) {
    asm volatile("s_waitcnt vmcnt(0)" ::: "memory");
    __syncthreads();
    if (threadIdx.x == 0) {
        unsigned* bar = b.bar;
        __builtin_amdgcn_s_waitcnt(0);
        unsigned nloc = b.st[0], nx = b.st[1];
        if (nloc == 0u) { xcd_barrier_complete(bar, b.x, nloc, nx); b.st[0] = nloc; b.st[1] = nx; }
        const unsigned old = xb_add(&bar[XB_XSUB(b.x)], 1u);
        const unsigned gen = old / nloc;
        if (old + 1u == (gen + 1u) * nloc) {
            __builtin_amdgcn_fence(__ATOMIC_RELEASE, "agent");
            asm volatile("s_waitcnt vmcnt(0)" ::: "memory");
            const unsigned og = xb_add(&bar[XB_TOP], 1u);
            const unsigned tg = og / nx;
            if (og + 1u == (tg + 1u) * nx) xb_add(&bar[XB_TOPGEN], 1u);
            else XB_SPIN(xb_ld(&bar[XB_TOPGEN]) == tg, bar);
            __builtin_amdgcn_fence(__ATOMIC_ACQUIRE, "agent");
            xb_add(&bar[XB_XGEN(b.x)], 1u);
            asm volatile("s_waitcnt vmcnt(0)" ::: "memory");
        } else {
            XB_SPIN(xb_ld(&bar[XB_XGEN(b.x)]) == gen, bar);
            __builtin_amdgcn_fence(__ATOMIC_ACQUIRE, "agent");
            asm volatile("s_waitcnt vmcnt(0)" ::: "memory");
        }
    }
    __syncthreads();
}
namespace att {
__device__ __forceinline__ int crow(int r, int hi) { return (r & 3) + 8 * (r >> 2) + 4 * hi; }
__device__ __forceinline__ unsigned cvtpk(float lo, float hi) { unsigned r; asm volatile("v_cvt_pk_bf16_f32 %0, %1, %2" : "=v"(r) : "v"(lo), "v"(hi)); return r; }
typedef short v4i16_t __attribute__((ext_vector_type(4)));
__device__ __forceinline__ s16x4 vtr(const LAS unsigned char* p) { return __builtin_bit_cast(s16x4, __builtin_amdgcn_ds_read_tr16_b64_v4i16((LAS v4i16_t*)p)); }
__device__ __forceinline__ float softmax_tile(f32x16& p0, f32x16& p1, float& m_reg, float& l_reg, bf16x8& pa0, bf16x8& pa1, bf16x8& pa2, bf16x8& pa3) {
    float pmax = p0[0];
#pragma unroll
    for (int r = 1; r < 16; ++r) pmax = fmaxf(pmax, p0[r]);
#pragma unroll
    for (int r = 0; r < 16; ++r) pmax = fmaxf(pmax, p1[r]);
    { auto rr = __builtin_amdgcn_permlane32_swap(__float_as_uint(pmax), __float_as_uint(pmax), false, false); pmax = fmaxf(__uint_as_float(rr[0]), __uint_as_float(rr[1])); }
    float alpha = 1.f;
    if (!__all(pmax - m_reg <= 8.f)) { const float mn = fmaxf(m_reg, pmax); alpha = __builtin_amdgcn_exp2f(m_reg - mn); m_reg = mn; }
    float ps = 0.f;
#pragma unroll
    for (int r = 0; r < 16; ++r) { p0[r] = __builtin_amdgcn_exp2f(p0[r] - m_reg); ps += p0[r]; }
#pragma unroll
    for (int r = 0; r < 16; ++r) { p1[r] = __builtin_amdgcn_exp2f(p1[r] - m_reg); ps += p1[r]; }
    { auto rr = __builtin_amdgcn_permlane32_swap(__float_as_uint(ps), __float_as_uint(ps), false, false); ps = __uint_as_float(rr[0]) + __uint_as_float(rr[1]); }
    l_reg = l_reg * alpha + ps;
#define PK4(P, BASE, OUT) do { unsigned a0 = cvtpk(P[BASE + 0], P[BASE + 1]), a1 = cvtpk(P[BASE + 2], P[BASE + 3]);   \
    unsigned b0 = cvtpk(P[BASE + 4], P[BASE + 5]), b1 = cvtpk(P[BASE + 6], P[BASE + 7]);                              \
    auto r0 = __builtin_amdgcn_permlane32_swap(a0, b0, false, false); auto r1 = __builtin_amdgcn_permlane32_swap(a1, b1, false, false); \
    v4u w = {r0[0], r1[0], r0[1], r1[1]}; OUT = __builtin_bit_cast(bf16x8, w); } while (0)
    PK4(p0, 0, pa0); PK4(p0, 8, pa1); PK4(p1, 0, pa2); PK4(p1, 8, pa3);
#undef PK4
    return alpha;
}
constexpr int MLA_KSTR = 400;
constexpr int MLA_KBUF = 64 * MLA_KSTR;
constexpr int ATT_SCR = 2 * MLA_KBUF;
__device__ __forceinline__ void mla_unit(LAS unsigned char* lds, const bf16* __restrict__ QP, const bf16* __restrict__ KV, bf16* __restrict__ OA, int b, int c) {
    int tid_ = threadIdx.x; asm volatile("" : "+v"(tid_));
    const int tid = tid_, lane = tid & 63, wid = __builtin_amdgcn_readfirstlane(tid >> 6), r32 = lane & 31, hi = lane >> 5;
    const int h = wid >> 1; const size_t qrow0 = (size_t)b * SEQ + c * 64 + (wid & 1) * 32;
    bf16x8 qr[12];
    { const bf16* qp = QP + (qrow0 + r32) * 768 + h * 192 + hi * 8;
#pragma unroll
      for (int d0 = 0; d0 < 12; ++d0) qr[d0] = *(const bf16x8*)(qp + d0 * 16); }
    float m_reg = -1e30f, l_reg = 0.f; f32x16 o[4];
#pragma unroll
    for (int d = 0; d < 4; ++d)
#pragma unroll
        for (int r = 0; r < 16; ++r) o[d][r] = 0.f;
    LAS float* scr = (LAS float*)(lds + ATT_SCR) + wid * 64;
    const bf16* kvb = KV + (size_t)b * SEQ * 192;
    int skey[3], sch[3];
#pragma unroll
    for (int i = 0; i < 3; ++i) { const int id = tid + 512 * i; skey[i] = id / 24; sch[i] = id % 24; }
    v4u st[3];
    const int NT = c + 1;
#pragma unroll
    for (int i = 0; i < 3; ++i) st[i] = *(const v4u*)(kvb + (size_t)skey[i] * 192 + sch[i] * 8);
#pragma unroll
    for (int i = 0; i < 3; ++i) *(LAS v4u*)(lds + skey[i] * MLA_KSTR + sch[i] * 16) = st[i];
    __syncthreads();
    const int troff = (((lane & 15) >> 2) + 8 * hi) * MLA_KSTR + (16 * ((lane >> 4) & 1) + 4 * (lane & 3)) * 2;
    for (int j = 0; j < NT; ++j) {
        const int buf = j & 1;
        if (j + 1 < NT) {
#pragma unroll
            for (int i = 0; i < 3; ++i) st[i] = *(const v4u*)(kvb + (size_t)(64 * (j + 1) + skey[i]) * 192 + sch[i] * 8);
        }
        const LAS unsigned char* kt = lds + buf * MLA_KBUF;
        f32x16 p0, p1;
#pragma unroll
        for (int r = 0; r < 16; ++r) { p0[r] = 0.f; p1[r] = 0.f; }
        { const LAS unsigned char* kb = kt + r32 * MLA_KSTR + hi * 16;
#pragma unroll
          for (int d0 = 0; d0 < 12; ++d0) { const bf16x8 a0 = *(const LAS bf16x8*)(kb + d0 * 32); const bf16x8 a1 = *(const LAS bf16x8*)(kb + 32 * MLA_KSTR + d0 * 32);
              p0 = __builtin_amdgcn_mfma_f32_32x32x16_bf16(a0, qr[d0], p0, 0, 0, 0); p1 = __builtin_amdgcn_mfma_f32_32x32x16_bf16(a1, qr[d0], p1, 0, 0, 0); } }
        bf16x8 pa0, pa1, pa2, pa3;
        const float alpha = softmax_tile(p0, p1, m_reg, l_reg, pa0, pa1, pa2, pa3);
        if (__any(alpha < 1.f)) { if (hi == 0) scr[r32] = alpha; LDS_WAIT();
#pragma unroll
            for (int r = 0; r < 16; ++r) { const float a = scr[crow(r, hi)];
#pragma unroll
                for (int d = 0; d < 4; ++d) o[d][r] *= a; } }
        const LAS unsigned char* vb = kt + troff;
#pragma unroll
        for (int d0 = 0; d0 < 4; ++d0) {
            s16x4 lo[4], hh[4];
#pragma unroll
            for (int ks = 0; ks < 4; ++ks) { lo[ks] = vtr(vb + (16 * ks) * MLA_KSTR + d0 * 64); hh[ks] = vtr(vb + (16 * ks + 4) * MLA_KSTR + d0 * 64); }
#define PK(k) (bf16x8){lo[k][0], lo[k][1], lo[k][2], lo[k][3], hh[k][0], hh[k][1], hh[k][2], hh[k][3]}
            o[d0] = __builtin_amdgcn_mfma_f32_32x32x16_bf16(pa0, PK(0), o[d0], 0, 0, 0);
            o[d0] = __builtin_amdgcn_mfma_f32_32x32x16_bf16(pa1, PK(1), o[d0], 0, 0, 0);
            o[d0] = __builtin_amdgcn_mfma_f32_32x32x16_bf16(pa2, PK(2), o[d0], 0, 0, 0);
            o[d0] = __builtin_amdgcn_mfma_f32_32x32x16_bf16(pa3, PK(3), o[d0], 0, 0, 0);
#undef PK
        }
        if (j + 1 < NT) {
#pragma unroll
            for (int i = 0; i < 3; ++i) *(LAS v4u*)(lds + (buf ^ 1) * MLA_KBUF + skey[i] * MLA_KSTR + sch[i] * 16) = st[i];
        }
        __syncthreads();
    }
    if (hi == 0) scr[r32] = l_reg; LDS_WAIT();
    bf16* ob = OA + qrow0 * 512 + h * 128 + r32;
#pragma unroll
    for (int r = 0; r < 16; ++r) { const int orow = crow(r, hi); const float rl = __builtin_amdgcn_rcpf(scr[orow]);
#pragma unroll
        for (int d0 = 0; d0 < 4; ++d0) ob[(size_t)orow * 512 + d0 * 32] = (bf16)f2bf(o[d0][r] * rl); }
    __syncthreads();
}
constexpr int CA_KSTR = 144;
constexpr int CA_TBUF = 64 * CA_KSTR;
constexpr int CA_BIAS = ATT_SCR + 8 * 256;
__device__ __forceinline__ void band_unit(LAS unsigned char* lds, const bf16* __restrict__ ZC, const float* __restrict__ relb, bf16* __restrict__ OC, int b, int h, int g) {
    int tid_ = threadIdx.x; asm volatile("" : "+v"(tid_));
    const int tid = tid_, lane = tid & 63, wid = __builtin_amdgcn_readfirstlane(tid >> 6), r32 = lane & 31, hi = lane >> 5;
    const int cw = 4 * g + (wid >> 1); const size_t qrow0 = (size_t)b * SEQ + cw * 64 + (wid & 1) * 32;
    LAS float* bias = (LAS float*)(lds + CA_BIAS);
    if (tid < 320) bias[tid] = relb[tid * 8 + h] * LOG2E;
    bf16x8 qr[4];
    { const bf16* qp = ZC + (qrow0 + r32) * 1536 + h * 64 + hi * 8;
#pragma unroll
      for (int d0 = 0; d0 < 4; ++d0) qr[d0] = *(const bf16x8*)(qp + d0 * 16); }
    float m_reg = -1e30f, l_reg = 0.f; f32x16 o[2];
#pragma unroll
    for (int d = 0; d < 2; ++d)
#pragma unroll
        for (int r = 0; r < 16; ++r) o[d][r] = 0.f;
    LAS float* scr = (LAS float*)(lds + ATT_SCR) + wid * 64;
    const int kc0 = (4 * g - 8) < 0 ? 0 : (4 * g - 8), kc1 = 4 * g + 3;
    const bf16* kbase = ZC + (size_t)b * SEQ * 1536 + 512 + h * 64; const bf16* vbase = kbase + 512;
    const int skey = tid >> 3, sch = tid & 7;
    v4u stk, stv;
    stk = *(const v4u*)(kbase + (size_t)(64 * kc0 + skey) * 1536 + sch * 8); stv = *(const v4u*)(vbase + (size_t)(64 * kc0 + skey) * 1536 + sch * 8);
    *(LAS v4u*)(lds + skey * CA_KSTR + sch * 16) = stk; *(LAS v4u*)(lds + CA_TBUF + skey * CA_KSTR + sch * 16) = stv;
    __syncthreads();
    const int troff = (((lane & 15) >> 2) + 8 * hi) * CA_KSTR + (16 * ((lane >> 4) & 1) + 4 * (lane & 3)) * 2;
    const int qin = (wid & 1) * 32 + r32;
    for (int kc = kc0; kc <= kc1; ++kc) {
        const int buf = (kc - kc0) & 1;
        if (kc < kc1) { stk = *(const v4u*)(kbase + (size_t)(64 * (kc + 1) + skey) * 1536 + sch * 8); stv = *(const v4u*)(vbase + (size_t)(64 * (kc + 1) + skey) * 1536 + sch * 8); }
        if (kc >= cw - 8 && kc <= cw) {
            const LAS unsigned char* kt = lds + buf * 2 * CA_TBUF;
            f32x16 p0, p1;
            const int dbase = (cw - kc) * 64 + qin + 63;
#pragma unroll
            for (int r = 0; r < 16; ++r) { int i0 = dbase - crow(r, hi), i1 = i0 - 32; i0 = i0 > 319 ? 319 : i0; i1 = i1 > 319 ? 319 : i1; p0[r] = bias[i0]; p1[r] = bias[i1]; }
            { const LAS unsigned char* kb = kt + r32 * CA_KSTR + hi * 16;
#pragma unroll
              for (int d0 = 0; d0 < 4; ++d0) { const bf16x8 a0 = *(const LAS bf16x8*)(kb + d0 * 32); const bf16x8 a1 = *(const LAS bf16x8*)(kb + 32 * CA_KSTR + d0 * 32);
                  p0 = __builtin_amdgcn_mfma_f32_32x32x16_bf16(a0, qr[d0], p0, 0, 0, 0); p1 = __builtin_amdgcn_mfma_f32_32x32x16_bf16(a1, qr[d0], p1, 0, 0, 0); } }
            bf16x8 pa0, pa1, pa2, pa3;
            const float alpha = softmax_tile(p0, p1, m_reg, l_reg, pa0, pa1, pa2, pa3);
            if (__any(alpha < 1.f)) { if (hi == 0) scr[r32] = alpha; LDS_WAIT();
#pragma unroll
                for (int r = 0; r < 16; ++r) { const float a = scr[crow(r, hi)]; o[0][r] *= a; o[1][r] *= a; } }
            const LAS unsigned char* vb = kt + CA_TBUF + troff;
#pragma unroll
            for (int d0 = 0; d0 < 2; ++d0) {
                s16x4 lo[4], hh[4];
#pragma unroll
                for (int ks = 0; ks < 4; ++ks) { lo[ks] = vtr(vb + (16 * ks) * CA_KSTR + d0 * 64); hh[ks] = vtr(vb + (16 * ks + 4) * CA_KSTR + d0 * 64); }
#define PK(k) (bf16x8){lo[k][0], lo[k][1], lo[k][2], lo[k][3], hh[k][0], hh[k][1], hh[k][2], hh[k][3]}
                o[d0] = __builtin_amdgcn_mfma_f32_32x32x16_bf16(pa0, PK(0), o[d0], 0, 0, 0);
                o[d0] = __builtin_amdgcn_mfma_f32_32x32x16_bf16(pa1, PK(1), o[d0], 0, 0, 0);
                o[d0] = __builtin_amdgcn_mfma_f32_32x32x16_bf16(pa2, PK(2), o[d0], 0, 0, 0);
                o[d0] = __builtin_amdgcn_mfma_f32_32x32x16_bf16(pa3, PK(3), o[d0], 0, 0, 0);
#undef PK
            }
        }
        if (kc < kc1) { *(LAS v4u*)(lds + (buf ^ 1) * 2 * CA_TBUF + skey * CA_KSTR + sch * 16) = stk; *(LAS v4u*)(lds + (buf ^ 1) * 2 * CA_TBUF + CA_TBUF + skey * CA_KSTR + sch * 16) = stv; }
        __syncthreads();
    }
    if (hi == 0) scr[r32] = l_reg; LDS_WAIT();
    bf16* ob = OC + qrow0 * 512 + h * 64 + r32;
#pragma unroll
    for (int r = 0; r < 16; ++r) { const int orow = crow(r, hi); const float rl = __builtin_amdgcn_rcpf(scr[orow]);
        ob[(size_t)orow * 512] = (bf16)f2bf(o[0][r] * rl); ob[(size_t)orow * 512 + 32] = (bf16)f2bf(o[1][r] * rl); }
    __syncthreads();
}
}
struct Args { const float* in[30]; float* out; unsigned char* ws; int start; int stop; };
#define KAS __attribute__((address_space(4)))
__device__ __forceinline__ const KAS unsigned char* kbase() { const KAS unsigned char* p = (const KAS unsigned char*)__builtin_amdgcn_kernarg_segment_ptr(); asm volatile("" : "+s"(p)); return p; }
__device__ __forceinline__ const float* kin(int i) { return *(const float* const KAS*)(kbase() + 8 * i); }
__device__ __forceinline__ float* kout() { return *(float* const KAS*)(kbase() + 240); }
__device__ __forceinline__ unsigned char* kws() { return *(unsigned char* const KAS*)(kbase() + 248); }
__device__ __forceinline__ int kstart() { return *(const int KAS*)(kbase() + 256); }
__device__ __forceinline__ int kstop() { return *(const int KAS*)(kbase() + 260); }
struct Frame { LAS unsigned char* lds; int tid, lane, wave, G, gw, NGW; };
__device__ __forceinline__ Frame make_frame(LAS unsigned char* lds) {
    Frame F; int tid = threadIdx.x; asm volatile("" : "+v"(tid)); int bx = blockIdx.x; asm volatile("" : "+s"(bx)); int G = gridDim.x; asm volatile("" : "+s"(G));
    F.lds = lds; F.tid = tid; F.lane = tid & 63; F.wave = __builtin_amdgcn_readfirstlane(tid >> 6); F.G = G; F.gw = bx * NWAVES + F.wave; F.NGW = G * NWAVES; return F;
}

__device__ const double ROPE_INV_FREQ[32] = {1, 0.74989420933245587, 0.56234132519034907, 0.42169650342858223, 0.31622776601683794, 0.23713737056616552, 0.17782794100389229, 0.1333521432163324, 0.10000000000000001, 0.074989420933245579, 0.056234132519034911, 0.042169650342858224, 0.031622776601683791, 0.023713737056616554, 0.017782794100389229, 0.013335214321633241, 0.01, 0.0074989420933245579, 0.005623413251903491, 0.0042169650342858229, 0.0031622776601683794, 0.0023713737056616554, 0.0017782794100389228, 0.0013335214321633241, 0.001, 0.00074989420933245586, 0.0005623413251903491, 0.00042169650342858224, 0.00031622776601683794, 0.00023713737056616554, 0.00017782794100389227, 0.0001333521432163324};
__device__ __forceinline__ void sincos_d(double a, float& s, float& c) {
    const double n = rint(a * 0.63661977236758134308);
    double r = fma(-n, 1.5707963267948966192, a); r = fma(-n, 6.123233995736766036e-17, r);
    const double r2 = r * r;
    double sp = -7.6471637318198164759e-13; sp = fma(sp, r2, 1.6059043836821614599e-10); sp = fma(sp, r2, -2.5052108385441718775e-08); sp = fma(sp, r2, 2.7557319223985890653e-06);
    sp = fma(sp, r2, -1.9841269841269841270e-04); sp = fma(sp, r2, 8.3333333333333333333e-03); sp = fma(sp, r2, -1.6666666666666666667e-01);
    const double sn = fma(sp * r2, r, r);
    double cp = 4.7794773323873852974e-14; cp = fma(cp, r2, -1.1470745597729724714e-11); cp = fma(cp, r2, 2.0876756987868098979e-09); cp = fma(cp, r2, -2.7557319223985890653e-07);
    cp = fma(cp, r2, 2.4801587301587301587e-05); cp = fma(cp, r2, -1.3888888888888888889e-03); cp = fma(cp, r2, 4.1666666666666666667e-02); cp = fma(cp, r2, -0.5);
    const double cs = fma(cp, r2, 1.0);
    const long long q = (long long)n & 3LL; double so, co;
    if (q == 0) { so = sn; co = cs; } else if (q == 1) { so = cs; co = -sn; } else if (q == 2) { so = -sn; co = -cs; } else { so = -cs; co = sn; }
    s = (float)so; c = (float)co;
}
__device__ __forceinline__ void transpose_item(const float* W, int ldw, int col0, int nblk, bf16* WT, int ldt, int row0, LAS float* scr, int item, int lane) {
    const int kb = item / nblk, nb = item % nblk, k0 = 64 * kb, n0 = 32 * nb;
#pragma unroll 8
    for (int i = 0; i < 32; ++i) { const int kk = 2 * i + (lane >> 5); scr[kk * 33 + (lane & 31)] = W[(size_t)(k0 + kk) * ldw + col0 + n0 + (lane & 31)]; }
    LDS_WAIT(); asm volatile("" ::: "memory");
    const int c = lane & 7;
#pragma unroll
    for (int j = 0; j < 4; ++j) { const int n = (lane >> 3) + 8 * j; const LAS float* s = scr + (8 * c) * 33 + n;
        v4u o; o.x = pk2(s[0 * 33], s[1 * 33]); o.y = pk2(s[2 * 33], s[3 * 33]); o.z = pk2(s[4 * 33], s[5 * 33]); o.w = pk2(s[6 * 33], s[7 * 33]);
        *(GAS v4u*)(WT + (size_t)(row0 + n0 + n) * ldt + k0 + 8 * c) = o; }
    LDS_WAIT(); asm volatile("" ::: "memory");
}
__device__ __forceinline__ void rope_table(LAS unsigned char* lds_) {
    const Frame F = make_frame(lds_); const int gt = F.gw * 64 + F.lane, NTH = F.NGW * 64;
    const int* pos = (const int*)kin(2); float* rope = (float*)(kws() + WS_ROPE);
    for (int i = gt; i < T * 32; i += NTH) { float s, c; sincos_d((double)pos[i >> 5] * ROPE_INV_FREQ[i & 31], s, c); rope[2 * (size_t)i] = c; rope[2 * (size_t)i + 1] = s; }
}
__device__ __forceinline__ void p0_prologue(LAS unsigned char* lds_, const Args& A, int l) {
    const Frame F = make_frame(lds_);
    LAS float* scr = (LAS float*)(F.lds + RING_OFF + F.wave * 16384);
    constexpr int I1 = 16 * 14, I2 = 16 * 48, I3 = 16 * 56, I4 = 16 * 96, I5 = 8 * 32, I6 = 8 * 32, I7 = 16 * 32, I8 = 16 * 128, I9 = 64 * 32, I10 = 16 * 32, I11 = 4 * 32;
    constexpr int NITEMS = I1 + I2 + I3 + I4 + I5 + I6 + I7 + I8 + I9 + I10 + I11;
#define WIN_ (kin(4) + (size_t)l * 1024 * IN_COLS)
#define WBR_ (kin(21) + (size_t)l * 1536 * 1024)
    for (int it = F.gw; it < NITEMS; it += F.NGW) {
        int r = it;
        if (r < I1) { transpose_item(WIN_, IN_COLS, 0, 14, (bf16*)(kws() + W_IN), 1024, 0, scr, r, F.lane); continue; } r -= I1;
        if (r < I2) { transpose_item(WIN_, IN_COLS, 2240, 48, (bf16*)(kws() + W_IN), 1024, 512, scr, r, F.lane); continue; } r -= I2;
        if (r < I3) { transpose_item(WIN_, IN_COLS, 448, 56, (bf16*)(kws() + W_IN), 1024, 2048, scr, r, F.lane); continue; } r -= I3;
        if (r < I4) { transpose_item(WIN_, IN_COLS, 3776, 96, (bf16*)(kws() + W_IN), 1024, 3840, scr, r, F.lane); continue; } r -= I4;
        if (r < I5) { transpose_item(WBR_ + (size_t)512 * 1024, 1024, 0, 32, (bf16*)(kws() + W_B) + (size_t)1024 * 512, 512, 0, scr, r, F.lane); continue; } r -= I5;
        if (r < I6) { transpose_item(WBR_ + (size_t)1024 * 1024, 1024, 0, 32, (bf16*)(kws() + W_B) + (size_t)2 * 1024 * 512, 512, 0, scr, r, F.lane); continue; } r -= I6;
        if (r < I7) { transpose_item(kin(22) + (size_t)l * 1024 * 1024, 1024, 0, 32, (bf16*)(kws() + W_OUT), 1024, 0, scr, r, F.lane); continue; } r -= I7;
        if (r < I8) { transpose_item(kin(25) + (size_t)l * 1024 * 4096, 4096, 0, 128, (bf16*)(kws() + W_1), 1024, 0, scr, r, F.lane); continue; } r -= I8;
        if (r < I9) { transpose_item(kin(26) + (size_t)l * 4096 * 1024, 1024, 0, 32, (bf16*)(kws() + W_2), 4096, 0, scr, r, F.lane); continue; } r -= I9;
        if (r < I10) { transpose_item(kin(28) + (size_t)l * 1024 * 1024, 1024, 0, 32, (bf16*)(kws() + W_G), 1024, 0, scr, r, F.lane); continue; } r -= I10;
        transpose_item(kin(29) + (size_t)l * 256 * 1024, 1024, 0, 32, (bf16*)(kws() + W_P), 256, 0, scr, r, F.lane);
    }
    const int gt = F.gw * 64 + F.lane, NTH = F.NGW * 64;
    { bf16* WinT = (bf16*)(kws() + W_IN); for (int i = gt; i < 64 * 1024; i += NTH) WinT[(size_t)448 * 1024 + i] = 0; }
    { const float* w_uq = kin(7) + (size_t)l * 256 * 768; const float* w_ukv = kin(8) + (size_t)l * 128 * 1024; bf16* WqT = (bf16*)(kws() + W_Q);
      for (int i = gt; i < 768 * 256; i += NTH) {
        const int n = i >> 8, kq = i & 255, h = n / 192, ii = n % 192; float s;
        if (ii < 128) { s = 0.f; const float* a = w_uq + (size_t)kq * 768 + h * 192; const float* b = w_ukv + (size_t)ii * 1024 + h * 256;
            for (int nn = 0; nn < 128; ++nn) s = fmaf(a[nn], b[nn], s); }
        else { const int jj = ii - 128, j = jj >> 1; s = w_uq[(size_t)kq * 768 + h * 192 + 128 + ((jj & 1) ? j + 32 : j)]; }
        WqT[i] = (bf16)f2bf(s);
      } }
    { const float* w_ukv = kin(8) + (size_t)l * 128 * 1024; const float* w_br = WBR_; bf16* WbT = (bf16*)(kws() + W_B);
      for (int i = gt; i < 512 * 1024; i += NTH) {
        const int dd = i & 1023, hl = i >> 10, h = hl >> 7, lat = hl & 127; float s = 0.f;
        const float* a = w_ukv + (size_t)lat * 1024 + h * 256 + 128; const float* b = w_br + (size_t)(h * 128) * 1024 + dd;
        for (int v = 0; v < 128; ++v) s = fmaf(a[v], b[(size_t)v * 1024], s);
        WbT[(size_t)dd * 512 + hl] = (bf16)f2bf(s);
      } }
    { const float* w_up = kin(11) + (size_t)l * 64 * 512; const float* a_up = kin(13) + (size_t)l * 64 * 512; const float* g_up = kin(14) + (size_t)l * 128 * 512; bf16* WloT = (bf16*)(kws() + W_LORA);
      for (int i = gt; i < 1536 * 256; i += NTH) {
        const int n = i >> 8, k = i & 255, blk = n >> 9, nn = n & 511; float s = 0.f;
        if (blk == 0) { if (k < 64) s = w_up[(size_t)k * 512 + nn]; } else if (blk == 1) { if (k >= 64 && k < 128) s = a_up[(size_t)(k - 64) * 512 + nn]; } else { if (k >= 128) s = g_up[(size_t)(k - 128) * 512 + nn]; }
        WloT[i] = (bf16)f2bf(s);
      } }
#undef WIN_
#undef WBR_
    unsigned char* ws = kws();
    const float* src = (l == 0) ? kin(0) : kout(); const float* g = kin(3) + l * 1024; bf16* U = (bf16*)(ws + WS_U);
    f32x4 gv[4];
#pragma unroll
    for (int j = 0; j < 4; ++j) gv[j] = *(const f32x4*)(g + 4 * F.lane + 256 * j);
    for (int m = F.gw; m < T; m += F.NGW) {
        const f32x4* xr = (const f32x4*)(src + (size_t)m * D) + F.lane; f32x4 v[4]; float s = 0.f;
#pragma unroll
        for (int j = 0; j < 4; ++j) { v[j] = xr[64 * j]; s += (v[j].x * v[j].x + v[j].y * v[j].y) + (v[j].z * v[j].z + v[j].w * v[j].w); }
        if (l == 0) { f32x4* ho = (f32x4*)(kout() + (size_t)m * D) + F.lane;
#pragma unroll
            for (int j = 0; j < 4; ++j) ho[64 * j] = v[j]; }
        const float rs = rsqrtf(wave_sum(s, F.lane) * (1.f / D) + NORM_EPS);
        v2u* o8 = (v2u*)(U + (size_t)m * D) + F.lane;
#pragma unroll
        for (int j = 0; j < 4; ++j) { const f32x4 y = v[j] * rs * gv[j]; v2u w; w.x = pk2(y.x, y.y); w.y = pk2(y.z, y.w); o8[64 * j] = w; }
    }
}
__device__ __forceinline__ void p2_mla_prep(LAS unsigned char* lds_, const Args& A, int l) {
    const Frame F = make_frame(lds_);
    const bf16* ZM = (const bf16*)(kws() + WS_OA); bf16* QN = (bf16*)(kws() + X_QN); bf16* KV = (bf16*)(kws() + X_KV); const float* rope = (const float*)(kws() + WS_ROPE);
    const f32x4 gq = *(const f32x4*)(kin(5) + l * 256 + 4 * F.lane); const float gk0 = kin(6)[l * 128 + 2 * F.lane], gk1 = kin(6)[l * 128 + 2 * F.lane + 1];
    for (int t = F.gw; t < T; t += F.NGW) {
        const bf16* z = ZM + (size_t)t * 512;
        const v2u wq = *(const v2u*)(z + 4 * F.lane); const unsigned wk = *(const unsigned*)(z + 256 + 2 * F.lane); const float kr = bfl((unsigned)z[384 + F.lane]);
        const float q0 = bfl(wq.x), q1 = bfh(wq.x), q2 = bfl(wq.y), q3 = bfh(wq.y), k0 = bfl(wk), k1 = bfh(wk);
        const float rq = rsqrtf(wave_sum(q0 * q0 + q1 * q1 + q2 * q2 + q3 * q3, F.lane) * (1.f / 256.f) + NORM_EPS);
        const float rk = rsqrtf(wave_sum(k0 * k0 + k1 * k1, F.lane) * (1.f / 128.f) + NORM_EPS);
        v2u o; o.x = pk2(q0 * rq * gq.x, q1 * rq * gq.y); o.y = pk2(q2 * rq * gq.z, q3 * rq * gq.w);
        *(v2u*)(QN + (size_t)t * 256 + 4 * F.lane) = o;
        *(unsigned*)(KV + (size_t)t * 192 + 2 * F.lane) = pk2(k0 * rk * gk0, k1 * rk * gk1);
        const float other = shfl_xor_f(kr, 32, F.lane);
        if (F.lane < 32) { const float c = rope[((size_t)t * 32 + F.lane) * 2], s = rope[((size_t)t * 32 + F.lane) * 2 + 1];
            *(unsigned*)(KV + (size_t)t * 192 + 128 + 2 * F.lane) = pk2(kr * c - other * s, other * c + kr * s); }
    }
}
__device__ __forceinline__ void p6_rw_prep(LAS unsigned char* lds_, const Args& A, int l) {
    const Frame F = make_frame(lds_);
    const bf16* ZR = (const bf16*)(kws() + X_ZR); bf16* LA = (bf16*)(kws() + X_LA);
    const f32x4 mu = *(const f32x4*)(kin(9) + l * RW_COLS + 1536 + 4 * F.lane);
    for (int t = F.gw; t < T; t += F.NGW) {
        const v2u wc = *(const v2u*)(ZR + (size_t)t * 1792 + 1536 + 4 * F.lane); v2u wp; wp.x = 0u; wp.y = 0u;
        if ((t & (SEQ - 1)) != 0) wp = *(const v2u*)(ZR + (size_t)(t - 1) * 1792 + 1536 + 4 * F.lane);
        float z[4] = {bfl(wc.x), bfh(wc.x), bfl(wc.y), bfh(wc.y)}; const float p[4] = {bfl(wp.x), bfh(wp.x), bfl(wp.y), bfh(wp.y)}; const float m[4] = {mu.x, mu.y, mu.z, mu.w};
#pragma unroll
        for (int e = 0; e < 4; ++e) { float v = z[e] + (p[e] - z[e]) * m[e]; if (F.lane < 16) v = 1.f - 2.f * __builtin_amdgcn_rcpf(1.f + __builtin_amdgcn_exp2f(2.f * LOG2E * v)); else if (F.lane >= 32) v = fsig(v); z[e] = v; }
        v2u o; o.x = pk2(z[0], z[1]); o.y = pk2(z[2], z[3]); *(v2u*)(LA + (size_t)t * 256 + 4 * F.lane) = o;
    }
}
template <int MODE>
__device__ __forceinline__ void rowpass(LAS unsigned char* lds_, const Args& A, const bf16* M, const float* g1, const float* g2, const float* pl) {
    const Frame F = make_frame(lds_);
    bf16* U = (bf16*)(kws() + WS_U); bf16* PB = (bf16*)(kws() + X_PB);
    f32x4 g1v[4], g2v[4];
#pragma unroll
    for (int j = 0; j < 4; ++j) { g1v[j] = *(const f32x4*)(g1 + 4 * F.lane + 256 * j); if (MODE == 0) g2v[j] = *(const f32x4*)(g2 + 4 * F.lane + 256 * j); }
    for (int m = F.gw; m < T; m += F.NGW) {
        const v2u* mr = (const v2u*)(M + (size_t)m * D) + F.lane; f32x4* hr = (f32x4*)(kout() + (size_t)m * D) + F.lane;
        f32x4 x[4], hv[4]; float s = 0.f;
#pragma unroll
        for (int j = 0; j < 4; ++j) { const v2u w = mr[64 * j]; x[j] = (f32x4){bfl(w.x), bfh(w.x), bfl(w.y), bfh(w.y)}; hv[j] = hr[64 * j]; s += (x[j].x * x[j].x + x[j].y * x[j].y) + (x[j].z * x[j].z + x[j].w * x[j].w); }
        const float rs = rsqrtf(wave_sum(s, F.lane) * (1.f / D) + NORM_EPS); float s2 = 0.f;
#pragma unroll
        for (int j = 0; j < 4; ++j) { hv[j] = hv[j] + x[j] * rs * g1v[j]; hr[64 * j] = hv[j]; s2 += (hv[j].x * hv[j].x + hv[j].y * hv[j].y) + (hv[j].z * hv[j].z + hv[j].w * hv[j].w); }
        v2u* o8 = (v2u*)(U + (size_t)m * D) + F.lane;
        if (MODE == 0) { const float rs2 = rsqrtf(wave_sum(s2, F.lane) * (1.f / D) + NORM_EPS);
#pragma unroll
            for (int j = 0; j < 4; ++j) { const f32x4 y = hv[j] * rs2 * g2v[j]; v2u w; w.x = pk2(y.x, y.y); w.y = pk2(y.z, y.w); o8[64 * j] = w; } }
        else {
#pragma unroll
            for (int j = 0; j < 4; ++j) { v2u w; w.x = pk2(hv[j].x, hv[j].y); w.y = pk2(hv[j].z, hv[j].w); o8[64 * j] = w; }
            const f32x4 pv = *((const f32x4*)(pl + (size_t)m * DPLE) + F.lane); v2u w; w.x = pk2(pv.x, pv.y); w.y = pk2(pv.z, pv.w); *((v2u*)(PB + (size_t)m * DPLE) + F.lane) = w; }
    }
}
namespace rw {
typedef short v4i16_t __attribute__((ext_vector_type(4)));
constexpr int RS = 144;
constexpr int O_AT = 0, O_BT = 9216, O_KT = 18432, O_RT = 27648;
constexpr int O_UV = 36864;
constexpr int O_BK = O_UV + 4 * 32 * RS;
constexpr int O_SB = O_BK + 4 * 32 * RS;
constexpr int O_RHS = O_SB + 64 * RS;
constexpr int O_SM = O_RHS + 32 * RS;
constexpr int O_GC = O_SM + 16 * 1024;
constexpr int O_CB = O_GC + 1024;
constexpr int O_LW = O_CB + 256;
constexpr int O_PAR = O_LW + 16384;
constexpr int LDS_END = O_PAR + 10 * 256;
static_assert(LDS_END <= RING_BYTES, "rwkv LDS map");
__device__ __forceinline__ bf16x8 trfrag(const LAS unsigned char* p) {
    const s16x4 lo = __builtin_bit_cast(s16x4, __builtin_amdgcn_ds_read_tr16_b64_v4i16((LAS v4i16_t*)p));
    const s16x4 hh = __builtin_bit_cast(s16x4, __builtin_amdgcn_ds_read_tr16_b64_v4i16((LAS v4i16_t*)(p + 4 * RS)));
    return (bf16x8){lo[0], lo[1], lo[2], lo[3], hh[0], hh[1], hh[2], hh[3]};
}
__device__ __forceinline__ void st_bf(LAS unsigned char* p, float x) { *(LAS unsigned short*)p = (unsigned short)f2bf(x); }
__device__ __forceinline__ void rw_unit(LAS unsigned char* lds, int l, int seq) {
    int tid_ = threadIdx.x; asm volatile("" : "+v"(tid_));
    const int tid = tid_, lane = tid & 63, w = __builtin_amdgcn_readfirstlane(tid >> 6), g4 = lane >> 4, l15 = lane & 15, q4 = l15 >> 2, p4 = lane & 3;
    const int b = seq >> 3, h = seq & 7;
    const bf16* ZRb = (const bf16*)(kws() + X_ZR) + (size_t)b * SEQ * 1792 + h * 64; const bf16* LOb = (const bf16*)(kws() + X_LO) + (size_t)b * SEQ * 1536 + h * 64;
    bf16* ORWb = (bf16*)(kws() + WS_ORW) + (size_t)b * SEQ * 512 + h * 64;
    LAS float* par = (LAS float*)(lds + O_PAR);
    if (tid < 64) { const int c = h * 64 + tid;
        par[tid] = kin(9)[l * RW_COLS + c]; par[64 + tid] = kin(9)[l * RW_COLS + 512 + c]; par[128 + tid] = kin(9)[l * RW_COLS + 1024 + c];
        par[192 + tid] = kin(10)[l * 512 + c]; par[256 + tid] = kin(12)[l * 512 + c]; par[320 + tid] = kin(15)[l * 512 + c]; par[384 + tid] = kin(16)[l * 512 + c];
        par[448 + tid] = kin(17)[l * 512 + c]; par[512 + tid] = kin(18)[l * 512 + c]; par[576 + tid] = kin(19)[l * 512 + c]; }
    for (int i = tid; i < (O_GC - O_UV) / 4; i += 512) ((LAS unsigned*)(lds + O_UV))[i] = 0u;
    f32x4 Sacc[2] = {{0.f, 0.f, 0.f, 0.f}, {0.f, 0.f, 0.f, 0.f}};
    f32x4 ykeep = {0.f, 0.f, 0.f, 0.f};
    __syncthreads();
    const int et = tid >> 3, ecg = tid & 7, ei = et >> 4, ett = et & 15;
    const int trrow = 8 * g4 + q4, trrow1 = 8 * (g4 & 1) + q4, trcol = 8 * p4;
    for (int sc = 0; sc < SEQ / 64; ++sc) {
        const int tok0 = sc * 64;
        {   const bf16* zr = ZRb + (size_t)(tok0 + et) * 1792 + 8 * ecg; const bf16* lo = LOb + (size_t)(tok0 + et) * 1536 + 8 * ecg;
            float cr[8], ck[8], cv[8], pr[8], pk[8], pv[8], tw[8], ta[8];
            pg8::unpack8(*(const v4u*)(zr), cr); pg8::unpack8(*(const v4u*)(zr + 512), ck); pg8::unpack8(*(const v4u*)(zr + 1024), cv);
            pg8::unpack8(*(const v4u*)(lo), tw); pg8::unpack8(*(const v4u*)(lo + 512), ta);
            if (tok0 + et > 0) { pg8::unpack8(*(const v4u*)(zr - 1792), pr); pg8::unpack8(*(const v4u*)(zr - 1792 + 512), pk); pg8::unpack8(*(const v4u*)(zr - 1792 + 1024), pv); }
            else { for (int e = 0; e < 8; ++e) { pr[e] = 0.f; pk[e] = 0.f; pv[e] = 0.f; } }
            float rr[8], kkv[8], kav[8], kmv[8], vv[8], lwv[8]; float ss = 0.f, cbp = 0.f;
#pragma unroll
            for (int e = 0; e < 8; ++e) { const int c = 8 * ecg + e;
                const float r = cr[e] + (pr[e] - cr[e]) * par[c], k = ck[e] + (pk[e] - ck[e]) * par[64 + c], v = cv[e] + (pv[e] - cv[e]) * par[128 + c];
                const float x = -(par[192 + c] + tw[e]); const float sp = fmaxf(x, 0.f) + 0.6931471805599453f * __builtin_amdgcn_logf(1.f + __builtin_amdgcn_exp2f(-LOG2E * fabsf(x)));
                lwv[e] = -__builtin_amdgcn_exp2f(LOG2E * (-sp - 0.5f));
                const float a = fsig(par[256 + c] + ta[e]);
                const float kk = k * par[320 + c]; ss += kk * kk;
                const float km = k * (1.f + (a - 1.f) * par[384 + c]);
                rr[e] = r; kkv[e] = kk; kav[e] = a; kmv[e] = km; vv[e] = v; cbp += r * km * par[448 + c]; }
            ss += shfl_xor_f(ss, 1, lane); ss += shfl_xor_f(ss, 2, lane); ss += shfl_xor_f(ss, 4, lane);
            cbp += shfl_xor_f(cbp, 1, lane); cbp += shfl_xor_f(cbp, 2, lane); cbp += shfl_xor_f(cbp, 4, lane);
            const float rn = rsqrtf(fmaxf(ss, 1e-24f));
            if (ecg == 0) ((LAS float*)(lds + O_CB))[et] = cbp;
            v4u wA, wB, wK, wR, wV;
#define PK8(dst, expr) do { float t_[8]; for (int e = 0; e < 8; ++e) { t_[e] = (expr); } dst.x = pk2(t_[0], t_[1]); dst.y = pk2(t_[2], t_[3]); dst.z = pk2(t_[4], t_[5]); dst.w = pk2(t_[6], t_[7]); } while (0)
            PK8(wA, -kkv[e] * rn); PK8(wB, kkv[e] * rn * kav[e]); PK8(wK, kmv[e]); PK8(wR, rr[e]); PK8(wV, vv[e]);
#undef PK8
            const int ro = et * RS + 16 * ecg;
            *(LAS v4u*)(lds + O_AT + ro) = wA; *(LAS v4u*)(lds + O_BT + ro) = wB; *(LAS v4u*)(lds + O_KT + ro) = wK; *(LAS v4u*)(lds + O_RT + ro) = wR;
            *(LAS v4u*)(lds + O_BK + (ei * 32 + ett) * RS + 16 * ecg) = wB; *(LAS v4u*)(lds + O_BK + (ei * 32 + 16 + ett) * RS + 16 * ecg) = wK;
            *(LAS v4u*)(lds + O_UV + (ei * 32 + 16 + ett) * RS + 16 * ecg) = wV;
            LAS float* lwp = (LAS float*)(lds + O_LW) + et * 64 + 8 * ecg;
            *(LAS f32x4*)lwp = (f32x4){lwv[0], lwv[1], lwv[2], lwv[3]}; *(LAS f32x4*)(lwp + 4) = (f32x4){lwv[4], lwv[5], lwv[6], lwv[7]};
        }
        __syncthreads();
        {   const int c = lane, i = w & 3, hf = w >> 2; const LAS float* lwc = (const LAS float*)(lds + O_LW) + (16 * i) * 64 + c;
            float cum[16]; float run = 0.f;
#pragma unroll
            for (int t = 0; t < 16; ++t) { run += lwc[t * 64]; cum[t] = run; }
            const float tot = run;
            if (hf == 0) ((LAS float*)(lds + O_GC))[i * 64 + c] = __builtin_amdgcn_exp2f(LOG2E * tot);
#pragma unroll
            for (int tt = 0; tt < 8; ++tt) { const int t = 8 * hf + tt; const float cu = hf ? cum[8 + tt] : cum[tt]; const float cprev = (t == 0) ? 0.f : (hf ? cum[7 + tt] : (tt ? cum[tt - 1] : 0.f));
                const float gg = __builtin_amdgcn_exp2f(LOG2E * cu), gp = __builtin_amdgcn_exp2f(LOG2E * cprev), gi = __builtin_amdgcn_exp2f(-LOG2E * cu), gh = __builtin_amdgcn_exp2f(LOG2E * (tot - cu));
                const int ro = (16 * i + t) * RS + 2 * c;
                LAS unsigned short* pa = (LAS unsigned short*)(lds + O_AT + ro); *pa = (unsigned short)f2bf(bfl((unsigned)*pa) * gp);
                LAS unsigned short* pb = (LAS unsigned short*)(lds + O_BT + ro); *pb = (unsigned short)f2bf(bfl((unsigned)*pb) * gi);
                LAS unsigned short* pk = (LAS unsigned short*)(lds + O_KT + ro); *pk = (unsigned short)f2bf(bfl((unsigned)*pk) * gi);
                LAS unsigned short* pr2 = (LAS unsigned short*)(lds + O_RT + ro); *pr2 = (unsigned short)f2bf(bfl((unsigned)*pr2) * gg);
                LAS unsigned short* pbh = (LAS unsigned short*)(lds + O_BK + (i * 32 + t) * RS + 2 * c); *pbh = (unsigned short)f2bf(bfl((unsigned)*pbh) * gh);
                LAS unsigned short* pkh = (LAS unsigned short*)(lds + O_BK + (i * 32 + 16 + t) * RS + 2 * c); *pkh = (unsigned short)f2bf(bfl((unsigned)*pkh) * gh); }
        }
        __syncthreads();
        {   const int i = w & 3, hf = w >> 2;
            const LAS unsigned char* xa = lds + (hf ? O_RT : O_AT) + (16 * i + l15) * RS + 16 * g4;
            const LAS unsigned char* xb = lds + O_BT + (16 * i + l15) * RS + 16 * g4; const LAS unsigned char* xk = lds + O_KT + (16 * i + l15) * RS + 16 * g4;
            f32x4 c1 = {0.f, 0.f, 0.f, 0.f}, c2 = {0.f, 0.f, 0.f, 0.f};
#pragma unroll
            for (int ks = 0; ks < 2; ++ks) { const bf16x8 a = *(const LAS bf16x8*)(xa + 64 * ks);
                c1 = __builtin_amdgcn_mfma_f32_16x16x32_bf16(a, *(const LAS bf16x8*)(xb + 64 * ks), c1, 0, 0, 0);
                c2 = __builtin_amdgcn_mfma_f32_16x16x32_bf16(a, *(const LAS bf16x8*)(xk + 64 * ks), c2, 0, 0, 0); }
#pragma unroll
            for (int r = 0; r < 4; ++r) { const int t = 4 * g4 + r; const bool keep = hf ? (l15 <= t) : (l15 < t); const float v1 = keep ? c1[r] : 0.f, v2 = keep ? c2[r] : 0.f;
                if (hf == 0) { ((LAS float*)(lds + O_LW))[(i * 16 + t) * 16 + l15] = v1; st_bf(lds + O_SM + (4 + i) * 1024 + t * 64 + 2 * l15, v2); }
                else { st_bf(lds + O_SM + (8 + i) * 1024 + t * 64 + 2 * l15, v1); st_bf(lds + O_SM + (12 + i) * 1024 + t * 64 + 2 * l15, v2); } }
        }
        __syncthreads();
        if (w < 4 && lane < 16) { const LAS float* Lm = (const LAS float*)(lds + O_LW) + w * 256; float x[16];
#pragma unroll
            for (int t = 0; t < 16; ++t) { float s = (t == lane) ? 1.f : 0.f;
#pragma unroll
                for (int s2 = 0; s2 < 16; ++s2) if (s2 < t) s = fmaf(Lm[t * 16 + s2], x[s2], s);
                x[t] = s; st_bf(lds + O_SM + w * 1024 + t * 64 + 2 * lane, s); } }
        __syncthreads();
#pragma unroll 1
        for (int i = 0; i < 4; ++i) {
            {
                const int which = w >> 2, v0 = 16 * (w & 3); f32x4 acc = {0.f, 0.f, 0.f, 0.f};
                const bf16x8 am = *(const LAS bf16x8*)(lds + O_SM + ((which ? 12 : 4) + i) * 1024 + l15 * 64 + 16 * g4);
                acc = __builtin_amdgcn_mfma_f32_16x16x32_bf16(am, trfrag(lds + O_UV + (i * 32 + 16 + trrow1) * RS + 2 * v0 + trcol), acc, 0, 0, 0);
                const LAS unsigned char* xa = lds + (which ? O_RT : O_AT) + (16 * i + l15) * RS + 16 * g4; const LAS unsigned char* sb = lds + O_SB + (v0 + l15) * RS + 16 * g4;
#pragma unroll
                for (int ks = 0; ks < 2; ++ks) acc = __builtin_amdgcn_mfma_f32_16x16x32_bf16(*(const LAS bf16x8*)(xa + 64 * ks), *(const LAS bf16x8*)(sb + 64 * ks), acc, 0, 0, 0);
                if (which == 0) {
#pragma unroll
                    for (int r = 0; r < 4; ++r) st_bf(lds + O_RHS + (4 * g4 + r) * RS + 2 * (v0 + l15), acc[r]); }
                else ykeep = acc;
            }
            __syncthreads();
            if (w < 4) {
                const int v0 = 16 * w; f32x4 acc = {0.f, 0.f, 0.f, 0.f};
                const bf16x8 tm = *(const LAS bf16x8*)(lds + O_SM + i * 1024 + l15 * 64 + 16 * g4);
                acc = __builtin_amdgcn_mfma_f32_16x16x32_bf16(tm, trfrag(lds + O_RHS + trrow1 * RS + 2 * v0 + trcol), acc, 0, 0, 0);
#pragma unroll
                for (int r = 0; r < 4; ++r) st_bf(lds + O_UV + (i * 32 + 4 * g4 + r) * RS + 2 * (v0 + l15), acc[r]);
            }
            __syncthreads();
            {
                if (w >= 4) { const int v0 = 16 * (w & 3);
                    const bf16x8 am = *(const LAS bf16x8*)(lds + O_SM + (8 + i) * 1024 + l15 * 64 + 16 * g4);
                    const f32x4 y = __builtin_amdgcn_mfma_f32_16x16x32_bf16(am, trfrag(lds + O_UV + (i * 32 + trrow1) * RS + 2 * v0 + trcol), ykeep, 0, 0, 0);
#pragma unroll
                    for (int r = 0; r < 4; ++r) st_bf(lds + O_LW + 4096 + (16 * i + 4 * g4 + r) * RS + 2 * (v0 + l15), y[r]); }
#pragma unroll
                for (int j = 0; j < 2; ++j) { const int id = 2 * w + j, vt = id >> 2, kt = id & 3;
                    const float gc = ((const LAS float*)(lds + O_GC))[i * 64 + 16 * kt + l15];
                    f32x4 acc = Sacc[j] * gc;
                    acc = __builtin_amdgcn_mfma_f32_16x16x32_bf16(trfrag(lds + O_UV + (i * 32 + trrow) * RS + 32 * vt + trcol), trfrag(lds + O_BK + (i * 32 + trrow) * RS + 32 * kt + trcol), acc, 0, 0, 0);
                    Sacc[j] = acc;
#pragma unroll
                    for (int r = 0; r < 4; ++r) st_bf(lds + O_SB + (16 * vt + 4 * g4 + r) * RS + 2 * (16 * kt + l15), acc[r]); }
            }
            __syncthreads();
        }
        {   float y[8], vv[8], gg[8];
            pg8::unpack8(*(const LAS v4u*)(lds + O_LW + 4096 + et * RS + 16 * ecg), y); pg8::unpack8(*(const LAS v4u*)(lds + O_UV + (ei * 32 + 16 + ett) * RS + 16 * ecg), vv);
            pg8::unpack8(*(const v4u*)(LOb + (size_t)(tok0 + et) * 1536 + 1024 + 8 * ecg), gg);
            float s = 0.f;
#pragma unroll
            for (int e = 0; e < 8; ++e) s += y[e];
            s += shfl_xor_f(s, 1, lane); s += shfl_xor_f(s, 2, lane); s += shfl_xor_f(s, 4, lane);
            const float mean = s * (1.f / 64.f); float q = 0.f;
#pragma unroll
            for (int e = 0; e < 8; ++e) { y[e] -= mean; q += y[e] * y[e]; }
            q += shfl_xor_f(q, 1, lane); q += shfl_xor_f(q, 2, lane); q += shfl_xor_f(q, 4, lane);
            const float rstd = rsqrtf(q * (1.f / 64.f) + RW_LN_EPS), cb = ((const LAS float*)(lds + O_CB))[et];
            float o[8];
#pragma unroll
            for (int e = 0; e < 8; ++e) { const int c = 8 * ecg + e; o[e] = (y[e] * rstd * par[512 + c] + par[576 + c] + cb * vv[e]) * gg[e]; }
            v4u wo; wo.x = pk2(o[0], o[1]); wo.y = pk2(o[2], o[3]); wo.z = pk2(o[4], o[5]); wo.w = pk2(o[6], o[7]);
            *(v4u*)(ORWb + (size_t)(tok0 + et) * 512 + 8 * ecg) = wo;
        }
        __syncthreads();
    }
}
}
#if defined(DBG_NAIVE_ATTN)
__device__ __forceinline__ void naive_mla(LAS unsigned char* lds_, const bf16* QP, const bf16* KV, bf16* OA) {
    const Frame F = make_frame(lds_); LAS float* sc = (LAS float*)(F.lds + F.wave * 16384);
    for (int item = F.gw; item < T * 4; item += F.NGW) {
        const int t = item >> 2, h = item & 3, b = t / SEQ, tl = t % SEQ, nk = ((tl >> 6) + 1) << 6;
        const bf16* q = QP + (size_t)t * 768 + h * 192; const bf16* kb = KV + (size_t)b * SEQ * 192;
        float mx = -1e30f;
        for (int k = F.lane; k < nk; k += 64) { float s = 0.f; const bf16* kr = kb + (size_t)k * 192;
            for (int d = 0; d < 192; ++d) s += bfl((unsigned)q[d]) * bfl((unsigned)kr[d]);
            sc[k] = s; mx = fmaxf(mx, s); }
        for (int o = 1; o < 64; o <<= 1) mx = fmaxf(mx, shfl_xor_f(mx, o, F.lane));
        float sum = 0.f;
        for (int k = F.lane; k < nk; k += 64) { const float p = exp2f(sc[k] - mx); sc[k] = p; sum += p; }
        sum = wave_sum(sum, F.lane);
        LDS_WAIT(); asm volatile("" ::: "memory");
        float o0 = 0.f, o1 = 0.f;
        for (int k = 0; k < nk; ++k) { const float p = sc[k]; o0 += p * bfl((unsigned)kb[(size_t)k * 192 + F.lane]); o1 += p * bfl((unsigned)kb[(size_t)k * 192 + 64 + F.lane]); }
        OA[(size_t)t * 512 + h * 128 + F.lane] = (bf16)f2bf(o0 / sum); OA[(size_t)t * 512 + h * 128 + 64 + F.lane] = (bf16)f2bf(o1 / sum);
        LDS_WAIT(); asm volatile("" ::: "memory");
    }
}
__device__ __forceinline__ void naive_band(LAS unsigned char* lds_, const bf16* ZC, const float* relb, bf16* OC) {
    const Frame F = make_frame(lds_); LAS float* sc = (LAS float*)(F.lds + F.wave * 16384);
    for (int item = F.gw; item < T * 8; item += F.NGW) {
        const int t = item >> 3, h = item & 7, b = t / SEQ, tl = t % SEQ, c = tl >> 6, k0 = (c - 8) * 64;
        const bf16* q = ZC + (size_t)t * 1536 + h * 64; const bf16* zb = ZC + (size_t)b * SEQ * 1536;
        float mx = -1e30f;
        for (int j = F.lane; j < 576; j += 64) { const int kp = k0 + j; float s = -1e30f;
            if (kp >= 0) { s = 0.f; const bf16* kr = zb + (size_t)kp * 1536 + 512 + h * 64; for (int d = 0; d < 64; ++d) s += bfl((unsigned)q[d]) * bfl((unsigned)kr[d]);
                int dist = tl - kp; dist = dist < -63 ? -63 : (dist > 256 ? 256 : dist); s += relb[(dist + 63) * 8 + h] * LOG2E; }
            sc[j] = s; mx = fmaxf(mx, s); }
        for (int o = 1; o < 64; o <<= 1) mx = fmaxf(mx, shfl_xor_f(mx, o, F.lane));
        float sum = 0.f;
        for (int j = F.lane; j < 576; j += 64) { const float p = (k0 + j >= 0) ? exp2f(sc[j] - mx) : 0.f; sc[j] = p; sum += p; }
        sum = wave_sum(sum, F.lane);
        LDS_WAIT(); asm volatile("" ::: "memory");
        float o0 = 0.f;
        for (int j = 0; j < 576; ++j) { const int kp = k0 + j; if (kp >= 0) o0 += sc[j] * bfl((unsigned)zb[(size_t)kp * 1536 + 1024 + h * 64 + F.lane]); }
        OC[(size_t)t * 512 + h * 64 + F.lane] = (bf16)f2bf(o0 / sum);
        LDS_WAIT(); asm volatile("" ::: "memory");
    }
}
#endif
__global__ void __launch_bounds__(NWAVES * 64, 2) mk_fwd(Args args) {
    extern __shared__ __attribute__((aligned(16))) unsigned char lds[];
    LAS unsigned char* const L = (LAS unsigned char*)lds;
    for (int u = threadIdx.x; u < (LDS_BYTES - LDSCTL_OFF) / 4; u += NWAVES * 64) ((LAS unsigned*)(L + LDSCTL_OFF))[u] = 0u;
    __syncthreads();
    XcdBarrier bar = xcd_barrier_post((unsigned*)(kws() + WS_CTL) + CW_BAR, (volatile LAS unsigned*)(L + MISC_OFF) + 8);
#define GRID_BAR() xcd_barrier(bar)
#if defined(DBG_BISECT)
#define IN(k) (l > 0 || ((k) >= kstart() && (k) <= kstop()) || ((k) == 9 && kstop() == 99))
#define LAYER_END() do { if (kstop() < 100) return; } while (0)
#else
#define IN(k) true
#define LAYER_END() do { } while (0)
#endif
#define PTRS() unsigned char* ws = opq(kws()); \
    bf16* U = (bf16*)(ws + WS_U); bf16* OA = (bf16*)(ws + WS_OA); bf16* OC = (bf16*)(ws + WS_OC); bf16* ORW = (bf16*)(ws + WS_ORW); \
    bf16* WinT = (bf16*)(ws + W_IN); bf16* WqT = (bf16*)(ws + W_Q); bf16* WloT = (bf16*)(ws + W_LORA); bf16* WbT = (bf16*)(ws + W_B); bf16* WoT = (bf16*)(ws + W_OUT); \
    bf16* W1T = (bf16*)(ws + W_1); bf16* W2T = (bf16*)(ws + W_2); bf16* WgT = (bf16*)(ws + W_G); bf16* WpT = (bf16*)(ws + W_P); \
    bf16* ZC = (bf16*)(ws + X_ZC); bf16* QN = (bf16*)(ws + X_QN); bf16* QP = (bf16*)(ws + X_QP); bf16* KV = (bf16*)(ws + X_KV); \
    bf16* ZR = (bf16*)(ws + X_ZR); bf16* LA = (bf16*)(ws + X_LA); bf16* LO = (bf16*)(ws + X_LO); \
    bf16* GT = (bf16*)(ws + X_GT); bf16* MG = (bf16*)(ws + X_MG); bf16* HID = (bf16*)(ws + X_HID); bf16* PB = (bf16*)(ws + X_PB); bf16* PP = (bf16*)(ws + X_PP); bf16* M2 = OA; \
    (void)U; (void)OA; (void)OC; (void)ORW; (void)WinT; (void)WqT; (void)WloT; (void)WbT; (void)WoT; (void)W1T; (void)W2T; (void)WgT; (void)WpT; (void)ZC; (void)QN; (void)QP; (void)KV; (void)ZR; (void)LA; (void)LO; (void)GT; (void)MG; (void)HID; (void)PB; (void)PP; (void)M2;
    typedef pg8::StaticOrder SO;
#define GEMM(EPI, Aptr, Bptr, N_, K_, Eobj) do { int bx_ = blockIdx.x; asm volatile("" : "+s"(bx_)); int G_ = gridDim.x; asm volatile("" : "+s"(G_)); pg8::Gemm g_{Aptr, Bptr, T, N_, K_}; SO S_; S_.init(T, N_, G_, bx_); pg8::gemm_phase<EPI, SO, true, true>(L + RING_OFF, g_, S_, Eobj); } while (0)

    rope_table(L);
    for (int l = 0; l < DEPTH; ++l) {
        if (IN(0)) {
        p0_prologue(L, args, l); GRID_BAR();
        }
        if (IN(1)) {
        { PTRS(); pg8::EpiRoute<0> E{OA, 512, 2, 1.f, ZC, 1536, 2, CA_QSCALE}; GEMM(pg8::EpiRoute<0>, U, WinT, 2048, 1024, E); } GRID_BAR();
        }
        if (IN(2)) {
        p2_mla_prep(L, args, l); GRID_BAR();
        }
        if (IN(3)) {
        { PTRS(); pg8::EpiQRope E{QP, (const float*)(ws + WS_ROPE), MLA_QSCALE}; GEMM(pg8::EpiQRope, QN, WqT, 768, 256, E); } GRID_BAR();
        }
        if (IN(4)) {
#if defined(DBG_NAIVE_ATTN)
        { PTRS(); naive_mla(L, QP, KV, OA); naive_band(L, ZC, kin(20) + (size_t)l * 320 * 8, OC); }
#else
        { PTRS(); int bx = blockIdx.x; asm volatile("" : "+s"(bx)); const int G = gridDim.x; for (int u = bx; u < 1280; u += G) {
            if (u < 256) { const int b = u >> 5, cc = u & 31; att::mla_unit(L + RING_OFF, QP, KV, OA, b, 63 - cc); att::mla_unit(L + RING_OFF, QP, KV, OA, b, cc); }
            else { const int bi = u - 256; att::band_unit(L + RING_OFF, ZC, kin(20) + (size_t)l * 320 * 8, OC, bi >> 7, (bi >> 4) & 7, bi & 15); }
        } }
#endif
        GRID_BAR();
        }
        if (IN(5)) {
        { PTRS(); pg8::EpiRoute<0> E{ZR, 1792, 7, 1.f, ZR, 1792, 0, 1.f}; GEMM(pg8::EpiRoute<0>, U, WinT + (size_t)2048 * 1024, 1792, 1024, E); } GRID_BAR();
        }
        if (IN(6)) {
        p6_rw_prep(L, args, l); GRID_BAR();
        }
        if (IN(7)) {
        { PTRS(); pg8::EpiRoute<0> E{LO, 1536, 6, 1.f, LO, 1536, 0, 1.f}; GEMM(pg8::EpiRoute<0>, LA, WloT, 1536, 256, E); } GRID_BAR();
        }
        if (IN(8)) {
        if (blockIdx.x < 64) rw::rw_unit(L + RING_OFF, l, (int)blockIdx.x);
        GRID_BAR();
        }
        if (IN(9)) {
#if defined(DBG_BISECT)
        if (kstop() == 99) { PTRS(); pg8::EpiRoute<0> E{GT, 3072, 12, 1.f, GT, 3072, 0, 1.f}; GEMM(pg8::EpiRoute<0>, U, WinT + (size_t)3840 * 1024, 3072, 1024, E); GRID_BAR(); return; }
#endif
        { PTRS(); pg8::EpiRoute<0> E{GT, 3072, 12, 1.f, GT, 3072, 0, 1.f}; GEMM(pg8::EpiRoute<0>, U, WinT + (size_t)3840 * 1024, 3072, 1024, E); } GRID_BAR();
        }
        if (IN(10)) {
        { PTRS(); pg8::EpiMerge<0> E0{MG, GT}; GEMM(pg8::EpiMerge<0>, OA, WbT, 1024, 512, E0);
          pg8::EpiMerge<1> E1{MG, GT}; GEMM(pg8::EpiMerge<1>, ORW, WbT + (size_t)1024 * 512, 1024, 512, E1);
          pg8::EpiMerge<2> E2{MG, GT}; GEMM(pg8::EpiMerge<2>, OC, WbT + (size_t)2 * 1024 * 512, 1024, 512, E2); } GRID_BAR();
        }
        if (IN(11)) {
        { PTRS(); pg8::EpiRoute<0> E{M2, 1024, 4, 1.f, M2, 1024, 0, 1.f}; GEMM(pg8::EpiRoute<0>, MG, WoT, 1024, 1024, E); } GRID_BAR();
        }
        if (IN(12)) {
        { PTRS(); rowpass<0>(L, args, M2, kin(23) + l * 1024, kin(24) + l * 1024, nullptr); } GRID_BAR();
        }
        if (IN(13)) {
        { PTRS(); pg8::EpiRoute<2> E{HID, 4096, 16, 1.f, HID, 4096, 0, 1.f}; GEMM(pg8::EpiRoute<2>, U, W1T, 4096, 1024, E); } GRID_BAR();
        }
        if (IN(14)) {
        { PTRS(); pg8::EpiRoute<0> E{M2, 1024, 4, 1.f, M2, 1024, 0, 1.f}; GEMM(pg8::EpiRoute<0>, HID, W2T, 1024, 4096, E); } GRID_BAR();
        }
        if (IN(15)) {
        { PTRS(); rowpass<1>(L, args, M2, kin(27) + l * 1024, nullptr, kin(1) + (size_t)l * T * DPLE); } GRID_BAR();
        }
        if (IN(16)) {
        { PTRS(); pg8::EpiRoute<0> E{PP, 1024, 4, 1.f, PP, 1024, 0, 1.f}; GEMM(pg8::EpiRoute<0>, PB, WpT, 1024, 256, E); } GRID_BAR();
        }
        if (IN(17)) {
        { PTRS(); pg8::EpiPle E{kout(), PP}; GEMM(pg8::EpiPle, U, WgT, 1024, 1024, E); }

        if (l + 1 < DEPTH) GRID_BAR();
        }
        LAYER_END();
    }
}

#if !defined(DBG_BISECT)
extern "C" void kernel_launch(void* const* d_in, const int* in_sizes, int n_in, void* d_out, int out_size, void* d_ws, size_t ws_size, hipStream_t stream) {
    static int grid = 0;
    if (grid == 0) {
        if (n_in != 30 || out_size != T * D || ws_size < WS_END) { fprintf(stderr, "kernel_launch: unexpected shapes (n_in %d out %d ws %zu, need ws >= %zu)\n", n_in, out_size, ws_size, (size_t)WS_END); grid = -1; return; }
        int dev = 0, cus = 0, per_cu = 0;
        if (hipGetDevice(&dev) != hipSuccess || hipDeviceGetAttribute(&cus, hipDeviceAttributeMultiprocessorCount, dev) != hipSuccess) { grid = -1; return; }
        if (hipFuncSetAttribute((const void*)mk_fwd, hipFuncAttributeMaxDynamicSharedMemorySize, LDS_BYTES) != hipSuccess) { fprintf(stderr, "kernel_launch: hipFuncSetAttribute failed\n"); grid = -1; return; }
        if (hipOccupancyMaxActiveBlocksPerMultiprocessor(&per_cu, (const void*)mk_fwd, NWAVES * 64, LDS_BYTES) != hipSuccess || per_cu < 1) { fprintf(stderr, "kernel_launch: occupancy query says %d\n", per_cu); }
        (void)hipGetLastError();
        grid = cus;
    }
    if (grid < 0) return;
    if (hipMemsetAsync((char*)d_ws + WS_CTL, 0, CTL_ZERO_BYTES, stream) != hipSuccess) return;
    Args a{};
    for (int i = 0; i < 30; ++i) a.in[i] = (const float*)d_in[i];
    a.out = (float*)d_out; a.ws = (unsigned char*)d_ws; a.start = 0; a.stop = 1000;
    hipLaunchKernelGGL(mk_fwd, dim3(grid), dim3(NWAVES * 64), LDS_BYTES, stream, a);
}
#endif
#if defined(DBG_BISECT)
namespace n0 {
constexpr int D_MODEL = 1024, BATCH = 8, SEQ = 4096, DEPTH = 2, CHUNK = 64, D_PLE = 256, D_FF = 4096;
constexpr int MLA_HEADS = 4, MLA_NOPE = 128, MLA_ROPE = 64, MLA_V = 128, MLA_Q_RANK = 256, MLA_KV_RANK = 128;
constexpr int RW_HEADS = 8, RW_HEAD = 64, RW_DIM = 512, RW_DECAY_LORA = 64, RW_AAA_LORA = 64, RW_GATE_LORA = 128;
constexpr int CA_HEADS = 8, CA_HEAD = 64, CA_DIM = 512, CA_LEFT = 8, CA_BAND = 576, REL_MIN = -63, REL_MAX = 256, REL_SIZE = 320;
constexpr int MLA_COLS = 448, RW_COLS = 1792, CA_COLS = 1536, GATE_COLS = 3072, IN_COLS = 6848;
constexpr int MIX_DIM = 1536;
constexpr float NORM_EPS = 1e-6f, RW_LN_EPS = 64e-5f;
constexpr int T_ALL = BATCH * SEQ;

__device__ const double ROPE_INV_FREQ[32] = {1, 0.74989420933245587, 0.56234132519034907, 0.42169650342858223, 0.31622776601683794, 0.23713737056616552, 0.17782794100389229, 0.1333521432163324, 0.10000000000000001, 0.074989420933245579, 0.056234132519034911, 0.042169650342858224, 0.031622776601683791, 0.023713737056616554, 0.017782794100389229, 0.013335214321633241, 0.01, 0.0074989420933245579, 0.005623413251903491, 0.0042169650342858229, 0.0031622776601683794, 0.0023713737056616554, 0.0017782794100389228, 0.0013335214321633241, 0.001, 0.00074989420933245586, 0.0005623413251903491, 0.00042169650342858224, 0.00031622776601683794, 0.00023713737056616554, 0.00017782794100389227, 0.0001333521432163324};

__device__ __forceinline__ void sincos_d(double a, float& s, float& c) {
    const double n = rint(a * 0.63661977236758134308);
    double r = fma(-n, 1.5707963267948966192, a);
    r = fma(-n, 6.123233995736766036e-17, r);
    const double r2 = r * r;
    double sp = -7.6471637318198164759e-13;
    sp = fma(sp, r2, 1.6059043836821614599e-10);
    sp = fma(sp, r2, -2.5052108385441718775e-08);
    sp = fma(sp, r2, 2.7557319223985890653e-06);
    sp = fma(sp, r2, -1.9841269841269841270e-04);
    sp = fma(sp, r2, 8.3333333333333333333e-03);
    sp = fma(sp, r2, -1.6666666666666666667e-01);
    const double sn = fma(sp * r2, r, r);
    double cp = 4.7794773323873852974e-14;
    cp = fma(cp, r2, -1.1470745597729724714e-11);
    cp = fma(cp, r2, 2.0876756987868098979e-09);
    cp = fma(cp, r2, -2.7557319223985890653e-07);
    cp = fma(cp, r2, 2.4801587301587301587e-05);
    cp = fma(cp, r2, -1.3888888888888888889e-03);
    cp = fma(cp, r2, 4.1666666666666666667e-02);
    cp = fma(cp, r2, -0.5);
    const double cs = fma(cp, r2, 1.0);
    const long long q = (long long)n & 3LL;
    double so, co;
    if (q == 0) { so = sn; co = cs; } else if (q == 1) { so = cs; co = -sn; } else if (q == 2) { so = -sn; co = -cs; } else { so = -cs; co = sn; }
    s = (float)so; c = (float)co;
}
__device__ __forceinline__ float sigmoidf_(float x) { return 1.0f / (1.0f + __expf(-x)); }

__global__ void k_copy(const float* __restrict__ a, float* __restrict__ o, size_t n4) {
    for (size_t i = blockIdx.x * (size_t)blockDim.x + threadIdx.x; i < n4; i += (size_t)gridDim.x * blockDim.x) ((float4*)o)[i] = ((const float4*)a)[i];
}
__global__ void k_copy2d(const float* __restrict__ a, int lda, float* __restrict__ o, int ldo, int cols, int rows) {
    for (int i = blockIdx.x * blockDim.x + threadIdx.x; i < rows * cols; i += gridDim.x * blockDim.x) { const int r = i / cols, c = i % cols; o[(size_t)r * ldo + c] = a[(size_t)r * lda + c]; }
}
__global__ void k_rmsnorm(const float* in, int ldi, const float* __restrict__ g, float* out, int ldo, int D, int rows, const float* res) {
    const int wave = (blockIdx.x * blockDim.x + threadIdx.x) >> 6, lane = threadIdx.x & 63, nw = (gridDim.x * blockDim.x) >> 6;
    for (int r = wave; r < rows; r += nw) {
        const float* x = in + (size_t)r * ldi; float s = 0.f;
        for (int c = lane; c < D; c += 64) { const float v = x[c]; s += v * v; }
        for (int o = 32; o; o >>= 1) s += __shfl_xor(s, o);
        const float rs = rsqrtf(s / (float)D + NORM_EPS);
        float* y = out + (size_t)r * ldo;
        for (int c = lane; c < D; c += 64) { float v = x[c] * rs * g[c]; if (res) v += res[(size_t)r * ldo + c]; y[c] = v; }
    }
}
template <int ACT>
__global__ void __launch_bounds__(256) k_gemm(const float* __restrict__ A, int lda, const float* __restrict__ B, int ldb, float* __restrict__ C, int ldc, int M, int N, int K) {
    __shared__ float As[16][132]; __shared__ float Bs[16][68];
    const int tid = threadIdx.x, tx = tid & 15, ty = tid >> 4;
    const int m0 = blockIdx.y * 128, n0 = blockIdx.x * 64;
    float acc[8][4];
#pragma unroll
    for (int i = 0; i < 8; ++i)
#pragma unroll
        for (int j = 0; j < 4; ++j) acc[i][j] = 0.f;
    for (int k0 = 0; k0 < K; k0 += 16) {
#pragma unroll
        for (int i = 0; i < 8; ++i) { const int e = tid + i * 256, r = e >> 4, c = e & 15; As[c][r] = A[(size_t)(m0 + r) * lda + k0 + c]; }
#pragma unroll
        for (int i = 0; i < 4; ++i) { const int e = tid + i * 256, r = e >> 6, c = e & 63; Bs[r][c] = B[(size_t)(k0 + r) * ldb + n0 + c]; }
        __syncthreads();
#pragma unroll
        for (int k = 0; k < 16; ++k) {
            float a[8], b[4];
#pragma unroll
            for (int i = 0; i < 8; ++i) a[i] = As[k][ty * 8 + i];
#pragma unroll
            for (int j = 0; j < 4; ++j) b[j] = Bs[k][tx * 4 + j];
#pragma unroll
            for (int i = 0; i < 8; ++i)
#pragma unroll
                for (int j = 0; j < 4; ++j) acc[i][j] = fmaf(a[i], b[j], acc[i][j]);
        }
        __syncthreads();
    }
#pragma unroll
    for (int i = 0; i < 8; ++i)
#pragma unroll
        for (int j = 0; j < 4; ++j) {
            float v = acc[i][j];
            if (ACT == 1) { v = v > 0.f ? v * v : 0.f; }
            if (ACT == 2) { v = sigmoidf_(v); }
            C[(size_t)(m0 + ty * 8 + i) * ldc + n0 + tx * 4 + j] = v;
        }
}
__global__ void k_rope(float* __restrict__ buf, int ld, int col0, int hstride, int nheads, const int* __restrict__ pos, int rows) {
    const int n = rows * nheads * 32;
    for (int i = blockIdx.x * blockDim.x + threadIdx.x; i < n; i += gridDim.x * blockDim.x) {
        const int j = i & 31, h = (i >> 5) % nheads, r = i / (32 * nheads);
        float s, c; sincos_d((double)pos[r] * ROPE_INV_FREQ[j], s, c);
        float* p = buf + (size_t)r * ld + col0 + h * hstride;
        const float x1 = p[j], x2 = p[j + 32];
        p[j] = x1 * c - x2 * s; p[j + 32] = x2 * c + x1 * s;
    }
}
__global__ void __launch_bounds__(128) k_mla_attn(const float* __restrict__ Q, const float* __restrict__ KV, const float* __restrict__ KR, float* __restrict__ O) {
    __shared__ float sc[2][SEQ]; __shared__ float qs[2][192];
    const int w = threadIdx.x >> 6, lane = threadIdx.x & 63;
    const int item = blockIdx.x * 2 + w; const int t = item >> 2, h = item & 3;
    const int nk = ((t >> 6) + 1) << 6;
    for (int d = lane; d < 192; d += 64) qs[w][d] = Q[(size_t)t * 768 + h * 192 + d];
    __syncthreads();
    const float scale = 0.07216878364870322f;
    float mx = -INFINITY;
    for (int k = lane; k < nk; k += 64) {
        const float4* kn = (const float4*)(KV + (size_t)k * 1024 + h * 256); const float4* kr = (const float4*)(KR + (size_t)k * 64);
        float s = 0.f;
#pragma unroll 8
        for (int d = 0; d < 32; ++d) { const float4 v = kn[d]; s += v.x * qs[w][4 * d] + v.y * qs[w][4 * d + 1] + v.z * qs[w][4 * d + 2] + v.w * qs[w][4 * d + 3]; }
#pragma unroll 8
        for (int d = 0; d < 16; ++d) { const float4 v = kr[d]; s += v.x * qs[w][128 + 4 * d] + v.y * qs[w][129 + 4 * d] + v.z * qs[w][130 + 4 * d] + v.w * qs[w][131 + 4 * d]; }
        s *= scale; sc[w][k] = s; mx = fmaxf(mx, s);
    }
    for (int o = 32; o; o >>= 1) mx = fmaxf(mx, __shfl_xor(mx, o));
    float sum = 0.f;
    for (int k = lane; k < nk; k += 64) { const float p = __expf(sc[w][k] - mx); sc[w][k] = p; sum += p; }
    for (int o = 32; o; o >>= 1) sum += __shfl_xor(sum, o);
    __syncthreads();
    float o0 = 0.f, o1 = 0.f;
    for (int k = 0; k < nk; ++k) { const float p = sc[w][k]; const float* v = KV + (size_t)k * 1024 + h * 256 + 128; o0 = fmaf(p, v[lane], o0); o1 = fmaf(p, v[lane + 64], o1); }
    const float inv = 1.f / sum;
    O[(size_t)t * 512 + h * 128 + lane] = o0 * inv; O[(size_t)t * 512 + h * 128 + 64 + lane] = o1 * inv;
}
__global__ void __launch_bounds__(256) k_band_attn(const float* __restrict__ Z, int ld, const float* __restrict__ bias, float* __restrict__ O) {
    __shared__ float sc[4][CA_BAND]; __shared__ float qs[4][64];
    const int w = threadIdx.x >> 6, lane = threadIdx.x & 63;
    const int item = blockIdx.x * 4 + w; const int t = item >> 3, h = item & 7;
    const int c = t >> 6; const int k0 = (c - CA_LEFT) * 64;
    qs[w][lane] = Z[(size_t)t * ld + h * 64 + lane];
    __syncthreads();
    float mx = -INFINITY;
    for (int j = lane; j < CA_BAND; j += 64) {
        const int kp = k0 + j; float s = -INFINITY;
        if (kp >= 0) {
            const float4* kv = (const float4*)(Z + (size_t)kp * ld + 512 + h * 64); s = 0.f;
#pragma unroll
            for (int d = 0; d < 16; ++d) { const float4 v = kv[d]; s += v.x * qs[w][4 * d] + v.y * qs[w][4 * d + 1] + v.z * qs[w][4 * d + 2] + v.w * qs[w][4 * d + 3]; }
            int dist = t - kp; dist = dist < REL_MIN ? REL_MIN : (dist > REL_MAX ? REL_MAX : dist);
            s = s * 0.125f + bias[(dist - REL_MIN) * 8 + h];
        }
        sc[w][j] = s; mx = fmaxf(mx, s);
    }
    for (int o = 32; o; o >>= 1) mx = fmaxf(mx, __shfl_xor(mx, o));
    float sum = 0.f;
    for (int j = lane; j < CA_BAND; j += 64) { const float p = __expf(sc[w][j] - mx); sc[w][j] = p; sum += p; }
    for (int o = 32; o; o >>= 1) sum += __shfl_xor(sum, o);
    __syncthreads();
    float o0 = 0.f;
    for (int j = 0; j < CA_BAND; ++j) { const int kp = k0 + j; if (kp < 0) continue; o0 = fmaf(sc[w][j], Z[(size_t)kp * ld + 1024 + h * 64 + lane], o0); }
    O[(size_t)t * 512 + h * 64 + lane] = o0 / sum;
}
__global__ void k_tokenshift(const float* __restrict__ Z, int ld, const float* __restrict__ mu, float* __restrict__ ZS) {
    const int n = SEQ * RW_COLS;
    for (int i = blockIdx.x * blockDim.x + threadIdx.x; i < n; i += gridDim.x * blockDim.x) {
        const int t = i / RW_COLS, c = i % RW_COLS;
        const float z = Z[(size_t)t * ld + c], pv = t > 0 ? Z[(size_t)(t - 1) * ld + c] : 0.f;
        float v = z + (pv - z) * mu[c];
        if (c >= 1536 && c < 1600) v = tanhf(v);
        if (c >= 1664) v = sigmoidf_(v);
        ZS[i] = v;
    }
}
__global__ void k_rw_prep(const float* __restrict__ ZS, const float* __restrict__ TW, const float* __restrict__ TA, const float* __restrict__ w0, const float* __restrict__ a0,
                          const float* __restrict__ k_k, const float* __restrict__ k_a, float* __restrict__ DEC, float* __restrict__ AA, float* __restrict__ KK, float* __restrict__ KM) {
    const int wave = (blockIdx.x * blockDim.x + threadIdx.x) >> 6, lane = threadIdx.x & 63, nw = (gridDim.x * blockDim.x) >> 6;
    for (int it = wave; it < SEQ * RW_HEADS; it += nw) {
        const int t = it >> 3, h = it & 7, c = h * 64 + lane; const size_t o = (size_t)t * 512 + c;
        const float x = -(w0[c] + TW[o]);
        const float sp = (x > 0.f ? x : 0.f) + log1pf(__expf(-fabsf(x)));
        const float wlog = -sp - 0.5f;
        DEC[o] = __expf(-__expf(wlog));
        const float a = sigmoidf_(a0[c] + TA[o]); AA[o] = a;
        const float k = ZS[(size_t)t * RW_COLS + 512 + c];
        const float kk = k * k_k[c]; float s = kk * kk;
        for (int q = 32; q; q >>= 1) s += __shfl_xor(s, q);
        KK[o] = kk * rsqrtf(fmaxf(s, 1e-24f));
        KM[o] = k * (1.f + (a - 1.f) * k_a[c]);
    }
}
__global__ void __launch_bounds__(64) k_rw_scan(const float* __restrict__ ZS, const float* __restrict__ DEC, const float* __restrict__ AA, const float* __restrict__ KK, const float* __restrict__ KM, float* __restrict__ Y) {
    __shared__ float sh[5][64];
    const int h = blockIdx.x, lane = threadIdx.x;
    float S[64];
#pragma unroll
    for (int k = 0; k < 64; ++k) S[k] = 0.f;
    for (int t = 0; t < SEQ; ++t) {
        const size_t o = (size_t)t * 512 + h * 64 + lane;
        sh[0][lane] = ZS[(size_t)t * RW_COLS + h * 64 + lane];
        sh[1][lane] = DEC[o]; sh[2][lane] = KM[o]; const float kkv = KK[o]; sh[3][lane] = kkv; sh[4][lane] = kkv * AA[o];
        const float vv = ZS[(size_t)t * RW_COLS + 1024 + h * 64 + lane];
        __syncthreads();
        float sa = 0.f;
#pragma unroll
        for (int k = 0; k < 64; ++k) sa = fmaf(S[k], -sh[3][k], sa);
        float y = 0.f;
#pragma unroll
        for (int k = 0; k < 64; ++k) { S[k] = fmaf(S[k], sh[1][k], fmaf(sa, sh[4][k], vv * sh[2][k])); y = fmaf(S[k], sh[0][k], y); }
        Y[o] = y;
        __syncthreads();
    }
}
__global__ void k_rw_out(const float* __restrict__ ZS, const float* __restrict__ KM, const float* __restrict__ Y, const float* __restrict__ G, const float* __restrict__ r_k, const float* __restrict__ ln_w, const float* __restrict__ ln_b, float* __restrict__ O) {
    const int wave = (blockIdx.x * blockDim.x + threadIdx.x) >> 6, lane = threadIdx.x & 63, nw = (gridDim.x * blockDim.x) >> 6;
    for (int it = wave; it < SEQ * RW_HEADS; it += nw) {
        const int t = it >> 3, h = it & 7, c = h * 64 + lane; const size_t o = (size_t)t * 512 + c;
        const float y = Y[o]; float s = y;
        for (int q = 32; q; q >>= 1) s += __shfl_xor(s, q);
        const float mean = s * (1.f / 64.f); const float d = y - mean; float v = d * d;
        for (int q = 32; q; q >>= 1) v += __shfl_xor(v, q);
        const float yn = d * rsqrtf(v * (1.f / 64.f) + RW_LN_EPS) * ln_w[c] + ln_b[c];
        const float r = ZS[(size_t)t * RW_COLS + c], vv = ZS[(size_t)t * RW_COLS + 1024 + c];
        float b = r * KM[o] * r_k[c];
        for (int q = 32; q; q >>= 1) b += __shfl_xor(b, q);
        O[o] = (yn + b * vv) * G[o];
    }
}
__global__ void k_merge(const float* __restrict__ Z, int ld, const float* __restrict__ Y3, float* __restrict__ M) {
    const int n = SEQ * D_MODEL;
    for (int i = blockIdx.x * blockDim.x + threadIdx.x; i < n; i += gridDim.x * blockDim.x) {
        const int t = i >> 10, d = i & 1023; float s = 0.f;
#pragma unroll
        for (int b = 0; b < 3; ++b) s += sigmoidf_(Z[(size_t)t * ld + 3776 + b * 1024 + d]) * Y3[(size_t)b * SEQ * D_MODEL + i];
        M[i] = s;
    }
}
__global__ void k_ple(float* __restrict__ h, const float* __restrict__ gate, const float* __restrict__ proj) {
    const int n = SEQ * D_MODEL;
    for (int i = blockIdx.x * blockDim.x + threadIdx.x; i < n; i += gridDim.x * blockDim.x) h[i] += gate[i] * proj[i];
}


}
#endif
#if defined(DBG_BISECT)
__device__ const int FP_ROWS[16] = {0, 1, 31, 32, 63, 64, 100, 255, 256, 257, 1023, 1024, 2048, 3000, 4094, 4095};
__global__ void fp_copy(const float* src, int ld, int col0, int ncols, float* dst, int dld, int dcol0) {
    const int ri = blockIdx.x; for (int c = threadIdx.x; c < ncols; c += blockDim.x) dst[(size_t)ri * dld + dcol0 + c] = src[(size_t)FP_ROWS[ri] * ld + col0 + c];
}
__global__ void fp_cmp(unsigned id, const void* mk, int is_bf16, int ld, int col0, int ncols, const float* ref, int mode, unsigned* code) {
    const int ri = blockIdx.x, row = FP_ROWS[ri]; __shared__ float s_num[256], s_den[256];
    float num = 0.f, den = 0.f;
    for (int c = threadIdx.x; c < ncols; c += 256) {
        float r = ref[(size_t)ri * ncols + c];
        if (mode == 1 && c < 512) r *= CA_QSCALE;
        if (mode == 3) r = 1.f / (1.f + expf(-r));
        if (mode == 2) { const int j = c >> 1, s = c & 1; r = ref[(size_t)ri * ncols + (s ? j + 32 : j)]; }
        const size_t idx = (size_t)row * ld + col0 + c;
        const float m = is_bf16 ? __uint_as_float((unsigned)((const unsigned short*)mk)[idx] << 16) : ((const float*)mk)[idx];
        num += (m - r) * (m - r); den += r * r;
    }
    s_num[threadIdx.x] = num; s_den[threadIdx.x] = den; __syncthreads();
    for (int o = 128; o; o >>= 1) { if ((int)threadIdx.x < o) { s_num[threadIdx.x] += s_num[threadIdx.x + o]; s_den[threadIdx.x] += s_den[threadIdx.x + o]; } __syncthreads(); }
    if (threadIdx.x == 0 && !(s_num[0] <= 1e-3f * s_den[0] + 1e-12f)) atomicMin(code, id);
}
__global__ void w_cmp(unsigned id, const unsigned short* WT, int ldt, int row0, const float* W, int ldw, int col0, int ncols, int K, unsigned* code) {
    for (size_t i = blockIdx.x * (size_t)blockDim.x + threadIdx.x; i < (size_t)ncols * K; i += (size_t)gridDim.x * blockDim.x) {
        const int n = (int)(i / K), kk = (int)(i % K); const unsigned short got = WT[(size_t)(row0 + n) * ldt + kk];
        const float w = W[(size_t)kk * ldw + col0 + n]; unsigned u = __float_as_uint(w); const unsigned short want = (unsigned short)((u + 0x7fffu + ((u >> 16) & 1u)) >> 16);
        if (got != want) atomicMin(code, id);
    }
}
__global__ void fp_emit(float* out, const unsigned* code) { if (threadIdx.x == 0 && blockIdx.x == 0) { const unsigned c = *code; if (c < 999u) out[0] = 100.f * (float)c; } }
__global__ void fp_init(unsigned* code) { if (threadIdx.x == 0 && blockIdx.x == 0) *code = 999u; }
template <int ACT> static void n0gemm(hipStream_t st, const float* A, int lda, const float* B, int ldb, float* C, int ldc, int M, int N, int K) {
    hipLaunchKernelGGL(n0::k_gemm<ACT>, dim3(N / 64, M / 128), dim3(256), 0, st, A, lda, B, ldb, C, ldc, M, N, K);
}
extern "C" void kernel_launch(void* const* d_in, const int* in_sizes, int n_in, void* d_out, int out_size, void* d_ws, size_t ws_size, hipStream_t stream) {
    static int grid = 0;
    if (grid == 0) {
        if (ws_size < 470 * MiB) { fprintf(stderr, "ws too small for the bisect build\n"); grid = -1; return; }
        if (hipFuncSetAttribute((const void*)mk_fwd, hipFuncAttributeMaxDynamicSharedMemorySize, LDS_BYTES) != hipSuccess) { grid = -1; return; }
        grid = 256;
    }
    if (grid < 0) return;
    using namespace n0;
    const float* x = (const float*)d_in[0]; const float* p = (const float*)d_in[1]; const int* positions = (const int*)d_in[2];
    const float* pre_mix_g = (const float*)d_in[3]; const float* w_in = (const float*)d_in[4]; const float* q_norm_g = (const float*)d_in[5]; const float* kv_norm_g = (const float*)d_in[6];
    const float* w_uq = (const float*)d_in[7]; const float* w_ukv = (const float*)d_in[8]; const float* rw_mu = (const float*)d_in[9]; const float* rw_w0 = (const float*)d_in[10];
    const float* rw_w_up = (const float*)d_in[11]; const float* rw_a0 = (const float*)d_in[12]; const float* rw_a_up = (const float*)d_in[13]; const float* rw_g_up = (const float*)d_in[14];
    const float* rw_k_k = (const float*)d_in[15]; const float* rw_k_a = (const float*)d_in[16]; const float* rw_r_k = (const float*)d_in[17]; const float* rw_ln_w = (const float*)d_in[18];
    const float* rw_ln_b = (const float*)d_in[19]; const float* ca_rel_bias = (const float*)d_in[20]; const float* w_branch = (const float*)d_in[21]; const float* w_out = (const float*)d_in[22];
    const float* post_mix_g = (const float*)d_in[23]; const float* pre_ff_g = (const float*)d_in[24]; const float* w_ff1 = (const float*)d_in[25]; const float* w_ff2 = (const float*)d_in[26];
    const float* post_ff_g = (const float*)d_in[27]; const float* w_ple_gate = (const float*)d_in[28]; const float* w_ple_proj = (const float*)d_in[29];
    float* hb = (float*)d_out;
    float* ws = (float*)d_ws; size_t off = 0;
    auto take = [&](size_t n) { float* r = ws + off; off += n; return r; };
    const size_t S = n0::SEQ;
    float* Z = take(S * 6848); float* U = take(S * 1024); float* QN = take(S * 256); float* KVN = take(S * 128);
    float* Q = take(S * 768); float* KV = take(S * 1024); float* KR = take(S * 64); float* OBR = take(S * 1536);
    float* ZS = take(S * 1792); float* TW = take(S * 512); float* TA = take(S * 512); float* G = take(S * 512);
    float* DEC = take(S * 512); float* AA = take(S * 512); float* KK = take(S * 512); float* KM = take(S * 512); float* Y = take(S * 512);
    float* Y3 = take(S * 3072); float* MER = take(S * 1024); float* M2 = take(S * 1024);
    float* F1 = Z; float* HID = Z + S * 1024; float* F3 = Z + S * 5120; float* GATE = Y3; float* PROJ = Y3 + S * 1024;
    unsigned* code = (unsigned*)((char*)d_ws + 466 * MiB); float* FP = (float*)((char*)d_ws + 466 * MiB + 256);
    size_t fo = 0; auto slot = [&](size_t ncols) { float* r = FP + fo; fo += 16 * ncols; return r; };
    float* f_U = slot(1024); float* f_ZM = slot(448); float* f_ZC = slot(1536); float* f_QN = slot(256); float* f_KVN = slot(128); float* f_KR = slot(64); float* f_OCA = slot(512);
    float* f_ZR = slot(1792); float* f_LO = slot(1536); float* f_ORW = slot(512); float* f_GT = slot(3072); float* f_MER = slot(1024); float* f_M2 = slot(1024); float* f_HM = slot(1024);
    float* f_F1 = slot(1024); float* f_HID = slot(4096); float* f_F3 = slot(1024); float* f_HF = slot(1024); float* f_PROJ = slot(1024); float* f_HP = slot(1024);
#define FPC(src, ld, c0, nc, dst) hipLaunchKernelGGL(fp_copy, dim3(16), dim3(256), 0, stream, (const float*)(src), (int)(ld), (int)(c0), (int)(nc), dst, (int)(nc), 0)
#define FPC2(src, ld, c0, nc, dst, dld, dc0) hipLaunchKernelGGL(fp_copy, dim3(16), dim3(256), 0, stream, (const float*)(src), (int)(ld), (int)(c0), (int)(nc), dst, (int)(dld), (int)(dc0))
    hipLaunchKernelGGL(fp_init, dim3(1), dim3(64), 0, stream, code);
    hipLaunchKernelGGL(k_copy, dim3(2048), dim3(256), 0, stream, x, hb, (size_t)S * 1024 / 4);
    {   const int l = 0; const int* pos = positions;
        hipLaunchKernelGGL(k_rmsnorm, dim3(512), dim3(256), 0, stream, hb, 1024, pre_mix_g, U, 1024, 1024, (int)S, (const float*)nullptr); FPC(U, 1024, 0, 1024, f_U);
        n0gemm<0>(stream, U, 1024, w_in, 6848, Z, 6848, S, 6848, 1024);
        FPC(Z, 6848, 0, 448, f_ZM); FPC(Z, 6848, 2240, 1536, f_ZC); FPC(Z, 6848, 448, 1792, f_ZR); FPC(Z, 6848, 3776, 3072, f_GT);
        hipLaunchKernelGGL(k_rmsnorm, dim3(512), dim3(256), 0, stream, Z, 6848, q_norm_g, QN, 256, 256, (int)S, (const float*)nullptr); FPC(QN, 256, 0, 256, f_QN);
        hipLaunchKernelGGL(k_rmsnorm, dim3(512), dim3(256), 0, stream, Z + 256, 6848, kv_norm_g, KVN, 128, 128, (int)S, (const float*)nullptr); FPC(KVN, 128, 0, 128, f_KVN);
        n0gemm<0>(stream, QN, 256, w_uq, 768, Q, 768, S, 768, 256);
        n0gemm<0>(stream, KVN, 128, w_ukv, 1024, KV, 1024, S, 1024, 128);
        hipLaunchKernelGGL(k_rope, dim3(512), dim3(256), 0, stream, Q, 768, 128, 192, 4, pos, (int)S);
        hipLaunchKernelGGL(k_copy2d, dim3(256), dim3(256), 0, stream, Z + 384, 6848, KR, 64, 64, (int)S);
        hipLaunchKernelGGL(k_rope, dim3(512), dim3(256), 0, stream, KR, 64, 0, 0, 1, pos, (int)S); FPC(KR, 64, 0, 64, f_KR);
        hipLaunchKernelGGL(k_mla_attn, dim3(S * 2), dim3(128), 0, stream, Q, KV, KR, OBR);
        hipLaunchKernelGGL(k_tokenshift, dim3(2048), dim3(256), 0, stream, Z + 448, 6848, rw_mu, ZS);
        n0gemm<0>(stream, ZS + 1536, 1792, rw_w_up, 512, TW, 512, S, 512, 64);
        n0gemm<0>(stream, ZS + 1600, 1792, rw_a_up, 512, TA, 512, S, 512, 64);
        n0gemm<0>(stream, ZS + 1664, 1792, rw_g_up, 512, G, 512, S, 512, 128);
        FPC2(TW, 512, 0, 512, f_LO, 1536, 0); FPC2(TA, 512, 0, 512, f_LO, 1536, 512); FPC2(G, 512, 0, 512, f_LO, 1536, 1024);
        hipLaunchKernelGGL(k_rw_prep, dim3(1024), dim3(256), 0, stream, ZS, TW, TA, rw_w0, rw_a0, rw_k_k, rw_k_a, DEC, AA, KK, KM);
        hipLaunchKernelGGL(k_rw_scan, dim3(8), dim3(64), 0, stream, ZS, DEC, AA, KK, KM, Y);
        hipLaunchKernelGGL(k_rw_out, dim3(1024), dim3(256), 0, stream, ZS, KM, Y, G, rw_r_k, rw_ln_w, rw_ln_b, OBR + S * 512); FPC(OBR + S * 512, 512, 0, 512, f_ORW);
        hipLaunchKernelGGL(k_band_attn, dim3(S * 2), dim3(256), 0, stream, Z + 2240, 6848, ca_rel_bias, OBR + 2 * S * 512); FPC(OBR + 2 * S * 512, 512, 0, 512, f_OCA);
        for (int n = 0; n < 3; ++n) n0gemm<0>(stream, OBR + n * S * 512, 512, w_branch + (size_t)n * 512 * 1024, 1024, Y3 + n * S * 1024, 1024, S, 1024, 512);
        hipLaunchKernelGGL(k_merge, dim3(2048), dim3(256), 0, stream, Z, 6848, Y3, MER); FPC(MER, 1024, 0, 1024, f_MER);
        n0gemm<0>(stream, MER, 1024, w_out, 1024, M2, 1024, S, 1024, 1024); FPC(M2, 1024, 0, 1024, f_M2);
        hipLaunchKernelGGL(k_rmsnorm, dim3(512), dim3(256), 0, stream, M2, 1024, post_mix_g, hb, 1024, 1024, (int)S, (const float*)hb); FPC(hb, 1024, 0, 1024, f_HM);
        hipLaunchKernelGGL(k_rmsnorm, dim3(512), dim3(256), 0, stream, hb, 1024, pre_ff_g, F1, 1024, 1024, (int)S, (const float*)nullptr); FPC(F1, 1024, 0, 1024, f_F1);
        n0gemm<1>(stream, F1, 1024, w_ff1, 4096, HID, 4096, S, 4096, 1024); FPC(HID, 4096, 0, 4096, f_HID);
        n0gemm<0>(stream, HID, 4096, w_ff2, 1024, F3, 1024, S, 1024, 4096); FPC(F3, 1024, 0, 1024, f_F3);
        hipLaunchKernelGGL(k_rmsnorm, dim3(512), dim3(256), 0, stream, F3, 1024, post_ff_g, hb, 1024, 1024, (int)S, (const float*)hb); FPC(hb, 1024, 0, 1024, f_HF);
        n0gemm<2>(stream, hb, 1024, w_ple_gate, 1024, GATE, 1024, S, 1024, 1024);
        n0gemm<0>(stream, p, 256, w_ple_proj, 1024, PROJ, 1024, S, 1024, 256); FPC(PROJ, 1024, 0, 1024, f_PROJ);
        hipLaunchKernelGGL(k_ple, dim3(2048), dim3(256), 0, stream, hb, GATE, PROJ); FPC(hb, 1024, 0, 1024, f_HP);
        (void)l;
    }
    Args a{};
    for (int i = 0; i < 30; ++i) a.in[i] = (const float*)d_in[i];
    a.out = (float*)d_out; a.ws = (unsigned char*)d_ws;
    unsigned char* w8 = (unsigned char*)d_ws;
#define RUNR(s0, s1) do { (void)hipMemsetAsync((char*)d_ws + WS_CTL, 0, CTL_ZERO_BYTES, stream); a.start = (s0); a.stop = (s1); hipLaunchKernelGGL(mk_fwd, dim3(grid), dim3(NWAVES * 64), LDS_BYTES, stream, a); } while (0)
#define RUN(stopph) do { if ((stopph) < 8) RUNR(0, (stopph)); else { RUNR(0, (stopph)); } } while (0)
#define CMP(id, ptr, isbf, ld, c0, nc, ref, mode) hipLaunchKernelGGL(fp_cmp, dim3(16), dim3(256), 0, stream, (unsigned)(id), (const void*)(ptr), (int)(isbf), (int)(ld), (int)(c0), (int)(nc), (const float*)(ref), (int)(mode), code)
    RUN(0);  CMP(1, w8 + WS_U, 1, 1024, 0, 1024, f_U, 0);
    RUN(1);  CMP(2, w8 + WS_OA, 1, 512, 0, 448, f_ZM, 0); CMP(3, w8 + X_ZC, 1, 1536, 0, 1536, f_ZC, 1);
    RUN(2);  CMP(4, w8 + X_QN, 1, 256, 0, 256, f_QN, 0); CMP(5, w8 + X_KV, 1, 192, 0, 128, f_KVN, 0); CMP(6, w8 + X_KV, 1, 192, 128, 64, f_KR, 2);
    RUN(4);  CMP(7, w8 + WS_OC, 1, 512, 0, 512, f_OCA, 0);
    RUN(5);  CMP(9, w8 + X_ZR, 1, 1792, 0, 1792, f_ZR, 0);
    RUN(7);  CMP(10, w8 + X_LO, 1, 1536, 0, 1536, f_LO, 0);
    RUN(8);  CMP(11, w8 + WS_ORW, 1, 512, 0, 512, f_ORW, 0);
    hipLaunchKernelGGL(w_cmp, dim3(1024), dim3(256), 0, stream, 30u, (const unsigned short*)(w8 + W_IN), 1024, 3840, w_in, 6848, 3776, 3072, 1024, code);
    hipLaunchKernelGGL(w_cmp, dim3(1024), dim3(256), 0, stream, 29u, (const unsigned short*)(w8 + W_IN), 1024, 2048, w_in, 6848, 448, 1792, 1024, code);
    RUNR(9, 99); CMP(31, w8 + X_GT, 1, 3072, 0, 3072, f_GT, 0);
    RUN(9);  CMP(52, w8 + X_GT, 1, 3072, 0, 3072, f_GT, 0);
    RUN(10); CMP(53, w8 + X_MG, 1, 1024, 0, 1024, f_MER, 0);
    RUN(11); CMP(54, w8 + WS_OA, 1, 1024, 0, 1024, f_M2, 0);
    RUN(12); CMP(55, d_out, 0, 1024, 0, 1024, f_HM, 0); CMP(56, w8 + WS_U, 1, 1024, 0, 1024, f_F1, 0);
    RUN(13); CMP(57, w8 + X_HID, 1, 4096, 0, 4096, f_HID, 0);
    RUN(14); CMP(58, w8 + WS_OA, 1, 1024, 0, 1024, f_F3, 0);
    RUN(15); CMP(59, d_out, 0, 1024, 0, 1024, f_HF, 0);
    RUN(16); CMP(60, w8 + X_PP, 1, 1024, 0, 1024, f_PROJ, 0);
    RUN(17); CMP(61, d_out, 0, 1024, 0, 1024, f_HP, 0);
    RUN(17);
    hipLaunchKernelGGL(fp_emit, dim3(1), dim3(64), 0, stream, (float*)d_out, (const unsigned*)code);
}
#endif
```

```cpp
#include <hip/hip_runtime.h>
#include <cstdio>
#include <cstdint>
#include <cmath>
namespace pg8 {
#define PG8_LAS __attribute__((address_space(3)))
typedef unsigned short bf16_t;
typedef short bf16x8 __attribute__((ext_vector_type(8)));
typedef float f32x4 __attribute__((ext_vector_type(4)));
typedef unsigned u32x4 __attribute__((ext_vector_type(4)));
constexpr int BM = 256, BK = 64, HALF = 128, HTB = HALF * BK * 2  , STAGE_BYTES = 8 * HTB, NXCD = 8, WGM = 8;

__host__ __device__ __forceinline__ int lds_byte(int r, int c) { const int st = (r >> 4) * 2 + (c >> 5), rr = r & 15, cc = c & 31, ob = rr * 64 + cc * 2; return st * 1024 + (ob ^ (((ob >> 9) & 1) << 5)); }
__host__ __device__ __forceinline__ void stage_rc(int b, int& R, int& C) { const int st = b / 1024, sb = b % 1024, swz = sb ^ (((sb >> 9) & 1) << 5); R = (st >> 1) * 16 + swz / 64; C = (st & 1) * 32 + (swz % 64) / 2; }
__host__ __device__ __forceinline__ int perm32(int rho) { const int n = rho >> 4, i = rho & 15; return 8 * (i >> 2) + 4 * n + (i & 3); }

struct Unit { int pm, pn; };
struct Gemm { const bf16_t* A; const bf16_t* Bt; int M, N, K; };

struct StaticOrder {
    int nM, nN, nwg, G, c;
    __host__ __device__ void init(int M, int N, int G_, int c_) { nM = M / BM; nN = N / BM; nwg = nM * nN; G = G_; c = c_; }
    __host__ __device__ bool next(int i, Unit& u) const {
        const long L = (long)i * G + c; if (L >= nwg) return false;
        int wgid = (int)L; { const int q = nwg / NXCD, r = nwg % NXCD, xcd = wgid % NXCD, off = wgid / NXCD; wgid = (xcd < r ? xcd * (q + 1) : r * (q + 1) + (xcd - r) * q) + off; }
        const int nig = WGM * nN, gid = wgid / nig, fm = gid * WGM, gsz = (nM - fm) < WGM ? (nM - fm) : WGM;
        u.pm = fm + ((wgid % nig) % gsz); u.pn = (wgid % nig) / gsz; return true;
    }
    __device__ __forceinline__ void a_ready(const Unit&) const {}
    __device__ __forceinline__ void done(const Unit&) const {}
};

__device__ __forceinline__ unsigned cvt_pk_bf16(float lo, float hi) { unsigned r; asm volatile("v_cvt_pk_bf16_f32 %0, %1, %2" : "=v"(r) : "v"(lo), "v"(hi)); return r; }
typedef float f32x2 __attribute__((ext_vector_type(2)));
__device__ __forceinline__ f32x2 gelu_pk(f32x2 v) {
    const f32x2 av = __builtin_elementwise_abs(v), d = av * 0.2316418882f + 1.0f;
    f32x2 t; t.x = __builtin_amdgcn_rcpf(d.x); t.y = __builtin_amdgcn_rcpf(d.y);
    f32x2 q = t * 0.5307027145f + (-0.7265760135f); q = q * t + 0.7107068705f; q = q * t + (-0.142248368f); q = q * t + 0.127414796f; q = q * t;
    const f32x2 s = (v * v) * (-0.72134752044f);
    f32x2 e; e.x = __builtin_amdgcn_exp2f(s.x); e.y = __builtin_amdgcn_exp2f(s.y);
    const f32x2 m = v * (q * e), r = v - m;
    f32x2 o; o.x = v.x < 0.f ? m.x : r.x; o.y = v.y < 0.f ? m.y : r.y; return o;
}

template <int ACT  > struct EpiBf16 {
    static constexpr bool PERM = true, AFTER_DRAIN = false; static_assert(ACT == 0 || ACT == 1, "EpiBf16: ACT is 0 (none) or 1 (gelu_pk)");
    bf16_t* O; int ldc; const float* bias; int split_cols; size_t split_stride; float scale0;
    __device__ __forceinline__ void operator()(const f32x4 (&acc)[2][2][4][2], const Unit& u, int wr, int wc, int fr, int fq) const {
        const int row0 = u.pm * BM + wr * 64 + fr; int colt = u.pn * BM; bf16_t* base = O;
        float sc = 1.f; if (split_cols) { const int t = colt / split_cols; base += (size_t)t * split_stride; colt -= t * split_cols; if (t == 0) sc = scale0; }
        const int col0 = colt + wc * 32 + 8 * fq, bcol0 = u.pn * BM + wc * 32 + 8 * fq;
        f32x4 bv[2][2];
#pragma unroll
        for (int bj = 0; bj < 2; ++bj)
#pragma unroll
            for (int n = 0; n < 2; ++n) bv[bj][n] = bias ? *(const f32x4*)(bias + bcol0 + bj * HALF + 4 * n) : (f32x4){0.f, 0.f, 0.f, 0.f};
#pragma unroll
        for (int ai = 0; ai < 2; ++ai)
#pragma unroll
            for (int m = 0; m < 4; ++m) { bf16_t* rowp = base + (size_t)(row0 + ai * HALF + m * 16) * ldc + col0;
#pragma unroll
                for (int bj = 0; bj < 2; ++bj) { f32x4 v0 = acc[ai][bj][m][0] + bv[bj][0], v1 = acc[ai][bj][m][1] + bv[bj][1];
                    if (ACT == 1) { f32x2 a = gelu_pk((f32x2){v0[0], v0[1]}), b = gelu_pk((f32x2){v0[2], v0[3]}), c = gelu_pk((f32x2){v1[0], v1[1]}), d = gelu_pk((f32x2){v1[2], v1[3]});
                        v0 = (f32x4){a.x, a.y, b.x, b.y}; v1 = (f32x4){c.x, c.y, d.x, d.y}; }
                    v0 = v0 * sc; v1 = v1 * sc; u32x4 w; w.x = cvt_pk_bf16(v0[0], v0[1]); w.y = cvt_pk_bf16(v0[2], v0[3]); w.z = cvt_pk_bf16(v1[0], v1[1]); w.w = cvt_pk_bf16(v1[2], v1[3]);
                    *(u32x4*)(rowp + bj * HALF) = w; } }
    }
};
__device__ __forceinline__ float bf2f(unsigned short b) { return __uint_as_float((unsigned)b << 16); }
__device__ __forceinline__ float sigm(float x) { return __builtin_amdgcn_rcpf(1.0f + __builtin_amdgcn_exp2f(-1.4426950408889634f * x)); }
__device__ __forceinline__ void unpack8(const u32x4 w, float (&f)[8]) {
    f[0] = __uint_as_float(w.x << 16); f[1] = __uint_as_float(w.x & 0xffff0000u); f[2] = __uint_as_float(w.y << 16); f[3] = __uint_as_float(w.y & 0xffff0000u);
    f[4] = __uint_as_float(w.z << 16); f[5] = __uint_as_float(w.z & 0xffff0000u); f[6] = __uint_as_float(w.w << 16); f[7] = __uint_as_float(w.w & 0xffff0000u);
}
template <int ACT> struct EpiRoute {
    static constexpr bool PERM = true, AFTER_DRAIN = false;
    bf16_t* O0; int ld0; int nt0;
    bf16_t* O1; int ld1; int nt1; int nts1; float sc1;
    bf16_t* O2; int ld2;
    __device__ __forceinline__ void operator()(const f32x4 (&acc)[2][2][4][2], const Unit& u, int wr, int wc, int fr, int fq) const {
        const int row0 = u.pm * BM + wr * 64 + fr;
        bf16_t* base; int ld, colt; float sc = 1.f;
        if (u.pn < nt0) { base = O0; ld = ld0; colt = u.pn * BM; }
        else if (u.pn < nt0 + nt1) { base = O1; ld = ld1; colt = (u.pn - nt0) * BM; if (u.pn - nt0 < nts1) sc = sc1; }
        else { base = O2; ld = ld2; colt = (u.pn - nt0 - nt1) * BM; }
        const int col0 = colt + wc * 32 + 8 * fq;
#pragma unroll
        for (int ai = 0; ai < 2; ++ai)
#pragma unroll
            for (int m = 0; m < 4; ++m) { bf16_t* rowp = base + (size_t)(row0 + ai * HALF + m * 16) * ld + col0;
#pragma unroll
                for (int bj = 0; bj < 2; ++bj) { f32x4 v0 = acc[ai][bj][m][0], v1 = acc[ai][bj][m][1];
                    if (ACT == 2) { for (int e = 0; e < 4; ++e) { const float a = fmaxf(v0[e], 0.f), b = fmaxf(v1[e], 0.f); v0[e] = a * a; v1[e] = b * b; } }
                    v0 = v0 * sc; v1 = v1 * sc; u32x4 w; w.x = cvt_pk_bf16(v0[0], v0[1]); w.y = cvt_pk_bf16(v0[2], v0[3]); w.z = cvt_pk_bf16(v1[0], v1[1]); w.w = cvt_pk_bf16(v1[2], v1[3]);
                    *(u32x4*)(rowp + bj * HALF) = w; } }
    }
};
struct EpiQRope {
    static constexpr bool PERM = true, AFTER_DRAIN = false;
    bf16_t* O; const float* rope; float sc;
    __device__ __forceinline__ void operator()(const f32x4 (&acc)[2][2][4][2], const Unit& u, int wr, int wc, int fr, int fq) const {
        const int row0 = u.pm * BM + wr * 64 + fr; const int col0 = u.pn * BM + wc * 32 + 8 * fq;
#pragma unroll
        for (int ai = 0; ai < 2; ++ai)
#pragma unroll
            for (int m = 0; m < 4; ++m) { const int row = row0 + ai * HALF + m * 16;
#pragma unroll
                for (int bj = 0; bj < 2; ++bj) { const int cg = col0 + bj * HALF; const int cm = cg % 192; f32x4 v0 = acc[ai][bj][m][0], v1 = acc[ai][bj][m][1];
                    if (cm >= 128) { const int j0 = (cm - 128) >> 1; const f32x4* rp = (const f32x4*)(rope + ((size_t)row * 32 + j0) * 2); const f32x4 a = rp[0], b = rp[1];
                        f32x4 r0, r1;
                        r0[0] = v0[0] * a[0] - v0[1] * a[1]; r0[1] = v0[1] * a[0] + v0[0] * a[1]; r0[2] = v0[2] * a[2] - v0[3] * a[3]; r0[3] = v0[3] * a[2] + v0[2] * a[3];
                        r1[0] = v1[0] * b[0] - v1[1] * b[1]; r1[1] = v1[1] * b[0] + v1[0] * b[1]; r1[2] = v1[2] * b[2] - v1[3] * b[3]; r1[3] = v1[3] * b[2] + v1[2] * b[3];
                        v0 = r0; v1 = r1; }
                    v0 = v0 * sc; v1 = v1 * sc; u32x4 w; w.x = cvt_pk_bf16(v0[0], v0[1]); w.y = cvt_pk_bf16(v0[2], v0[3]); w.z = cvt_pk_bf16(v1[0], v1[1]); w.w = cvt_pk_bf16(v1[2], v1[3]);
                    *(u32x4*)(O + (size_t)row * 768 + cg) = w; } }
    }
};
template <int NI> struct EpiMerge {
    static constexpr bool PERM = true, AFTER_DRAIN = false;
    bf16_t* MG; const bf16_t* GT;
    __device__ __forceinline__ void operator()(const f32x4 (&acc)[2][2][4][2], const Unit& u, int wr, int wc, int fr, int fq) const {
        const int row0 = u.pm * BM + wr * 64 + fr; const int col0 = u.pn * BM + wc * 32 + 8 * fq;
#pragma unroll
        for (int ai = 0; ai < 2; ++ai)
#pragma unroll
            for (int m = 0; m < 4; ++m) { const int row = row0 + ai * HALF + m * 16;
#pragma unroll
                for (int bj = 0; bj < 2; ++bj) { const int c = col0 + bj * HALF; const f32x4 v0 = acc[ai][bj][m][0], v1 = acc[ai][bj][m][1];
                    float g[8]; unpack8(*(const u32x4*)(GT + (size_t)row * 3072 + NI * 1024 + c), g);
                    for (int e = 0; e < 8; ++e) g[e] = sigm(g[e]);
                    float o[8];
                    if (NI > 0) unpack8(*(const u32x4*)(MG + (size_t)row * 1024 + c), o); else { for (int e = 0; e < 8; ++e) o[e] = 0.f; }
                    for (int e = 0; e < 4; ++e) { o[e] += g[e] * v0[e]; o[4 + e] += g[4 + e] * v1[e]; }
                    u32x4 w; w.x = cvt_pk_bf16(o[0], o[1]); w.y = cvt_pk_bf16(o[2], o[3]); w.z = cvt_pk_bf16(o[4], o[5]); w.w = cvt_pk_bf16(o[6], o[7]);
                    *(u32x4*)(MG + (size_t)row * 1024 + c) = w; } }
    }
};
struct EpiPle {
    static constexpr bool PERM = true, AFTER_DRAIN = false;
    float* H; const bf16_t* PP;
    __device__ __forceinline__ void operator()(const f32x4 (&acc)[2][2][4][2], const Unit& u, int wr, int wc, int fr, int fq) const {
        const int row0 = u.pm * BM + wr * 64 + fr; const int col0 = u.pn * BM + wc * 32 + 8 * fq;
#pragma unroll
        for (int ai = 0; ai < 2; ++ai)
#pragma unroll
            for (int m = 0; m < 4; ++m) { const int row = row0 + ai * HALF + m * 16;
#pragma unroll
                for (int bj = 0; bj < 2; ++bj) { const int c = col0 + bj * HALF; const f32x4 v0 = acc[ai][bj][m][0], v1 = acc[ai][bj][m][1];
                    float p[8]; unpack8(*(const u32x4*)(PP + (size_t)row * 1024 + c), p);
                    f32x4* hp = (f32x4*)(H + (size_t)row * 1024 + c); f32x4 h0 = hp[0], h1 = hp[1];
                    for (int e = 0; e < 4; ++e) { h0[e] += sigm(v0[e]) * p[e]; h1[e] += sigm(v1[e]) * p[4 + e]; }
                    hp[0] = h0; hp[1] = h1; } }
    }
};
template <class Epi, class Sched, bool ALIGN_EPI = false, bool SP2 = false>
__device__ __forceinline__ void gemm_phase(PG8_LAS unsigned char* lds, const Gemm g, const Sched& S, const Epi& E) {
    int tid_ = threadIdx.x; asm volatile("" : "+v"(tid_));
    const int tid = tid_, wid = __builtin_amdgcn_readfirstlane(tid >> 6), lane = tid & 63, wr = wid >> 2, wc = wid & 3, fr = lane & 15, fq = lane >> 4;
    const int K = g.K, nt = K / BK;
    unsigned voffA[2], voffB[2];
#pragma unroll
    for (int i = 0; i < 2; ++i) { int R, C; stage_rc(tid * 16 + i * 8192, R, C); const int Rb = Epi::PERM ? ((R & ~31) + perm32(R & 31)) : R;
        voffA[i] = (unsigned)(R * K + C) * 2u; voffB[i] = (unsigned)(Rb * K + C) * 2u; }
    const size_t kstep = (size_t)(BK * 2);
    const size_t hstep = (size_t)HALF * K * 2;
    const size_t tstep = 2 * hstep;
    const unsigned ldsw = (unsigned)wid * 1024u;
    const int aoff = lds_byte(wr * 64 + fr, fq * 8), boff = lds_byte(wc * 32 + fr, fq * 8);
#define PG8_SA(b, h) (((b) * 2 + (h)) * HTB)
#define PG8_SB(b, h) ((4 + (b) * 2 + (h)) * HTB)
#define PG8_STAGE(bufoff, gbase, voff) do { _Pragma("unroll") for (int _i = 0; _i < 2; ++_i) \
        __builtin_amdgcn_global_load_lds((const unsigned*)((const char*)(gbase) + (voff)[_i]), (PG8_LAS unsigned*)(lds + (bufoff) + ldsw + _i * 8192), 16, 0, 0); } while (0)
#define PG8_LDA(dst, b, h) do { _Pragma("unroll") for (int m = 0; m < 4; ++m) _Pragma("unroll") for (int k = 0; k < 2; ++k) dst[m][k] = *(const PG8_LAS bf16x8*)(lds + PG8_SA(b, h) + aoff + m * 2048 + k * 1024); } while (0)
#define PG8_LDB(dst, b, h) do { _Pragma("unroll") for (int n = 0; n < 2; ++n) _Pragma("unroll") for (int k = 0; k < 2; ++k) dst[n][k] = *(const PG8_LAS bf16x8*)(lds + PG8_SB(b, h) + boff + n * 2048 + k * 1024); } while (0)
#define PG8_MMA(ai, bj, At, Bt) do { __builtin_amdgcn_s_setprio(1); _Pragma("unroll") for (int m = 0; m < 4; ++m) _Pragma("unroll") for (int n = 0; n < 2; ++n) _Pragma("unroll") for (int k = 0; k < 2; ++k) \
        acc[ai][bj][m][n] = __builtin_amdgcn_mfma_f32_16x16x32_bf16(Bt[n][k], At[m][k], acc[ai][bj][m][n], 0, 0, 0); __builtin_amdgcn_s_setprio(0); } while (0)
#define PG8_WAIT_V(n) asm volatile("s_waitcnt vmcnt(" #n ")" ::: "memory")
#define PG8_WAIT_L(n) asm volatile("s_waitcnt lgkmcnt(" #n ")" ::: "memory")
#define PG8_BAR __builtin_amdgcn_s_barrier()
#define PG8_SCHED __builtin_amdgcn_sched_barrier(0)
    Unit cur, nxt; int ui = 0;
    if (!S.next(0, cur)) return;
    f32x4 acc[2][2][4][2];
#pragma unroll
    for (int a = 0; a < 2; ++a)
#pragma unroll
        for (int b = 0; b < 2; ++b)
#pragma unroll
            for (int m = 0; m < 4; ++m)
#pragma unroll
                for (int n = 0; n < 2; ++n) acc[a][b][m][n] = (f32x4){0.f, 0.f, 0.f, 0.f};
    bf16x8 At[4][2], B0[2][2], B1[2][2];
    const char* cA = (const char*)g.A + (size_t)cur.pm * tstep; const char* cB = (const char*)g.Bt + (size_t)cur.pn * tstep;
    S.a_ready(cur);
    if constexpr (SP2) {
        PG8_STAGE(PG8_SB(0, 0), cB, voffB); PG8_STAGE(PG8_SB(0, 1), cB + hstep, voffB); PG8_STAGE(PG8_SA(0, 0), cA, voffA); PG8_STAGE(PG8_SA(0, 1), cA + hstep, voffA);
        if (wr == 1) PG8_BAR;
        PG8_WAIT_V(2); PG8_BAR;
        PG8_STAGE(PG8_SB(1, 0), cB + kstep, voffB); PG8_STAGE(PG8_SA(1, 0), cA + kstep, voffA); PG8_STAGE(PG8_SB(1, 1), cB + hstep + kstep, voffB);
        PG8_WAIT_V(6); PG8_BAR;
    } else {
        PG8_STAGE(PG8_SB(0, 0), cB, voffB); PG8_STAGE(PG8_SA(0, 0), cA, voffA); PG8_STAGE(PG8_SB(0, 1), cB + hstep, voffB); PG8_STAGE(PG8_SA(0, 1), cA + hstep, voffA);
        if (wr == 1) PG8_BAR;
        PG8_WAIT_V(4); PG8_BAR;
        PG8_STAGE(PG8_SB(1, 0), cB + kstep, voffB); PG8_STAGE(PG8_SA(1, 0), cA + kstep, voffA); PG8_STAGE(PG8_SB(1, 1), cB + hstep + kstep, voffB);
        PG8_WAIT_V(6); PG8_BAR;
    }
    for (;;) {
        const bool has_next = S.next(ui + 1, nxt);
        const char* nA = has_next ? (const char*)g.A + (size_t)nxt.pm * tstep : cA; const char* nB = has_next ? (const char*)g.Bt + (size_t)nxt.pn * tstep : cB;
        for (int t = 0; t < nt; t += 2) {
            const bool last = (t == nt - 2);
            const char* a1 = cA + (size_t)(t + 1) * kstep;
            const char* a2 = last ? nA : cA + (size_t)(t + 2) * kstep; const char* b2 = last ? nB : cB + (size_t)(t + 2) * kstep;
            const char* a3 = a2 + kstep; const char* b3 = b2 + kstep;
            if (last && has_next) S.a_ready(nxt);
            if constexpr (SP2) {
            PG8_LDB(B0, 0, 0); PG8_LDB(B1, 0, 1); PG8_SCHED; PG8_LDA(At, 0, 0); PG8_STAGE(PG8_SA(1, 1), a1 + hstep, voffA);
            PG8_WAIT_V(8); PG8_WAIT_L(0); PG8_BAR; PG8_MMA(0, 0, At, B0); PG8_MMA(0, 1, At, B1); PG8_BAR; PG8_SCHED;
            PG8_LDA(At, 0, 1); PG8_STAGE(PG8_SB(0, 0), b2, voffB); PG8_STAGE(PG8_SB(0, 1), b2 + hstep, voffB); PG8_STAGE(PG8_SA(0, 0), a2, voffA);
            PG8_WAIT_V(8); PG8_WAIT_L(0); PG8_BAR; PG8_MMA(1, 0, At, B0); PG8_MMA(1, 1, At, B1); PG8_BAR; PG8_SCHED;
            PG8_LDB(B0, 1, 0); PG8_LDB(B1, 1, 1); PG8_SCHED; PG8_LDA(At, 1, 0); PG8_STAGE(PG8_SA(0, 1), a2 + hstep, voffA);
            PG8_WAIT_V(8); PG8_WAIT_L(0); PG8_BAR; PG8_MMA(0, 0, At, B0); PG8_MMA(0, 1, At, B1); PG8_BAR; PG8_SCHED;
            PG8_LDA(At, 1, 1); PG8_STAGE(PG8_SB(1, 0), b3, voffB); PG8_STAGE(PG8_SB(1, 1), b3 + hstep, voffB); PG8_STAGE(PG8_SA(1, 0), a3, voffA);
            PG8_WAIT_V(8); PG8_WAIT_L(0); PG8_BAR; PG8_MMA(1, 0, At, B0); PG8_MMA(1, 1, At, B1); PG8_BAR; PG8_SCHED;
            } else {
            PG8_LDB(B0, 0, 0); PG8_SCHED; PG8_LDA(At, 0, 0); PG8_STAGE(PG8_SA(1, 1), a1 + hstep, voffA);
            PG8_WAIT_L(8); PG8_BAR; PG8_WAIT_L(0); PG8_MMA(0, 0, At, B0); PG8_BAR; PG8_SCHED;
            PG8_LDB(B1, 0, 1); PG8_STAGE(PG8_SB(0, 0), b2, voffB);
            PG8_BAR; PG8_WAIT_L(0); PG8_MMA(0, 1, At, B1); PG8_BAR;
            PG8_LDA(At, 0, 1); PG8_STAGE(PG8_SA(0, 0), a2, voffA);
            PG8_BAR; PG8_WAIT_L(0); PG8_MMA(1, 0, At, B0); PG8_BAR; PG8_SCHED;
            PG8_STAGE(PG8_SB(0, 1), b2 + hstep, voffB);
            PG8_WAIT_V(6); PG8_BAR; PG8_MMA(1, 1, At, B1); PG8_BAR;
            PG8_LDB(B0, 1, 0); PG8_SCHED; PG8_LDA(At, 1, 0); PG8_STAGE(PG8_SA(0, 1), a2 + hstep, voffA);
            PG8_WAIT_L(8); PG8_BAR; PG8_WAIT_L(0); PG8_MMA(0, 0, At, B0); PG8_BAR; PG8_SCHED;
            PG8_LDB(B1, 1, 1); PG8_STAGE(PG8_SB(1, 0), b3, voffB);
            PG8_BAR; PG8_WAIT_L(0); PG8_MMA(0, 1, At, B1); PG8_BAR;
            PG8_LDA(At, 1, 1); PG8_STAGE(PG8_SA(1, 0), a3, voffA);
            PG8_BAR; PG8_WAIT_L(0); PG8_MMA(1, 0, At, B0); PG8_BAR; PG8_SCHED;
            PG8_STAGE(PG8_SB(1, 1), b3 + hstep, voffB);
            PG8_WAIT_V(6); PG8_BAR; PG8_MMA(1, 1, At, B1); PG8_BAR;
            }
        }
        if constexpr (ALIGN_EPI) { if (wr == 0) PG8_BAR; }
        if constexpr (!Epi::AFTER_DRAIN) { int t2_ = threadIdx.x; asm volatile("" : "+v"(t2_)); const int l2_ = t2_ & 63, w2_ = __builtin_amdgcn_readfirstlane(t2_ >> 6);
            E(acc, cur, w2_ >> 2, w2_ & 3, l2_ & 15, l2_ >> 4); S.done(cur); }
        if (!has_next) break;
#pragma unroll
        for (int a = 0; a < 2; ++a)
#pragma unroll
            for (int b = 0; b < 2; ++b)
#pragma unroll
                for (int m = 0; m < 4; ++m)
#pragma unroll
                    for (int n = 0; n < 2; ++n) acc[a][b][m][n] = (f32x4){0.f, 0.f, 0.f, 0.f};
        cur = nxt; cA = nA; cB = nB; ++ui;
        if constexpr (ALIGN_EPI) { if (wr == 1) PG8_BAR; }
    }
    PG8_WAIT_V(0);
    if constexpr (!ALIGN_EPI) { if (wr == 0) PG8_BAR; }
    PG8_BAR;
    if constexpr (Epi::AFTER_DRAIN) { E.fused(acc, cur, wr, wc, fr, fq, lds, wid, lane); S.done(cur); }
#undef PG8_SA
#undef PG8_SB
#undef PG8_STAGE
#undef PG8_LDA
#undef PG8_LDB
#undef PG8_MMA
#undef PG8_WAIT_V
#undef PG8_WAIT_L
#undef PG8_BAR
#undef PG8_SCHED
}
}
constexpr int NWAVES = 8;
constexpr int D = 1024, BATCH = 8, SEQ = 4096, T = BATCH * SEQ, DEPTH = 2, FF = 4096, DPLE = 256;
constexpr int IN_COLS = 6848, RW_COLS = 1792;
constexpr float NORM_EPS = 1e-6f, RW_LN_EPS = 64e-5f;
constexpr float LOG2E = 1.4426950408889634f;
constexpr float MLA_QSCALE = 0.07216878364870322f * LOG2E;
constexpr float CA_QSCALE = 0.125f * LOG2E;
constexpr size_t MiB = 1u << 20;
constexpr size_t WS_CTL = 0, CTL_ZERO_BYTES = 1 * MiB;
constexpr size_t WS_ROPE = 1 * MiB;
constexpr size_t WS_W = 9 * MiB;
constexpr size_t W_IN = WS_W, W_Q = W_IN + (size_t)6912 * 1024 * 2, W_LORA = W_Q + (size_t)768 * 256 * 2, W_B = W_LORA + (size_t)1536 * 256 * 2,
                 W_OUT = W_B + (size_t)3 * 1024 * 512 * 2, W_1 = W_OUT + (size_t)1024 * 1024 * 2, W_2 = W_1 + (size_t)4096 * 1024 * 2, W_G = W_2 + (size_t)4096 * 1024 * 2,
                 W_P = W_G + (size_t)1024 * 1024 * 2, W_END = W_P + (size_t)1024 * 256 * 2;
constexpr size_t WS_U = 49 * MiB;
constexpr size_t WS_OA = 113 * MiB, WS_OC = 145 * MiB, WS_ORW = 177 * MiB;
constexpr size_t WS_X = 209 * MiB, WS_END = 512 * MiB;
constexpr size_t X_ZC = WS_X, X_QP = X_ZC + (size_t)T * 1536 * 2, X_KV = X_QP + (size_t)T * 768 * 2, X_ZR = X_KV + (size_t)T * 192 * 2, X_TW = X_ZR + (size_t)T * 1792 * 2;
constexpr size_t X_TA = WS_U, X_G = WS_U + (size_t)T * 512 * 2, X_QN = WS_OC, X_LA = WS_ORW;
constexpr size_t X_GT = WS_X, X_MG = X_GT + (size_t)T * 3072 * 2;
constexpr size_t X_HID = WS_X, X_PB = WS_X, X_PP = X_PB + (size_t)T * 256 * 2;
static_assert(X_TW + (size_t)T * 512 * 2 <= WS_END && X_MG + (size_t)T * 1024 * 2 <= WS_END && X_HID + (size_t)T * 4096 * 2 <= WS_END, "X map");
constexpr int CW_TMO = 0, CW_QUEUE = 1024  , CW_BAR = 4096;
constexpr int RING_OFF = 0, RING_BYTES = 131072;
constexpr int LDSCTL_OFF = RING_BYTES, MISC_OFF = LDSCTL_OFF + 320;
constexpr int LDS_BYTES = 147456;

#define GAS __attribute__((address_space(1)))
#define LAS __attribute__((address_space(3)))
typedef unsigned short bf16;
typedef unsigned v4u __attribute__((ext_vector_type(4)));
typedef unsigned v2u __attribute__((ext_vector_type(2)));
typedef float f32x4 __attribute__((ext_vector_type(4)));
typedef float f32x16 __attribute__((ext_vector_type(16)));
typedef short bf16x8 __attribute__((ext_vector_type(8)));
typedef short s16x4 __attribute__((ext_vector_type(4)));
#define LDS_WAIT() asm volatile("s_waitcnt lgkmcnt(0)" ::: "memory")
#define VM_WAIT() asm volatile("s_waitcnt vmcnt(0)" ::: "memory")
__device__ __forceinline__ unsigned f2bf(float f) { unsigned u = __builtin_bit_cast(unsigned, f); return (u + 0x7fffu + ((u >> 16) & 1u)) >> 16; }
__device__ __forceinline__ unsigned pk2(float lo, float hi) { return f2bf(lo) | (f2bf(hi) << 16); }
__device__ __forceinline__ float bfl(unsigned w) { return __uint_as_float(w << 16); }
__device__ __forceinline__ float bfh(unsigned w) { return __uint_as_float(w & 0xffff0000u); }
__device__ __forceinline__ float sigmoidf_(float x) { return 1.0f / (1.0f + __expf(-x)); }
__device__ __forceinline__ float shfl_xor_f(float v, int o, int lane) { return __int_as_float(__builtin_amdgcn_ds_bpermute((lane ^ o) << 2, __float_as_int(v))); }
__device__ __forceinline__ float wave_sum(float v, int lane) {
#pragma unroll
    for (int o = 1; o < 64; o <<= 1) v += shfl_xor_f(v, o, lane);
    return v;
}
__device__ __forceinline__ unsigned char* opq(unsigned char* p) { asm volatile("" : "+s"(p)); return p; }
__device__ __forceinline__ float fsig(float x) { return __builtin_amdgcn_rcpf(1.0f + __builtin_amdgcn_exp2f(-LOG2E * x)); }
#define XB_TMO      128
#define XB_XCNT(j)  (256  + 64 * (j))
#define XB_XSUB(j)  (1280 + 64 * (j))
#define XB_XGEN(j)  (2304 + 64 * (j))
#define XB_TOP      3328
#define XB_TOPGEN   3392
#define XCD_BAR_WORDS 3456
#define XB_SPIN_CAP (1u << 25)

__device__ __forceinline__ unsigned xb_ld(unsigned* p)              { return __hip_atomic_load(p, __ATOMIC_RELAXED, __HIP_MEMORY_SCOPE_AGENT); }
__device__ __forceinline__ unsigned xb_add(unsigned* p, unsigned v) { return __hip_atomic_fetch_add(p, v, __ATOMIC_RELAXED, __HIP_MEMORY_SCOPE_AGENT); }
__device__ __forceinline__ unsigned xb_xcc_id() { return (unsigned)__builtin_amdgcn_s_getreg((3 << 11) | 20) & 0xFu; }
#define XB_SPIN(cond, bar) do { unsigned _sp = 0; while (cond) { __builtin_amdgcn_s_sleep(1); \
    if ((++_sp & 255u) == 0u) { if (xb_ld(&(bar)[XB_TMO])) break; if (_sp > XB_SPIN_CAP) { atomicAdd(&(bar)[XB_TMO], 1u); break; } } } } while (0)

struct XcdBarrier {
    unsigned* bar; unsigned x;
    volatile LAS unsigned* st;
};

__device__ __forceinline__ XcdBarrier xcd_barrier_post(unsigned* bar, volatile LAS unsigned* st) {
    XcdBarrier b; b.bar = bar; b.x = xb_xcc_id(); b.st = st;
    if (threadIdx.x == 0) (void)xb_add(&bar[XB_XCNT(b.x)], 1u);
    return b;
}
__device__ __forceinline__ void xcd_barrier_complete(unsigned* bar, unsigned x, unsigned& nloc, unsigned& nx) {
    const unsigned G = gridDim.x * gridDim.y * gridDim.z;
    unsigned sum, cnt, mine, sp = 0u;
    for (;;) {
        sum = 0u; cnt = 0u; mine = 0u;
#pragma unroll
        for (unsigned j = 0; j < 16; ++j) { const unsigned c = xb_ld(&bar[XB_XCNT(j)]); sum += c; cnt += (c > 0u) ? 1u : 0u; mine = (j == x) ? c : mine; }
        if (sum == G) break;
        __builtin_amdgcn_s_sleep(1);
        if ((++sp & 255u) == 0u) { if (xb_ld(&bar[XB_TMO])) break; if (sp > XB_SPIN_CAP) { atomicAdd(&bar[XB_TMO], 1u); break; } }
    }
    nloc = mine > 0u ? mine : 1u; nx = cnt > 0u ? cnt : 1u;
}

__device__ __forceinline__ void xcd_barrier(const XcdBarrier& b) {
    asm volatile("s_waitcnt vmcnt(0)" ::: "memory");
    __syncthreads();
    if (threadIdx.x == 0) {
        unsigned* bar = b.bar;
        __builtin_amdgcn_s_waitcnt(0);
        unsigned nloc = b.st[0], nx = b.st[1];
        if (nloc == 0u) { xcd_barrier_complete(bar, b.x, nloc, nx); b.st[0] = nloc; b.st[1] = nx; }
        const unsigned old = xb_add(&bar[XB_XSUB(b.x)], 1u);
        const unsigned gen = old / nloc;
        if (old + 1u == (gen + 1u) * nloc) {
            __builtin_amdgcn_fence(__ATOMIC_RELEASE, "agent");
            asm volatile("s_waitcnt vmcnt(0)" ::: "memory");
            const unsigned og = xb_add(&bar[XB_TOP], 1u);
            const unsigned tg = og / nx;
            if (og + 1u == (tg + 1u) * nx) xb_add(&bar[XB_TOPGEN], 1u);
            else XB_SPIN(xb_ld(&bar[XB_TOPGEN]) == tg, bar);
            __builtin_amdgcn_fence(__ATOMIC_ACQUIRE, "agent");
            xb_add(&bar[XB_XGEN(b.x)], 1u);
            asm volatile("s_waitcnt vmcnt(0)" ::: "memory");
        } else {
            XB_SPIN(xb_ld(&bar[XB_XGEN(b.x)]) == gen, bar);
            __builtin_amdgcn_fence(__ATOMIC_ACQUIRE, "agent");
            asm volatile("s_waitcnt vmcnt(0)" ::: "memory");
        }
    }
    __syncthreads();
}
namespace att {
__device__ __forceinline__ int crow(int r, int hi) { return (r & 3) + 8 * (r >> 2) + 4 * hi; }
__device__ __forceinline__ unsigned cvtpk(float lo, float hi) { unsigned r; asm volatile("v_cvt_pk_bf16_f32 %0, %1, %2" : "=v"(r) : "v"(lo), "v"(hi)); return r; }
typedef short v4i16_t __attribute__((ext_vector_type(4)));
__device__ __forceinline__ s16x4 vtr(const LAS unsigned char* p) { return __builtin_bit_cast(s16x4, __builtin_amdgcn_ds_read_tr16_b64_v4i16((LAS v4i16_t*)p)); }
__device__ __forceinline__ float softmax_tile(f32x16& p0, f32x16& p1, float& m_reg, float& l_reg, bf16x8& pa0, bf16x8& pa1, bf16x8& pa2, bf16x8& pa3) {
    float pmax = p0[0];
#pragma unroll
    for (int r = 1; r < 16; ++r) pmax = fmaxf(pmax, p0[r]);
#pragma unroll
    for (int r = 0; r < 16; ++r) pmax = fmaxf(pmax, p1[r]);
    { auto rr = __builtin_amdgcn_permlane32_swap(__float_as_uint(pmax), __float_as_uint(pmax), false, false); pmax = fmaxf(__uint_as_float(rr[0]), __uint_as_float(rr[1])); }
    float alpha = 1.f;
    if (!__all(pmax - m_reg <= 8.f)) { const float mn = fmaxf(m_reg, pmax); alpha = __builtin_amdgcn_exp2f(m_reg - mn); m_reg = mn; }
    float ps = 0.f;
#pragma unroll
    for (int r = 0; r < 16; ++r) { p0[r] = __builtin_amdgcn_exp2f(p0[r] - m_reg); ps += p0[r]; }
#pragma unroll
    for (int r = 0; r < 16; ++r) { p1[r] = __builtin_amdgcn_exp2f(p1[r] - m_reg); ps += p1[r]; }
    { auto rr = __builtin_amdgcn_permlane32_swap(__float_as_uint(ps), __float_as_uint(ps), false, false); ps = __uint_as_float(rr[0]) + __uint_as_float(rr[1]); }
    l_reg = l_reg * alpha + ps;
#define PK4(P, BASE, OUT) do { unsigned a0 = cvtpk(P[BASE + 0], P[BASE + 1]), a1 = cvtpk(P[BASE + 2], P[BASE + 3]);   \
    unsigned b0 = cvtpk(P[BASE + 4], P[BASE + 5]), b1 = cvtpk(P[BASE + 6], P[BASE + 7]);                              \
    auto r0 = __builtin_amdgcn_permlane32_swap(a0, b0, false, false); auto r1 = __builtin_amdgcn_permlane32_swap(a1, b1, false, false); \
    v4u w = {r0[0], r1[0], r0[1], r1[1]}; OUT = __builtin_bit_cast(bf16x8, w); } while (0)
    PK4(p0, 0, pa0); PK4(p0, 8, pa1); PK4(p1, 0, pa2); PK4(p1, 8, pa3);
#undef PK4
    return alpha;
}
constexpr int MLA_KSTR = 400;
constexpr int MLA_KBUF = 64 * MLA_KSTR;
constexpr int ATT_SCR = 2 * MLA_KBUF;
__device__ __forceinline__ void mla_unit(LAS unsigned char* lds, const bf16* __restrict__ QP, const bf16* __restrict__ KV, bf16* __restrict__ OA, int b, int c) {
    int tid_ = threadIdx.x; asm volatile("" : "+v"(tid_));
    const int tid = tid_, lane = tid & 63, wid = __builtin_amdgcn_readfirstlane(tid >> 6), r32 = lane & 31, hi = lane >> 5;
    const int h = wid >> 1; const size_t qrow0 = (size_t)b * SEQ + c * 64 + (wid & 1) * 32;
    bf16x8 qr[12];
    { const bf16* qp = QP + (qrow0 + r32) * 768 + h * 192 + hi * 8;
#pragma unroll
      for (int d0 = 0; d0 < 12; ++d0) qr[d0] = *(const bf16x8*)(qp + d0 * 16); }
    float m_reg = -1e30f, l_reg = 0.f; f32x16 o[4];
#pragma unroll
    for (int d = 0; d < 4; ++d)
#pragma unroll
        for (int r = 0; r < 16; ++r) o[d][r] = 0.f;
    LAS float* scr = (LAS float*)(lds + ATT_SCR) + wid * 64;
    const bf16* kvb = KV + (size_t)b * SEQ * 192;
    int skey[3], sch[3];
#pragma unroll
    for (int i = 0; i < 3; ++i) { const int id = tid + 512 * i; skey[i] = id / 24; sch[i] = id % 24; }
    v4u st[3];
    const int NT = c + 1;
#pragma unroll
    for (int i = 0; i < 3; ++i) st[i] = *(const v4u*)(kvb + (size_t)skey[i] * 192 + sch[i] * 8);
#pragma unroll
    for (int i = 0; i < 3; ++i) *(LAS v4u*)(lds + skey[i] * MLA_KSTR + sch[i] * 16) = st[i];
    __syncthreads();
    const int troff = (((lane & 15) >> 2) + 8 * hi) * MLA_KSTR + (16 * ((lane >> 4) & 1) + 4 * (lane & 3)) * 2;
    for (int j = 0; j < NT; ++j) {
        const int buf = j & 1;
        if (j + 1 < NT) {
#pragma unroll
            for (int i = 0; i < 3; ++i) st[i] = *(const v4u*)(kvb + (size_t)(64 * (j + 1) + skey[i]) * 192 + sch[i] * 8);
        }
        const LAS unsigned char* kt = lds + buf * MLA_KBUF;
        f32x16 p0, p1;
#pragma unroll
        for (int r = 0; r < 16; ++r) { p0[r] = 0.f; p1[r] = 0.f; }
        { const LAS unsigned char* kb = kt + r32 * MLA_KSTR + hi * 16;
#pragma unroll
          for (int d0 = 0; d0 < 12; ++d0) { const bf16x8 a0 = *(const LAS bf16x8*)(kb + d0 * 32); const bf16x8 a1 = *(const LAS bf16x8*)(kb + 32 * MLA_KSTR + d0 * 32);
              p0 = __builtin_amdgcn_mfma_f32_32x32x16_bf16(a0, qr[d0], p0, 0, 0, 0); p1 = __builtin_amdgcn_mfma_f32_32x32x16_bf16(a1, qr[d0], p1, 0, 0, 0); } }
        bf16x8 pa0, pa1, pa2, pa3;
        const float alpha = softmax_tile(p0, p1, m_reg, l_reg, pa0, pa1, pa2, pa3);
        if (__any(alpha < 1.f)) { if (hi == 0) scr[r32] = alpha; LDS_WAIT();
#pragma unroll
            for (int r = 0; r < 16; ++r) { const float a = scr[crow(r, hi)];
#pragma unroll
                for (int d = 0; d < 4; ++d) o[d][r] *= a; } }
        const LAS unsigned char* vb = kt + troff;
#pragma unroll
        for (int d0 = 0; d0 < 4; ++d0) {
            s16x4 lo[4], hh[4];
#pragma unroll
            for (int ks = 0; ks < 4; ++ks) { lo[ks] = vtr(vb + (16 * ks) * MLA_KSTR + d0 * 64); hh[ks] = vtr(vb + (16 * ks + 4) * MLA_KSTR + d0 * 64); }
#define PK(k) (bf16x8){lo[k][0], lo[k][1], lo[k][2], lo[k][3], hh[k][0], hh[k][1], hh[k][2], hh[k][3]}
            o[d0] = __builtin_amdgcn_mfma_f32_32x32x16_bf16(pa0, PK(0), o[d0], 0, 0, 0);
            o[d0] = __builtin_amdgcn_mfma_f32_32x32x16_bf16(pa1, PK(1), o[d0], 0, 0, 0);
            o[d0] = __builtin_amdgcn_mfma_f32_32x32x16_bf16(pa2, PK(2), o[d0], 0, 0, 0);
            o[d0] = __builtin_amdgcn_mfma_f32_32x32x16_bf16(pa3, PK(3), o[d0], 0, 0, 0);
#undef PK
        }
        if (j + 1 < NT) {
#pragma unroll
            for (int i = 0; i < 3; ++i) *(LAS v4u*)(lds + (buf ^ 1) * MLA_KBUF + skey[i] * MLA_KSTR + sch[i] * 16) = st[i];
        }
        __syncthreads();
    }
    if (hi == 0) scr[r32] = l_reg; LDS_WAIT();
    bf16* ob = OA + qrow0 * 512 + h * 128 + r32;
#pragma unroll
    for (int r = 0; r < 16; ++r) { const int orow = crow(r, hi); const float rl = __builtin_amdgcn_rcpf(scr[orow]);
#pragma unroll
        for (int d0 = 0; d0 < 4; ++d0) ob[(size_t)orow * 512 + d0 * 32] = (bf16)f2bf(o[d0][r] * rl); }
    __syncthreads();
}
constexpr int CA_KSTR = 144;
constexpr int CA_TBUF = 64 * CA_KSTR;
constexpr int CA_BIAS = ATT_SCR + 8 * 256;
__device__ __forceinline__ void band_unit(LAS unsigned char* lds, const bf16* __restrict__ ZC, const float* __restrict__ relb, bf16* __restrict__ OC, int b, int h, int g) {
    int tid_ = threadIdx.x; asm volatile("" : "+v"(tid_));
    const int tid = tid_, lane = tid & 63, wid = __builtin_amdgcn_readfirstlane(tid >> 6), r32 = lane & 31, hi = lane >> 5;
    const int cw = 4 * g + (wid >> 1); const size_t qrow0 = (size_t)b * SEQ + cw * 64 + (wid & 1) * 32;
    LAS float* bias = (LAS float*)(lds + CA_BIAS);
    if (tid < 320) bias[tid] = relb[tid * 8 + h] * LOG2E;
    bf16x8 qr[4];
    { const bf16* qp = ZC + (qrow0 + r32) * 1536 + h * 64 + hi * 8;
#pragma unroll
      for (int d0 = 0; d0 < 4; ++d0) qr[d0] = *(const bf16x8*)(qp + d0 * 16); }
    float m_reg = -1e30f, l_reg = 0.f; f32x16 o[2];
#pragma unroll
    for (int d = 0; d < 2; ++d)
#pragma unroll
        for (int r = 0; r < 16; ++r) o[d][r] = 0.f;
    LAS float* scr = (LAS float*)(lds + ATT_SCR) + wid * 64;
    const int kc0 = (4 * g - 8) < 0 ? 0 : (4 * g - 8), kc1 = 4 * g + 3;
    const bf16* kbase = ZC + (size_t)b * SEQ * 1536 + 512 + h * 64; const bf16* vbase = kbase + 512;
    const int skey = tid >> 3, sch = tid & 7;
    v4u stk, stv;
    stk = *(const v4u*)(kbase + (size_t)(64 * kc0 + skey) * 1536 + sch * 8); stv = *(const v4u*)(vbase + (size_t)(64 * kc0 + skey) * 1536 + sch * 8);
    *(LAS v4u*)(lds + skey * CA_KSTR + sch * 16) = stk; *(LAS v4u*)(lds + CA_TBUF + skey * CA_KSTR + sch * 16) = stv;
    __syncthreads();
    const int troff = (((lane & 15) >> 2) + 8 * hi) * CA_KSTR + (16 * ((lane >> 4) & 1) + 4 * (lane & 3)) * 2;
    const int qin = (wid & 1) * 32 + r32;
    for (int kc = kc0; kc <= kc1; ++kc) {
        const int buf = (kc - kc0) & 1;
        if (kc < kc1) { stk = *(const v4u*)(kbase + (size_t)(64 * (kc + 1) + skey) * 1536 + sch * 8); stv = *(const v4u*)(vbase + (size_t)(64 * (kc + 1) + skey) * 1536 + sch * 8); }
        if (kc >= cw - 8 && kc <= cw) {
            const LAS unsigned char* kt = lds + buf * 2 * CA_TBUF;
            f32x16 p0, p1;
            const int dbase = (cw - kc) * 64 + qin + 63;
#pragma unroll
            for (int r = 0; r < 16; ++r) { int i0 = dbase - crow(r, hi), i1 = i0 - 32; i0 = i0 > 319 ? 319 : i0; i1 = i1 > 319 ? 319 : i1; p0[r] = bias[i0]; p1[r] = bias[i1]; }
            { const LAS unsigned char* kb = kt + r32 * CA_KSTR + hi * 16;
#pragma unroll
              for (int d0 = 0; d0 < 4; ++d0) { const bf16x8 a0 = *(const LAS bf16x8*)(kb + d0 * 32); const bf16x8 a1 = *(const LAS bf16x8*)(kb + 32 * CA_KSTR + d0 * 32);
                  p0 = __builtin_amdgcn_mfma_f32_32x32x16_bf16(a0, qr[d0], p0, 0, 0, 0); p1 = __builtin_amdgcn_mfma_f32_32x32x16_bf16(a1, qr[d0], p1, 0, 0, 0); } }
            bf16x8 pa0, pa1, pa2, pa3;
            const float alpha = softmax_tile(p0, p1, m_reg, l_reg, pa0, pa1, pa2, pa3);
            if (__any(alpha < 1.f)) { if (hi == 0) scr[r32] = alpha; LDS_WAIT();
#pragma unroll
                for (int r = 0; r < 16; ++r) { const float a = scr[crow(r, hi)]; o[0][r] *= a; o[1][r] *= a; } }
            const LAS unsigned char* vb = kt + CA_TBUF + troff;
#pragma unroll
            for (int d0 = 0; d0 < 2; ++d0) {
                s16x4 lo[4], hh[4];
#pragma unroll
                for (int ks = 0; ks < 4; ++ks) { lo[ks] = vtr(vb + (16 * ks) * CA_KSTR + d0 * 64); hh[ks] = vtr(vb + (16 * ks + 4) * CA_KSTR + d0 * 64); }
#define PK(k) (bf16x8){lo[k][0], lo[k][1], lo[k][2], lo[k][3], hh[k][0], hh[k][1], hh[k][2], hh[k][3]}
                o[d0] = __builtin_amdgcn_mfma_f32_32x32x16_bf16(pa0, PK(0), o[d0], 0, 0, 0);
                o[d0] = __builtin_amdgcn_mfma_f32_32x32x16_bf16(pa1, PK(1), o[d0], 0, 0, 0);
                o[d0] = __builtin_amdgcn_mfma_f32_32x32x16_bf16(pa2, PK(2), o[d0], 0, 0, 0);
                o[d0] = __builtin_amdgcn_mfma_f32_32x32x16_bf16(pa3, PK(3), o[d0], 0, 0, 0);
#undef PK
            }
        }
        if (kc < kc1) { *(LAS v4u*)(lds + (buf ^ 1) * 2 * CA_TBUF + skey * CA_KSTR + sch * 16) = stk; *(LAS v4u*)(lds + (buf ^ 1) * 2 * CA_TBUF + CA_TBUF + skey * CA_KSTR + sch * 16) = stv; }
        __syncthreads();
    }
    if (hi == 0) scr[r32] = l_reg; LDS_WAIT();
    bf16* ob = OC + qrow0 * 512 + h * 64 + r32;
#pragma unroll
    for (int r = 0; r < 16; ++r) { const int orow = crow(r, hi); const float rl = __builtin_amdgcn_rcpf(scr[orow]);
        ob[(size_t)orow * 512] = (bf16)f2bf(o[0][r] * rl); ob[(size_t)orow * 512 + 32] = (bf16)f2bf(o[1][r] * rl); }
    __syncthreads();
}
}
struct Args { const float* in[30]; float* out; unsigned char* ws; int start; int stop; };
#define KAS __attribute__((address_space(4)))
__device__ __forceinline__ const KAS unsigned char* kbase() { const KAS unsigned char* p = (const KAS unsigned char*)__builtin_amdgcn_kernarg_segment_ptr(); asm volatile("" : "+s"(p)); return p; }
__device__ __forceinline__ const float* kin(int i) { return *(const float* const KAS*)(kbase() + 8 * i); }
__device__ __forceinline__ float* kout() { return *(float* const KAS*)(kbase() + 240); }
__device__ __forceinline__ unsigned char* kws() { return *(unsigned char* const KAS*)(kbase() + 248); }
__device__ __forceinline__ int kstart() { return *(const int KAS*)(kbase() + 256); }
__device__ __forceinline__ int kstop() { return *(const int KAS*)(kbase() + 260); }
struct Frame { LAS unsigned char* lds; int tid, lane, wave, G, gw, NGW; };
__device__ __forceinline__ Frame make_frame(LAS unsigned char* lds) {
    Frame F; int tid = threadIdx.x; asm volatile("" : "+v"(tid)); int bx = blockIdx.x; asm volatile("" : "+s"(bx)); int G = gridDim.x; asm volatile("" : "+s"(G));
    F.lds = lds; F.tid = tid; F.lane = tid & 63; F.wave = __builtin_amdgcn_readfirstlane(tid >> 6); F.G = G; F.gw = bx * NWAVES + F.wave; F.NGW = G * NWAVES; return F;
}

__device__ const double ROPE_INV_FREQ[32] = {1, 0.74989420933245587, 0.56234132519034907, 0.42169650342858223, 0.31622776601683794, 0.23713737056616552, 0.17782794100389229, 0.1333521432163324, 0.10000000000000001, 0.074989420933245579, 0.056234132519034911, 0.042169650342858224, 0.031622776601683791, 0.023713737056616554, 0.017782794100389229, 0.013335214321633241, 0.01, 0.0074989420933245579, 0.005623413251903491, 0.0042169650342858229, 0.0031622776601683794, 0.0023713737056616554, 0.0017782794100389228, 0.0013335214321633241, 0.001, 0.00074989420933245586, 0.0005623413251903491, 0.00042169650342858224, 0.00031622776601683794, 0.00023713737056616554, 0.00017782794100389227, 0.0001333521432163324};
__device__ __forceinline__ void sincos_d(double a, float& s, float& c) {
    const double n = rint(a * 0.63661977236758134308);
    double r = fma(-n, 1.5707963267948966192, a); r = fma(-n, 6.123233995736766036e-17, r);
    const double r2 = r * r;
    double sp = -7.6471637318198164759e-13; sp = fma(sp, r2, 1.6059043836821614599e-10); sp = fma(sp, r2, -2.5052108385441718775e-08); sp = fma(sp, r2, 2.7557319223985890653e-06);
    sp = fma(sp, r2, -1.9841269841269841270e-04); sp = fma(sp, r2, 8.3333333333333333333e-03); sp = fma(sp, r2, -1.6666666666666666667e-01);
    const double sn = fma(sp * r2, r, r);
    double cp = 4.7794773323873852974e-14; cp = fma(cp, r2, -1.1470745597729724714e-11); cp = fma(cp, r2, 2.0876756987868098979e-09); cp = fma(cp, r2, -2.7557319223985890653e-07);
    cp = fma(cp, r2, 2.4801587301587301587e-05); cp = fma(cp, r2, -1.3888888888888888889e-03); cp = fma(cp, r2, 4.1666666666666666667e-02); cp = fma(cp, r2, -0.5);
    const double cs = fma(cp, r2, 1.0);
    const long long q = (long long)n & 3LL; double so, co;
    if (q == 0) { so = sn; co = cs; } else if (q == 1) { so = cs; co = -sn; } else if (q == 2) { so = -sn; co = -cs; } else { so = -cs; co = sn; }
    s = (float)so; c = (float)co;
}
__device__ __forceinline__ void transpose_item(const float* W, int ldw, int col0, int nblk, bf16* WT, int ldt, int row0, LAS float* scr, int item, int lane) {
    const int kb = item / nblk, nb = item % nblk, k0 = 64 * kb, n0 = 32 * nb;
#pragma unroll 8
    for (int i = 0; i < 32; ++i) { const int kk = 2 * i + (lane >> 5); scr[kk * 33 + (lane & 31)] = W[(size_t)(k0 + kk) * ldw + col0 + n0 + (lane & 31)]; }
    LDS_WAIT(); asm volatile("" ::: "memory");
    const int c = lane & 7;
#pragma unroll
    for (int j = 0; j < 4; ++j) { const int n = (lane >> 3) + 8 * j; const LAS float* s = scr + (8 * c) * 33 + n;
        v4u o; o.x = pk2(s[0 * 33], s[1 * 33]); o.y = pk2(s[2 * 33], s[3 * 33]); o.z = pk2(s[4 * 33], s[5 * 33]); o.w = pk2(s[6 * 33], s[7 * 33]);
        *(GAS v4u*)(WT + (size_t)(row0 + n0 + n) * ldt + k0 + 8 * c) = o; }
    LDS_WAIT(); asm volatile("" ::: "memory");
}
__device__ __forceinline__ void rope_table(LAS unsigned char* lds_) {
    const Frame F = make_frame(lds_); const int gt = F.gw * 64 + F.lane, NTH = F.NGW * 64;
    const int* pos = (const int*)kin(2); float* rope = (float*)(kws() + WS_ROPE);
    for (int i = gt; i < T * 32; i += NTH) { float s, c; sincos_d((double)pos[i >> 5] * ROPE_INV_FREQ[i & 31], s, c); rope[2 * (size_t)i] = c; rope[2 * (size_t)i + 1] = s; }
}
__device__ __forceinline__ void p0_prologue(LAS unsigned char* lds_, const Args& A, int l) {
    const Frame F = make_frame(lds_);
    LAS float* scr = (LAS float*)(F.lds + RING_OFF + F.wave * 16384);
    constexpr int I1 = 16 * 14, I2 = 16 * 48, I3 = 16 * 56, I4 = 16 * 96, I5 = 8 * 32, I6 = 8 * 32, I7 = 16 * 32, I8 = 16 * 128, I9 = 64 * 32, I10 = 16 * 32, I11 = 4 * 32;
    constexpr int NITEMS = I1 + I2 + I3 + I4 + I5 + I6 + I7 + I8 + I9 + I10 + I11;
#define WIN_ (kin(4) + (size_t)l * 1024 * IN_COLS)
#define WBR_ (kin(21) + (size_t)l * 1536 * 1024)
    for (int it = F.gw; it < NITEMS; it += F.NGW) {
        int r = it;
        if (r < I1) { transpose_item(WIN_, IN_COLS, 0, 14, (bf16*)(kws() + W_IN), 1024, 0, scr, r, F.lane); continue; } r -= I1;
        if (r < I2) { transpose_item(WIN_, IN_COLS, 2240, 48, (bf16*)(kws() + W_IN), 1024, 512, scr, r, F.lane); continue; } r -= I2;
        if (r < I3) { transpose_item(WIN_, IN_COLS, 448, 56, (bf16*)(kws() + W_IN), 1024, 2048, scr, r, F.lane); continue; } r -= I3;
        if (r < I4) { transpose_item(WIN_, IN_COLS, 3776, 96, (bf16*)(kws() + W_IN), 1024, 3840, scr, r, F.lane); continue; } r -= I4;
        if (r < I5) { transpose_item(WBR_ + (size_t)512 * 1024, 1024, 0, 32, (bf16*)(kws() + W_B) + (size_t)1024 * 512, 512, 0, scr, r, F.lane); continue; } r -= I5;
        if (r < I6) { transpose_item(WBR_ + (size_t)1024 * 1024, 1024, 0, 32, (bf16*)(kws() + W_B) + (size_t)2 * 1024 * 512, 512, 0, scr, r, F.lane); continue; } r -= I6;
        if (r < I7) { transpose_item(kin(22) + (size_t)l * 1024 * 1024, 1024, 0, 32, (bf16*)(kws() + W_OUT), 1024, 0, scr, r, F.lane); continue; } r -= I7;
        if (r < I8) { transpose_item(kin(25) + (size_t)l * 1024 * 4096, 4096, 0, 128, (bf16*)(kws() + W_1), 1024, 0, scr, r, F.lane); continue; } r -= I8;
        if (r < I9) { transpose_item(kin(26) + (size_t)l * 4096 * 1024, 1024, 0, 32, (bf16*)(kws() + W_2), 4096, 0, scr, r, F.lane); continue; } r -= I9;
        if (r < I10) { transpose_item(kin(28) + (size_t)l * 1024 * 1024, 1024, 0, 32, (bf16*)(kws() + W_G), 1024, 0, scr, r, F.lane); continue; } r -= I10;
        transpose_item(kin(29) + (size_t)l * 256 * 1024, 1024, 0, 32, (bf16*)(kws() + W_P), 256, 0, scr, r, F.lane);
    }
    const int gt = F.gw * 64 + F.lane, NTH = F.NGW * 64;
    { bf16* WinT = (bf16*)(kws() + W_IN); for (int i = gt; i < 64 * 1024; i += NTH) WinT[(size_t)448 * 1024 + i] = 0; }
    { const float* w_uq = kin(7) + (size_t)l * 256 * 768; const float* w_ukv = kin(8) + (size_t)l * 128 * 1024; bf16* WqT = (bf16*)(kws() + W_Q);
      for (int i = gt; i < 768 * 256; i += NTH) {
        const int n = i >> 8, kq = i & 255, h = n / 192, ii = n % 192; float s;
        if (ii < 128) { s = 0.f; const float* a = w_uq + (size_t)kq * 768 + h * 192; const float* b = w_ukv + (size_t)ii * 1024 + h * 256;
            for (int nn = 0; nn < 128; ++nn) s = fmaf(a[nn], b[nn], s); }
        else { const int jj = ii - 128, j = jj >> 1; s = w_uq[(size_t)kq * 768 + h * 192 + 128 + ((jj & 1) ? j + 32 : j)]; }
        WqT[i] = (bf16)f2bf(s);
      } }
    { const float* w_ukv = kin(8) + (size_t)l * 128 * 1024; const float* w_br = WBR_; bf16* WbT = (bf16*)(kws() + W_B);
      for (int i = gt; i < 512 * 1024; i += NTH) {
        const int dd = i & 1023, hl = i >> 10, h = hl >> 7, lat = hl & 127; float s = 0.f;
        const float* a = w_ukv + (size_t)lat * 1024 + h * 256 + 128; const float* b = w_br + (size_t)(h * 128) * 1024 + dd;
        for (int v = 0; v < 128; ++v) s = fmaf(a[v], b[(size_t)v * 1024], s);
        WbT[(size_t)dd * 512 + hl] = (bf16)f2bf(s);
      } }
    { const float* w_up = kin(11) + (size_t)l * 64 * 512; const float* a_up = kin(13) + (size_t)l * 64 * 512; const float* g_up = kin(14) + (size_t)l * 128 * 512; bf16* WloT = (bf16*)(kws() + W_LORA);
      for (int i = gt; i < 1536 * 256; i += NTH) {
        const int n = i >> 8, k = i & 255, blk = n >> 9, nn = n & 511; float s = 0.f;
        if (blk == 0) { if (k < 64) s = w_up[(size_t)k * 512 + nn]; } else if (blk == 1) { if (k >= 64 && k < 128) s = a_up[(size_t)(k - 64) * 512 + nn]; } else { if (k >= 128) s = g_up[(size_t)(k - 128) * 512 + nn]; }
        WloT[i] = (bf16)f2bf(s);
      } }
#undef WIN_
#undef WBR_
}
__device__ __forceinline__ void u_rowpass(LAS unsigned char* lds_, int l, bool from_x) {
    const Frame F = make_frame(lds_); unsigned char* ws = kws();
    const float* src = from_x ? kin(0) : kout(); const float* g = kin(3) + l * 1024; bf16* U = (bf16*)(ws + WS_U);
    f32x4 gv[4];
#pragma unroll
    for (int j = 0; j < 4; ++j) gv[j] = *(const f32x4*)(g + 4 * F.lane + 256 * j);
    for (int m = F.gw; m < T; m += F.NGW) {
        const f32x4* xr = (const f32x4*)(src + (size_t)m * D) + F.lane; f32x4 v[4]; float s = 0.f;
#pragma unroll
        for (int j = 0; j < 4; ++j) { v[j] = xr[64 * j]; s += (v[j].x * v[j].x + v[j].y * v[j].y) + (v[j].z * v[j].z + v[j].w * v[j].w); }
        if (from_x) { f32x4* ho = (f32x4*)(kout() + (size_t)m * D) + F.lane;
#pragma unroll
            for (int j = 0; j < 4; ++j) ho[64 * j] = v[j]; }
        const float rs = rsqrtf(wave_sum(s, F.lane) * (1.f / D) + NORM_EPS);
        v2u* o8 = (v2u*)(U + (size_t)m * D) + F.lane;
#pragma unroll
        for (int j = 0; j < 4; ++j) { const f32x4 y = v[j] * rs * gv[j]; v2u w; w.x = pk2(y.x, y.y); w.y = pk2(y.z, y.w); o8[64 * j] = w; }
    }
}
__device__ __forceinline__ void p2_mla_prep(LAS unsigned char* lds_, const Args& A, int l) {
    const Frame F = make_frame(lds_);
    const bf16* ZM = (const bf16*)(kws() + WS_OA); bf16* QN = (bf16*)(kws() + X_QN); bf16* KV = (bf16*)(kws() + X_KV); const float* rope = (const float*)(kws() + WS_ROPE);
    const f32x4 gq = *(const f32x4*)(kin(5) + l * 256 + 4 * F.lane); const float gk0 = kin(6)[l * 128 + 2 * F.lane], gk1 = kin(6)[l * 128 + 2 * F.lane + 1];
    for (int t = F.gw; t < T; t += F.NGW) {
        const bf16* z = ZM + (size_t)t * 512;
        const v2u wq = *(const v2u*)(z + 4 * F.lane); const unsigned wk = *(const unsigned*)(z + 256 + 2 * F.lane); const float kr = bfl((unsigned)z[384 + F.lane]);
        const float q0 = bfl(wq.x), q1 = bfh(wq.x), q2 = bfl(wq.y), q3 = bfh(wq.y), k0 = bfl(wk), k1 = bfh(wk);
        const float rq = rsqrtf(wave_sum(q0 * q0 + q1 * q1 + q2 * q2 + q3 * q3, F.lane) * (1.f / 256.f) + NORM_EPS);
        const float rk = rsqrtf(wave_sum(k0 * k0 + k1 * k1, F.lane) * (1.f / 128.f) + NORM_EPS);
        v2u o; o.x = pk2(q0 * rq * gq.x, q1 * rq * gq.y); o.y = pk2(q2 * rq * gq.z, q3 * rq * gq.w);
        *(v2u*)(QN + (size_t)t * 256 + 4 * F.lane) = o;
        *(unsigned*)(KV + (size_t)t * 192 + 2 * F.lane) = pk2(k0 * rk * gk0, k1 * rk * gk1);
        const float other = shfl_xor_f(kr, 32, F.lane);
        if (F.lane < 32) { const float c = rope[((size_t)t * 32 + F.lane) * 2], s = rope[((size_t)t * 32 + F.lane) * 2 + 1];
            *(unsigned*)(KV + (size_t)t * 192 + 128 + 2 * F.lane) = pk2(kr * c - other * s, other * c + kr * s); }
    }
}
__device__ __forceinline__ void p6_rw_prep(LAS unsigned char* lds_, const Args& A, int l) {
    const Frame F = make_frame(lds_);
    const bf16* ZR = (const bf16*)(kws() + X_ZR); bf16* LA = (bf16*)(kws() + X_LA);
    const f32x4 mu = *(const f32x4*)(kin(9) + l * RW_COLS + 1536 + 4 * F.lane);
    for (int t = F.gw; t < T; t += F.NGW) {
        const v2u wc = *(const v2u*)(ZR + (size_t)t * 1792 + 1536 + 4 * F.lane); v2u wp; wp.x = 0u; wp.y = 0u;
        if ((t & (SEQ - 1)) != 0) wp = *(const v2u*)(ZR + (size_t)(t - 1) * 1792 + 1536 + 4 * F.lane);
        float z[4] = {bfl(wc.x), bfh(wc.x), bfl(wc.y), bfh(wc.y)}; const float p[4] = {bfl(wp.x), bfh(wp.x), bfl(wp.y), bfh(wp.y)}; const float m[4] = {mu.x, mu.y, mu.z, mu.w};
#pragma unroll
        for (int e = 0; e < 4; ++e) { float v = z[e] + (p[e] - z[e]) * m[e]; if (F.lane < 16) v = 1.f - 2.f * __builtin_amdgcn_rcpf(1.f + __builtin_amdgcn_exp2f(2.f * LOG2E * v)); else if (F.lane >= 32) v = fsig(v); z[e] = v; }
        v2u o; o.x = pk2(z[0], z[1]); o.y = pk2(z[2], z[3]); *(v2u*)(LA + (size_t)t * 256 + 4 * F.lane) = o;
    }
}
template <int MODE>
__device__ __forceinline__ void rowpass(LAS unsigned char* lds_, const Args& A, const bf16* M, const float* g1, const float* g2, const float* pl) {
    const Frame F = make_frame(lds_);
    bf16* U = (bf16*)(kws() + WS_U); bf16* PB = (bf16*)(kws() + X_PB);
    f32x4 g1v[4], g2v[4];
#pragma unroll
    for (int j = 0; j < 4; ++j) { g1v[j] = *(const f32x4*)(g1 + 4 * F.lane + 256 * j); if (MODE == 0) g2v[j] = *(const f32x4*)(g2 + 4 * F.lane + 256 * j); }
    for (int m = F.gw; m < T; m += F.NGW) {
        const v2u* mr = (const v2u*)(M + (size_t)m * D) + F.lane; f32x4* hr = (f32x4*)(kout() + (size_t)m * D) + F.lane;
        f32x4 x[4], hv[4]; float s = 0.f;
#pragma unroll
        for (int j = 0; j < 4; ++j) { const v2u w = mr[64 * j]; x[j] = (f32x4){bfl(w.x), bfh(w.x), bfl(w.y), bfh(w.y)}; hv[j] = hr[64 * j]; s += (x[j].x * x[j].x + x[j].y * x[j].y) + (x[j].z * x[j].z + x[j].w * x[j].w); }
        const float rs = rsqrtf(wave_sum(s, F.lane) * (1.f / D) + NORM_EPS); float s2 = 0.f;
#pragma unroll
        for (int j = 0; j < 4; ++j) { hv[j] = hv[j] + x[j] * rs * g1v[j]; hr[64 * j] = hv[j]; s2 += (hv[j].x * hv[j].x + hv[j].y * hv[j].y) + (hv[j].z * hv[j].z + hv[j].w * hv[j].w); }
        v2u* o8 = (v2u*)(U + (size_t)m * D) + F.lane;
        if (MODE == 0) { const float rs2 = rsqrtf(wave_sum(s2, F.lane) * (1.f / D) + NORM_EPS);
#pragma unroll
            for (int j = 0; j < 4; ++j) { const f32x4 y = hv[j] * rs2 * g2v[j]; v2u w; w.x = pk2(y.x, y.y); w.y = pk2(y.z, y.w); o8[64 * j] = w; } }
        else {
#pragma unroll
            for (int j = 0; j < 4; ++j) { v2u w; w.x = pk2(hv[j].x, hv[j].y); w.y = pk2(hv[j].z, hv[j].w); o8[64 * j] = w; }
            const f32x4 pv = *((const f32x4*)(pl + (size_t)m * DPLE) + F.lane); v2u w; w.x = pk2(pv.x, pv.y); w.y = pk2(pv.z, pv.w); *((v2u*)(PB + (size_t)m * DPLE) + F.lane) = w; }
    }
}
namespace rw {
typedef short v4i16_t __attribute__((ext_vector_type(4)));
constexpr int RS = 144;
constexpr int O_AT = 0, O_BT = 9216, O_KT = 18432, O_RT = 27648;
constexpr int O_UV = 36864;
constexpr int O_BK = O_UV + 4 * 32 * RS;
constexpr int O_SB = O_BK + 4 * 32 * RS;
constexpr int O_RHS = O_SB + 64 * RS;
constexpr int O_SM = O_RHS + 32 * RS;
constexpr int O_GC = O_SM + 16 * 1024;
constexpr int O_CB = O_GC + 1024;
constexpr int O_LW = O_CB + 256;
constexpr int O_PAR = O_LW + 16384;
constexpr int LDS_END = O_PAR + 10 * 256;
static_assert(LDS_END <= RING_BYTES, "rwkv LDS map");
__device__ __forceinline__ bf16x8 trfrag(const LAS unsigned char* p) {
    const s16x4 lo = __builtin_bit_cast(s16x4, __builtin_amdgcn_ds_read_tr16_b64_v4i16((LAS v4i16_t*)p));
    const s16x4 hh = __builtin_bit_cast(s16x4, __builtin_amdgcn_ds_read_tr16_b64_v4i16((LAS v4i16_t*)(p + 4 * RS)));
    return (bf16x8){lo[0], lo[1], lo[2], lo[3], hh[0], hh[1], hh[2], hh[3]};
}
__device__ __forceinline__ void st_bf(LAS unsigned char* p, float x) { *(LAS unsigned short*)p = (unsigned short)f2bf(x); }
__device__ __forceinline__ void rw_unit(LAS unsigned char* lds, int l, int seq) {
    int tid_ = threadIdx.x; asm volatile("" : "+v"(tid_));
    const int tid = tid_, lane = tid & 63, w = __builtin_amdgcn_readfirstlane(tid >> 6), g4 = lane >> 4, l15 = lane & 15, q4 = l15 >> 2, p4 = lane & 3;
    const int b = seq >> 3, h = seq & 7;
    const bf16* ZRb = (const bf16*)(kws() + X_ZR) + (size_t)b * SEQ * 1792 + h * 64; const bf16* TWb = (const bf16*)(kws() + X_TW) + (size_t)b * SEQ * 512 + h * 64; const bf16* TAb = (const bf16*)(kws() + X_TA) + (size_t)b * SEQ * 512 + h * 64; const bf16* Gb = (const bf16*)(kws() + X_G) + (size_t)b * SEQ * 512 + h * 64;
    bf16* ORWb = (bf16*)(kws() + WS_ORW) + (size_t)b * SEQ * 512 + h * 64;
    LAS float* par = (LAS float*)(lds + O_PAR);
    if (tid < 64) { const int c = h * 64 + tid;
        par[tid] = kin(9)[l * RW_COLS + c]; par[64 + tid] = kin(9)[l * RW_COLS + 512 + c]; par[128 + tid] = kin(9)[l * RW_COLS + 1024 + c];
        par[192 + tid] = kin(10)[l * 512 + c]; par[256 + tid] = kin(12)[l * 512 + c]; par[320 + tid] = kin(15)[l * 512 + c]; par[384 + tid] = kin(16)[l * 512 + c];
        par[448 + tid] = kin(17)[l * 512 + c]; par[512 + tid] = kin(18)[l * 512 + c]; par[576 + tid] = kin(19)[l * 512 + c]; }
    for (int i = tid; i < (O_GC - O_UV) / 4; i += 512) ((LAS unsigned*)(lds + O_UV))[i] = 0u;
    f32x4 Sacc[2] = {{0.f, 0.f, 0.f, 0.f}, {0.f, 0.f, 0.f, 0.f}};
    f32x4 ykeep = {0.f, 0.f, 0.f, 0.f};
    __syncthreads();
    const int et = tid >> 3, ecg = tid & 7, ei = et >> 4, ett = et & 15;
    const int trrow = 8 * g4 + q4, trrow1 = 8 * (g4 & 1) + q4, trcol = 8 * p4;
    for (int sc = 0; sc < SEQ / 64; ++sc) {
        const int tok0 = sc * 64;
        {   const bf16* zr = ZRb + (size_t)(tok0 + et) * 1792 + 8 * ecg; const size_t lo = (size_t)(tok0 + et) * 512 + 8 * ecg;
            float cr[8], ck[8], cv[8], pr[8], pk[8], pv[8], tw[8], ta[8];
            pg8::unpack8(*(const v4u*)(zr), cr); pg8::unpack8(*(const v4u*)(zr + 512), ck); pg8::unpack8(*(const v4u*)(zr + 1024), cv);
            pg8::unpack8(*(const v4u*)(TWb + lo), tw); pg8::unpack8(*(const v4u*)(TAb + lo), ta);
            if (tok0 + et > 0) { pg8::unpack8(*(const v4u*)(zr - 1792), pr); pg8::unpack8(*(const v4u*)(zr - 1792 + 512), pk); pg8::unpack8(*(const v4u*)(zr - 1792 + 1024), pv); }
            else { for (int e = 0; e < 8; ++e) { pr[e] = 0.f; pk[e] = 0.f; pv[e] = 0.f; } }
            float rr[8], kkv[8], kav[8], kmv[8], vv[8], lwv[8]; float ss = 0.f, cbp = 0.f;
#pragma unroll
            for (int e = 0; e < 8; ++e) { const int c = 8 * ecg + e;
                const float r = cr[e] + (pr[e] - cr[e]) * par[c], k = ck[e] + (pk[e] - ck[e]) * par[64 + c], v = cv[e] + (pv[e] - cv[e]) * par[128 + c];
                const float x = -(par[192 + c] + tw[e]); const float sp = fmaxf(x, 0.f) + 0.6931471805599453f * __builtin_amdgcn_logf(1.f + __builtin_amdgcn_exp2f(-LOG2E * fabsf(x)));
                lwv[e] = -__builtin_amdgcn_exp2f(LOG2E * (-sp - 0.5f));
                const float a = fsig(par[256 + c] + ta[e]);
                const float kk = k * par[320 + c]; ss += kk * kk;
                const float km = k * (1.f + (a - 1.f) * par[384 + c]);
                rr[e] = r; kkv[e] = kk; kav[e] = a; kmv[e] = km; vv[e] = v; cbp += r * km * par[448 + c]; }
            ss += shfl_xor_f(ss, 1, lane); ss += shfl_xor_f(ss, 2, lane); ss += shfl_xor_f(ss, 4, lane);
            cbp += shfl_xor_f(cbp, 1, lane); cbp += shfl_xor_f(cbp, 2, lane); cbp += shfl_xor_f(cbp, 4, lane);
            const float rn = rsqrtf(fmaxf(ss, 1e-24f));
            if (ecg == 0) ((LAS float*)(lds + O_CB))[et] = cbp;
            v4u wA, wB, wK, wR, wV;
#define PK8(dst, expr) do { float t_[8]; for (int e = 0; e < 8; ++e) { t_[e] = (expr); } dst.x = pk2(t_[0], t_[1]); dst.y = pk2(t_[2], t_[3]); dst.z = pk2(t_[4], t_[5]); dst.w = pk2(t_[6], t_[7]); } while (0)
            PK8(wA, -kkv[e] * rn); PK8(wB, kkv[e] * rn * kav[e]); PK8(wK, kmv[e]); PK8(wR, rr[e]); PK8(wV, vv[e]);
#undef PK8
            const int ro = et * RS + 16 * ecg;
            *(LAS v4u*)(lds + O_AT + ro) = wA; *(LAS v4u*)(lds + O_BT + ro) = wB; *(LAS v4u*)(lds + O_KT + ro) = wK; *(LAS v4u*)(lds + O_RT + ro) = wR;
            *(LAS v4u*)(lds + O_BK + (ei * 32 + ett) * RS + 16 * ecg) = wB; *(LAS v4u*)(lds + O_BK + (ei * 32 + 16 + ett) * RS + 16 * ecg) = wK;
            *(LAS v4u*)(lds + O_UV + (ei * 32 + 16 + ett) * RS + 16 * ecg) = wV;
            LAS float* lwp = (LAS float*)(lds + O_LW) + et * 64 + 8 * ecg;
            *(LAS f32x4*)lwp = (f32x4){lwv[0], lwv[1], lwv[2], lwv[3]}; *(LAS f32x4*)(lwp + 4) = (f32x4){lwv[4], lwv[5], lwv[6], lwv[7]};
        }
        __syncthreads();
        {   const int c = lane, i = w & 3, hf = w >> 2; const LAS float* lwc = (const LAS float*)(lds + O_LW) + (16 * i) * 64 + c;
            float cum[16]; float run = 0.f;
#pragma unroll
            for (int t = 0; t < 16; ++t) { run += lwc[t * 64]; cum[t] = run; }
            const float tot = run;
            if (hf == 0) ((LAS float*)(lds + O_GC))[i * 64 + c] = __builtin_amdgcn_exp2f(LOG2E * tot);
#pragma unroll
            for (int tt = 0; tt < 8; ++tt) { const int t = 8 * hf + tt; const float cu = hf ? cum[8 + tt] : cum[tt]; const float cprev = (t == 0) ? 0.f : (hf ? cum[7 + tt] : (tt ? cum[tt - 1] : 0.f));
                const float gg = __builtin_amdgcn_exp2f(LOG2E * cu), gp = __builtin_amdgcn_exp2f(LOG2E * cprev), gi = __builtin_amdgcn_exp2f(-LOG2E * cu), gh = __builtin_amdgcn_exp2f(LOG2E * (tot - cu));
                const int ro = (16 * i + t) * RS + 2 * c;
                LAS unsigned short* pa = (LAS unsigned short*)(lds + O_AT + ro); *pa = (unsigned short)f2bf(bfl((unsigned)*pa) * gp);
                LAS unsigned short* pb = (LAS unsigned short*)(lds + O_BT + ro); *pb = (unsigned short)f2bf(bfl((unsigned)*pb) * gi);
                LAS unsigned short* pk = (LAS unsigned short*)(lds + O_KT + ro); *pk = (unsigned short)f2bf(bfl((unsigned)*pk) * gi);
                LAS unsigned short* pr2 = (LAS unsigned short*)(lds + O_RT + ro); *pr2 = (unsigned short)f2bf(bfl((unsigned)*pr2) * gg);
                LAS unsigned short* pbh = (LAS unsigned short*)(lds + O_BK + (i * 32 + t) * RS + 2 * c); *pbh = (unsigned short)f2bf(bfl((unsigned)*pbh) * gh);
                LAS unsigned short* pkh = (LAS unsigned short*)(lds + O_BK + (i * 32 + 16 + t) * RS + 2 * c); *pkh = (unsigned short)f2bf(bfl((unsigned)*pkh) * gh); }
        }
        __syncthreads();
        {   const int i = w & 3, hf = w >> 2;
            const LAS unsigned char* xa = lds + (hf ? O_RT : O_AT) + (16 * i + l15) * RS + 16 * g4;
            const LAS unsigned char* xb = lds + O_BT + (16 * i + l15) * RS + 16 * g4; const LAS unsigned char* xk = lds + O_KT + (16 * i + l15) * RS + 16 * g4;
            f32x4 c1 = {0.f, 0.f, 0.f, 0.f}, c2 = {0.f, 0.f, 0.f, 0.f};
#pragma unroll
            for (int ks = 0; ks < 2; ++ks) { const bf16x8 a = *(const LAS bf16x8*)(xa + 64 * ks);
                c1 = __builtin_amdgcn_mfma_f32_16x16x32_bf16(a, *(const LAS bf16x8*)(xb + 64 * ks), c1, 0, 0, 0);
                c2 = __builtin_amdgcn_mfma_f32_16x16x32_bf16(a, *(const LAS bf16x8*)(xk + 64 * ks), c2, 0, 0, 0); }
#pragma unroll
            for (int r = 0; r < 4; ++r) { const int t = 4 * g4 + r; const bool keep = hf ? (l15 <= t) : (l15 < t); const float v1 = keep ? c1[r] : 0.f, v2 = keep ? c2[r] : 0.f;
                if (hf == 0) { ((LAS float*)(lds + O_LW))[(i * 16 + t) * 16 + l15] = v1; st_bf(lds + O_SM + (4 + i) * 1024 + t * 64 + 2 * l15, v2); }
                else { st_bf(lds + O_SM + (8 + i) * 1024 + t * 64 + 2 * l15, v1); st_bf(lds + O_SM + (12 + i) * 1024 + t * 64 + 2 * l15, v2); } }
        }
        __syncthreads();
        if (w < 4 && lane < 16) { const LAS float* Lm = (const LAS float*)(lds + O_LW) + w * 256; float x[16];
#pragma unroll
            for (int t = 0; t < 16; ++t) { float s = (t == lane) ? 1.f : 0.f;
#pragma unroll
                for (int s2 = 0; s2 < 16; ++s2) if (s2 < t) s = fmaf(Lm[t * 16 + s2], x[s2], s);
                x[t] = s; st_bf(lds + O_SM + w * 1024 + t * 64 + 2 * lane, s); } }
        __syncthreads();
#pragma unroll 1
        for (int i = 0; i < 4; ++i) {
            {
                const int which = w >> 2, v0 = 16 * (w & 3); f32x4 acc = {0.f, 0.f, 0.f, 0.f};
                const bf16x8 am = *(const LAS bf16x8*)(lds + O_SM + ((which ? 12 : 4) + i) * 1024 + l15 * 64 + 16 * g4);
                acc = __builtin_amdgcn_mfma_f32_16x16x32_bf16(am, trfrag(lds + O_UV + (i * 32 + 16 + trrow1) * RS + 2 * v0 + trcol), acc, 0, 0, 0);
                const LAS unsigned char* xa = lds + (which ? O_RT : O_AT) + (16 * i + l15) * RS + 16 * g4; const LAS unsigned char* sb = lds + O_SB + (v0 + l15) * RS + 16 * g4;
#pragma unroll
                for (int ks = 0; ks < 2; ++ks) acc = __builtin_amdgcn_mfma_f32_16x16x32_bf16(*(const LAS bf16x8*)(xa + 64 * ks), *(const LAS bf16x8*)(sb + 64 * ks), acc, 0, 0, 0);
                if (which == 0) {
#pragma unroll
                    for (int r = 0; r < 4; ++r) st_bf(lds + O_RHS + (4 * g4 + r) * RS + 2 * (v0 + l15), acc[r]); }
                else ykeep = acc;
            }
            __syncthreads();
            if (w < 4) {
                const int v0 = 16 * w; f32x4 acc = {0.f, 0.f, 0.f, 0.f};
                const bf16x8 tm = *(const LAS bf16x8*)(lds + O_SM + i * 1024 + l15 * 64 + 16 * g4);
                acc = __builtin_amdgcn_mfma_f32_16x16x32_bf16(tm, trfrag(lds + O_RHS + trrow1 * RS + 2 * v0 + trcol), acc, 0, 0, 0);
#pragma unroll
                for (int r = 0; r < 4; ++r) st_bf(lds + O_UV + (i * 32 + 4 * g4 + r) * RS + 2 * (v0 + l15), acc[r]);
            }
            __syncthreads();
            {
                if (w >= 4) { const int v0 = 16 * (w & 3);
                    const bf16x8 am = *(const LAS bf16x8*)(lds + O_SM + (8 + i) * 1024 + l15 * 64 + 16 * g4);
                    const f32x4 y = __builtin_amdgcn_mfma_f32_16x16x32_bf16(am, trfrag(lds + O_UV + (i * 32 + trrow1) * RS + 2 * v0 + trcol), ykeep, 0, 0, 0);
#pragma unroll
                    for (int r = 0; r < 4; ++r) st_bf(lds + O_LW + 4096 + (16 * i + 4 * g4 + r) * RS + 2 * (v0 + l15), y[r]); }
#pragma unroll
                for (int j = 0; j < 2; ++j) { const int id = 2 * w + j, vt = id >> 2, kt = id & 3;
                    const float gc = ((const LAS float*)(lds + O_GC))[i * 64 + 16 * kt + l15];
                    f32x4 acc = Sacc[j] * gc;
                    acc = __builtin_amdgcn_mfma_f32_16x16x32_bf16(trfrag(lds + O_UV + (i * 32 + trrow) * RS + 32 * vt + trcol), trfrag(lds + O_BK + (i * 32 + trrow) * RS + 32 * kt + trcol), acc, 0, 0, 0);
                    Sacc[j] = acc;
#pragma unroll
                    for (int r = 0; r < 4; ++r) st_bf(lds + O_SB + (16 * vt + 4 * g4 + r) * RS + 2 * (16 * kt + l15), acc[r]); }
            }
            __syncthreads();
        }
        {   float y[8], vv[8], gg[8];
            pg8::unpack8(*(const LAS v4u*)(lds + O_LW + 4096 + et * RS + 16 * ecg), y); pg8::unpack8(*(const LAS v4u*)(lds + O_UV + (ei * 32 + 16 + ett) * RS + 16 * ecg), vv);
            pg8::unpack8(*(const v4u*)(Gb + (size_t)(tok0 + et) * 512 + 8 * ecg), gg);
            float s = 0.f;
#pragma unroll
            for (int e = 0; e < 8; ++e) s += y[e];
            s += shfl_xor_f(s, 1, lane); s += shfl_xor_f(s, 2, lane); s += shfl_xor_f(s, 4, lane);
            const float mean = s * (1.f / 64.f); float q = 0.f;
#pragma unroll
            for (int e = 0; e < 8; ++e) { y[e] -= mean; q += y[e] * y[e]; }
            q += shfl_xor_f(q, 1, lane); q += shfl_xor_f(q, 2, lane); q += shfl_xor_f(q, 4, lane);
            const float rstd = rsqrtf(q * (1.f / 64.f) + RW_LN_EPS), cb = ((const LAS float*)(lds + O_CB))[et];
            float o[8];
#pragma unroll
            for (int e = 0; e < 8; ++e) { const int c = 8 * ecg + e; o[e] = (y[e] * rstd * par[512 + c] + par[576 + c] + cb * vv[e]) * gg[e]; }
            v4u wo; wo.x = pk2(o[0], o[1]); wo.y = pk2(o[2], o[3]); wo.z = pk2(o[4], o[5]); wo.w = pk2(o[6], o[7]);
            *(v4u*)(ORWb + (size_t)(tok0 + et) * 512 + 8 * ecg) = wo;
        }
        __syncthreads();
    }
}
}
#ifndef PROBE_DBL
#define PROBE_DBL -1
#endif
__global__ void __launch_bounds__(NWAVES * 64, 2) mk_fwd(Args args) {
    extern __shared__ __attribute__((aligned(16))) unsigned char lds[];
    LAS unsigned char* const L = (LAS unsigned char*)lds;
    for (int u = threadIdx.x; u < (LDS_BYTES - LDSCTL_OFF) / 4; u += NWAVES * 64) ((LAS unsigned*)(L + LDSCTL_OFF))[u] = 0u;
    __syncthreads();
    XcdBarrier bar = xcd_barrier_post((unsigned*)(kws() + WS_CTL) + CW_BAR, (volatile LAS unsigned*)(L + MISC_OFF) + 8);
#define GRID_BAR() xcd_barrier(bar)
#if defined(DBG_BISECT)
#define IN(k) (l > 0 || ((k) >= kstart() && (k) <= kstop()) || ((k) == 9 && kstop() == 99))
#define LAYER_END() do { if (kstop() < 100) return; } while (0)
#else
#define IN(k) true
#define LAYER_END() do { } while (0)
#endif
#define PTRS() unsigned char* ws = opq(kws()); \
    bf16* U = (bf16*)(ws + WS_U); bf16* OA = (bf16*)(ws + WS_OA); bf16* OC = (bf16*)(ws + WS_OC); bf16* ORW = (bf16*)(ws + WS_ORW); \
    bf16* WinT = (bf16*)(ws + W_IN); bf16* WqT = (bf16*)(ws + W_Q); bf16* WloT = (bf16*)(ws + W_LORA); bf16* WbT = (bf16*)(ws + W_B); bf16* WoT = (bf16*)(ws + W_OUT); \
    bf16* W1T = (bf16*)(ws + W_1); bf16* W2T = (bf16*)(ws + W_2); bf16* WgT = (bf16*)(ws + W_G); bf16* WpT = (bf16*)(ws + W_P); \
    bf16* ZC = (bf16*)(ws + X_ZC); bf16* QN = (bf16*)(ws + X_QN); bf16* QP = (bf16*)(ws + X_QP); bf16* KV = (bf16*)(ws + X_KV); \
    bf16* ZR = (bf16*)(ws + X_ZR); bf16* LA = (bf16*)(ws + X_LA); bf16* TW = (bf16*)(ws + X_TW); bf16* TA = (bf16*)(ws + X_TA); bf16* GG = (bf16*)(ws + X_G); \
    bf16* GT = (bf16*)(ws + X_GT); bf16* MG = (bf16*)(ws + X_MG); bf16* HID = (bf16*)(ws + X_HID); bf16* PB = (bf16*)(ws + X_PB); bf16* PP = (bf16*)(ws + X_PP); bf16* M2 = OA; \
    (void)U; (void)OA; (void)OC; (void)ORW; (void)WinT; (void)WqT; (void)WloT; (void)WbT; (void)WoT; (void)W1T; (void)W2T; (void)WgT; (void)WpT; (void)ZC; (void)QN; (void)QP; (void)KV; (void)ZR; (void)LA; (void)TW; (void)TA; (void)GG; (void)GT; (void)MG; (void)HID; (void)PB; (void)PP; (void)M2;
    typedef pg8::StaticOrder SO;
#define GEMM(EPI, Aptr, Bptr, N_, K_, Eobj) do { int bx_ = blockIdx.x; asm volatile("" : "+s"(bx_)); int G_ = gridDim.x; asm volatile("" : "+s"(G_)); pg8::Gemm g_{Aptr, Bptr, T, N_, K_}; SO S_; S_.init(T, N_, G_, bx_); pg8::gemm_phase<EPI, SO, true, true>(L + RING_OFF, g_, S_, Eobj); } while (0)
#define PH(n) for (int rep_ = 0; rep_ < ((PROBE_DBL == (n)) ? 2 : 1); ++rep_) if (IN(n))
    typedef pg8::EpiRoute<0> ER0;
    rope_table(L);
    for (int l = 0; l < DEPTH; ++l) {
        PH(0) { p0_prologue(L, args, l); u_rowpass(L, l, l == 0); GRID_BAR(); }
        PH(1) { PTRS(); ER0 E{OA, 512, 2, ZC, 1536, 6, 2, CA_QSCALE, ZR, 1792}; GEMM(ER0, U, WinT, 3840, 1024, E); GRID_BAR(); }
        PH(2) { p2_mla_prep(L, args, l); p6_rw_prep(L, args, l); GRID_BAR(); }
        PH(3) { PTRS(); pg8::EpiQRope E{QP, (const float*)(ws + WS_ROPE), MLA_QSCALE}; GEMM(pg8::EpiQRope, QN, WqT, 768, 256, E);
                ER0 E2{TW, 512, 2, TA, 512, 2, 0, 1.f, GG, 512}; GEMM(ER0, LA, WloT, 1536, 256, E2); GRID_BAR(); }
        PH(4) { PTRS();
            if (blockIdx.x < 64) rw::rw_unit(L + RING_OFF, l, (int)blockIdx.x);
            volatile LAS unsigned* qs = (volatile LAS unsigned*)(L + MISC_OFF) + 12; unsigned* qhead = (unsigned*)(ws + WS_CTL) + CW_QUEUE + 64 * l + 16 * rep_;
            for (;;) {
                __syncthreads();
                if (threadIdx.x == 0) *qs = atomicAdd(qhead, 1u);
                __syncthreads();
                const unsigned u = *qs;
                if (u >= 1280u) break;
                if (u < 256u) { const int b = (int)u >> 5, cc = (int)u & 31; att::mla_unit(L + RING_OFF, QP, KV, OA, b, 63 - cc); att::mla_unit(L + RING_OFF, QP, KV, OA, b, cc); }
                else { const int bi = (int)u - 256; att::band_unit(L + RING_OFF, ZC, kin(20) + (size_t)l * 320 * 8, OC, bi >> 7, (bi >> 4) & 7, bi & 15); }
            }
            GRID_BAR(); }
        PH(5) { u_rowpass(L, l, false); GRID_BAR(); }
        PH(9) { PTRS(); ER0 E{GT, 3072, 12, GT, 3072, 0, 0, 1.f, GT, 3072}; GEMM(ER0, U, WinT + (size_t)3840 * 1024, 3072, 1024, E); GRID_BAR(); }
        PH(10) { PTRS(); pg8::EpiMerge<0> E0{MG, GT}; GEMM(pg8::EpiMerge<0>, OA, WbT, 1024, 512, E0);
                 pg8::EpiMerge<1> E1{MG, GT}; GEMM(pg8::EpiMerge<1>, ORW, WbT + (size_t)1024 * 512, 1024, 512, E1);
                 pg8::EpiMerge<2> E2{MG, GT}; GEMM(pg8::EpiMerge<2>, OC, WbT + (size_t)2 * 1024 * 512, 1024, 512, E2); GRID_BAR(); }
        PH(11) { PTRS(); ER0 E{M2, 1024, 4, M2, 1024, 0, 0, 1.f, M2, 1024}; GEMM(ER0, MG, WoT, 1024, 1024, E); GRID_BAR(); }
        if (IN(12)) { PTRS(); rowpass<0>(L, args, M2, kin(23) + l * 1024, kin(24) + l * 1024, nullptr); GRID_BAR(); }
        PH(13) { PTRS(); pg8::EpiRoute<2> E{HID, 4096, 16, HID, 4096, 0, 0, 1.f, HID, 4096}; GEMM(pg8::EpiRoute<2>, U, W1T, 4096, 1024, E); GRID_BAR(); }
        PH(14) { PTRS(); ER0 E{M2, 1024, 4, M2, 1024, 0, 0, 1.f, M2, 1024}; GEMM(ER0, HID, W2T, 1024, 4096, E); GRID_BAR(); }
        if (IN(15)) { PTRS(); rowpass<1>(L, args, M2, kin(27) + l * 1024, nullptr, kin(1) + (size_t)l * T * DPLE); GRID_BAR(); }
        PH(16) { PTRS(); ER0 E{PP, 1024, 4, PP, 1024, 0, 0, 1.f, PP, 1024}; GEMM(ER0, PB, WpT, 1024, 256, E); GRID_BAR(); }
        if (IN(17)) { PTRS(); pg8::EpiPle E{kout(), PP}; GEMM(pg8::EpiPle, U, WgT, 1024, 1024, E); }
        LAYER_END();
        if (l + 1 < DEPTH) GRID_BAR();
    }
}

#if !defined(DBG_BISECT)
extern "C" void kernel_launch(void* const* d_in, const int* in_sizes, int n_in, void* d_out, int out_size, void* d_ws, size_t ws_size, hipStream_t stream) {
    static int grid = 0;
    if (grid == 0) {
        if (n_in != 30 || out_size != T * D || ws_size < (size_t)WS_END) { fprintf(stderr, "kernel_launch: unexpected shapes (n_in %d out %d ws %zu, need ws >= %zu)\n", n_in, out_size, ws_size, (size_t)WS_END); grid = -1; return; }
        int dev = 0, cus = 0, per_cu = 0;
        if (hipGetDevice(&dev) != hipSuccess || hipDeviceGetAttribute(&cus, hipDeviceAttributeMultiprocessorCount, dev) != hipSuccess) { grid = -1; return; }
        if (hipFuncSetAttribute((const void*)mk_fwd, hipFuncAttributeMaxDynamicSharedMemorySize, LDS_BYTES) != hipSuccess) { fprintf(stderr, "kernel_launch: hipFuncSetAttribute failed\n"); grid = -1; return; }
        if (hipOccupancyMaxActiveBlocksPerMultiprocessor(&per_cu, (const void*)mk_fwd, NWAVES * 64, LDS_BYTES) != hipSuccess || per_cu < 1) { fprintf(stderr, "kernel_launch: occupancy query says %d\n", per_cu); }
        (void)hipGetLastError();
        grid = cus;
    }
    if (grid < 0) return;
    if (hipMemsetAsync((char*)d_ws + WS_CTL, 0, CTL_ZERO_BYTES, stream) != hipSuccess) return;
    Args a{};
    for (int i = 0; i < 30; ++i) a.in[i] = (const float*)d_in[i];
    a.out = (float*)d_out; a.ws = (unsigned char*)d_ws; a.start = 0; a.stop = 1000;
    hipLaunchKernelGGL(mk_fwd, dim3(grid), dim3(NWAVES * 64), LDS_BYTES, stream, a);
}
#endif
```

```cpp
#include <hip/hip_runtime.h>
#include <cstdio>
#include <cstdint>
#include <cmath>
typedef _Float16 h16x8_t __attribute__((ext_vector_type(8)));
typedef _Float16 h16x2_t __attribute__((ext_vector_type(2)));
typedef short s16x8_t __attribute__((ext_vector_type(8)));
typedef float f32x4_t_ __attribute__((ext_vector_type(4)));
typedef float f32x16_t_ __attribute__((ext_vector_type(16)));
__device__ __forceinline__ unsigned h_pk2(float lo, float hi) { const h16x2_t v = {(_Float16)lo, (_Float16)hi}; return __builtin_bit_cast(unsigned, v); }
__device__ __forceinline__ unsigned h_f2h(float f) { return (unsigned)__builtin_bit_cast(unsigned short, (_Float16)f); }
__device__ __forceinline__ float h_lo(unsigned w) { return (float)__builtin_bit_cast(_Float16, (unsigned short)(w & 0xffffu)); }
__device__ __forceinline__ float h_hi(unsigned w) { return (float)__builtin_bit_cast(_Float16, (unsigned short)(w >> 16)); }
__device__ __forceinline__ f32x4_t_ MFMA16(s16x8_t a, s16x8_t b, f32x4_t_ c) { return __builtin_amdgcn_mfma_f32_16x16x32_f16(__builtin_bit_cast(h16x8_t, a), __builtin_bit_cast(h16x8_t, b), c, 0, 0, 0); }
__device__ __forceinline__ f32x16_t_ MFMA32(s16x8_t a, s16x8_t b, f32x16_t_ c) { return __builtin_amdgcn_mfma_f32_32x32x16_f16(__builtin_bit_cast(h16x8_t, a), __builtin_bit_cast(h16x8_t, b), c, 0, 0, 0); }
#define MK_WAVETAB_LDS 131072
__device__ __forceinline__ int my_tid() {
    const unsigned hw = (unsigned)__builtin_amdgcn_s_getreg((5 << 11) | 4) & 63u;
    const unsigned wv = (unsigned)__builtin_amdgcn_readfirstlane((int)((volatile __attribute__((address_space(3))) unsigned*)MK_WAVETAB_LDS)[hw]);
    unsigned lane; asm volatile("v_mbcnt_lo_u32_b32 %0, -1, 0\n\tv_mbcnt_hi_u32_b32 %0, -1, %0" : "=v"(lane));
    return (int)(wv * 64u + lane);
}
namespace pg8 {
#define PG8_LAS __attribute__((address_space(3)))
typedef unsigned short bf16_t;
typedef short bf16x8 __attribute__((ext_vector_type(8)));
typedef float f32x4 __attribute__((ext_vector_type(4)));
typedef unsigned u32x4 __attribute__((ext_vector_type(4)));
constexpr int BM = 256, BK = 64, HALF = 128, HTB = HALF * BK * 2  , STAGE_BYTES = 8 * HTB, NXCD = 8, WGM = 8;

__host__ __device__ __forceinline__ int lds_byte(int r, int c) { const int st = (r >> 4) * 2 + (c >> 5), rr = r & 15, cc = c & 31, ob = rr * 64 + cc * 2; return st * 1024 + (ob ^ (((ob >> 9) & 1) << 5)); }
__host__ __device__ __forceinline__ void stage_rc(int b, int& R, int& C) { const int st = b / 1024, sb = b % 1024, swz = sb ^ (((sb >> 9) & 1) << 5); R = (st >> 1) * 16 + swz / 64; C = (st & 1) * 32 + (swz % 64) / 2; }
__host__ __device__ __forceinline__ int perm32(int rho) { const int n = rho >> 4, i = rho & 15; return 8 * (i >> 2) + 4 * n + (i & 3); }

struct Unit { int pm, pn; };
struct Gemm { const bf16_t* A; const bf16_t* Bt; int M, N, K; };

struct StaticOrder {
    int nM, nN, nwg, G, c;
    __host__ __device__ void init(int M, int N, int G_, int c_) { nM = M / BM; nN = N / BM; nwg = nM * nN; G = G_; c = c_; }
    __host__ __device__ bool next(int i, Unit& u) const {
        const long L = (long)i * G + c; if (L >= nwg) return false;
        int wgid = (int)L; { const int q = nwg / NXCD, r = nwg % NXCD, xcd = wgid % NXCD, off = wgid / NXCD; wgid = (xcd < r ? xcd * (q + 1) : r * (q + 1) + (xcd - r) * q) + off; }
        const int nig = WGM * nN, gid = wgid / nig, fm = gid * WGM, gsz = (nM - fm) < WGM ? (nM - fm) : WGM;
        u.pm = fm + ((wgid % nig) % gsz); u.pn = (wgid % nig) / gsz; return true;
    }
    __device__ __forceinline__ void a_ready(const Unit&) const {}
    __device__ __forceinline__ void done(const Unit&) const {}
};

__device__ __forceinline__ unsigned cvt_pk_bf16(float lo, float hi) { typedef __fp16 hp2 __attribute__((ext_vector_type(2))); const hp2 v = __builtin_amdgcn_cvt_pkrtz(lo, hi); return __builtin_bit_cast(unsigned, v); }
typedef float f32x2 __attribute__((ext_vector_type(2)));
__device__ __forceinline__ f32x2 gelu_pk(f32x2 v) {
    const f32x2 av = __builtin_elementwise_abs(v), d = av * 0.2316418882f + 1.0f;
    f32x2 t; t.x = __builtin_amdgcn_rcpf(d.x); t.y = __builtin_amdgcn_rcpf(d.y);
    f32x2 q = t * 0.5307027145f + (-0.7265760135f); q = q * t + 0.7107068705f; q = q * t + (-0.142248368f); q = q * t + 0.127414796f; q = q * t;
    const f32x2 s = (v * v) * (-0.72134752044f);
    f32x2 e; e.x = __builtin_amdgcn_exp2f(s.x); e.y = __builtin_amdgcn_exp2f(s.y);
    const f32x2 m = v * (q * e), r = v - m;
    f32x2 o; o.x = v.x < 0.f ? m.x : r.x; o.y = v.y < 0.f ? m.y : r.y; return o;
}

template <int ACT  > struct EpiBf16 {
    static constexpr bool PERM = true, AFTER_DRAIN = false; static_assert(ACT == 0 || ACT == 1, "EpiBf16: ACT is 0 (none) or 1 (gelu_pk)");
    bf16_t* O; int ldc; const float* bias; int split_cols; size_t split_stride; float scale0;
    __device__ __forceinline__ void operator()(const f32x4 (&acc)[2][2][4][2], const Unit& u, int wr, int wc, int fr, int fq) const {
        const int row0 = u.pm * BM + wr * 64 + fr; int colt = u.pn * BM; bf16_t* base = O;
        float sc = 1.f; if (split_cols) { const int t = colt / split_cols; base += (size_t)t * split_stride; colt -= t * split_cols; if (t == 0) sc = scale0; }
        const int col0 = colt + wc * 32 + 8 * fq, bcol0 = u.pn * BM + wc * 32 + 8 * fq;
        f32x4 bv[2][2];
#pragma unroll
        for (int bj = 0; bj < 2; ++bj)
#pragma unroll
            for (int n = 0; n < 2; ++n) bv[bj][n] = bias ? *(const f32x4*)(bias + bcol0 + bj * HALF + 4 * n) : (f32x4){0.f, 0.f, 0.f, 0.f};
#pragma unroll
        for (int ai = 0; ai < 2; ++ai)
#pragma unroll
            for (int m = 0; m < 4; ++m) { bf16_t* rowp = base + (size_t)(row0 + ai * HALF + m * 16) * ldc + col0;
#pragma unroll
                for (int bj = 0; bj < 2; ++bj) { f32x4 v0 = acc[ai][bj][m][0] + bv[bj][0], v1 = acc[ai][bj][m][1] + bv[bj][1];
                    if (ACT == 1) { f32x2 a = gelu_pk((f32x2){v0[0], v0[1]}), b = gelu_pk((f32x2){v0[2], v0[3]}), c = gelu_pk((f32x2){v1[0], v1[1]}), d = gelu_pk((f32x2){v1[2], v1[3]});
                        v0 = (f32x4){a.x, a.y, b.x, b.y}; v1 = (f32x4){c.x, c.y, d.x, d.y}; }
                    v0 = v0 * sc; v1 = v1 * sc; u32x4 w; w.x = cvt_pk_bf16(v0[0], v0[1]); w.y = cvt_pk_bf16(v0[2], v0[3]); w.z = cvt_pk_bf16(v1[0], v1[1]); w.w = cvt_pk_bf16(v1[2], v1[3]);
                    *(u32x4*)(rowp + bj * HALF) = w; } }
    }
};
__device__ __forceinline__ float bf2f(unsigned short b) { return h_lo((unsigned)b); }
__device__ __forceinline__ float sigm(float x) { return __builtin_amdgcn_rcpf(1.0f + __builtin_amdgcn_exp2f(-1.4426950408889634f * x)); }
__device__ __forceinline__ void unpack8(const u32x4 w, float (&f)[8]) {
    f[0] = h_lo(w.x); f[1] = h_hi(w.x); f[2] = h_lo(w.y); f[3] = h_hi(w.y); f[4] = h_lo(w.z); f[5] = h_hi(w.z); f[6] = h_lo(w.w); f[7] = h_hi(w.w);
}
template <int ACT> struct EpiRoute {
    static constexpr bool PERM = true, AFTER_DRAIN = false;
    bf16_t* O0; int ld0; int nt0;
    bf16_t* O1; int ld1; int nt1; int nts1; float sc1;
    bf16_t* O2; int ld2;
    __device__ __forceinline__ void operator()(const f32x4 (&acc)[2][2][4][2], const Unit& u, int wr, int wc, int fr, int fq) const {
        const int row0 = u.pm * BM + wr * 64 + fr;
        bf16_t* base; int ld, colt; float sc = 1.f;
        if (u.pn < nt0) { base = O0; ld = ld0; colt = u.pn * BM; }
        else if (u.pn < nt0 + nt1) { base = O1; ld = ld1; colt = (u.pn - nt0) * BM; if (u.pn - nt0 < nts1) sc = sc1; }
        else { base = O2; ld = ld2; colt = (u.pn - nt0 - nt1) * BM; }
        const int col0 = colt + wc * 32 + 8 * fq;
#pragma unroll
        for (int ai = 0; ai < 2; ++ai)
#pragma unroll
            for (int m = 0; m < 4; ++m) { bf16_t* rowp = base + (size_t)(row0 + ai * HALF + m * 16) * ld + col0;
#pragma unroll
                for (int bj = 0; bj < 2; ++bj) { f32x4 v0 = acc[ai][bj][m][0], v1 = acc[ai][bj][m][1];
                    if (ACT == 2) { for (int e = 0; e < 4; ++e) { const float a = fmaxf(v0[e], 0.f), b = fmaxf(v1[e], 0.f); v0[e] = a * a; v1[e] = b * b; } }
                    v0 = v0 * sc; v1 = v1 * sc; u32x4 w; w.x = cvt_pk_bf16(v0[0], v0[1]); w.y = cvt_pk_bf16(v0[2], v0[3]); w.z = cvt_pk_bf16(v1[0], v1[1]); w.w = cvt_pk_bf16(v1[2], v1[3]);
                    *(u32x4*)(rowp + bj * HALF) = w; } }
    }
};
struct EpiSig {
    static constexpr bool PERM = true, AFTER_DRAIN = false;
    bf16_t* O; const float* p; float scale;
    __device__ __forceinline__ void operator()(const f32x4 (&acc)[2][2][4][2], const Unit& u, int wr, int wc, int fr, int fq) const {
        const int row0 = u.pm * BM + wr * 64 + fr; const int col0 = u.pn * BM + wc * 32 + 8 * fq;
        const f32x4 pA0 = *(const f32x4*)(p + col0), pA1 = *(const f32x4*)(p + col0 + 4), pB0 = *(const f32x4*)(p + col0 + HALF), pB1 = *(const f32x4*)(p + col0 + HALF + 4);
#pragma unroll
        for (int ai = 0; ai < 2; ++ai)
#pragma unroll
            for (int m = 0; m < 4; ++m) { bf16_t* rowp = O + (size_t)(row0 + ai * HALF + m * 16) * 512 + col0;
#pragma unroll
                for (int bj = 0; bj < 2; ++bj) { f32x4 v0 = acc[ai][bj][m][0], v1 = acc[ai][bj][m][1]; const f32x4 p0 = bj ? pB0 : pA0, p1 = bj ? pB1 : pA1;
                    v0 = (f32x4){sigm(p0[0] + v0[0]), sigm(p0[1] + v0[1]), sigm(p0[2] + v0[2]), sigm(p0[3] + v0[3])} * scale; v1 = (f32x4){sigm(p1[0] + v1[0]), sigm(p1[1] + v1[1]), sigm(p1[2] + v1[2]), sigm(p1[3] + v1[3])} * scale;
                    u32x4 w; w.x = cvt_pk_bf16(v0[0], v0[1]); w.y = cvt_pk_bf16(v0[2], v0[3]); w.z = cvt_pk_bf16(v1[0], v1[1]); w.w = cvt_pk_bf16(v1[2], v1[3]);
                    *(u32x4*)(rowp + bj * HALF) = w; } }
    }
};
struct EpiQRope {
    static constexpr bool PERM = true, AFTER_DRAIN = false;
    bf16_t* O; const float* rope; float sc;
    __device__ __forceinline__ void operator()(const f32x4 (&acc)[2][2][4][2], const Unit& u, int wr, int wc, int fr, int fq) const {
        const int row0 = u.pm * BM + wr * 64 + fr; const int col0 = u.pn * BM + wc * 32 + 8 * fq;
#pragma unroll
        for (int ai = 0; ai < 2; ++ai)
#pragma unroll
            for (int m = 0; m < 4; ++m) { const int row = row0 + ai * HALF + m * 16;
#pragma unroll
                for (int bj = 0; bj < 2; ++bj) { const int cg = col0 + bj * HALF; const int cm = cg % 192; f32x4 v0 = acc[ai][bj][m][0], v1 = acc[ai][bj][m][1];
                    if (cm >= 128) { const int j0 = (cm - 128) >> 1; const f32x4* rp = (const f32x4*)(rope + ((size_t)row * 32 + j0) * 2); const f32x4 a = rp[0], b = rp[1];
                        f32x4 r0, r1;
                        r0[0] = v0[0] * a[0] - v0[1] * a[1]; r0[1] = v0[1] * a[0] + v0[0] * a[1]; r0[2] = v0[2] * a[2] - v0[3] * a[3]; r0[3] = v0[3] * a[2] + v0[2] * a[3];
                        r1[0] = v1[0] * b[0] - v1[1] * b[1]; r1[1] = v1[1] * b[0] + v1[0] * b[1]; r1[2] = v1[2] * b[2] - v1[3] * b[3]; r1[3] = v1[3] * b[2] + v1[2] * b[3];
                        v0 = r0; v1 = r1; }
                    v0 = v0 * sc; v1 = v1 * sc; u32x4 w; w.x = cvt_pk_bf16(v0[0], v0[1]); w.y = cvt_pk_bf16(v0[2], v0[3]); w.z = cvt_pk_bf16(v1[0], v1[1]); w.w = cvt_pk_bf16(v1[2], v1[3]);
                    *(u32x4*)(O + (size_t)row * 768 + cg) = w; } }
    }
};
template <int NI> struct EpiMerge {
    static constexpr bool PERM = true, AFTER_DRAIN = false;
    bf16_t* MG; const bf16_t* GT;
    __device__ __forceinline__ void operator()(const f32x4 (&acc)[2][2][4][2], const Unit& u, int wr, int wc, int fr, int fq) const {
        typedef unsigned u32x2 __attribute__((ext_vector_type(2)));
        const int row0 = u.pm * BM + wr * 64 + fr; const int col0 = u.pn * BM + wc * 32 + 8 * fq;
#pragma unroll
        for (int ai = 0; ai < 2; ++ai)
#pragma unroll
            for (int m = 0; m < 4; ++m) { const int row = row0 + ai * HALF + m * 16;
#pragma unroll
                for (int bj = 0; bj < 2; ++bj)
#pragma unroll
                    for (int n = 0; n < 2; ++n) { const int c = col0 + bj * HALF + 4 * n; const f32x4 v = acc[ai][bj][m][n];
                        const u32x2 gw = *(const u32x2*)(GT + (size_t)row * 3072 + NI * 1024 + c);
                        f32x4 o = {0.f, 0.f, 0.f, 0.f};
                        if (NI > 0) { const u32x2 ow = *(const u32x2*)(MG + (size_t)row * 1024 + c); o = (f32x4){h_lo(ow.x), h_hi(ow.x), h_lo(ow.y), h_hi(ow.y)}; }
                        o[0] += sigm(h_lo(gw.x)) * v[0]; o[1] += sigm(h_hi(gw.x)) * v[1]; o[2] += sigm(h_lo(gw.y)) * v[2]; o[3] += sigm(h_hi(gw.y)) * v[3];
                        u32x2 w; w.x = cvt_pk_bf16(o[0], o[1]); w.y = cvt_pk_bf16(o[2], o[3]);
                        *(u32x2*)(MG + (size_t)row * 1024 + c) = w; } }
    }
};
struct EpiPle {
    static constexpr bool PERM = true, AFTER_DRAIN = false;
    float* H; const bf16_t* PP;
    __device__ __forceinline__ void operator()(const f32x4 (&acc)[2][2][4][2], const Unit& u, int wr, int wc, int fr, int fq) const {
        const int row0 = u.pm * BM + wr * 64 + fr; const int col0 = u.pn * BM + wc * 32 + 8 * fq;
#pragma unroll
        for (int ai = 0; ai < 2; ++ai)
#pragma unroll
            for (int m = 0; m < 4; ++m) { const int row = row0 + ai * HALF + m * 16;
#pragma unroll
                for (int bj = 0; bj < 2; ++bj) { const int c = col0 + bj * HALF; const f32x4 v0 = acc[ai][bj][m][0], v1 = acc[ai][bj][m][1];
                    float p[8]; unpack8(*(const u32x4*)(PP + (size_t)row * 1024 + c), p);
                    f32x4* hp = (f32x4*)(H + (size_t)row * 1024 + c); f32x4 h0 = hp[0], h1 = hp[1];
                    for (int e = 0; e < 4; ++e) { h0[e] += sigm(v0[e]) * p[e]; h1[e] += sigm(v1[e]) * p[4 + e]; }
                    hp[0] = h0; hp[1] = h1; } }
    }
};
template <class Epi, class Sched, bool ALIGN_EPI = false, bool SP2 = false>
__device__ __forceinline__ void gemm_phase(PG8_LAS unsigned char* lds, const Gemm g, const Sched& S, const Epi& E) {
    int tid_ = my_tid(); asm volatile("" : "+v"(tid_));
    const int tid = tid_, wid = __builtin_amdgcn_readfirstlane(tid >> 6), lane = tid & 63, wr = wid >> 2, wc = wid & 3, fr = lane & 15, fq = lane >> 4;
    const int K = g.K, nt = K / BK;
    unsigned voffA[2], voffB[2];
#pragma unroll
    for (int i = 0; i < 2; ++i) { int R, C; stage_rc(tid * 16 + i * 8192, R, C); const int Rb = Epi::PERM ? ((R & ~31) + perm32(R & 31)) : R;
        voffA[i] = (unsigned)(R * K + C) * 2u; voffB[i] = (unsigned)(Rb * K + C) * 2u; }
    const size_t kstep = (size_t)(BK * 2);
    const size_t hstep = (size_t)HALF * K * 2;
    const size_t tstep = 2 * hstep;
    const unsigned ldsw = (unsigned)wid * 1024u;
    const int aoff = lds_byte(wr * 64 + fr, fq * 8), boff = lds_byte(wc * 32 + fr, fq * 8);
#define PG8_SA(b, h) (((b) * 2 + (h)) * HTB)
#define PG8_SB(b, h) ((4 + (b) * 2 + (h)) * HTB)
#define PG8_STAGE(bufoff, gbase, voff) do { _Pragma("unroll") for (int _i = 0; _i < 2; ++_i) \
        __builtin_amdgcn_global_load_lds((const unsigned*)((const char*)(gbase) + (voff)[_i]), (PG8_LAS unsigned*)(lds + (bufoff) + ldsw + _i * 8192), 16, 0, 0); } while (0)
#define PG8_LDA(dst, b, h) do { _Pragma("unroll") for (int m = 0; m < 4; ++m) _Pragma("unroll") for (int k = 0; k < 2; ++k) dst[m][k] = *(const PG8_LAS bf16x8*)(lds + PG8_SA(b, h) + aoff + m * 2048 + k * 1024); } while (0)
#define PG8_LDB(dst, b, h) do { _Pragma("unroll") for (int n = 0; n < 2; ++n) _Pragma("unroll") for (int k = 0; k < 2; ++k) dst[n][k] = *(const PG8_LAS bf16x8*)(lds + PG8_SB(b, h) + boff + n * 2048 + k * 1024); } while (0)
#define PG8_MMA(ai, bj, At, Bt) do { __builtin_amdgcn_s_setprio(1); _Pragma("unroll") for (int m = 0; m < 4; ++m) _Pragma("unroll") for (int n = 0; n < 2; ++n) _Pragma("unroll") for (int k = 0; k < 2; ++k) \
        acc[ai][bj][m][n] = MFMA16(Bt[n][k], At[m][k], acc[ai][bj][m][n]); __builtin_amdgcn_s_setprio(0); } while (0)
#define PG8_WAIT_V(n) asm volatile("s_waitcnt vmcnt(" #n ")" ::: "memory")
#define PG8_WAIT_L(n) asm volatile("s_waitcnt lgkmcnt(" #n ")" ::: "memory")
#define PG8_BAR __builtin_amdgcn_s_barrier()
#define PG8_SCHED __builtin_amdgcn_sched_barrier(0)
    Unit cur, nxt; int ui = 0;
    if (!S.next(0, cur)) return;
    f32x4 acc[2][2][4][2];
#pragma unroll
    for (int a = 0; a < 2; ++a)
#pragma unroll
        for (int b = 0; b < 2; ++b)
#pragma unroll
            for (int m = 0; m < 4; ++m)
#pragma unroll
                for (int n = 0; n < 2; ++n) acc[a][b][m][n] = (f32x4){0.f, 0.f, 0.f, 0.f};
    bf16x8 At[4][2], B0[2][2], B1[2][2];
    const char* cA = (const char*)g.A + (size_t)cur.pm * tstep; const char* cB = (const char*)g.Bt + (size_t)cur.pn * tstep;
    S.a_ready(cur);
    if constexpr (SP2) {
        PG8_STAGE(PG8_SB(0, 0), cB, voffB); PG8_STAGE(PG8_SB(0, 1), cB + hstep, voffB); PG8_STAGE(PG8_SA(0, 0), cA, voffA); PG8_STAGE(PG8_SA(0, 1), cA + hstep, voffA);
        if (wr == 1) PG8_BAR;
        PG8_WAIT_V(2); PG8_BAR;
        PG8_STAGE(PG8_SB(1, 0), cB + kstep, voffB); PG8_STAGE(PG8_SA(1, 0), cA + kstep, voffA); PG8_STAGE(PG8_SB(1, 1), cB + hstep + kstep, voffB);
        PG8_WAIT_V(6); PG8_BAR;
    } else {
        PG8_STAGE(PG8_SB(0, 0), cB, voffB); PG8_STAGE(PG8_SA(0, 0), cA, voffA); PG8_STAGE(PG8_SB(0, 1), cB + hstep, voffB); PG8_STAGE(PG8_SA(0, 1), cA + hstep, voffA);
        if (wr == 1) PG8_BAR;
        PG8_WAIT_V(4); PG8_BAR;
        PG8_STAGE(PG8_SB(1, 0), cB + kstep, voffB); PG8_STAGE(PG8_SA(1, 0), cA + kstep, voffA); PG8_STAGE(PG8_SB(1, 1), cB + hstep + kstep, voffB);
        PG8_WAIT_V(6); PG8_BAR;
    }
    for (;;) {
        const bool has_next = S.next(ui + 1, nxt);
        const char* nA = has_next ? (const char*)g.A + (size_t)nxt.pm * tstep : cA; const char* nB = has_next ? (const char*)g.Bt + (size_t)nxt.pn * tstep : cB;
        for (int t = 0; t < nt; t += 2) {
            const bool last = (t == nt - 2);
            const char* a1 = cA + (size_t)(t + 1) * kstep;
            const char* a2 = last ? nA : cA + (size_t)(t + 2) * kstep; const char* b2 = last ? nB : cB + (size_t)(t + 2) * kstep;
            const char* a3 = a2 + kstep; const char* b3 = b2 + kstep;
            if (last && has_next) S.a_ready(nxt);
            if constexpr (SP2) {
            PG8_LDB(B0, 0, 0); PG8_LDB(B1, 0, 1); PG8_SCHED; PG8_LDA(At, 0, 0); PG8_STAGE(PG8_SA(1, 1), a1 + hstep, voffA);
            PG8_WAIT_V(8); PG8_WAIT_L(0); PG8_BAR; PG8_MMA(0, 0, At, B0); PG8_MMA(0, 1, At, B1); PG8_BAR; PG8_SCHED;
            PG8_LDA(At, 0, 1); PG8_STAGE(PG8_SB(0, 0), b2, voffB); PG8_STAGE(PG8_SB(0, 1), b2 + hstep, voffB); PG8_STAGE(PG8_SA(0, 0), a2, voffA);
            PG8_WAIT_V(8); PG8_WAIT_L(0); PG8_BAR; PG8_MMA(1, 0, At, B0); PG8_MMA(1, 1, At, B1); PG8_BAR; PG8_SCHED;
            PG8_LDB(B0, 1, 0); PG8_LDB(B1, 1, 1); PG8_SCHED; PG8_LDA(At, 1, 0); PG8_STAGE(PG8_SA(0, 1), a2 + hstep, voffA);
            PG8_WAIT_V(8); PG8_WAIT_L(0); PG8_BAR; PG8_MMA(0, 0, At, B0); PG8_MMA(0, 1, At, B1); PG8_BAR; PG8_SCHED;
            PG8_LDA(At, 1, 1); PG8_STAGE(PG8_SB(1, 0), b3, voffB); PG8_STAGE(PG8_SB(1, 1), b3 + hstep, voffB); PG8_STAGE(PG8_SA(1, 0), a3, voffA);
            PG8_WAIT_V(8); PG8_WAIT_L(0); PG8_BAR; PG8_MMA(1, 0, At, B0); PG8_MMA(1, 1, At, B1); PG8_BAR; PG8_SCHED;
            } else {
            PG8_LDB(B0, 0, 0); PG8_SCHED; PG8_LDA(At, 0, 0); PG8_STAGE(PG8_SA(1, 1), a1 + hstep, voffA);
            PG8_WAIT_L(8); PG8_BAR; PG8_WAIT_L(0); PG8_MMA(0, 0, At, B0); PG8_BAR; PG8_SCHED;
            PG8_LDB(B1, 0, 1); PG8_STAGE(PG8_SB(0, 0), b2, voffB);
            PG8_BAR; PG8_WAIT_L(0); PG8_MMA(0, 1, At, B1); PG8_BAR;
            PG8_LDA(At, 0, 1); PG8_STAGE(PG8_SA(0, 0), a2, voffA);
            PG8_BAR; PG8_WAIT_L(0); PG8_MMA(1, 0, At, B0); PG8_BAR; PG8_SCHED;
            PG8_STAGE(PG8_SB(0, 1), b2 + hstep, voffB);
            PG8_WAIT_V(6); PG8_BAR; PG8_MMA(1, 1, At, B1); PG8_BAR;
            PG8_LDB(B0, 1, 0); PG8_SCHED; PG8_LDA(At, 1, 0); PG8_STAGE(PG8_SA(0, 1), a2 + hstep, voffA);
            PG8_WAIT_L(8); PG8_BAR; PG8_WAIT_L(0); PG8_MMA(0, 0, At, B0); PG8_BAR; PG8_SCHED;
            PG8_LDB(B1, 1, 1); PG8_STAGE(PG8_SB(1, 0), b3, voffB);
            PG8_BAR; PG8_WAIT_L(0); PG8_MMA(0, 1, At, B1); PG8_BAR;
            PG8_LDA(At, 1, 1); PG8_STAGE(PG8_SA(1, 0), a3, voffA);
            PG8_BAR; PG8_WAIT_L(0); PG8_MMA(1, 0, At, B0); PG8_BAR; PG8_SCHED;
            PG8_STAGE(PG8_SB(1, 1), b3 + hstep, voffB);
            PG8_WAIT_V(6); PG8_BAR; PG8_MMA(1, 1, At, B1); PG8_BAR;
            }
        }
        if constexpr (ALIGN_EPI) { if (wr == 0) PG8_BAR; }
        if constexpr (!Epi::AFTER_DRAIN) { int t2_ = my_tid(); asm volatile("" : "+v"(t2_)); const int l2_ = t2_ & 63, w2_ = __builtin_amdgcn_readfirstlane(t2_ >> 6);
            E(acc, cur, w2_ >> 2, w2_ & 3, l2_ & 15, l2_ >> 4); S.done(cur); }
        if (!has_next) break;
#pragma unroll
        for (int a = 0; a < 2; ++a)
#pragma unroll
            for (int b = 0; b < 2; ++b)
#pragma unroll
                for (int m = 0; m < 4; ++m)
#pragma unroll
                    for (int n = 0; n < 2; ++n) acc[a][b][m][n] = (f32x4){0.f, 0.f, 0.f, 0.f};
        cur = nxt; cA = nA; cB = nB; ++ui;
        if constexpr (ALIGN_EPI) { if (wr == 1) PG8_BAR; }
    }
    PG8_WAIT_V(0);
    if constexpr (!ALIGN_EPI) { if (wr == 0) PG8_BAR; }
    PG8_BAR;
    if constexpr (Epi::AFTER_DRAIN) { E.fused(acc, cur, wr, wc, fr, fq, lds, wid, lane); S.done(cur); }
#undef PG8_SA
#undef PG8_SB
#undef PG8_STAGE
#undef PG8_LDA
#undef PG8_LDB
#undef PG8_MMA
#undef PG8_WAIT_V
#undef PG8_WAIT_L
#undef PG8_BAR
#undef PG8_SCHED
}
}
constexpr int NWAVES = 8;
constexpr int D = 1024, BATCH = 8, SEQ = 4096, T = BATCH * SEQ, DEPTH = 2, FF = 4096, DPLE = 256;
constexpr int IN_COLS = 6848, RW_COLS = 1792;
constexpr float NORM_EPS = 1e-6f, RW_LN_EPS = 64e-5f;
constexpr float LOG2E = 1.4426950408889634f;
constexpr float MLA_QSCALE = 0.07216878364870322f * LOG2E;
constexpr float CA_QSCALE = 0.125f * LOG2E;
constexpr size_t MiB = 1u << 20;
constexpr size_t WS_CTL = 0, CTL_ZERO_BYTES = 1 * MiB;
constexpr size_t WS_ROPE = 1 * MiB;
constexpr size_t WS_W = 9 * MiB;
constexpr size_t W_IN = WS_W, W_Q = W_IN + (size_t)6912 * 1024 * 2, W_LORA = W_Q + (size_t)768 * 256 * 2, W_B = W_LORA + (size_t)1536 * 256 * 2,
                 W_OUT = W_B + (size_t)3 * 1024 * 512 * 2, W_1 = W_OUT + (size_t)1024 * 1024 * 2, W_2 = W_1 + (size_t)4096 * 1024 * 2, W_G = W_2 + (size_t)4096 * 1024 * 2,
                 W_P = W_G + (size_t)1024 * 1024 * 2, W_END = W_P + (size_t)1024 * 256 * 2;
constexpr size_t WS_U = 49 * MiB;
constexpr size_t WS_OA = 113 * MiB, WS_OC = 145 * MiB, WS_ORW = 177 * MiB;
constexpr size_t WS_X = 209 * MiB, WS_END = 512 * MiB;
constexpr size_t X_ZC = WS_X, X_QP = X_ZC + (size_t)T * 1536 * 2, X_KV = X_QP + (size_t)T * 768 * 2, X_ZR = X_KV + (size_t)T * 192 * 2, X_TW = X_ZR + (size_t)T * 1792 * 2;
constexpr size_t X_TA = WS_U, X_G = WS_U + (size_t)T * 512 * 2, X_QN = WS_OC, X_LA = WS_ORW;
constexpr size_t X_GT = WS_X, X_MG = X_GT + (size_t)T * 3072 * 2;
constexpr size_t X_HID = WS_X, X_PB = WS_X, X_PP = X_PB + (size_t)T * 256 * 2;
static_assert(X_TW + (size_t)T * 512 * 2 <= WS_END && X_MG + (size_t)T * 1024 * 2 <= WS_END && X_HID + (size_t)T * 4096 * 2 <= WS_END, "X map");
constexpr int CW_TMO = 0, CW_QUEUE = 1024  , CW_BAR = 4096;
constexpr int RING_OFF = 0, RING_BYTES = 131072;
constexpr int LDSCTL_OFF = RING_BYTES, MISC_OFF = LDSCTL_OFF + 320;
constexpr int LDS_BYTES = 147456;

#define GAS __attribute__((address_space(1)))
#define LAS __attribute__((address_space(3)))
typedef unsigned short bf16;
typedef unsigned v4u __attribute__((ext_vector_type(4)));
typedef unsigned v2u __attribute__((ext_vector_type(2)));
typedef float f32x4 __attribute__((ext_vector_type(4)));
typedef float f32x16 __attribute__((ext_vector_type(16)));
typedef short bf16x8 __attribute__((ext_vector_type(8)));
typedef short s16x4 __attribute__((ext_vector_type(4)));
#define LDS_WAIT() asm volatile("s_waitcnt lgkmcnt(0)" ::: "memory")
#define VM_WAIT() asm volatile("s_waitcnt vmcnt(0)" ::: "memory")
__device__ __forceinline__ unsigned f2bf(float f) { return h_f2h(f); }
__device__ __forceinline__ unsigned pk2(float lo, float hi) { return h_pk2(lo, hi); }
__device__ __forceinline__ float bfl(unsigned w) { return h_lo(w); }
__device__ __forceinline__ float bfh(unsigned w) { return h_hi(w); }
__device__ __forceinline__ float sigmoidf_(float x) { return 1.0f / (1.0f + __expf(-x)); }
__device__ __forceinline__ float shfl_xor_f(float v, int o, int lane) { return __int_as_float(__builtin_amdgcn_ds_bpermute((lane ^ o) << 2, __float_as_int(v))); }
__device__ __forceinline__ float wave_sum(float v, int lane) {
#pragma unroll
    for (int o = 1; o < 64; o <<= 1) v += shfl_xor_f(v, o, lane);
    return v;
}
__device__ __forceinline__ unsigned char* opq(unsigned char* p) { asm volatile("" : "+s"(p)); return p; }
__device__ __forceinline__ float fsig(float x) { return __builtin_amdgcn_rcpf(1.0f + __builtin_amdgcn_exp2f(-LOG2E * x)); }
#define XB_TMO      128
#define XB_XCNT(j)  (256  + 64 * (j))
#define XB_XSUB(j)  (1280 + 64 * (j))
#define XB_XGEN(j)  (2304 + 64 * (j))
#define XB_TOP      3328
#define XB_TOPGEN   3392
#define XCD_BAR_WORDS 3456
#define XB_SPIN_CAP (1u << 25)

__device__ __forceinline__ unsigned xb_ld(unsigned* p)              { return __hip_atomic_load(p, __ATOMIC_RELAXED, __HIP_MEMORY_SCOPE_AGENT); }
__device__ __forceinline__ unsigned xb_add(unsigned* p, unsigned v) { return __hip_atomic_fetch_add(p, v, __ATOMIC_RELAXED, __HIP_MEMORY_SCOPE_AGENT); }
__device__ __forceinline__ unsigned xb_xcc_id() { return (unsigned)__builtin_amdgcn_s_getreg((3 << 11) | 20) & 0xFu; }
#define XB_SPIN(cond, bar) do { unsigned _sp = 0; while (cond) { __builtin_amdgcn_s_sleep(1); \
    if ((++_sp & 255u) == 0u) { if (xb_ld(&(bar)[XB_TMO])) break; if (_sp > XB_SPIN_CAP) { atomicAdd(&(bar)[XB_TMO], 1u); break; } } } } while (0)

struct XcdBarrier {
    unsigned* bar; unsigned x;
    volatile LAS unsigned* st;
};

__device__ __forceinline__ XcdBarrier xcd_barrier_post(unsigned* bar, volatile LAS unsigned* st) {
    XcdBarrier b; b.bar = bar; b.x = xb_xcc_id(); b.st = st;
    if (my_tid() == 0) (void)xb_add(&bar[XB_XCNT(b.x)], 1u);
    return b;
}
__device__ __forceinline__ void xcd_barrier_complete(unsigned* bar, unsigned x, unsigned& nloc, unsigned& nx) {
    const unsigned G = gridDim.x * gridDim.y * gridDim.z;
    unsigned sum, cnt, mine, sp = 0u;
    for (;;) {
        sum = 0u; cnt = 0u; mine = 0u;
#pragma unroll
        for (unsigned j = 0; j < 16; ++j) { const unsigned c = xb_ld(&bar[XB_XCNT(j)]); sum += c; cnt += (c > 0u) ? 1u : 0u; mine = (j == x) ? c : mine; }
        if (sum == G) break;
        __builtin_amdgcn_s_sleep(1);
        if ((++sp & 255u) == 0u) { if (xb_ld(&bar[XB_TMO])) break; if (sp > XB_SPIN_CAP) { atomicAdd(&bar[XB_TMO], 1u); break; } }
    }
    nloc = mine > 0u ? mine : 1u; nx = cnt > 0u ? cnt : 1u;
}

__device__ __forceinline__ void xcd_barrier(const XcdBarrier& b) {
    asm volatile("s_waitcnt vmcnt(0)" ::: "memory");
    __syncthreads();
    if (my_tid() == 0) {
        unsigned* bar = b.bar;
        __builtin_amdgcn_s_waitcnt(0);
        unsigned nloc = b.st[0], nx = b.st[1];
        if (nloc == 0u) { xcd_barrier_complete(bar, b.x, nloc, nx); b.st[0] = nloc; b.st[1] = nx; }
        const unsigned old = xb_add(&bar[XB_XSUB(b.x)], 1u);
        const unsigned gen = old / nloc;
        if (old + 1u == (gen + 1u) * nloc) {
            __builtin_amdgcn_fence(__ATOMIC_RELEASE, "agent");
            asm volatile("s_waitcnt vmcnt(0)" ::: "memory");
            const unsigned og = xb_add(&bar[XB_TOP], 1u);
            const unsigned tg = og / nx;
            if (og + 1u == (tg + 1u) * nx) xb_add(&bar[XB_TOPGEN], 1u);
            else XB_SPIN(xb_ld(&bar[XB_TOPGEN]) == tg, bar);
            __builtin_amdgcn_fence(__ATOMIC_ACQUIRE, "agent");
            xb_add(&bar[XB_XGEN(b.x)], 1u);
            asm volatile("s_waitcnt vmcnt(0)" ::: "memory");
        } else {
            XB_SPIN(xb_ld(&bar[XB_XGEN(b.x)]) == gen, bar);
            __builtin_amdgcn_fence(__ATOMIC_ACQUIRE, "agent");
            asm volatile("s_waitcnt vmcnt(0)" ::: "memory");
        }
    }
    __syncthreads();
}
namespace att {
__device__ __forceinline__ int crow(int r, int hi) { return (r & 3) + 8 * (r >> 2) + 4 * hi; }
__device__ __forceinline__ unsigned cvtpk(float lo, float hi) { return h_pk2(lo, hi); }
typedef short v4i16_t __attribute__((ext_vector_type(4)));
__device__ __forceinline__ s16x4 vtr(const LAS unsigned char* p) { return __builtin_bit_cast(s16x4, __builtin_amdgcn_ds_read_tr16_b64_v4i16((LAS v4i16_t*)p)); }
__device__ __forceinline__ float softmax_tile(f32x16& p0, f32x16& p1, float& m_reg, float& l_reg, bf16x8& pa0, bf16x8& pa1, bf16x8& pa2, bf16x8& pa3) {
    float pmax = p0[0];
#pragma unroll
    for (int r = 1; r < 16; ++r) pmax = fmaxf(pmax, p0[r]);
#pragma unroll
    for (int r = 0; r < 16; ++r) pmax = fmaxf(pmax, p1[r]);
    { auto rr = __builtin_amdgcn_permlane32_swap(__float_as_uint(pmax), __float_as_uint(pmax), false, false); pmax = fmaxf(__uint_as_float(rr[0]), __uint_as_float(rr[1])); }
    float alpha = 1.f;
    if (!__all(pmax - m_reg <= 8.f)) { const float mn = fmaxf(m_reg, pmax); alpha = __builtin_amdgcn_exp2f(m_reg - mn); m_reg = mn; }
    float ps = 0.f;
#pragma unroll
    for (int r = 0; r < 16; ++r) { p0[r] = __builtin_amdgcn_exp2f(p0[r] - m_reg); ps += p0[r]; }
#pragma unroll
    for (int r = 0; r < 16; ++r) { p1[r] = __builtin_amdgcn_exp2f(p1[r] - m_reg); ps += p1[r]; }
    { auto rr = __builtin_amdgcn_permlane32_swap(__float_as_uint(ps), __float_as_uint(ps), false, false); ps = __uint_as_float(rr[0]) + __uint_as_float(rr[1]); }
    l_reg = l_reg * alpha + ps;
#define PK4(P, BASE, OUT) do { unsigned a0 = cvtpk(P[BASE + 0], P[BASE + 1]), a1 = cvtpk(P[BASE + 2], P[BASE + 3]);   \
    unsigned b0 = cvtpk(P[BASE + 4], P[BASE + 5]), b1 = cvtpk(P[BASE + 6], P[BASE + 7]);                              \
    auto r0 = __builtin_amdgcn_permlane32_swap(a0, b0, false, false); auto r1 = __builtin_amdgcn_permlane32_swap(a1, b1, false, false); \
    v4u w = {r0[0], r1[0], r0[1], r1[1]}; OUT = __builtin_bit_cast(bf16x8, w); } while (0)
    PK4(p0, 0, pa0); PK4(p0, 8, pa1); PK4(p1, 0, pa2); PK4(p1, 8, pa3);
#undef PK4
    return alpha;
}
constexpr int MLA_KSTR = 400;
constexpr int MLA_KBUF = 64 * MLA_KSTR;
constexpr int ATT_SCR = 2 * MLA_KBUF;
__device__ __forceinline__ void mla_unit(LAS unsigned char* lds, const bf16* __restrict__ QP, const bf16* __restrict__ KV, bf16* __restrict__ OA, int b, int c) {
    int tid_ = my_tid(); asm volatile("" : "+v"(tid_));
    const int tid = tid_, lane = tid & 63, wid = __builtin_amdgcn_readfirstlane(tid >> 6), r32 = lane & 31, hi = lane >> 5;
    const int h = wid >> 1; const size_t qrow0 = (size_t)b * SEQ + c * 64 + (wid & 1) * 32;
    bf16x8 qr[12];
    { const bf16* qp = QP + (qrow0 + r32) * 768 + h * 192 + hi * 8;
#pragma unroll
      for (int d0 = 0; d0 < 12; ++d0) qr[d0] = *(const bf16x8*)(qp + d0 * 16); }
    float m_reg = -1e30f, l_reg = 0.f; f32x16 o[4];
#pragma unroll
    for (int d = 0; d < 4; ++d)
#pragma unroll
        for (int r = 0; r < 16; ++r) o[d][r] = 0.f;
    LAS float* scr = (LAS float*)(lds + ATT_SCR) + wid * 64;
    const bf16* kvb = KV + (size_t)b * SEQ * 192;
    int skey[3], sch[3];
#pragma unroll
    for (int i = 0; i < 3; ++i) { const int id = tid + 512 * i; skey[i] = id / 24; sch[i] = id % 24; }
    v4u st[3];
    const int NT = c + 1;
#pragma unroll
    for (int i = 0; i < 3; ++i) st[i] = *(const v4u*)(kvb + (size_t)skey[i] * 192 + sch[i] * 8);
#pragma unroll
    for (int i = 0; i < 3; ++i) *(LAS v4u*)(lds + skey[i] * MLA_KSTR + sch[i] * 16) = st[i];
    __syncthreads();
    const int troff = (((lane & 15) >> 2) + 8 * hi) * MLA_KSTR + (16 * ((lane >> 4) & 1) + 4 * (lane & 3)) * 2;
    for (int j = 0; j < NT; ++j) {
        const int buf = j & 1;
        if (j + 1 < NT) {
#pragma unroll
            for (int i = 0; i < 3; ++i) st[i] = *(const v4u*)(kvb + (size_t)(64 * (j + 1) + skey[i]) * 192 + sch[i] * 8);
        }
        const LAS unsigned char* kt = lds + buf * MLA_KBUF;
        f32x16 p0, p1;
#pragma unroll
        for (int r = 0; r < 16; ++r) { p0[r] = 0.f; p1[r] = 0.f; }
        { const LAS unsigned char* kb = kt + r32 * MLA_KSTR + hi * 16;
#pragma unroll
          for (int d0 = 0; d0 < 12; ++d0) { const bf16x8 a0 = *(const LAS bf16x8*)(kb + d0 * 32); const bf16x8 a1 = *(const LAS bf16x8*)(kb + 32 * MLA_KSTR + d0 * 32);
              p0 = MFMA32(a0, qr[d0], p0); p1 = MFMA32(a1, qr[d0], p1); } }
        bf16x8 pa0, pa1, pa2, pa3;
        const float alpha = softmax_tile(p0, p1, m_reg, l_reg, pa0, pa1, pa2, pa3);
        if (__any(alpha < 1.f)) { if (hi == 0) scr[r32] = alpha; LDS_WAIT();
#pragma unroll
            for (int r = 0; r < 16; ++r) { const float a = scr[crow(r, hi)];
#pragma unroll
                for (int d = 0; d < 4; ++d) o[d][r] *= a; } }
        const LAS unsigned char* vb = kt + troff;
#pragma unroll
        for (int d0 = 0; d0 < 4; ++d0) {
            s16x4 lo[4], hh[4];
#pragma unroll
            for (int ks = 0; ks < 4; ++ks) { lo[ks] = vtr(vb + (16 * ks) * MLA_KSTR + d0 * 64); hh[ks] = vtr(vb + (16 * ks + 4) * MLA_KSTR + d0 * 64); }
#define PK(k) (bf16x8){lo[k][0], lo[k][1], lo[k][2], lo[k][3], hh[k][0], hh[k][1], hh[k][2], hh[k][3]}
            o[d0] = MFMA32(pa0, PK(0), o[d0]);
            o[d0] = MFMA32(pa1, PK(1), o[d0]);
            o[d0] = MFMA32(pa2, PK(2), o[d0]);
            o[d0] = MFMA32(pa3, PK(3), o[d0]);
#undef PK
        }
        if (j + 1 < NT) {
#pragma unroll
            for (int i = 0; i < 3; ++i) *(LAS v4u*)(lds + (buf ^ 1) * MLA_KBUF + skey[i] * MLA_KSTR + sch[i] * 16) = st[i];
        }
        __syncthreads();
    }
    if (hi == 0) scr[r32] = l_reg; LDS_WAIT();
    bf16* ob = OA + qrow0 * 512 + h * 128 + r32;
#pragma unroll
    for (int r = 0; r < 16; ++r) { const int orow = crow(r, hi); const float rl = __builtin_amdgcn_rcpf(scr[orow]);
#pragma unroll
        for (int d0 = 0; d0 < 4; ++d0) ob[(size_t)orow * 512 + d0 * 32] = (bf16)f2bf(o[d0][r] * rl); }
    __syncthreads();
}
constexpr int CA_KSTR = 144;
constexpr int CA_TBUF = 64 * CA_KSTR;
constexpr int CA_BIAS = ATT_SCR + 8 * 256;
__device__ __forceinline__ void band_unit(LAS unsigned char* lds, const bf16* __restrict__ ZC, const float* __restrict__ relb, bf16* __restrict__ OC, int b, int h, int g) {
    int tid_ = my_tid(); asm volatile("" : "+v"(tid_));
    const int tid = tid_, lane = tid & 63, wid = __builtin_amdgcn_readfirstlane(tid >> 6), r32 = lane & 31, hi = lane >> 5;
    const int cw = 4 * g + (wid >> 1); const size_t qrow0 = (size_t)b * SEQ + cw * 64 + (wid & 1) * 32;
    LAS float* bias = (LAS float*)(lds + CA_BIAS);
    if (tid < 320) bias[tid] = relb[tid * 8 + h] * LOG2E;
    bf16x8 qr[4];
    { const bf16* qp = ZC + (qrow0 + r32) * 1536 + h * 64 + hi * 8;
#pragma unroll
      for (int d0 = 0; d0 < 4; ++d0) qr[d0] = *(const bf16x8*)(qp + d0 * 16); }
    float m_reg = -1e30f, l_reg = 0.f; f32x16 o[2];
#pragma unroll
    for (int d = 0; d < 2; ++d)
#pragma unroll
        for (int r = 0; r < 16; ++r) o[d][r] = 0.f;
    LAS float* scr = (LAS float*)(lds + ATT_SCR) + wid * 64;
    const int kc0 = (4 * g - 8) < 0 ? 0 : (4 * g - 8), kc1 = 4 * g + 3;
    const bf16* kbase = ZC + (size_t)b * SEQ * 1536 + 512 + h * 64; const bf16* vbase = kbase + 512;
    const int skey = tid >> 3, sch = tid & 7;
    v4u stk, stv;
    stk = *(const v4u*)(kbase + (size_t)(64 * kc0 + skey) * 1536 + sch * 8); stv = *(const v4u*)(vbase + (size_t)(64 * kc0 + skey) * 1536 + sch * 8);
    *(LAS v4u*)(lds + skey * CA_KSTR + sch * 16) = stk; *(LAS v4u*)(lds + CA_TBUF + skey * CA_KSTR + sch * 16) = stv;
    __syncthreads();
    const int troff = (((lane & 15) >> 2) + 8 * hi) * CA_KSTR + (16 * ((lane >> 4) & 1) + 4 * (lane & 3)) * 2;
    const int qin = (wid & 1) * 32 + r32;
    for (int kc = kc0; kc <= kc1; ++kc) {
        const int buf = (kc - kc0) & 1;
        if (kc < kc1) { stk = *(const v4u*)(kbase + (size_t)(64 * (kc + 1) + skey) * 1536 + sch * 8); stv = *(const v4u*)(vbase + (size_t)(64 * (kc + 1) + skey) * 1536 + sch * 8); }
        if (kc >= cw - 8 && kc <= cw) {
            const LAS unsigned char* kt = lds + buf * 2 * CA_TBUF;
            f32x16 p0, p1;
            const int dbase = (cw - kc) * 64 + qin + 63;
#pragma unroll
            for (int r = 0; r < 16; ++r) { int i0 = dbase - crow(r, hi), i1 = i0 - 32; i0 = i0 > 319 ? 319 : i0; i1 = i1 > 319 ? 319 : i1; p0[r] = bias[i0]; p1[r] = bias[i1]; }
            { const LAS unsigned char* kb = kt + r32 * CA_KSTR + hi * 16;
#pragma unroll
              for (int d0 = 0; d0 < 4; ++d0) { const bf16x8 a0 = *(const LAS bf16x8*)(kb + d0 * 32); const bf16x8 a1 = *(const LAS bf16x8*)(kb + 32 * CA_KSTR + d0 * 32);
                  p0 = MFMA32(a0, qr[d0], p0); p1 = MFMA32(a1, qr[d0], p1); } }
            bf16x8 pa0, pa1, pa2, pa3;
            const float alpha = softmax_tile(p0, p1, m_reg, l_reg, pa0, pa1, pa2, pa3);
            if (__any(alpha < 1.f)) { if (hi == 0) scr[r32] = alpha; LDS_WAIT();
#pragma unroll
                for (int r = 0; r < 16; ++r) { const float a = scr[crow(r, hi)]; o[0][r] *= a; o[1][r] *= a; } }
            const LAS unsigned char* vb = kt + CA_TBUF + troff;
#pragma unroll
            for (int d0 = 0; d0 < 2; ++d0) {
                s16x4 lo[4], hh[4];
#pragma unroll
                for (int ks = 0; ks < 4; ++ks) { lo[ks] = vtr(vb + (16 * ks) * CA_KSTR + d0 * 64); hh[ks] = vtr(vb + (16 * ks + 4) * CA_KSTR + d0 * 64); }
#define PK(k) (bf16x8){lo[k][0], lo[k][1], lo[k][2], lo[k][3], hh[k][0], hh[k][1], hh[k][2], hh[k][3]}
                o[d0] = MFMA32(pa0, PK(0), o[d0]);
                o[d0] = MFMA32(pa1, PK(1), o[d0]);
                o[d0] = MFMA32(pa2, PK(2), o[d0]);
                o[d0] = MFMA32(pa3, PK(3), o[d0]);
#undef PK
            }
        }
        if (kc < kc1) { *(LAS v4u*)(lds + (buf ^ 1) * 2 * CA_TBUF + skey * CA_KSTR + sch * 16) = stk; *(LAS v4u*)(lds + (buf ^ 1) * 2 * CA_TBUF + CA_TBUF + skey * CA_KSTR + sch * 16) = stv; }
        __syncthreads();
    }
    if (hi == 0) scr[r32] = l_reg; LDS_WAIT();
    bf16* ob = OC + qrow0 * 512 + h * 64 + r32;
#pragma unroll
    for (int r = 0; r < 16; ++r) { const int orow = crow(r, hi); const float rl = __builtin_amdgcn_rcpf(scr[orow]);
        ob[(size_t)orow * 512] = (bf16)f2bf(o[0][r] * rl); ob[(size_t)orow * 512 + 32] = (bf16)f2bf(o[1][r] * rl); }
    __syncthreads();
}
}
struct Args { const float* in[30]; float* out; unsigned char* ws; int start; int stop; };
#define KAS __attribute__((address_space(4)))
__device__ __forceinline__ const KAS unsigned char* kbase() { const KAS unsigned char* p = (const KAS unsigned char*)__builtin_amdgcn_kernarg_segment_ptr(); asm volatile("" : "+s"(p)); return p; }
__device__ __forceinline__ const float* kin(int i) { return *(const float* const KAS*)(kbase() + 8 * i); }
__device__ __forceinline__ float* kout() { return *(float* const KAS*)(kbase() + 240); }
__device__ __forceinline__ unsigned char* kws() { return *(unsigned char* const KAS*)(kbase() + 248); }
__device__ __forceinline__ int kstart() { return *(const int KAS*)(kbase() + 256); }
__device__ __forceinline__ int kstop() { return *(const int KAS*)(kbase() + 260); }
struct Frame { LAS unsigned char* lds; int tid, lane, wave, G, gw, NGW; };
__device__ __forceinline__ Frame make_frame(LAS unsigned char* lds) {
    Frame F; int tid = my_tid(); asm volatile("" : "+v"(tid)); int bx = blockIdx.x; asm volatile("" : "+s"(bx)); int G = gridDim.x; asm volatile("" : "+s"(G));
    F.lds = lds; F.tid = tid; F.lane = tid & 63; F.wave = __builtin_amdgcn_readfirstlane(tid >> 6); F.G = G; F.gw = bx * NWAVES + F.wave; F.NGW = G * NWAVES; return F;
}

__device__ const double ROPE_INV_FREQ[32] = {1, 0.74989420933245587, 0.56234132519034907, 0.42169650342858223, 0.31622776601683794, 0.23713737056616552, 0.17782794100389229, 0.1333521432163324, 0.10000000000000001, 0.074989420933245579, 0.056234132519034911, 0.042169650342858224, 0.031622776601683791, 0.023713737056616554, 0.017782794100389229, 0.013335214321633241, 0.01, 0.0074989420933245579, 0.005623413251903491, 0.0042169650342858229, 0.0031622776601683794, 0.0023713737056616554, 0.0017782794100389228, 0.0013335214321633241, 0.001, 0.00074989420933245586, 0.0005623413251903491, 0.00042169650342858224, 0.00031622776601683794, 0.00023713737056616554, 0.00017782794100389227, 0.0001333521432163324};
__device__ __forceinline__ void sincos_d(double a, float& s, float& c) {
    const double n = rint(a * 0.63661977236758134308);
    double r = fma(-n, 1.5707963267948966192, a); r = fma(-n, 6.123233995736766036e-17, r);
    const double r2 = r * r;
    double sp = -7.6471637318198164759e-13; sp = fma(sp, r2, 1.6059043836821614599e-10); sp = fma(sp, r2, -2.5052108385441718775e-08); sp = fma(sp, r2, 2.7557319223985890653e-06);
    sp = fma(sp, r2, -1.9841269841269841270e-04); sp = fma(sp, r2, 8.3333333333333333333e-03); sp = fma(sp, r2, -1.6666666666666666667e-01);
    const double sn = fma(sp * r2, r, r);
    double cp = 4.7794773323873852974e-14; cp = fma(cp, r2, -1.1470745597729724714e-11); cp = fma(cp, r2, 2.0876756987868098979e-09); cp = fma(cp, r2, -2.7557319223985890653e-07);
    cp = fma(cp, r2, 2.4801587301587301587e-05); cp = fma(cp, r2, -1.3888888888888888889e-03); cp = fma(cp, r2, 4.1666666666666666667e-02); cp = fma(cp, r2, -0.5);
    const double cs = fma(cp, r2, 1.0);
    const long long q = (long long)n & 3LL; double so, co;
    if (q == 0) { so = sn; co = cs; } else if (q == 1) { so = cs; co = -sn; } else if (q == 2) { so = -sn; co = -cs; } else { so = -cs; co = sn; }
    s = (float)so; c = (float)co;
}
__device__ __forceinline__ void transpose_item(const float* W, int ldw, int col0, int nblk, bf16* WT, int ldt, int row0, LAS float* scr, int item, int lane) {
    const int kb = item / nblk, nb = item % nblk, k0 = 64 * kb, n0 = 32 * nb;
#pragma unroll 8
    for (int i = 0; i < 32; ++i) { const int kk = 2 * i + (lane >> 5); scr[kk * 33 + (lane & 31)] = W[(size_t)(k0 + kk) * ldw + col0 + n0 + (lane & 31)]; }
    LDS_WAIT(); asm volatile("" ::: "memory");
    const int c = lane & 7;
#pragma unroll
    for (int j = 0; j < 4; ++j) { const int n = (lane >> 3) + 8 * j; const LAS float* s = scr + (8 * c) * 33 + n;
        v4u o; o.x = pk2(s[0 * 33], s[1 * 33]); o.y = pk2(s[2 * 33], s[3 * 33]); o.z = pk2(s[4 * 33], s[5 * 33]); o.w = pk2(s[6 * 33], s[7 * 33]);
        *(GAS v4u*)(WT + (size_t)(row0 + n0 + n) * ldt + k0 + 8 * c) = o; }
    LDS_WAIT(); asm volatile("" ::: "memory");
}
__device__ __forceinline__ void rope_table(LAS unsigned char* lds_) {
    const Frame F = make_frame(lds_); const int gt = F.gw * 64 + F.lane, NTH = F.NGW * 64;
    const int* pos = (const int*)kin(2); float* rope = (float*)(kws() + WS_ROPE);
    for (int i = gt; i < T * 32; i += NTH) { float s, c; sincos_d((double)pos[i >> 5] * ROPE_INV_FREQ[i & 31], s, c); rope[2 * (size_t)i] = c; rope[2 * (size_t)i + 1] = s; }
}
__device__ __forceinline__ void p0_prologue(LAS unsigned char* lds_, const Args& A, int l) {
    const Frame F = make_frame(lds_);
    LAS float* scr = (LAS float*)(F.lds + RING_OFF + F.wave * 16384);
    constexpr int I1 = 16 * 14, I2 = 16 * 48, I3 = 16 * 56, I4 = 16 * 96, I5 = 8 * 32, I6 = 8 * 32, I7 = 16 * 32, I8 = 16 * 128, I9 = 64 * 32, I10 = 16 * 32, I11 = 4 * 32;
    constexpr int NITEMS = I1 + I2 + I3 + I4 + I5 + I6 + I7 + I8 + I9 + I10 + I11;
#define WIN_ (kin(4) + (size_t)l * 1024 * IN_COLS)
#define WBR_ (kin(21) + (size_t)l * 1536 * 1024)
    for (int it = F.gw; it < NITEMS; it += F.NGW) {
        int r = it;
        if (r < I1) { transpose_item(WIN_, IN_COLS, 0, 14, (bf16*)(kws() + W_IN), 1024, 0, scr, r, F.lane); continue; } r -= I1;
        if (r < I2) { transpose_item(WIN_, IN_COLS, 2240, 48, (bf16*)(kws() + W_IN), 1024, 512, scr, r, F.lane); continue; } r -= I2;
        if (r < I3) { transpose_item(WIN_, IN_COLS, 448, 56, (bf16*)(kws() + W_IN), 1024, 2048, scr, r, F.lane); continue; } r -= I3;
        if (r < I4) { transpose_item(WIN_, IN_COLS, 3776, 96, (bf16*)(kws() + W_IN), 1024, 3840, scr, r, F.lane); continue; } r -= I4;
        if (r < I5) { transpose_item(WBR_ + (size_t)512 * 1024, 1024, 0, 32, (bf16*)(kws() + W_B) + (size_t)1024 * 512, 512, 0, scr, r, F.lane); continue; } r -= I5;
        if (r < I6) { transpose_item(WBR_ + (size_t)1024 * 1024, 1024, 0, 32, (bf16*)(kws() + W_B) + (size_t)2 * 1024 * 512, 512, 0, scr, r, F.lane); continue; } r -= I6;
        if (r < I7) { transpose_item(kin(22) + (size_t)l * 1024 * 1024, 1024, 0, 32, (bf16*)(kws() + W_OUT), 1024, 0, scr, r, F.lane); continue; } r -= I7;
        if (r < I8) { transpose_item(kin(25) + (size_t)l * 1024 * 4096, 4096, 0, 128, (bf16*)(kws() + W_1), 1024, 0, scr, r, F.lane); continue; } r -= I8;
        if (r < I9) { transpose_item(kin(26) + (size_t)l * 4096 * 1024, 1024, 0, 32, (bf16*)(kws() + W_2), 4096, 0, scr, r, F.lane); continue; } r -= I9;
        if (r < I10) { transpose_item(kin(28) + (size_t)l * 1024 * 1024, 1024, 0, 32, (bf16*)(kws() + W_G), 1024, 0, scr, r, F.lane); continue; } r -= I10;
        transpose_item(kin(29) + (size_t)l * 256 * 1024, 1024, 0, 32, (bf16*)(kws() + W_P), 256, 0, scr, r, F.lane);
    }
    const int gt = F.gw * 64 + F.lane, NTH = F.NGW * 64;
    { bf16* WinT = (bf16*)(kws() + W_IN); for (int i = gt; i < 64 * 1024; i += NTH) WinT[(size_t)448 * 1024 + i] = 0; }
    { const float* w_uq = kin(7) + (size_t)l * 256 * 768; const float* w_ukv = kin(8) + (size_t)l * 128 * 1024; bf16* WqT = (bf16*)(kws() + W_Q);
      for (int i = gt; i < 768 * 256; i += NTH) {
        const int n = i >> 8, kq = i & 255, h = n / 192, ii = n % 192; float s;
        if (ii < 128) { s = 0.f; const float* a = w_uq + (size_t)kq * 768 + h * 192; const float* b = w_ukv + (size_t)ii * 1024 + h * 256;
            for (int nn = 0; nn < 128; ++nn) s = fmaf(a[nn], b[nn], s); }
        else { const int jj = ii - 128, j = jj >> 1; s = w_uq[(size_t)kq * 768 + h * 192 + 128 + ((jj & 1) ? j + 32 : j)]; }
        WqT[i] = (bf16)f2bf(s);
      } }
    { const float* w_ukv = kin(8) + (size_t)l * 128 * 1024; const float* w_br = WBR_; bf16* WbT = (bf16*)(kws() + W_B);
      for (int i = gt; i < 512 * 1024; i += NTH) {
        const int dd = i & 1023, hl = i >> 10, h = hl >> 7, lat = hl & 127; float s = 0.f;
        const float* a = w_ukv + (size_t)lat * 1024 + h * 256 + 128; const float* b = w_br + (size_t)(h * 128) * 1024 + dd;
        for (int v = 0; v < 128; ++v) s = fmaf(a[v], b[(size_t)v * 1024], s);
        WbT[(size_t)dd * 512 + hl] = (bf16)f2bf(s);
      } }
    { const float* w_up = kin(11) + (size_t)l * 64 * 512; const float* a_up = kin(13) + (size_t)l * 64 * 512; const float* g_up = kin(14) + (size_t)l * 128 * 512; bf16* WloT = (bf16*)(kws() + W_LORA);
      for (int i = gt; i < 1536 * 256; i += NTH) {
        const int n = i >> 8, k = i & 255, blk = n >> 9, nn = n & 511; float s = 0.f;
        if (blk == 0) { if (k < 64) s = w_up[(size_t)k * 512 + nn]; } else if (blk == 1) { if (k >= 64 && k < 128) s = a_up[(size_t)(k - 64) * 512 + nn]; } else { if (k >= 128) s = g_up[(size_t)(k - 128) * 512 + nn]; }
        WloT[i] = (bf16)f2bf(s);
      } }
#undef WIN_
#undef WBR_
}
__device__ __forceinline__ void u_rowpass(LAS unsigned char* lds_, int l, bool from_x) {
    const Frame F = make_frame(lds_); unsigned char* ws = kws();
    const float* src = from_x ? kin(0) : kout(); const float* g = kin(3) + l * 1024; bf16* U = (bf16*)(ws + WS_U);
    f32x4 gv[4];
#pragma unroll
    for (int j = 0; j < 4; ++j) gv[j] = *(const f32x4*)(g + 4 * F.lane + 256 * j);
    for (int m = F.gw; m < T; m += F.NGW) {
        const f32x4* xr = (const f32x4*)(src + (size_t)m * D) + F.lane; f32x4 v[4]; float s = 0.f;
#pragma unroll
        for (int j = 0; j < 4; ++j) { v[j] = xr[64 * j]; s += (v[j].x * v[j].x + v[j].y * v[j].y) + (v[j].z * v[j].z + v[j].w * v[j].w); }
        if (from_x) { f32x4* ho = (f32x4*)(kout() + (size_t)m * D) + F.lane;
#pragma unroll
            for (int j = 0; j < 4; ++j) ho[64 * j] = v[j]; }
        const float rs = rsqrtf(wave_sum(s, F.lane) * (1.f / D) + NORM_EPS);
        v2u* o8 = (v2u*)(U + (size_t)m * D) + F.lane;
#pragma unroll
        for (int j = 0; j < 4; ++j) { const f32x4 y = v[j] * rs * gv[j]; v2u w; w.x = pk2(y.x, y.y); w.y = pk2(y.z, y.w); o8[64 * j] = w; }
    }
}
__device__ __forceinline__ void p2_mla_prep(LAS unsigned char* lds_, const Args& A, int l) {
    const Frame F = make_frame(lds_);
    const bf16* ZM = (const bf16*)(kws() + WS_OA); bf16* QN = (bf16*)(kws() + X_QN); bf16* KV = (bf16*)(kws() + X_KV); const float* rope = (const float*)(kws() + WS_ROPE);
    const f32x4 gq = *(const f32x4*)(kin(5) + l * 256 + 4 * F.lane); const float gk0 = kin(6)[l * 128 + 2 * F.lane], gk1 = kin(6)[l * 128 + 2 * F.lane + 1];
    for (int t = F.gw; t < T; t += F.NGW) {
        const bf16* z = ZM + (size_t)t * 512;
        const v2u wq = *(const v2u*)(z + 4 * F.lane); const unsigned wk = *(const unsigned*)(z + 256 + 2 * F.lane); const float kr = bfl((unsigned)z[384 + F.lane]);
        const float q0 = bfl(wq.x), q1 = bfh(wq.x), q2 = bfl(wq.y), q3 = bfh(wq.y), k0 = bfl(wk), k1 = bfh(wk);
        const float rq = rsqrtf(wave_sum(q0 * q0 + q1 * q1 + q2 * q2 + q3 * q3, F.lane) * (1.f / 256.f) + NORM_EPS);
        const float rk = rsqrtf(wave_sum(k0 * k0 + k1 * k1, F.lane) * (1.f / 128.f) + NORM_EPS);
        v2u o; o.x = pk2(q0 * rq * gq.x, q1 * rq * gq.y); o.y = pk2(q2 * rq * gq.z, q3 * rq * gq.w);
        *(v2u*)(QN + (size_t)t * 256 + 4 * F.lane) = o;
        *(unsigned*)(KV + (size_t)t * 192 + 2 * F.lane) = pk2(k0 * rk * gk0, k1 * rk * gk1);
        const float other = shfl_xor_f(kr, 32, F.lane);
        if (F.lane < 32) { const float c = rope[((size_t)t * 32 + F.lane) * 2], s = rope[((size_t)t * 32 + F.lane) * 2 + 1];
            *(unsigned*)(KV + (size_t)t * 192 + 128 + 2 * F.lane) = pk2(kr * c - other * s, other * c + kr * s); }
    }
}
__device__ __forceinline__ void p6_rw_prep(LAS unsigned char* lds_, const Args& A, int l) {
    const Frame F = make_frame(lds_);
    const bf16* ZR = (const bf16*)(kws() + X_ZR); bf16* LA = (bf16*)(kws() + X_LA);
    const f32x4 mu = *(const f32x4*)(kin(9) + l * RW_COLS + 1536 + 4 * F.lane);
    for (int t = F.gw; t < T; t += F.NGW) {
        const v2u wc = *(const v2u*)(ZR + (size_t)t * 1792 + 1536 + 4 * F.lane); v2u wp; wp.x = 0u; wp.y = 0u;
        if ((t & (SEQ - 1)) != 0) wp = *(const v2u*)(ZR + (size_t)(t - 1) * 1792 + 1536 + 4 * F.lane);
        float z[4] = {bfl(wc.x), bfh(wc.x), bfl(wc.y), bfh(wc.y)}; const float p[4] = {bfl(wp.x), bfh(wp.x), bfl(wp.y), bfh(wp.y)}; const float m[4] = {mu.x, mu.y, mu.z, mu.w};
#pragma unroll
        for (int e = 0; e < 4; ++e) { float v = z[e] + (p[e] - z[e]) * m[e]; if (F.lane < 16) v = 1.f - 2.f * __builtin_amdgcn_rcpf(1.f + __builtin_amdgcn_exp2f(2.f * LOG2E * v)); else if (F.lane >= 32) v = fsig(v); z[e] = v; }
        v2u o; o.x = pk2(z[0], z[1]); o.y = pk2(z[2], z[3]); *(v2u*)(LA + (size_t)t * 256 + 4 * F.lane) = o;
    }
}
template <int MODE>
__device__ __forceinline__ void rowpass(LAS unsigned char* lds_, const Args& A, const bf16* M, const float* g1, const float* g2, const float* pl) {
    const Frame F = make_frame(lds_);
    bf16* U = (bf16*)(kws() + WS_U); bf16* PB = (bf16*)(kws() + X_PB);
    f32x4 g1v[4], g2v[4];
#pragma unroll
    for (int j = 0; j < 4; ++j) { g1v[j] = *(const f32x4*)(g1 + 4 * F.lane + 256 * j); if (MODE == 0) g2v[j] = *(const f32x4*)(g2 + 4 * F.lane + 256 * j); }
    for (int m = F.gw; m < T; m += F.NGW) {
        const v2u* mr = (const v2u*)(M + (size_t)m * D) + F.lane; f32x4* hr = (f32x4*)(kout() + (size_t)m * D) + F.lane;
        f32x4 x[4], hv[4]; float s = 0.f;
#pragma unroll
        for (int j = 0; j < 4; ++j) { const v2u w = mr[64 * j]; x[j] = (f32x4){bfl(w.x), bfh(w.x), bfl(w.y), bfh(w.y)}; hv[j] = hr[64 * j]; s += (x[j].x * x[j].x + x[j].y * x[j].y) + (x[j].z * x[j].z + x[j].w * x[j].w); }
        const float rs = rsqrtf(wave_sum(s, F.lane) * (1.f / D) + NORM_EPS); float s2 = 0.f;
#pragma unroll
        for (int j = 0; j < 4; ++j) { hv[j] = hv[j] + x[j] * rs * g1v[j]; hr[64 * j] = hv[j]; s2 += (hv[j].x * hv[j].x + hv[j].y * hv[j].y) + (hv[j].z * hv[j].z + hv[j].w * hv[j].w); }
        v2u* o8 = (v2u*)(U + (size_t)m * D) + F.lane;
        if (MODE == 0) { const float rs2 = rsqrtf(wave_sum(s2, F.lane) * (1.f / D) + NORM_EPS);
#pragma unroll
            for (int j = 0; j < 4; ++j) { const f32x4 y = hv[j] * rs2 * g2v[j]; v2u w; w.x = pk2(y.x, y.y); w.y = pk2(y.z, y.w); o8[64 * j] = w; } }
        else {
#pragma unroll
            for (int j = 0; j < 4; ++j) { v2u w; w.x = pk2(hv[j].x, hv[j].y); w.y = pk2(hv[j].z, hv[j].w); o8[64 * j] = w; }
            const f32x4 pv = *((const f32x4*)(pl + (size_t)m * DPLE) + F.lane); v2u w; w.x = pk2(pv.x, pv.y); w.y = pk2(pv.z, pv.w); *((v2u*)(PB + (size_t)m * DPLE) + F.lane) = w; }
    }
}
namespace rw {
typedef short v4i16_t __attribute__((ext_vector_type(4)));
constexpr int RS = 144;
constexpr int O_AT = 0, O_BT = 9216, O_KT = 18432, O_RT = 27648;
constexpr int O_UV = 36864;
constexpr int O_BK = O_UV + 4 * 32 * RS;
constexpr int O_SB = O_BK + 4 * 32 * RS;
constexpr int O_W1 = O_SB + 64 * RS;
constexpr int O_SM = O_W1 + 64 * RS;
constexpr int O_GC = O_SM + 16 * 1024;
constexpr int O_CB = O_GC + 1024;
constexpr int O_LM = O_CB + 256;
constexpr int O_YO = O_LM + 4096;
constexpr int O_PAR = O_YO + 64 * RS;
constexpr int LDS_END = O_PAR + 512;
static_assert(LDS_END <= RING_BYTES, "rwkv LDS map");
__device__ __forceinline__ bf16x8 trfrag(const LAS unsigned char* p) {
    const s16x4 lo = __builtin_bit_cast(s16x4, __builtin_amdgcn_ds_read_tr16_b64_v4i16((LAS v4i16_t*)p));
    const s16x4 hh = __builtin_bit_cast(s16x4, __builtin_amdgcn_ds_read_tr16_b64_v4i16((LAS v4i16_t*)(p + 4 * RS)));
    return (bf16x8){lo[0], lo[1], lo[2], lo[3], hh[0], hh[1], hh[2], hh[3]};
}
__device__ __forceinline__ void lbar() { asm volatile("s_waitcnt lgkmcnt(0)\n\ts_barrier" ::: "memory"); }
__device__ __forceinline__ void st_bf(LAS unsigned char* p, float x) { *(LAS unsigned short*)p = (unsigned short)h_f2h(__builtin_amdgcn_fmed3f(x, -60000.f, 60000.f)); }
__device__ __forceinline__ float ld_bf(const LAS unsigned char* p) { return bfl((unsigned)*(const LAS unsigned short*)p); }
template <int CTRL> __device__ __forceinline__ float dpp_add(float v) { return v + __int_as_float(__builtin_amdgcn_update_dpp(0, __float_as_int(v), CTRL, 0xf, 0xf, true)); }
__device__ __forceinline__ void wsum8(float (&v)[8], int lane) {
#pragma unroll
    for (int e = 0; e < 8; ++e) { float x = v[e]; x = dpp_add<0xB1>(x); x = dpp_add<0x4E>(x); x = dpp_add<0x141>(x); x = dpp_add<0x140>(x); v[e] = x; }
#pragma unroll
    for (int e = 0; e < 8; ++e) v[e] += shfl_xor_f(v[e], 16, lane);
#pragma unroll
    for (int e = 0; e < 8; ++e) v[e] += shfl_xor_f(v[e], 32, lane);
}
__device__ __forceinline__ void rw_unit(LAS unsigned char* lds, int l, int seq) {
    int tid_ = my_tid(); asm volatile("" : "+v"(tid_));
    const int tid = tid_, lane = tid & 63, w = __builtin_amdgcn_readfirstlane(tid >> 6), g4 = lane >> 4, l15 = lane & 15, q4 = l15 >> 2, p4 = lane & 3;
    const int b = seq >> 3, h = seq & 7;
    const bf16* ZRb = (const bf16*)(kws() + X_ZR) + (size_t)b * SEQ * 1792 + h * 64;
    const bf16* TWb = (const bf16*)(kws() + X_TW) + (size_t)b * SEQ * 512 + h * 64; const bf16* TAb = (const bf16*)(kws() + X_TA) + (size_t)b * SEQ * 512 + h * 64; const bf16* Gb = (const bf16*)(kws() + X_G) + (size_t)b * SEQ * 512 + h * 64;
    bf16* ORWb = (bf16*)(kws() + WS_ORW) + (size_t)b * SEQ * 512 + h * 64;
    LAS float* par = (LAS float*)(lds + O_PAR);
    const int pc = h * 64 + lane;
    const float mu_r = kin(9)[l * RW_COLS + pc], mu_k = kin(9)[l * RW_COLS + 512 + pc], mu_v = kin(9)[l * RW_COLS + 1024 + pc];
    const float k_k = kin(15)[l * 512 + pc], k_a = kin(16)[l * 512 + pc], r_k = kin(17)[l * 512 + pc];
    if (tid < 64) { par[tid] = kin(18)[l * 512 + pc]; par[64 + tid] = kin(19)[l * 512 + pc]; }
    for (int i = tid; i < (O_GC - O_UV) / 4; i += 512) ((LAS unsigned*)(lds + O_UV))[i] = 0u;
    f32x4 Sacc[2] = {{0.f, 0.f, 0.f, 0.f}, {0.f, 0.f, 0.f, 0.f}};
    __syncthreads();
    const int et = tid >> 3, ecg = tid & 7, ei = et >> 4, ett = et & 15;
    const int trrow = 8 * g4 + q4, trrow1 = 8 * (g4 & 1) + q4, trcol = 8 * p4;
    const int ei2 = w >> 1, ehf = w & 1;
    unsigned ptw[16], pcr[8], pck[8], pcv[8], pta[8], ppr, ppk, ppv; v4u pgg;
#define RW_LOADS(TOK0) do { const size_t r0_ = (size_t)(TOK0) + 16 * ei2, rA_ = r0_ + 8 * ehf; \
        _Pragma("unroll") for (int s = 0; s < 16; ++s) ptw[s] = (unsigned)TWb[(r0_ + s) * 512 + lane]; \
        _Pragma("unroll") for (int tt = 0; tt < 8; ++tt) { const bf16* zc_ = ZRb + (rA_ + tt) * 1792 + lane; pcr[tt] = (unsigned)zc_[0]; pck[tt] = (unsigned)zc_[512]; pcv[tt] = (unsigned)zc_[1024]; pta[tt] = (unsigned)TAb[(rA_ + tt) * 512 + lane]; } \
        { const bf16* zp_ = ZRb + (rA_ > 0 ? rA_ - 1 : 0) * 1792 + lane; ppr = (unsigned)zp_[0]; ppk = (unsigned)zp_[512]; ppv = (unsigned)zp_[1024]; if (rA_ == 0) { ppr = 0u; ppk = 0u; ppv = 0u; } } \
        pgg = *(const v4u*)(Gb + (size_t)((TOK0) + et) * 512 + 8 * ecg); } while (0)
    RW_LOADS(0);
    for (int sc = 0; sc < SEQ / 64; ++sc) {
        const int tok0 = sc * 64;
        unsigned twv[16], ucr[8], uck[8], ucv[8], uta[8], upr, upk, upv; v4u ugg;
        {
#pragma unroll
            for (int s = 0; s < 16; ++s) twv[s] = ptw[s];
#pragma unroll
            for (int tt = 0; tt < 8; ++tt) { ucr[tt] = pcr[tt]; uck[tt] = pck[tt]; ucv[tt] = pcv[tt]; uta[tt] = pta[tt]; }
            upr = ppr; upk = ppk; upv = ppv; ugg = pgg;
        }
        {   const int c = lane;
            float cumLo[8], cumHi[8];
            {   asm volatile("" : "+v"(twv[0]), "+v"(twv[1]), "+v"(twv[2]), "+v"(twv[3]), "+v"(twv[4]), "+v"(twv[5]), "+v"(twv[6]), "+v"(twv[7]), "+v"(twv[8]), "+v"(twv[9]), "+v"(twv[10]), "+v"(twv[11]), "+v"(twv[12]), "+v"(twv[13]), "+v"(twv[14]), "+v"(twv[15]));
                float run = 0.f;
#pragma unroll
                for (int s = 0; s < 16; ++s) { run += bfl(twv[s]); if (s < 8) cumLo[s] = run; else cumHi[s - 8] = run; } }
            const float tot = cumHi[7];
            const float fh = ehf ? 1.f : 0.f;
            const float gctot = __builtin_amdgcn_exp2f(LOG2E * tot);
            if (ehf == 0) ((LAS float*)(lds + O_GC))[ei2 * 64 + c] = gctot;
            float pr = bfl(upr), pk = bfl(upk), pv = bfl(upv);
            float rr[8], kkv[8], av[8], kmv[8], vv[8], ss[8], cbv[8];
            {   float cr[8], ck[8], cv[8], ta[8];
                asm volatile("" : "+v"(ucr[0]), "+v"(ucr[1]), "+v"(ucr[2]), "+v"(ucr[3]), "+v"(ucr[4]), "+v"(ucr[5]), "+v"(ucr[6]), "+v"(ucr[7]), "+v"(uck[0]), "+v"(uck[1]), "+v"(uck[2]), "+v"(uck[3]), "+v"(uck[4]), "+v"(uck[5]), "+v"(uck[6]), "+v"(uck[7]),
                                  "+v"(ucv[0]), "+v"(ucv[1]), "+v"(ucv[2]), "+v"(ucv[3]), "+v"(ucv[4]), "+v"(ucv[5]), "+v"(ucv[6]), "+v"(ucv[7]));
                asm volatile("" : "+v"(uta[0]), "+v"(uta[1]), "+v"(uta[2]), "+v"(uta[3]), "+v"(uta[4]), "+v"(uta[5]), "+v"(uta[6]), "+v"(uta[7]));
#pragma unroll
                for (int tt = 0; tt < 8; ++tt) { cr[tt] = bfl(ucr[tt]); ck[tt] = bfl(uck[tt]); cv[tt] = bfl(ucv[tt]); ta[tt] = bfl(uta[tt]); }
#pragma unroll
                for (int tt = 0; tt < 8; ++tt) {
                    const float r = cr[tt] + (pr - cr[tt]) * mu_r, k = ck[tt] + (pk - ck[tt]) * mu_k, v = cv[tt] + (pv - cv[tt]) * mu_v; pr = cr[tt]; pk = ck[tt]; pv = cv[tt];
                    const float a = ta[tt], kk = k * k_k, km = k * (1.f + (a - 1.f) * k_a);
                    rr[tt] = r; kkv[tt] = kk; av[tt] = a; kmv[tt] = km; vv[tt] = v; ss[tt] = kk * kk; cbv[tt] = r * km * r_k; } }
            wsum8(ss, lane); wsum8(cbv, lane);
#pragma unroll
            for (int tt = 0; tt < 8; ++tt) { const int t = 8 * ehf + tt;
                const float cu = cumLo[tt] + fh * (cumHi[tt] - cumLo[tt]); const float pl = tt ? cumLo[tt - 1] : 0.f, ph = tt ? cumHi[tt - 1] : cumLo[7]; const float cprev = pl + fh * (ph - pl);
                const float gg = __builtin_amdgcn_exp2f(LOG2E * cu), gp = __builtin_amdgcn_exp2f(LOG2E * cprev), gi = __builtin_amdgcn_exp2f(-LOG2E * cu), gh = gctot * gi;
                const float kn = kkv[tt] * rsqrtf(fmaxf(ss[tt], 1e-24f)), ka = kn * av[tt];
                const int ro = (16 * ei2 + t) * RS + 2 * c;
                st_bf(lds + O_AT + ro, -kn * gp); st_bf(lds + O_BT + ro, ka * gi); st_bf(lds + O_KT + ro, kmv[tt] * gi); st_bf(lds + O_RT + ro, rr[tt] * gg);
                st_bf(lds + O_BK + (ei2 * 32 + t) * RS + 2 * c, ka * gh); st_bf(lds + O_BK + (ei2 * 32 + 16 + t) * RS + 2 * c, kmv[tt] * gh);
                st_bf(lds + O_UV + (ei2 * 32 + 16 + t) * RS + 2 * c, vv[tt]);
                if (c == 0) ((LAS float*)(lds + O_CB))[16 * ei2 + t] = cbv[tt]; }
        }
        { const int nxt = (sc + 1 < SEQ / 64) ? tok0 + 64 : tok0; RW_LOADS(nxt); }
        lbar();
        {   const int i = w & 3, hf = w >> 2;
            const LAS unsigned char* xa = lds + (hf ? O_RT : O_AT) + (16 * i + l15) * RS + 16 * g4;
            const LAS unsigned char* xb = lds + O_BT + (16 * i + l15) * RS + 16 * g4; const LAS unsigned char* xk = lds + O_KT + (16 * i + l15) * RS + 16 * g4;
            f32x4 c1 = {0.f, 0.f, 0.f, 0.f}, c2 = {0.f, 0.f, 0.f, 0.f};
#pragma unroll
            for (int ks = 0; ks < 2; ++ks) { const bf16x8 a = *(const LAS bf16x8*)(xa + 64 * ks);
                c1 = MFMA16(a, *(const LAS bf16x8*)(xb + 64 * ks), c1);
                c2 = MFMA16(a, *(const LAS bf16x8*)(xk + 64 * ks), c2); }
#pragma unroll
            for (int r = 0; r < 4; ++r) { const int t = 4 * g4 + r; const bool keep = hf ? (l15 <= t) : (l15 < t); const float v1 = keep ? c1[r] : 0.f, v2 = keep ? c2[r] : 0.f;
                if (hf == 0) { ((LAS float*)(lds + O_LM))[(i * 16 + t) * 16 + l15] = v1; st_bf(lds + O_SM + (4 + i) * 1024 + t * 64 + 2 * l15, v2); }
                else { st_bf(lds + O_SM + (8 + i) * 1024 + t * 64 + 2 * l15, v1); st_bf(lds + O_SM + (12 + i) * 1024 + t * 64 + 2 * l15, v2); } }
        }
        lbar();
        if (w < 4) { if (lane < 16) { const LAS float* Lm = (const LAS float*)(lds + O_LM) + w * 256; float acc[16];
#pragma unroll
                for (int t = 0; t < 16; ++t) acc[t] = (t == lane) ? 1.f : 0.f;
#pragma unroll
                for (int s = 0; s < 15; ++s) { const float xs = acc[s];
#pragma unroll
                    for (int t = s + 1; t < 16; ++t) acc[t] = fmaf(Lm[t * 16 + s], xs, acc[t]); }
#pragma unroll
                for (int t = 0; t < 16; ++t) st_bf(lds + O_SM + w * 1024 + t * 64 + 2 * lane, acc[t]); } }
        else { const int i = w - 4; const bf16x8 am = *(const LAS bf16x8*)(lds + O_SM + (4 + i) * 1024 + l15 * 64 + 16 * g4);
#pragma unroll
            for (int ct = 0; ct < 4; ++ct) { f32x4 acc = {0.f, 0.f, 0.f, 0.f};
                acc = MFMA16(am, trfrag(lds + O_UV + (i * 32 + 16 + trrow1) * RS + 32 * ct + trcol), acc);
#pragma unroll
                for (int r = 0; r < 4; ++r) st_bf(lds + O_W1 + (16 * i + 4 * g4 + r) * RS + 2 * (16 * ct + l15), acc[r]); } }
        lbar();
        f32x4 wy[4];
        {   const int ct = w & 3; const int base = (w < 4) ? O_W1 : O_AT;
#pragma unroll
            for (int i = 0; i < 4; ++i) { const bf16x8 tm = *(const LAS bf16x8*)(lds + O_SM + i * 1024 + l15 * 64 + 16 * g4); f32x4 acc = {0.f, 0.f, 0.f, 0.f};
                acc = MFMA16(tm, trfrag(lds + base + (16 * i + trrow1) * RS + 32 * ct + trcol), acc);
                if (w < 4) wy[i] = acc;
#pragma unroll
                for (int r = 0; r < 4; ++r) st_bf(lds + base + (16 * i + 4 * g4 + r) * RS + 2 * (16 * ct + l15), acc[r]); } }
        lbar();
        {   const int ct = w & 3;
#pragma unroll
            for (int i = 0; i < 4; ++i) { const bf16x8 arb = *(const LAS bf16x8*)(lds + O_SM + (8 + i) * 1024 + l15 * 64 + 16 * g4);
                if (w >= 4) { const bf16x8 ark = *(const LAS bf16x8*)(lds + O_SM + (12 + i) * 1024 + l15 * 64 + 16 * g4); f32x4 acc = {0.f, 0.f, 0.f, 0.f};
                    acc = MFMA16(arb, trfrag(lds + O_W1 + (16 * i + trrow1) * RS + 32 * ct + trcol), acc);
                    acc = MFMA16(ark, trfrag(lds + O_UV + (i * 32 + 16 + trrow1) * RS + 32 * ct + trcol), acc);
                    wy[i] = acc; }
                else { f32x4 acc;
#pragma unroll
                    for (int r = 0; r < 4; ++r) acc[r] = ld_bf(lds + O_RT + (16 * i + 4 * g4 + r) * RS + 2 * (16 * ct + l15));
                    acc = MFMA16(arb, trfrag(lds + O_AT + (16 * i + trrow1) * RS + 32 * ct + trcol), acc);
#pragma unroll
                    for (int r = 0; r < 4; ++r) st_bf(lds + O_RT + (16 * i + 4 * g4 + r) * RS + 2 * (16 * ct + l15), acc[r]); } } }
        lbar();
#pragma unroll
        for (int i = 0; i < 4; ++i) {
            {
                const int v0 = 16 * (w & 3); f32x4 acc = wy[i];
                const LAS unsigned char* xa = lds + ((w < 4) ? O_AT : O_RT) + (16 * i + l15) * RS + 16 * g4; const LAS unsigned char* sb = lds + O_SB + (v0 + l15) * RS + 16 * g4;
#pragma unroll
                for (int ks = 0; ks < 2; ++ks) acc = MFMA16(*(const LAS bf16x8*)(xa + 64 * ks), *(const LAS bf16x8*)(sb + 64 * ks), acc);
                LAS unsigned char* dst = (w < 4) ? (lds + O_UV + (i * 32 + 4 * g4) * RS + 2 * (v0 + l15)) : (lds + O_YO + (16 * i + 4 * g4) * RS + 2 * (v0 + l15));
#pragma unroll
                for (int r = 0; r < 4; ++r) st_bf(dst + r * RS, acc[r]);
            }
            lbar();
            {
#pragma unroll
                for (int j = 0; j < 2; ++j) { const int id = 2 * w + j, vt = id >> 2, kt = id & 3;
                    const float gc = ((const LAS float*)(lds + O_GC))[i * 64 + 16 * kt + l15];
                    f32x4 acc = Sacc[j] * gc;
                    acc = MFMA16(trfrag(lds + O_UV + (i * 32 + trrow) * RS + 32 * vt + trcol), trfrag(lds + O_BK + (i * 32 + trrow) * RS + 32 * kt + trcol), acc);
                    Sacc[j] = acc;
#pragma unroll
                    for (int r = 0; r < 4; ++r) st_bf(lds + O_SB + (16 * vt + 4 * g4 + r) * RS + 2 * (16 * kt + l15), acc[r]); }
            }
            lbar();
        }
        {   float y[8], vv[8], gg[8];
            pg8::unpack8(*(const LAS v4u*)(lds + O_YO + et * RS + 16 * ecg), y); pg8::unpack8(*(const LAS v4u*)(lds + O_UV + (ei * 32 + 16 + ett) * RS + 16 * ecg), vv);
            pg8::unpack8(ugg, gg);
            float s = 0.f;
#pragma unroll
            for (int e = 0; e < 8; ++e) s += y[e];
            s = dpp_add<0xB1>(s); s = dpp_add<0x4E>(s); s = dpp_add<0x141>(s);
            const float mean = s * (1.f / 64.f); float q = 0.f;
#pragma unroll
            for (int e = 0; e < 8; ++e) { y[e] -= mean; q += y[e] * y[e]; }
            q = dpp_add<0xB1>(q); q = dpp_add<0x4E>(q); q = dpp_add<0x141>(q);
            const float rstd = rsqrtf(q * (1.f / 64.f) + RW_LN_EPS), cb = ((const LAS float*)(lds + O_CB))[et];
            float o[8];
#pragma unroll
            for (int e = 0; e < 8; ++e) { const int c = 8 * ecg + e; o[e] = (y[e] * rstd * par[c] + par[64 + c] + cb * vv[e]) * gg[e]; }
            v4u wo; wo.x = pk2(o[0], o[1]); wo.y = pk2(o[2], o[3]); wo.z = pk2(o[4], o[5]); wo.w = pk2(o[6], o[7]);
            *(v4u*)(ORWb + (size_t)(tok0 + et) * 512 + 8 * ecg) = wo;
        }
        lbar();
    }
}
}
#ifndef PROBE_DBL
#define PROBE_DBL -1
#endif
__global__ void __launch_bounds__(NWAVES * 64, 2) mk_fwd(Args args) {
    extern __shared__ __attribute__((aligned(16))) unsigned char lds[];
    LAS unsigned char* const L = (LAS unsigned char*)lds;
    for (int u = threadIdx.x; u < (LDS_BYTES - LDSCTL_OFF) / 4; u += NWAVES * 64) ((LAS unsigned*)(L + LDSCTL_OFF))[u] = 0u;
    __syncthreads();
    static_assert(LDSCTL_OFF == MK_WAVETAB_LDS, "wave table address");
    if ((threadIdx.x & 63) == 0) ((LAS unsigned*)(L + LDSCTL_OFF))[(unsigned)__builtin_amdgcn_s_getreg((5 << 11) | 4) & 63u] = threadIdx.x >> 6;
    __syncthreads();
    XcdBarrier bar = xcd_barrier_post((unsigned*)(kws() + WS_CTL) + CW_BAR, (volatile LAS unsigned*)(L + MISC_OFF) + 8);
#define GRID_BAR() xcd_barrier(bar)
#if defined(DBG_BISECT)
#define IN(k) (l > 0 || ((k) >= kstart() && (k) <= kstop()) || ((k) == 9 && kstop() == 99))
#define LAYER_END() do { if (kstop() < 100) return; } while (0)
#else
#define IN(k) true
#define LAYER_END() do { } while (0)
#endif
#define PTRS() unsigned char* ws = opq(kws()); \
    bf16* U = (bf16*)(ws + WS_U); bf16* OA = (bf16*)(ws + WS_OA); bf16* OC = (bf16*)(ws + WS_OC); bf16* ORW = (bf16*)(ws + WS_ORW); \
    bf16* WinT = (bf16*)(ws + W_IN); bf16* WqT = (bf16*)(ws + W_Q); bf16* WloT = (bf16*)(ws + W_LORA); bf16* WbT = (bf16*)(ws + W_B); bf16* WoT = (bf16*)(ws + W_OUT); \
    bf16* W1T = (bf16*)(ws + W_1); bf16* W2T = (bf16*)(ws + W_2); bf16* WgT = (bf16*)(ws + W_G); bf16* WpT = (bf16*)(ws + W_P); \
    bf16* ZC = (bf16*)(ws + X_ZC); bf16* QN = (bf16*)(ws + X_QN); bf16* QP = (bf16*)(ws + X_QP); bf16* KV = (bf16*)(ws + X_KV); \
    bf16* ZR = (bf16*)(ws + X_ZR); bf16* LA = (bf16*)(ws + X_LA); bf16* TW = (bf16*)(ws + X_TW); bf16* TA = (bf16*)(ws + X_TA); bf16* GG = (bf16*)(ws + X_G); \
    bf16* GT = (bf16*)(ws + X_GT); bf16* MG = (bf16*)(ws + X_MG); bf16* HID = (bf16*)(ws + X_HID); bf16* PB = (bf16*)(ws + X_PB); bf16* PP = (bf16*)(ws + X_PP); bf16* M2 = OA; \
    (void)U; (void)OA; (void)OC; (void)ORW; (void)WinT; (void)WqT; (void)WloT; (void)WbT; (void)WoT; (void)W1T; (void)W2T; (void)WgT; (void)WpT; (void)ZC; (void)QN; (void)QP; (void)KV; (void)ZR; (void)LA; (void)TW; (void)TA; (void)GG; (void)GT; (void)MG; (void)HID; (void)PB; (void)PP; (void)M2;
    typedef pg8::StaticOrder SO;
#define GEMM(EPI, Aptr, Bptr, N_, K_, Eobj) do { int bx_ = blockIdx.x; asm volatile("" : "+s"(bx_)); int G_ = gridDim.x; asm volatile("" : "+s"(G_)); pg8::Gemm g_{Aptr, Bptr, T, N_, K_}; SO S_; S_.init(T, N_, G_, bx_); pg8::gemm_phase<EPI, SO, true, true>(L + RING_OFF, g_, S_, Eobj); } while (0)
#define PH(n) for (int rep_ = 0; rep_ < ((PROBE_DBL == (n)) ? 2 : 1); ++rep_) if (IN(n))
    typedef pg8::EpiRoute<0> ER0;
    rope_table(L);
    for (int l = 0; l < DEPTH; ++l) {
        PH(0) { p0_prologue(L, args, l); u_rowpass(L, l, l == 0); GRID_BAR(); }
        PH(1) { PTRS(); ER0 E{OA, 512, 2, ZC, 1536, 6, 2, CA_QSCALE, ZR, 1792}; GEMM(ER0, U, WinT, 3840, 1024, E); GRID_BAR(); }
        PH(2) { p2_mla_prep(L, args, l); p6_rw_prep(L, args, l); GRID_BAR(); }
        PH(3) { PTRS(); pg8::EpiQRope E{QP, (const float*)(ws + WS_ROPE), MLA_QSCALE}; GEMM(pg8::EpiQRope, QN, WqT, 768, 256, E);
                pg8::EpiSig E2{TW, kin(10) + l * 512, -0.6065306597126334f}; GEMM(pg8::EpiSig, LA, WloT, 512, 256, E2);
                pg8::EpiSig E3{TA, kin(12) + l * 512, 1.f}; GEMM(pg8::EpiSig, LA, WloT + (size_t)512 * 256, 512, 256, E3);
                ER0 E4{GG, 512, 2, GG, 512, 0, 0, 1.f, GG, 512}; GEMM(ER0, LA, WloT + (size_t)1024 * 256, 512, 256, E4); GRID_BAR(); }
        PH(4) { PTRS();
            if (blockIdx.x < 64) rw::rw_unit(L + RING_OFF, l, (int)blockIdx.x);
            volatile LAS unsigned* qs = (volatile LAS unsigned*)(L + MISC_OFF) + 12; unsigned* qhead = (unsigned*)(ws + WS_CTL) + CW_QUEUE + 64 * l + 16 * rep_;
            for (;;) {
                __syncthreads();
                if (my_tid() == 0) *qs = atomicAdd(qhead, 1u);
                __syncthreads();
                const unsigned u = *qs;
                if (u >= 1280u) break;
                if (u < 256u) { const int b = (int)u >> 5, cc = (int)u & 31; att::mla_unit(L + RING_OFF, QP, KV, OA, b, 63 - cc); att::mla_unit(L + RING_OFF, QP, KV, OA, b, cc); }
                else { const int bi = (int)u - 256; att::band_unit(L + RING_OFF, ZC, kin(20) + (size_t)l * 320 * 8, OC, bi >> 7, (bi >> 4) & 7, bi & 15); }
            }
            GRID_BAR(); }
        PH(5) { u_rowpass(L, l, false); GRID_BAR(); }
        PH(9) { PTRS(); ER0 E{GT, 3072, 12, GT, 3072, 0, 0, 1.f, GT, 3072}; GEMM(ER0, U, WinT + (size_t)3840 * 1024, 3072, 1024, E); GRID_BAR(); }
        PH(10) { PTRS(); pg8::EpiMerge<0> E0{MG, GT}; GEMM(pg8::EpiMerge<0>, OA, WbT, 1024, 512, E0);
                 pg8::EpiMerge<1> E1{MG, GT}; GEMM(pg8::EpiMerge<1>, ORW, WbT + (size_t)1024 * 512, 1024, 512, E1);
                 pg8::EpiMerge<2> E2{MG, GT}; GEMM(pg8::EpiMerge<2>, OC, WbT + (size_t)2 * 1024 * 512, 1024, 512, E2); GRID_BAR(); }
        PH(11) { PTRS(); ER0 E{M2, 1024, 4, M2, 1024, 0, 0, 1.f, M2, 1024}; GEMM(ER0, MG, WoT, 1024, 1024, E); GRID_BAR(); }
        if (IN(12)) { PTRS(); rowpass<0>(L, args, M2, kin(23) + l * 1024, kin(24) + l * 1024, nullptr); GRID_BAR(); }
        PH(13) { PTRS(); pg8::EpiRoute<2> E{HID, 4096, 16, HID, 4096, 0, 0, 1.f, HID, 4096}; GEMM(pg8::EpiRoute<2>, U, W1T, 4096, 1024, E); GRID_BAR(); }
        PH(14) { PTRS(); ER0 E{M2, 1024, 4, M2, 1024, 0, 0, 1.f, M2, 1024}; GEMM(ER0, HID, W2T, 1024, 4096, E); GRID_BAR(); }
        if (IN(15)) { PTRS(); rowpass<1>(L, args, M2, kin(27) + l * 1024, nullptr, kin(1) + (size_t)l * T * DPLE); GRID_BAR(); }
        PH(16) { PTRS(); ER0 E{PP, 1024, 4, PP, 1024, 0, 0, 1.f, PP, 1024}; GEMM(ER0, PB, WpT, 1024, 256, E); GRID_BAR(); }
        if (IN(17)) { PTRS(); pg8::EpiPle E{kout(), PP}; GEMM(pg8::EpiPle, U, WgT, 1024, 1024, E); }
        LAYER_END();
        if (l + 1 < DEPTH) GRID_BAR();
    }
}

#if !defined(DBG_BISECT)
extern "C" void kernel_launch(void* const* d_in, const int* in_sizes, int n_in, void* d_out, int out_size, void* d_ws, size_t ws_size, hipStream_t stream) {
    static int grid = 0;
    if (grid == 0) {
        if (n_in != 30 || out_size != T * D || ws_size < (size_t)WS_END) { fprintf(stderr, "kernel_launch: unexpected shapes (n_in %d out %d ws %zu, need ws >= %zu)\n", n_in, out_size, ws_size, (size_t)WS_END); grid = -1; return; }
        int dev = 0, cus = 0, per_cu = 0;
        if (hipGetDevice(&dev) != hipSuccess || hipDeviceGetAttribute(&cus, hipDeviceAttributeMultiprocessorCount, dev) != hipSuccess) { grid = -1; return; }
        if (hipFuncSetAttribute((const void*)mk_fwd, hipFuncAttributeMaxDynamicSharedMemorySize, LDS_BYTES) != hipSuccess) { fprintf(stderr, "kernel_launch: hipFuncSetAttribute failed\n"); grid = -1; return; }
        if (hipOccupancyMaxActiveBlocksPerMultiprocessor(&per_cu, (const void*)mk_fwd, NWAVES * 64, LDS_BYTES) != hipSuccess || per_cu < 1) { fprintf(stderr, "kernel_launch: occupancy query says %d\n", per_cu); }
        (void)hipGetLastError();
        grid = cus;
    }
    if (grid < 0) return;
    if (hipMemsetAsync((char*)d_ws + WS_CTL, 0, CTL_ZERO_BYTES, stream) != hipSuccess) return;
    Args a{};
    for (int i = 0; i < 30; ++i) a.in[i] = (const float*)d_in[i];
    a.out = (float*)d_out; a.ws = (unsigned char*)d_ws; a.start = 0; a.stop = 1000;
    hipLaunchKernelGGL(mk_fwd, dim3(grid), dim3(NWAVES * 64), LDS_BYTES, stream, a);
}
#endif
```

```cpp
#include <hip/hip_runtime.h>
#include <cstdio>
#include <cstdint>
#include <cmath>
typedef _Float16 h16x8_t __attribute__((ext_vector_type(8)));
typedef _Float16 h16x2_t __attribute__((ext_vector_type(2)));
typedef short s16x8_t __attribute__((ext_vector_type(8)));
typedef float f32x4_t_ __attribute__((ext_vector_type(4)));
typedef float f32x16_t_ __attribute__((ext_vector_type(16)));
__device__ __forceinline__ unsigned h_pk2(float lo, float hi) { const h16x2_t v = {(_Float16)lo, (_Float16)hi}; return __builtin_bit_cast(unsigned, v); }
__device__ __forceinline__ unsigned h_f2h(float f) { return (unsigned)__builtin_bit_cast(unsigned short, (_Float16)f); }
__device__ __forceinline__ float h_lo(unsigned w) { return (float)__builtin_bit_cast(_Float16, (unsigned short)(w & 0xffffu)); }
__device__ __forceinline__ float h_hi(unsigned w) { return (float)__builtin_bit_cast(_Float16, (unsigned short)(w >> 16)); }
__device__ __forceinline__ f32x4_t_ MFMA16(s16x8_t a, s16x8_t b, f32x4_t_ c) { return __builtin_amdgcn_mfma_f32_16x16x32_f16(__builtin_bit_cast(h16x8_t, a), __builtin_bit_cast(h16x8_t, b), c, 0, 0, 0); }
__device__ __forceinline__ f32x16_t_ MFMA32(s16x8_t a, s16x8_t b, f32x16_t_ c) { return __builtin_amdgcn_mfma_f32_32x32x16_f16(__builtin_bit_cast(h16x8_t, a), __builtin_bit_cast(h16x8_t, b), c, 0, 0, 0); }
#define MK_WAVETAB_LDS 131072
__device__ __forceinline__ int my_tid() {
    const unsigned hw = (unsigned)__builtin_amdgcn_s_getreg((5 << 11) | 4) & 63u;
    const unsigned wv = (unsigned)__builtin_amdgcn_readfirstlane((int)((volatile __attribute__((address_space(3))) unsigned*)MK_WAVETAB_LDS)[hw]);
    unsigned lane; asm volatile("v_mbcnt_lo_u32_b32 %0, -1, 0\n\tv_mbcnt_hi_u32_b32 %0, -1, %0" : "=v"(lane));
    return (int)(wv * 64u + lane);
}
namespace pg8 {
#define PG8_LAS __attribute__((address_space(3)))
typedef unsigned short bf16_t;
typedef short bf16x8 __attribute__((ext_vector_type(8)));
typedef float f32x4 __attribute__((ext_vector_type(4)));
typedef unsigned u32x4 __attribute__((ext_vector_type(4)));
constexpr int BM = 256, BK = 64, HALF = 128, HTB = HALF * BK * 2  , STAGE_BYTES = 8 * HTB, NXCD = 8, WGM = 8;

__host__ __device__ __forceinline__ int lds_byte(int r, int c) { const int st = (r >> 4) * 2 + (c >> 5), rr = r & 15, cc = c & 31, ob = rr * 64 + cc * 2; return st * 1024 + (ob ^ (((ob >> 9) & 1) << 5)); }
__host__ __device__ __forceinline__ void stage_rc(int b, int& R, int& C) { const int st = b / 1024, sb = b % 1024, swz = sb ^ (((sb >> 9) & 1) << 5); R = (st >> 1) * 16 + swz / 64; C = (st & 1) * 32 + (swz % 64) / 2; }
__host__ __device__ __forceinline__ int perm32(int rho) { const int n = rho >> 4, i = rho & 15; return 8 * (i >> 2) + 4 * n + (i & 3); }

struct Unit { int pm, pn; };
struct Gemm { const bf16_t* A; const bf16_t* Bt; int M, N, K; };

struct StaticOrder {
    int nM, nN, nwg, G, c;
    __host__ __device__ void init(int M, int N, int G_, int c_) { nM = M / BM; nN = N / BM; nwg = nM * nN; G = G_; c = c_; }
    __host__ __device__ bool next(int i, Unit& u) const {
        const long L = (long)i * G + c; if (L >= nwg) return false;
        int wgid = (int)L; { const int q = nwg / NXCD, r = nwg % NXCD, xcd = wgid % NXCD, off = wgid / NXCD; wgid = (xcd < r ? xcd * (q + 1) : r * (q + 1) + (xcd - r) * q) + off; }
        const int nig = WGM * nN, gid = wgid / nig, fm = gid * WGM, gsz = (nM - fm) < WGM ? (nM - fm) : WGM;
        u.pm = fm + ((wgid % nig) % gsz); u.pn = (wgid % nig) / gsz; return true;
    }
    __device__ __forceinline__ void a_ready(const Unit&) const {}
    __device__ __forceinline__ void done(const Unit&) const {}
};

__device__ __forceinline__ unsigned cvt_pk_bf16(float lo, float hi) { typedef __fp16 hp2 __attribute__((ext_vector_type(2))); const hp2 v = __builtin_amdgcn_cvt_pkrtz(lo, hi); return __builtin_bit_cast(unsigned, v); }
typedef float f32x2 __attribute__((ext_vector_type(2)));
__device__ __forceinline__ f32x2 gelu_pk(f32x2 v) {
    const f32x2 av = __builtin_elementwise_abs(v), d = av * 0.2316418882f + 1.0f;
    f32x2 t; t.x = __builtin_amdgcn_rcpf(d.x); t.y = __builtin_amdgcn_rcpf(d.y);
    f32x2 q = t * 0.5307027145f + (-0.7265760135f); q = q * t + 0.7107068705f; q = q * t + (-0.142248368f); q = q * t + 0.127414796f; q = q * t;
    const f32x2 s = (v * v) * (-0.72134752044f);
    f32x2 e; e.x = __builtin_amdgcn_exp2f(s.x); e.y = __builtin_amdgcn_exp2f(s.y);
    const f32x2 m = v * (q * e), r = v - m;
    f32x2 o; o.x = v.x < 0.f ? m.x : r.x; o.y = v.y < 0.f ? m.y : r.y; return o;
}

template <int ACT  > struct EpiBf16 {
    static constexpr bool PERM = true, AFTER_DRAIN = false; static_assert(ACT == 0 || ACT == 1, "EpiBf16: ACT is 0 (none) or 1 (gelu_pk)");
    bf16_t* O; int ldc; const float* bias; int split_cols; size_t split_stride; float scale0;
    __device__ __forceinline__ void operator()(const f32x4 (&acc)[2][2][4][2], const Unit& u, int wr, int wc, int fr, int fq) const {
        const int row0 = u.pm * BM + wr * 64 + fr; int colt = u.pn * BM; bf16_t* base = O;
        float sc = 1.f; if (split_cols) { const int t = colt / split_cols; base += (size_t)t * split_stride; colt -= t * split_cols; if (t == 0) sc = scale0; }
        const int col0 = colt + wc * 32 + 8 * fq, bcol0 = u.pn * BM + wc * 32 + 8 * fq;
        f32x4 bv[2][2];
#pragma unroll
        for (int bj = 0; bj < 2; ++bj)
#pragma unroll
            for (int n = 0; n < 2; ++n) bv[bj][n] = bias ? *(const f32x4*)(bias + bcol0 + bj * HALF + 4 * n) : (f32x4){0.f, 0.f, 0.f, 0.f};
#pragma unroll
        for (int ai = 0; ai < 2; ++ai)
#pragma unroll
            for (int m = 0; m < 4; ++m) { bf16_t* rowp = base + (size_t)(row0 + ai * HALF + m * 16) * ldc + col0;
#pragma unroll
                for (int bj = 0; bj < 2; ++bj) { f32x4 v0 = acc[ai][bj][m][0] + bv[bj][0], v1 = acc[ai][bj][m][1] + bv[bj][1];
                    if (ACT == 1) { f32x2 a = gelu_pk((f32x2){v0[0], v0[1]}), b = gelu_pk((f32x2){v0[2], v0[3]}), c = gelu_pk((f32x2){v1[0], v1[1]}), d = gelu_pk((f32x2){v1[2], v1[3]});
                        v0 = (f32x4){a.x, a.y, b.x, b.y}; v1 = (f32x4){c.x, c.y, d.x, d.y}; }
                    v0 = v0 * sc; v1 = v1 * sc; u32x4 w; w.x = cvt_pk_bf16(v0[0], v0[1]); w.y = cvt_pk_bf16(v0[2], v0[3]); w.z = cvt_pk_bf16(v1[0], v1[1]); w.w = cvt_pk_bf16(v1[2], v1[3]);
                    *(u32x4*)(rowp + bj * HALF) = w; } }
    }
};
__device__ __forceinline__ float bf2f(unsigned short b) { return h_lo((unsigned)b); }
__device__ __forceinline__ float sigm(float x) { return __builtin_amdgcn_rcpf(1.0f + __builtin_amdgcn_exp2f(-1.4426950408889634f * x)); }
__device__ __forceinline__ void unpack8(const u32x4 w, float (&f)[8]) {
    f[0] = h_lo(w.x); f[1] = h_hi(w.x); f[2] = h_lo(w.y); f[3] = h_hi(w.y); f[4] = h_lo(w.z); f[5] = h_hi(w.z); f[6] = h_lo(w.w); f[7] = h_hi(w.w);
}
template <int ACT> struct EpiRoute {
    static constexpr bool PERM = true, AFTER_DRAIN = false;
    bf16_t* O0; int ld0; int nt0;
    bf16_t* O1; int ld1; int nt1; int nts1; float sc1;
    bf16_t* O2; int ld2;
    __device__ __forceinline__ void operator()(const f32x4 (&acc)[2][2][4][2], const Unit& u, int wr, int wc, int fr, int fq) const {
        const int row0 = u.pm * BM + wr * 64 + fr;
        bf16_t* base; int ld, colt; float sc = 1.f;
        if (u.pn < nt0) { base = O0; ld = ld0; colt = u.pn * BM; }
        else if (u.pn < nt0 + nt1) { base = O1; ld = ld1; colt = (u.pn - nt0) * BM; if (u.pn - nt0 < nts1) sc = sc1; }
        else { base = O2; ld = ld2; colt = (u.pn - nt0 - nt1) * BM; }
        const int col0 = colt + wc * 32 + 8 * fq;
#pragma unroll
        for (int ai = 0; ai < 2; ++ai)
#pragma unroll
            for (int m = 0; m < 4; ++m) { bf16_t* rowp = base + (size_t)(row0 + ai * HALF + m * 16) * ld + col0;
#pragma unroll
                for (int bj = 0; bj < 2; ++bj) { f32x4 v0 = acc[ai][bj][m][0], v1 = acc[ai][bj][m][1];
                    if (ACT == 2) { for (int e = 0; e < 4; ++e) { const float a = fmaxf(v0[e], 0.f), b = fmaxf(v1[e], 0.f); v0[e] = a * a; v1[e] = b * b; } }
                    v0 = v0 * sc; v1 = v1 * sc; u32x4 w; w.x = cvt_pk_bf16(v0[0], v0[1]); w.y = cvt_pk_bf16(v0[2], v0[3]); w.z = cvt_pk_bf16(v1[0], v1[1]); w.w = cvt_pk_bf16(v1[2], v1[3]);
                    *(u32x4*)(rowp + bj * HALF) = w; } }
    }
};
struct EpiSig {
    static constexpr bool PERM = true, AFTER_DRAIN = false;
    bf16_t* O; const float* p; float scale;
    __device__ __forceinline__ void operator()(const f32x4 (&acc)[2][2][4][2], const Unit& u, int wr, int wc, int fr, int fq) const {
        const int row0 = u.pm * BM + wr * 64 + fr; const int col0 = u.pn * BM + wc * 32 + 8 * fq;
        const f32x4 pA0 = *(const f32x4*)(p + col0), pA1 = *(const f32x4*)(p + col0 + 4), pB0 = *(const f32x4*)(p + col0 + HALF), pB1 = *(const f32x4*)(p + col0 + HALF + 4);
#pragma unroll
        for (int ai = 0; ai < 2; ++ai)
#pragma unroll
            for (int m = 0; m < 4; ++m) { bf16_t* rowp = O + (size_t)(row0 + ai * HALF + m * 16) * 512 + col0;
#pragma unroll
                for (int bj = 0; bj < 2; ++bj) { f32x4 v0 = acc[ai][bj][m][0], v1 = acc[ai][bj][m][1]; const f32x4 p0 = bj ? pB0 : pA0, p1 = bj ? pB1 : pA1;
                    v0 = (f32x4){sigm(p0[0] + v0[0]), sigm(p0[1] + v0[1]), sigm(p0[2] + v0[2]), sigm(p0[3] + v0[3])} * scale; v1 = (f32x4){sigm(p1[0] + v1[0]), sigm(p1[1] + v1[1]), sigm(p1[2] + v1[2]), sigm(p1[3] + v1[3])} * scale;
                    u32x4 w; w.x = cvt_pk_bf16(v0[0], v0[1]); w.y = cvt_pk_bf16(v0[2], v0[3]); w.z = cvt_pk_bf16(v1[0], v1[1]); w.w = cvt_pk_bf16(v1[2], v1[3]);
                    *(u32x4*)(rowp + bj * HALF) = w; } }
    }
};
struct EpiQRope {
    static constexpr bool PERM = true, AFTER_DRAIN = false;
    bf16_t* O; const float* rope; float sc;
    __device__ __forceinline__ void operator()(const f32x4 (&acc)[2][2][4][2], const Unit& u, int wr, int wc, int fr, int fq) const {
        const int row0 = u.pm * BM + wr * 64 + fr; const int col0 = u.pn * BM + wc * 32 + 8 * fq;
#pragma unroll
        for (int ai = 0; ai < 2; ++ai)
#pragma unroll
            for (int m = 0; m < 4; ++m) { const int row = row0 + ai * HALF + m * 16;
#pragma unroll
                for (int bj = 0; bj < 2; ++bj) { const int cg = col0 + bj * HALF; const int cm = cg % 192; f32x4 v0 = acc[ai][bj][m][0], v1 = acc[ai][bj][m][1];
                    if (cm >= 128) { const int j0 = (cm - 128) >> 1; const f32x4* rp = (const f32x4*)(rope + ((size_t)row * 32 + j0) * 2); const f32x4 a = rp[0], b = rp[1];
                        f32x4 r0, r1;
                        r0[0] = v0[0] * a[0] - v0[1] * a[1]; r0[1] = v0[1] * a[0] + v0[0] * a[1]; r0[2] = v0[2] * a[2] - v0[3] * a[3]; r0[3] = v0[3] * a[2] + v0[2] * a[3];
                        r1[0] = v1[0] * b[0] - v1[1] * b[1]; r1[1] = v1[1] * b[0] + v1[0] * b[1]; r1[2] = v1[2] * b[2] - v1[3] * b[3]; r1[3] = v1[3] * b[2] + v1[2] * b[3];
                        v0 = r0; v1 = r1; }
                    v0 = v0 * sc; v1 = v1 * sc; u32x4 w; w.x = cvt_pk_bf16(v0[0], v0[1]); w.y = cvt_pk_bf16(v0[2], v0[3]); w.z = cvt_pk_bf16(v1[0], v1[1]); w.w = cvt_pk_bf16(v1[2], v1[3]);
                    *(u32x4*)(O + (size_t)row * 768 + cg) = w; } }
    }
};
template <int NI> struct EpiMerge {
    static constexpr bool PERM = true, AFTER_DRAIN = false;
    bf16_t* MG; const bf16_t* GT;
    __device__ __forceinline__ void operator()(const f32x4 (&acc)[2][2][4][2], const Unit& u, int wr, int wc, int fr, int fq) const {
        const int row0 = u.pm * BM + wr * 64 + fr; const int col0 = u.pn * BM + wc * 32 + 8 * fq;
#pragma unroll
        for (int ai = 0; ai < 2; ++ai)
#pragma unroll
            for (int m = 0; m < 4; ++m) { const int row = row0 + ai * HALF + m * 16;
#pragma unroll
                for (int bj = 0; bj < 2; ++bj) { const int c = col0 + bj * HALF; const f32x4 v0 = acc[ai][bj][m][0], v1 = acc[ai][bj][m][1];
                    const u32x4 gw = *(const u32x4*)(GT + (size_t)row * 3072 + NI * 1024 + c);
                    f32x4 o0 = {0.f, 0.f, 0.f, 0.f}, o1 = {0.f, 0.f, 0.f, 0.f};
                    if (NI > 0) { const u32x4 ow = *(const u32x4*)(MG + (size_t)row * 1024 + c); o0 = (f32x4){h_lo(ow.x), h_hi(ow.x), h_lo(ow.y), h_hi(ow.y)}; o1 = (f32x4){h_lo(ow.z), h_hi(ow.z), h_lo(ow.w), h_hi(ow.w)}; }
                    o0[0] += sigm(h_lo(gw.x)) * v0[0]; o0[1] += sigm(h_hi(gw.x)) * v0[1]; o0[2] += sigm(h_lo(gw.y)) * v0[2]; o0[3] += sigm(h_hi(gw.y)) * v0[3];
                    o1[0] += sigm(h_lo(gw.z)) * v1[0]; o1[1] += sigm(h_hi(gw.z)) * v1[1]; o1[2] += sigm(h_lo(gw.w)) * v1[2]; o1[3] += sigm(h_hi(gw.w)) * v1[3];
                    u32x4 w; w.x = cvt_pk_bf16(o0[0], o0[1]); w.y = cvt_pk_bf16(o0[2], o0[3]); w.z = cvt_pk_bf16(o1[0], o1[1]); w.w = cvt_pk_bf16(o1[2], o1[3]);
                    *(u32x4*)(MG + (size_t)row * 1024 + c) = w; } }
    }
};
struct EpiMergeAll {
    static constexpr bool PERM = true, AFTER_DRAIN = false;
    bf16_t* MG; const bf16_t* GT;
    __device__ __forceinline__ void operator()(const f32x4 (&acc)[2][2][4][2], const Unit& u, int wr, int wc, int fr, int fq) const {
        const int a = u.pm >> 7, p = u.pm & 127, br = u.pn >> 2, q = u.pn & 3;
        const int row0 = p * BM + wr * 64 + fr; const int col0 = q * BM + wc * 32 + 8 * fq;
#pragma unroll
        for (int ai = 0; ai < 2; ++ai) {
            u32x4 gw[4][2], ow[4][2];
#pragma unroll
            for (int m = 0; m < 4; ++m)
#pragma unroll
                for (int bj = 0; bj < 2; ++bj) { const int row = row0 + ai * HALF + m * 16, c = col0 + bj * HALF;
                    gw[m][bj] = *(const u32x4*)(GT + (size_t)row * 3072 + br * 1024 + c);
                    if (a > 0) ow[m][bj] = *(const u32x4*)(MG + (size_t)row * 1024 + c); else ow[m][bj] = (u32x4){0u, 0u, 0u, 0u}; }
            __builtin_amdgcn_sched_barrier(0);
#pragma unroll
            for (int m = 0; m < 4; ++m)
#pragma unroll
                for (int bj = 0; bj < 2; ++bj) { const int row = row0 + ai * HALF + m * 16, c = col0 + bj * HALF; const f32x4 v0 = acc[ai][bj][m][0], v1 = acc[ai][bj][m][1]; const u32x4 g = gw[m][bj], o = ow[m][bj];
                    f32x4 o0 = (f32x4){h_lo(o.x), h_hi(o.x), h_lo(o.y), h_hi(o.y)}, o1 = (f32x4){h_lo(o.z), h_hi(o.z), h_lo(o.w), h_hi(o.w)};
                    o0[0] += sigm(h_lo(g.x)) * v0[0]; o0[1] += sigm(h_hi(g.x)) * v0[1]; o0[2] += sigm(h_lo(g.y)) * v0[2]; o0[3] += sigm(h_hi(g.y)) * v0[3];
                    o1[0] += sigm(h_lo(g.z)) * v1[0]; o1[1] += sigm(h_hi(g.z)) * v1[1]; o1[2] += sigm(h_lo(g.w)) * v1[2]; o1[3] += sigm(h_hi(g.w)) * v1[3];
                    u32x4 w; w.x = cvt_pk_bf16(o0[0], o0[1]); w.y = cvt_pk_bf16(o0[2], o0[3]); w.z = cvt_pk_bf16(o1[0], o1[1]); w.w = cvt_pk_bf16(o1[2], o1[3]);
                    *(u32x4*)(MG + (size_t)row * 1024 + c) = w; }
            __builtin_amdgcn_sched_barrier(0);
        }
    }
};
struct MergeOrder {
    int G, c;
    __device__ __forceinline__ bool next(int i, Unit& u) const { if (i >= 6 || G != 256) { if (G == 256) return false; const int t = c + G * (i / 3), a = i % 3; if (t >= 512) return false;
            const int p = t >> 2, q = t & 3, br = (a == 0) ? 0 : (a == 1 ? 2 : 1); u.pm = a * 128 + p; u.pn = br * 4 + q; return true; }
        const int x = c & 7, s = c >> 3, p = x * 16 + (s >> 1), q = 2 * (s & 1) + i / 3, a = i % 3, br = (a == 0) ? 0 : (a == 1 ? 2 : 1);
        u.pm = a * 128 + p; u.pn = br * 4 + q; return true; }
    __device__ __forceinline__ void a_ready(const Unit&) const {}
    __device__ __forceinline__ void done(const Unit&) const {}
};
struct EpiPle {
    static constexpr bool PERM = true, AFTER_DRAIN = false;
    float* H; const bf16_t* PP;
    __device__ __forceinline__ void operator()(const f32x4 (&acc)[2][2][4][2], const Unit& u, int wr, int wc, int fr, int fq) const {
        const int row0 = u.pm * BM + wr * 64 + fr; const int col0 = u.pn * BM + wc * 32 + 8 * fq;
#pragma unroll
        for (int ai = 0; ai < 2; ++ai)
#pragma unroll
            for (int mp = 0; mp < 2; ++mp) {
                u32x4 pw[2][2]; f32x4 hv[2][2][2];
#pragma unroll
                for (int mm = 0; mm < 2; ++mm)
#pragma unroll
                    for (int bj = 0; bj < 2; ++bj) { const int row = row0 + ai * HALF + (2 * mp + mm) * 16, c = col0 + bj * HALF;
                        pw[mm][bj] = *(const u32x4*)(PP + (size_t)row * 1024 + c); const f32x4* hp = (const f32x4*)(H + (size_t)row * 1024 + c); hv[mm][bj][0] = hp[0]; hv[mm][bj][1] = hp[1]; }
                __builtin_amdgcn_sched_barrier(0);
#pragma unroll
                for (int mm = 0; mm < 2; ++mm)
#pragma unroll
                    for (int bj = 0; bj < 2; ++bj) { const int m = 2 * mp + mm; const int row = row0 + ai * HALF + m * 16, c = col0 + bj * HALF; const f32x4 v0 = acc[ai][bj][m][0], v1 = acc[ai][bj][m][1]; const u32x4 pq = pw[mm][bj];
                        f32x4 h0 = hv[mm][bj][0], h1 = hv[mm][bj][1];
                        h0[0] += sigm(v0[0]) * h_lo(pq.x); h0[1] += sigm(v0[1]) * h_hi(pq.x); h0[2] += sigm(v0[2]) * h_lo(pq.y); h0[3] += sigm(v0[3]) * h_hi(pq.y);
                        h1[0] += sigm(v1[0]) * h_lo(pq.z); h1[1] += sigm(v1[1]) * h_hi(pq.z); h1[2] += sigm(v1[2]) * h_lo(pq.w); h1[3] += sigm(v1[3]) * h_hi(pq.w);
                        f32x4* hp = (f32x4*)(H + (size_t)row * 1024 + c); hp[0] = h0; hp[1] = h1; }
                __builtin_amdgcn_sched_barrier(0);
            }
    }
};
template <class Epi, class Sched, bool ALIGN_EPI = false, bool SP2 = false>
__device__ __forceinline__ void gemm_phase(PG8_LAS unsigned char* lds, const Gemm g, const Sched& S, const Epi& E) {
    int tid_ = my_tid(); asm volatile("" : "+v"(tid_));
    const int tid = tid_, wid = __builtin_amdgcn_readfirstlane(tid >> 6), lane = tid & 63, wr = wid >> 2, wc = wid & 3, fr = lane & 15, fq = lane >> 4;
    const int K = g.K, nt = K / BK;
    unsigned voffA[2], voffB[2];
#pragma unroll
    for (int i = 0; i < 2; ++i) { int R, C; stage_rc(tid * 16 + i * 8192, R, C); const int Rb = Epi::PERM ? ((R & ~31) + perm32(R & 31)) : R;
        voffA[i] = (unsigned)(R * K + C) * 2u; voffB[i] = (unsigned)(Rb * K + C) * 2u; }
    const size_t kstep = (size_t)(BK * 2);
    const size_t hstep = (size_t)HALF * K * 2;
    const size_t tstep = 2 * hstep;
    const unsigned ldsw = (unsigned)wid * 1024u;
    const int aoff = lds_byte(wr * 64 + fr, fq * 8), boff = lds_byte(wc * 32 + fr, fq * 8);
#define PG8_SA(b, h) (((b) * 2 + (h)) * HTB)
#define PG8_SB(b, h) ((4 + (b) * 2 + (h)) * HTB)
#define PG8_STAGE(bufoff, gbase, voff) do { _Pragma("unroll") for (int _i = 0; _i < 2; ++_i) \
        __builtin_amdgcn_global_load_lds((const unsigned*)((const char*)(gbase) + (voff)[_i]), (PG8_LAS unsigned*)(lds + (bufoff) + ldsw + _i * 8192), 16, 0, 0); } while (0)
#define PG8_LDA(dst, b, h) do { _Pragma("unroll") for (int m = 0; m < 4; ++m) _Pragma("unroll") for (int k = 0; k < 2; ++k) dst[m][k] = *(const PG8_LAS bf16x8*)(lds + PG8_SA(b, h) + aoff + m * 2048 + k * 1024); } while (0)
#define PG8_LDB(dst, b, h) do { _Pragma("unroll") for (int n = 0; n < 2; ++n) _Pragma("unroll") for (int k = 0; k < 2; ++k) dst[n][k] = *(const PG8_LAS bf16x8*)(lds + PG8_SB(b, h) + boff + n * 2048 + k * 1024); } while (0)
#define PG8_MMA(ai, bj, At, Bt) do { __builtin_amdgcn_s_setprio(1); _Pragma("unroll") for (int m = 0; m < 4; ++m) _Pragma("unroll") for (int n = 0; n < 2; ++n) _Pragma("unroll") for (int k = 0; k < 2; ++k) \
        acc[ai][bj][m][n] = MFMA16(Bt[n][k], At[m][k], acc[ai][bj][m][n]); __builtin_amdgcn_s_setprio(0); } while (0)
#define PG8_WAIT_V(n) asm volatile("s_waitcnt vmcnt(" #n ")" ::: "memory")
#define PG8_WAIT_L(n) asm volatile("s_waitcnt lgkmcnt(" #n ")" ::: "memory")
#define PG8_BAR __builtin_amdgcn_s_barrier()
#define PG8_SCHED __builtin_amdgcn_sched_barrier(0)
    Unit cur, nxt; int ui = 0;
    if (!S.next(0, cur)) return;
    f32x4 acc[2][2][4][2];
#pragma unroll
    for (int a = 0; a < 2; ++a)
#pragma unroll
        for (int b = 0; b < 2; ++b)
#pragma unroll
            for (int m = 0; m < 4; ++m)
#pragma unroll
                for (int n = 0; n < 2; ++n) acc[a][b][m][n] = (f32x4){0.f, 0.f, 0.f, 0.f};
    bf16x8 At[4][2], B0[2][2], B1[2][2];
    const char* cA = (const char*)g.A + (size_t)cur.pm * tstep; const char* cB = (const char*)g.Bt + (size_t)cur.pn * tstep;
    S.a_ready(cur);
    if constexpr (SP2) {
        PG8_STAGE(PG8_SB(0, 0), cB, voffB); PG8_STAGE(PG8_SB(0, 1), cB + hstep, voffB); PG8_STAGE(PG8_SA(0, 0), cA, voffA); PG8_STAGE(PG8_SA(0, 1), cA + hstep, voffA);
        if (wr == 1) PG8_BAR;
        PG8_WAIT_V(2); PG8_BAR;
        PG8_STAGE(PG8_SB(1, 0), cB + kstep, voffB); PG8_STAGE(PG8_SA(1, 0), cA + kstep, voffA); PG8_STAGE(PG8_SB(1, 1), cB + hstep + kstep, voffB);
        PG8_WAIT_V(6); PG8_BAR;
    } else {
        PG8_STAGE(PG8_SB(0, 0), cB, voffB); PG8_STAGE(PG8_SA(0, 0), cA, voffA); PG8_STAGE(PG8_SB(0, 1), cB + hstep, voffB); PG8_STAGE(PG8_SA(0, 1), cA + hstep, voffA);
        if (wr == 1) PG8_BAR;
        PG8_WAIT_V(4); PG8_BAR;
        PG8_STAGE(PG8_SB(1, 0), cB + kstep, voffB); PG8_STAGE(PG8_SA(1, 0), cA + kstep, voffA); PG8_STAGE(PG8_SB(1, 1), cB + hstep + kstep, voffB);
        PG8_WAIT_V(6); PG8_BAR;
    }
    for (;;) {
        const bool has_next = S.next(ui + 1, nxt);
        const char* nA = has_next ? (const char*)g.A + (size_t)nxt.pm * tstep : cA; const char* nB = has_next ? (const char*)g.Bt + (size_t)nxt.pn * tstep : cB;
        for (int t = 0; t < nt; t += 2) {
            const bool last = (t == nt - 2);
            const char* a1 = cA + (size_t)(t + 1) * kstep;
            const char* a2 = last ? nA : cA + (size_t)(t + 2) * kstep; const char* b2 = last ? nB : cB + (size_t)(t + 2) * kstep;
            const char* a3 = a2 + kstep; const char* b3 = b2 + kstep;
            if (last && has_next) S.a_ready(nxt);
            if constexpr (SP2) {
            PG8_LDB(B0, 0, 0); PG8_LDB(B1, 0, 1); PG8_SCHED; PG8_LDA(At, 0, 0); PG8_STAGE(PG8_SA(1, 1), a1 + hstep, voffA);
            PG8_WAIT_V(8); PG8_WAIT_L(0); PG8_BAR; PG8_MMA(0, 0, At, B0); PG8_MMA(0, 1, At, B1); PG8_BAR; PG8_SCHED;
            PG8_LDA(At, 0, 1); PG8_STAGE(PG8_SB(0, 0), b2, voffB); PG8_STAGE(PG8_SB(0, 1), b2 + hstep, voffB); PG8_STAGE(PG8_SA(0, 0), a2, voffA);
            PG8_WAIT_V(8); PG8_WAIT_L(0); PG8_BAR; PG8_MMA(1, 0, At, B0); PG8_MMA(1, 1, At, B1); PG8_BAR; PG8_SCHED;
            PG8_LDB(B0, 1, 0); PG8_LDB(B1, 1, 1); PG8_SCHED; PG8_LDA(At, 1, 0); PG8_STAGE(PG8_SA(0, 1), a2 + hstep, voffA);
            PG8_WAIT_V(8); PG8_WAIT_L(0); PG8_BAR; PG8_MMA(0, 0, At, B0); PG8_MMA(0, 1, At, B1); PG8_BAR; PG8_SCHED;
            PG8_LDA(At, 1, 1); PG8_STAGE(PG8_SB(1, 0), b3, voffB); PG8_STAGE(PG8_SB(1, 1), b3 + hstep, voffB); PG8_STAGE(PG8_SA(1, 0), a3, voffA);
            PG8_WAIT_V(8); PG8_WAIT_L(0); PG8_BAR; PG8_MMA(1, 0, At, B0); PG8_MMA(1, 1, At, B1); PG8_BAR; PG8_SCHED;
            } else {
            PG8_LDB(B0, 0, 0); PG8_SCHED; PG8_LDA(At, 0, 0); PG8_STAGE(PG8_SA(1, 1), a1 + hstep, voffA);
            PG8_WAIT_L(8); PG8_BAR; PG8_WAIT_L(0); PG8_MMA(0, 0, At, B0); PG8_BAR; PG8_SCHED;
            PG8_LDB(B1, 0, 1); PG8_STAGE(PG8_SB(0, 0), b2, voffB);
            PG8_BAR; PG8_WAIT_L(0); PG8_MMA(0, 1, At, B1); PG8_BAR;
            PG8_LDA(At, 0, 1); PG8_STAGE(PG8_SA(0, 0), a2, voffA);
            PG8_BAR; PG8_WAIT_L(0); PG8_MMA(1, 0, At, B0); PG8_BAR; PG8_SCHED;
            PG8_STAGE(PG8_SB(0, 1), b2 + hstep, voffB);
            PG8_WAIT_V(6); PG8_BAR; PG8_MMA(1, 1, At, B1); PG8_BAR;
            PG8_LDB(B0, 1, 0); PG8_SCHED; PG8_LDA(At, 1, 0); PG8_STAGE(PG8_SA(0, 1), a2 + hstep, voffA);
            PG8_WAIT_L(8); PG8_BAR; PG8_WAIT_L(0); PG8_MMA(0, 0, At, B0); PG8_BAR; PG8_SCHED;
            PG8_LDB(B1, 1, 1); PG8_STAGE(PG8_SB(1, 0), b3, voffB);
            PG8_BAR; PG8_WAIT_L(0); PG8_MMA(0, 1, At, B1); PG8_BAR;
            PG8_LDA(At, 1, 1); PG8_STAGE(PG8_SA(1, 0), a3, voffA);
            PG8_BAR; PG8_WAIT_L(0); PG8_MMA(1, 0, At, B0); PG8_BAR; PG8_SCHED;
            PG8_STAGE(PG8_SB(1, 1), b3 + hstep, voffB);
            PG8_WAIT_V(6); PG8_BAR; PG8_MMA(1, 1, At, B1); PG8_BAR;
            }
        }
        if constexpr (ALIGN_EPI) { if (wr == 0) PG8_BAR; }
        if constexpr (!Epi::AFTER_DRAIN) { int t2_ = my_tid(); asm volatile("" : "+v"(t2_)); const int l2_ = t2_ & 63, w2_ = __builtin_amdgcn_readfirstlane(t2_ >> 6);
            E(acc, cur, w2_ >> 2, w2_ & 3, l2_ & 15, l2_ >> 4); S.done(cur); }
        if (!has_next) break;
#pragma unroll
        for (int a = 0; a < 2; ++a)
#pragma unroll
            for (int b = 0; b < 2; ++b)
#pragma unroll
                for (int m = 0; m < 4; ++m)
#pragma unroll
                    for (int n = 0; n < 2; ++n) acc[a][b][m][n] = (f32x4){0.f, 0.f, 0.f, 0.f};
        cur = nxt; cA = nA; cB = nB; ++ui;
        if constexpr (ALIGN_EPI) { if (wr == 1) PG8_BAR; }
    }
    PG8_WAIT_V(0);
    if constexpr (!ALIGN_EPI) { if (wr == 0) PG8_BAR; }
    PG8_BAR;
    if constexpr (Epi::AFTER_DRAIN) { E.fused(acc, cur, wr, wc, fr, fq, lds, wid, lane); S.done(cur); }
#undef PG8_SA
#undef PG8_SB
#undef PG8_STAGE
#undef PG8_LDA
#undef PG8_LDB
#undef PG8_MMA
#undef PG8_WAIT_V
#undef PG8_WAIT_L
#undef PG8_BAR
#undef PG8_SCHED
}
}
constexpr int NWAVES = 8;
constexpr int D = 1024, BATCH = 8, SEQ = 4096, T = BATCH * SEQ, DEPTH = 2, FF = 4096, DPLE = 256;
constexpr int IN_COLS = 6848, RW_COLS = 1792;
constexpr float NORM_EPS = 1e-6f, RW_LN_EPS = 64e-5f;
constexpr float LOG2E = 1.4426950408889634f;
constexpr float MLA_QSCALE = 0.07216878364870322f * LOG2E;
constexpr float CA_QSCALE = 0.125f * LOG2E;
constexpr size_t MiB = 1u << 20;
constexpr size_t WS_CTL = 0, CTL_ZERO_BYTES = 1 * MiB;
constexpr size_t WS_ROPE = 1 * MiB;
constexpr size_t WS_W = 9 * MiB;
constexpr size_t W_IN = WS_W, W_Q = W_IN + (size_t)6912 * 1024 * 2, W_LORA = W_Q + (size_t)768 * 256 * 2, W_B = W_LORA + (size_t)1536 * 256 * 2,
                 W_OUT = W_B + (size_t)3 * 1024 * 512 * 2, W_1 = W_OUT + (size_t)1024 * 1024 * 2, W_2 = W_1 + (size_t)4096 * 1024 * 2, W_G = W_2 + (size_t)4096 * 1024 * 2,
                 W_P = W_G + (size_t)1024 * 1024 * 2, W_END = W_P + (size_t)1024 * 256 * 2;
constexpr size_t WS_U = 49 * MiB;
constexpr size_t WS_OA = 113 * MiB, WS_OC = 145 * MiB, WS_ORW = 177 * MiB;
constexpr size_t WS_X = 209 * MiB, WS_END = 512 * MiB;
constexpr size_t X_ZC = WS_X, X_QP = X_ZC + (size_t)T * 1536 * 2, X_KV = X_QP + (size_t)T * 768 * 2, X_ZR = X_KV + (size_t)T * 192 * 2, X_TW = X_ZR + (size_t)T * 1792 * 2;
constexpr size_t X_TA = WS_U, X_G = WS_U + (size_t)T * 512 * 2, X_QN = WS_OC, X_LA = WS_ORW;
constexpr size_t X_GT = WS_X, X_MG = X_GT + (size_t)T * 3072 * 2;
constexpr size_t X_HID = WS_X, X_PB = WS_X, X_PP = X_PB + (size_t)T * 256 * 2;
static_assert(X_TW + (size_t)T * 512 * 2 <= WS_END && X_MG + (size_t)T * 1024 * 2 <= WS_END && X_HID + (size_t)T * 4096 * 2 <= WS_END, "X map");
constexpr int CW_TMO = 0, CW_QUEUE = 1024  , CW_BAR = 4096;
constexpr int RING_OFF = 0, RING_BYTES = 131072;
constexpr int LDSCTL_OFF = RING_BYTES, MISC_OFF = LDSCTL_OFF + 320;
constexpr int LDS_BYTES = 147456;

#define GAS __attribute__((address_space(1)))
#define LAS __attribute__((address_space(3)))
typedef unsigned short bf16;
typedef unsigned v4u __attribute__((ext_vector_type(4)));
typedef unsigned v2u __attribute__((ext_vector_type(2)));
typedef float f32x4 __attribute__((ext_vector_type(4)));
typedef float f32x16 __attribute__((ext_vector_type(16)));
typedef short bf16x8 __attribute__((ext_vector_type(8)));
typedef short s16x4 __attribute__((ext_vector_type(4)));
#define LDS_WAIT() asm volatile("s_waitcnt lgkmcnt(0)" ::: "memory")
#define VM_WAIT() asm volatile("s_waitcnt vmcnt(0)" ::: "memory")
__device__ __forceinline__ unsigned f2bf(float f) { return h_f2h(f); }
__device__ __forceinline__ unsigned pk2(float lo, float hi) { return h_pk2(lo, hi); }
__device__ __forceinline__ float bfl(unsigned w) { return h_lo(w); }
__device__ __forceinline__ float bfh(unsigned w) { return h_hi(w); }
__device__ __forceinline__ float sigmoidf_(float x) { return 1.0f / (1.0f + __expf(-x)); }
__device__ __forceinline__ float shfl_xor_f(float v, int o, int lane) { return __int_as_float(__builtin_amdgcn_ds_bpermute((lane ^ o) << 2, __float_as_int(v))); }
__device__ __forceinline__ float wave_sum(float v, int lane) {
#pragma unroll
    for (int o = 1; o < 64; o <<= 1) v += shfl_xor_f(v, o, lane);
    return v;
}
__device__ __forceinline__ unsigned char* opq(unsigned char* p) { asm volatile("" : "+s"(p)); return p; }
__device__ __forceinline__ float fsig(float x) { return __builtin_amdgcn_rcpf(1.0f + __builtin_amdgcn_exp2f(-LOG2E * x)); }
#define XB_TMO      128
#define XB_XCNT(j)  (256  + 64 * (j))
#define XB_XSUB(j)  (1280 + 64 * (j))
#define XB_XGEN(j)  (2304 + 64 * (j))
#define XB_TOP      3328
#define XB_TOPGEN   3392
#define XCD_BAR_WORDS 3456
#define XB_SPIN_CAP (1u << 25)

__device__ __forceinline__ unsigned xb_ld(unsigned* p)              { return __hip_atomic_load(p, __ATOMIC_RELAXED, __HIP_MEMORY_SCOPE_AGENT); }
__device__ __forceinline__ unsigned xb_add(unsigned* p, unsigned v) { return __hip_atomic_fetch_add(p, v, __ATOMIC_RELAXED, __HIP_MEMORY_SCOPE_AGENT); }
__device__ __forceinline__ unsigned xb_xcc_id() { return (unsigned)__builtin_amdgcn_s_getreg((3 << 11) | 20) & 0xFu; }
#define XB_SPIN(cond, bar) do { unsigned _sp = 0; while (cond) { __builtin_amdgcn_s_sleep(1); \
    if ((++_sp & 255u) == 0u) { if (xb_ld(&(bar)[XB_TMO])) break; if (_sp > XB_SPIN_CAP) { atomicAdd(&(bar)[XB_TMO], 1u); break; } } } } while (0)

struct XcdBarrier {
    unsigned* bar; unsigned x;
    volatile LAS unsigned* st;
};

__device__ __forceinline__ XcdBarrier xcd_barrier_post(unsigned* bar, volatile LAS unsigned* st) {
    XcdBarrier b; b.bar = bar; b.x = xb_xcc_id(); b.st = st;
    if (my_tid() == 0) (void)xb_add(&bar[XB_XCNT(b.x)], 1u);
    return b;
}
__device__ __forceinline__ void xcd_barrier_complete(unsigned* bar, unsigned x, unsigned& nloc, unsigned& nx) {
    const unsigned G = gridDim.x * gridDim.y * gridDim.z;
    unsigned sum, cnt, mine, sp = 0u;
    for (;;) {
        sum = 0u; cnt = 0u; mine = 0u;
#pragma unroll
        for (unsigned j = 0; j < 16; ++j) { const unsigned c = xb_ld(&bar[XB_XCNT(j)]); sum += c; cnt += (c > 0u) ? 1u : 0u; mine = (j == x) ? c : mine; }
        if (sum == G) break;
        __builtin_amdgcn_s_sleep(1);
        if ((++sp & 255u) == 0u) { if (xb_ld(&bar[XB_TMO])) break; if (sp > XB_SPIN_CAP) { atomicAdd(&bar[XB_TMO], 1u); break; } }
    }
    nloc = mine > 0u ? mine : 1u; nx = cnt > 0u ? cnt : 1u;
}

__device__ __forceinline__ void xcd_barrier(const XcdBarrier& b) {
    asm volatile("s_waitcnt vmcnt(0)" ::: "memory");
    __syncthreads();
    if (my_tid() == 0) {
        unsigned* bar = b.bar;
        __builtin_amdgcn_s_waitcnt(0);
        unsigned nloc = b.st[0], nx = b.st[1];
        if (nloc == 0u) { xcd_barrier_complete(bar, b.x, nloc, nx); b.st[0] = nloc; b.st[1] = nx; }
        const unsigned old = xb_add(&bar[XB_XSUB(b.x)], 1u);
        const unsigned gen = old / nloc;
        if (old + 1u == (gen + 1u) * nloc) {
            __builtin_amdgcn_fence(__ATOMIC_RELEASE, "agent");
            asm volatile("s_waitcnt vmcnt(0)" ::: "memory");
            const unsigned og = xb_add(&bar[XB_TOP], 1u);
            const unsigned tg = og / nx;
            if (og + 1u == (tg + 1u) * nx) xb_add(&bar[XB_TOPGEN], 1u);
            else XB_SPIN(xb_ld(&bar[XB_TOPGEN]) == tg, bar);
            __builtin_amdgcn_fence(__ATOMIC_ACQUIRE, "agent");
            xb_add(&bar[XB_XGEN(b.x)], 1u);
            asm volatile("s_waitcnt vmcnt(0)" ::: "memory");
        } else {
            XB_SPIN(xb_ld(&bar[XB_XGEN(b.x)]) == gen, bar);
            __builtin_amdgcn_fence(__ATOMIC_ACQUIRE, "agent");
            asm volatile("s_waitcnt vmcnt(0)" ::: "memory");
        }
    }
    __syncthreads();
}
namespace att {
__device__ __forceinline__ int crow(int r, int hi) { return (r & 3) + 8 * (r >> 2) + 4 * hi; }
__device__ __forceinline__ unsigned cvtpk(float lo, float hi) { return h_pk2(lo, hi); }
typedef short v4i16_t __attribute__((ext_vector_type(4)));
__device__ __forceinline__ s16x4 vtr(const LAS unsigned char* p) { return __builtin_bit_cast(s16x4, __builtin_amdgcn_ds_read_tr16_b64_v4i16((LAS v4i16_t*)p)); }
__device__ __forceinline__ float softmax_tile(f32x16& p0, f32x16& p1, float& m_reg, float& l_reg, bf16x8& pa0, bf16x8& pa1, bf16x8& pa2, bf16x8& pa3) {
    float pmax = p0[0];
#pragma unroll
    for (int r = 1; r < 16; ++r) pmax = fmaxf(pmax, p0[r]);
#pragma unroll
    for (int r = 0; r < 16; ++r) pmax = fmaxf(pmax, p1[r]);
    { auto rr = __builtin_amdgcn_permlane32_swap(__float_as_uint(pmax), __float_as_uint(pmax), false, false); pmax = fmaxf(__uint_as_float(rr[0]), __uint_as_float(rr[1])); }
    float alpha = 1.f;
    if (!__all(pmax - m_reg <= 8.f)) { const float mn = fmaxf(m_reg, pmax); alpha = __builtin_amdgcn_exp2f(m_reg - mn); m_reg = mn; }
    float ps = 0.f;
#pragma unroll
    for (int r = 0; r < 16; ++r) { p0[r] = __builtin_amdgcn_exp2f(p0[r] - m_reg); ps += p0[r]; }
#pragma unroll
    for (int r = 0; r < 16; ++r) { p1[r] = __builtin_amdgcn_exp2f(p1[r] - m_reg); ps += p1[r]; }
    { auto rr = __builtin_amdgcn_permlane32_swap(__float_as_uint(ps), __float_as_uint(ps), false, false); ps = __uint_as_float(rr[0]) + __uint_as_float(rr[1]); }
    l_reg = l_reg * alpha + ps;
#define PK4(P, BASE, OUT) do { unsigned a0 = cvtpk(P[BASE + 0], P[BASE + 1]), a1 = cvtpk(P[BASE + 2], P[BASE + 3]);   \
    unsigned b0 = cvtpk(P[BASE + 4], P[BASE + 5]), b1 = cvtpk(P[BASE + 6], P[BASE + 7]);                              \
    auto r0 = __builtin_amdgcn_permlane32_swap(a0, b0, false, false); auto r1 = __builtin_amdgcn_permlane32_swap(a1, b1, false, false); \
    v4u w = {r0[0], r1[0], r0[1], r1[1]}; OUT = __builtin_bit_cast(bf16x8, w); } while (0)
    PK4(p0, 0, pa0); PK4(p0, 8, pa1); PK4(p1, 0, pa2); PK4(p1, 8, pa3);
#undef PK4
    return alpha;
}
constexpr int MLA_KSTR = 400;
constexpr int MLA_KBUF = 64 * MLA_KSTR;
constexpr int ATT_SCR = 2 * MLA_KBUF;
__device__ __forceinline__ void mla_unit(LAS unsigned char* lds, const bf16* __restrict__ QP, const bf16* __restrict__ KV, bf16* __restrict__ OA, int b, int c) {
    int tid_ = my_tid(); asm volatile("" : "+v"(tid_));
    const int tid = tid_, lane = tid & 63, wid = __builtin_amdgcn_readfirstlane(tid >> 6), r32 = lane & 31, hi = lane >> 5;
    const int h = wid >> 1; const size_t qrow0 = (size_t)b * SEQ + c * 64 + (wid & 1) * 32;
    bf16x8 qr[12];
    { const bf16* qp = QP + (qrow0 + r32) * 768 + h * 192 + hi * 8;
#pragma unroll
      for (int d0 = 0; d0 < 12; ++d0) qr[d0] = *(const bf16x8*)(qp + d0 * 16); }
    float m_reg = -1e30f, l_reg = 0.f; f32x16 o[4];
#pragma unroll
    for (int d = 0; d < 4; ++d)
#pragma unroll
        for (int r = 0; r < 16; ++r) o[d][r] = 0.f;
    LAS float* scr = (LAS float*)(lds + ATT_SCR) + wid * 64;
    const bf16* kvb = KV + (size_t)b * SEQ * 192;
    int skey[3], sch[3];
#pragma unroll
    for (int i = 0; i < 3; ++i) { const int id = tid + 512 * i; skey[i] = id / 24; sch[i] = id % 24; }
    v4u st[3];
    const int NT = c + 1;
#pragma unroll
    for (int i = 0; i < 3; ++i) st[i] = *(const v4u*)(kvb + (size_t)skey[i] * 192 + sch[i] * 8);
#pragma unroll
    for (int i = 0; i < 3; ++i) *(LAS v4u*)(lds + skey[i] * MLA_KSTR + sch[i] * 16) = st[i];
    __syncthreads();
    const int troff = (((lane & 15) >> 2) + 8 * hi) * MLA_KSTR + (16 * ((lane >> 4) & 1) + 4 * (lane & 3)) * 2;
    for (int j = 0; j < NT; ++j) {
        const int buf = j & 1;
        if (j + 1 < NT) {
#pragma unroll
            for (int i = 0; i < 3; ++i) st[i] = *(const v4u*)(kvb + (size_t)(64 * (j + 1) + skey[i]) * 192 + sch[i] * 8);
        }
        const LAS unsigned char* kt = lds + buf * MLA_KBUF;
        f32x16 p0, p1;
#pragma unroll
        for (int r = 0; r < 16; ++r) { p0[r] = 0.f; p1[r] = 0.f; }
        { const LAS unsigned char* kb = kt + r32 * MLA_KSTR + hi * 16;
#pragma unroll
          for (int d0 = 0; d0 < 12; ++d0) { const bf16x8 a0 = *(const LAS bf16x8*)(kb + d0 * 32); const bf16x8 a1 = *(const LAS bf16x8*)(kb + 32 * MLA_KSTR + d0 * 32);
              p0 = MFMA32(a0, qr[d0], p0); p1 = MFMA32(a1, qr[d0], p1); } }
        bf16x8 pa0, pa1, pa2, pa3;
        const float alpha = softmax_tile(p0, p1, m_reg, l_reg, pa0, pa1, pa2, pa3);
        if (__any(alpha < 1.f)) { if (hi == 0) scr[r32] = alpha; LDS_WAIT();
#pragma unroll
            for (int r = 0; r < 16; ++r) { const float a = scr[crow(r, hi)];
#pragma unroll
                for (int d = 0; d < 4; ++d) o[d][r] *= a; } }
        const LAS unsigned char* vb = kt + troff;
#pragma unroll
        for (int d0 = 0; d0 < 4; ++d0) {
            s16x4 lo[4], hh[4];
#pragma unroll
            for (int ks = 0; ks < 4; ++ks) { lo[ks] = vtr(vb + (16 * ks) * MLA_KSTR + d0 * 64); hh[ks] = vtr(vb + (16 * ks + 4) * MLA_KSTR + d0 * 64); }
#define PK(k) (bf16x8){lo[k][0], lo[k][1], lo[k][2], lo[k][3], hh[k][0], hh[k][1], hh[k][2], hh[k][3]}
            o[d0] = MFMA32(pa0, PK(0), o[d0]);
            o[d0] = MFMA32(pa1, PK(1), o[d0]);
            o[d0] = MFMA32(pa2, PK(2), o[d0]);
            o[d0] = MFMA32(pa3, PK(3), o[d0]);
#undef PK
        }
        if (j + 1 < NT) {
#pragma unroll
            for (int i = 0; i < 3; ++i) *(LAS v4u*)(lds + (buf ^ 1) * MLA_KBUF + skey[i] * MLA_KSTR + sch[i] * 16) = st[i];
        }
        __syncthreads();
    }
    if (hi == 0) scr[r32] = l_reg; LDS_WAIT();
    bf16* ob = OA + qrow0 * 512 + h * 128 + r32;
#pragma unroll
    for (int r = 0; r < 16; ++r) { const int orow = crow(r, hi); const float rl = __builtin_amdgcn_rcpf(scr[orow]);
#pragma unroll
        for (int d0 = 0; d0 < 4; ++d0) ob[(size_t)orow * 512 + d0 * 32] = (bf16)f2bf(o[d0][r] * rl); }
    __syncthreads();
}
constexpr int CA_KSTR = 144;
constexpr int CA_TBUF = 64 * CA_KSTR;
constexpr int CA_BIAS = ATT_SCR + 8 * 256;
__device__ __forceinline__ void band_unit(LAS unsigned char* lds, const bf16* __restrict__ ZC, const float* __restrict__ relb, bf16* __restrict__ OC, int b, int h, int g) {
    int tid_ = my_tid(); asm volatile("" : "+v"(tid_));
    const int tid = tid_, lane = tid & 63, wid = __builtin_amdgcn_readfirstlane(tid >> 6), r32 = lane & 31, hi = lane >> 5;
    const int cw = 4 * g + (wid >> 1); const size_t qrow0 = (size_t)b * SEQ + cw * 64 + (wid & 1) * 32;
    LAS float* bias = (LAS float*)(lds + CA_BIAS);
    if (tid < 320) bias[tid] = relb[tid * 8 + h] * LOG2E;
    bf16x8 qr[4];
    { const bf16* qp = ZC + (qrow0 + r32) * 1536 + h * 64 + hi * 8;
#pragma unroll
      for (int d0 = 0; d0 < 4; ++d0) qr[d0] = *(const bf16x8*)(qp + d0 * 16); }
    float m_reg = -1e30f, l_reg = 0.f; f32x16 o[2];
#pragma unroll
    for (int d = 0; d < 2; ++d)
#pragma unroll
        for (int r = 0; r < 16; ++r) o[d][r] = 0.f;
    LAS float* scr = (LAS float*)(lds + ATT_SCR) + wid * 64;
    const int kc0 = (4 * g - 8) < 0 ? 0 : (4 * g - 8), kc1 = 4 * g + 3;
    const bf16* kbase = ZC + (size_t)b * SEQ * 1536 + 512 + h * 64; const bf16* vbase = kbase + 512;
    const int skey = tid >> 3, sch = tid & 7;
    v4u stk, stv;
    stk = *(const v4u*)(kbase + (size_t)(64 * kc0 + skey) * 1536 + sch * 8); stv = *(const v4u*)(vbase + (size_t)(64 * kc0 + skey) * 1536 + sch * 8);
    *(LAS v4u*)(lds + skey * CA_KSTR + sch * 16) = stk; *(LAS v4u*)(lds + CA_TBUF + skey * CA_KSTR + sch * 16) = stv;
    __syncthreads();
    const int troff = (((lane & 15) >> 2) + 8 * hi) * CA_KSTR + (16 * ((lane >> 4) & 1) + 4 * (lane & 3)) * 2;
    const int qin = (wid & 1) * 32 + r32;
    for (int kc = kc0; kc <= kc1; ++kc) {
        const int buf = (kc - kc0) & 1;
        if (kc < kc1) { stk = *(const v4u*)(kbase + (size_t)(64 * (kc + 1) + skey) * 1536 + sch * 8); stv = *(const v4u*)(vbase + (size_t)(64 * (kc + 1) + skey) * 1536 + sch * 8); }
        if (kc >= cw - 8 && kc <= cw) {
            const LAS unsigned char* kt = lds + buf * 2 * CA_TBUF;
            f32x16 p0, p1;
            const int dbase = (cw - kc) * 64 + qin + 63;
#pragma unroll
            for (int r = 0; r < 16; ++r) { int i0 = dbase - crow(r, hi), i1 = i0 - 32; i0 = i0 > 319 ? 319 : i0; i1 = i1 > 319 ? 319 : i1; p0[r] = bias[i0]; p1[r] = bias[i1]; }
            { const LAS unsigned char* kb = kt + r32 * CA_KSTR + hi * 16;
#pragma unroll
              for (int d0 = 0; d0 < 4; ++d0) { const bf16x8 a0 = *(const LAS bf16x8*)(kb + d0 * 32); const bf16x8 a1 = *(const LAS bf16x8*)(kb + 32 * CA_KSTR + d0 * 32);
                  p0 = MFMA32(a0, qr[d0], p0); p1 = MFMA32(a1, qr[d0], p1); } }
            bf16x8 pa0, pa1, pa2, pa3;
            const float alpha = softmax_tile(p0, p1, m_reg, l_reg, pa0, pa1, pa2, pa3);
            if (__any(alpha < 1.f)) { if (hi == 0) scr[r32] = alpha; LDS_WAIT();
#pragma unroll
                for (int r = 0; r < 16; ++r) { const float a = scr[crow(r, hi)]; o[0][r] *= a; o[1][r] *= a; } }
            const LAS unsigned char* vb = kt + CA_TBUF + troff;
#pragma unroll
            for (int d0 = 0; d0 < 2; ++d0) {
                s16x4 lo[4], hh[4];
#pragma unroll
                for (int ks = 0; ks < 4; ++ks) { lo[ks] = vtr(vb + (16 * ks) * CA_KSTR + d0 * 64); hh[ks] = vtr(vb + (16 * ks + 4) * CA_KSTR + d0 * 64); }
#define PK(k) (bf16x8){lo[k][0], lo[k][1], lo[k][2], lo[k][3], hh[k][0], hh[k][1], hh[k][2], hh[k][3]}
                o[d0] = MFMA32(pa0, PK(0), o[d0]);
                o[d0] = MFMA32(pa1, PK(1), o[d0]);
                o[d0] = MFMA32(pa2, PK(2), o[d0]);
                o[d0] = MFMA32(pa3, PK(3), o[d0]);
#undef PK
            }
        }
        if (kc < kc1) { *(LAS v4u*)(lds + (buf ^ 1) * 2 * CA_TBUF + skey * CA_KSTR + sch * 16) = stk; *(LAS v4u*)(lds + (buf ^ 1) * 2 * CA_TBUF + CA_TBUF + skey * CA_KSTR + sch * 16) = stv; }
        __syncthreads();
    }
    if (hi == 0) scr[r32] = l_reg; LDS_WAIT();
    bf16* ob = OC + qrow0 * 512 + h * 64 + r32;
#pragma unroll
    for (int r = 0; r < 16; ++r) { const int orow = crow(r, hi); const float rl = __builtin_amdgcn_rcpf(scr[orow]);
        ob[(size_t)orow * 512] = (bf16)f2bf(o[0][r] * rl); ob[(size_t)orow * 512 + 32] = (bf16)f2bf(o[1][r] * rl); }
    __syncthreads();
}
}
struct Args { const float* in[30]; float* out; unsigned char* ws; int start; int stop; };
#define KAS __attribute__((address_space(4)))
__device__ __forceinline__ const KAS unsigned char* kbase() { const KAS unsigned char* p = (const KAS unsigned char*)__builtin_amdgcn_kernarg_segment_ptr(); asm volatile("" : "+s"(p)); return p; }
__device__ __forceinline__ const float* kin(int i) { return *(const float* const KAS*)(kbase() + 8 * i); }
__device__ __forceinline__ float* kout() { return *(float* const KAS*)(kbase() + 240); }
__device__ __forceinline__ unsigned char* kws() { return *(unsigned char* const KAS*)(kbase() + 248); }
__device__ __forceinline__ int kstart() { return *(const int KAS*)(kbase() + 256); }
__device__ __forceinline__ int kstop() { return *(const int KAS*)(kbase() + 260); }
struct Frame { LAS unsigned char* lds; int tid, lane, wave, G, gw, NGW; };
__device__ __forceinline__ Frame make_frame(LAS unsigned char* lds) {
    Frame F; int tid = my_tid(); asm volatile("" : "+v"(tid)); int bx = blockIdx.x; asm volatile("" : "+s"(bx)); int G = gridDim.x; asm volatile("" : "+s"(G));
    F.lds = lds; F.tid = tid; F.lane = tid & 63; F.wave = __builtin_amdgcn_readfirstlane(tid >> 6); F.G = G; F.gw = bx * NWAVES + F.wave; F.NGW = G * NWAVES; return F;
}

__device__ const double ROPE_INV_FREQ[32] = {1, 0.74989420933245587, 0.56234132519034907, 0.42169650342858223, 0.31622776601683794, 0.23713737056616552, 0.17782794100389229, 0.1333521432163324, 0.10000000000000001, 0.074989420933245579, 0.056234132519034911, 0.042169650342858224, 0.031622776601683791, 0.023713737056616554, 0.017782794100389229, 0.013335214321633241, 0.01, 0.0074989420933245579, 0.005623413251903491, 0.0042169650342858229, 0.0031622776601683794, 0.0023713737056616554, 0.0017782794100389228, 0.0013335214321633241, 0.001, 0.00074989420933245586, 0.0005623413251903491, 0.00042169650342858224, 0.00031622776601683794, 0.00023713737056616554, 0.00017782794100389227, 0.0001333521432163324};
__device__ __forceinline__ void sincos_d(double a, float& s, float& c) {
    const double n = rint(a * 0.63661977236758134308);
    double r = fma(-n, 1.5707963267948966192, a); r = fma(-n, 6.123233995736766036e-17, r);
    const double r2 = r * r;
    double sp = -7.6471637318198164759e-13; sp = fma(sp, r2, 1.6059043836821614599e-10); sp = fma(sp, r2, -2.5052108385441718775e-08); sp = fma(sp, r2, 2.7557319223985890653e-06);
    sp = fma(sp, r2, -1.9841269841269841270e-04); sp = fma(sp, r2, 8.3333333333333333333e-03); sp = fma(sp, r2, -1.6666666666666666667e-01);
    const double sn = fma(sp * r2, r, r);
    double cp = 4.7794773323873852974e-14; cp = fma(cp, r2, -1.1470745597729724714e-11); cp = fma(cp, r2, 2.0876756987868098979e-09); cp = fma(cp, r2, -2.7557319223985890653e-07);
    cp = fma(cp, r2, 2.4801587301587301587e-05); cp = fma(cp, r2, -1.3888888888888888889e-03); cp = fma(cp, r2, 4.1666666666666666667e-02); cp = fma(cp, r2, -0.5);
    const double cs = fma(cp, r2, 1.0);
    const long long q = (long long)n & 3LL; double so, co;
    if (q == 0) { so = sn; co = cs; } else if (q == 1) { so = cs; co = -sn; } else if (q == 2) { so = -sn; co = -cs; } else { so = -cs; co = sn; }
    s = (float)so; c = (float)co;
}
__device__ __forceinline__ void transpose_item(const float* W, int ldw, int col0, int nblk, bf16* WT, int ldt, int row0, LAS float* scr, int item, int lane) {
    const int kb = item / nblk, nb = item % nblk, k0 = 64 * kb, n0 = 32 * nb;
#pragma unroll 8
    for (int i = 0; i < 32; ++i) { const int kk = 2 * i + (lane >> 5); scr[kk * 33 + (lane & 31)] = W[(size_t)(k0 + kk) * ldw + col0 + n0 + (lane & 31)]; }
    LDS_WAIT(); asm volatile("" ::: "memory");
    const int c = lane & 7;
#pragma unroll
    for (int j = 0; j < 4; ++j) { const int n = (lane >> 3) + 8 * j; const LAS float* s = scr + (8 * c) * 33 + n;
        v4u o; o.x = pk2(s[0 * 33], s[1 * 33]); o.y = pk2(s[2 * 33], s[3 * 33]); o.z = pk2(s[4 * 33], s[5 * 33]); o.w = pk2(s[6 * 33], s[7 * 33]);
        *(GAS v4u*)(WT + (size_t)(row0 + n0 + n) * ldt + k0 + 8 * c) = o; }
    LDS_WAIT(); asm volatile("" ::: "memory");
}
__device__ __forceinline__ void rope_table(LAS unsigned char* lds_) {
    const Frame F = make_frame(lds_); const int gt = F.gw * 64 + F.lane, NTH = F.NGW * 64;
    const int* pos = (const int*)kin(2); float* rope = (float*)(kws() + WS_ROPE);
    for (int i = gt; i < T * 32; i += NTH) { float s, c; sincos_d((double)pos[i >> 5] * ROPE_INV_FREQ[i & 31], s, c); rope[2 * (size_t)i] = c; rope[2 * (size_t)i + 1] = s; }
}
__device__ __forceinline__ void p0_prologue(LAS unsigned char* lds_, const Args& A, int l) {
    const Frame F = make_frame(lds_);
    LAS float* scr = (LAS float*)(F.lds + RING_OFF + F.wave * 16384);
    constexpr int I1 = 16 * 14, I2 = 16 * 48, I3 = 16 * 56, I4 = 16 * 96, I5 = 8 * 32, I6 = 8 * 32, I7 = 16 * 32, I8 = 16 * 128, I9 = 64 * 32, I10 = 16 * 32, I11 = 4 * 32;
    constexpr int NITEMS = I1 + I2 + I3 + I4 + I5 + I6 + I7 + I8 + I9 + I10 + I11;
#define WIN_ (kin(4) + (size_t)l * 1024 * IN_COLS)
#define WBR_ (kin(21) + (size_t)l * 1536 * 1024)
    for (int it = F.gw; it < NITEMS; it += F.NGW) {
        int r = it;
        if (r < I1) { transpose_item(WIN_, IN_COLS, 0, 14, (bf16*)(kws() + W_IN), 1024, 0, scr, r, F.lane); continue; } r -= I1;
        if (r < I2) { transpose_item(WIN_, IN_COLS, 2240, 48, (bf16*)(kws() + W_IN), 1024, 512, scr, r, F.lane); continue; } r -= I2;
        if (r < I3) { transpose_item(WIN_, IN_COLS, 448, 56, (bf16*)(kws() + W_IN), 1024, 2048, scr, r, F.lane); continue; } r -= I3;
        if (r < I4) { transpose_item(WIN_, IN_COLS, 3776, 96, (bf16*)(kws() + W_IN), 1024, 3840, scr, r, F.lane); continue; } r -= I4;
        if (r < I5) { transpose_item(WBR_ + (size_t)512 * 1024, 1024, 0, 32, (bf16*)(kws() + W_B) + (size_t)1024 * 512, 512, 0, scr, r, F.lane); continue; } r -= I5;
        if (r < I6) { transpose_item(WBR_ + (size_t)1024 * 1024, 1024, 0, 32, (bf16*)(kws() + W_B) + (size_t)2 * 1024 * 512, 512, 0, scr, r, F.lane); continue; } r -= I6;
        if (r < I7) { transpose_item(kin(22) + (size_t)l * 1024 * 1024, 1024, 0, 32, (bf16*)(kws() + W_OUT), 1024, 0, scr, r, F.lane); continue; } r -= I7;
        if (r < I8) { transpose_item(kin(25) + (size_t)l * 1024 * 4096, 4096, 0, 128, (bf16*)(kws() + W_1), 1024, 0, scr, r, F.lane); continue; } r -= I8;
        if (r < I9) { transpose_item(kin(26) + (size_t)l * 4096 * 1024, 1024, 0, 32, (bf16*)(kws() + W_2), 4096, 0, scr, r, F.lane); continue; } r -= I9;
        if (r < I10) { transpose_item(kin(28) + (size_t)l * 1024 * 1024, 1024, 0, 32, (bf16*)(kws() + W_G), 1024, 0, scr, r, F.lane); continue; } r -= I10;
        transpose_item(kin(29) + (size_t)l * 256 * 1024, 1024, 0, 32, (bf16*)(kws() + W_P), 256, 0, scr, r, F.lane);
    }
    const int gt = F.gw * 64 + F.lane, NTH = F.NGW * 64;
    { bf16* WinT = (bf16*)(kws() + W_IN); for (int i = gt; i < 64 * 1024; i += NTH) WinT[(size_t)448 * 1024 + i] = 0; }
    { const float* w_uq = kin(7) + (size_t)l * 256 * 768; const float* w_ukv = kin(8) + (size_t)l * 128 * 1024; bf16* WqT = (bf16*)(kws() + W_Q);
      for (int i = gt; i < 768 * 256; i += NTH) {
        const int n = i >> 8, kq = i & 255, h = n / 192, ii = n % 192; float s;
        if (ii < 128) { s = 0.f; const float* a = w_uq + (size_t)kq * 768 + h * 192; const float* b = w_ukv + (size_t)ii * 1024 + h * 256;
            for (int nn = 0; nn < 128; ++nn) s = fmaf(a[nn], b[nn], s); }
        else { const int jj = ii - 128, j = jj >> 1; s = w_uq[(size_t)kq * 768 + h * 192 + 128 + ((jj & 1) ? j + 32 : j)]; }
        WqT[i] = (bf16)f2bf(s);
      } }
    { const float* w_ukv = kin(8) + (size_t)l * 128 * 1024; const float* w_br = WBR_; bf16* WbT = (bf16*)(kws() + W_B);
      for (int i = gt; i < 512 * 1024; i += NTH) {
        const int dd = i & 1023, hl = i >> 10, h = hl >> 7, lat = hl & 127; float s = 0.f;
        const float* a = w_ukv + (size_t)lat * 1024 + h * 256 + 128; const float* b = w_br + (size_t)(h * 128) * 1024 + dd;
        for (int v = 0; v < 128; ++v) s = fmaf(a[v], b[(size_t)v * 1024], s);
        WbT[(size_t)dd * 512 + hl] = (bf16)f2bf(s);
      } }
    { const float* w_up = kin(11) + (size_t)l * 64 * 512; const float* a_up = kin(13) + (size_t)l * 64 * 512; const float* g_up = kin(14) + (size_t)l * 128 * 512; bf16* WloT = (bf16*)(kws() + W_LORA);
      for (int i = gt; i < 1536 * 256; i += NTH) {
        const int n = i >> 8, k = i & 255, blk = n >> 9, nn = n & 511; float s = 0.f;
        if (blk == 0) { if (k < 64) s = w_up[(size_t)k * 512 + nn]; } else if (blk == 1) { if (k >= 64 && k < 128) s = a_up[(size_t)(k - 64) * 512 + nn]; } else { if (k >= 128) s = g_up[(size_t)(k - 128) * 512 + nn]; }
        WloT[i] = (bf16)f2bf(s);
      } }
#undef WIN_
#undef WBR_
}
__device__ __forceinline__ void u_rowpass(LAS unsigned char* lds_, int l, bool from_x) {
    const Frame F = make_frame(lds_); unsigned char* ws = kws();
    const float* src = from_x ? kin(0) : kout(); const float* g = kin(3) + l * 1024; bf16* U = (bf16*)(ws + WS_U);
    f32x4 gv[4];
#pragma unroll
    for (int j = 0; j < 4; ++j) gv[j] = *(const f32x4*)(g + 4 * F.lane + 256 * j);
    for (int m = F.gw; m < T; m += F.NGW) {
        const f32x4* xr = (const f32x4*)(src + (size_t)m * D) + F.lane; f32x4 v[4]; float s = 0.f;
#pragma unroll
        for (int j = 0; j < 4; ++j) { v[j] = xr[64 * j]; s += (v[j].x * v[j].x + v[j].y * v[j].y) + (v[j].z * v[j].z + v[j].w * v[j].w); }
        if (from_x) { f32x4* ho = (f32x4*)(kout() + (size_t)m * D) + F.lane;
#pragma unroll
            for (int j = 0; j < 4; ++j) ho[64 * j] = v[j]; }
        const float rs = rsqrtf(wave_sum(s, F.lane) * (1.f / D) + NORM_EPS);
        v2u* o8 = (v2u*)(U + (size_t)m * D) + F.lane;
#pragma unroll
        for (int j = 0; j < 4; ++j) { const f32x4 y = v[j] * rs * gv[j]; v2u w; w.x = pk2(y.x, y.y); w.y = pk2(y.z, y.w); o8[64 * j] = w; }
    }
}
__device__ __forceinline__ void p2_mla_prep(LAS unsigned char* lds_, const Args& A, int l) {
    const Frame F = make_frame(lds_);
    const bf16* ZM = (const bf16*)(kws() + WS_OA); bf16* QN = (bf16*)(kws() + X_QN); bf16* KV = (bf16*)(kws() + X_KV); const float* rope = (const float*)(kws() + WS_ROPE);
    const f32x4 gq = *(const f32x4*)(kin(5) + l * 256 + 4 * F.lane); const float gk0 = kin(6)[l * 128 + 2 * F.lane], gk1 = kin(6)[l * 128 + 2 * F.lane + 1];
    for (int t = F.gw; t < T; t += F.NGW) {
        const bf16* z = ZM + (size_t)t * 512;
        const v2u wq = *(const v2u*)(z + 4 * F.lane); const unsigned wk = *(const unsigned*)(z + 256 + 2 * F.lane); const float kr = bfl((unsigned)z[384 + F.lane]);
        const float q0 = bfl(wq.x), q1 = bfh(wq.x), q2 = bfl(wq.y), q3 = bfh(wq.y), k0 = bfl(wk), k1 = bfh(wk);
        const float rq = rsqrtf(wave_sum(q0 * q0 + q1 * q1 + q2 * q2 + q3 * q3, F.lane) * (1.f / 256.f) + NORM_EPS);
        const float rk = rsqrtf(wave_sum(k0 * k0 + k1 * k1, F.lane) * (1.f / 128.f) + NORM_EPS);
        v2u o; o.x = pk2(q0 * rq * gq.x, q1 * rq * gq.y); o.y = pk2(q2 * rq * gq.z, q3 * rq * gq.w);
        *(v2u*)(QN + (size_t)t * 256 + 4 * F.lane) = o;
        *(unsigned*)(KV + (size_t)t * 192 + 2 * F.lane) = pk2(k0 * rk * gk0, k1 * rk * gk1);
        const float other = shfl_xor_f(kr, 32, F.lane);
        if (F.lane < 32) { const float c = rope[((size_t)t * 32 + F.lane) * 2], s = rope[((size_t)t * 32 + F.lane) * 2 + 1];
            *(unsigned*)(KV + (size_t)t * 192 + 128 + 2 * F.lane) = pk2(kr * c - other * s, other * c + kr * s); }
    }
}
__device__ __forceinline__ void p6_rw_prep(LAS unsigned char* lds_, const Args& A, int l) {
    const Frame F = make_frame(lds_);
    const bf16* ZR = (const bf16*)(kws() + X_ZR); bf16* LA = (bf16*)(kws() + X_LA);
    const f32x4 mu = *(const f32x4*)(kin(9) + l * RW_COLS + 1536 + 4 * F.lane);
    for (int t = F.gw; t < T; t += F.NGW) {
        const v2u wc = *(const v2u*)(ZR + (size_t)t * 1792 + 1536 + 4 * F.lane); v2u wp; wp.x = 0u; wp.y = 0u;
        if ((t & (SEQ - 1)) != 0) wp = *(const v2u*)(ZR + (size_t)(t - 1) * 1792 + 1536 + 4 * F.lane);
        float z[4] = {bfl(wc.x), bfh(wc.x), bfl(wc.y), bfh(wc.y)}; const float p[4] = {bfl(wp.x), bfh(wp.x), bfl(wp.y), bfh(wp.y)}; const float m[4] = {mu.x, mu.y, mu.z, mu.w};
#pragma unroll
        for (int e = 0; e < 4; ++e) { float v = z[e] + (p[e] - z[e]) * m[e]; if (F.lane < 16) v = 1.f - 2.f * __builtin_amdgcn_rcpf(1.f + __builtin_amdgcn_exp2f(2.f * LOG2E * v)); else if (F.lane >= 32) v = fsig(v); z[e] = v; }
        v2u o; o.x = pk2(z[0], z[1]); o.y = pk2(z[2], z[3]); *(v2u*)(LA + (size_t)t * 256 + 4 * F.lane) = o;
    }
}
template <int MODE>
__device__ __forceinline__ void rowpass(LAS unsigned char* lds_, const Args& A, const bf16* M, const float* g1, const float* g2, const float* pl) {
    const Frame F = make_frame(lds_);
    bf16* U = (bf16*)(kws() + WS_U); bf16* PB = (bf16*)(kws() + X_PB);
    f32x4 g1v[4], g2v[4];
#pragma unroll
    for (int j = 0; j < 4; ++j) { g1v[j] = *(const f32x4*)(g1 + 4 * F.lane + 256 * j); if (MODE == 0) g2v[j] = *(const f32x4*)(g2 + 4 * F.lane + 256 * j); }
    for (int m = F.gw; m < T; m += F.NGW) {
        const v2u* mr = (const v2u*)(M + (size_t)m * D) + F.lane; f32x4* hr = (f32x4*)(kout() + (size_t)m * D) + F.lane;
        f32x4 x[4], hv[4]; float s = 0.f;
#pragma unroll
        for (int j = 0; j < 4; ++j) { const v2u w = mr[64 * j]; x[j] = (f32x4){bfl(w.x), bfh(w.x), bfl(w.y), bfh(w.y)}; hv[j] = hr[64 * j]; s += (x[j].x * x[j].x + x[j].y * x[j].y) + (x[j].z * x[j].z + x[j].w * x[j].w); }
        const float rs = rsqrtf(wave_sum(s, F.lane) * (1.f / D) + NORM_EPS); float s2 = 0.f;
#pragma unroll
        for (int j = 0; j < 4; ++j) { hv[j] = hv[j] + x[j] * rs * g1v[j]; hr[64 * j] = hv[j]; s2 += (hv[j].x * hv[j].x + hv[j].y * hv[j].y) + (hv[j].z * hv[j].z + hv[j].w * hv[j].w); }
        v2u* o8 = (v2u*)(U + (size_t)m * D) + F.lane;
        if (MODE == 0) { const float rs2 = rsqrtf(wave_sum(s2, F.lane) * (1.f / D) + NORM_EPS);
#pragma unroll
            for (int j = 0; j < 4; ++j) { const f32x4 y = hv[j] * rs2 * g2v[j]; v2u w; w.x = pk2(y.x, y.y); w.y = pk2(y.z, y.w); o8[64 * j] = w; } }
        else {
#pragma unroll
            for (int j = 0; j < 4; ++j) { v2u w; w.x = pk2(hv[j].x, hv[j].y); w.y = pk2(hv[j].z, hv[j].w); o8[64 * j] = w; }
            const f32x4 pv = *((const f32x4*)(pl + (size_t)m * DPLE) + F.lane); v2u w; w.x = pk2(pv.x, pv.y); w.y = pk2(pv.z, pv.w); *((v2u*)(PB + (size_t)m * DPLE) + F.lane) = w; }
    }
}
namespace rw {
typedef short v4i16_t __attribute__((ext_vector_type(4)));
constexpr int RS = 144;
constexpr int O_AT = 0, O_BT = 9216, O_KT = 18432, O_RT = 27648;
constexpr int O_UV = 36864;
constexpr int O_BK = O_UV + 4 * 32 * RS;
constexpr int O_SB = O_BK + 4 * 32 * RS;
constexpr int O_W1 = O_SB + 64 * RS;
constexpr int O_SM = O_W1 + 64 * RS;
constexpr int O_GC = O_SM + 16 * 1024;
constexpr int O_CB = O_GC + 1024;
constexpr int O_LM = O_CB + 256;
constexpr int O_YO = O_LM + 4096;
constexpr int O_PAR = O_YO + 64 * RS;
constexpr int LDS_END = O_PAR + 512;
static_assert(LDS_END <= RING_BYTES, "rwkv LDS map");
__device__ __forceinline__ bf16x8 trfrag(const LAS unsigned char* p) {
    const s16x4 lo = __builtin_bit_cast(s16x4, __builtin_amdgcn_ds_read_tr16_b64_v4i16((LAS v4i16_t*)p));
    const s16x4 hh = __builtin_bit_cast(s16x4, __builtin_amdgcn_ds_read_tr16_b64_v4i16((LAS v4i16_t*)(p + 4 * RS)));
    return (bf16x8){lo[0], lo[1], lo[2], lo[3], hh[0], hh[1], hh[2], hh[3]};
}
__device__ __forceinline__ void lbar() { asm volatile("s_waitcnt lgkmcnt(0)\n\ts_barrier" ::: "memory"); }
__device__ __forceinline__ void st_bf(LAS unsigned char* p, float x) { *(LAS unsigned short*)p = (unsigned short)h_f2h(__builtin_amdgcn_fmed3f(x, -60000.f, 60000.f)); }
__device__ __forceinline__ unsigned pk_rtz(float lo, float hi) { typedef __fp16 hp2 __attribute__((ext_vector_type(2))); const hp2 v = __builtin_amdgcn_cvt_pkrtz(lo, hi); return __builtin_bit_cast(unsigned, v); }
__device__ __forceinline__ void st2(LAS unsigned char* p0, LAS unsigned char* p1, float x0, float x1) { const unsigned w = pk_rtz(x0, x1); *(LAS unsigned short*)p0 = (unsigned short)w; *(LAS unsigned short*)p1 = (unsigned short)(w >> 16); }
__device__ __forceinline__ void st4(LAS unsigned char* p, int stride, const f32x4 v) { st2(p, p + stride, v[0], v[1]); st2(p + 2 * stride, p + 3 * stride, v[2], v[3]); }
__device__ __forceinline__ float ld_bf(const LAS unsigned char* p) { return bfl((unsigned)*(const LAS unsigned short*)p); }
template <int CTRL> __device__ __forceinline__ float dpp_add(float v) { return v + __int_as_float(__builtin_amdgcn_update_dpp(0, __float_as_int(v), CTRL, 0xf, 0xf, true)); }
__device__ __forceinline__ void wsum8(float (&v)[8], int lane) {
#pragma unroll
    for (int e = 0; e < 8; ++e) { float x = v[e]; x = dpp_add<0xB1>(x); x = dpp_add<0x4E>(x); x = dpp_add<0x141>(x); x = dpp_add<0x140>(x); v[e] = x; }
#pragma unroll
    for (int e = 0; e < 8; ++e) v[e] += shfl_xor_f(v[e], 16, lane);
#pragma unroll
    for (int e = 0; e < 8; ++e) v[e] += shfl_xor_f(v[e], 32, lane);
}
__device__ __forceinline__ void rw_unit(LAS unsigned char* lds, int l, int seq) {
    int tid_ = my_tid(); asm volatile("" : "+v"(tid_));
    const int tid = tid_, lane = tid & 63, w = __builtin_amdgcn_readfirstlane(tid >> 6), g4 = lane >> 4, l15 = lane & 15, q4 = l15 >> 2, p4 = lane & 3;
    const int b = seq >> 3, h = seq & 7;
    const bf16* ZRb = (const bf16*)(kws() + X_ZR) + (size_t)b * SEQ * 1792 + h * 64;
    const bf16* TWb = (const bf16*)(kws() + X_TW) + (size_t)b * SEQ * 512 + h * 64; const bf16* TAb = (const bf16*)(kws() + X_TA) + (size_t)b * SEQ * 512 + h * 64; const bf16* Gb = (const bf16*)(kws() + X_G) + (size_t)b * SEQ * 512 + h * 64;
    bf16* ORWb = (bf16*)(kws() + WS_ORW) + (size_t)b * SEQ * 512 + h * 64;
    LAS float* par = (LAS float*)(lds + O_PAR);
    const int pc = h * 64 + lane;
    const float mu_r = kin(9)[l * RW_COLS + pc], mu_k = kin(9)[l * RW_COLS + 512 + pc], mu_v = kin(9)[l * RW_COLS + 1024 + pc];
    const float k_k = kin(15)[l * 512 + pc], k_a = kin(16)[l * 512 + pc], r_k = kin(17)[l * 512 + pc];
    if (tid < 64) { par[tid] = kin(18)[l * 512 + pc]; par[64 + tid] = kin(19)[l * 512 + pc]; }
    for (int i = tid; i < (O_GC - O_UV) / 4; i += 512) ((LAS unsigned*)(lds + O_UV))[i] = 0u;
    f32x4 Sacc[2] = {{0.f, 0.f, 0.f, 0.f}, {0.f, 0.f, 0.f, 0.f}};
    __syncthreads();
    const int et = tid >> 3, ecg = tid & 7, ei = et >> 4, ett = et & 15;
    const int trrow = 8 * g4 + q4, trrow1 = 8 * (g4 & 1) + q4, trcol = 8 * p4;
    const int ei2 = w >> 1, ehf = w & 1;
    unsigned ptw[16], pcr[8], pck[8], pcv[8], pta[8], ppr, ppk, ppv; v4u pgg;
#define RW_LOADS(TOK0) do { const size_t r0_ = (size_t)(TOK0) + 16 * ei2, rA_ = r0_ + 8 * ehf; \
        _Pragma("unroll") for (int s = 0; s < 16; ++s) ptw[s] = (unsigned)TWb[(r0_ + s) * 512 + lane]; \
        _Pragma("unroll") for (int tt = 0; tt < 8; ++tt) { const bf16* zc_ = ZRb + (rA_ + tt) * 1792 + lane; pcr[tt] = (unsigned)zc_[0]; pck[tt] = (unsigned)zc_[512]; pcv[tt] = (unsigned)zc_[1024]; pta[tt] = (unsigned)TAb[(rA_ + tt) * 512 + lane]; } \
        { const bf16* zp_ = ZRb + (rA_ > 0 ? rA_ - 1 : 0) * 1792 + lane; ppr = (unsigned)zp_[0]; ppk = (unsigned)zp_[512]; ppv = (unsigned)zp_[1024]; if (rA_ == 0) { ppr = 0u; ppk = 0u; ppv = 0u; } } \
        pgg = *(const v4u*)(Gb + (size_t)((TOK0) + et) * 512 + 8 * ecg); } while (0)
    RW_LOADS(0);
    for (int sc = 0; sc < SEQ / 64; ++sc) {
        const int tok0 = sc * 64;
        unsigned twv[16], ucr[8], uck[8], ucv[8], uta[8], upr, upk, upv; v4u ugg;
        {
#pragma unroll
            for (int s = 0; s < 16; ++s) twv[s] = ptw[s];
#pragma unroll
            for (int tt = 0; tt < 8; ++tt) { ucr[tt] = pcr[tt]; uck[tt] = pck[tt]; ucv[tt] = pcv[tt]; uta[tt] = pta[tt]; }
            upr = ppr; upk = ppk; upv = ppv; ugg = pgg;
        }
        {   const int c = lane;
            float cumLo[8], cumHi[8];
            {   asm volatile("" : "+v"(twv[0]), "+v"(twv[1]), "+v"(twv[2]), "+v"(twv[3]), "+v"(twv[4]), "+v"(twv[5]), "+v"(twv[6]), "+v"(twv[7]), "+v"(twv[8]), "+v"(twv[9]), "+v"(twv[10]), "+v"(twv[11]), "+v"(twv[12]), "+v"(twv[13]), "+v"(twv[14]), "+v"(twv[15]));
                float run = 0.f;
#pragma unroll
                for (int s = 0; s < 16; ++s) { run += bfl(twv[s]); if (s < 8) cumLo[s] = run; else cumHi[s - 8] = run; } }
            const float tot = cumHi[7];
            const float fh = ehf ? 1.f : 0.f;
            const float gctot = __builtin_amdgcn_exp2f(LOG2E * tot);
            if (ehf == 0) ((LAS float*)(lds + O_GC))[ei2 * 64 + c] = gctot;
            float pr = bfl(upr), pk = bfl(upk), pv = bfl(upv);
            float rr[8], kkv[8], av[8], kmv[8], vv[8], ss[8], cbv[8];
            {   float cr[8], ck[8], cv[8], ta[8];
                asm volatile("" : "+v"(ucr[0]), "+v"(ucr[1]), "+v"(ucr[2]), "+v"(ucr[3]), "+v"(ucr[4]), "+v"(ucr[5]), "+v"(ucr[6]), "+v"(ucr[7]), "+v"(uck[0]), "+v"(uck[1]), "+v"(uck[2]), "+v"(uck[3]), "+v"(uck[4]), "+v"(uck[5]), "+v"(uck[6]), "+v"(uck[7]),
                                  "+v"(ucv[0]), "+v"(ucv[1]), "+v"(ucv[2]), "+v"(ucv[3]), "+v"(ucv[4]), "+v"(ucv[5]), "+v"(ucv[6]), "+v"(ucv[7]));
                asm volatile("" : "+v"(uta[0]), "+v"(uta[1]), "+v"(uta[2]), "+v"(uta[3]), "+v"(uta[4]), "+v"(uta[5]), "+v"(uta[6]), "+v"(uta[7]));
#pragma unroll
                for (int tt = 0; tt < 8; ++tt) { cr[tt] = bfl(ucr[tt]); ck[tt] = bfl(uck[tt]); cv[tt] = bfl(ucv[tt]); ta[tt] = bfl(uta[tt]); }
#pragma unroll
                for (int tt = 0; tt < 8; ++tt) {
                    const float r = cr[tt] + (pr - cr[tt]) * mu_r, k = ck[tt] + (pk - ck[tt]) * mu_k, v = cv[tt] + (pv - cv[tt]) * mu_v; pr = cr[tt]; pk = ck[tt]; pv = cv[tt];
                    const float a = ta[tt], kk = k * k_k, km = k * (1.f + (a - 1.f) * k_a);
                    rr[tt] = r; kkv[tt] = kk; av[tt] = a; kmv[tt] = km; vv[tt] = v; ss[tt] = kk * kk; cbv[tt] = r * km * r_k; } }
            wsum8(ss, lane); wsum8(cbv, lane);
            float ggprev = 1.f;
#pragma unroll
            for (int tt = 0; tt < 8; ++tt) { const int t = 8 * ehf + tt;
                const float cu = cumLo[tt] + fh * (cumHi[tt] - cumLo[tt]); const float pl = tt ? cumLo[tt - 1] : 0.f, ph = tt ? cumHi[tt - 1] : cumLo[7]; const float cprev = pl + fh * (ph - pl);
                const float gg = __builtin_amdgcn_exp2f(LOG2E * cu), gp = (tt == 0) ? __builtin_amdgcn_exp2f(LOG2E * cprev) : ggprev, gi = __builtin_amdgcn_exp2f(-LOG2E * cu), gh = gctot * gi; ggprev = gg;
                const float kn = kkv[tt] * rsqrtf(fmaxf(ss[tt], 1e-24f)), ka = kn * av[tt];
                const int ro = (16 * ei2 + t) * RS + 2 * c;
                st2(lds + O_BT + ro, lds + O_KT + ro, __builtin_amdgcn_fmed3f(ka * gi, -60000.f, 60000.f), __builtin_amdgcn_fmed3f(kmv[tt] * gi, -60000.f, 60000.f));
                st2(lds + O_AT + ro, lds + O_RT + ro, -kn * gp, rr[tt] * gg);
                st2(lds + O_BK + (ei2 * 32 + t) * RS + 2 * c, lds + O_BK + (ei2 * 32 + 16 + t) * RS + 2 * c, ka * gh, kmv[tt] * gh);
                *(LAS unsigned short*)(lds + O_UV + (ei2 * 32 + 16 + t) * RS + 2 * c) = (unsigned short)h_f2h(vv[tt]);
                if (c == 0) ((LAS float*)(lds + O_CB))[16 * ei2 + t] = cbv[tt]; }
        }
        { const int nxt = (sc + 1 < SEQ / 64) ? tok0 + 64 : tok0; RW_LOADS(nxt); }
        lbar();
        {   const int i = w & 3, hf = w >> 2;
            const LAS unsigned char* xa = lds + (hf ? O_RT : O_AT) + (16 * i + l15) * RS + 16 * g4;
            const LAS unsigned char* xb = lds + O_BT + (16 * i + l15) * RS + 16 * g4; const LAS unsigned char* xk = lds + O_KT + (16 * i + l15) * RS + 16 * g4;
            f32x4 c1 = {0.f, 0.f, 0.f, 0.f}, c2 = {0.f, 0.f, 0.f, 0.f};
#pragma unroll
            for (int ks = 0; ks < 2; ++ks) { const bf16x8 a = *(const LAS bf16x8*)(xa + 64 * ks);
                c1 = MFMA16(a, *(const LAS bf16x8*)(xb + 64 * ks), c1);
                c2 = MFMA16(a, *(const LAS bf16x8*)(xk + 64 * ks), c2); }
#pragma unroll
            for (int r = 0; r < 4; ++r) { const int t = 4 * g4 + r; const bool keep = hf ? (l15 <= t) : (l15 < t); const float v1 = keep ? c1[r] : 0.f, v2 = keep ? c2[r] : 0.f;
                if (hf == 0) { ((LAS float*)(lds + O_LM))[(i * 16 + t) * 16 + l15] = v1; *(LAS unsigned short*)(lds + O_SM + (4 + i) * 1024 + t * 64 + 2 * l15) = (unsigned short)h_f2h(v2); }
                else st2(lds + O_SM + (8 + i) * 1024 + t * 64 + 2 * l15, lds + O_SM + (12 + i) * 1024 + t * 64 + 2 * l15, v1, v2); }
        }
        lbar();
        if (w < 4) { if (lane < 16) { const LAS float* Lm = (const LAS float*)(lds + O_LM) + w * 256; float acc[16];
#pragma unroll
                for (int t = 0; t < 16; ++t) acc[t] = (t == lane) ? 1.f : 0.f;
#pragma unroll
                for (int s = 0; s < 15; ++s) { const float xs = acc[s];
#pragma unroll
                    for (int t = s + 1; t < 16; ++t) acc[t] = fmaf(Lm[t * 16 + s], xs, acc[t]); }
#pragma unroll
                for (int t = 0; t < 16; t += 2) st2(lds + O_SM + w * 1024 + t * 64 + 2 * lane, lds + O_SM + w * 1024 + (t + 1) * 64 + 2 * lane, acc[t], acc[t + 1]); } }
        else { const int i = w - 4; const bf16x8 am = *(const LAS bf16x8*)(lds + O_SM + (4 + i) * 1024 + l15 * 64 + 16 * g4);
#pragma unroll
            for (int ct = 0; ct < 4; ++ct) { f32x4 acc = {0.f, 0.f, 0.f, 0.f};
                acc = MFMA16(am, trfrag(lds + O_UV + (i * 32 + 16 + trrow1) * RS + 32 * ct + trcol), acc);
st4(lds + O_W1 + (16 * i + 4 * g4) * RS + 2 * (16 * ct + l15), RS, acc); } }
        lbar();
        f32x4 wy[4];
        {   const int ct = w & 3; const int base = (w < 4) ? O_W1 : O_AT;
#pragma unroll
            for (int i = 0; i < 4; ++i) { const bf16x8 tm = *(const LAS bf16x8*)(lds + O_SM + i * 1024 + l15 * 64 + 16 * g4); f32x4 acc = {0.f, 0.f, 0.f, 0.f};
                acc = MFMA16(tm, trfrag(lds + base + (16 * i + trrow1) * RS + 32 * ct + trcol), acc);
                if (w < 4) wy[i] = acc;
                st4(lds + base + (16 * i + 4 * g4) * RS + 2 * (16 * ct + l15), RS, acc); } }
        lbar();
        {   const int ct = w & 3;
#pragma unroll
            for (int i = 0; i < 4; ++i) { const bf16x8 arb = *(const LAS bf16x8*)(lds + O_SM + (8 + i) * 1024 + l15 * 64 + 16 * g4);
                if (w >= 4) { const bf16x8 ark = *(const LAS bf16x8*)(lds + O_SM + (12 + i) * 1024 + l15 * 64 + 16 * g4); f32x4 acc = {0.f, 0.f, 0.f, 0.f};
                    acc = MFMA16(arb, trfrag(lds + O_W1 + (16 * i + trrow1) * RS + 32 * ct + trcol), acc);
                    acc = MFMA16(ark, trfrag(lds + O_UV + (i * 32 + 16 + trrow1) * RS + 32 * ct + trcol), acc);
                    wy[i] = acc; }
                else { f32x4 acc;
#pragma unroll
                    for (int r = 0; r < 4; ++r) acc[r] = ld_bf(lds + O_RT + (16 * i + 4 * g4 + r) * RS + 2 * (16 * ct + l15));
                    acc = MFMA16(arb, trfrag(lds + O_AT + (16 * i + trrow1) * RS + 32 * ct + trcol), acc);
st4(lds + O_RT + (16 * i + 4 * g4) * RS + 2 * (16 * ct + l15), RS, acc); } } }
        lbar();
#pragma unroll
        for (int i = 0; i < 4; ++i) {
            {
                const int v0 = 16 * (w & 3); f32x4 acc = wy[i];
                const LAS unsigned char* xa = lds + ((w < 4) ? O_AT : O_RT) + (16 * i + l15) * RS + 16 * g4; const LAS unsigned char* sb = lds + O_SB + (v0 + l15) * RS + 16 * g4;
#pragma unroll
                for (int ks = 0; ks < 2; ++ks) acc = MFMA16(*(const LAS bf16x8*)(xa + 64 * ks), *(const LAS bf16x8*)(sb + 64 * ks), acc);
                LAS unsigned char* dst = (w < 4) ? (lds + O_UV + (i * 32 + 4 * g4) * RS + 2 * (v0 + l15)) : (lds + O_YO + (16 * i + 4 * g4) * RS + 2 * (v0 + l15));
st4(dst, RS, acc);
            }
            lbar();
            {
#pragma unroll
                for (int j = 0; j < 2; ++j) { const int id = 2 * w + j, vt = id >> 2, kt = id & 3;
                    const float gc = ((const LAS float*)(lds + O_GC))[i * 64 + 16 * kt + l15];
                    f32x4 acc = Sacc[j] * gc;
                    acc = MFMA16(trfrag(lds + O_UV + (i * 32 + trrow) * RS + 32 * vt + trcol), trfrag(lds + O_BK + (i * 32 + trrow) * RS + 32 * kt + trcol), acc);
                    Sacc[j] = acc;
st4(lds + O_SB + (16 * vt + 4 * g4) * RS + 2 * (16 * kt + l15), RS, acc); }
            }
            lbar();
        }
        {   float y[8], vv[8], gg[8];
            pg8::unpack8(*(const LAS v4u*)(lds + O_YO + et * RS + 16 * ecg), y); pg8::unpack8(*(const LAS v4u*)(lds + O_UV + (ei * 32 + 16 + ett) * RS + 16 * ecg), vv);
            pg8::unpack8(ugg, gg);
            float s = 0.f;
#pragma unroll
            for (int e = 0; e < 8; ++e) s += y[e];
            s = dpp_add<0xB1>(s); s = dpp_add<0x4E>(s); s = dpp_add<0x141>(s);
            const float mean = s * (1.f / 64.f); float q = 0.f;
#pragma unroll
            for (int e = 0; e < 8; ++e) { y[e] -= mean; q += y[e] * y[e]; }
            q = dpp_add<0xB1>(q); q = dpp_add<0x4E>(q); q = dpp_add<0x141>(q);
            const float rstd = rsqrtf(q * (1.f / 64.f) + RW_LN_EPS), cb = ((const LAS float*)(lds + O_CB))[et];
            float o[8];
#pragma unroll
            for (int e = 0; e < 8; ++e) { const int c = 8 * ecg + e; o[e] = (y[e] * rstd * par[c] + par[64 + c] + cb * vv[e]) * gg[e]; }
            v4u wo; wo.x = pk2(o[0], o[1]); wo.y = pk2(o[2], o[3]); wo.z = pk2(o[4], o[5]); wo.w = pk2(o[6], o[7]);
            *(v4u*)(ORWb + (size_t)(tok0 + et) * 512 + 8 * ecg) = wo;
        }
        lbar();
    }
}
}
#ifndef PROBE_QREP
#define PROBE_QREP 1
#endif
#ifndef PROBE_MASK
#define PROBE_MASK 0
#endif
__global__ void __launch_bounds__(NWAVES * 64, 2) mk_fwd(Args args) {
    extern __shared__ __attribute__((aligned(16))) unsigned char lds[];
    LAS unsigned char* const L = (LAS unsigned char*)lds;
    for (int u = threadIdx.x; u < (LDS_BYTES - LDSCTL_OFF) / 4; u += NWAVES * 64) ((LAS unsigned*)(L + LDSCTL_OFF))[u] = 0u;
    __syncthreads();
    static_assert(LDSCTL_OFF == MK_WAVETAB_LDS, "wave table address");
    if ((threadIdx.x & 63) == 0) ((LAS unsigned*)(L + LDSCTL_OFF))[(unsigned)__builtin_amdgcn_s_getreg((5 << 11) | 4) & 63u] = threadIdx.x >> 6;
    __syncthreads();
    XcdBarrier bar = xcd_barrier_post((unsigned*)(kws() + WS_CTL) + CW_BAR, (volatile LAS unsigned*)(L + MISC_OFF) + 8);
#define GRID_BAR() xcd_barrier(bar)
#if defined(DBG_BISECT)
#define IN(k) (l > 0 || ((k) >= kstart() && (k) <= kstop()) || ((k) == 9 && kstop() == 99))
#define LAYER_END() do { if (kstop() < 100) return; } while (0)
#else
#define IN(k) true
#define LAYER_END() do { } while (0)
#endif
#define PTRS() unsigned char* ws = opq(kws()); \
    bf16* U = (bf16*)(ws + WS_U); bf16* OA = (bf16*)(ws + WS_OA); bf16* OC = (bf16*)(ws + WS_OC); bf16* ORW = (bf16*)(ws + WS_ORW); \
    bf16* WinT = (bf16*)(ws + W_IN); bf16* WqT = (bf16*)(ws + W_Q); bf16* WloT = (bf16*)(ws + W_LORA); bf16* WbT = (bf16*)(ws + W_B); bf16* WoT = (bf16*)(ws + W_OUT); \
    bf16* W1T = (bf16*)(ws + W_1); bf16* W2T = (bf16*)(ws + W_2); bf16* WgT = (bf16*)(ws + W_G); bf16* WpT = (bf16*)(ws + W_P); \
    bf16* ZC = (bf16*)(ws + X_ZC); bf16* QN = (bf16*)(ws + X_QN); bf16* QP = (bf16*)(ws + X_QP); bf16* KV = (bf16*)(ws + X_KV); \
    bf16* ZR = (bf16*)(ws + X_ZR); bf16* LA = (bf16*)(ws + X_LA); bf16* TW = (bf16*)(ws + X_TW); bf16* TA = (bf16*)(ws + X_TA); bf16* GG = (bf16*)(ws + X_G); \
    bf16* GT = (bf16*)(ws + X_GT); bf16* MG = (bf16*)(ws + X_MG); bf16* HID = (bf16*)(ws + X_HID); bf16* PB = (bf16*)(ws + X_PB); bf16* PP = (bf16*)(ws + X_PP); bf16* M2 = OA; \
    (void)U; (void)OA; (void)OC; (void)ORW; (void)WinT; (void)WqT; (void)WloT; (void)WbT; (void)WoT; (void)W1T; (void)W2T; (void)WgT; (void)WpT; (void)ZC; (void)QN; (void)QP; (void)KV; (void)ZR; (void)LA; (void)TW; (void)TA; (void)GG; (void)GT; (void)MG; (void)HID; (void)PB; (void)PP; (void)M2;
    typedef pg8::StaticOrder SO;
#define GEMM(EPI, Aptr, Bptr, N_, K_, Eobj) do { int bx_ = blockIdx.x; asm volatile("" : "+s"(bx_)); int G_ = gridDim.x; asm volatile("" : "+s"(G_)); pg8::Gemm g_{Aptr, Bptr, T, N_, K_}; SO S_; S_.init(T, N_, G_, bx_); pg8::gemm_phase<EPI, SO, true, true>(L + RING_OFF, g_, S_, Eobj); } while (0)
#define PH(n) for (int rep_ = 0; rep_ < (((PROBE_MASK >> (n)) & 1) ? 2 : 1); ++rep_) if (IN(n))
    typedef pg8::EpiRoute<0> ER0;
    rope_table(L);
    for (int l = 0; l < DEPTH; ++l) {
        PH(0) { p0_prologue(L, args, l); u_rowpass(L, l, l == 0); GRID_BAR(); }
        PH(1) { PTRS(); ER0 E{OA, 512, 2, ZC, 1536, 6, 2, CA_QSCALE, ZR, 1792}; GEMM(ER0, U, WinT, 3840, 1024, E); GRID_BAR(); }
        PH(2) { p2_mla_prep(L, args, l); p6_rw_prep(L, args, l); GRID_BAR(); }
        PH(3) { PTRS(); pg8::EpiQRope E{QP, (const float*)(ws + WS_ROPE), MLA_QSCALE}; GEMM(pg8::EpiQRope, QN, WqT, 768, 256, E);
                pg8::EpiSig E2{TW, kin(10) + l * 512, -0.6065306597126334f}; GEMM(pg8::EpiSig, LA, WloT, 512, 256, E2);
                pg8::EpiSig E3{TA, kin(12) + l * 512, 1.f}; GEMM(pg8::EpiSig, LA, WloT + (size_t)512 * 256, 512, 256, E3);
                ER0 E4{GG, 512, 2, GG, 512, 0, 0, 1.f, GG, 512}; GEMM(ER0, LA, WloT + (size_t)1024 * 256, 512, 256, E4); GRID_BAR(); }
        PH(4) { PTRS();
            if (blockIdx.x < 64) rw::rw_unit(L + RING_OFF, l, (int)blockIdx.x);
            volatile LAS unsigned* qs = (volatile LAS unsigned*)(L + MISC_OFF) + 12;
            for (int qrep_ = 0; qrep_ < PROBE_QREP; ++qrep_) { unsigned* qhead = (unsigned*)(ws + WS_CTL) + CW_QUEUE + 64 * l + 16 * rep_ + 32 * qrep_;
            for (;;) {
                __syncthreads();
                if (my_tid() == 0) *qs = atomicAdd(qhead, 1u);
                __syncthreads();
                const unsigned u = *qs;
                if (u >= 1280u) break;
                if (u < 256u) { const int b = (int)u >> 5, cc = (int)u & 31; att::mla_unit(L + RING_OFF, QP, KV, OA, b, 63 - cc); att::mla_unit(L + RING_OFF, QP, KV, OA, b, cc); }
                else { const int bi = (int)u - 256; att::band_unit(L + RING_OFF, ZC, kin(20) + (size_t)l * 320 * 8, OC, bi >> 7, (bi >> 4) & 7, bi & 15); }
            }
            }
            GRID_BAR(); }
        PH(5) { u_rowpass(L, l, false); GRID_BAR(); }
        PH(9) { PTRS(); ER0 E{GT, 3072, 12, GT, 3072, 0, 0, 1.f, GT, 3072}; GEMM(ER0, U, WinT + (size_t)3840 * 1024, 3072, 1024, E); GRID_BAR(); }
        PH(10) { PTRS(); int bx_ = blockIdx.x; asm volatile("" : "+s"(bx_)); int G_ = gridDim.x; asm volatile("" : "+s"(G_));
                 pg8::Gemm g_{OA, WbT, 3 * T, 3072, 512}; pg8::MergeOrder S_{G_, bx_}; pg8::EpiMergeAll E{MG, GT};
                 pg8::gemm_phase<pg8::EpiMergeAll, pg8::MergeOrder, true, true>(L + RING_OFF, g_, S_, E); GRID_BAR(); }
        PH(11) { PTRS(); ER0 E{M2, 1024, 4, M2, 1024, 0, 0, 1.f, M2, 1024}; GEMM(ER0, MG, WoT, 1024, 1024, E); GRID_BAR(); }
        if (IN(12)) { PTRS(); rowpass<0>(L, args, M2, kin(23) + l * 1024, kin(24) + l * 1024, nullptr); GRID_BAR(); }
        PH(13) { PTRS(); pg8::EpiRoute<2> E{HID, 4096, 16, HID, 4096, 0, 0, 1.f, HID, 4096}; GEMM(pg8::EpiRoute<2>, U, W1T, 4096, 1024, E); GRID_BAR(); }
        PH(14) { PTRS(); ER0 E{M2, 1024, 4, M2, 1024, 0, 0, 1.f, M2, 1024}; GEMM(ER0, HID, W2T, 1024, 4096, E); GRID_BAR(); }
        if (IN(15)) { PTRS(); rowpass<1>(L, args, M2, kin(27) + l * 1024, nullptr, kin(1) + (size_t)l * T * DPLE); GRID_BAR(); }
        if (IN(17)) { PTRS(); ER0 E{PP, 1024, 4, PP, 1024, 0, 0, 1.f, PP, 1024}; GEMM(ER0, PB, WpT, 1024, 256, E);
                      pg8::EpiPle E2{kout(), PP}; GEMM(pg8::EpiPle, U, WgT, 1024, 1024, E2); }
        LAYER_END();
        if (l + 1 < DEPTH) GRID_BAR();
    }
}

#if !defined(DBG_BISECT)
extern "C" void kernel_launch(void* const* d_in, const int* in_sizes, int n_in, void* d_out, int out_size, void* d_ws, size_t ws_size, hipStream_t stream) {
    static int grid = 0;
    if (grid == 0) {
        if (n_in != 30 || out_size != T * D || ws_size < (size_t)WS_END) { fprintf(stderr, "kernel_launch: unexpected shapes (n_in %d out %d ws %zu, need ws >= %zu)\n", n_in, out_size, ws_size, (size_t)WS_END); grid = -1; return; }
        int dev = 0, cus = 0, per_cu = 0;
        if (hipGetDevice(&dev) != hipSuccess || hipDeviceGetAttribute(&cus, hipDeviceAttributeMultiprocessorCount, dev) != hipSuccess) { grid = -1; return; }
        if (hipFuncSetAttribute((const void*)mk_fwd, hipFuncAttributeMaxDynamicSharedMemorySize, LDS_BYTES) != hipSuccess) { fprintf(stderr, "kernel_launch: hipFuncSetAttribute failed\n"); grid = -1; return; }
        if (hipOccupancyMaxActiveBlocksPerMultiprocessor(&per_cu, (const void*)mk_fwd, NWAVES * 64, LDS_BYTES) != hipSuccess || per_cu < 1) { fprintf(stderr, "kernel_launch: occupancy query says %d\n", per_cu); }
        (void)hipGetLastError();
        grid = cus;
    }
    if (grid < 0) return;
    if (hipMemsetAsync((char*)d_ws + WS_CTL, 0, CTL_ZERO_BYTES, stream) != hipSuccess) return;
    Args a{};
    for (int i = 0; i < 30; ++i) a.in[i] = (const float*)d_in[i];
    a.out = (float*)d_out; a.ws = (unsigned char*)d_ws; a.start = 0; a.stop = 1000;
    hipLaunchKernelGGL(mk_fwd, dim3(grid), dim3(NWAVES * 64), LDS_BYTES, stream, a);
}
#endif
```

```cpp
#include <hip/hip_runtime.h>
#include <cstdio>
#include <cstdint>
#include <cmath>
typedef _Float16 h16x8_t __attribute__((ext_vector_type(8)));
typedef _Float16 h16x2_t __attribute__((ext_vector_type(2)));
typedef short s16x8_t __attribute__((ext_vector_type(8)));
typedef float f32x4_t_ __attribute__((ext_vector_type(4)));
typedef float f32x16_t_ __attribute__((ext_vector_type(16)));
__device__ __forceinline__ unsigned h_pk2(float lo, float hi) { const h16x2_t v = {(_Float16)lo, (_Float16)hi}; return __builtin_bit_cast(unsigned, v); }
__device__ __forceinline__ unsigned h_f2h(float f) { return (unsigned)__builtin_bit_cast(unsigned short, (_Float16)f); }
__device__ __forceinline__ float h_lo(unsigned w) { return (float)__builtin_bit_cast(_Float16, (unsigned short)(w & 0xffffu)); }
__device__ __forceinline__ float h_hi(unsigned w) { return (float)__builtin_bit_cast(_Float16, (unsigned short)(w >> 16)); }
__device__ __forceinline__ f32x4_t_ MFMA16(s16x8_t a, s16x8_t b, f32x4_t_ c) { return __builtin_amdgcn_mfma_f32_16x16x32_f16(__builtin_bit_cast(h16x8_t, a), __builtin_bit_cast(h16x8_t, b), c, 0, 0, 0); }
__device__ __forceinline__ f32x16_t_ MFMA32(s16x8_t a, s16x8_t b, f32x16_t_ c) { return __builtin_amdgcn_mfma_f32_32x32x16_f16(__builtin_bit_cast(h16x8_t, a), __builtin_bit_cast(h16x8_t, b), c, 0, 0, 0); }
#define MK_WAVETAB_LDS 131072
__device__ __forceinline__ int my_tid() {
    const unsigned hw = (unsigned)__builtin_amdgcn_s_getreg((5 << 11) | 4) & 63u;
    const unsigned wv = (unsigned)__builtin_amdgcn_readfirstlane((int)((volatile __attribute__((address_space(3))) unsigned*)MK_WAVETAB_LDS)[hw]);
    unsigned lane; asm volatile("v_mbcnt_lo_u32_b32 %0, -1, 0\n\tv_mbcnt_hi_u32_b32 %0, -1, %0" : "=v"(lane));
    return (int)(wv * 64u + lane);
}
namespace pg8 {
#define PG8_LAS __attribute__((address_space(3)))
typedef unsigned short bf16_t;
typedef short bf16x8 __attribute__((ext_vector_type(8)));
typedef float f32x4 __attribute__((ext_vector_type(4)));
typedef unsigned u32x4 __attribute__((ext_vector_type(4)));
constexpr int BM = 256, BK = 64, HALF = 128, HTB = HALF * BK * 2  , STAGE_BYTES = 8 * HTB, NXCD = 8, WGM = 8;

__host__ __device__ __forceinline__ int lds_byte(int r, int c) { const int st = (r >> 4) * 2 + (c >> 5), rr = r & 15, cc = c & 31, ob = rr * 64 + cc * 2; return st * 1024 + (ob ^ (((ob >> 9) & 1) << 5)); }
__host__ __device__ __forceinline__ void stage_rc(int b, int& R, int& C) { const int st = b / 1024, sb = b % 1024, swz = sb ^ (((sb >> 9) & 1) << 5); R = (st >> 1) * 16 + swz / 64; C = (st & 1) * 32 + (swz % 64) / 2; }
__host__ __device__ __forceinline__ int perm32(int rho) { const int n = rho >> 4, i = rho & 15; return 8 * (i >> 2) + 4 * n + (i & 3); }

struct Unit { int pm, pn; };
struct Gemm { const bf16_t* A; const bf16_t* Bt; int M, N, K; };

struct StaticOrder {
    int nM, nN, nwg, G, c;
    __host__ __device__ void init(int M, int N, int G_, int c_) { nM = M / BM; nN = N / BM; nwg = nM * nN; G = G_; c = c_; }
    __host__ __device__ bool next(int i, Unit& u) const {
        const long L = (long)i * G + c; if (L >= nwg) return false;
        int wgid = (int)L; { const int q = nwg / NXCD, r = nwg % NXCD, xcd = wgid % NXCD, off = wgid / NXCD; wgid = (xcd < r ? xcd * (q + 1) : r * (q + 1) + (xcd - r) * q) + off; }
        const int nig = WGM * nN, gid = wgid / nig, fm = gid * WGM, gsz = (nM - fm) < WGM ? (nM - fm) : WGM;
        u.pm = fm + ((wgid % nig) % gsz); u.pn = (wgid % nig) / gsz; return true;
    }
    __device__ __forceinline__ void a_ready(const Unit&) const {}
    __device__ __forceinline__ void done(const Unit&) const {}
};

__device__ __forceinline__ unsigned cvt_pk_bf16(float lo, float hi) { typedef __fp16 hp2 __attribute__((ext_vector_type(2))); const hp2 v = __builtin_amdgcn_cvt_pkrtz(lo, hi); return __builtin_bit_cast(unsigned, v); }
typedef float f32x2 __attribute__((ext_vector_type(2)));
__device__ __forceinline__ f32x2 gelu_pk(f32x2 v) {
    const f32x2 av = __builtin_elementwise_abs(v), d = av * 0.2316418882f + 1.0f;
    f32x2 t; t.x = __builtin_amdgcn_rcpf(d.x); t.y = __builtin_amdgcn_rcpf(d.y);
    f32x2 q = t * 0.5307027145f + (-0.7265760135f); q = q * t + 0.7107068705f; q = q * t + (-0.142248368f); q = q * t + 0.127414796f; q = q * t;
    const f32x2 s = (v * v) * (-0.72134752044f);
    f32x2 e; e.x = __builtin_amdgcn_exp2f(s.x); e.y = __builtin_amdgcn_exp2f(s.y);
    const f32x2 m = v * (q * e), r = v - m;
    f32x2 o; o.x = v.x < 0.f ? m.x : r.x; o.y = v.y < 0.f ? m.y : r.y; return o;
}

template <int ACT  > struct EpiBf16 {
    static constexpr bool PERM = true, AFTER_DRAIN = false; static_assert(ACT == 0 || ACT == 1, "EpiBf16: ACT is 0 (none) or 1 (gelu_pk)");
    bf16_t* O; int ldc; const float* bias; int split_cols; size_t split_stride; float scale0;
    __device__ __forceinline__ void operator()(const f32x4 (&acc)[2][2][4][2], const Unit& u, int wr, int wc, int fr, int fq) const {
        const int row0 = u.pm * BM + wr * 64 + fr; int colt = u.pn * BM; bf16_t* base = O;
        float sc = 1.f; if (split_cols) { const int t = colt / split_cols; base += (size_t)t * split_stride; colt -= t * split_cols; if (t == 0) sc = scale0; }
        const int col0 = colt + wc * 32 + 8 * fq, bcol0 = u.pn * BM + wc * 32 + 8 * fq;
        f32x4 bv[2][2];
#pragma unroll
        for (int bj = 0; bj < 2; ++bj)
#pragma unroll
            for (int n = 0; n < 2; ++n) bv[bj][n] = bias ? *(const f32x4*)(bias + bcol0 + bj * HALF + 4 * n) : (f32x4){0.f, 0.f, 0.f, 0.f};
#pragma unroll
        for (int ai = 0; ai < 2; ++ai)
#pragma unroll
            for (int m = 0; m < 4; ++m) { bf16_t* rowp = base + (size_t)(row0 + ai * HALF + m * 16) * ldc + col0;
#pragma unroll
                for (int bj = 0; bj < 2; ++bj) { f32x4 v0 = acc[ai][bj][m][0] + bv[bj][0], v1 = acc[ai][bj][m][1] + bv[bj][1];
                    if (ACT == 1) { f32x2 a = gelu_pk((f32x2){v0[0], v0[1]}), b = gelu_pk((f32x2){v0[2], v0[3]}), c = gelu_pk((f32x2){v1[0], v1[1]}), d = gelu_pk((f32x2){v1[2], v1[3]});
                        v0 = (f32x4){a.x, a.y, b.x, b.y}; v1 = (f32x4){c.x, c.y, d.x, d.y}; }
                    v0 = v0 * sc; v1 = v1 * sc; u32x4 w; w.x = cvt_pk_bf16(v0[0], v0[1]); w.y = cvt_pk_bf16(v0[2], v0[3]); w.z = cvt_pk_bf16(v1[0], v1[1]); w.w = cvt_pk_bf16(v1[2], v1[3]);
                    *(u32x4*)(rowp + bj * HALF) = w; } }
    }
};
__device__ __forceinline__ float bf2f(unsigned short b) { return h_lo((unsigned)b); }
__device__ __forceinline__ float sigm(float x) { return __builtin_amdgcn_rcpf(1.0f + __builtin_amdgcn_exp2f(-1.4426950408889634f * x)); }
__device__ __forceinline__ void unpack8(const u32x4 w, float (&f)[8]) {
    f[0] = h_lo(w.x); f[1] = h_hi(w.x); f[2] = h_lo(w.y); f[3] = h_hi(w.y); f[4] = h_lo(w.z); f[5] = h_hi(w.z); f[6] = h_lo(w.w); f[7] = h_hi(w.w);
}
template <int ACT> struct EpiRoute {
    static constexpr bool PERM = true, AFTER_DRAIN = false;
    bf16_t* O0; int ld0; int nt0;
    bf16_t* O1; int ld1; int nt1; int nts1; float sc1;
    bf16_t* O2; int ld2;
    __device__ __forceinline__ void operator()(const f32x4 (&acc)[2][2][4][2], const Unit& u, int wr, int wc, int fr, int fq) const {
        const int row0 = u.pm * BM + wr * 64 + fr;
        bf16_t* base; int ld, colt; float sc = 1.f;
        if (u.pn < nt0) { base = O0; ld = ld0; colt = u.pn * BM; }
        else if (u.pn < nt0 + nt1) { base = O1; ld = ld1; colt = (u.pn - nt0) * BM; if (u.pn - nt0 < nts1) sc = sc1; }
        else { base = O2; ld = ld2; colt = (u.pn - nt0 - nt1) * BM; }
        const int col0 = colt + wc * 32 + 8 * fq;
#pragma unroll
        for (int ai = 0; ai < 2; ++ai)
#pragma unroll
            for (int m = 0; m < 4; ++m) { bf16_t* rowp = base + (size_t)(row0 + ai * HALF + m * 16) * ld + col0;
#pragma unroll
                for (int bj = 0; bj < 2; ++bj) { f32x4 v0 = acc[ai][bj][m][0], v1 = acc[ai][bj][m][1];
                    if (ACT == 2) { for (int e = 0; e < 4; ++e) { const float a = fmaxf(v0[e], 0.f), b = fmaxf(v1[e], 0.f); v0[e] = a * a; v1[e] = b * b; } }
                    v0 = v0 * sc; v1 = v1 * sc; u32x4 w; w.x = cvt_pk_bf16(v0[0], v0[1]); w.y = cvt_pk_bf16(v0[2], v0[3]); w.z = cvt_pk_bf16(v1[0], v1[1]); w.w = cvt_pk_bf16(v1[2], v1[3]);
                    *(u32x4*)(rowp + bj * HALF) = w; } }
    }
};
struct EpiSig {
    static constexpr bool PERM = true, AFTER_DRAIN = false;
    bf16_t* O; const float* p; float scale; int ld;
    __device__ __forceinline__ void operator()(const f32x4 (&acc)[2][2][4][2], const Unit& u, int wr, int wc, int fr, int fq) const {
        const int row0 = u.pm * BM + wr * 64 + fr; const int col0 = u.pn * BM + wc * 32 + 8 * fq;
        const f32x4 pA0 = *(const f32x4*)(p + col0), pA1 = *(const f32x4*)(p + col0 + 4), pB0 = *(const f32x4*)(p + col0 + HALF), pB1 = *(const f32x4*)(p + col0 + HALF + 4);
#pragma unroll
        for (int ai = 0; ai < 2; ++ai)
#pragma unroll
            for (int m = 0; m < 4; ++m) { bf16_t* rowp = O + (size_t)(row0 + ai * HALF + m * 16) * ld + col0;
#pragma unroll
                for (int bj = 0; bj < 2; ++bj) { f32x4 v0 = acc[ai][bj][m][0], v1 = acc[ai][bj][m][1]; const f32x4 p0 = bj ? pB0 : pA0, p1 = bj ? pB1 : pA1;
                    v0 = (f32x4){sigm(p0[0] + v0[0]), sigm(p0[1] + v0[1]), sigm(p0[2] + v0[2]), sigm(p0[3] + v0[3])} * scale; v1 = (f32x4){sigm(p1[0] + v1[0]), sigm(p1[1] + v1[1]), sigm(p1[2] + v1[2]), sigm(p1[3] + v1[3])} * scale;
                    u32x4 w; w.x = cvt_pk_bf16(v0[0], v0[1]); w.y = cvt_pk_bf16(v0[2], v0[3]); w.z = cvt_pk_bf16(v1[0], v1[1]); w.w = cvt_pk_bf16(v1[2], v1[3]);
                    *(u32x4*)(rowp + bj * HALF) = w; } }
    }
};
struct EpiQRope {
    static constexpr bool PERM = true, AFTER_DRAIN = false;
    bf16_t* O; const float* rope; float sc;
    __device__ __forceinline__ void operator()(const f32x4 (&acc)[2][2][4][2], const Unit& u, int wr, int wc, int fr, int fq) const {
        const int row0 = u.pm * BM + wr * 64 + fr; const int col0 = u.pn * BM + wc * 32 + 8 * fq;
#pragma unroll
        for (int ai = 0; ai < 2; ++ai)
#pragma unroll
            for (int m = 0; m < 4; ++m) { const int row = row0 + ai * HALF + m * 16;
#pragma unroll
                for (int bj = 0; bj < 2; ++bj) { const int cg = col0 + bj * HALF; const int cm = cg % 192; f32x4 v0 = acc[ai][bj][m][0], v1 = acc[ai][bj][m][1];
                    if (cm >= 128) { const int j0 = (cm - 128) >> 1; const f32x4* rp = (const f32x4*)(rope + ((size_t)row * 32 + j0) * 2); const f32x4 a = rp[0], b = rp[1];
                        f32x4 r0, r1;
                        r0[0] = v0[0] * a[0] - v0[1] * a[1]; r0[1] = v0[1] * a[0] + v0[0] * a[1]; r0[2] = v0[2] * a[2] - v0[3] * a[3]; r0[3] = v0[3] * a[2] + v0[2] * a[3];
                        r1[0] = v1[0] * b[0] - v1[1] * b[1]; r1[1] = v1[1] * b[0] + v1[0] * b[1]; r1[2] = v1[2] * b[2] - v1[3] * b[3]; r1[3] = v1[3] * b[2] + v1[2] * b[3];
                        v0 = r0; v1 = r1; }
                    v0 = v0 * sc; v1 = v1 * sc; u32x4 w; w.x = cvt_pk_bf16(v0[0], v0[1]); w.y = cvt_pk_bf16(v0[2], v0[3]); w.z = cvt_pk_bf16(v1[0], v1[1]); w.w = cvt_pk_bf16(v1[2], v1[3]);
                    *(u32x4*)(O + (size_t)row * 768 + cg) = w; } }
    }
};
template <int NI> struct EpiMerge {
    static constexpr bool PERM = true, AFTER_DRAIN = false;
    bf16_t* MG; const bf16_t* GT;
    __device__ __forceinline__ void operator()(const f32x4 (&acc)[2][2][4][2], const Unit& u, int wr, int wc, int fr, int fq) const {
        const int row0 = u.pm * BM + wr * 64 + fr; const int col0 = u.pn * BM + wc * 32 + 8 * fq;
#pragma unroll
        for (int ai = 0; ai < 2; ++ai)
#pragma unroll
            for (int m = 0; m < 4; ++m) { const int row = row0 + ai * HALF + m * 16;
#pragma unroll
                for (int bj = 0; bj < 2; ++bj) { const int c = col0 + bj * HALF; const f32x4 v0 = acc[ai][bj][m][0], v1 = acc[ai][bj][m][1];
                    const u32x4 gw = *(const u32x4*)(GT + (size_t)row * 3072 + NI * 1024 + c);
                    f32x4 o0 = {0.f, 0.f, 0.f, 0.f}, o1 = {0.f, 0.f, 0.f, 0.f};
                    if (NI > 0) { const u32x4 ow = *(const u32x4*)(MG + (size_t)row * 1024 + c); o0 = (f32x4){h_lo(ow.x), h_hi(ow.x), h_lo(ow.y), h_hi(ow.y)}; o1 = (f32x4){h_lo(ow.z), h_hi(ow.z), h_lo(ow.w), h_hi(ow.w)}; }
                    o0[0] += sigm(h_lo(gw.x)) * v0[0]; o0[1] += sigm(h_hi(gw.x)) * v0[1]; o0[2] += sigm(h_lo(gw.y)) * v0[2]; o0[3] += sigm(h_hi(gw.y)) * v0[3];
                    o1[0] += sigm(h_lo(gw.z)) * v1[0]; o1[1] += sigm(h_hi(gw.z)) * v1[1]; o1[2] += sigm(h_lo(gw.w)) * v1[2]; o1[3] += sigm(h_hi(gw.w)) * v1[3];
                    u32x4 w; w.x = cvt_pk_bf16(o0[0], o0[1]); w.y = cvt_pk_bf16(o0[2], o0[3]); w.z = cvt_pk_bf16(o1[0], o1[1]); w.w = cvt_pk_bf16(o1[2], o1[3]);
                    *(u32x4*)(MG + (size_t)row * 1024 + c) = w; } }
    }
};
__device__ __forceinline__ unsigned pk_fma_h(unsigned a, unsigned b, unsigned c) { unsigned r; asm("v_pk_fma_f16 %0, %1, %2, %3" : "=v"(r) : "v"(a), "v"(b), "v"(c)); return r; }
struct EpiMergeAll {
    static constexpr bool PERM = true, AFTER_DRAIN = false;
    bf16_t* MG; const bf16_t* GT;
    __device__ __forceinline__ void operator()(const f32x4 (&acc)[2][2][4][2], const Unit& u, int wr, int wc, int fr, int fq) const {
        const int a = u.pm >> 7, p = u.pm & 127, br = u.pn >> 2, q = u.pn & 3;
        const int row0 = p * BM + wr * 64 + fr; const int col0 = q * BM + wc * 32 + 8 * fq;
#pragma unroll
        for (int ai = 0; ai < 2; ++ai) {
            u32x4 gw[4][2], ow[4][2];
#pragma unroll
            for (int m = 0; m < 4; ++m)
#pragma unroll
                for (int bj = 0; bj < 2; ++bj) { const int row = row0 + ai * HALF + m * 16, c = col0 + bj * HALF;
                    gw[m][bj] = *(const u32x4*)(GT + (size_t)row * 3072 + br * 1024 + c);
                    if (a > 0) ow[m][bj] = *(const u32x4*)(MG + (size_t)row * 1024 + c); else ow[m][bj] = (u32x4){0u, 0u, 0u, 0u}; }
            __builtin_amdgcn_sched_barrier(0);
#pragma unroll
            for (int m = 0; m < 4; ++m)
#pragma unroll
                for (int bj = 0; bj < 2; ++bj) { const int row = row0 + ai * HALF + m * 16, c = col0 + bj * HALF; const f32x4 v0 = acc[ai][bj][m][0], v1 = acc[ai][bj][m][1]; const u32x4 g = gw[m][bj], o = ow[m][bj];
                    u32x4 w;
                    w.x = pk_fma_h(cvt_pk_bf16(sigm(h_lo(g.x)), sigm(h_hi(g.x))), cvt_pk_bf16(v0[0], v0[1]), o.x);
                    w.y = pk_fma_h(cvt_pk_bf16(sigm(h_lo(g.y)), sigm(h_hi(g.y))), cvt_pk_bf16(v0[2], v0[3]), o.y);
                    w.z = pk_fma_h(cvt_pk_bf16(sigm(h_lo(g.z)), sigm(h_hi(g.z))), cvt_pk_bf16(v1[0], v1[1]), o.z);
                    w.w = pk_fma_h(cvt_pk_bf16(sigm(h_lo(g.w)), sigm(h_hi(g.w))), cvt_pk_bf16(v1[2], v1[3]), o.w);
                    *(u32x4*)(MG + (size_t)row * 1024 + c) = w; }
            __builtin_amdgcn_sched_barrier(0);
        }
    }
};
struct MergeOrder {
    int G, c;
    __device__ __forceinline__ bool next(int i, Unit& u) const { if (i >= 6 || G != 256) { if (G == 256) return false; const int t = c + G * (i / 3), a = i % 3; if (t >= 512) return false;
            const int p = t >> 2, q = t & 3, br = (a == 0) ? 0 : (a == 1 ? 2 : 1); u.pm = a * 128 + p; u.pn = br * 4 + q; return true; }
        const int x = c & 7, s = c >> 3, p = x * 16 + (s >> 1), q = 2 * (s & 1) + i / 3, a = i % 3, br = (a == 0) ? 0 : (a == 1 ? 2 : 1);
        u.pm = a * 128 + p; u.pn = br * 4 + q; return true; }
    __device__ __forceinline__ void a_ready(const Unit&) const {}
    __device__ __forceinline__ void done(const Unit&) const {}
};
struct EpiPle {
    static constexpr bool PERM = true, AFTER_DRAIN = false;
    bf16_t* H16; const bf16_t* PP; float* outLo; float* outHi; int last;
    __device__ __forceinline__ void operator()(const f32x4 (&acc)[2][2][4][2], const Unit& u, int wr, int wc, int fr, int fq) const {
        const int row0 = u.pm * BM + wr * 64 + fr; const int col0 = u.pn * BM + wc * 32 + 8 * fq;
#pragma unroll
        for (int ai = 0; ai < 2; ++ai) {
            u32x4 pw[4][2], hw[4][2];
#pragma unroll
            for (int m = 0; m < 4; ++m)
#pragma unroll
                for (int bj = 0; bj < 2; ++bj) { const int row = row0 + ai * HALF + m * 16, c = col0 + bj * HALF;
                    pw[m][bj] = *(const u32x4*)(PP + (size_t)row * 1024 + c); hw[m][bj] = *(const u32x4*)(H16 + (size_t)row * 1024 + c); }
            __builtin_amdgcn_sched_barrier(0);
#pragma unroll
            for (int m = 0; m < 4; ++m)
#pragma unroll
                for (int bj = 0; bj < 2; ++bj) { const int row = row0 + ai * HALF + m * 16, c = col0 + bj * HALF; const f32x4 v0 = acc[ai][bj][m][0], v1 = acc[ai][bj][m][1]; const u32x4 pq = pw[m][bj], hq = hw[m][bj];
                    f32x4 h0 = (f32x4){h_lo(hq.x), h_hi(hq.x), h_lo(hq.y), h_hi(hq.y)}, h1 = (f32x4){h_lo(hq.z), h_hi(hq.z), h_lo(hq.w), h_hi(hq.w)};
                    h0[0] += sigm(v0[0]) * h_lo(pq.x); h0[1] += sigm(v0[1]) * h_hi(pq.x); h0[2] += sigm(v0[2]) * h_lo(pq.y); h0[3] += sigm(v0[3]) * h_hi(pq.y);
                    h1[0] += sigm(v1[0]) * h_lo(pq.z); h1[1] += sigm(v1[1]) * h_hi(pq.z); h1[2] += sigm(v1[2]) * h_lo(pq.w); h1[3] += sigm(v1[3]) * h_hi(pq.w);
                    if (last) { float* op = (row < 16384) ? (outLo + (size_t)row * 1024 + c) : (outHi + (size_t)(row - 16384) * 1024 + c); *(f32x4*)op = h0; *(f32x4*)(op + 4) = h1; }
                    else { u32x4 w; w.x = h_pk2(h0[0], h0[1]); w.y = h_pk2(h0[2], h0[3]); w.z = h_pk2(h1[0], h1[1]); w.w = h_pk2(h1[2], h1[3]); *(u32x4*)(H16 + (size_t)row * 1024 + c) = w; } }
            __builtin_amdgcn_sched_barrier(0);
        }
    }
};
template <class Epi, class Sched, bool ALIGN_EPI = false, bool SP2 = false>
__device__ __forceinline__ void gemm_phase(PG8_LAS unsigned char* lds, const Gemm g, const Sched& S, const Epi& E) {
    int tid_ = my_tid(); asm volatile("" : "+v"(tid_));
    const int tid = tid_, wid = __builtin_amdgcn_readfirstlane(tid >> 6), lane = tid & 63, wr = wid >> 2, wc = wid & 3, fr = lane & 15, fq = lane >> 4;
    const int K = g.K, nt = K / BK;
    unsigned voffA[2], voffB[2];
#pragma unroll
    for (int i = 0; i < 2; ++i) { int R, C; stage_rc(tid * 16 + i * 8192, R, C); const int Rb = Epi::PERM ? ((R & ~31) + perm32(R & 31)) : R;
        voffA[i] = (unsigned)(R * K + C) * 2u; voffB[i] = (unsigned)(Rb * K + C) * 2u; }
    const size_t kstep = (size_t)(BK * 2);
    const size_t hstep = (size_t)HALF * K * 2;
    const size_t tstep = 2 * hstep;
    const unsigned ldsw = (unsigned)wid * 1024u;
    const int aoff = lds_byte(wr * 64 + fr, fq * 8), boff = lds_byte(wc * 32 + fr, fq * 8);
#define PG8_SA(b, h) (((b) * 2 + (h)) * HTB)
#define PG8_SB(b, h) ((4 + (b) * 2 + (h)) * HTB)
#define PG8_STAGE(bufoff, gbase, voff) do { _Pragma("unroll") for (int _i = 0; _i < 2; ++_i) \
        __builtin_amdgcn_global_load_lds((const unsigned*)((const char*)(gbase) + (voff)[_i]), (PG8_LAS unsigned*)(lds + (bufoff) + ldsw + _i * 8192), 16, 0, 0); } while (0)
#define PG8_LDA(dst, b, h) do { _Pragma("unroll") for (int m = 0; m < 4; ++m) _Pragma("unroll") for (int k = 0; k < 2; ++k) dst[m][k] = *(const PG8_LAS bf16x8*)(lds + PG8_SA(b, h) + aoff + m * 2048 + k * 1024); } while (0)
#define PG8_LDB(dst, b, h) do { _Pragma("unroll") for (int n = 0; n < 2; ++n) _Pragma("unroll") for (int k = 0; k < 2; ++k) dst[n][k] = *(const PG8_LAS bf16x8*)(lds + PG8_SB(b, h) + boff + n * 2048 + k * 1024); } while (0)
#define PG8_MMA(ai, bj, At, Bt) do { __builtin_amdgcn_s_setprio(1); _Pragma("unroll") for (int m = 0; m < 4; ++m) _Pragma("unroll") for (int n = 0; n < 2; ++n) _Pragma("unroll") for (int k = 0; k < 2; ++k) \
        acc[ai][bj][m][n] = MFMA16(Bt[n][k], At[m][k], acc[ai][bj][m][n]); __builtin_amdgcn_s_setprio(0); } while (0)
#define PG8_WAIT_V(n) asm volatile("s_waitcnt vmcnt(" #n ")" ::: "memory")
#define PG8_WAIT_L(n) asm volatile("s_waitcnt lgkmcnt(" #n ")" ::: "memory")
#define PG8_BAR __builtin_amdgcn_s_barrier()
#define PG8_SCHED __builtin_amdgcn_sched_barrier(0)
    Unit cur, nxt; int ui = 0;
    if (!S.next(0, cur)) return;
    f32x4 acc[2][2][4][2];
#pragma unroll
    for (int a = 0; a < 2; ++a)
#pragma unroll
        for (int b = 0; b < 2; ++b)
#pragma unroll
            for (int m = 0; m < 4; ++m)
#pragma unroll
                for (int n = 0; n < 2; ++n) acc[a][b][m][n] = (f32x4){0.f, 0.f, 0.f, 0.f};
    bf16x8 At[4][2], B0[2][2], B1[2][2];
    const char* cA = (const char*)g.A + (size_t)cur.pm * tstep; const char* cB = (const char*)g.Bt + (size_t)cur.pn * tstep;
    S.a_ready(cur);
    if constexpr (SP2) {
        PG8_STAGE(PG8_SB(0, 0), cB, voffB); PG8_STAGE(PG8_SB(0, 1), cB + hstep, voffB); PG8_STAGE(PG8_SA(0, 0), cA, voffA); PG8_STAGE(PG8_SA(0, 1), cA + hstep, voffA);
        if (wr == 1) PG8_BAR;
        PG8_WAIT_V(2); PG8_BAR;
        PG8_STAGE(PG8_SB(1, 0), cB + kstep, voffB); PG8_STAGE(PG8_SA(1, 0), cA + kstep, voffA); PG8_STAGE(PG8_SB(1, 1), cB + hstep + kstep, voffB);
        PG8_WAIT_V(6); PG8_BAR;
    } else {
        PG8_STAGE(PG8_SB(0, 0), cB, voffB); PG8_STAGE(PG8_SA(0, 0), cA, voffA); PG8_STAGE(PG8_SB(0, 1), cB + hstep, voffB); PG8_STAGE(PG8_SA(0, 1), cA + hstep, voffA);
        if (wr == 1) PG8_BAR;
        PG8_WAIT_V(4); PG8_BAR;
        PG8_STAGE(PG8_SB(1, 0), cB + kstep, voffB); PG8_STAGE(PG8_SA(1, 0), cA + kstep, voffA); PG8_STAGE(PG8_SB(1, 1), cB + hstep + kstep, voffB);
        PG8_WAIT_V(6); PG8_BAR;
    }
    for (;;) {
        const bool has_next = S.next(ui + 1, nxt);
        const char* nA = has_next ? (const char*)g.A + (size_t)nxt.pm * tstep : cA; const char* nB = has_next ? (const char*)g.Bt + (size_t)nxt.pn * tstep : cB;
        for (int t = 0; t < nt; t += 2) {
            const bool last = (t == nt - 2);
            const char* a1 = cA + (size_t)(t + 1) * kstep;
            const char* a2 = last ? nA : cA + (size_t)(t + 2) * kstep; const char* b2 = last ? nB : cB + (size_t)(t + 2) * kstep;
            const char* a3 = a2 + kstep; const char* b3 = b2 + kstep;
            if (last && has_next) S.a_ready(nxt);
            if constexpr (SP2) {
            PG8_LDB(B0, 0, 0); PG8_LDB(B1, 0, 1); PG8_SCHED; PG8_LDA(At, 0, 0); PG8_STAGE(PG8_SA(1, 1), a1 + hstep, voffA);
            PG8_WAIT_V(8); PG8_WAIT_L(0); PG8_BAR; PG8_MMA(0, 0, At, B0); PG8_MMA(0, 1, At, B1); PG8_BAR; PG8_SCHED;
            PG8_LDA(At, 0, 1); PG8_STAGE(PG8_SB(0, 0), b2, voffB); PG8_STAGE(PG8_SB(0, 1), b2 + hstep, voffB); PG8_STAGE(PG8_SA(0, 0), a2, voffA);
            PG8_WAIT_V(8); PG8_WAIT_L(0); PG8_BAR; PG8_MMA(1, 0, At, B0); PG8_MMA(1, 1, At, B1); PG8_BAR; PG8_SCHED;
            PG8_LDB(B0, 1, 0); PG8_LDB(B1, 1, 1); PG8_SCHED; PG8_LDA(At, 1, 0); PG8_STAGE(PG8_SA(0, 1), a2 + hstep, voffA);
            PG8_WAIT_V(8); PG8_WAIT_L(0); PG8_BAR; PG8_MMA(0, 0, At, B0); PG8_MMA(0, 1, At, B1); PG8_BAR; PG8_SCHED;
            PG8_LDA(At, 1, 1); PG8_STAGE(PG8_SB(1, 0), b3, voffB); PG8_STAGE(PG8_SB(1, 1), b3 + hstep, voffB); PG8_STAGE(PG8_SA(1, 0), a3, voffA);
            PG8_WAIT_V(8); PG8_WAIT_L(0); PG8_BAR; PG8_MMA(1, 0, At, B0); PG8_MMA(1, 1, At, B1); PG8_BAR; PG8_SCHED;
            } else {
            PG8_LDB(B0, 0, 0); PG8_SCHED; PG8_LDA(At, 0, 0); PG8_STAGE(PG8_SA(1, 1), a1 + hstep, voffA);
            PG8_WAIT_L(8); PG8_BAR; PG8_WAIT_L(0); PG8_MMA(0, 0, At, B0); PG8_BAR; PG8_SCHED;
            PG8_LDB(B1, 0, 1); PG8_STAGE(PG8_SB(0, 0), b2, voffB);
            PG8_BAR; PG8_WAIT_L(0); PG8_MMA(0, 1, At, B1); PG8_BAR;
            PG8_LDA(At, 0, 1); PG8_STAGE(PG8_SA(0, 0), a2, voffA);
            PG8_BAR; PG8_WAIT_L(0); PG8_MMA(1, 0, At, B0); PG8_BAR; PG8_SCHED;
            PG8_STAGE(PG8_SB(0, 1), b2 + hstep, voffB);
            PG8_WAIT_V(6); PG8_BAR; PG8_MMA(1, 1, At, B1); PG8_BAR;
            PG8_LDB(B0, 1, 0); PG8_SCHED; PG8_LDA(At, 1, 0); PG8_STAGE(PG8_SA(0, 1), a2 + hstep, voffA);
            PG8_WAIT_L(8); PG8_BAR; PG8_WAIT_L(0); PG8_MMA(0, 0, At, B0); PG8_BAR; PG8_SCHED;
            PG8_LDB(B1, 1, 1); PG8_STAGE(PG8_SB(1, 0), b3, voffB);
            PG8_BAR; PG8_WAIT_L(0); PG8_MMA(0, 1, At, B1); PG8_BAR;
            PG8_LDA(At, 1, 1); PG8_STAGE(PG8_SA(1, 0), a3, voffA);
            PG8_BAR; PG8_WAIT_L(0); PG8_MMA(1, 0, At, B0); PG8_BAR; PG8_SCHED;
            PG8_STAGE(PG8_SB(1, 1), b3 + hstep, voffB);
            PG8_WAIT_V(6); PG8_BAR; PG8_MMA(1, 1, At, B1); PG8_BAR;
            }
        }
        if constexpr (ALIGN_EPI) { if (wr == 0) PG8_BAR; }
        if constexpr (!Epi::AFTER_DRAIN) { int t2_ = my_tid(); asm volatile("" : "+v"(t2_)); const int l2_ = t2_ & 63, w2_ = __builtin_amdgcn_readfirstlane(t2_ >> 6);
            E(acc, cur, w2_ >> 2, w2_ & 3, l2_ & 15, l2_ >> 4); S.done(cur); }
        if (!has_next) break;
#pragma unroll
        for (int a = 0; a < 2; ++a)
#pragma unroll
            for (int b = 0; b < 2; ++b)
#pragma unroll
                for (int m = 0; m < 4; ++m)
#pragma unroll
                    for (int n = 0; n < 2; ++n) acc[a][b][m][n] = (f32x4){0.f, 0.f, 0.f, 0.f};
        cur = nxt; cA = nA; cB = nB; ++ui;
        if constexpr (ALIGN_EPI) { if (wr == 1) PG8_BAR; }
    }
    PG8_WAIT_V(0);
    if constexpr (!ALIGN_EPI) { if (wr == 0) PG8_BAR; }
    PG8_BAR;
    if constexpr (Epi::AFTER_DRAIN) { E.fused(acc, cur, wr, wc, fr, fq, lds, wid, lane); S.done(cur); }
#undef PG8_SA
#undef PG8_SB
#undef PG8_STAGE
#undef PG8_LDA
#undef PG8_LDB
#undef PG8_MMA
#undef PG8_WAIT_V
#undef PG8_WAIT_L
#undef PG8_BAR
#undef PG8_SCHED
}
}
constexpr int NWAVES = 8;
constexpr int D = 1024, BATCH = 8, SEQ = 4096, T = BATCH * SEQ, DEPTH = 2, FF = 4096, DPLE = 256;
constexpr int IN_COLS = 6848, RW_COLS = 1792;
constexpr float NORM_EPS = 1e-6f, RW_LN_EPS = 64e-5f;
constexpr float LOG2E = 1.4426950408889634f;
constexpr float MLA_QSCALE = 0.07216878364870322f * LOG2E;
constexpr float CA_QSCALE = 0.125f * LOG2E;
constexpr size_t MiB = 1u << 20;
constexpr size_t WS_CTL = 0, CTL_ZERO_BYTES = 1 * MiB;
constexpr size_t WS_ROPE = 1 * MiB;
constexpr size_t WS_W = 9 * MiB;
constexpr size_t W_IN = WS_W, W_Q = W_IN + (size_t)6912 * 1024 * 2, W_LORA = W_Q + (size_t)768 * 256 * 2, W_B = W_LORA + (size_t)1536 * 256 * 2,
                 W_OUT = W_B + (size_t)3 * 1024 * 512 * 2, W_1 = W_OUT + (size_t)1024 * 1024 * 2, W_2 = W_1 + (size_t)4096 * 1024 * 2, W_G = W_2 + (size_t)4096 * 1024 * 2,
                 W_P = W_G + (size_t)1024 * 1024 * 2, W_END = W_P + (size_t)1024 * 256 * 2;
constexpr size_t WS_U = 49 * MiB;
constexpr size_t WS_OA = 113 * MiB, WS_OC = 145 * MiB, WS_ORW = 177 * MiB;
constexpr size_t WS_X = 209 * MiB, WS_END = 512 * MiB;
constexpr size_t X_ZC = WS_X, X_QP = X_ZC + (size_t)T * 1536 * 2, X_KV = X_QP + (size_t)T * 768 * 2, X_ZR = X_KV + (size_t)T * 192 * 2, X_TW = X_ZR + (size_t)T * 1792 * 2;
constexpr size_t X_TA = WS_ORW  , X_QN = WS_OC, X_LA = WS_OC + (size_t)T * 256 * 2;
constexpr size_t DO_G = 0, DO_H16 = 64 * MiB;
constexpr size_t X_STG = WS_X + 96 * MiB;
constexpr size_t X_GT = WS_X, X_MG = X_GT + (size_t)T * 3072 * 2;
constexpr size_t X_HID = WS_X, X_PB = WS_X, X_PP = X_PB + (size_t)T * 256 * 2;
static_assert(X_TW + (size_t)T * 512 * 2 <= WS_END && X_MG + (size_t)T * 1024 * 2 <= WS_END && X_HID + (size_t)T * 4096 * 2 <= WS_END, "X map");
constexpr int CW_TMO = 0, CW_QUEUE = 1024  , CW_BAR = 4096;
constexpr int RING_OFF = 0, RING_BYTES = 131072;
constexpr int LDSCTL_OFF = RING_BYTES, MISC_OFF = LDSCTL_OFF + 320;
constexpr int LDS_BYTES = 147456;

#define GAS __attribute__((address_space(1)))
#define LAS __attribute__((address_space(3)))
typedef unsigned short bf16;
typedef unsigned v4u __attribute__((ext_vector_type(4)));
typedef unsigned v2u __attribute__((ext_vector_type(2)));
typedef float f32x4 __attribute__((ext_vector_type(4)));
typedef float f32x16 __attribute__((ext_vector_type(16)));
typedef short bf16x8 __attribute__((ext_vector_type(8)));
typedef short s16x4 __attribute__((ext_vector_type(4)));
#define LDS_WAIT() asm volatile("s_waitcnt lgkmcnt(0)" ::: "memory")
#define VM_WAIT() asm volatile("s_waitcnt vmcnt(0)" ::: "memory")
__device__ __forceinline__ unsigned f2bf(float f) { return h_f2h(f); }
__device__ __forceinline__ unsigned pk2(float lo, float hi) { return h_pk2(lo, hi); }
__device__ __forceinline__ float bfl(unsigned w) { return h_lo(w); }
__device__ __forceinline__ float bfh(unsigned w) { return h_hi(w); }
__device__ __forceinline__ float sigmoidf_(float x) { return 1.0f / (1.0f + __expf(-x)); }
__device__ __forceinline__ float shfl_xor_f(float v, int o, int lane) { return __int_as_float(__builtin_amdgcn_ds_bpermute((lane ^ o) << 2, __float_as_int(v))); }
__device__ __forceinline__ float wave_sum(float v, int lane) {
#pragma unroll
    for (int o = 1; o < 64; o <<= 1) v += shfl_xor_f(v, o, lane);
    return v;
}
__device__ __forceinline__ unsigned char* opq(unsigned char* p) { asm volatile("" : "+s"(p)); return p; }
__device__ __forceinline__ float fsig(float x) { return __builtin_amdgcn_rcpf(1.0f + __builtin_amdgcn_exp2f(-LOG2E * x)); }
#define XB_TMO      128
#define XB_XCNT(j)  (256  + 64 * (j))
#define XB_XSUB(j)  (1280 + 64 * (j))
#define XB_XGEN(j)  (2304 + 64 * (j))
#define XB_TOP      3328
#define XB_TOPGEN   3392
#define XCD_BAR_WORDS 3456
#define XB_SPIN_CAP (1u << 25)

__device__ __forceinline__ unsigned xb_ld(unsigned* p)              { return __hip_atomic_load(p, __ATOMIC_RELAXED, __HIP_MEMORY_SCOPE_AGENT); }
__device__ __forceinline__ unsigned xb_add(unsigned* p, unsigned v) { return __hip_atomic_fetch_add(p, v, __ATOMIC_RELAXED, __HIP_MEMORY_SCOPE_AGENT); }
__device__ __forceinline__ unsigned xb_xcc_id() { return (unsigned)__builtin_amdgcn_s_getreg((3 << 11) | 20) & 0xFu; }
#define XB_SPIN(cond, bar) do { unsigned _sp = 0; while (cond) { __builtin_amdgcn_s_sleep(1); \
    if ((++_sp & 255u) == 0u) { if (xb_ld(&(bar)[XB_TMO])) break; if (_sp > XB_SPIN_CAP) { atomicAdd(&(bar)[XB_TMO], 1u); break; } } } } while (0)

struct XcdBarrier {
    unsigned* bar; unsigned x;
    volatile LAS unsigned* st;
};

__device__ __forceinline__ XcdBarrier xcd_barrier_post(unsigned* bar, volatile LAS unsigned* st) {
    XcdBarrier b; b.bar = bar; b.x = xb_xcc_id(); b.st = st;
    if (my_tid() == 0) (void)xb_add(&bar[XB_XCNT(b.x)], 1u);
    return b;
}
__device__ __forceinline__ void xcd_barrier_complete(unsigned* bar, unsigned x, unsigned& nloc, unsigned& nx) {
    const unsigned G = gridDim.x * gridDim.y * gridDim.z;
    unsigned sum, cnt, mine, sp = 0u;
    for (;;) {
        sum = 0u; cnt = 0u; mine = 0u;
#pragma unroll
        for (unsigned j = 0; j < 16; ++j) { const unsigned c = xb_ld(&bar[XB_XCNT(j)]); sum += c; cnt += (c > 0u) ? 1u : 0u; mine = (j == x) ? c : mine; }
        if (sum == G) break;
        __builtin_amdgcn_s_sleep(1);
        if ((++sp & 255u) == 0u) { if (xb_ld(&bar[XB_TMO])) break; if (sp > XB_SPIN_CAP) { atomicAdd(&bar[XB_TMO], 1u); break; } }
    }
    nloc = mine > 0u ? mine : 1u; nx = cnt > 0u ? cnt : 1u;
}

__device__ __forceinline__ void xcd_barrier(const XcdBarrier& b) {
    asm volatile("s_waitcnt vmcnt(0)" ::: "memory");
    __syncthreads();
    if (my_tid() == 0) {
        unsigned* bar = b.bar;
        __builtin_amdgcn_s_waitcnt(0);
        unsigned nloc = b.st[0], nx = b.st[1];
        if (nloc == 0u) { xcd_barrier_complete(bar, b.x, nloc, nx); b.st[0] = nloc; b.st[1] = nx; }
        const unsigned old = xb_add(&bar[XB_XSUB(b.x)], 1u);
        const unsigned gen = old / nloc;
        if (old + 1u == (gen + 1u) * nloc) {
            __builtin_amdgcn_fence(__ATOMIC_RELEASE, "agent");
            asm volatile("s_waitcnt vmcnt(0)" ::: "memory");
            const unsigned og = xb_add(&bar[XB_TOP], 1u);
            const unsigned tg = og / nx;
            if (og + 1u == (tg + 1u) * nx) xb_add(&bar[XB_TOPGEN], 1u);
            else XB_SPIN(xb_ld(&bar[XB_TOPGEN]) == tg, bar);
            __builtin_amdgcn_fence(__ATOMIC_ACQUIRE, "agent");
            xb_add(&bar[XB_XGEN(b.x)], 1u);
            asm volatile("s_waitcnt vmcnt(0)" ::: "memory");
        } else {
            XB_SPIN(xb_ld(&bar[XB_XGEN(b.x)]) == gen, bar);
            __builtin_amdgcn_fence(__ATOMIC_ACQUIRE, "agent");
            asm volatile("s_waitcnt vmcnt(0)" ::: "memory");
        }
    }
    __syncthreads();
}
namespace att {
__device__ __forceinline__ int crow(int r, int hi) { return (r & 3) + 8 * (r >> 2) + 4 * hi; }
__device__ __forceinline__ unsigned cvtpk(float lo, float hi) { return h_pk2(lo, hi); }
typedef short v4i16_t __attribute__((ext_vector_type(4)));
__device__ __forceinline__ s16x4 vtr(const LAS unsigned char* p) { return __builtin_bit_cast(s16x4, __builtin_amdgcn_ds_read_tr16_b64_v4i16((LAS v4i16_t*)p)); }
__device__ __forceinline__ float softmax_tile(f32x16& p0, f32x16& p1, float& m_reg, float& l_reg, bf16x8& pa0, bf16x8& pa1, bf16x8& pa2, bf16x8& pa3) {
    float pmax = p0[0];
#pragma unroll
    for (int r = 1; r < 16; ++r) pmax = fmaxf(pmax, p0[r]);
#pragma unroll
    for (int r = 0; r < 16; ++r) pmax = fmaxf(pmax, p1[r]);
    { auto rr = __builtin_amdgcn_permlane32_swap(__float_as_uint(pmax), __float_as_uint(pmax), false, false); pmax = fmaxf(__uint_as_float(rr[0]), __uint_as_float(rr[1])); }
    float alpha = 1.f;
    if (!__all(pmax - m_reg <= 8.f)) { const float mn = fmaxf(m_reg, pmax); alpha = __builtin_amdgcn_exp2f(m_reg - mn); m_reg = mn; }
    float ps = 0.f;
#pragma unroll
    for (int r = 0; r < 16; ++r) { p0[r] = __builtin_amdgcn_exp2f(p0[r] - m_reg); ps += p0[r]; }
#pragma unroll
    for (int r = 0; r < 16; ++r) { p1[r] = __builtin_amdgcn_exp2f(p1[r] - m_reg); ps += p1[r]; }
    { auto rr = __builtin_amdgcn_permlane32_swap(__float_as_uint(ps), __float_as_uint(ps), false, false); ps = __uint_as_float(rr[0]) + __uint_as_float(rr[1]); }
    l_reg = l_reg * alpha + ps;
#define PK4(P, BASE, OUT) do { unsigned a0 = cvtpk(P[BASE + 0], P[BASE + 1]), a1 = cvtpk(P[BASE + 2], P[BASE + 3]);   \
    unsigned b0 = cvtpk(P[BASE + 4], P[BASE + 5]), b1 = cvtpk(P[BASE + 6], P[BASE + 7]);                              \
    auto r0 = __builtin_amdgcn_permlane32_swap(a0, b0, false, false); auto r1 = __builtin_amdgcn_permlane32_swap(a1, b1, false, false); \
    v4u w = {r0[0], r1[0], r0[1], r1[1]}; OUT = __builtin_bit_cast(bf16x8, w); } while (0)
    PK4(p0, 0, pa0); PK4(p0, 8, pa1); PK4(p1, 0, pa2); PK4(p1, 8, pa3);
#undef PK4
    return alpha;
}
constexpr int MLA_KSTR = 400;
constexpr int MLA_KBUF = 64 * MLA_KSTR;
constexpr int ATT_SCR = 2 * MLA_KBUF;
__device__ __forceinline__ void mla_unit(LAS unsigned char* lds, const bf16* __restrict__ QP, const bf16* __restrict__ KV, bf16* __restrict__ OA, int b, int c) {
    int tid_ = my_tid(); asm volatile("" : "+v"(tid_));
    const int tid = tid_, lane = tid & 63, wid = __builtin_amdgcn_readfirstlane(tid >> 6), r32 = lane & 31, hi = lane >> 5;
    const int h = wid >> 1; const size_t qrow0 = (size_t)b * SEQ + c * 64 + (wid & 1) * 32;
    bf16x8 qr[12];
    { const bf16* qp = QP + (qrow0 + r32) * 768 + h * 192 + hi * 8;
#pragma unroll
      for (int d0 = 0; d0 < 12; ++d0) qr[d0] = *(const bf16x8*)(qp + d0 * 16); }
    float m_reg = -1e30f, l_reg = 0.f; f32x16 o[4];
#pragma unroll
    for (int d = 0; d < 4; ++d)
#pragma unroll
        for (int r = 0; r < 16; ++r) o[d][r] = 0.f;
    LAS float* scr = (LAS float*)(lds + ATT_SCR) + wid * 64;
    const bf16* kvb = KV + (size_t)b * SEQ * 192;
    int skey[3], sch[3];
#pragma unroll
    for (int i = 0; i < 3; ++i) { const int id = tid + 512 * i; skey[i] = id / 24; sch[i] = id % 24; }
    v4u st[3];
    const int NT = c + 1;
#pragma unroll
    for (int i = 0; i < 3; ++i) st[i] = *(const v4u*)(kvb + (size_t)skey[i] * 192 + sch[i] * 8);
#pragma unroll
    for (int i = 0; i < 3; ++i) *(LAS v4u*)(lds + skey[i] * MLA_KSTR + sch[i] * 16) = st[i];
    __syncthreads();
    const int troff = (((lane & 15) >> 2) + 8 * hi) * MLA_KSTR + (16 * ((lane >> 4) & 1) + 4 * (lane & 3)) * 2;
    for (int j = 0; j < NT; ++j) {
        const int buf = j & 1;
        if (j + 1 < NT) {
#pragma unroll
            for (int i = 0; i < 3; ++i) st[i] = *(const v4u*)(kvb + (size_t)(64 * (j + 1) + skey[i]) * 192 + sch[i] * 8);
        }
        const LAS unsigned char* kt = lds + buf * MLA_KBUF;
        f32x16 p0, p1;
#pragma unroll
        for (int r = 0; r < 16; ++r) { p0[r] = 0.f; p1[r] = 0.f; }
        { const LAS unsigned char* kb = kt + r32 * MLA_KSTR + hi * 16;
#pragma unroll
          for (int d0 = 0; d0 < 12; ++d0) { const bf16x8 a0 = *(const LAS bf16x8*)(kb + d0 * 32); const bf16x8 a1 = *(const LAS bf16x8*)(kb + 32 * MLA_KSTR + d0 * 32);
              p0 = MFMA32(a0, qr[d0], p0); p1 = MFMA32(a1, qr[d0], p1); } }
        bf16x8 pa0, pa1, pa2, pa3;
        const float alpha = softmax_tile(p0, p1, m_reg, l_reg, pa0, pa1, pa2, pa3);
        if (__any(alpha < 1.f)) { if (hi == 0) scr[r32] = alpha; LDS_WAIT();
#pragma unroll
            for (int r = 0; r < 16; ++r) { const float a = scr[crow(r, hi)];
#pragma unroll
                for (int d = 0; d < 4; ++d) o[d][r] *= a; } }
        const LAS unsigned char* vb = kt + troff;
#pragma unroll
        for (int d0 = 0; d0 < 4; ++d0) {
            s16x4 lo[4], hh[4];
#pragma unroll
            for (int ks = 0; ks < 4; ++ks) { lo[ks] = vtr(vb + (16 * ks) * MLA_KSTR + d0 * 64); hh[ks] = vtr(vb + (16 * ks + 4) * MLA_KSTR + d0 * 64); }
#define PK(k) (bf16x8){lo[k][0], lo[k][1], lo[k][2], lo[k][3], hh[k][0], hh[k][1], hh[k][2], hh[k][3]}
            o[d0] = MFMA32(pa0, PK(0), o[d0]);
            o[d0] = MFMA32(pa1, PK(1), o[d0]);
            o[d0] = MFMA32(pa2, PK(2), o[d0]);
            o[d0] = MFMA32(pa3, PK(3), o[d0]);
#undef PK
        }
        if (j + 1 < NT) {
#pragma unroll
            for (int i = 0; i < 3; ++i) *(LAS v4u*)(lds + (buf ^ 1) * MLA_KBUF + skey[i] * MLA_KSTR + sch[i] * 16) = st[i];
        }
        __syncthreads();
    }
    if (hi == 0) scr[r32] = l_reg; LDS_WAIT();
    bf16* ob = OA + qrow0 * 512 + h * 128 + r32;
#pragma unroll
    for (int r = 0; r < 16; ++r) { const int orow = crow(r, hi); const float rl = __builtin_amdgcn_rcpf(scr[orow]);
#pragma unroll
        for (int d0 = 0; d0 < 4; ++d0) ob[(size_t)orow * 512 + d0 * 32] = (bf16)f2bf(o[d0][r] * rl); }
    __syncthreads();
}
constexpr int CA_KSTR = 144;
constexpr int CA_TBUF = 64 * CA_KSTR;
constexpr int CA_BIAS = ATT_SCR + 8 * 256;
__device__ __forceinline__ void band_unit(LAS unsigned char* lds, const bf16* __restrict__ ZC, const float* __restrict__ relb, bf16* __restrict__ OC, int b, int h, int g) {
    int tid_ = my_tid(); asm volatile("" : "+v"(tid_));
    const int tid = tid_, lane = tid & 63, wid = __builtin_amdgcn_readfirstlane(tid >> 6), r32 = lane & 31, hi = lane >> 5;
    const int cw = 4 * g + (wid >> 1); const size_t qrow0 = (size_t)b * SEQ + cw * 64 + (wid & 1) * 32;
    LAS float* bias = (LAS float*)(lds + CA_BIAS);
    if (tid < 320) bias[tid] = relb[tid * 8 + h] * LOG2E;
    bf16x8 qr[4];
    { const bf16* qp = ZC + (qrow0 + r32) * 1536 + h * 64 + hi * 8;
#pragma unroll
      for (int d0 = 0; d0 < 4; ++d0) qr[d0] = *(const bf16x8*)(qp + d0 * 16); }
    float m_reg = -1e30f, l_reg = 0.f; f32x16 o[2];
#pragma unroll
    for (int d = 0; d < 2; ++d)
#pragma unroll
        for (int r = 0; r < 16; ++r) o[d][r] = 0.f;
    LAS float* scr = (LAS float*)(lds + ATT_SCR) + wid * 64;
    const int kc0 = (4 * g - 8) < 0 ? 0 : (4 * g - 8), kc1 = 4 * g + 3;
    const bf16* kbase = ZC + (size_t)b * SEQ * 1536 + 512 + h * 64; const bf16* vbase = kbase + 512;
    const int skey = tid >> 3, sch = tid & 7;
    v4u stk, stv;
    stk = *(const v4u*)(kbase + (size_t)(64 * kc0 + skey) * 1536 + sch * 8); stv = *(const v4u*)(vbase + (size_t)(64 * kc0 + skey) * 1536 + sch * 8);
    *(LAS v4u*)(lds + skey * CA_KSTR + sch * 16) = stk; *(LAS v4u*)(lds + CA_TBUF + skey * CA_KSTR + sch * 16) = stv;
    __syncthreads();
    const int troff = (((lane & 15) >> 2) + 8 * hi) * CA_KSTR + (16 * ((lane >> 4) & 1) + 4 * (lane & 3)) * 2;
    const int qin = (wid & 1) * 32 + r32;
    for (int kc = kc0; kc <= kc1; ++kc) {
        const int buf = (kc - kc0) & 1;
        if (kc < kc1) { stk = *(const v4u*)(kbase + (size_t)(64 * (kc + 1) + skey) * 1536 + sch * 8); stv = *(const v4u*)(vbase + (size_t)(64 * (kc + 1) + skey) * 1536 + sch * 8); }
        if (kc >= cw - 8 && kc <= cw) {
            const LAS unsigned char* kt = lds + buf * 2 * CA_TBUF;
            f32x16 p0, p1;
            const int dbase = (cw - kc) * 64 + qin + 63;
#pragma unroll
            for (int r = 0; r < 16; ++r) { int i0 = dbase - crow(r, hi), i1 = i0 - 32; i0 = i0 > 319 ? 319 : i0; i1 = i1 > 319 ? 319 : i1; p0[r] = bias[i0]; p1[r] = bias[i1]; }
            { const LAS unsigned char* kb = kt + r32 * CA_KSTR + hi * 16;
#pragma unroll
              for (int d0 = 0; d0 < 4; ++d0) { const bf16x8 a0 = *(const LAS bf16x8*)(kb + d0 * 32); const bf16x8 a1 = *(const LAS bf16x8*)(kb + 32 * CA_KSTR + d0 * 32);
                  p0 = MFMA32(a0, qr[d0], p0); p1 = MFMA32(a1, qr[d0], p1); } }
            bf16x8 pa0, pa1, pa2, pa3;
            const float alpha = softmax_tile(p0, p1, m_reg, l_reg, pa0, pa1, pa2, pa3);
            if (__any(alpha < 1.f)) { if (hi == 0) scr[r32] = alpha; LDS_WAIT();
#pragma unroll
                for (int r = 0; r < 16; ++r) { const float a = scr[crow(r, hi)]; o[0][r] *= a; o[1][r] *= a; } }
            const LAS unsigned char* vb = kt + CA_TBUF + troff;
#pragma unroll
            for (int d0 = 0; d0 < 2; ++d0) {
                s16x4 lo[4], hh[4];
#pragma unroll
                for (int ks = 0; ks < 4; ++ks) { lo[ks] = vtr(vb + (16 * ks) * CA_KSTR + d0 * 64); hh[ks] = vtr(vb + (16 * ks + 4) * CA_KSTR + d0 * 64); }
#define PK(k) (bf16x8){lo[k][0], lo[k][1], lo[k][2], lo[k][3], hh[k][0], hh[k][1], hh[k][2], hh[k][3]}
                o[d0] = MFMA32(pa0, PK(0), o[d0]);
                o[d0] = MFMA32(pa1, PK(1), o[d0]);
                o[d0] = MFMA32(pa2, PK(2), o[d0]);
                o[d0] = MFMA32(pa3, PK(3), o[d0]);
#undef PK
            }
        }
        if (kc < kc1) { *(LAS v4u*)(lds + (buf ^ 1) * 2 * CA_TBUF + skey * CA_KSTR + sch * 16) = stk; *(LAS v4u*)(lds + (buf ^ 1) * 2 * CA_TBUF + CA_TBUF + skey * CA_KSTR + sch * 16) = stv; }
        __syncthreads();
    }
    if (hi == 0) scr[r32] = l_reg; LDS_WAIT();
    bf16* ob = OC + qrow0 * 512 + h * 64 + r32;
#pragma unroll
    for (int r = 0; r < 16; ++r) { const int orow = crow(r, hi); const float rl = __builtin_amdgcn_rcpf(scr[orow]);
        ob[(size_t)orow * 512] = (bf16)f2bf(o[0][r] * rl); ob[(size_t)orow * 512 + 32] = (bf16)f2bf(o[1][r] * rl); }
    __syncthreads();
}
}
struct Args { const float* in[30]; float* out; unsigned char* ws; int start; int stop; };
#define KAS __attribute__((address_space(4)))
__device__ __forceinline__ const KAS unsigned char* kbase() { const KAS unsigned char* p = (const KAS unsigned char*)__builtin_amdgcn_kernarg_segment_ptr(); asm volatile("" : "+s"(p)); return p; }
__device__ __forceinline__ const float* kin(int i) { return *(const float* const KAS*)(kbase() + 8 * i); }
__device__ __forceinline__ float* kout() { return *(float* const KAS*)(kbase() + 240); }
__device__ __forceinline__ unsigned char* kws() { return *(unsigned char* const KAS*)(kbase() + 248); }
__device__ __forceinline__ int kstart() { return *(const int KAS*)(kbase() + 256); }
__device__ __forceinline__ int kstop() { return *(const int KAS*)(kbase() + 260); }
struct Frame { LAS unsigned char* lds; int tid, lane, wave, G, gw, NGW; };
__device__ __forceinline__ Frame make_frame(LAS unsigned char* lds) {
    Frame F; int tid = my_tid(); asm volatile("" : "+v"(tid)); int bx = blockIdx.x; asm volatile("" : "+s"(bx)); int G = gridDim.x; asm volatile("" : "+s"(G));
    F.lds = lds; F.tid = tid; F.lane = tid & 63; F.wave = __builtin_amdgcn_readfirstlane(tid >> 6); F.G = G; F.gw = bx * NWAVES + F.wave; F.NGW = G * NWAVES; return F;
}

__device__ const double ROPE_INV_FREQ[32] = {1, 0.74989420933245587, 0.56234132519034907, 0.42169650342858223, 0.31622776601683794, 0.23713737056616552, 0.17782794100389229, 0.1333521432163324, 0.10000000000000001, 0.074989420933245579, 0.056234132519034911, 0.042169650342858224, 0.031622776601683791, 0.023713737056616554, 0.017782794100389229, 0.013335214321633241, 0.01, 0.0074989420933245579, 0.005623413251903491, 0.0042169650342858229, 0.0031622776601683794, 0.0023713737056616554, 0.0017782794100389228, 0.0013335214321633241, 0.001, 0.00074989420933245586, 0.0005623413251903491, 0.00042169650342858224, 0.00031622776601683794, 0.00023713737056616554, 0.00017782794100389227, 0.0001333521432163324};
__device__ __forceinline__ void sincos_d(double a, float& s, float& c) {
    const double n = rint(a * 0.63661977236758134308);
    double r = fma(-n, 1.5707963267948966192, a); r = fma(-n, 6.123233995736766036e-17, r);
    const double r2 = r * r;
    double sp = -7.6471637318198164759e-13; sp = fma(sp, r2, 1.6059043836821614599e-10); sp = fma(sp, r2, -2.5052108385441718775e-08); sp = fma(sp, r2, 2.7557319223985890653e-06);
    sp = fma(sp, r2, -1.9841269841269841270e-04); sp = fma(sp, r2, 8.3333333333333333333e-03); sp = fma(sp, r2, -1.6666666666666666667e-01);
    const double sn = fma(sp * r2, r, r);
    double cp = 4.7794773323873852974e-14; cp = fma(cp, r2, -1.1470745597729724714e-11); cp = fma(cp, r2, 2.0876756987868098979e-09); cp = fma(cp, r2, -2.7557319223985890653e-07);
    cp = fma(cp, r2, 2.4801587301587301587e-05); cp = fma(cp, r2, -1.3888888888888888889e-03); cp = fma(cp, r2, 4.1666666666666666667e-02); cp = fma(cp, r2, -0.5);
    const double cs = fma(cp, r2, 1.0);
    const long long q = (long long)n & 3LL; double so, co;
    if (q == 0) { so = sn; co = cs; } else if (q == 1) { so = cs; co = -sn; } else if (q == 2) { so = -sn; co = -cs; } else { so = -cs; co = sn; }
    s = (float)so; c = (float)co;
}
__device__ __forceinline__ void transpose_item(const float* W, int ldw, int col0, int nblk, bf16* WT, int ldt, int row0, LAS float* scr, int item, int lane) {
    const int kb = item / nblk, nb = item % nblk, k0 = 64 * kb, n0 = 32 * nb;
#pragma unroll 8
    for (int i = 0; i < 32; ++i) { const int kk = 2 * i + (lane >> 5); scr[kk * 33 + (lane & 31)] = W[(size_t)(k0 + kk) * ldw + col0 + n0 + (lane & 31)]; }
    LDS_WAIT(); asm volatile("" ::: "memory");
    const int c = lane & 7;
#pragma unroll
    for (int j = 0; j < 4; ++j) { const int n = (lane >> 3) + 8 * j; const LAS float* s = scr + (8 * c) * 33 + n;
        v4u o; o.x = pk2(s[0 * 33], s[1 * 33]); o.y = pk2(s[2 * 33], s[3 * 33]); o.z = pk2(s[4 * 33], s[5 * 33]); o.w = pk2(s[6 * 33], s[7 * 33]);
        *(GAS v4u*)(WT + (size_t)(row0 + n0 + n) * ldt + k0 + 8 * c) = o; }
    LDS_WAIT(); asm volatile("" ::: "memory");
}
__device__ __forceinline__ void rope_table(LAS unsigned char* lds_) {
    const Frame F = make_frame(lds_); const int gt = F.gw * 64 + F.lane, NTH = F.NGW * 64;
    const int* pos = (const int*)kin(2); float* rope = (float*)(kws() + WS_ROPE);
    for (int i = gt; i < T * 32; i += NTH) { float s, c; sincos_d((double)pos[i >> 5] * ROPE_INV_FREQ[i & 31], s, c); rope[2 * (size_t)i] = c; rope[2 * (size_t)i + 1] = s; }
}
__device__ __forceinline__ void p0_prologue(LAS unsigned char* lds_, const Args& A, int l) {
    const Frame F = make_frame(lds_);
    LAS float* scr = (LAS float*)(F.lds + RING_OFF + F.wave * 16384);
    constexpr int I1 = 16 * 14, I2 = 16 * 48, I3 = 16 * 56, I4 = 16 * 96, I5 = 8 * 32, I6 = 8 * 32, I7 = 16 * 32, I8 = 16 * 128, I9 = 64 * 32, I10 = 16 * 32, I11 = 4 * 32;
    constexpr int NITEMS = I1 + I2 + I3 + I4 + I5 + I6 + I7 + I8 + I9 + I10 + I11;
#define WIN_ (kin(4) + (size_t)l * 1024 * IN_COLS)
#define WBR_ (kin(21) + (size_t)l * 1536 * 1024)
    for (int it = F.gw; it < NITEMS; it += F.NGW) {
        int r = it;
        if (r < I1) { transpose_item(WIN_, IN_COLS, 0, 14, (bf16*)(kws() + W_IN), 1024, 0, scr, r, F.lane); continue; } r -= I1;
        if (r < I2) { transpose_item(WIN_, IN_COLS, 2240, 48, (bf16*)(kws() + W_IN), 1024, 512, scr, r, F.lane); continue; } r -= I2;
        if (r < I3) { transpose_item(WIN_, IN_COLS, 448, 56, (bf16*)(kws() + W_IN), 1024, 2048, scr, r, F.lane); continue; } r -= I3;
        if (r < I4) { transpose_item(WIN_, IN_COLS, 3776, 96, (bf16*)(kws() + W_IN), 1024, 3840, scr, r, F.lane); continue; } r -= I4;
        if (r < I5) { transpose_item(WBR_ + (size_t)512 * 1024, 1024, 0, 32, (bf16*)(kws() + W_B) + (size_t)1024 * 512, 512, 0, scr, r, F.lane); continue; } r -= I5;
        if (r < I6) { transpose_item(WBR_ + (size_t)1024 * 1024, 1024, 0, 32, (bf16*)(kws() + W_B) + (size_t)2 * 1024 * 512, 512, 0, scr, r, F.lane); continue; } r -= I6;
        if (r < I7) { transpose_item(kin(22) + (size_t)l * 1024 * 1024, 1024, 0, 32, (bf16*)(kws() + W_OUT), 1024, 0, scr, r, F.lane); continue; } r -= I7;
        if (r < I8) { transpose_item(kin(25) + (size_t)l * 1024 * 4096, 4096, 0, 128, (bf16*)(kws() + W_1), 1024, 0, scr, r, F.lane); continue; } r -= I8;
        if (r < I9) { transpose_item(kin(26) + (size_t)l * 4096 * 1024, 1024, 0, 32, (bf16*)(kws() + W_2), 4096, 0, scr, r, F.lane); continue; } r -= I9;
        if (r < I10) { transpose_item(kin(28) + (size_t)l * 1024 * 1024, 1024, 0, 32, (bf16*)(kws() + W_G), 1024, 0, scr, r, F.lane); continue; } r -= I10;
        transpose_item(kin(29) + (size_t)l * 256 * 1024, 1024, 0, 32, (bf16*)(kws() + W_P), 256, 0, scr, r, F.lane);
    }
    const int gt = F.gw * 64 + F.lane, NTH = F.NGW * 64;
    { bf16* WinT = (bf16*)(kws() + W_IN); for (int i = gt; i < 64 * 1024; i += NTH) WinT[(size_t)448 * 1024 + i] = 0; }
    { const float* w_uq = kin(7) + (size_t)l * 256 * 768; const float* w_ukv = kin(8) + (size_t)l * 128 * 1024; bf16* WqT = (bf16*)(kws() + W_Q);
      for (int i = gt; i < 768 * 256; i += NTH) {
        const int n = i >> 8, kq = i & 255, h = n / 192, ii = n % 192; float s;
        if (ii < 128) { s = 0.f; const float* a = w_uq + (size_t)kq * 768 + h * 192; const float* b = w_ukv + (size_t)ii * 1024 + h * 256;
            for (int nn = 0; nn < 128; ++nn) s = fmaf(a[nn], b[nn], s); }
        else { const int jj = ii - 128, j = jj >> 1; s = w_uq[(size_t)kq * 768 + h * 192 + 128 + ((jj & 1) ? j + 32 : j)]; }
        WqT[i] = (bf16)f2bf(s);
      } }
    { const float* w_ukv = kin(8) + (size_t)l * 128 * 1024; const float* w_br = WBR_; bf16* WbT = (bf16*)(kws() + W_B);
      for (int i = gt; i < 512 * 1024; i += NTH) {
        const int dd = i & 1023, hl = i >> 10, h = hl >> 7, lat = hl & 127; float s = 0.f;
        const float* a = w_ukv + (size_t)lat * 1024 + h * 256 + 128; const float* b = w_br + (size_t)(h * 128) * 1024 + dd;
        for (int v = 0; v < 128; ++v) s = fmaf(a[v], b[(size_t)v * 1024], s);
        WbT[(size_t)dd * 512 + hl] = (bf16)f2bf(s);
      } }
    { const float* w_up = kin(11) + (size_t)l * 64 * 512; const float* a_up = kin(13) + (size_t)l * 64 * 512; const float* g_up = kin(14) + (size_t)l * 128 * 512; bf16* WloT = (bf16*)(kws() + W_LORA);
      for (int i = gt; i < 1536 * 256; i += NTH) {
        const int n = i >> 8, k = i & 255, blk = n >> 9, nn = n & 511; float s = 0.f;
        if (blk == 0) { if (k < 64) s = w_up[(size_t)k * 512 + nn]; } else if (blk == 1) { if (k >= 64 && k < 128) s = a_up[(size_t)(k - 64) * 512 + nn]; } else { if (k >= 128) s = g_up[(size_t)(k - 128) * 512 + nn]; }
        WloT[i] = (bf16)f2bf(s);
      } }
#undef WIN_
#undef WBR_
}
__device__ __forceinline__ void u_rowpass(LAS unsigned char* lds_, int l, bool from_x) {
    const Frame F = make_frame(lds_); unsigned char* ws = kws();
    const float* g = kin(3) + l * 1024; bf16* U = (bf16*)(ws + WS_U); bf16* H16 = (bf16*)((unsigned char*)kout() + DO_H16);
    f32x4 gv[4];
#pragma unroll
    for (int j = 0; j < 4; ++j) gv[j] = *(const f32x4*)(g + 4 * F.lane + 256 * j);
    for (int m = F.gw; m < T; m += F.NGW) {
        f32x4 v[4]; float s = 0.f;
        if (from_x) { const f32x4* xr = (const f32x4*)(kin(0) + (size_t)m * D) + F.lane; v2u* ho = (v2u*)(H16 + (size_t)m * D) + F.lane;
#pragma unroll
            for (int j = 0; j < 4; ++j) { v[j] = xr[64 * j]; v2u w; w.x = pk2(v[j].x, v[j].y); w.y = pk2(v[j].z, v[j].w); ho[64 * j] = w; } }
        else { const v2u* hr = (const v2u*)(H16 + (size_t)m * D) + F.lane;
#pragma unroll
            for (int j = 0; j < 4; ++j) { const v2u w = hr[64 * j]; v[j] = (f32x4){bfl(w.x), bfh(w.x), bfl(w.y), bfh(w.y)}; } }
#pragma unroll
        for (int j = 0; j < 4; ++j) s += (v[j].x * v[j].x + v[j].y * v[j].y) + (v[j].z * v[j].z + v[j].w * v[j].w);
        const float rs = rsqrtf(wave_sum(s, F.lane) * (1.f / D) + NORM_EPS);
        v2u* o8 = (v2u*)(U + (size_t)m * D) + F.lane;
#pragma unroll
        for (int j = 0; j < 4; ++j) { const f32x4 y = v[j] * rs * gv[j]; v2u w; w.x = pk2(y.x, y.y); w.y = pk2(y.z, y.w); o8[64 * j] = w; }
    }
}
__device__ __forceinline__ void p2_mla_prep(LAS unsigned char* lds_, const Args& A, int l) {
    const Frame F = make_frame(lds_);
    const bf16* ZM = (const bf16*)(kws() + WS_OA); bf16* QN = (bf16*)(kws() + X_QN); bf16* KV = (bf16*)(kws() + X_KV); const float* rope = (const float*)(kws() + WS_ROPE);
    const f32x4 gq = *(const f32x4*)(kin(5) + l * 256 + 4 * F.lane); const float gk0 = kin(6)[l * 128 + 2 * F.lane], gk1 = kin(6)[l * 128 + 2 * F.lane + 1];
    for (int t = F.gw; t < T; t += F.NGW) {
        const bf16* z = ZM + (size_t)t * 512;
        const v2u wq = *(const v2u*)(z + 4 * F.lane); const unsigned wk = *(const unsigned*)(z + 256 + 2 * F.lane); const float kr = bfl((unsigned)z[384 + F.lane]);
        const float q0 = bfl(wq.x), q1 = bfh(wq.x), q2 = bfl(wq.y), q3 = bfh(wq.y), k0 = bfl(wk), k1 = bfh(wk);
        const float rq = rsqrtf(wave_sum(q0 * q0 + q1 * q1 + q2 * q2 + q3 * q3, F.lane) * (1.f / 256.f) + NORM_EPS);
        const float rk = rsqrtf(wave_sum(k0 * k0 + k1 * k1, F.lane) * (1.f / 128.f) + NORM_EPS);
        v2u o; o.x = pk2(q0 * rq * gq.x, q1 * rq * gq.y); o.y = pk2(q2 * rq * gq.z, q3 * rq * gq.w);
        *(v2u*)(QN + (size_t)t * 256 + 4 * F.lane) = o;
        *(unsigned*)(KV + (size_t)t * 192 + 2 * F.lane) = pk2(k0 * rk * gk0, k1 * rk * gk1);
        const float other = shfl_xor_f(kr, 32, F.lane);
        if (F.lane < 32) { const float c = rope[((size_t)t * 32 + F.lane) * 2], s = rope[((size_t)t * 32 + F.lane) * 2 + 1];
            *(unsigned*)(KV + (size_t)t * 192 + 128 + 2 * F.lane) = pk2(kr * c - other * s, other * c + kr * s); }
    }
}
__device__ __forceinline__ void p6_rw_prep(LAS unsigned char* lds_, const Args& A, int l) {
    const Frame F = make_frame(lds_);
    const bf16* ZR = (const bf16*)(kws() + X_ZR); bf16* LA = (bf16*)(kws() + X_LA);
    const f32x4 mu = *(const f32x4*)(kin(9) + l * RW_COLS + 1536 + 4 * F.lane);
    for (int t = F.gw; t < T; t += F.NGW) {
        const v2u wc = *(const v2u*)(ZR + (size_t)t * 1792 + 1536 + 4 * F.lane); v2u wp; wp.x = 0u; wp.y = 0u;
        if ((t & (SEQ - 1)) != 0) wp = *(const v2u*)(ZR + (size_t)(t - 1) * 1792 + 1536 + 4 * F.lane);
        float z[4] = {bfl(wc.x), bfh(wc.x), bfl(wc.y), bfh(wc.y)}; const float p[4] = {bfl(wp.x), bfh(wp.x), bfl(wp.y), bfh(wp.y)}; const float m[4] = {mu.x, mu.y, mu.z, mu.w};
#pragma unroll
        for (int e = 0; e < 4; ++e) { float v = z[e] + (p[e] - z[e]) * m[e]; if (F.lane < 16) v = 1.f - 2.f * __builtin_amdgcn_rcpf(1.f + __builtin_amdgcn_exp2f(2.f * LOG2E * v)); else if (F.lane >= 32) v = fsig(v); z[e] = v; }
        v2u o; o.x = pk2(z[0], z[1]); o.y = pk2(z[2], z[3]); *(v2u*)(LA + (size_t)t * 256 + 4 * F.lane) = o;
    }
}
template <int MODE>
__device__ __forceinline__ void rowpass(LAS unsigned char* lds_, const Args& A, const bf16* M, const float* g1, const float* g2, const float* pl) {
    const Frame F = make_frame(lds_);
    bf16* U = (bf16*)(kws() + WS_U); bf16* PB = (bf16*)(kws() + X_PB); bf16* H16 = (bf16*)((unsigned char*)kout() + DO_H16);
    f32x4 g1v[4], g2v[4];
#pragma unroll
    for (int j = 0; j < 4; ++j) { g1v[j] = *(const f32x4*)(g1 + 4 * F.lane + 256 * j); if (MODE == 0) g2v[j] = *(const f32x4*)(g2 + 4 * F.lane + 256 * j); }
    for (int m = F.gw; m < T; m += F.NGW) {
        const v2u* mr = (const v2u*)(M + (size_t)m * D) + F.lane; v2u* hr = (v2u*)(H16 + (size_t)m * D) + F.lane;
        f32x4 x[4], hv[4]; float s = 0.f;
#pragma unroll
        for (int j = 0; j < 4; ++j) { const v2u w = mr[64 * j]; x[j] = (f32x4){bfl(w.x), bfh(w.x), bfl(w.y), bfh(w.y)}; const v2u hw = hr[64 * j]; hv[j] = (f32x4){bfl(hw.x), bfh(hw.x), bfl(hw.y), bfh(hw.y)};
            s += (x[j].x * x[j].x + x[j].y * x[j].y) + (x[j].z * x[j].z + x[j].w * x[j].w); }
        const float rs = rsqrtf(wave_sum(s, F.lane) * (1.f / D) + NORM_EPS); float s2 = 0.f;
#pragma unroll
        for (int j = 0; j < 4; ++j) { hv[j] = hv[j] + x[j] * rs * g1v[j]; v2u w; w.x = pk2(hv[j].x, hv[j].y); w.y = pk2(hv[j].z, hv[j].w); hr[64 * j] = w;
            s2 += (hv[j].x * hv[j].x + hv[j].y * hv[j].y) + (hv[j].z * hv[j].z + hv[j].w * hv[j].w); }
        if (MODE == 0) { const float rs2 = rsqrtf(wave_sum(s2, F.lane) * (1.f / D) + NORM_EPS); v2u* o8 = (v2u*)(U + (size_t)m * D) + F.lane;
#pragma unroll
            for (int j = 0; j < 4; ++j) { const f32x4 y = hv[j] * rs2 * g2v[j]; v2u w; w.x = pk2(y.x, y.y); w.y = pk2(y.z, y.w); o8[64 * j] = w; } }
        else { v2u* o8 = (v2u*)(U + (size_t)m * D) + F.lane;
#pragma unroll
            for (int j = 0; j < 4; ++j) { v2u w; w.x = pk2(hv[j].x, hv[j].y); w.y = pk2(hv[j].z, hv[j].w); o8[64 * j] = w; }
            const f32x4 pv = *((const f32x4*)(pl + (size_t)m * DPLE) + F.lane); v2u w; w.x = pk2(pv.x, pv.y); w.y = pk2(pv.z, pv.w); *((v2u*)(PB + (size_t)m * DPLE) + F.lane) = w; }
    }
}
namespace rw {
typedef short v4i16_t __attribute__((ext_vector_type(4)));
constexpr int RS = 144;
constexpr int O_AT = 0, O_BT = 9216, O_KT = 18432, O_RT = 27648;
constexpr int O_UV = 36864;
constexpr int O_BK = O_UV + 4 * 32 * RS;
constexpr int O_SB = O_BK + 4 * 32 * RS;
constexpr int O_W1 = O_SB + 64 * RS;
constexpr int O_SM = O_W1 + 64 * RS;
constexpr int O_GC = O_SM + 16 * 1024;
constexpr int O_CB = O_GC + 1024;
constexpr int O_LM = O_CB + 256;
constexpr int O_YO = O_LM + 4096;
constexpr int O_PAR = O_YO + 64 * RS;
constexpr int LDS_END = O_PAR + 512;
static_assert(LDS_END <= RING_BYTES, "rwkv LDS map");
__device__ __forceinline__ bf16x8 trfrag(const LAS unsigned char* p) {
    const s16x4 lo = __builtin_bit_cast(s16x4, __builtin_amdgcn_ds_read_tr16_b64_v4i16((LAS v4i16_t*)p));
    const s16x4 hh = __builtin_bit_cast(s16x4, __builtin_amdgcn_ds_read_tr16_b64_v4i16((LAS v4i16_t*)(p + 4 * RS)));
    return (bf16x8){lo[0], lo[1], lo[2], lo[3], hh[0], hh[1], hh[2], hh[3]};
}
__device__ __forceinline__ void lbar() { asm volatile("s_waitcnt lgkmcnt(0)\n\ts_barrier" ::: "memory"); }
__device__ __forceinline__ void st_bf(LAS unsigned char* p, float x) { *(LAS unsigned short*)p = (unsigned short)h_f2h(__builtin_amdgcn_fmed3f(x, -60000.f, 60000.f)); }
__device__ __forceinline__ unsigned pk_rtz(float lo, float hi) { typedef __fp16 hp2 __attribute__((ext_vector_type(2))); const hp2 v = __builtin_amdgcn_cvt_pkrtz(lo, hi); return __builtin_bit_cast(unsigned, v); }
__device__ __forceinline__ void st2(LAS unsigned char* p0, LAS unsigned char* p1, float x0, float x1) { const unsigned w = pk_rtz(x0, x1); *(LAS unsigned short*)p0 = (unsigned short)w; *(LAS unsigned short*)p1 = (unsigned short)(w >> 16); }
__device__ __forceinline__ void st4(LAS unsigned char* p, int stride, const f32x4 v) { st2(p, p + stride, v[0], v[1]); st2(p + 2 * stride, p + 3 * stride, v[2], v[3]); }
__device__ __forceinline__ float ld_bf(const LAS unsigned char* p) { return bfl((unsigned)*(const LAS unsigned short*)p); }
template <int CTRL> __device__ __forceinline__ float dpp_add(float v) { return v + __int_as_float(__builtin_amdgcn_update_dpp(0, __float_as_int(v), CTRL, 0xf, 0xf, true)); }
__device__ __forceinline__ void wsum8(float (&v)[8], int lane) {
#pragma unroll
    for (int e = 0; e < 8; ++e) { float x = v[e]; x = dpp_add<0xB1>(x); x = dpp_add<0x4E>(x); x = dpp_add<0x141>(x); x = dpp_add<0x140>(x); v[e] = x; }
#pragma unroll
    for (int e = 0; e < 8; ++e) v[e] += shfl_xor_f(v[e], 16, lane);
#pragma unroll
    for (int e = 0; e < 8; ++e) v[e] += shfl_xor_f(v[e], 32, lane);
}
__device__ __forceinline__ void rw_unit(LAS unsigned char* lds, int l, int seq) {
    int tid_ = my_tid(); asm volatile("" : "+v"(tid_));
    const int tid = tid_, lane = tid & 63, w = __builtin_amdgcn_readfirstlane(tid >> 6), g4 = lane >> 4, l15 = lane & 15, q4 = l15 >> 2, p4 = lane & 3;
    const int b = seq >> 3, h = seq & 7;
    const bf16* ZRb = (const bf16*)(kws() + X_ZR) + (size_t)b * SEQ * 1792 + h * 64;
    const bf16* TWb = (const bf16*)(kws() + X_TW) + (size_t)b * SEQ * 512 + h * 64; const bf16* TAb = (const bf16*)(kws() + X_TA) + (size_t)b * SEQ * 512 + h * 64; const bf16* Gb = (const bf16*)((const unsigned char*)kout() + DO_G) + (size_t)b * SEQ * 512 + h * 64;
    bf16* ORWb = (bf16*)(kws() + WS_ORW) + (size_t)b * SEQ * 512 + h * 64;
    LAS float* par = (LAS float*)(lds + O_PAR);
    const int pc = h * 64 + lane;
    const float mu_r = kin(9)[l * RW_COLS + pc], mu_k = kin(9)[l * RW_COLS + 512 + pc], mu_v = kin(9)[l * RW_COLS + 1024 + pc];
    const float k_k = kin(15)[l * 512 + pc], k_a = kin(16)[l * 512 + pc], r_k = kin(17)[l * 512 + pc];
    if (tid < 64) { par[tid] = kin(18)[l * 512 + pc]; par[64 + tid] = kin(19)[l * 512 + pc]; }
    for (int i = tid; i < (O_GC - O_UV) / 4; i += 512) ((LAS unsigned*)(lds + O_UV))[i] = 0u;
    f32x4 Sacc[2] = {{0.f, 0.f, 0.f, 0.f}, {0.f, 0.f, 0.f, 0.f}};
    __syncthreads();
    const int et = tid >> 3, ecg = tid & 7, ei = et >> 4, ett = et & 15;
    const int trrow = 8 * g4 + q4, trrow1 = 8 * (g4 & 1) + q4, trcol = 8 * p4;
    const int ei2 = w >> 1, ehf = w & 1;
    unsigned ptw[16], pcr[8], pck[8], pcv[8], pta[8], ppr, ppk, ppv; v4u pgg;
#define RW_LOADS(TOK0) do { const size_t r0_ = (size_t)(TOK0) + 16 * ei2, rA_ = r0_ + 8 * ehf; \
        _Pragma("unroll") for (int s = 0; s < 16; ++s) ptw[s] = (unsigned)TWb[(r0_ + s) * 512 + lane]; \
        _Pragma("unroll") for (int tt = 0; tt < 8; ++tt) { const bf16* zc_ = ZRb + (rA_ + tt) * 1792 + lane; pcr[tt] = (unsigned)zc_[0]; pck[tt] = (unsigned)zc_[512]; pcv[tt] = (unsigned)zc_[1024]; pta[tt] = (unsigned)TAb[(rA_ + tt) * 512 + lane]; } \
        { const bf16* zp_ = ZRb + (rA_ > 0 ? rA_ - 1 : 0) * 1792 + lane; ppr = (unsigned)zp_[0]; ppk = (unsigned)zp_[512]; ppv = (unsigned)zp_[1024]; if (rA_ == 0) { ppr = 0u; ppk = 0u; ppv = 0u; } } \
        pgg = *(const v4u*)(Gb + (size_t)((TOK0) + et) * 512 + 8 * ecg); } while (0)
    RW_LOADS(0);
    for (int sc = 0; sc < SEQ / 64; ++sc) {
        const int tok0 = sc * 64;
        unsigned twv[16], ucr[8], uck[8], ucv[8], uta[8], upr, upk, upv; v4u ugg;
        {
#pragma unroll
            for (int s = 0; s < 16; ++s) twv[s] = ptw[s];
#pragma unroll
            for (int tt = 0; tt < 8; ++tt) { ucr[tt] = pcr[tt]; uck[tt] = pck[tt]; ucv[tt] = pcv[tt]; uta[tt] = pta[tt]; }
            upr = ppr; upk = ppk; upv = ppv; ugg = pgg;
        }
        {   const int c = lane;
            float cumLo[8], cumHi[8];
            {   asm volatile("" : "+v"(twv[0]), "+v"(twv[1]), "+v"(twv[2]), "+v"(twv[3]), "+v"(twv[4]), "+v"(twv[5]), "+v"(twv[6]), "+v"(twv[7]), "+v"(twv[8]), "+v"(twv[9]), "+v"(twv[10]), "+v"(twv[11]), "+v"(twv[12]), "+v"(twv[13]), "+v"(twv[14]), "+v"(twv[15]));
                float run = 0.f;
#pragma unroll
                for (int s = 0; s < 16; ++s) { run += bfl(twv[s]); if (s < 8) cumLo[s] = run; else cumHi[s - 8] = run; } }
            const float tot = cumHi[7];
            const float fh = ehf ? 1.f : 0.f;
            const float gctot = __builtin_amdgcn_exp2f(LOG2E * tot);
            if (ehf == 0) ((LAS float*)(lds + O_GC))[ei2 * 64 + c] = gctot;
            float pr = bfl(upr), pk = bfl(upk), pv = bfl(upv);
            float rr[8], kkv[8], av[8], kmv[8], vv[8], ss[8], cbv[8];
            {   float cr[8], ck[8], cv[8], ta[8];
                asm volatile("" : "+v"(ucr[0]), "+v"(ucr[1]), "+v"(ucr[2]), "+v"(ucr[3]), "+v"(ucr[4]), "+v"(ucr[5]), "+v"(ucr[6]), "+v"(ucr[7]), "+v"(uck[0]), "+v"(uck[1]), "+v"(uck[2]), "+v"(uck[3]), "+v"(uck[4]), "+v"(uck[5]), "+v"(uck[6]), "+v"(uck[7]),
                                  "+v"(ucv[0]), "+v"(ucv[1]), "+v"(ucv[2]), "+v"(ucv[3]), "+v"(ucv[4]), "+v"(ucv[5]), "+v"(ucv[6]), "+v"(ucv[7]));
                asm volatile("" : "+v"(uta[0]), "+v"(uta[1]), "+v"(uta[2]), "+v"(uta[3]), "+v"(uta[4]), "+v"(uta[5]), "+v"(uta[6]), "+v"(uta[7]));
#pragma unroll
                for (int tt = 0; tt < 8; ++tt) { cr[tt] = bfl(ucr[tt]); ck[tt] = bfl(uck[tt]); cv[tt] = bfl(ucv[tt]); ta[tt] = bfl(uta[tt]); }
#pragma unroll
                for (int tt = 0; tt < 8; ++tt) {
                    const float r = cr[tt] + (pr - cr[tt]) * mu_r, k = ck[tt] + (pk - ck[tt]) * mu_k, v = cv[tt] + (pv - cv[tt]) * mu_v; pr = cr[tt]; pk = ck[tt]; pv = cv[tt];
                    const float a = ta[tt], kk = k * k_k, km = k * (1.f + (a - 1.f) * k_a);
                    rr[tt] = r; kkv[tt] = kk; av[tt] = a; kmv[tt] = km; vv[tt] = v; ss[tt] = kk * kk; cbv[tt] = r * km * r_k; } }
            wsum8(ss, lane); wsum8(cbv, lane);
            float ggprev = 1.f;
#pragma unroll
            for (int tt = 0; tt < 8; ++tt) { const int t = 8 * ehf + tt;
                const float cu = cumLo[tt] + fh * (cumHi[tt] - cumLo[tt]); const float pl = tt ? cumLo[tt - 1] : 0.f, ph = tt ? cumHi[tt - 1] : cumLo[7]; const float cprev = pl + fh * (ph - pl);
                const float gg = __builtin_amdgcn_exp2f(LOG2E * cu), gp = (tt == 0) ? __builtin_amdgcn_exp2f(LOG2E * cprev) : ggprev, gi = __builtin_amdgcn_exp2f(-LOG2E * cu), gh = gctot * gi; ggprev = gg;
                const float kn = kkv[tt] * rsqrtf(fmaxf(ss[tt], 1e-24f)), ka = kn * av[tt];
                const int ro = (16 * ei2 + t) * RS + 2 * c;
                st2(lds + O_BT + ro, lds + O_KT + ro, __builtin_amdgcn_fmed3f(ka * gi, -60000.f, 60000.f), __builtin_amdgcn_fmed3f(kmv[tt] * gi, -60000.f, 60000.f));
                st2(lds + O_AT + ro, lds + O_RT + ro, -kn * gp, rr[tt] * gg);
                st2(lds + O_BK + (ei2 * 32 + t) * RS + 2 * c, lds + O_BK + (ei2 * 32 + 16 + t) * RS + 2 * c, ka * gh, kmv[tt] * gh);
                *(LAS unsigned short*)(lds + O_UV + (ei2 * 32 + 16 + t) * RS + 2 * c) = (unsigned short)h_f2h(vv[tt]);
                if (c == 0) ((LAS float*)(lds + O_CB))[16 * ei2 + t] = cbv[tt]; }
        }
        { const int nxt = (sc + 1 < SEQ / 64) ? tok0 + 64 : tok0; RW_LOADS(nxt); }
        lbar();
        {   const int i = w & 3, hf = w >> 2;
            const LAS unsigned char* xa = lds + (hf ? O_RT : O_AT) + (16 * i + l15) * RS + 16 * g4;
            const LAS unsigned char* xb = lds + O_BT + (16 * i + l15) * RS + 16 * g4; const LAS unsigned char* xk = lds + O_KT + (16 * i + l15) * RS + 16 * g4;
            f32x4 c1 = {0.f, 0.f, 0.f, 0.f}, c2 = {0.f, 0.f, 0.f, 0.f};
#pragma unroll
            for (int ks = 0; ks < 2; ++ks) { const bf16x8 a = *(const LAS bf16x8*)(xa + 64 * ks);
                c1 = MFMA16(a, *(const LAS bf16x8*)(xb + 64 * ks), c1);
                c2 = MFMA16(a, *(const LAS bf16x8*)(xk + 64 * ks), c2); }
#pragma unroll
            for (int r = 0; r < 4; ++r) { const int t = 4 * g4 + r; const bool keep = hf ? (l15 <= t) : (l15 < t); const float v1 = keep ? c1[r] : 0.f, v2 = keep ? c2[r] : 0.f;
                if (hf == 0) { ((LAS float*)(lds + O_LM))[(i * 16 + t) * 16 + l15] = v1; *(LAS unsigned short*)(lds + O_SM + (4 + i) * 1024 + t * 64 + 2 * l15) = (unsigned short)h_f2h(v2); }
                else st2(lds + O_SM + (8 + i) * 1024 + t * 64 + 2 * l15, lds + O_SM + (12 + i) * 1024 + t * 64 + 2 * l15, v1, v2); }
        }
        lbar();
        if (w < 4) { if (lane < 16) { const LAS float* Lm = (const LAS float*)(lds + O_LM) + w * 256; float acc[16];
#pragma unroll
                for (int t = 0; t < 16; ++t) acc[t] = (t == lane) ? 1.f : 0.f;
#pragma unroll
                for (int s = 0; s < 15; ++s) { const float xs = acc[s];
#pragma unroll
                    for (int t = s + 1; t < 16; ++t) acc[t] = fmaf(Lm[t * 16 + s], xs, acc[t]); }
#pragma unroll
                for (int t = 0; t < 16; t += 2) st2(lds + O_SM + w * 1024 + t * 64 + 2 * lane, lds + O_SM + w * 1024 + (t + 1) * 64 + 2 * lane, acc[t], acc[t + 1]); } }
        else { const int i = w - 4; const bf16x8 am = *(const LAS bf16x8*)(lds + O_SM + (4 + i) * 1024 + l15 * 64 + 16 * g4);
#pragma unroll
            for (int ct = 0; ct < 4; ++ct) { f32x4 acc = {0.f, 0.f, 0.f, 0.f};
                acc = MFMA16(am, trfrag(lds + O_UV + (i * 32 + 16 + trrow1) * RS + 32 * ct + trcol), acc);
st4(lds + O_W1 + (16 * i + 4 * g4) * RS + 2 * (16 * ct + l15), RS, acc); } }
        lbar();
        f32x4 wy[4];
        {   const int ct = w & 3; const int base = (w < 4) ? O_W1 : O_AT;
#pragma unroll
            for (int i = 0; i < 4; ++i) { const bf16x8 tm = *(const LAS bf16x8*)(lds + O_SM + i * 1024 + l15 * 64 + 16 * g4); f32x4 acc = {0.f, 0.f, 0.f, 0.f};
                acc = MFMA16(tm, trfrag(lds + base + (16 * i + trrow1) * RS + 32 * ct + trcol), acc);
                if (w < 4) wy[i] = acc;
                st4(lds + base + (16 * i + 4 * g4) * RS + 2 * (16 * ct + l15), RS, acc); } }
        lbar();
        {   const int ct = w & 3;
#pragma unroll
            for (int i = 0; i < 4; ++i) { const bf16x8 arb = *(const LAS bf16x8*)(lds + O_SM + (8 + i) * 1024 + l15 * 64 + 16 * g4);
                if (w >= 4) { const bf16x8 ark = *(const LAS bf16x8*)(lds + O_SM + (12 + i) * 1024 + l15 * 64 + 16 * g4); f32x4 acc = {0.f, 0.f, 0.f, 0.f};
                    acc = MFMA16(arb, trfrag(lds + O_W1 + (16 * i + trrow1) * RS + 32 * ct + trcol), acc);
                    acc = MFMA16(ark, trfrag(lds + O_UV + (i * 32 + 16 + trrow1) * RS + 32 * ct + trcol), acc);
                    wy[i] = acc; }
                else { f32x4 acc;
#pragma unroll
                    for (int r = 0; r < 4; ++r) acc[r] = ld_bf(lds + O_RT + (16 * i + 4 * g4 + r) * RS + 2 * (16 * ct + l15));
                    acc = MFMA16(arb, trfrag(lds + O_AT + (16 * i + trrow1) * RS + 32 * ct + trcol), acc);
st4(lds + O_RT + (16 * i + 4 * g4) * RS + 2 * (16 * ct + l15), RS, acc); } } }
        lbar();
#pragma unroll
        for (int i = 0; i < 4; ++i) {
            {
                const int v0 = 16 * (w & 3); f32x4 acc = wy[i];
                const LAS unsigned char* xa = lds + ((w < 4) ? O_AT : O_RT) + (16 * i + l15) * RS + 16 * g4; const LAS unsigned char* sb = lds + O_SB + (v0 + l15) * RS + 16 * g4;
#pragma unroll
                for (int ks = 0; ks < 2; ++ks) acc = MFMA16(*(const LAS bf16x8*)(xa + 64 * ks), *(const LAS bf16x8*)(sb + 64 * ks), acc);
                LAS unsigned char* dst = (w < 4) ? (lds + O_UV + (i * 32 + 4 * g4) * RS + 2 * (v0 + l15)) : (lds + O_YO + (16 * i + 4 * g4) * RS + 2 * (v0 + l15));
st4(dst, RS, acc);
            }
            lbar();
            {
#pragma unroll
                for (int j = 0; j < 2; ++j) { const int id = 2 * w + j, vt = id >> 2, kt = id & 3;
                    const float gc = ((const LAS float*)(lds + O_GC))[i * 64 + 16 * kt + l15];
                    f32x4 acc = Sacc[j] * gc;
                    acc = MFMA16(trfrag(lds + O_UV + (i * 32 + trrow) * RS + 32 * vt + trcol), trfrag(lds + O_BK + (i * 32 + trrow) * RS + 32 * kt + trcol), acc);
                    Sacc[j] = acc;
st4(lds + O_SB + (16 * vt + 4 * g4) * RS + 2 * (16 * kt + l15), RS, acc); }
            }
            lbar();
        }
        {   float y[8], vv[8], gg[8];
            pg8::unpack8(*(const LAS v4u*)(lds + O_YO + et * RS + 16 * ecg), y); pg8::unpack8(*(const LAS v4u*)(lds + O_UV + (ei * 32 + 16 + ett) * RS + 16 * ecg), vv);
            pg8::unpack8(ugg, gg);
            float s = 0.f;
#pragma unroll
            for (int e = 0; e < 8; ++e) s += y[e];
            s = dpp_add<0xB1>(s); s = dpp_add<0x4E>(s); s = dpp_add<0x141>(s);
            const float mean = s * (1.f / 64.f); float q = 0.f;
#pragma unroll
            for (int e = 0; e < 8; ++e) { y[e] -= mean; q += y[e] * y[e]; }
            q = dpp_add<0xB1>(q); q = dpp_add<0x4E>(q); q = dpp_add<0x141>(q);
            const float rstd = rsqrtf(q * (1.f / 64.f) + RW_LN_EPS), cb = ((const LAS float*)(lds + O_CB))[et];
            float o[8];
#pragma unroll
            for (int e = 0; e < 8; ++e) { const int c = 8 * ecg + e; o[e] = (y[e] * rstd * par[c] + par[64 + c] + cb * vv[e]) * gg[e]; }
            v4u wo; wo.x = pk2(o[0], o[1]); wo.y = pk2(o[2], o[3]); wo.z = pk2(o[4], o[5]); wo.w = pk2(o[6], o[7]);
            *(v4u*)(ORWb + (size_t)(tok0 + et) * 512 + 8 * ecg) = wo;
        }
        lbar();
    }
}
}
#ifndef PROBE_QREP
#define PROBE_QREP 1
#endif
#ifndef PROBE_MASK
#define PROBE_MASK 0
#endif
__global__ void __launch_bounds__(NWAVES * 64, 2) mk_fwd(Args args) {
    extern __shared__ __attribute__((aligned(16))) unsigned char lds[];
    LAS unsigned char* const L = (LAS unsigned char*)lds;
    for (int u = threadIdx.x; u < (LDS_BYTES - LDSCTL_OFF) / 4; u += NWAVES * 64) ((LAS unsigned*)(L + LDSCTL_OFF))[u] = 0u;
    __syncthreads();
    static_assert(LDSCTL_OFF == MK_WAVETAB_LDS, "wave table address");
    if ((threadIdx.x & 63) == 0) ((LAS unsigned*)(L + LDSCTL_OFF))[(unsigned)__builtin_amdgcn_s_getreg((5 << 11) | 4) & 63u] = threadIdx.x >> 6;
    __syncthreads();
    XcdBarrier bar = xcd_barrier_post((unsigned*)(kws() + WS_CTL) + CW_BAR, (volatile LAS unsigned*)(L + MISC_OFF) + 8);
#define GRID_BAR() xcd_barrier(bar)
#if defined(DBG_BISECT)
#define IN(k) (l > 0 || ((k) >= kstart() && (k) <= kstop()) || ((k) == 9 && kstop() == 99))
#define LAYER_END() do { if (kstop() < 100) return; } while (0)
#else
#define IN(k) true
#define LAYER_END() do { } while (0)
#endif
#define PTRS() unsigned char* ws = opq(kws()); \
    bf16* U = (bf16*)(ws + WS_U); bf16* OA = (bf16*)(ws + WS_OA); bf16* OC = (bf16*)(ws + WS_OC); bf16* ORW = (bf16*)(ws + WS_ORW); \
    bf16* WinT = (bf16*)(ws + W_IN); bf16* WqT = (bf16*)(ws + W_Q); bf16* WloT = (bf16*)(ws + W_LORA); bf16* WbT = (bf16*)(ws + W_B); bf16* WoT = (bf16*)(ws + W_OUT); \
    bf16* W1T = (bf16*)(ws + W_1); bf16* W2T = (bf16*)(ws + W_2); bf16* WgT = (bf16*)(ws + W_G); bf16* WpT = (bf16*)(ws + W_P); \
    bf16* ZC = (bf16*)(ws + X_ZC); bf16* QN = (bf16*)(ws + X_QN); bf16* QP = (bf16*)(ws + X_QP); bf16* KV = (bf16*)(ws + X_KV); \
    bf16* ZR = (bf16*)(ws + X_ZR); bf16* LA = (bf16*)(ws + X_LA); bf16* TW = (bf16*)(ws + X_TW); bf16* TA = (bf16*)(ws + X_TA); bf16* GG = (bf16*)((unsigned char*)kout() + DO_G); bf16* H16 = (bf16*)((unsigned char*)kout() + DO_H16); \
    bf16* GT = (bf16*)(ws + X_GT); bf16* MG = (bf16*)(ws + X_MG); bf16* HID = (bf16*)(ws + X_HID); bf16* PB = (bf16*)(ws + X_PB); bf16* PP = (bf16*)(ws + X_PP); bf16* M2 = OA; \
    (void)U; (void)OA; (void)OC; (void)ORW; (void)WinT; (void)WqT; (void)WloT; (void)WbT; (void)WoT; (void)W1T; (void)W2T; (void)WgT; (void)WpT; (void)ZC; (void)QN; (void)QP; (void)KV; (void)ZR; (void)LA; (void)TW; (void)TA; (void)GG; (void)H16; (void)GT; (void)MG; (void)HID; (void)PB; (void)PP; (void)M2;
    typedef pg8::StaticOrder SO;
#define GEMM(EPI, Aptr, Bptr, N_, K_, Eobj) do { int bx_ = blockIdx.x; asm volatile("" : "+s"(bx_)); int G_ = gridDim.x; asm volatile("" : "+s"(G_)); pg8::Gemm g_{Aptr, Bptr, T, N_, K_}; SO S_; S_.init(T, N_, G_, bx_); pg8::gemm_phase<EPI, SO, true, true>(L + RING_OFF, g_, S_, Eobj); } while (0)
#define PH(n) for (int rep_ = 0; rep_ < (((PROBE_MASK >> (n)) & 1) ? 2 : 1); ++rep_) if (IN(n))
    typedef pg8::EpiRoute<0> ER0;
    rope_table(L);
    for (int l = 0; l < DEPTH; ++l) {
        PH(0) { p0_prologue(L, args, l); u_rowpass(L, l, l == 0); GRID_BAR(); }
        PH(1) { PTRS(); ER0 E{OA, 512, 2, ZC, 1536, 6, 2, CA_QSCALE, ZR, 1792}; GEMM(ER0, U, WinT, 3840, 1024, E); GRID_BAR(); }
        PH(2) { p2_mla_prep(L, args, l); p6_rw_prep(L, args, l); GRID_BAR(); }
        PH(3) { PTRS(); pg8::EpiQRope E{QP, (const float*)(ws + WS_ROPE), MLA_QSCALE}; GEMM(pg8::EpiQRope, QN, WqT, 768, 256, E);
                pg8::EpiSig E2{TW, kin(10) + l * 512, -0.6065306597126334f, 512}; GEMM(pg8::EpiSig, LA, WloT, 512, 256, E2);
                pg8::EpiSig E3{TA, kin(12) + l * 512, 1.f, 512}; GEMM(pg8::EpiSig, LA, WloT + (size_t)512 * 256, 512, 256, E3);
                ER0 E4{GG, 512, 2, GG, 512, 0, 0, 1.f, GG, 512}; GEMM(ER0, LA, WloT + (size_t)1024 * 256, 512, 256, E4); GRID_BAR(); }
        PH(4) { PTRS();
            if (blockIdx.x < 64) rw::rw_unit(L + RING_OFF, l, (int)blockIdx.x);
            volatile LAS unsigned* qs = (volatile LAS unsigned*)(L + MISC_OFF) + 12;
            for (int qrep_ = 0; qrep_ < PROBE_QREP; ++qrep_) { unsigned* qhead = (unsigned*)(ws + WS_CTL) + CW_QUEUE + 64 * l + 16 * rep_ + 32 * qrep_;
            for (;;) {
                __syncthreads();
                if (my_tid() == 0) *qs = atomicAdd(qhead, 1u);
                __syncthreads();
                const unsigned u = *qs;
                if (u >= 1280u) break;
                if (u < 256u) { const int b = (int)u >> 5, cc = (int)u & 31; att::mla_unit(L + RING_OFF, QP, KV, OA, b, 63 - cc); att::mla_unit(L + RING_OFF, QP, KV, OA, b, cc); }
                else { const int bi = (int)u - 256; att::band_unit(L + RING_OFF, ZC, kin(20) + (size_t)l * 320 * 8, OC, bi >> 7, (bi >> 4) & 7, bi & 15); }
            }
            }
            GRID_BAR(); }
        PH(9) { PTRS(); ER0 E{GT, 3072, 12, GT, 3072, 0, 0, 1.f, GT, 3072}; GEMM(ER0, U, WinT + (size_t)3840 * 1024, 3072, 1024, E); GRID_BAR(); }
        PH(10) { PTRS(); int bx_ = blockIdx.x; asm volatile("" : "+s"(bx_)); int G_ = gridDim.x; asm volatile("" : "+s"(G_));
                 pg8::Gemm g_{OA, WbT, 3 * T, 3072, 512}; pg8::MergeOrder S_{G_, bx_}; pg8::EpiMergeAll E{MG, GT};
                 pg8::gemm_phase<pg8::EpiMergeAll, pg8::MergeOrder, true, true>(L + RING_OFF, g_, S_, E); GRID_BAR(); }
        PH(11) { PTRS(); ER0 E{M2, 1024, 4, M2, 1024, 0, 0, 1.f, M2, 1024}; GEMM(ER0, MG, WoT, 1024, 1024, E); GRID_BAR(); }
        if (IN(12)) { PTRS(); rowpass<0>(L, args, M2, kin(23) + l * 1024, kin(24) + l * 1024, nullptr); GRID_BAR(); }
        PH(13) { PTRS(); pg8::EpiRoute<2> E{HID, 4096, 16, HID, 4096, 0, 0, 1.f, HID, 4096}; GEMM(pg8::EpiRoute<2>, U, W1T, 4096, 1024, E); GRID_BAR(); }
        PH(14) { PTRS(); ER0 E{M2, 1024, 4, M2, 1024, 0, 0, 1.f, M2, 1024}; GEMM(ER0, HID, W2T, 1024, 4096, E); GRID_BAR(); }
        if (IN(15)) { PTRS(); rowpass<1>(L, args, M2, kin(27) + l * 1024, nullptr, kin(1) + (size_t)l * T * DPLE); GRID_BAR(); }
        if (IN(17)) { PTRS(); ER0 E{PP, 1024, 4, PP, 1024, 0, 0, 1.f, PP, 1024}; GEMM(ER0, PB, WpT, 1024, 256, E);
                      pg8::EpiPle E2{H16, PP, kout(), (float*)(ws + X_STG), (l + 1 == DEPTH) ? 1 : 0}; GEMM(pg8::EpiPle, U, WgT, 1024, 1024, E2); }
        LAYER_END();
        if (l + 1 < DEPTH) GRID_BAR();
    }
    GRID_BAR();
    {   const Frame F = make_frame(L); const f32x4* src = (const f32x4*)(kws() + X_STG); f32x4* dst = (f32x4*)((unsigned char*)kout() + 64 * MiB);
        const size_t n = (size_t)16384 * 1024 / 4, gt = (size_t)F.gw * 64 + F.lane, NTH = (size_t)F.NGW * 64;
        for (size_t i = gt; i < n; i += NTH) dst[i] = src[i]; }
}

#if !defined(DBG_BISECT)
extern "C" void kernel_launch(void* const* d_in, const int* in_sizes, int n_in, void* d_out, int out_size, void* d_ws, size_t ws_size, hipStream_t stream) {
    static int grid = 0;
    if (grid == 0) {
        if (n_in != 30 || out_size != T * D || ws_size < (size_t)WS_END) { fprintf(stderr, "kernel_launch: unexpected shapes (n_in %d out %d ws %zu, need ws >= %zu)\n", n_in, out_size, ws_size, (size_t)WS_END); grid = -1; return; }
        int dev = 0, cus = 0, per_cu = 0;
        if (hipGetDevice(&dev) != hipSuccess || hipDeviceGetAttribute(&cus, hipDeviceAttributeMultiprocessorCount, dev) != hipSuccess) { grid = -1; return; }
        if (hipFuncSetAttribute((const void*)mk_fwd, hipFuncAttributeMaxDynamicSharedMemorySize, LDS_BYTES) != hipSuccess) { fprintf(stderr, "kernel_launch: hipFuncSetAttribute failed\n"); grid = -1; return; }
        if (hipOccupancyMaxActiveBlocksPerMultiprocessor(&per_cu, (const void*)mk_fwd, NWAVES * 64, LDS_BYTES) != hipSuccess || per_cu < 1) { fprintf(stderr, "kernel_launch: occupancy query says %d\n", per_cu); }
        (void)hipGetLastError();
        grid = cus;
    }
    if (grid < 0) return;
    if (hipMemsetAsync((char*)d_ws + WS_CTL, 0, CTL_ZERO_BYTES, stream) != hipSuccess) return;
    Args a{};
    for (int i = 0; i < 30; ++i) a.in[i] = (const float*)d_in[i];
    a.out = (float*)d_out; a.ws = (unsigned char*)d_ws; a.start = 0; a.stop = 1000;
    hipLaunchKernelGGL(mk_fwd, dim3(grid), dim3(NWAVES * 64), LDS_BYTES, stream, a);
}
#endif
```

```cpp
#include <hip/hip_runtime.h>
#include <cstdio>
#include <cstdint>
#include <cmath>
typedef _Float16 h16x8_t __attribute__((ext_vector_type(8)));
typedef _Float16 h16x2_t __attribute__((ext_vector_type(2)));
typedef short s16x8_t __attribute__((ext_vector_type(8)));
typedef float f32x4_t_ __attribute__((ext_vector_type(4)));
typedef float f32x16_t_ __attribute__((ext_vector_type(16)));
__device__ __forceinline__ unsigned h_pk2(float lo, float hi) { const h16x2_t v = {(_Float16)lo, (_Float16)hi}; return __builtin_bit_cast(unsigned, v); }
__device__ __forceinline__ unsigned h_f2h(float f) { return (unsigned)__builtin_bit_cast(unsigned short, (_Float16)f); }
__device__ __forceinline__ float h_lo(unsigned w) { return (float)__builtin_bit_cast(_Float16, (unsigned short)(w & 0xffffu)); }
__device__ __forceinline__ float h_hi(unsigned w) { return (float)__builtin_bit_cast(_Float16, (unsigned short)(w >> 16)); }
__device__ __forceinline__ f32x4_t_ MFMA16(s16x8_t a, s16x8_t b, f32x4_t_ c) { return __builtin_amdgcn_mfma_f32_16x16x32_f16(__builtin_bit_cast(h16x8_t, a), __builtin_bit_cast(h16x8_t, b), c, 0, 0, 0); }
__device__ __forceinline__ f32x16_t_ MFMA32(s16x8_t a, s16x8_t b, f32x16_t_ c) { return __builtin_amdgcn_mfma_f32_32x32x16_f16(__builtin_bit_cast(h16x8_t, a), __builtin_bit_cast(h16x8_t, b), c, 0, 0, 0); }
#define MK_WAVETAB_LDS 131072
__device__ __forceinline__ int my_tid() {
    const unsigned hw = (unsigned)__builtin_amdgcn_s_getreg((5 << 11) | 4) & 63u;
    const unsigned wv = (unsigned)__builtin_amdgcn_readfirstlane((int)((volatile __attribute__((address_space(3))) unsigned*)MK_WAVETAB_LDS)[hw]);
    unsigned lane; asm volatile("v_mbcnt_lo_u32_b32 %0, -1, 0\n\tv_mbcnt_hi_u32_b32 %0, -1, %0" : "=v"(lane));
    return (int)(wv * 64u + lane);
}
namespace pg8 {
#define PG8_LAS __attribute__((address_space(3)))
typedef unsigned short bf16_t;
typedef short bf16x8 __attribute__((ext_vector_type(8)));
typedef float f32x4 __attribute__((ext_vector_type(4)));
typedef unsigned u32x4 __attribute__((ext_vector_type(4)));
constexpr int BM = 256, BK = 64, HALF = 128, HTB = HALF * BK * 2  , STAGE_BYTES = 8 * HTB, NXCD = 8, WGM = 8;

__host__ __device__ __forceinline__ int lds_byte(int r, int c) { const int st = (r >> 4) * 2 + (c >> 5), rr = r & 15, cc = c & 31, ob = rr * 64 + cc * 2; return st * 1024 + (ob ^ (((ob >> 9) & 1) << 5)); }
__host__ __device__ __forceinline__ void stage_rc(int b, int& R, int& C) { const int st = b / 1024, sb = b % 1024, swz = sb ^ (((sb >> 9) & 1) << 5); R = (st >> 1) * 16 + swz / 64; C = (st & 1) * 32 + (swz % 64) / 2; }
__host__ __device__ __forceinline__ int perm32(int rho) { const int n = rho >> 4, i = rho & 15; return 8 * (i >> 2) + 4 * n + (i & 3); }

struct Unit { int pm, pn; };
struct Gemm { const bf16_t* A; const bf16_t* Bt; int M, N, K; };

struct StaticOrder {
    int nM, nN, nwg, G, c;
    __host__ __device__ void init(int M, int N, int G_, int c_) { nM = M / BM; nN = N / BM; nwg = nM * nN; G = G_; c = c_; }
    __host__ __device__ bool next(int i, Unit& u) const {
        const long L = (long)i * G + c; if (L >= nwg) return false;
        int wgid = (int)L; { const int q = nwg / NXCD, r = nwg % NXCD, xcd = wgid % NXCD, off = wgid / NXCD; wgid = (xcd < r ? xcd * (q + 1) : r * (q + 1) + (xcd - r) * q) + off; }
        const int nig = WGM * nN, gid = wgid / nig, fm = gid * WGM, gsz = (nM - fm) < WGM ? (nM - fm) : WGM;
        u.pm = fm + ((wgid % nig) % gsz); u.pn = (wgid % nig) / gsz; return true;
    }
    __device__ __forceinline__ void a_ready(const Unit&) const {}
    __device__ __forceinline__ void done(const Unit&) const {}
};

__device__ __forceinline__ unsigned cvt_pk_bf16(float lo, float hi) { typedef __fp16 hp2 __attribute__((ext_vector_type(2))); const hp2 v = __builtin_amdgcn_cvt_pkrtz(lo, hi); return __builtin_bit_cast(unsigned, v); }
typedef float f32x2 __attribute__((ext_vector_type(2)));
__device__ __forceinline__ f32x2 gelu_pk(f32x2 v) {
    const f32x2 av = __builtin_elementwise_abs(v), d = av * 0.2316418882f + 1.0f;
    f32x2 t; t.x = __builtin_amdgcn_rcpf(d.x); t.y = __builtin_amdgcn_rcpf(d.y);
    f32x2 q = t * 0.5307027145f + (-0.7265760135f); q = q * t + 0.7107068705f; q = q * t + (-0.142248368f); q = q * t + 0.127414796f; q = q * t;
    const f32x2 s = (v * v) * (-0.72134752044f);
    f32x2 e; e.x = __builtin_amdgcn_exp2f(s.x); e.y = __builtin_amdgcn_exp2f(s.y);
    const f32x2 m = v * (q * e), r = v - m;
    f32x2 o; o.x = v.x < 0.f ? m.x : r.x; o.y = v.y < 0.f ? m.y : r.y; return o;
}

template <int ACT  > struct EpiBf16 {
    static constexpr bool PERM = true, AFTER_DRAIN = false; static_assert(ACT == 0 || ACT == 1, "EpiBf16: ACT is 0 (none) or 1 (gelu_pk)");
    bf16_t* O; int ldc; const float* bias; int split_cols; size_t split_stride; float scale0;
    __device__ __forceinline__ void operator()(const f32x4 (&acc)[2][2][4][2], const Unit& u, int wr, int wc, int fr, int fq) const {
        const int row0 = u.pm * BM + wr * 64 + fr; int colt = u.pn * BM; bf16_t* base = O;
        float sc = 1.f; if (split_cols) { const int t = colt / split_cols; base += (size_t)t * split_stride; colt -= t * split_cols; if (t == 0) sc = scale0; }
        const int col0 = colt + wc * 32 + 8 * fq, bcol0 = u.pn * BM + wc * 32 + 8 * fq;
        f32x4 bv[2][2];
#pragma unroll
        for (int bj = 0; bj < 2; ++bj)
#pragma unroll
            for (int n = 0; n < 2; ++n) bv[bj][n] = bias ? *(const f32x4*)(bias + bcol0 + bj * HALF + 4 * n) : (f32x4){0.f, 0.f, 0.f, 0.f};
#pragma unroll
        for (int ai = 0; ai < 2; ++ai)
#pragma unroll
            for (int m = 0; m < 4; ++m) { bf16_t* rowp = base + (size_t)(row0 + ai * HALF + m * 16) * ldc + col0;
#pragma unroll
                for (int bj = 0; bj < 2; ++bj) { f32x4 v0 = acc[ai][bj][m][0] + bv[bj][0], v1 = acc[ai][bj][m][1] + bv[bj][1];
                    if (ACT == 1) { f32x2 a = gelu_pk((f32x2){v0[0], v0[1]}), b = gelu_pk((f32x2){v0[2], v0[3]}), c = gelu_pk((f32x2){v1[0], v1[1]}), d = gelu_pk((f32x2){v1[2], v1[3]});
                        v0 = (f32x4){a.x, a.y, b.x, b.y}; v1 = (f32x4){c.x, c.y, d.x, d.y}; }
                    v0 = v0 * sc; v1 = v1 * sc; u32x4 w; w.x = cvt_pk_bf16(v0[0], v0[1]); w.y = cvt_pk_bf16(v0[2], v0[3]); w.z = cvt_pk_bf16(v1[0], v1[1]); w.w = cvt_pk_bf16(v1[2], v1[3]);
                    *(u32x4*)(rowp + bj * HALF) = w; } }
    }
};
__device__ __forceinline__ float bf2f(unsigned short b) { return h_lo((unsigned)b); }
__device__ __forceinline__ float sigm(float x) { return __builtin_amdgcn_rcpf(1.0f + __builtin_amdgcn_exp2f(-1.4426950408889634f * x)); }
__device__ __forceinline__ void unpack8(const u32x4 w, float (&f)[8]) {
    f[0] = h_lo(w.x); f[1] = h_hi(w.x); f[2] = h_lo(w.y); f[3] = h_hi(w.y); f[4] = h_lo(w.z); f[5] = h_hi(w.z); f[6] = h_lo(w.w); f[7] = h_hi(w.w);
}
template <int ACT> struct EpiRoute {
    static constexpr bool PERM = true, AFTER_DRAIN = false;
    bf16_t* O0; int ld0; int nt0;
    bf16_t* O1; int ld1; int nt1; int nts1; float sc1;
    bf16_t* O2; int ld2;
    __device__ __forceinline__ void operator()(const f32x4 (&acc)[2][2][4][2], const Unit& u, int wr, int wc, int fr, int fq) const {
        const int row0 = u.pm * BM + wr * 64 + fr;
        bf16_t* base; int ld, colt; float sc = 1.f;
        if (u.pn < nt0) { base = O0; ld = ld0; colt = u.pn * BM; }
        else if (u.pn < nt0 + nt1) { base = O1; ld = ld1; colt = (u.pn - nt0) * BM; if (u.pn - nt0 < nts1) sc = sc1; }
        else { base = O2; ld = ld2; colt = (u.pn - nt0 - nt1) * BM; }
        const int col0 = colt + wc * 32 + 8 * fq;
#pragma unroll
        for (int ai = 0; ai < 2; ++ai)
#pragma unroll
            for (int m = 0; m < 4; ++m) { bf16_t* rowp = base + (size_t)(row0 + ai * HALF + m * 16) * ld + col0;
#pragma unroll
                for (int bj = 0; bj < 2; ++bj) { f32x4 v0 = acc[ai][bj][m][0], v1 = acc[ai][bj][m][1];
                    if (ACT == 2) { for (int e = 0; e < 4; ++e) { const float a = fmaxf(v0[e], 0.f), b = fmaxf(v1[e], 0.f); v0[e] = a * a; v1[e] = b * b; } }
                    v0 = v0 * sc; v1 = v1 * sc; u32x4 w; w.x = cvt_pk_bf16(v0[0], v0[1]); w.y = cvt_pk_bf16(v0[2], v0[3]); w.z = cvt_pk_bf16(v1[0], v1[1]); w.w = cvt_pk_bf16(v1[2], v1[3]);
                    *(u32x4*)(rowp + bj * HALF) = w; } }
    }
};
struct EpiSig {
    static constexpr bool PERM = true, AFTER_DRAIN = false;
    bf16_t* O; const float* p; float scale; int ld;
    __device__ __forceinline__ void operator()(const f32x4 (&acc)[2][2][4][2], const Unit& u, int wr, int wc, int fr, int fq) const {
        const int row0 = u.pm * BM + wr * 64 + fr; const int col0 = u.pn * BM + wc * 32 + 8 * fq;
        const f32x4 pA0 = *(const f32x4*)(p + col0), pA1 = *(const f32x4*)(p + col0 + 4), pB0 = *(const f32x4*)(p + col0 + HALF), pB1 = *(const f32x4*)(p + col0 + HALF + 4);
#pragma unroll
        for (int ai = 0; ai < 2; ++ai)
#pragma unroll
            for (int m = 0; m < 4; ++m) { bf16_t* rowp = O + (size_t)(row0 + ai * HALF + m * 16) * ld + col0;
#pragma unroll
                for (int bj = 0; bj < 2; ++bj) { f32x4 v0 = acc[ai][bj][m][0], v1 = acc[ai][bj][m][1]; const f32x4 p0 = bj ? pB0 : pA0, p1 = bj ? pB1 : pA1;
                    v0 = (f32x4){sigm(p0[0] + v0[0]), sigm(p0[1] + v0[1]), sigm(p0[2] + v0[2]), sigm(p0[3] + v0[3])} * scale; v1 = (f32x4){sigm(p1[0] + v1[0]), sigm(p1[1] + v1[1]), sigm(p1[2] + v1[2]), sigm(p1[3] + v1[3])} * scale;
                    u32x4 w; w.x = cvt_pk_bf16(v0[0], v0[1]); w.y = cvt_pk_bf16(v0[2], v0[3]); w.z = cvt_pk_bf16(v1[0], v1[1]); w.w = cvt_pk_bf16(v1[2], v1[3]);
                    *(u32x4*)(rowp + bj * HALF) = w; } }
    }
};
struct EpiQRope {
    static constexpr bool PERM = true, AFTER_DRAIN = false;
    bf16_t* O; const float* rope; float sc;
    __device__ __forceinline__ void operator()(const f32x4 (&acc)[2][2][4][2], const Unit& u, int wr, int wc, int fr, int fq) const {
        const int row0 = u.pm * BM + wr * 64 + fr; const int col0 = u.pn * BM + wc * 32 + 8 * fq;
#pragma unroll
        for (int ai = 0; ai < 2; ++ai)
#pragma unroll
            for (int m = 0; m < 4; ++m) { const int row = row0 + ai * HALF + m * 16;
#pragma unroll
                for (int bj = 0; bj < 2; ++bj) { const int cg = col0 + bj * HALF; const int cm = cg % 192; f32x4 v0 = acc[ai][bj][m][0], v1 = acc[ai][bj][m][1];
                    if (cm >= 128) { const int j0 = (cm - 128) >> 1; const f32x4* rp = (const f32x4*)(rope + ((size_t)row * 32 + j0) * 2); const f32x4 a = rp[0], b = rp[1];
                        f32x4 r0, r1;
                        r0[0] = v0[0] * a[0] - v0[1] * a[1]; r0[1] = v0[1] * a[0] + v0[0] * a[1]; r0[2] = v0[2] * a[2] - v0[3] * a[3]; r0[3] = v0[3] * a[2] + v0[2] * a[3];
                        r1[0] = v1[0] * b[0] - v1[1] * b[1]; r1[1] = v1[1] * b[0] + v1[0] * b[1]; r1[2] = v1[2] * b[2] - v1[3] * b[3]; r1[3] = v1[3] * b[2] + v1[2] * b[3];
                        v0 = r0; v1 = r1; }
                    v0 = v0 * sc; v1 = v1 * sc; u32x4 w; w.x = cvt_pk_bf16(v0[0], v0[1]); w.y = cvt_pk_bf16(v0[2], v0[3]); w.z = cvt_pk_bf16(v1[0], v1[1]); w.w = cvt_pk_bf16(v1[2], v1[3]);
                    *(u32x4*)(O + (size_t)row * 768 + cg) = w; } }
    }
};
template <int NI> struct EpiMerge {
    static constexpr bool PERM = true, AFTER_DRAIN = false;
    bf16_t* MG; const bf16_t* GT;
    __device__ __forceinline__ void operator()(const f32x4 (&acc)[2][2][4][2], const Unit& u, int wr, int wc, int fr, int fq) const {
        const int row0 = u.pm * BM + wr * 64 + fr; const int col0 = u.pn * BM + wc * 32 + 8 * fq;
#pragma unroll
        for (int ai = 0; ai < 2; ++ai)
#pragma unroll
            for (int m = 0; m < 4; ++m) { const int row = row0 + ai * HALF + m * 16;
#pragma unroll
                for (int bj = 0; bj < 2; ++bj) { const int c = col0 + bj * HALF; const f32x4 v0 = acc[ai][bj][m][0], v1 = acc[ai][bj][m][1];
                    const u32x4 gw = *(const u32x4*)(GT + (size_t)row * 3072 + NI * 1024 + c);
                    f32x4 o0 = {0.f, 0.f, 0.f, 0.f}, o1 = {0.f, 0.f, 0.f, 0.f};
                    if (NI > 0) { const u32x4 ow = *(const u32x4*)(MG + (size_t)row * 1024 + c); o0 = (f32x4){h_lo(ow.x), h_hi(ow.x), h_lo(ow.y), h_hi(ow.y)}; o1 = (f32x4){h_lo(ow.z), h_hi(ow.z), h_lo(ow.w), h_hi(ow.w)}; }
                    o0[0] += sigm(h_lo(gw.x)) * v0[0]; o0[1] += sigm(h_hi(gw.x)) * v0[1]; o0[2] += sigm(h_lo(gw.y)) * v0[2]; o0[3] += sigm(h_hi(gw.y)) * v0[3];
                    o1[0] += sigm(h_lo(gw.z)) * v1[0]; o1[1] += sigm(h_hi(gw.z)) * v1[1]; o1[2] += sigm(h_lo(gw.w)) * v1[2]; o1[3] += sigm(h_hi(gw.w)) * v1[3];
                    u32x4 w; w.x = cvt_pk_bf16(o0[0], o0[1]); w.y = cvt_pk_bf16(o0[2], o0[3]); w.z = cvt_pk_bf16(o1[0], o1[1]); w.w = cvt_pk_bf16(o1[2], o1[3]);
                    *(u32x4*)(MG + (size_t)row * 1024 + c) = w; } }
    }
};
__device__ __forceinline__ unsigned pk_fma_h(unsigned a, unsigned b, unsigned c) { unsigned r; asm("v_pk_fma_f16 %0, %1, %2, %3" : "=v"(r) : "v"(a), "v"(b), "v"(c)); return r; }
struct EpiMergeAll {
    static constexpr bool PERM = true, AFTER_DRAIN = false;
    bf16_t* MG; const bf16_t* GT;
    __device__ __forceinline__ void operator()(const f32x4 (&acc)[2][2][4][2], const Unit& u, int wr, int wc, int fr, int fq) const {
        const int a = u.pm >> 7, p = u.pm & 127, br = u.pn >> 2, q = u.pn & 3;
        const int row0 = p * BM + wr * 64 + fr; const int col0 = q * BM + wc * 32 + 8 * fq;
#pragma unroll
        for (int ai = 0; ai < 2; ++ai) {
            u32x4 gw[4][2], ow[4][2];
#pragma unroll
            for (int m = 0; m < 4; ++m)
#pragma unroll
                for (int bj = 0; bj < 2; ++bj) { const int row = row0 + ai * HALF + m * 16, c = col0 + bj * HALF;
                    gw[m][bj] = *(const u32x4*)(GT + (size_t)row * 3072 + br * 1024 + c);
                    if (a > 0) ow[m][bj] = *(const u32x4*)(MG + (size_t)row * 1024 + c); else ow[m][bj] = (u32x4){0u, 0u, 0u, 0u}; }
            __builtin_amdgcn_sched_barrier(0);
#pragma unroll
            for (int m = 0; m < 4; ++m)
#pragma unroll
                for (int bj = 0; bj < 2; ++bj) { const int row = row0 + ai * HALF + m * 16, c = col0 + bj * HALF; const f32x4 v0 = acc[ai][bj][m][0], v1 = acc[ai][bj][m][1]; const u32x4 g = gw[m][bj], o = ow[m][bj];
                    u32x4 w;
                    w.x = pk_fma_h(cvt_pk_bf16(sigm(h_lo(g.x)), sigm(h_hi(g.x))), cvt_pk_bf16(v0[0], v0[1]), o.x);
                    w.y = pk_fma_h(cvt_pk_bf16(sigm(h_lo(g.y)), sigm(h_hi(g.y))), cvt_pk_bf16(v0[2], v0[3]), o.y);
                    w.z = pk_fma_h(cvt_pk_bf16(sigm(h_lo(g.z)), sigm(h_hi(g.z))), cvt_pk_bf16(v1[0], v1[1]), o.z);
                    w.w = pk_fma_h(cvt_pk_bf16(sigm(h_lo(g.w)), sigm(h_hi(g.w))), cvt_pk_bf16(v1[2], v1[3]), o.w);
                    *(u32x4*)(MG + (size_t)row * 1024 + c) = w; }
            __builtin_amdgcn_sched_barrier(0);
        }
    }
};
struct MergeOrder {
    int G, c;
    __device__ __forceinline__ bool next(int i, Unit& u) const { if (i >= 6 || G != 256) { if (G == 256) return false; const int t = c + G * (i / 3), a = i % 3; if (t >= 512) return false;
            const int p = t >> 2, q = t & 3, br = (a == 0) ? 0 : (a == 1 ? 2 : 1); u.pm = a * 128 + p; u.pn = br * 4 + q; return true; }
        const int x = c & 7, s = c >> 3, p = x * 16 + (s >> 1), q = 2 * (s & 1) + i / 3, a = i % 3, br = (a == 0) ? 0 : (a == 1 ? 2 : 1);
        u.pm = a * 128 + p; u.pn = br * 4 + q; return true; }
    __device__ __forceinline__ void a_ready(const Unit&) const {}
    __device__ __forceinline__ void done(const Unit&) const {}
};
struct EpiPle {
    static constexpr bool PERM = true, AFTER_DRAIN = false;
    bf16_t* H16; const bf16_t* PP; float* outLo; float* outHi; int last;
    __device__ __forceinline__ void operator()(const f32x4 (&acc)[2][2][4][2], const Unit& u, int wr, int wc, int fr, int fq) const {
        const int row0 = u.pm * BM + wr * 64 + fr; const int col0 = u.pn * BM + wc * 32 + 8 * fq;
#pragma unroll
        for (int ai = 0; ai < 2; ++ai) {
            u32x4 pw[4][2], hw[4][2];
#pragma unroll
            for (int m = 0; m < 4; ++m)
#pragma unroll
                for (int bj = 0; bj < 2; ++bj) { const int row = row0 + ai * HALF + m * 16, c = col0 + bj * HALF;
                    pw[m][bj] = *(const u32x4*)(PP + (size_t)row * 1024 + c); hw[m][bj] = *(const u32x4*)(H16 + (size_t)row * 1024 + c); }
            __builtin_amdgcn_sched_barrier(0);
#pragma unroll
            for (int m = 0; m < 4; ++m)
#pragma unroll
                for (int bj = 0; bj < 2; ++bj) { const int row = row0 + ai * HALF + m * 16, c = col0 + bj * HALF; const f32x4 v0 = acc[ai][bj][m][0], v1 = acc[ai][bj][m][1]; const u32x4 pq = pw[m][bj], hq = hw[m][bj];
                    f32x4 h0 = (f32x4){h_lo(hq.x), h_hi(hq.x), h_lo(hq.y), h_hi(hq.y)}, h1 = (f32x4){h_lo(hq.z), h_hi(hq.z), h_lo(hq.w), h_hi(hq.w)};
                    h0[0] += sigm(v0[0]) * h_lo(pq.x); h0[1] += sigm(v0[1]) * h_hi(pq.x); h0[2] += sigm(v0[2]) * h_lo(pq.y); h0[3] += sigm(v0[3]) * h_hi(pq.y);
                    h1[0] += sigm(v1[0]) * h_lo(pq.z); h1[1] += sigm(v1[1]) * h_hi(pq.z); h1[2] += sigm(v1[2]) * h_lo(pq.w); h1[3] += sigm(v1[3]) * h_hi(pq.w);
                    if (last) { float* op = (row < 16384) ? (outLo + (size_t)row * 1024 + c) : (outHi + (size_t)(row - 16384) * 1024 + c); *(f32x4*)op = h0; *(f32x4*)(op + 4) = h1; }
                    else { u32x4 w; w.x = h_pk2(h0[0], h0[1]); w.y = h_pk2(h0[2], h0[3]); w.z = h_pk2(h1[0], h1[1]); w.w = h_pk2(h1[2], h1[3]); *(u32x4*)(H16 + (size_t)row * 1024 + c) = w; } }
            __builtin_amdgcn_sched_barrier(0);
        }
    }
};
template <class Epi, class Sched, bool ALIGN_EPI = false, bool SP2 = false>
__device__ __forceinline__ void gemm_phase(PG8_LAS unsigned char* lds, const Gemm g, const Sched& S, const Epi& E) {
    int tid_ = my_tid(); asm volatile("" : "+v"(tid_));
    const int tid = tid_, wid = __builtin_amdgcn_readfirstlane(tid >> 6), lane = tid & 63, wr = wid >> 2, wc = wid & 3, fr = lane & 15, fq = lane >> 4;
    const int K = g.K, nt = K / BK;
    unsigned voffA[2], voffB[2];
#pragma unroll
    for (int i = 0; i < 2; ++i) { int R, C; stage_rc(tid * 16 + i * 8192, R, C); const int Rb = Epi::PERM ? ((R & ~31) + perm32(R & 31)) : R;
        voffA[i] = (unsigned)(R * K + C) * 2u; voffB[i] = (unsigned)(Rb * K + C) * 2u; }
    const size_t kstep = (size_t)(BK * 2);
    const size_t hstep = (size_t)HALF * K * 2;
    const size_t tstep = 2 * hstep;
    const unsigned ldsw = (unsigned)wid * 1024u;
    const int aoff = lds_byte(wr * 64 + fr, fq * 8), boff = lds_byte(wc * 32 + fr, fq * 8);
#define PG8_SA(b, h) (((b) * 2 + (h)) * HTB)
#define PG8_SB(b, h) ((4 + (b) * 2 + (h)) * HTB)
#define PG8_STAGE(bufoff, gbase, voff) do { _Pragma("unroll") for (int _i = 0; _i < 2; ++_i) \
        __builtin_amdgcn_global_load_lds((const unsigned*)((const char*)(gbase) + (voff)[_i]), (PG8_LAS unsigned*)(lds + (bufoff) + ldsw + _i * 8192), 16, 0, 0); } while (0)
#define PG8_LDA(dst, b, h) do { _Pragma("unroll") for (int m = 0; m < 4; ++m) _Pragma("unroll") for (int k = 0; k < 2; ++k) dst[m][k] = *(const PG8_LAS bf16x8*)(lds + PG8_SA(b, h) + aoff + m * 2048 + k * 1024); } while (0)
#define PG8_LDB(dst, b, h) do { _Pragma("unroll") for (int n = 0; n < 2; ++n) _Pragma("unroll") for (int k = 0; k < 2; ++k) dst[n][k] = *(const PG8_LAS bf16x8*)(lds + PG8_SB(b, h) + boff + n * 2048 + k * 1024); } while (0)
#define PG8_MMA(ai, bj, At, Bt) do { __builtin_amdgcn_s_setprio(1); _Pragma("unroll") for (int m = 0; m < 4; ++m) _Pragma("unroll") for (int n = 0; n < 2; ++n) _Pragma("unroll") for (int k = 0; k < 2; ++k) \
        acc[ai][bj][m][n] = MFMA16(Bt[n][k], At[m][k], acc[ai][bj][m][n]); __builtin_amdgcn_s_setprio(0); } while (0)
#define PG8_WAIT_V(n) asm volatile("s_waitcnt vmcnt(" #n ")" ::: "memory")
#define PG8_WAIT_L(n) asm volatile("s_waitcnt lgkmcnt(" #n ")" ::: "memory")
#define PG8_BAR __builtin_amdgcn_s_barrier()
#define PG8_SCHED __builtin_amdgcn_sched_barrier(0)
    Unit cur, nxt; int ui = 0;
    if (!S.next(0, cur)) return;
    f32x4 acc[2][2][4][2];
#pragma unroll
    for (int a = 0; a < 2; ++a)
#pragma unroll
        for (int b = 0; b < 2; ++b)
#pragma unroll
            for (int m = 0; m < 4; ++m)
#pragma unroll
                for (int n = 0; n < 2; ++n) acc[a][b][m][n] = (f32x4){0.f, 0.f, 0.f, 0.f};
    bf16x8 At[4][2], B0[2][2], B1[2][2];
    const char* cA = (const char*)g.A + (size_t)cur.pm * tstep; const char* cB = (const char*)g.Bt + (size_t)cur.pn * tstep;
    S.a_ready(cur);
    if constexpr (SP2) {
        PG8_STAGE(PG8_SB(0, 0), cB, voffB); PG8_STAGE(PG8_SB(0, 1), cB + hstep, voffB); PG8_STAGE(PG8_SA(0, 0), cA, voffA); PG8_STAGE(PG8_SA(0, 1), cA + hstep, voffA);
        if (wr == 1) PG8_BAR;
        PG8_WAIT_V(2); PG8_BAR;
        PG8_STAGE(PG8_SB(1, 0), cB + kstep, voffB); PG8_STAGE(PG8_SA(1, 0), cA + kstep, voffA); PG8_STAGE(PG8_SB(1, 1), cB + hstep + kstep, voffB);
        PG8_WAIT_V(6); PG8_BAR;
    } else {
        PG8_STAGE(PG8_SB(0, 0), cB, voffB); PG8_STAGE(PG8_SA(0, 0), cA, voffA); PG8_STAGE(PG8_SB(0, 1), cB + hstep, voffB); PG8_STAGE(PG8_SA(0, 1), cA + hstep, voffA);
        if (wr == 1) PG8_BAR;
        PG8_WAIT_V(4); PG8_BAR;
        PG8_STAGE(PG8_SB(1, 0), cB + kstep, voffB); PG8_STAGE(PG8_SA(1, 0), cA + kstep, voffA); PG8_STAGE(PG8_SB(1, 1), cB + hstep + kstep, voffB);
        PG8_WAIT_V(6); PG8_BAR;
    }
    for (;;) {
        const bool has_next = S.next(ui + 1, nxt);
        const char* nA = has_next ? (const char*)g.A + (size_t)nxt.pm * tstep : cA; const char* nB = has_next ? (const char*)g.Bt + (size_t)nxt.pn * tstep : cB;
        for (int t = 0; t < nt; t += 2) {
            const bool last = (t == nt - 2);
            const char* a1 = cA + (size_t)(t + 1) * kstep;
            const char* a2 = last ? nA : cA + (size_t)(t + 2) * kstep; const char* b2 = last ? nB : cB + (size_t)(t + 2) * kstep;
            const char* a3 = a2 + kstep; const char* b3 = b2 + kstep;
            if (last && has_next) S.a_ready(nxt);
            if constexpr (SP2) {
            PG8_LDB(B0, 0, 0); PG8_LDB(B1, 0, 1); PG8_SCHED; PG8_LDA(At, 0, 0); PG8_STAGE(PG8_SA(1, 1), a1 + hstep, voffA);
            PG8_WAIT_V(8); PG8_WAIT_L(0); PG8_BAR; PG8_MMA(0, 0, At, B0); PG8_MMA(0, 1, At, B1); PG8_BAR; PG8_SCHED;
            PG8_LDA(At, 0, 1); PG8_STAGE(PG8_SB(0, 0), b2, voffB); PG8_STAGE(PG8_SB(0, 1), b2 + hstep, voffB); PG8_STAGE(PG8_SA(0, 0), a2, voffA);
            PG8_WAIT_V(8); PG8_WAIT_L(0); PG8_BAR; PG8_MMA(1, 0, At, B0); PG8_MMA(1, 1, At, B1); PG8_BAR; PG8_SCHED;
            PG8_LDB(B0, 1, 0); PG8_LDB(B1, 1, 1); PG8_SCHED; PG8_LDA(At, 1, 0); PG8_STAGE(PG8_SA(0, 1), a2 + hstep, voffA);
            PG8_WAIT_V(8); PG8_WAIT_L(0); PG8_BAR; PG8_MMA(0, 0, At, B0); PG8_MMA(0, 1, At, B1); PG8_BAR; PG8_SCHED;
            PG8_LDA(At, 1, 1); PG8_STAGE(PG8_SB(1, 0), b3, voffB); PG8_STAGE(PG8_SB(1, 1), b3 + hstep, voffB); PG8_STAGE(PG8_SA(1, 0), a3, voffA);
            PG8_WAIT_V(8); PG8_WAIT_L(0); PG8_BAR; PG8_MMA(1, 0, At, B0); PG8_MMA(1, 1, At, B1); PG8_BAR; PG8_SCHED;
            } else {
            PG8_LDB(B0, 0, 0); PG8_SCHED; PG8_LDA(At, 0, 0); PG8_STAGE(PG8_SA(1, 1), a1 + hstep, voffA);
            PG8_WAIT_L(8); PG8_BAR; PG8_WAIT_L(0); PG8_MMA(0, 0, At, B0); PG8_BAR; PG8_SCHED;
            PG8_LDB(B1, 0, 1); PG8_STAGE(PG8_SB(0, 0), b2, voffB);
            PG8_BAR; PG8_WAIT_L(0); PG8_MMA(0, 1, At, B1); PG8_BAR;
            PG8_LDA(At, 0, 1); PG8_STAGE(PG8_SA(0, 0), a2, voffA);
            PG8_BAR; PG8_WAIT_L(0); PG8_MMA(1, 0, At, B0); PG8_BAR; PG8_SCHED;
            PG8_STAGE(PG8_SB(0, 1), b2 + hstep, voffB);
            PG8_WAIT_V(6); PG8_BAR; PG8_MMA(1, 1, At, B1); PG8_BAR;
            PG8_LDB(B0, 1, 0); PG8_SCHED; PG8_LDA(At, 1, 0); PG8_STAGE(PG8_SA(0, 1), a2 + hstep, voffA);
            PG8_WAIT_L(8); PG8_BAR; PG8_WAIT_L(0); PG8_MMA(0, 0, At, B0); PG8_BAR; PG8_SCHED;
            PG8_LDB(B1, 1, 1); PG8_STAGE(PG8_SB(1, 0), b3, voffB);
            PG8_BAR; PG8_WAIT_L(0); PG8_MMA(0, 1, At, B1); PG8_BAR;
            PG8_LDA(At, 1, 1); PG8_STAGE(PG8_SA(1, 0), a3, voffA);
            PG8_BAR; PG8_WAIT_L(0); PG8_MMA(1, 0, At, B0); PG8_BAR; PG8_SCHED;
            PG8_STAGE(PG8_SB(1, 1), b3 + hstep, voffB);
            PG8_WAIT_V(6); PG8_BAR; PG8_MMA(1, 1, At, B1); PG8_BAR;
            }
        }
        if constexpr (ALIGN_EPI) { if (wr == 0) PG8_BAR; }
        if constexpr (!Epi::AFTER_DRAIN) { int t2_ = my_tid(); asm volatile("" : "+v"(t2_)); const int l2_ = t2_ & 63, w2_ = __builtin_amdgcn_readfirstlane(t2_ >> 6);
            E(acc, cur, w2_ >> 2, w2_ & 3, l2_ & 15, l2_ >> 4); S.done(cur); }
        if (!has_next) break;
#pragma unroll
        for (int a = 0; a < 2; ++a)
#pragma unroll
            for (int b = 0; b < 2; ++b)
#pragma unroll
                for (int m = 0; m < 4; ++m)
#pragma unroll
                    for (int n = 0; n < 2; ++n) acc[a][b][m][n] = (f32x4){0.f, 0.f, 0.f, 0.f};
        cur = nxt; cA = nA; cB = nB; ++ui;
        if constexpr (ALIGN_EPI) { if (wr == 1) PG8_BAR; }
    }
    PG8_WAIT_V(0);
    if constexpr (!ALIGN_EPI) { if (wr == 0) PG8_BAR; }
    PG8_BAR;
    if constexpr (Epi::AFTER_DRAIN) { E.fused(acc, cur, wr, wc, fr, fq, lds, wid, lane); S.done(cur); }
#undef PG8_SA
#undef PG8_SB
#undef PG8_STAGE
#undef PG8_LDA
#undef PG8_LDB
#undef PG8_MMA
#undef PG8_WAIT_V
#undef PG8_WAIT_L
#undef PG8_BAR
#undef PG8_SCHED
}
}
constexpr int NWAVES = 8;
constexpr int D = 1024, BATCH = 8, SEQ = 4096, T = BATCH * SEQ, DEPTH = 2, FF = 4096, DPLE = 256;
constexpr int IN_COLS = 6848, RW_COLS = 1792;
constexpr float NORM_EPS = 1e-6f, RW_LN_EPS = 64e-5f;
constexpr float LOG2E = 1.4426950408889634f;
constexpr float MLA_QSCALE = 0.07216878364870322f * LOG2E;
constexpr float CA_QSCALE = 0.125f * LOG2E;
constexpr size_t MiB = 1u << 20;
constexpr size_t WS_CTL = 0, CTL_ZERO_BYTES = 1 * MiB;
constexpr size_t WS_ROPE = 1 * MiB;
constexpr size_t WS_W = 9 * MiB;
constexpr size_t W_IN = WS_W, W_Q = W_IN + (size_t)6912 * 1024 * 2, W_LORA = W_Q + (size_t)768 * 256 * 2, W_B = W_LORA + (size_t)1536 * 256 * 2,
                 W_OUT = W_B + (size_t)3 * 1024 * 512 * 2, W_1 = W_OUT + (size_t)1024 * 1024 * 2, W_2 = W_1 + (size_t)4096 * 1024 * 2, W_G = W_2 + (size_t)4096 * 1024 * 2,
                 W_P = W_G + (size_t)1024 * 1024 * 2, W_END = W_P + (size_t)1024 * 256 * 2;
constexpr size_t WS_U = 49 * MiB;
constexpr size_t WS_OA = 113 * MiB, WS_OC = 145 * MiB, WS_ORW = 177 * MiB;
constexpr size_t WS_X = 209 * MiB, WS_END = 512 * MiB;
constexpr size_t X_ZC = WS_X, X_QP = X_ZC + (size_t)T * 1536 * 2, X_KV = X_QP + (size_t)T * 768 * 2, X_ZR = X_KV + (size_t)T * 192 * 2, X_TW = X_ZR + (size_t)T * 1792 * 2;
constexpr size_t X_QN = WS_OC, X_LA = WS_OC + (size_t)T * 256 * 2;
constexpr size_t DO_G = 0, DO_TA = 32 * MiB, DO_H16 = 64 * MiB;
constexpr size_t X_STG = WS_X + 96 * MiB;
constexpr size_t X_GT = WS_X, X_MG = X_GT + (size_t)T * 3072 * 2;
constexpr size_t X_HID = WS_X, X_PB = WS_X, X_PP = X_PB + (size_t)T * 256 * 2;
static_assert(X_TW + (size_t)T * 512 * 2 <= WS_END && X_MG + (size_t)T * 1024 * 2 <= WS_END && X_HID + (size_t)T * 4096 * 2 <= WS_END, "X map");
constexpr int CW_TMO = 0, CW_QUEUE = 1024  , CW_BAR = 4096;
constexpr int RING_OFF = 0, RING_BYTES = 131072;
constexpr int LDSCTL_OFF = RING_BYTES, MISC_OFF = LDSCTL_OFF + 320;
constexpr int LDS_BYTES = 147456;

#define GAS __attribute__((address_space(1)))
#define LAS __attribute__((address_space(3)))
typedef unsigned short bf16;
typedef unsigned v4u __attribute__((ext_vector_type(4)));
typedef unsigned v2u __attribute__((ext_vector_type(2)));
typedef float f32x4 __attribute__((ext_vector_type(4)));
typedef float f32x16 __attribute__((ext_vector_type(16)));
typedef short bf16x8 __attribute__((ext_vector_type(8)));
typedef short s16x4 __attribute__((ext_vector_type(4)));
#define LDS_WAIT() asm volatile("s_waitcnt lgkmcnt(0)" ::: "memory")
#define VM_WAIT() asm volatile("s_waitcnt vmcnt(0)" ::: "memory")
__device__ __forceinline__ unsigned f2bf(float f) { return h_f2h(f); }
__device__ __forceinline__ unsigned pk2(float lo, float hi) { return h_pk2(lo, hi); }
__device__ __forceinline__ float bfl(unsigned w) { return h_lo(w); }
__device__ __forceinline__ float bfh(unsigned w) { return h_hi(w); }
__device__ __forceinline__ float sigmoidf_(float x) { return 1.0f / (1.0f + __expf(-x)); }
__device__ __forceinline__ float shfl_xor_f(float v, int o, int lane) { return __int_as_float(__builtin_amdgcn_ds_bpermute((lane ^ o) << 2, __float_as_int(v))); }
__device__ __forceinline__ float wave_sum(float v, int lane) {
#pragma unroll
    for (int o = 1; o < 64; o <<= 1) v += shfl_xor_f(v, o, lane);
    return v;
}
__device__ __forceinline__ unsigned char* opq(unsigned char* p) { asm volatile("" : "+s"(p)); return p; }
__device__ __forceinline__ float fsig(float x) { return __builtin_amdgcn_rcpf(1.0f + __builtin_amdgcn_exp2f(-LOG2E * x)); }
#define XB_TMO      128
#define XB_XCNT(j)  (256  + 64 * (j))
#define XB_XSUB(j)  (1280 + 64 * (j))
#define XB_XGEN(j)  (2304 + 64 * (j))
#define XB_TOP      3328
#define XB_TOPGEN   3392
#define XCD_BAR_WORDS 3456
#define XB_SPIN_CAP (1u << 25)

__device__ __forceinline__ unsigned xb_ld(unsigned* p)              { return __hip_atomic_load(p, __ATOMIC_RELAXED, __HIP_MEMORY_SCOPE_AGENT); }
__device__ __forceinline__ unsigned xb_add(unsigned* p, unsigned v) { return __hip_atomic_fetch_add(p, v, __ATOMIC_RELAXED, __HIP_MEMORY_SCOPE_AGENT); }
__device__ __forceinline__ unsigned xb_xcc_id() { return (unsigned)__builtin_amdgcn_s_getreg((3 << 11) | 20) & 0xFu; }
#define XB_SPIN(cond, bar) do { unsigned _sp = 0; while (cond) { __builtin_amdgcn_s_sleep(1); \
    if ((++_sp & 255u) == 0u) { if (xb_ld(&(bar)[XB_TMO])) break; if (_sp > XB_SPIN_CAP) { atomicAdd(&(bar)[XB_TMO], 1u); break; } } } } while (0)

struct XcdBarrier {
    unsigned* bar; unsigned x;
    volatile LAS unsigned* st;
};

__device__ __forceinline__ XcdBarrier xcd_barrier_post(unsigned* bar, volatile LAS unsigned* st) {
    XcdBarrier b; b.bar = bar; b.x = xb_xcc_id(); b.st = st;
    if (my_tid() == 0) (void)xb_add(&bar[XB_XCNT(b.x)], 1u);
    return b;
}
__device__ __forceinline__ void xcd_barrier_complete(unsigned* bar, unsigned x, unsigned& nloc, unsigned& nx) {
    const unsigned G = gridDim.x * gridDim.y * gridDim.z;
    unsigned sum, cnt, mine, sp = 0u;
    for (;;) {
        sum = 0u; cnt = 0u; mine = 0u;
#pragma unroll
        for (unsigned j = 0; j < 16; ++j) { const unsigned c = xb_ld(&bar[XB_XCNT(j)]); sum += c; cnt += (c > 0u) ? 1u : 0u; mine = (j == x) ? c : mine; }
        if (sum == G) break;
        __builtin_amdgcn_s_sleep(1);
        if ((++sp & 255u) == 0u) { if (xb_ld(&bar[XB_TMO])) break; if (sp > XB_SPIN_CAP) { atomicAdd(&bar[XB_TMO], 1u); break; } }
    }
    nloc = mine > 0u ? mine : 1u; nx = cnt > 0u ? cnt : 1u;
}

__device__ __forceinline__ void xcd_barrier(const XcdBarrier& b) {
    asm volatile("s_waitcnt vmcnt(0)" ::: "memory");
    __syncthreads();
    if (my_tid() == 0) {
        unsigned* bar = b.bar;
        __builtin_amdgcn_s_waitcnt(0);
        unsigned nloc = b.st[0], nx = b.st[1];
        if (nloc == 0u) { xcd_barrier_complete(bar, b.x, nloc, nx); b.st[0] = nloc; b.st[1] = nx; }
        const unsigned old = xb_add(&bar[XB_XSUB(b.x)], 1u);
        const unsigned gen = old / nloc;
        if (old + 1u == (gen + 1u) * nloc) {
            __builtin_amdgcn_fence(__ATOMIC_RELEASE, "agent");
            asm volatile("s_waitcnt vmcnt(0)" ::: "memory");
            const unsigned og = xb_add(&bar[XB_TOP], 1u);
            const unsigned tg = og / nx;
            if (og + 1u == (tg + 1u) * nx) xb_add(&bar[XB_TOPGEN], 1u);
            else XB_SPIN(xb_ld(&bar[XB_TOPGEN]) == tg, bar);
            __builtin_amdgcn_fence(__ATOMIC_ACQUIRE, "agent");
            xb_add(&bar[XB_XGEN(b.x)], 1u);
            asm volatile("s_waitcnt vmcnt(0)" ::: "memory");
        } else {
            XB_SPIN(xb_ld(&bar[XB_XGEN(b.x)]) == gen, bar);
            __builtin_amdgcn_fence(__ATOMIC_ACQUIRE, "agent");
            asm volatile("s_waitcnt vmcnt(0)" ::: "memory");
        }
    }
    __syncthreads();
}
namespace att {
__device__ __forceinline__ int crow(int r, int hi) { return (r & 3) + 8 * (r >> 2) + 4 * hi; }
__device__ __forceinline__ unsigned cvtpk(float lo, float hi) { return h_pk2(lo, hi); }
typedef short v4i16_t __attribute__((ext_vector_type(4)));
__device__ __forceinline__ s16x4 vtr(const LAS unsigned char* p) { return __builtin_bit_cast(s16x4, __builtin_amdgcn_ds_read_tr16_b64_v4i16((LAS v4i16_t*)p)); }
__device__ __forceinline__ float softmax_tile(f32x16& p0, f32x16& p1, float& m_reg, float& l_reg, bf16x8& pa0, bf16x8& pa1, bf16x8& pa2, bf16x8& pa3) {
    float pmax = p0[0];
#pragma unroll
    for (int r = 1; r < 16; ++r) pmax = fmaxf(pmax, p0[r]);
#pragma unroll
    for (int r = 0; r < 16; ++r) pmax = fmaxf(pmax, p1[r]);
    { auto rr = __builtin_amdgcn_permlane32_swap(__float_as_uint(pmax), __float_as_uint(pmax), false, false); pmax = fmaxf(__uint_as_float(rr[0]), __uint_as_float(rr[1])); }
    float alpha = 1.f;
    if (!__all(pmax - m_reg <= 8.f)) { const float mn = fmaxf(m_reg, pmax); alpha = __builtin_amdgcn_exp2f(m_reg - mn); m_reg = mn; }
    float ps = 0.f;
#pragma unroll
    for (int r = 0; r < 16; ++r) { p0[r] = __builtin_amdgcn_exp2f(p0[r] - m_reg); ps += p0[r]; }
#pragma unroll
    for (int r = 0; r < 16; ++r) { p1[r] = __builtin_amdgcn_exp2f(p1[r] - m_reg); ps += p1[r]; }
    { auto rr = __builtin_amdgcn_permlane32_swap(__float_as_uint(ps), __float_as_uint(ps), false, false); ps = __uint_as_float(rr[0]) + __uint_as_float(rr[1]); }
    l_reg = l_reg * alpha + ps;
#define PK4(P, BASE, OUT) do { unsigned a0 = cvtpk(P[BASE + 0], P[BASE + 1]), a1 = cvtpk(P[BASE + 2], P[BASE + 3]);   \
    unsigned b0 = cvtpk(P[BASE + 4], P[BASE + 5]), b1 = cvtpk(P[BASE + 6], P[BASE + 7]);                              \
    auto r0 = __builtin_amdgcn_permlane32_swap(a0, b0, false, false); auto r1 = __builtin_amdgcn_permlane32_swap(a1, b1, false, false); \
    v4u w = {r0[0], r1[0], r0[1], r1[1]}; OUT = __builtin_bit_cast(bf16x8, w); } while (0)
    PK4(p0, 0, pa0); PK4(p0, 8, pa1); PK4(p1, 0, pa2); PK4(p1, 8, pa3);
#undef PK4
    return alpha;
}
constexpr int MLA_KSTR = 400;
constexpr int MLA_KBUF = 64 * MLA_KSTR;
constexpr int ATT_SCR = 2 * MLA_KBUF;
__device__ __forceinline__ void mla_unit(LAS unsigned char* lds, const bf16* __restrict__ QP, const bf16* __restrict__ KV, bf16* __restrict__ OA, int b, int c) {
    int tid_ = my_tid(); asm volatile("" : "+v"(tid_));
    const int tid = tid_, lane = tid & 63, wid = __builtin_amdgcn_readfirstlane(tid >> 6), r32 = lane & 31, hi = lane >> 5;
    const int h = wid >> 1; const size_t qrow0 = (size_t)b * SEQ + c * 64 + (wid & 1) * 32;
    bf16x8 qr[12];
    { const bf16* qp = QP + (qrow0 + r32) * 768 + h * 192 + hi * 8;
#pragma unroll
      for (int d0 = 0; d0 < 12; ++d0) qr[d0] = *(const bf16x8*)(qp + d0 * 16); }
    float m_reg = -1e30f, l_reg = 0.f; f32x16 o[4];
#pragma unroll
    for (int d = 0; d < 4; ++d)
#pragma unroll
        for (int r = 0; r < 16; ++r) o[d][r] = 0.f;
    LAS float* scr = (LAS float*)(lds + ATT_SCR) + wid * 64;
    const bf16* kvb = KV + (size_t)b * SEQ * 192;
    int skey[3], sch[3];
#pragma unroll
    for (int i = 0; i < 3; ++i) { const int id = tid + 512 * i; skey[i] = id / 24; sch[i] = id % 24; }
    v4u st[3];
    const int NT = c + 1;
#pragma unroll
    for (int i = 0; i < 3; ++i) st[i] = *(const v4u*)(kvb + (size_t)skey[i] * 192 + sch[i] * 8);
#pragma unroll
    for (int i = 0; i < 3; ++i) *(LAS v4u*)(lds + skey[i] * MLA_KSTR + sch[i] * 16) = st[i];
    __syncthreads();
    const int troff = (((lane & 15) >> 2) + 8 * hi) * MLA_KSTR + (16 * ((lane >> 4) & 1) + 4 * (lane & 3)) * 2;
    for (int j = 0; j < NT; ++j) {
        const int buf = j & 1;
        if (j + 1 < NT) {
#pragma unroll
            for (int i = 0; i < 3; ++i) st[i] = *(const v4u*)(kvb + (size_t)(64 * (j + 1) + skey[i]) * 192 + sch[i] * 8);
        }
        const LAS unsigned char* kt = lds + buf * MLA_KBUF;
        f32x16 p0, p1;
#pragma unroll
        for (int r = 0; r < 16; ++r) { p0[r] = 0.f; p1[r] = 0.f; }
        { const LAS unsigned char* kb = kt + r32 * MLA_KSTR + hi * 16;
#pragma unroll
          for (int d0 = 0; d0 < 12; ++d0) { const bf16x8 a0 = *(const LAS bf16x8*)(kb + d0 * 32); const bf16x8 a1 = *(const LAS bf16x8*)(kb + 32 * MLA_KSTR + d0 * 32);
              p0 = MFMA32(a0, qr[d0], p0); p1 = MFMA32(a1, qr[d0], p1); } }
        bf16x8 pa0, pa1, pa2, pa3;
        const float alpha = softmax_tile(p0, p1, m_reg, l_reg, pa0, pa1, pa2, pa3);
        if (__any(alpha < 1.f)) { if (hi == 0) scr[r32] = alpha; LDS_WAIT();
#pragma unroll
            for (int r = 0; r < 16; ++r) { const float a = scr[crow(r, hi)];
#pragma unroll
                for (int d = 0; d < 4; ++d) o[d][r] *= a; } }
        const LAS unsigned char* vb = kt + troff;
#pragma unroll
        for (int d0 = 0; d0 < 4; ++d0) {
            s16x4 lo[4], hh[4];
#pragma unroll
            for (int ks = 0; ks < 4; ++ks) { lo[ks] = vtr(vb + (16 * ks) * MLA_KSTR + d0 * 64); hh[ks] = vtr(vb + (16 * ks + 4) * MLA_KSTR + d0 * 64); }
#define PK(k) (bf16x8){lo[k][0], lo[k][1], lo[k][2], lo[k][3], hh[k][0], hh[k][1], hh[k][2], hh[k][3]}
            o[d0] = MFMA32(pa0, PK(0), o[d0]);
            o[d0] = MFMA32(pa1, PK(1), o[d0]);
            o[d0] = MFMA32(pa2, PK(2), o[d0]);
            o[d0] = MFMA32(pa3, PK(3), o[d0]);
#undef PK
        }
        if (j + 1 < NT) {
#pragma unroll
            for (int i = 0; i < 3; ++i) *(LAS v4u*)(lds + (buf ^ 1) * MLA_KBUF + skey[i] * MLA_KSTR + sch[i] * 16) = st[i];
        }
        __syncthreads();
    }
    if (hi == 0) scr[r32] = l_reg; LDS_WAIT();
    bf16* ob = OA + qrow0 * 512 + h * 128 + r32;
#pragma unroll
    for (int r = 0; r < 16; ++r) { const int orow = crow(r, hi); const float rl = __builtin_amdgcn_rcpf(scr[orow]);
#pragma unroll
        for (int d0 = 0; d0 < 4; ++d0) ob[(size_t)orow * 512 + d0 * 32] = (bf16)f2bf(o[d0][r] * rl); }
    __syncthreads();
}
constexpr int CA_KSTR = 144;
constexpr int CA_TBUF = 64 * CA_KSTR;
constexpr int CA_BIAS = ATT_SCR + 8 * 256;
__device__ __forceinline__ void band_unit(LAS unsigned char* lds, const bf16* __restrict__ ZC, const float* __restrict__ relb, bf16* __restrict__ OC, int b, int h, int g) {
    int tid_ = my_tid(); asm volatile("" : "+v"(tid_));
    const int tid = tid_, lane = tid & 63, wid = __builtin_amdgcn_readfirstlane(tid >> 6), r32 = lane & 31, hi = lane >> 5;
    const int cw = 4 * g + (wid >> 1); const size_t qrow0 = (size_t)b * SEQ + cw * 64 + (wid & 1) * 32;
    LAS float* bias = (LAS float*)(lds + CA_BIAS);
    if (tid < 320) bias[tid] = relb[tid * 8 + h] * LOG2E;
    bf16x8 qr[4];
    { const bf16* qp = ZC + (qrow0 + r32) * 1536 + h * 64 + hi * 8;
#pragma unroll
      for (int d0 = 0; d0 < 4; ++d0) qr[d0] = *(const bf16x8*)(qp + d0 * 16); }
    float m_reg = -1e30f, l_reg = 0.f; f32x16 o[2];
#pragma unroll
    for (int d = 0; d < 2; ++d)
#pragma unroll
        for (int r = 0; r < 16; ++r) o[d][r] = 0.f;
    LAS float* scr = (LAS float*)(lds + ATT_SCR) + wid * 64;
    const int kc0 = (4 * g - 8) < 0 ? 0 : (4 * g - 8), kc1 = 4 * g + 3;
    const bf16* kbase = ZC + (size_t)b * SEQ * 1536 + 512 + h * 64; const bf16* vbase = kbase + 512;
    const int skey = tid >> 3, sch = tid & 7;
    v4u stk, stv;
    stk = *(const v4u*)(kbase + (size_t)(64 * kc0 + skey) * 1536 + sch * 8); stv = *(const v4u*)(vbase + (size_t)(64 * kc0 + skey) * 1536 + sch * 8);
    *(LAS v4u*)(lds + skey * CA_KSTR + sch * 16) = stk; *(LAS v4u*)(lds + CA_TBUF + skey * CA_KSTR + sch * 16) = stv;
    __syncthreads();
    const int troff = (((lane & 15) >> 2) + 8 * hi) * CA_KSTR + (16 * ((lane >> 4) & 1) + 4 * (lane & 3)) * 2;
    const int qin = (wid & 1) * 32 + r32;
    for (int kc = kc0; kc <= kc1; ++kc) {
        const int buf = (kc - kc0) & 1;
        if (kc < kc1) { stk = *(const v4u*)(kbase + (size_t)(64 * (kc + 1) + skey) * 1536 + sch * 8); stv = *(const v4u*)(vbase + (size_t)(64 * (kc + 1) + skey) * 1536 + sch * 8); }
        if (kc >= cw - 8 && kc <= cw) {
            const LAS unsigned char* kt = lds + buf * 2 * CA_TBUF;
            f32x16 p0, p1;
            const int dbase = (cw - kc) * 64 + qin + 63;
#pragma unroll
            for (int r = 0; r < 16; ++r) { int i0 = dbase - crow(r, hi), i1 = i0 - 32; i0 = i0 > 319 ? 319 : i0; i1 = i1 > 319 ? 319 : i1; p0[r] = bias[i0]; p1[r] = bias[i1]; }
            { const LAS unsigned char* kb = kt + r32 * CA_KSTR + hi * 16;
#pragma unroll
              for (int d0 = 0; d0 < 4; ++d0) { const bf16x8 a0 = *(const LAS bf16x8*)(kb + d0 * 32); const bf16x8 a1 = *(const LAS bf16x8*)(kb + 32 * CA_KSTR + d0 * 32);
                  p0 = MFMA32(a0, qr[d0], p0); p1 = MFMA32(a1, qr[d0], p1); } }
            bf16x8 pa0, pa1, pa2, pa3;
            const float alpha = softmax_tile(p0, p1, m_reg, l_reg, pa0, pa1, pa2, pa3);
            if (__any(alpha < 1.f)) { if (hi == 0) scr[r32] = alpha; LDS_WAIT();
#pragma unroll
                for (int r = 0; r < 16; ++r) { const float a = scr[crow(r, hi)]; o[0][r] *= a; o[1][r] *= a; } }
            const LAS unsigned char* vb = kt + CA_TBUF + troff;
#pragma unroll
            for (int d0 = 0; d0 < 2; ++d0) {
                s16x4 lo[4], hh[4];
#pragma unroll
                for (int ks = 0; ks < 4; ++ks) { lo[ks] = vtr(vb + (16 * ks) * CA_KSTR + d0 * 64); hh[ks] = vtr(vb + (16 * ks + 4) * CA_KSTR + d0 * 64); }
#define PK(k) (bf16x8){lo[k][0], lo[k][1], lo[k][2], lo[k][3], hh[k][0], hh[k][1], hh[k][2], hh[k][3]}
                o[d0] = MFMA32(pa0, PK(0), o[d0]);
                o[d0] = MFMA32(pa1, PK(1), o[d0]);
                o[d0] = MFMA32(pa2, PK(2), o[d0]);
                o[d0] = MFMA32(pa3, PK(3), o[d0]);
#undef PK
            }
        }
        if (kc < kc1) { *(LAS v4u*)(lds + (buf ^ 1) * 2 * CA_TBUF + skey * CA_KSTR + sch * 16) = stk; *(LAS v4u*)(lds + (buf ^ 1) * 2 * CA_TBUF + CA_TBUF + skey * CA_KSTR + sch * 16) = stv; }
        __syncthreads();
    }
    if (hi == 0) scr[r32] = l_reg; LDS_WAIT();
    bf16* ob = OC + qrow0 * 512 + h * 64 + r32;
#pragma unroll
    for (int r = 0; r < 16; ++r) { const int orow = crow(r, hi); const float rl = __builtin_amdgcn_rcpf(scr[orow]);
        ob[(size_t)orow * 512] = (bf16)f2bf(o[0][r] * rl); ob[(size_t)orow * 512 + 32] = (bf16)f2bf(o[1][r] * rl); }
    __syncthreads();
}
}
struct Args { const float* in[30]; float* out; unsigned char* ws; int start; int stop; };
#define KAS __attribute__((address_space(4)))
__device__ __forceinline__ const KAS unsigned char* kbase() { const KAS unsigned char* p = (const KAS unsigned char*)__builtin_amdgcn_kernarg_segment_ptr(); asm volatile("" : "+s"(p)); return p; }
__device__ __forceinline__ const float* kin(int i) { return *(const float* const KAS*)(kbase() + 8 * i); }
__device__ __forceinline__ float* kout() { return *(float* const KAS*)(kbase() + 240); }
__device__ __forceinline__ unsigned char* kws() { return *(unsigned char* const KAS*)(kbase() + 248); }
__device__ __forceinline__ int kstart() { return *(const int KAS*)(kbase() + 256); }
__device__ __forceinline__ int kstop() { return *(const int KAS*)(kbase() + 260); }
struct Frame { LAS unsigned char* lds; int tid, lane, wave, G, gw, NGW; };
__device__ __forceinline__ Frame make_frame(LAS unsigned char* lds) {
    Frame F; int tid = my_tid(); asm volatile("" : "+v"(tid)); int bx = blockIdx.x; asm volatile("" : "+s"(bx)); int G = gridDim.x; asm volatile("" : "+s"(G));
    F.lds = lds; F.tid = tid; F.lane = tid & 63; F.wave = __builtin_amdgcn_readfirstlane(tid >> 6); F.G = G; F.gw = bx * NWAVES + F.wave; F.NGW = G * NWAVES; return F;
}

__device__ const double ROPE_INV_FREQ[32] = {1, 0.74989420933245587, 0.56234132519034907, 0.42169650342858223, 0.31622776601683794, 0.23713737056616552, 0.17782794100389229, 0.1333521432163324, 0.10000000000000001, 0.074989420933245579, 0.056234132519034911, 0.042169650342858224, 0.031622776601683791, 0.023713737056616554, 0.017782794100389229, 0.013335214321633241, 0.01, 0.0074989420933245579, 0.005623413251903491, 0.0042169650342858229, 0.0031622776601683794, 0.0023713737056616554, 0.0017782794100389228, 0.0013335214321633241, 0.001, 0.00074989420933245586, 0.0005623413251903491, 0.00042169650342858224, 0.00031622776601683794, 0.00023713737056616554, 0.00017782794100389227, 0.0001333521432163324};
__device__ __forceinline__ void sincos_d(double a, float& s, float& c) {
    const double n = rint(a * 0.63661977236758134308);
    double r = fma(-n, 1.5707963267948966192, a); r = fma(-n, 6.123233995736766036e-17, r);
    const double r2 = r * r;
    double sp = -7.6471637318198164759e-13; sp = fma(sp, r2, 1.6059043836821614599e-10); sp = fma(sp, r2, -2.5052108385441718775e-08); sp = fma(sp, r2, 2.7557319223985890653e-06);
    sp = fma(sp, r2, -1.9841269841269841270e-04); sp = fma(sp, r2, 8.3333333333333333333e-03); sp = fma(sp, r2, -1.6666666666666666667e-01);
    const double sn = fma(sp * r2, r, r);
    double cp = 4.7794773323873852974e-14; cp = fma(cp, r2, -1.1470745597729724714e-11); cp = fma(cp, r2, 2.0876756987868098979e-09); cp = fma(cp, r2, -2.7557319223985890653e-07);
    cp = fma(cp, r2, 2.4801587301587301587e-05); cp = fma(cp, r2, -1.3888888888888888889e-03); cp = fma(cp, r2, 4.1666666666666666667e-02); cp = fma(cp, r2, -0.5);
    const double cs = fma(cp, r2, 1.0);
    const long long q = (long long)n & 3LL; double so, co;
    if (q == 0) { so = sn; co = cs; } else if (q == 1) { so = cs; co = -sn; } else if (q == 2) { so = -sn; co = -cs; } else { so = -cs; co = sn; }
    s = (float)so; c = (float)co;
}
__device__ __forceinline__ void transpose_item(const float* W, int ldw, int col0, int nblk, bf16* WT, int ldt, int row0, LAS float* scr, int item, int lane) {
    const int kb = item / nblk, nb = item % nblk, k0 = 64 * kb, n0 = 32 * nb;
#pragma unroll 8
    for (int i = 0; i < 32; ++i) { const int kk = 2 * i + (lane >> 5); scr[kk * 33 + (lane & 31)] = W[(size_t)(k0 + kk) * ldw + col0 + n0 + (lane & 31)]; }
    LDS_WAIT(); asm volatile("" ::: "memory");
    const int c = lane & 7;
#pragma unroll
    for (int j = 0; j < 4; ++j) { const int n = (lane >> 3) + 8 * j; const LAS float* s = scr + (8 * c) * 33 + n;
        v4u o; o.x = pk2(s[0 * 33], s[1 * 33]); o.y = pk2(s[2 * 33], s[3 * 33]); o.z = pk2(s[4 * 33], s[5 * 33]); o.w = pk2(s[6 * 33], s[7 * 33]);
        *(GAS v4u*)(WT + (size_t)(row0 + n0 + n) * ldt + k0 + 8 * c) = o; }
    LDS_WAIT(); asm volatile("" ::: "memory");
}
__device__ __forceinline__ void rope_table(LAS unsigned char* lds_) {
    const Frame F = make_frame(lds_); const int gt = F.gw * 64 + F.lane, NTH = F.NGW * 64;
    const int* pos = (const int*)kin(2); float* rope = (float*)(kws() + WS_ROPE);
    for (int i = gt; i < T * 32; i += NTH) { float s, c; sincos_d((double)pos[i >> 5] * ROPE_INV_FREQ[i & 31], s, c); rope[2 * (size_t)i] = c; rope[2 * (size_t)i + 1] = s; }
}
__device__ __forceinline__ void p0_prologue(LAS unsigned char* lds_, const Args& A, int l) {
    const Frame F = make_frame(lds_);
    LAS float* scr = (LAS float*)(F.lds + RING_OFF + F.wave * 16384);
    constexpr int I1 = 16 * 14, I2 = 16 * 48, I3 = 16 * 56, I4 = 16 * 96, I5 = 8 * 32, I6 = 8 * 32, I7 = 16 * 32, I8 = 16 * 128, I9 = 64 * 32, I10 = 16 * 32, I11 = 4 * 32;
    constexpr int NITEMS = I1 + I2 + I3 + I4 + I5 + I6 + I7 + I8 + I9 + I10 + I11;
#define WIN_ (kin(4) + (size_t)l * 1024 * IN_COLS)
#define WBR_ (kin(21) + (size_t)l * 1536 * 1024)
    for (int it = F.gw; it < NITEMS; it += F.NGW) {
        int r = it;
        if (r < I1) { transpose_item(WIN_, IN_COLS, 0, 14, (bf16*)(kws() + W_IN), 1024, 0, scr, r, F.lane); continue; } r -= I1;
        if (r < I2) { transpose_item(WIN_, IN_COLS, 2240, 48, (bf16*)(kws() + W_IN), 1024, 512, scr, r, F.lane); continue; } r -= I2;
        if (r < I3) { transpose_item(WIN_, IN_COLS, 448, 56, (bf16*)(kws() + W_IN), 1024, 2048, scr, r, F.lane); continue; } r -= I3;
        if (r < I4) { transpose_item(WIN_, IN_COLS, 3776, 96, (bf16*)(kws() + W_IN), 1024, 3840, scr, r, F.lane); continue; } r -= I4;
        if (r < I5) { transpose_item(WBR_ + (size_t)512 * 1024, 1024, 0, 32, (bf16*)(kws() + W_B) + (size_t)1024 * 512, 512, 0, scr, r, F.lane); continue; } r -= I5;
        if (r < I6) { transpose_item(WBR_ + (size_t)1024 * 1024, 1024, 0, 32, (bf16*)(kws() + W_B) + (size_t)2 * 1024 * 512, 512, 0, scr, r, F.lane); continue; } r -= I6;
        if (r < I7) { transpose_item(kin(22) + (size_t)l * 1024 * 1024, 1024, 0, 32, (bf16*)(kws() + W_OUT), 1024, 0, scr, r, F.lane); continue; } r -= I7;
        if (r < I8) { transpose_item(kin(25) + (size_t)l * 1024 * 4096, 4096, 0, 128, (bf16*)(kws() + W_1), 1024, 0, scr, r, F.lane); continue; } r -= I8;
        if (r < I9) { transpose_item(kin(26) + (size_t)l * 4096 * 1024, 1024, 0, 32, (bf16*)(kws() + W_2), 4096, 0, scr, r, F.lane); continue; } r -= I9;
        if (r < I10) { transpose_item(kin(28) + (size_t)l * 1024 * 1024, 1024, 0, 32, (bf16*)(kws() + W_G), 1024, 0, scr, r, F.lane); continue; } r -= I10;
        transpose_item(kin(29) + (size_t)l * 256 * 1024, 1024, 0, 32, (bf16*)(kws() + W_P), 256, 0, scr, r, F.lane);
    }
    const int gt = F.gw * 64 + F.lane, NTH = F.NGW * 64;
    { bf16* WinT = (bf16*)(kws() + W_IN); for (int i = gt; i < 64 * 1024; i += NTH) WinT[(size_t)448 * 1024 + i] = 0; }
    { const float* w_uq = kin(7) + (size_t)l * 256 * 768; const float* w_ukv = kin(8) + (size_t)l * 128 * 1024; bf16* WqT = (bf16*)(kws() + W_Q);
      for (int i = gt; i < 768 * 256; i += NTH) {
        const int n = i >> 8, kq = i & 255, h = n / 192, ii = n % 192; float s;
        if (ii < 128) { s = 0.f; const float* a = w_uq + (size_t)kq * 768 + h * 192; const float* b = w_ukv + (size_t)ii * 1024 + h * 256;
            for (int nn = 0; nn < 128; ++nn) s = fmaf(a[nn], b[nn], s); }
        else { const int jj = ii - 128, j = jj >> 1; s = w_uq[(size_t)kq * 768 + h * 192 + 128 + ((jj & 1) ? j + 32 : j)]; }
        WqT[i] = (bf16)f2bf(s);
      } }
    { const float* w_ukv = kin(8) + (size_t)l * 128 * 1024; const float* w_br = WBR_; bf16* WbT = (bf16*)(kws() + W_B);
      for (int i = gt; i < 512 * 1024; i += NTH) {
        const int dd = i & 1023, hl = i >> 10, h = hl >> 7, lat = hl & 127; float s = 0.f;
        const float* a = w_ukv + (size_t)lat * 1024 + h * 256 + 128; const float* b = w_br + (size_t)(h * 128) * 1024 + dd;
        for (int v = 0; v < 128; ++v) s = fmaf(a[v], b[(size_t)v * 1024], s);
        WbT[(size_t)dd * 512 + hl] = (bf16)f2bf(s);
      } }
    { const float* w_up = kin(11) + (size_t)l * 64 * 512; const float* a_up = kin(13) + (size_t)l * 64 * 512; const float* g_up = kin(14) + (size_t)l * 128 * 512; bf16* WloT = (bf16*)(kws() + W_LORA);
      for (int i = gt; i < 1536 * 256; i += NTH) {
        const int n = i >> 8, k = i & 255, blk = n >> 9, nn = n & 511; float s = 0.f;
        if (blk == 0) { if (k < 64) s = w_up[(size_t)k * 512 + nn]; } else if (blk == 1) { if (k >= 64 && k < 128) s = a_up[(size_t)(k - 64) * 512 + nn]; } else { if (k >= 128) s = g_up[(size_t)(k - 128) * 512 + nn]; }
        WloT[i] = (bf16)f2bf(s);
      } }
#undef WIN_
#undef WBR_
}
__device__ __forceinline__ void u_rowpass(LAS unsigned char* lds_, int l, bool from_x) {
    const Frame F = make_frame(lds_); unsigned char* ws = kws();
    const float* g = kin(3) + l * 1024; bf16* U = (bf16*)(ws + WS_U); bf16* H16 = (bf16*)((unsigned char*)kout() + DO_H16);
    f32x4 gv[4];
#pragma unroll
    for (int j = 0; j < 4; ++j) gv[j] = *(const f32x4*)(g + 4 * F.lane + 256 * j);
    for (int m = F.gw; m < T; m += F.NGW) {
        f32x4 v[4]; float s = 0.f;
        if (from_x) { const f32x4* xr = (const f32x4*)(kin(0) + (size_t)m * D) + F.lane; v2u* ho = (v2u*)(H16 + (size_t)m * D) + F.lane;
#pragma unroll
            for (int j = 0; j < 4; ++j) { v[j] = xr[64 * j]; v2u w; w.x = pk2(v[j].x, v[j].y); w.y = pk2(v[j].z, v[j].w); ho[64 * j] = w; } }
        else { const v2u* hr = (const v2u*)(H16 + (size_t)m * D) + F.lane;
#pragma unroll
            for (int j = 0; j < 4; ++j) { const v2u w = hr[64 * j]; v[j] = (f32x4){bfl(w.x), bfh(w.x), bfl(w.y), bfh(w.y)}; } }
#pragma unroll
        for (int j = 0; j < 4; ++j) s += (v[j].x * v[j].x + v[j].y * v[j].y) + (v[j].z * v[j].z + v[j].w * v[j].w);
        const float rs = rsqrtf(wave_sum(s, F.lane) * (1.f / D) + NORM_EPS);
        v2u* o8 = (v2u*)(U + (size_t)m * D) + F.lane;
#pragma unroll
        for (int j = 0; j < 4; ++j) { const f32x4 y = v[j] * rs * gv[j]; v2u w; w.x = pk2(y.x, y.y); w.y = pk2(y.z, y.w); o8[64 * j] = w; }
    }
}
__device__ __forceinline__ void p2_mla_prep(LAS unsigned char* lds_, const Args& A, int l) {
    const Frame F = make_frame(lds_);
    const bf16* ZM = (const bf16*)(kws() + WS_OA); bf16* QN = (bf16*)(kws() + X_QN); bf16* KV = (bf16*)(kws() + X_KV); const float* rope = (const float*)(kws() + WS_ROPE);
    const f32x4 gq = *(const f32x4*)(kin(5) + l * 256 + 4 * F.lane); const float gk0 = kin(6)[l * 128 + 2 * F.lane], gk1 = kin(6)[l * 128 + 2 * F.lane + 1];
    for (int t = F.gw; t < T; t += F.NGW) {
        const bf16* z = ZM + (size_t)t * 512;
        const v2u wq = *(const v2u*)(z + 4 * F.lane); const unsigned wk = *(const unsigned*)(z + 256 + 2 * F.lane); const float kr = bfl((unsigned)z[384 + F.lane]);
        const float q0 = bfl(wq.x), q1 = bfh(wq.x), q2 = bfl(wq.y), q3 = bfh(wq.y), k0 = bfl(wk), k1 = bfh(wk);
        const float rq = rsqrtf(wave_sum(q0 * q0 + q1 * q1 + q2 * q2 + q3 * q3, F.lane) * (1.f / 256.f) + NORM_EPS);
        const float rk = rsqrtf(wave_sum(k0 * k0 + k1 * k1, F.lane) * (1.f / 128.f) + NORM_EPS);
        v2u o; o.x = pk2(q0 * rq * gq.x, q1 * rq * gq.y); o.y = pk2(q2 * rq * gq.z, q3 * rq * gq.w);
        *(v2u*)(QN + (size_t)t * 256 + 4 * F.lane) = o;
        *(unsigned*)(KV + (size_t)t * 192 + 2 * F.lane) = pk2(k0 * rk * gk0, k1 * rk * gk1);
        const float other = shfl_xor_f(kr, 32, F.lane);
        if (F.lane < 32) { const float c = rope[((size_t)t * 32 + F.lane) * 2], s = rope[((size_t)t * 32 + F.lane) * 2 + 1];
            *(unsigned*)(KV + (size_t)t * 192 + 128 + 2 * F.lane) = pk2(kr * c - other * s, other * c + kr * s); }
    }
}
__device__ __forceinline__ void p6_rw_prep(LAS unsigned char* lds_, const Args& A, int l) {
    const Frame F = make_frame(lds_);
    const bf16* ZR = (const bf16*)(kws() + X_ZR); bf16* LA = (bf16*)(kws() + X_LA);
    const f32x4 mu = *(const f32x4*)(kin(9) + l * RW_COLS + 1536 + 4 * F.lane);
    for (int t = F.gw; t < T; t += F.NGW) {
        const v2u wc = *(const v2u*)(ZR + (size_t)t * 1792 + 1536 + 4 * F.lane); v2u wp; wp.x = 0u; wp.y = 0u;
        if ((t & (SEQ - 1)) != 0) wp = *(const v2u*)(ZR + (size_t)(t - 1) * 1792 + 1536 + 4 * F.lane);
        float z[4] = {bfl(wc.x), bfh(wc.x), bfl(wc.y), bfh(wc.y)}; const float p[4] = {bfl(wp.x), bfh(wp.x), bfl(wp.y), bfh(wp.y)}; const float m[4] = {mu.x, mu.y, mu.z, mu.w};
#pragma unroll
        for (int e = 0; e < 4; ++e) { float v = z[e] + (p[e] - z[e]) * m[e]; if (F.lane < 16) v = 1.f - 2.f * __builtin_amdgcn_rcpf(1.f + __builtin_amdgcn_exp2f(2.f * LOG2E * v)); else if (F.lane >= 32) v = fsig(v); z[e] = v; }
        v2u o; o.x = pk2(z[0], z[1]); o.y = pk2(z[2], z[3]); *(v2u*)(LA + (size_t)t * 256 + 4 * F.lane) = o;
    }
}
template <int MODE>
__device__ __forceinline__ void rowpass(LAS unsigned char* lds_, const Args& A, const bf16* M, const float* g1, const float* g2, const float* pl) {
    const Frame F = make_frame(lds_);
    bf16* U = (bf16*)(kws() + WS_U); bf16* PB = (bf16*)(kws() + X_PB); bf16* H16 = (bf16*)((unsigned char*)kout() + DO_H16);
    f32x4 g1v[4], g2v[4];
#pragma unroll
    for (int j = 0; j < 4; ++j) { g1v[j] = *(const f32x4*)(g1 + 4 * F.lane + 256 * j); if (MODE == 0) g2v[j] = *(const f32x4*)(g2 + 4 * F.lane + 256 * j); }
    for (int m = F.gw; m < T; m += F.NGW) {
        const v2u* mr = (const v2u*)(M + (size_t)m * D) + F.lane; v2u* hr = (v2u*)(H16 + (size_t)m * D) + F.lane;
        f32x4 x[4], hv[4]; float s = 0.f;
#pragma unroll
        for (int j = 0; j < 4; ++j) { const v2u w = mr[64 * j]; x[j] = (f32x4){bfl(w.x), bfh(w.x), bfl(w.y), bfh(w.y)}; const v2u hw = hr[64 * j]; hv[j] = (f32x4){bfl(hw.x), bfh(hw.x), bfl(hw.y), bfh(hw.y)};
            s += (x[j].x * x[j].x + x[j].y * x[j].y) + (x[j].z * x[j].z + x[j].w * x[j].w); }
        const float rs = rsqrtf(wave_sum(s, F.lane) * (1.f / D) + NORM_EPS); float s2 = 0.f;
#pragma unroll
        for (int j = 0; j < 4; ++j) { hv[j] = hv[j] + x[j] * rs * g1v[j]; v2u w; w.x = pk2(hv[j].x, hv[j].y); w.y = pk2(hv[j].z, hv[j].w); hr[64 * j] = w;
            s2 += (hv[j].x * hv[j].x + hv[j].y * hv[j].y) + (hv[j].z * hv[j].z + hv[j].w * hv[j].w); }
        if (MODE == 0) { const float rs2 = rsqrtf(wave_sum(s2, F.lane) * (1.f / D) + NORM_EPS); v2u* o8 = (v2u*)(U + (size_t)m * D) + F.lane;
#pragma unroll
            for (int j = 0; j < 4; ++j) { const f32x4 y = hv[j] * rs2 * g2v[j]; v2u w; w.x = pk2(y.x, y.y); w.y = pk2(y.z, y.w); o8[64 * j] = w; } }
        else { v2u* o8 = (v2u*)(U + (size_t)m * D) + F.lane;
#pragma unroll
            for (int j = 0; j < 4; ++j) { v2u w; w.x = pk2(hv[j].x, hv[j].y); w.y = pk2(hv[j].z, hv[j].w); o8[64 * j] = w; }
            const f32x4 pv = *((const f32x4*)(pl + (size_t)m * DPLE) + F.lane); v2u w; w.x = pk2(pv.x, pv.y); w.y = pk2(pv.z, pv.w); *((v2u*)(PB + (size_t)m * DPLE) + F.lane) = w; }
    }
}
namespace rw {
typedef short v4i16_t __attribute__((ext_vector_type(4)));
constexpr int RS = 144;
constexpr int O_AT = 0, O_BT = 9216, O_KT = 18432, O_RT = 27648;
constexpr int O_UV = 36864;
constexpr int O_BK = O_UV + 4 * 32 * RS;
constexpr int O_SB = O_BK + 4 * 32 * RS;
constexpr int O_W1 = O_SB + 64 * RS;
constexpr int O_SM = O_W1 + 64 * RS;
constexpr int O_GC = O_SM + 16 * 1024;
constexpr int O_CB = O_GC + 1024;
constexpr int O_LM = O_CB + 256;
constexpr int O_YO = O_LM + 4096;
constexpr int O_PAR = O_YO + 64 * RS;
constexpr int LDS_END = O_PAR + 512;
static_assert(LDS_END <= RING_BYTES, "rwkv LDS map");
__device__ __forceinline__ bf16x8 trfrag(const LAS unsigned char* p) {
    const s16x4 lo = __builtin_bit_cast(s16x4, __builtin_amdgcn_ds_read_tr16_b64_v4i16((LAS v4i16_t*)p));
    const s16x4 hh = __builtin_bit_cast(s16x4, __builtin_amdgcn_ds_read_tr16_b64_v4i16((LAS v4i16_t*)(p + 4 * RS)));
    return (bf16x8){lo[0], lo[1], lo[2], lo[3], hh[0], hh[1], hh[2], hh[3]};
}
__device__ __forceinline__ unsigned pk_rtz(float lo, float hi) { typedef __fp16 hp2 __attribute__((ext_vector_type(2))); const hp2 v = __builtin_amdgcn_cvt_pkrtz(lo, hi); return __builtin_bit_cast(unsigned, v); }
typedef _Float16 h16x4_t __attribute__((ext_vector_type(4)));
__device__ __forceinline__ h16x4_t tr4(const LAS unsigned char* p) { return __builtin_bit_cast(h16x4_t, __builtin_amdgcn_ds_read_tr16_b64_v4i16((LAS v4i16_t*)p)); }
__device__ __forceinline__ h16x4_t ld4h(const LAS unsigned char* p) { return *(const LAS h16x4_t*)p; }
__device__ __forceinline__ h16x4_t acc2h(const f32x4 v) { typedef unsigned u2 __attribute__((ext_vector_type(2))); u2 w; w.x = pk_rtz(v[0], v[1]); w.y = pk_rtz(v[2], v[3]); return __builtin_bit_cast(h16x4_t, w); }
__device__ __forceinline__ f32x4 MFMA4(h16x4_t a, h16x4_t b, f32x4 c) { return __builtin_amdgcn_mfma_f32_16x16x16f16(a, b, c, 0, 0, 0); }
__device__ __forceinline__ void lbar() { asm volatile("s_waitcnt lgkmcnt(0)\n\ts_barrier" ::: "memory"); }
__device__ __forceinline__ void st_bf(LAS unsigned char* p, float x) { *(LAS unsigned short*)p = (unsigned short)h_f2h(__builtin_amdgcn_fmed3f(x, -60000.f, 60000.f)); }
__device__ __forceinline__ void st2(LAS unsigned char* p0, LAS unsigned char* p1, float x0, float x1) { const unsigned w = pk_rtz(x0, x1); *(LAS unsigned short*)p0 = (unsigned short)w; *(LAS unsigned short*)p1 = (unsigned short)(w >> 16); }
__device__ __forceinline__ void st4(LAS unsigned char* p, int stride, const f32x4 v) { st2(p, p + stride, v[0], v[1]); st2(p + 2 * stride, p + 3 * stride, v[2], v[3]); }
__device__ __forceinline__ float ld_bf(const LAS unsigned char* p) { return bfl((unsigned)*(const LAS unsigned short*)p); }
template <int CTRL> __device__ __forceinline__ float dpp_add(float v) { return v + __int_as_float(__builtin_amdgcn_update_dpp(0, __float_as_int(v), CTRL, 0xf, 0xf, true)); }
__device__ __forceinline__ void wsum8(float (&v)[8], int lane) {
#pragma unroll
    for (int e = 0; e < 8; ++e) { float x = v[e]; x = dpp_add<0xB1>(x); x = dpp_add<0x4E>(x); x = dpp_add<0x141>(x); x = dpp_add<0x140>(x); v[e] = x; }
#pragma unroll
    for (int e = 0; e < 8; ++e) v[e] += shfl_xor_f(v[e], 16, lane);
#pragma unroll
    for (int e = 0; e < 8; ++e) v[e] += shfl_xor_f(v[e], 32, lane);
}
__device__ __forceinline__ void wsum16(float (&a)[8], float (&b)[8], int lane) {
#pragma unroll
    for (int e = 0; e < 8; ++e) { float x = a[e]; x = dpp_add<0xB1>(x); x = dpp_add<0x4E>(x); x = dpp_add<0x141>(x); x = dpp_add<0x140>(x); a[e] = x;
                                  float y = b[e]; y = dpp_add<0xB1>(y); y = dpp_add<0x4E>(y); y = dpp_add<0x141>(y); y = dpp_add<0x140>(y); b[e] = y; }
    float ta[8], tb[8];
#pragma unroll
    for (int e = 0; e < 8; ++e) { ta[e] = shfl_xor_f(a[e], 16, lane); tb[e] = shfl_xor_f(b[e], 16, lane); }
#pragma unroll
    for (int e = 0; e < 8; ++e) { a[e] += ta[e]; b[e] += tb[e]; }
#pragma unroll
    for (int e = 0; e < 8; ++e) { ta[e] = shfl_xor_f(a[e], 32, lane); tb[e] = shfl_xor_f(b[e], 32, lane); }
#pragma unroll
    for (int e = 0; e < 8; ++e) { a[e] += ta[e]; b[e] += tb[e]; }
}
__device__ __forceinline__ void rw_unit(LAS unsigned char* lds, int l, int seq) {
    int tid_ = my_tid(); asm volatile("" : "+v"(tid_));
    const int tid = tid_, lane = tid & 63, w = __builtin_amdgcn_readfirstlane(tid >> 6), g4 = lane >> 4, l15 = lane & 15, q4 = l15 >> 2, p4 = lane & 3;
    const int b = seq >> 3, h = seq & 7;
    const bf16* ZRb = (const bf16*)(kws() + X_ZR) + (size_t)b * SEQ * 1792 + h * 64;
    const bf16* TWb = (const bf16*)(kws() + X_TW) + (size_t)b * SEQ * 512 + h * 64; const bf16* TAb = (const bf16*)((const unsigned char*)kout() + DO_TA) + (size_t)b * SEQ * 512 + h * 64; const bf16* Gb = (const bf16*)((const unsigned char*)kout() + DO_G) + (size_t)b * SEQ * 512 + h * 64;
    bf16* ORWb = (bf16*)(kws() + WS_ORW) + (size_t)b * SEQ * 512 + h * 64;
    LAS float* par = (LAS float*)(lds + O_PAR);
    const int pc = h * 64 + lane;
    const float mu_r = kin(9)[l * RW_COLS + pc], mu_k = kin(9)[l * RW_COLS + 512 + pc], mu_v = kin(9)[l * RW_COLS + 1024 + pc];
    const float k_k = kin(15)[l * 512 + pc], k_a = kin(16)[l * 512 + pc], r_k = kin(17)[l * 512 + pc];
    if (tid < 64) { par[tid] = kin(18)[l * 512 + pc]; par[64 + tid] = kin(19)[l * 512 + pc]; }
    for (int i = tid; i < (O_GC - O_UV) / 4; i += 512) ((LAS unsigned*)(lds + O_UV))[i] = 0u;
    f32x4 ST[4] = {{0.f, 0.f, 0.f, 0.f}, {0.f, 0.f, 0.f, 0.f}, {0.f, 0.f, 0.f, 0.f}, {0.f, 0.f, 0.f, 0.f}};
    __syncthreads();
    const int et = tid >> 3, ecg = tid & 7, ei = et >> 4, ett = et & 15;
    const int trrow = 8 * g4 + q4, trrow1 = 8 * (g4 & 1) + q4, trcol = 8 * p4;
    const int ei2 = w >> 1, ehf = w & 1;
    unsigned ptw[16], pcr[8], pck[8], pcv[8], pta[8], ppr, ppk, ppv; v4u pgg;
#define RW_LOADS(TOK0) do { const size_t r0_ = (size_t)(TOK0) + 16 * ei2, rA_ = r0_ + 8 * ehf; \
        _Pragma("unroll") for (int s = 0; s < 16; ++s) ptw[s] = (unsigned)TWb[(r0_ + s) * 512 + lane]; \
        _Pragma("unroll") for (int tt = 0; tt < 8; ++tt) { const bf16* zc_ = ZRb + (rA_ + tt) * 1792 + lane; pcr[tt] = (unsigned)zc_[0]; pck[tt] = (unsigned)zc_[512]; pcv[tt] = (unsigned)zc_[1024]; pta[tt] = (unsigned)TAb[(rA_ + tt) * 512 + lane]; } \
        { const bf16* zp_ = ZRb + (rA_ > 0 ? rA_ - 1 : 0) * 1792 + lane; ppr = (unsigned)zp_[0]; ppk = (unsigned)zp_[512]; ppv = (unsigned)zp_[1024]; if (rA_ == 0) { ppr = 0u; ppk = 0u; ppv = 0u; } } \
        pgg = *(const v4u*)(Gb + (size_t)((TOK0) + et) * 512 + 8 * ecg); } while (0)
    RW_LOADS(0);
    for (int sc = 0; sc < SEQ / 64; ++sc) {
        const int tok0 = sc * 64;
        unsigned twv[16], ucr[8], uck[8], ucv[8], uta[8], upr, upk, upv; v4u ugg;
        {
#pragma unroll
            for (int s = 0; s < 16; ++s) twv[s] = ptw[s];
#pragma unroll
            for (int tt = 0; tt < 8; ++tt) { ucr[tt] = pcr[tt]; uck[tt] = pck[tt]; ucv[tt] = pcv[tt]; uta[tt] = pta[tt]; }
            upr = ppr; upk = ppk; upv = ppv; ugg = pgg;
        }
        {   const int c = lane;
            float cumLo[8], cumHi[8];
            {   asm volatile("" : "+v"(twv[0]), "+v"(twv[1]), "+v"(twv[2]), "+v"(twv[3]), "+v"(twv[4]), "+v"(twv[5]), "+v"(twv[6]), "+v"(twv[7]), "+v"(twv[8]), "+v"(twv[9]), "+v"(twv[10]), "+v"(twv[11]), "+v"(twv[12]), "+v"(twv[13]), "+v"(twv[14]), "+v"(twv[15]));
                float run = 0.f;
#pragma unroll
                for (int s = 0; s < 16; ++s) { run += bfl(twv[s]); if (s < 8) cumLo[s] = run; else cumHi[s - 8] = run; } }
            const float tot = cumHi[7];
            const float fh = ehf ? 1.f : 0.f;
            const float gctot = __builtin_amdgcn_exp2f(LOG2E * tot);
            if (ehf == 0) ((LAS float*)(lds + O_GC))[ei2 * 64 + c] = gctot;
            float pr = bfl(upr), pk = bfl(upk), pv = bfl(upv);
            float rr[8], kkv[8], av[8], kmv[8], vv[8], ss[8], cbv[8];
            {   float cr[8], ck[8], cv[8], ta[8];
                asm volatile("" : "+v"(ucr[0]), "+v"(ucr[1]), "+v"(ucr[2]), "+v"(ucr[3]), "+v"(ucr[4]), "+v"(ucr[5]), "+v"(ucr[6]), "+v"(ucr[7]), "+v"(uck[0]), "+v"(uck[1]), "+v"(uck[2]), "+v"(uck[3]), "+v"(uck[4]), "+v"(uck[5]), "+v"(uck[6]), "+v"(uck[7]),
                                  "+v"(ucv[0]), "+v"(ucv[1]), "+v"(ucv[2]), "+v"(ucv[3]), "+v"(ucv[4]), "+v"(ucv[5]), "+v"(ucv[6]), "+v"(ucv[7]));
                asm volatile("" : "+v"(uta[0]), "+v"(uta[1]), "+v"(uta[2]), "+v"(uta[3]), "+v"(uta[4]), "+v"(uta[5]), "+v"(uta[6]), "+v"(uta[7]));
#pragma unroll
                for (int tt = 0; tt < 8; ++tt) { cr[tt] = bfl(ucr[tt]); ck[tt] = bfl(uck[tt]); cv[tt] = bfl(ucv[tt]); ta[tt] = bfl(uta[tt]); }
#pragma unroll
                for (int tt = 0; tt < 8; ++tt) {
                    const float r = cr[tt] + (pr - cr[tt]) * mu_r, k = ck[tt] + (pk - ck[tt]) * mu_k, v = cv[tt] + (pv - cv[tt]) * mu_v; pr = cr[tt]; pk = ck[tt]; pv = cv[tt];
                    const float a = ta[tt], kk = k * k_k, km = k * (1.f + (a - 1.f) * k_a);
                    rr[tt] = r; kkv[tt] = kk; av[tt] = a; kmv[tt] = km; vv[tt] = v; ss[tt] = kk * kk; cbv[tt] = r * km * r_k; } }
            wsum16(ss, cbv, lane);
            float ggprev = 1.f;
#pragma unroll
            for (int tt = 0; tt < 8; ++tt) { const int t = 8 * ehf + tt;
                const float cu = cumLo[tt] + fh * (cumHi[tt] - cumLo[tt]); const float pl = tt ? cumLo[tt - 1] : 0.f, ph = tt ? cumHi[tt - 1] : cumLo[7]; const float cprev = pl + fh * (ph - pl);
                const float gg = __builtin_amdgcn_exp2f(LOG2E * cu), gp = (tt == 0) ? __builtin_amdgcn_exp2f(LOG2E * cprev) : ggprev, gi = __builtin_amdgcn_exp2f(-LOG2E * cu), gh = gctot * gi; ggprev = gg;
                const float kn = kkv[tt] * rsqrtf(fmaxf(ss[tt], 1e-24f)), ka = kn * av[tt];
                const int ro = (16 * ei2 + t) * RS + 2 * c;
                st2(lds + O_BT + ro, lds + O_KT + ro, __builtin_amdgcn_fmed3f(ka * gi, -60000.f, 60000.f), __builtin_amdgcn_fmed3f(kmv[tt] * gi, -60000.f, 60000.f));
                st2(lds + O_AT + ro, lds + O_RT + ro, -kn * gp, rr[tt] * gg);
                st2(lds + O_BK + (ei2 * 32 + t) * RS + 2 * c, lds + O_BK + (ei2 * 32 + 16 + t) * RS + 2 * c, ka * gh, kmv[tt] * gh);
                *(LAS unsigned short*)(lds + O_UV + (ei2 * 32 + 16 + t) * RS + 2 * c) = (unsigned short)h_f2h(vv[tt]);
                if (c == 0) ((LAS float*)(lds + O_CB))[16 * ei2 + t] = cbv[tt]; }
        }
        { const int nxt = (sc + 1 < SEQ / 64) ? tok0 + 64 : tok0; RW_LOADS(nxt); }
        lbar();
        {   const int i = w & 3, hf = w >> 2;
            const LAS unsigned char* xa = lds + (hf ? O_RT : O_AT) + (16 * i + l15) * RS + 16 * g4;
            const LAS unsigned char* xb = lds + O_BT + (16 * i + l15) * RS + 16 * g4; const LAS unsigned char* xk = lds + O_KT + (16 * i + l15) * RS + 16 * g4;
            f32x4 c1 = {0.f, 0.f, 0.f, 0.f}, c2 = {0.f, 0.f, 0.f, 0.f};
#pragma unroll
            for (int ks = 0; ks < 2; ++ks) { const bf16x8 a = *(const LAS bf16x8*)(xa + 64 * ks);
                c1 = MFMA16(a, *(const LAS bf16x8*)(xb + 64 * ks), c1);
                c2 = MFMA16(a, *(const LAS bf16x8*)(xk + 64 * ks), c2); }
#pragma unroll
            for (int r = 0; r < 4; ++r) { const int t = 4 * g4 + r; const bool keep = hf ? (l15 <= t) : (l15 < t); const float v1 = keep ? c1[r] : 0.f, v2 = keep ? c2[r] : 0.f;
                if (hf == 0) { ((LAS float*)(lds + O_LM))[(i * 16 + t) * 16 + l15] = v1; *(LAS unsigned short*)(lds + O_SM + (4 + i) * 1024 + t * 64 + 2 * l15) = (unsigned short)h_f2h(v2); }
                else st2(lds + O_SM + (8 + i) * 1024 + t * 64 + 2 * l15, lds + O_SM + (12 + i) * 1024 + t * 64 + 2 * l15, v1, v2); }
        }
        lbar();
        if (w < 4) { if (lane < 16) { const LAS float* Lm = (const LAS float*)(lds + O_LM) + w * 256; float acc[16];
#pragma unroll
                for (int t = 0; t < 16; ++t) acc[t] = (t == lane) ? 1.f : 0.f;
#pragma unroll
                for (int s = 0; s < 15; ++s) { const float xs = acc[s];
#pragma unroll
                    for (int t = s + 1; t < 16; ++t) acc[t] = fmaf(Lm[t * 16 + s], xs, acc[t]); }
#pragma unroll
                for (int t = 0; t < 16; t += 2) st2(lds + O_SM + w * 1024 + t * 64 + 2 * lane, lds + O_SM + w * 1024 + (t + 1) * 64 + 2 * lane, acc[t], acc[t + 1]); } }
        else { const int i = w - 4; const bf16x8 am = *(const LAS bf16x8*)(lds + O_SM + (4 + i) * 1024 + l15 * 64 + 16 * g4);
#pragma unroll
            for (int ct = 0; ct < 4; ++ct) { f32x4 acc = {0.f, 0.f, 0.f, 0.f};
                acc = MFMA16(am, trfrag(lds + O_UV + (i * 32 + 16 + trrow1) * RS + 32 * ct + trcol), acc);
st4(lds + O_W1 + (16 * i + 4 * g4) * RS + 2 * (16 * ct + l15), RS, acc); } }
        lbar();
        f32x4 wy[4];
        {   const int ct = w & 3; const int base = (w < 4) ? O_W1 : O_AT;
            bf16x8 tm[4], fb[4];
#pragma unroll
            for (int i = 0; i < 4; ++i) { tm[i] = *(const LAS bf16x8*)(lds + O_SM + i * 1024 + l15 * 64 + 16 * g4); fb[i] = trfrag(lds + base + (16 * i + trrow1) * RS + 32 * ct + trcol); }
#pragma unroll
            for (int i = 0; i < 4; ++i) { f32x4 acc = {0.f, 0.f, 0.f, 0.f}; wy[i] = MFMA16(tm[i], fb[i], acc); }
#pragma unroll
            for (int i = 0; i < 4; ++i) st4(lds + base + (16 * i + 4 * g4) * RS + 2 * (16 * ct + l15), RS, wy[i]); }
        lbar();
        {   const int ct = w & 3;
#pragma unroll
            for (int ih = 0; ih < 4; ih += 2) {
                bf16x8 arb[2], f1[2], ark[2], f2[2]; f32x4 cacc[2];
#pragma unroll
                for (int ii = 0; ii < 2; ++ii) { const int i = ih + ii; arb[ii] = *(const LAS bf16x8*)(lds + O_SM + (8 + i) * 1024 + l15 * 64 + 16 * g4);
                    if (w >= 4) { ark[ii] = *(const LAS bf16x8*)(lds + O_SM + (12 + i) * 1024 + l15 * 64 + 16 * g4);
                        f1[ii] = trfrag(lds + O_W1 + (16 * i + trrow1) * RS + 32 * ct + trcol); f2[ii] = trfrag(lds + O_UV + (i * 32 + 16 + trrow1) * RS + 32 * ct + trcol); cacc[ii] = (f32x4){0.f, 0.f, 0.f, 0.f}; }
                    else { f1[ii] = trfrag(lds + O_AT + (16 * i + trrow1) * RS + 32 * ct + trcol);
#pragma unroll
                        for (int r = 0; r < 4; ++r) cacc[ii][r] = ld_bf(lds + O_RT + (16 * i + 4 * g4 + r) * RS + 2 * (16 * ct + l15)); } }
#pragma unroll
                for (int ii = 0; ii < 2; ++ii) { cacc[ii] = MFMA16(arb[ii], f1[ii], cacc[ii]); if (w >= 4) cacc[ii] = MFMA16(ark[ii], f2[ii], cacc[ii]); }
#pragma unroll
                for (int ii = 0; ii < 2; ++ii) st4(lds + ((w >= 4) ? O_YO : O_RT) + (16 * (ih + ii) + 4 * g4) * RS + 2 * (16 * ct + l15), RS, cacc[ii]);
            } }
        lbar();
        if (w < 4) {
            const int v0 = 16 * w;
#pragma unroll
            for (int i = 0; i < 4; ++i) {
                h16x4_t sb[4];
#pragma unroll
                for (int kt = 0; kt < 4; ++kt) sb[kt] = acc2h(ST[kt]);
                f32x4 u = wy[i], y;
#pragma unroll
                for (int r = 0; r < 4; ++r) y[r] = ld_bf(lds + O_YO + (16 * i + 4 * g4 + r) * RS + 2 * (v0 + l15));
                const LAS unsigned char* pa = lds + O_AT + (16 * i + l15) * RS + 8 * g4; const LAS unsigned char* pq = lds + O_RT + (16 * i + l15) * RS + 8 * g4;
#pragma unroll
                for (int kt = 0; kt < 4; ++kt) { u = MFMA4(ld4h(pa + 32 * kt), sb[kt], u); y = MFMA4(ld4h(pq + 32 * kt), sb[kt], y); }
                st4(lds + O_YO + (16 * i + 4 * g4) * RS + 2 * (v0 + l15), RS, y);
                const h16x4_t ub = acc2h(u), vb = tr4(lds + O_UV + (i * 32 + 16 + 4 * g4 + q4) * RS + 2 * v0 + trcol);
#pragma unroll
                for (int kt = 0; kt < 4; ++kt) { const f32x4 gc = *(const LAS f32x4*)(lds + O_GC + (i * 64 + 16 * kt + 4 * g4) * 4);
                    f32x4 acc = ST[kt] * gc;
                    acc = MFMA4(tr4(lds + O_BK + (i * 32 + 4 * g4 + q4) * RS + 32 * kt + trcol), ub, acc);
                    acc = MFMA4(tr4(lds + O_BK + (i * 32 + 16 + 4 * g4 + q4) * RS + 32 * kt + trcol), vb, acc);
                    ST[kt] = acc; }
            }
        }
        lbar();
        {   float y[8], vv[8], gg[8];
            pg8::unpack8(*(const LAS v4u*)(lds + O_YO + et * RS + 16 * ecg), y); pg8::unpack8(*(const LAS v4u*)(lds + O_UV + (ei * 32 + 16 + ett) * RS + 16 * ecg), vv);
            pg8::unpack8(ugg, gg);
            float s = 0.f;
#pragma unroll
            for (int e = 0; e < 8; ++e) s += y[e];
            s = dpp_add<0xB1>(s); s = dpp_add<0x4E>(s); s = dpp_add<0x141>(s);
            const float mean = s * (1.f / 64.f); float q = 0.f;
#pragma unroll
            for (int e = 0; e < 8; ++e) { y[e] -= mean; q += y[e] * y[e]; }
            q = dpp_add<0xB1>(q); q = dpp_add<0x4E>(q); q = dpp_add<0x141>(q);
            const float rstd = rsqrtf(q * (1.f / 64.f) + RW_LN_EPS), cb = ((const LAS float*)(lds + O_CB))[et];
            float o[8];
#pragma unroll
            for (int e = 0; e < 8; ++e) { const int c = 8 * ecg + e; o[e] = (y[e] * rstd * par[c] + par[64 + c] + cb * vv[e]) * gg[e]; }
            v4u wo; wo.x = pk2(o[0], o[1]); wo.y = pk2(o[2], o[3]); wo.z = pk2(o[4], o[5]); wo.w = pk2(o[6], o[7]);
            *(v4u*)(ORWb + (size_t)(tok0 + et) * 512 + 8 * ecg) = wo;
        }
        lbar();
    }
}
}
#ifndef PROBE_QREP
#define PROBE_QREP 1
#endif
#ifndef PROBE_MASK
#define PROBE_MASK 0
#endif
__global__ void __launch_bounds__(NWAVES * 64, 2) mk_fwd(Args args) {
    extern __shared__ __attribute__((aligned(16))) unsigned char lds[];
    LAS unsigned char* const L = (LAS unsigned char*)lds;
    for (int u = threadIdx.x; u < (LDS_BYTES - LDSCTL_OFF) / 4; u += NWAVES * 64) ((LAS unsigned*)(L + LDSCTL_OFF))[u] = 0u;
    __syncthreads();
    static_assert(LDSCTL_OFF == MK_WAVETAB_LDS, "wave table address");
    if ((threadIdx.x & 63) == 0) ((LAS unsigned*)(L + LDSCTL_OFF))[(unsigned)__builtin_amdgcn_s_getreg((5 << 11) | 4) & 63u] = threadIdx.x >> 6;
    __syncthreads();
    XcdBarrier bar = xcd_barrier_post((unsigned*)(kws() + WS_CTL) + CW_BAR, (volatile LAS unsigned*)(L + MISC_OFF) + 8);
#define GRID_BAR() xcd_barrier(bar)
#if defined(DBG_BISECT)
#define IN(k) (l > 0 || ((k) >= kstart() && (k) <= kstop()) || ((k) == 9 && kstop() == 99))
#define LAYER_END() do { if (kstop() < 100) return; } while (0)
#else
#define IN(k) true
#define LAYER_END() do { } while (0)
#endif
#define PTRS() unsigned char* ws = opq(kws()); \
    bf16* U = (bf16*)(ws + WS_U); bf16* OA = (bf16*)(ws + WS_OA); bf16* OC = (bf16*)(ws + WS_OC); bf16* ORW = (bf16*)(ws + WS_ORW); \
    bf16* WinT = (bf16*)(ws + W_IN); bf16* WqT = (bf16*)(ws + W_Q); bf16* WloT = (bf16*)(ws + W_LORA); bf16* WbT = (bf16*)(ws + W_B); bf16* WoT = (bf16*)(ws + W_OUT); \
    bf16* W1T = (bf16*)(ws + W_1); bf16* W2T = (bf16*)(ws + W_2); bf16* WgT = (bf16*)(ws + W_G); bf16* WpT = (bf16*)(ws + W_P); \
    bf16* ZC = (bf16*)(ws + X_ZC); bf16* QN = (bf16*)(ws + X_QN); bf16* QP = (bf16*)(ws + X_QP); bf16* KV = (bf16*)(ws + X_KV); \
    bf16* ZR = (bf16*)(ws + X_ZR); bf16* LA = (bf16*)(ws + X_LA); bf16* TW = (bf16*)(ws + X_TW); bf16* TA = (bf16*)((unsigned char*)kout() + DO_TA); bf16* GG = (bf16*)((unsigned char*)kout() + DO_G); bf16* H16 = (bf16*)((unsigned char*)kout() + DO_H16); \
    bf16* GT = (bf16*)(ws + X_GT); bf16* MG = (bf16*)(ws + X_MG); bf16* HID = (bf16*)(ws + X_HID); bf16* PB = (bf16*)(ws + X_PB); bf16* PP = (bf16*)(ws + X_PP); bf16* M2 = OA; \
    (void)U; (void)OA; (void)OC; (void)ORW; (void)WinT; (void)WqT; (void)WloT; (void)WbT; (void)WoT; (void)W1T; (void)W2T; (void)WgT; (void)WpT; (void)ZC; (void)QN; (void)QP; (void)KV; (void)ZR; (void)LA; (void)TW; (void)TA; (void)GG; (void)H16; (void)GT; (void)MG; (void)HID; (void)PB; (void)PP; (void)M2;
    typedef pg8::StaticOrder SO;
#define GEMM(EPI, Aptr, Bptr, N_, K_, Eobj) do { int bx_ = blockIdx.x; asm volatile("" : "+s"(bx_)); int G_ = gridDim.x; asm volatile("" : "+s"(G_)); pg8::Gemm g_{Aptr, Bptr, T, N_, K_}; SO S_; S_.init(T, N_, G_, bx_); pg8::gemm_phase<EPI, SO, true, true>(L + RING_OFF, g_, S_, Eobj); } while (0)
#define PH(n) for (int rep_ = 0; rep_ < (((PROBE_MASK >> (n)) & 1) ? 2 : 1); ++rep_) if (IN(n))
    typedef pg8::EpiRoute<0> ER0;
    rope_table(L);
    for (int l = 0; l < DEPTH; ++l) {
        PH(0) { p0_prologue(L, args, l); u_rowpass(L, l, l == 0); GRID_BAR(); }
        PH(1) { PTRS(); ER0 E{OA, 512, 2, ZC, 1536, 6, 2, CA_QSCALE, ZR, 1792}; GEMM(ER0, U, WinT, 3840, 1024, E); GRID_BAR(); }
        PH(2) { p2_mla_prep(L, args, l); p6_rw_prep(L, args, l); GRID_BAR(); }
        PH(3) { PTRS(); pg8::EpiQRope E{QP, (const float*)(ws + WS_ROPE), MLA_QSCALE}; GEMM(pg8::EpiQRope, QN, WqT, 768, 256, E);
                pg8::EpiSig E2{TW, kin(10) + l * 512, -0.6065306597126334f, 512}; GEMM(pg8::EpiSig, LA, WloT, 512, 256, E2);
                pg8::EpiSig E3{TA, kin(12) + l * 512, 1.f, 512}; GEMM(pg8::EpiSig, LA, WloT + (size_t)512 * 256, 512, 256, E3);
                ER0 E4{GG, 512, 2, GG, 512, 0, 0, 1.f, GG, 512}; GEMM(ER0, LA, WloT + (size_t)1024 * 256, 512, 256, E4); GRID_BAR(); }
        PH(4) { PTRS();
            if (blockIdx.x < 64) rw::rw_unit(L + RING_OFF, l, (int)blockIdx.x);
            volatile LAS unsigned* qs = (volatile LAS unsigned*)(L + MISC_OFF) + 12;
            for (int qrep_ = 0; qrep_ < PROBE_QREP; ++qrep_) { unsigned* qhead = (unsigned*)(ws + WS_CTL) + CW_QUEUE + 64 * l + 16 * rep_ + 32 * qrep_;
            for (;;) {
                __syncthreads();
                if (my_tid() == 0) *qs = atomicAdd(qhead, 1u);
                __syncthreads();
                const unsigned u = *qs;
                if (u >= 1280u) break;
                if (u < 256u) { const int b = (int)u >> 5, cc = (int)u & 31; att::mla_unit(L + RING_OFF, QP, KV, OA, b, 63 - cc); att::mla_unit(L + RING_OFF, QP, KV, OA, b, cc); }
                else { const int bi = (int)u - 256; att::band_unit(L + RING_OFF, ZC, kin(20) + (size_t)l * 320 * 8, OC, bi >> 7, (bi >> 4) & 7, bi & 15); }
            }
            }
            GRID_BAR(); }
        PH(9) { PTRS(); ER0 E{GT, 3072, 12, GT, 3072, 0, 0, 1.f, GT, 3072}; GEMM(ER0, U, WinT + (size_t)3840 * 1024, 3072, 1024, E); GRID_BAR(); }
        PH(10) { PTRS(); int bx_ = blockIdx.x; asm volatile("" : "+s"(bx_)); int G_ = gridDim.x; asm volatile("" : "+s"(G_));
                 pg8::Gemm g_{OA, WbT, 3 * T, 3072, 512}; pg8::MergeOrder S_{G_, bx_}; pg8::EpiMergeAll E{MG, GT};
                 pg8::gemm_phase<pg8::EpiMergeAll, pg8::MergeOrder, true, true>(L + RING_OFF, g_, S_, E); GRID_BAR(); }
        PH(11) { PTRS(); ER0 E{M2, 1024, 4, M2, 1024, 0, 0, 1.f, M2, 1024}; GEMM(ER0, MG, WoT, 1024, 1024, E); GRID_BAR(); }
        if (IN(12)) { PTRS(); rowpass<0>(L, args, M2, kin(23) + l * 1024, kin(24) + l * 1024, nullptr); GRID_BAR(); }
        PH(13) { PTRS(); pg8::EpiRoute<2> E{HID, 4096, 16, HID, 4096, 0, 0, 1.f, HID, 4096}; GEMM(pg8::EpiRoute<2>, U, W1T, 4096, 1024, E); GRID_BAR(); }
        PH(14) { PTRS(); ER0 E{M2, 1024, 4, M2, 1024, 0, 0, 1.f, M2, 1024}; GEMM(ER0, HID, W2T, 1024, 4096, E); GRID_BAR(); }
        if (IN(15)) { PTRS(); rowpass<1>(L, args, M2, kin(27) + l * 1024, nullptr, kin(1) + (size_t)l * T * DPLE); GRID_BAR(); }
        if (IN(17)) { PTRS(); ER0 E{PP, 1024, 4, PP, 1024, 0, 0, 1.f, PP, 1024}; GEMM(ER0, PB, WpT, 1024, 256, E);
                      pg8::EpiPle E2{H16, PP, kout(), (float*)(ws + X_STG), (l + 1 == DEPTH) ? 1 : 0}; GEMM(pg8::EpiPle, U, WgT, 1024, 1024, E2); }
        LAYER_END();
        if (l + 1 < DEPTH) GRID_BAR();
    }
    GRID_BAR();
    {   const Frame F = make_frame(L); const f32x4* src = (const f32x4*)(kws() + X_STG); f32x4* dst = (f32x4*)((unsigned char*)kout() + 64 * MiB);
        const size_t n = (size_t)16384 * 1024 / 4, gt = (size_t)F.gw * 64 + F.lane, NTH = (size_t)F.NGW * 64;
        for (size_t i = gt; i < n; i += NTH) dst[i] = src[i]; }
}

#if !defined(DBG_BISECT)
extern "C" void kernel_launch(void* const* d_in, const int* in_sizes, int n_in, void* d_out, int out_size, void* d_ws, size_t ws_size, hipStream_t stream) {
    static int grid = 0;
    if (grid == 0) {
        if (n_in != 30 || out_size != T * D || ws_size < (size_t)WS_END) { fprintf(stderr, "kernel_launch: unexpected shapes (n_in %d out %d ws %zu, need ws >= %zu)\n", n_in, out_size, ws_size, (size_t)WS_END); grid = -1; return; }
        int dev = 0, cus = 0, per_cu = 0;
        if (hipGetDevice(&dev) != hipSuccess || hipDeviceGetAttribute(&cus, hipDeviceAttributeMultiprocessorCount, dev) != hipSuccess) { grid = -1; return; }
        if (hipFuncSetAttribute((const void*)mk_fwd, hipFuncAttributeMaxDynamicSharedMemorySize, LDS_BYTES) != hipSuccess) { fprintf(stderr, "kernel_launch: hipFuncSetAttribute failed\n"); grid = -1; return; }
        if (hipOccupancyMaxActiveBlocksPerMultiprocessor(&per_cu, (const void*)mk_fwd, NWAVES * 64, LDS_BYTES) != hipSuccess || per_cu < 1) { fprintf(stderr, "kernel_launch: occupancy query says %d\n", per_cu); }
        (void)hipGetLastError();
        grid = cus;
    }
    if (grid < 0) return;
    if (hipMemsetAsync((char*)d_ws + WS_CTL, 0, CTL_ZERO_BYTES, stream) != hipSuccess) return;
    Args a{};
    for (int i = 0; i < 30; ++i) a.in[i] = (const float*)d_in[i];
    a.out = (float*)d_out; a.ws = (unsigned char*)d_ws; a.start = 0; a.stop = 1000;
    hipLaunchKernelGGL(mk_fwd, dim3(grid), dim3(NWAVES * 64), LDS_BYTES, stream, a);
}
#endif
```

```cpp
#include <hip/hip_runtime.h>
#include <cstdio>
#include <cstdint>
#include <cmath>
typedef _Float16 h16x8_t __attribute__((ext_vector_type(8)));
typedef _Float16 h16x2_t __attribute__((ext_vector_type(2)));
typedef short s16x8_t __attribute__((ext_vector_type(8)));
typedef float f32x4_t_ __attribute__((ext_vector_type(4)));
typedef float f32x16_t_ __attribute__((ext_vector_type(16)));
__device__ __forceinline__ unsigned h_pk2(float lo, float hi) { const h16x2_t v = {(_Float16)lo, (_Float16)hi}; return __builtin_bit_cast(unsigned, v); }
__device__ __forceinline__ unsigned h_f2h(float f) { return (unsigned)__builtin_bit_cast(unsigned short, (_Float16)f); }
__device__ __forceinline__ float h_lo(unsigned w) { return (float)__builtin_bit_cast(_Float16, (unsigned short)(w & 0xffffu)); }
__device__ __forceinline__ float h_hi(unsigned w) { return (float)__builtin_bit_cast(_Float16, (unsigned short)(w >> 16)); }
__device__ __forceinline__ f32x4_t_ MFMA16(s16x8_t a, s16x8_t b, f32x4_t_ c) { return __builtin_amdgcn_mfma_f32_16x16x32_f16(__builtin_bit_cast(h16x8_t, a), __builtin_bit_cast(h16x8_t, b), c, 0, 0, 0); }
__device__ __forceinline__ f32x16_t_ MFMA32(s16x8_t a, s16x8_t b, f32x16_t_ c) { return __builtin_amdgcn_mfma_f32_32x32x16_f16(__builtin_bit_cast(h16x8_t, a), __builtin_bit_cast(h16x8_t, b), c, 0, 0, 0); }
#define MK_WAVETAB_LDS 131072
__device__ __forceinline__ int my_tid() {
    const unsigned hw = (unsigned)__builtin_amdgcn_s_getreg((5 << 11) | 4) & 63u;
    const unsigned wv = (unsigned)__builtin_amdgcn_readfirstlane((int)((volatile __attribute__((address_space(3))) unsigned*)MK_WAVETAB_LDS)[hw]);
    unsigned lane; asm volatile("v_mbcnt_lo_u32_b32 %0, -1, 0\n\tv_mbcnt_hi_u32_b32 %0, -1, %0" : "=v"(lane));
    return (int)(wv * 64u + lane);
}
namespace pg8 {
#define PG8_LAS __attribute__((address_space(3)))
#define PG8_GAS __attribute__((address_space(1)))
typedef unsigned short bf16_t;
typedef short bf16x8 __attribute__((ext_vector_type(8)));
typedef float f32x4 __attribute__((ext_vector_type(4)));
typedef unsigned u32x4 __attribute__((ext_vector_type(4)));
constexpr int BM = 256, BK = 64, HALF = 128, HTB = HALF * BK * 2  , STAGE_BYTES = 8 * HTB, NXCD = 8, WGM = 8;

__host__ __device__ __forceinline__ int lds_byte(int r, int c) { const int st = (r >> 4) * 2 + (c >> 5), rr = r & 15, cc = c & 31, ob = rr * 64 + cc * 2; return st * 1024 + (ob ^ (((ob >> 9) & 1) << 5)); }
__host__ __device__ __forceinline__ void stage_rc(int b, int& R, int& C) { const int st = b / 1024, sb = b % 1024, swz = sb ^ (((sb >> 9) & 1) << 5); R = (st >> 1) * 16 + swz / 64; C = (st & 1) * 32 + (swz % 64) / 2; }
__host__ __device__ __forceinline__ int perm32(int rho) { const int n = rho >> 4, i = rho & 15; return 8 * (i >> 2) + 4 * n + (i & 3); }

struct Unit { int pm, pn; };
struct Gemm { const bf16_t* A; const bf16_t* Bt; int M, N, K; };

struct StaticOrder {
    int nM, nN, nwg, G, c;
    __host__ __device__ void init(int M, int N, int G_, int c_) { nM = M / BM; nN = N / BM; nwg = nM * nN; G = G_; c = c_; }
    __host__ __device__ bool next(int i, Unit& u) const {
        const long L = (long)i * G + c; if (L >= nwg) return false;
        int wgid = (int)L; { const int q = nwg / NXCD, r = nwg % NXCD, xcd = wgid % NXCD, off = wgid / NXCD; wgid = (xcd < r ? xcd * (q + 1) : r * (q + 1) + (xcd - r) * q) + off; }
        const int nig = WGM * nN, gid = wgid / nig, fm = gid * WGM, gsz = (nM - fm) < WGM ? (nM - fm) : WGM;
        u.pm = fm + ((wgid % nig) % gsz); u.pn = (wgid % nig) / gsz; return true;
    }
    __device__ __forceinline__ void a_ready(const Unit&) const {}
    __device__ __forceinline__ void done(const Unit&) const {}
};

__device__ __forceinline__ unsigned cvt_pk_bf16(float lo, float hi) { typedef __fp16 hp2 __attribute__((ext_vector_type(2))); const hp2 v = __builtin_amdgcn_cvt_pkrtz(lo, hi); return __builtin_bit_cast(unsigned, v); }
typedef float f32x2 __attribute__((ext_vector_type(2)));
__device__ __forceinline__ f32x2 gelu_pk(f32x2 v) {
    const f32x2 av = __builtin_elementwise_abs(v), d = av * 0.2316418882f + 1.0f;
    f32x2 t; t.x = __builtin_amdgcn_rcpf(d.x); t.y = __builtin_amdgcn_rcpf(d.y);
    f32x2 q = t * 0.5307027145f + (-0.7265760135f); q = q * t + 0.7107068705f; q = q * t + (-0.142248368f); q = q * t + 0.127414796f; q = q * t;
    const f32x2 s = (v * v) * (-0.72134752044f);
    f32x2 e; e.x = __builtin_amdgcn_exp2f(s.x); e.y = __builtin_amdgcn_exp2f(s.y);
    const f32x2 m = v * (q * e), r = v - m;
    f32x2 o; o.x = v.x < 0.f ? m.x : r.x; o.y = v.y < 0.f ? m.y : r.y; return o;
}

template <int ACT  > struct EpiBf16 {
    static constexpr bool PERM = true, AFTER_DRAIN = false; static_assert(ACT == 0 || ACT == 1, "EpiBf16: ACT is 0 (none) or 1 (gelu_pk)");
    bf16_t* O; int ldc; const float* bias; int split_cols; size_t split_stride; float scale0;
    __device__ __forceinline__ void operator()(const f32x4 (&acc)[2][2][4][2], const Unit& u, int wr, int wc, int fr, int fq) const {
        const int row0 = u.pm * BM + wr * 64 + fr; int colt = u.pn * BM; bf16_t* base = O;
        float sc = 1.f; if (split_cols) { const int t = colt / split_cols; base += (size_t)t * split_stride; colt -= t * split_cols; if (t == 0) sc = scale0; }
        const int col0 = colt + wc * 32 + 8 * fq, bcol0 = u.pn * BM + wc * 32 + 8 * fq;
        f32x4 bv[2][2];
#pragma unroll
        for (int bj = 0; bj < 2; ++bj)
#pragma unroll
            for (int n = 0; n < 2; ++n) bv[bj][n] = bias ? *(const f32x4*)(bias + bcol0 + bj * HALF + 4 * n) : (f32x4){0.f, 0.f, 0.f, 0.f};
#pragma unroll
        for (int ai = 0; ai < 2; ++ai)
#pragma unroll
            for (int m = 0; m < 4; ++m) { bf16_t* rowp = base + (size_t)(row0 + ai * HALF + m * 16) * ldc + col0;
#pragma unroll
                for (int bj = 0; bj < 2; ++bj) { f32x4 v0 = acc[ai][bj][m][0] + bv[bj][0], v1 = acc[ai][bj][m][1] + bv[bj][1];
                    if (ACT == 1) { f32x2 a = gelu_pk((f32x2){v0[0], v0[1]}), b = gelu_pk((f32x2){v0[2], v0[3]}), c = gelu_pk((f32x2){v1[0], v1[1]}), d = gelu_pk((f32x2){v1[2], v1[3]});
                        v0 = (f32x4){a.x, a.y, b.x, b.y}; v1 = (f32x4){c.x, c.y, d.x, d.y}; }
                    v0 = v0 * sc; v1 = v1 * sc; u32x4 w; w.x = cvt_pk_bf16(v0[0], v0[1]); w.y = cvt_pk_bf16(v0[2], v0[3]); w.z = cvt_pk_bf16(v1[0], v1[1]); w.w = cvt_pk_bf16(v1[2], v1[3]);
                    *(u32x4*)(rowp + bj * HALF) = w; } }
    }
};
__device__ __forceinline__ float bf2f(unsigned short b) { return h_lo((unsigned)b); }
__device__ __forceinline__ float sigm(float x) { return __builtin_amdgcn_rcpf(1.0f + __builtin_amdgcn_exp2f(-1.4426950408889634f * x)); }
__device__ __forceinline__ void unpack8(const u32x4 w, float (&f)[8]) {
    f[0] = h_lo(w.x); f[1] = h_hi(w.x); f[2] = h_lo(w.y); f[3] = h_hi(w.y); f[4] = h_lo(w.z); f[5] = h_hi(w.z); f[6] = h_lo(w.w); f[7] = h_hi(w.w);
}
template <int ACT> struct EpiRoute {
    static constexpr bool PERM = true, AFTER_DRAIN = false;
    bf16_t* O0; int ld0; int nt0;
    bf16_t* O1; int ld1; int nt1; int nts1; float sc1;
    bf16_t* O2; int ld2;
    __device__ __forceinline__ void operator()(const f32x4 (&acc)[2][2][4][2], const Unit& u, int wr, int wc, int fr, int fq) const {
        const int row0 = u.pm * BM + wr * 64 + fr;
        bf16_t* base; int ld, colt; float sc = 1.f;
        if (u.pn < nt0) { base = O0; ld = ld0; colt = u.pn * BM; }
        else if (u.pn < nt0 + nt1) { base = O1; ld = ld1; colt = (u.pn - nt0) * BM; if (u.pn - nt0 < nts1) sc = sc1; }
        else { base = O2; ld = ld2; colt = (u.pn - nt0 - nt1) * BM; }
        const int col0 = colt + wc * 32 + 8 * fq;
#pragma unroll
        for (int ai = 0; ai < 2; ++ai)
#pragma unroll
            for (int m = 0; m < 4; ++m) { bf16_t* rowp = base + (size_t)(row0 + ai * HALF + m * 16) * ld + col0;
#pragma unroll
                for (int bj = 0; bj < 2; ++bj) { f32x4 v0 = acc[ai][bj][m][0], v1 = acc[ai][bj][m][1];
                    if (ACT == 2) { for (int e = 0; e < 4; ++e) { const float a = fmaxf(v0[e], 0.f), b = fmaxf(v1[e], 0.f); v0[e] = a * a; v1[e] = b * b; } }
                    v0 = v0 * sc; v1 = v1 * sc; u32x4 w; w.x = cvt_pk_bf16(v0[0], v0[1]); w.y = cvt_pk_bf16(v0[2], v0[3]); w.z = cvt_pk_bf16(v1[0], v1[1]); w.w = cvt_pk_bf16(v1[2], v1[3]);
                    *(PG8_GAS u32x4*)(rowp + bj * HALF) = w; } }
    }
};
struct EpiSig {
    static constexpr bool PERM = true, AFTER_DRAIN = false;
    bf16_t* O; const float* p; float scale; int ld;
    __device__ __forceinline__ void operator()(const f32x4 (&acc)[2][2][4][2], const Unit& u, int wr, int wc, int fr, int fq) const {
        const int row0 = u.pm * BM + wr * 64 + fr; const int col0 = u.pn * BM + wc * 32 + 8 * fq;
        const f32x4 pA0 = *(const PG8_GAS f32x4*)(p + col0), pA1 = *(const PG8_GAS f32x4*)(p + col0 + 4), pB0 = *(const PG8_GAS f32x4*)(p + col0 + HALF), pB1 = *(const PG8_GAS f32x4*)(p + col0 + HALF + 4);
#pragma unroll
        for (int ai = 0; ai < 2; ++ai)
#pragma unroll
            for (int m = 0; m < 4; ++m) { bf16_t* rowp = O + (size_t)(row0 + ai * HALF + m * 16) * ld + col0;
#pragma unroll
                for (int bj = 0; bj < 2; ++bj) { f32x4 v0 = acc[ai][bj][m][0], v1 = acc[ai][bj][m][1]; const f32x4 p0 = bj ? pB0 : pA0, p1 = bj ? pB1 : pA1;
                    v0 = (f32x4){sigm(p0[0] + v0[0]), sigm(p0[1] + v0[1]), sigm(p0[2] + v0[2]), sigm(p0[3] + v0[3])} * scale; v1 = (f32x4){sigm(p1[0] + v1[0]), sigm(p1[1] + v1[1]), sigm(p1[2] + v1[2]), sigm(p1[3] + v1[3])} * scale;
                    u32x4 w; w.x = cvt_pk_bf16(v0[0], v0[1]); w.y = cvt_pk_bf16(v0[2], v0[3]); w.z = cvt_pk_bf16(v1[0], v1[1]); w.w = cvt_pk_bf16(v1[2], v1[3]);
                    *(PG8_GAS u32x4*)(rowp + bj * HALF) = w; } }
    }
};
struct EpiQRope {
    static constexpr bool PERM = true, AFTER_DRAIN = false;
    bf16_t* O; const float* rope; float sc;
    __device__ __forceinline__ void operator()(const f32x4 (&acc)[2][2][4][2], const Unit& u, int wr, int wc, int fr, int fq) const {
        const int row0 = u.pm * BM + wr * 64 + fr; const int col0 = u.pn * BM + wc * 32 + 8 * fq;
#pragma unroll
        for (int ai = 0; ai < 2; ++ai)
#pragma unroll
            for (int m = 0; m < 4; ++m) { const int row = row0 + ai * HALF + m * 16;
#pragma unroll
                for (int bj = 0; bj < 2; ++bj) { const int cg = col0 + bj * HALF; const int cm = cg % 192; f32x4 v0 = acc[ai][bj][m][0], v1 = acc[ai][bj][m][1];
                    if (cm >= 128) { const int j0 = (cm - 128) >> 1; const PG8_GAS f32x4* rp = (const PG8_GAS f32x4*)(rope + ((size_t)row * 32 + j0) * 2); const f32x4 a = rp[0], b = rp[1];
                        f32x4 r0, r1;
                        r0[0] = v0[0] * a[0] - v0[1] * a[1]; r0[1] = v0[1] * a[0] + v0[0] * a[1]; r0[2] = v0[2] * a[2] - v0[3] * a[3]; r0[3] = v0[3] * a[2] + v0[2] * a[3];
                        r1[0] = v1[0] * b[0] - v1[1] * b[1]; r1[1] = v1[1] * b[0] + v1[0] * b[1]; r1[2] = v1[2] * b[2] - v1[3] * b[3]; r1[3] = v1[3] * b[2] + v1[2] * b[3];
                        v0 = r0; v1 = r1; }
                    v0 = v0 * sc; v1 = v1 * sc; u32x4 w; w.x = cvt_pk_bf16(v0[0], v0[1]); w.y = cvt_pk_bf16(v0[2], v0[3]); w.z = cvt_pk_bf16(v1[0], v1[1]); w.w = cvt_pk_bf16(v1[2], v1[3]);
                    *(PG8_GAS u32x4*)(O + (size_t)row * 768 + cg) = w; } }
    }
};
template <int NI> struct EpiMerge {
    static constexpr bool PERM = true, AFTER_DRAIN = false;
    bf16_t* MG; const bf16_t* GT;
    __device__ __forceinline__ void operator()(const f32x4 (&acc)[2][2][4][2], const Unit& u, int wr, int wc, int fr, int fq) const {
        const int row0 = u.pm * BM + wr * 64 + fr; const int col0 = u.pn * BM + wc * 32 + 8 * fq;
#pragma unroll
        for (int ai = 0; ai < 2; ++ai)
#pragma unroll
            for (int m = 0; m < 4; ++m) { const int row = row0 + ai * HALF + m * 16;
#pragma unroll
                for (int bj = 0; bj < 2; ++bj) { const int c = col0 + bj * HALF; const f32x4 v0 = acc[ai][bj][m][0], v1 = acc[ai][bj][m][1];
                    const u32x4 gw = *(const PG8_GAS u32x4*)(GT + (size_t)row * 3072 + NI * 1024 + c);
                    f32x4 o0 = {0.f, 0.f, 0.f, 0.f}, o1 = {0.f, 0.f, 0.f, 0.f};
                    if (NI > 0) { const u32x4 ow = *(const PG8_GAS u32x4*)(MG + (size_t)row * 1024 + c); o0 = (f32x4){h_lo(ow.x), h_hi(ow.x), h_lo(ow.y), h_hi(ow.y)}; o1 = (f32x4){h_lo(ow.z), h_hi(ow.z), h_lo(ow.w), h_hi(ow.w)}; }
                    o0[0] += sigm(h_lo(gw.x)) * v0[0]; o0[1] += sigm(h_hi(gw.x)) * v0[1]; o0[2] += sigm(h_lo(gw.y)) * v0[2]; o0[3] += sigm(h_hi(gw.y)) * v0[3];
                    o1[0] += sigm(h_lo(gw.z)) * v1[0]; o1[1] += sigm(h_hi(gw.z)) * v1[1]; o1[2] += sigm(h_lo(gw.w)) * v1[2]; o1[3] += sigm(h_hi(gw.w)) * v1[3];
                    u32x4 w; w.x = cvt_pk_bf16(o0[0], o0[1]); w.y = cvt_pk_bf16(o0[2], o0[3]); w.z = cvt_pk_bf16(o1[0], o1[1]); w.w = cvt_pk_bf16(o1[2], o1[3]);
                    *(PG8_GAS u32x4*)(MG + (size_t)row * 1024 + c) = w; } }
    }
};
__device__ __forceinline__ unsigned pk_fma_h(unsigned a, unsigned b, unsigned c) { unsigned r; asm("v_pk_fma_f16 %0, %1, %2, %3" : "=v"(r) : "v"(a), "v"(b), "v"(c)); return r; }
struct EpiMergeAll {
    static constexpr bool PERM = true, AFTER_DRAIN = false;
    bf16_t* MG; const bf16_t* GT;
    __device__ __forceinline__ void operator()(const f32x4 (&acc)[2][2][4][2], const Unit& u, int wr, int wc, int fr, int fq) const {
        const int a = u.pm >> 7, p = u.pm & 127, br = u.pn >> 2, q = u.pn & 3;
        const int row0 = p * BM + wr * 64 + fr; const int col0 = q * BM + wc * 32 + 8 * fq;
#pragma unroll
        for (int ai = 0; ai < 2; ++ai) {
            u32x4 gw[4][2], ow[4][2];
#pragma unroll
            for (int m = 0; m < 4; ++m)
#pragma unroll
                for (int bj = 0; bj < 2; ++bj) { const int row = row0 + ai * HALF + m * 16, c = col0 + bj * HALF;
                    gw[m][bj] = *(const PG8_GAS u32x4*)(GT + (size_t)row * 3072 + br * 1024 + c);
                    if (a > 0) ow[m][bj] = *(const PG8_GAS u32x4*)(MG + (size_t)row * 1024 + c); else ow[m][bj] = (u32x4){0u, 0u, 0u, 0u}; }
            __builtin_amdgcn_sched_barrier(0);
#pragma unroll
            for (int m = 0; m < 4; ++m)
#pragma unroll
                for (int bj = 0; bj < 2; ++bj) { const int row = row0 + ai * HALF + m * 16, c = col0 + bj * HALF; const f32x4 v0 = acc[ai][bj][m][0], v1 = acc[ai][bj][m][1]; const u32x4 g = gw[m][bj], o = ow[m][bj];
                    u32x4 w;
                    w.x = pk_fma_h(cvt_pk_bf16(sigm(h_lo(g.x)), sigm(h_hi(g.x))), cvt_pk_bf16(v0[0], v0[1]), o.x);
                    w.y = pk_fma_h(cvt_pk_bf16(sigm(h_lo(g.y)), sigm(h_hi(g.y))), cvt_pk_bf16(v0[2], v0[3]), o.y);
                    w.z = pk_fma_h(cvt_pk_bf16(sigm(h_lo(g.z)), sigm(h_hi(g.z))), cvt_pk_bf16(v1[0], v1[1]), o.z);
                    w.w = pk_fma_h(cvt_pk_bf16(sigm(h_lo(g.w)), sigm(h_hi(g.w))), cvt_pk_bf16(v1[2], v1[3]), o.w);
                    *(PG8_GAS u32x4*)(MG + (size_t)row * 1024 + c) = w; }
            __builtin_amdgcn_sched_barrier(0);
        }
    }
};
struct MergeOrder {
    int G, c;
    __device__ __forceinline__ bool next(int i, Unit& u) const { if (i >= 6 || G != 256) { if (G == 256) return false; const int t = c + G * (i / 3), a = i % 3; if (t >= 512) return false;
            const int p = t >> 2, q = t & 3, br = (a == 0) ? 0 : (a == 1 ? 2 : 1); u.pm = a * 128 + p; u.pn = br * 4 + q; return true; }
        const int x = c & 7, s = c >> 3, p = x * 16 + (s >> 1), q = 2 * (s & 1) + i / 3, a = i % 3, br = (a == 0) ? 0 : (a == 1 ? 2 : 1);
        u.pm = a * 128 + p; u.pn = br * 4 + q; return true; }
    __device__ __forceinline__ void a_ready(const Unit&) const {}
    __device__ __forceinline__ void done(const Unit&) const {}
};
struct EpiPle {
    static constexpr bool PERM = true, AFTER_DRAIN = false;
    bf16_t* H16; const bf16_t* PP; float* outLo; float* outHi; int last;
    __device__ __forceinline__ void operator()(const f32x4 (&acc)[2][2][4][2], const Unit& u, int wr, int wc, int fr, int fq) const {
        const int row0 = u.pm * BM + wr * 64 + fr; const int col0 = u.pn * BM + wc * 32 + 8 * fq;
#pragma unroll
        for (int ai = 0; ai < 2; ++ai) {
            u32x4 pw[4][2], hw[4][2];
#pragma unroll
            for (int m = 0; m < 4; ++m)
#pragma unroll
                for (int bj = 0; bj < 2; ++bj) { const int row = row0 + ai * HALF + m * 16, c = col0 + bj * HALF;
                    pw[m][bj] = *(const PG8_GAS u32x4*)(PP + (size_t)row * 1024 + c); hw[m][bj] = *(const PG8_GAS u32x4*)(H16 + (size_t)row * 1024 + c); }
            __builtin_amdgcn_sched_barrier(0);
#pragma unroll
            for (int m = 0; m < 4; ++m)
#pragma unroll
                for (int bj = 0; bj < 2; ++bj) { const int row = row0 + ai * HALF + m * 16, c = col0 + bj * HALF; const f32x4 v0 = acc[ai][bj][m][0], v1 = acc[ai][bj][m][1]; const u32x4 pq = pw[m][bj], hq = hw[m][bj];
                    f32x4 h0 = (f32x4){h_lo(hq.x), h_hi(hq.x), h_lo(hq.y), h_hi(hq.y)}, h1 = (f32x4){h_lo(hq.z), h_hi(hq.z), h_lo(hq.w), h_hi(hq.w)};
                    h0[0] += sigm(v0[0]) * h_lo(pq.x); h0[1] += sigm(v0[1]) * h_hi(pq.x); h0[2] += sigm(v0[2]) * h_lo(pq.y); h0[3] += sigm(v0[3]) * h_hi(pq.y);
                    h1[0] += sigm(v1[0]) * h_lo(pq.z); h1[1] += sigm(v1[1]) * h_hi(pq.z); h1[2] += sigm(v1[2]) * h_lo(pq.w); h1[3] += sigm(v1[3]) * h_hi(pq.w);
                    if (last) { float* op = (row < 16384) ? (outLo + (size_t)row * 1024 + c) : (outHi + (size_t)(row - 16384) * 1024 + c); *(PG8_GAS f32x4*)op = h0; *(PG8_GAS f32x4*)(op + 4) = h1; }
                    else { u32x4 w; w.x = h_pk2(h0[0], h0[1]); w.y = h_pk2(h0[2], h0[3]); w.z = h_pk2(h1[0], h1[1]); w.w = h_pk2(h1[2], h1[3]); *(PG8_GAS u32x4*)(H16 + (size_t)row * 1024 + c) = w; } }
            __builtin_amdgcn_sched_barrier(0);
        }
    }
};
template <class Epi, class Sched, bool ALIGN_EPI = false, bool SP2 = false>
__device__ __forceinline__ void gemm_phase(PG8_LAS unsigned char* lds, const Gemm g, const Sched& S, const Epi& E) {
    int tid_ = my_tid(); asm volatile("" : "+v"(tid_));
    const int tid = tid_, wid = __builtin_amdgcn_readfirstlane(tid >> 6), lane = tid & 63, wr = wid >> 2, wc = wid & 3, fr = lane & 15, fq = lane >> 4;
    const int K = g.K, nt = K / BK;
    unsigned voffA[2], voffB[2];
#pragma unroll
    for (int i = 0; i < 2; ++i) { int R, C; stage_rc(tid * 16 + i * 8192, R, C); const int Rb = Epi::PERM ? ((R & ~31) + perm32(R & 31)) : R;
        voffA[i] = (unsigned)(R * K + C) * 2u; voffB[i] = (unsigned)(Rb * K + C) * 2u; }
    const size_t kstep = (size_t)(BK * 2);
    const size_t hstep = (size_t)HALF * K * 2;
    const size_t tstep = 2 * hstep;
    const unsigned ldsw = (unsigned)wid * 1024u;
    const int aoff = lds_byte(wr * 64 + fr, fq * 8), boff = lds_byte(wc * 32 + fr, fq * 8);
#define PG8_SA(b, h) (((b) * 2 + (h)) * HTB)
#define PG8_SB(b, h) ((4 + (b) * 2 + (h)) * HTB)
#define PG8_STAGE(bufoff, gbase, voff) do { _Pragma("unroll") for (int _i = 0; _i < 2; ++_i) \
        __builtin_amdgcn_global_load_lds((const unsigned*)((const char*)(gbase) + (voff)[_i]), (PG8_LAS unsigned*)(lds + (bufoff) + ldsw + _i * 8192), 16, 0, 0); } while (0)
#define PG8_LDA(dst, b, h) do { _Pragma("unroll") for (int m = 0; m < 4; ++m) _Pragma("unroll") for (int k = 0; k < 2; ++k) dst[m][k] = *(const PG8_LAS bf16x8*)(lds + PG8_SA(b, h) + aoff + m * 2048 + k * 1024); } while (0)
#define PG8_LDB(dst, b, h) do { _Pragma("unroll") for (int n = 0; n < 2; ++n) _Pragma("unroll") for (int k = 0; k < 2; ++k) dst[n][k] = *(const PG8_LAS bf16x8*)(lds + PG8_SB(b, h) + boff + n * 2048 + k * 1024); } while (0)
#define PG8_MMA(ai, bj, At, Bt) do { __builtin_amdgcn_s_setprio(1); _Pragma("unroll") for (int m = 0; m < 4; ++m) _Pragma("unroll") for (int n = 0; n < 2; ++n) _Pragma("unroll") for (int k = 0; k < 2; ++k) \
        acc[ai][bj][m][n] = MFMA16(Bt[n][k], At[m][k], acc[ai][bj][m][n]); __builtin_amdgcn_s_setprio(0); } while (0)
#define PG8_WAIT_V(n) asm volatile("s_waitcnt vmcnt(" #n ")" ::: "memory")
#define PG8_WAIT_L(n) asm volatile("s_waitcnt lgkmcnt(" #n ")" ::: "memory")
#define PG8_BAR __builtin_amdgcn_s_barrier()
#define PG8_SCHED __builtin_amdgcn_sched_barrier(0)
    Unit cur, nxt; int ui = 0;
    if (!S.next(0, cur)) return;
    f32x4 acc[2][2][4][2];
#pragma unroll
    for (int a = 0; a < 2; ++a)
#pragma unroll
        for (int b = 0; b < 2; ++b)
#pragma unroll
            for (int m = 0; m < 4; ++m)
#pragma unroll
                for (int n = 0; n < 2; ++n) acc[a][b][m][n] = (f32x4){0.f, 0.f, 0.f, 0.f};
    bf16x8 At[4][2], B0[2][2], B1[2][2];
    const char* cA = (const char*)g.A + (size_t)cur.pm * tstep; const char* cB = (const char*)g.Bt + (size_t)cur.pn * tstep;
    S.a_ready(cur);
    if constexpr (SP2) {
        PG8_STAGE(PG8_SB(0, 0), cB, voffB); PG8_STAGE(PG8_SB(0, 1), cB + hstep, voffB); PG8_STAGE(PG8_SA(0, 0), cA, voffA); PG8_STAGE(PG8_SA(0, 1), cA + hstep, voffA);
        if (wr == 1) PG8_BAR;
        PG8_WAIT_V(2); PG8_BAR;
        PG8_STAGE(PG8_SB(1, 0), cB + kstep, voffB); PG8_STAGE(PG8_SA(1, 0), cA + kstep, voffA); PG8_STAGE(PG8_SB(1, 1), cB + hstep + kstep, voffB);
        PG8_WAIT_V(6); PG8_BAR;
    } else {
        PG8_STAGE(PG8_SB(0, 0), cB, voffB); PG8_STAGE(PG8_SA(0, 0), cA, voffA); PG8_STAGE(PG8_SB(0, 1), cB + hstep, voffB); PG8_STAGE(PG8_SA(0, 1), cA + hstep, voffA);
        if (wr == 1) PG8_BAR;
        PG8_WAIT_V(4); PG8_BAR;
        PG8_STAGE(PG8_SB(1, 0), cB + kstep, voffB); PG8_STAGE(PG8_SA(1, 0), cA + kstep, voffA); PG8_STAGE(PG8_SB(1, 1), cB + hstep + kstep, voffB);
        PG8_WAIT_V(6); PG8_BAR;
    }
    for (;;) {
        const bool has_next = S.next(ui + 1, nxt);
        const char* nA = has_next ? (const char*)g.A + (size_t)nxt.pm * tstep : cA; const char* nB = has_next ? (const char*)g.Bt + (size_t)nxt.pn * tstep : cB;
        for (int t = 0; t < nt; t += 2) {
            const bool last = (t == nt - 2);
            const char* a1 = cA + (size_t)(t + 1) * kstep;
            const char* a2 = last ? nA : cA + (size_t)(t + 2) * kstep; const char* b2 = last ? nB : cB + (size_t)(t + 2) * kstep;
            const char* a3 = a2 + kstep; const char* b3 = b2 + kstep;
            if (last && has_next) S.a_ready(nxt);
            if constexpr (SP2) {
            PG8_LDB(B0, 0, 0); PG8_LDB(B1, 0, 1); PG8_SCHED; PG8_LDA(At, 0, 0); PG8_STAGE(PG8_SA(1, 1), a1 + hstep, voffA);
            PG8_WAIT_V(8); PG8_WAIT_L(0); PG8_BAR; PG8_MMA(0, 0, At, B0); PG8_MMA(0, 1, At, B1); PG8_BAR; PG8_SCHED;
            PG8_LDA(At, 0, 1); PG8_STAGE(PG8_SB(0, 0), b2, voffB); PG8_STAGE(PG8_SB(0, 1), b2 + hstep, voffB); PG8_STAGE(PG8_SA(0, 0), a2, voffA);
            PG8_WAIT_V(8); PG8_WAIT_L(0); PG8_BAR; PG8_MMA(1, 0, At, B0); PG8_MMA(1, 1, At, B1); PG8_BAR; PG8_SCHED;
            PG8_LDB(B0, 1, 0); PG8_LDB(B1, 1, 1); PG8_SCHED; PG8_LDA(At, 1, 0); PG8_STAGE(PG8_SA(0, 1), a2 + hstep, voffA);
            PG8_WAIT_V(8); PG8_WAIT_L(0); PG8_BAR; PG8_MMA(0, 0, At, B0); PG8_MMA(0, 1, At, B1); PG8_BAR; PG8_SCHED;
            PG8_LDA(At, 1, 1); PG8_STAGE(PG8_SB(1, 0), b3, voffB); PG8_STAGE(PG8_SB(1, 1), b3 + hstep, voffB); PG8_STAGE(PG8_SA(1, 0), a3, voffA);
            PG8_WAIT_V(8); PG8_WAIT_L(0); PG8_BAR; PG8_MMA(1, 0, At, B0); PG8_MMA(1, 1, At, B1); PG8_BAR; PG8_SCHED;
            } else {
            PG8_LDB(B0, 0, 0); PG8_SCHED; PG8_LDA(At, 0, 0); PG8_STAGE(PG8_SA(1, 1), a1 + hstep, voffA);
            PG8_WAIT_L(8); PG8_BAR; PG8_WAIT_L(0); PG8_MMA(0, 0, At, B0); PG8_BAR; PG8_SCHED;
            PG8_LDB(B1, 0, 1); PG8_STAGE(PG8_SB(0, 0), b2, voffB);
            PG8_BAR; PG8_WAIT_L(0); PG8_MMA(0, 1, At, B1); PG8_BAR;
            PG8_LDA(At, 0, 1); PG8_STAGE(PG8_SA(0, 0), a2, voffA);
            PG8_BAR; PG8_WAIT_L(0); PG8_MMA(1, 0, At, B0); PG8_BAR; PG8_SCHED;
            PG8_STAGE(PG8_SB(0, 1), b2 + hstep, voffB);
            PG8_WAIT_V(6); PG8_BAR; PG8_MMA(1, 1, At, B1); PG8_BAR;
            PG8_LDB(B0, 1, 0); PG8_SCHED; PG8_LDA(At, 1, 0); PG8_STAGE(PG8_SA(0, 1), a2 + hstep, voffA);
            PG8_WAIT_L(8); PG8_BAR; PG8_WAIT_L(0); PG8_MMA(0, 0, At, B0); PG8_BAR; PG8_SCHED;
            PG8_LDB(B1, 1, 1); PG8_STAGE(PG8_SB(1, 0), b3, voffB);
            PG8_BAR; PG8_WAIT_L(0); PG8_MMA(0, 1, At, B1); PG8_BAR;
            PG8_LDA(At, 1, 1); PG8_STAGE(PG8_SA(1, 0), a3, voffA);
            PG8_BAR; PG8_WAIT_L(0); PG8_MMA(1, 0, At, B0); PG8_BAR; PG8_SCHED;
            PG8_STAGE(PG8_SB(1, 1), b3 + hstep, voffB);
            PG8_WAIT_V(6); PG8_BAR; PG8_MMA(1, 1, At, B1); PG8_BAR;
            }
        }
        if constexpr (ALIGN_EPI) { if (wr == 0) PG8_BAR; }
        if constexpr (!Epi::AFTER_DRAIN) { int t2_ = my_tid(); asm volatile("" : "+v"(t2_)); const int l2_ = t2_ & 63, w2_ = __builtin_amdgcn_readfirstlane(t2_ >> 6);
            E(acc, cur, w2_ >> 2, w2_ & 3, l2_ & 15, l2_ >> 4); S.done(cur); }
        if (!has_next) break;
#pragma unroll
        for (int a = 0; a < 2; ++a)
#pragma unroll
            for (int b = 0; b < 2; ++b)
#pragma unroll
                for (int m = 0; m < 4; ++m)
#pragma unroll
                    for (int n = 0; n < 2; ++n) acc[a][b][m][n] = (f32x4){0.f, 0.f, 0.f, 0.f};
        cur = nxt; cA = nA; cB = nB; ++ui;
        if constexpr (ALIGN_EPI) { if (wr == 1) PG8_BAR; }
    }
    PG8_WAIT_V(0);
    if constexpr (!ALIGN_EPI) { if (wr == 0) PG8_BAR; }
    PG8_BAR;
    if constexpr (Epi::AFTER_DRAIN) { E.fused(acc, cur, wr, wc, fr, fq, lds, wid, lane); S.done(cur); }
#undef PG8_SA
#undef PG8_SB
#undef PG8_STAGE
#undef PG8_LDA
#undef PG8_LDB
#undef PG8_MMA
#undef PG8_WAIT_V
#undef PG8_WAIT_L
#undef PG8_BAR
#undef PG8_SCHED
}
}
constexpr int NWAVES = 8;
constexpr int D = 1024, BATCH = 8, SEQ = 4096, T = BATCH * SEQ, DEPTH = 2, FF = 4096, DPLE = 256;
constexpr int IN_COLS = 6848, RW_COLS = 1792;
constexpr float NORM_EPS = 1e-6f, RW_LN_EPS = 64e-5f;
constexpr float LOG2E = 1.4426950408889634f;
constexpr float MLA_QSCALE = 0.07216878364870322f * LOG2E;
constexpr float CA_QSCALE = 0.125f * LOG2E;
constexpr size_t MiB = 1u << 20;
constexpr size_t WS_CTL = 0, CTL_ZERO_BYTES = 1 * MiB;
constexpr size_t WS_ROPE = 1 * MiB;
constexpr size_t WS_W = 9 * MiB;
constexpr size_t W_IN = WS_W, W_Q = W_IN + (size_t)6912 * 1024 * 2, W_LORA = W_Q + (size_t)768 * 256 * 2, W_B = W_LORA + (size_t)1536 * 256 * 2,
                 W_OUT = W_B + (size_t)3 * 1024 * 512 * 2, W_1 = W_OUT + (size_t)1024 * 1024 * 2, W_2 = W_1 + (size_t)4096 * 1024 * 2, W_G = W_2 + (size_t)4096 * 1024 * 2,
                 W_P = W_G + (size_t)1024 * 1024 * 2, W_END = W_P + (size_t)1024 * 256 * 2;
constexpr size_t WS_U = 49 * MiB;
constexpr size_t WS_OA = 113 * MiB, WS_OC = 145 * MiB, WS_ORW = 177 * MiB;
constexpr size_t WS_X = 209 * MiB, WS_END = 512 * MiB;
constexpr size_t X_ZC = WS_X, X_QP = X_ZC + (size_t)T * 1536 * 2, X_KV = X_QP + (size_t)T * 768 * 2, X_ZR = X_KV + (size_t)T * 192 * 2, X_TW = X_ZR + (size_t)T * 1792 * 2;
constexpr size_t X_QN = WS_OC, X_LA = WS_OC + (size_t)T * 256 * 2;
constexpr size_t DO_G = 0, DO_TA = 32 * MiB, DO_H16 = 64 * MiB;
constexpr size_t X_STG = WS_X + 96 * MiB;
constexpr size_t X_GT = WS_X, X_MG = X_GT + (size_t)T * 3072 * 2;
constexpr size_t X_HID = WS_X, X_PB = WS_X, X_PP = X_PB + (size_t)T * 256 * 2;
static_assert(X_TW + (size_t)T * 512 * 2 <= WS_END && X_MG + (size_t)T * 1024 * 2 <= WS_END && X_HID + (size_t)T * 4096 * 2 <= WS_END, "X map");
constexpr int CW_TMO = 0, CW_QUEUE = 1024  , CW_SUB = 2048  , CW_BAR = 4096;
constexpr int RING_OFF = 0, RING_BYTES = 131072;
constexpr int LDSCTL_OFF = RING_BYTES, MISC_OFF = LDSCTL_OFF + 320;
constexpr int LDS_BYTES = 147456;

#define GAS __attribute__((address_space(1)))
#define LAS __attribute__((address_space(3)))
typedef unsigned short bf16;
typedef unsigned v4u __attribute__((ext_vector_type(4)));
typedef unsigned v2u __attribute__((ext_vector_type(2)));
typedef float f32x4 __attribute__((ext_vector_type(4)));
typedef float f32x16 __attribute__((ext_vector_type(16)));
typedef short bf16x8 __attribute__((ext_vector_type(8)));
typedef short s16x4 __attribute__((ext_vector_type(4)));
#define LDS_WAIT() asm volatile("s_waitcnt lgkmcnt(0)" ::: "memory")
#define VM_WAIT() asm volatile("s_waitcnt vmcnt(0)" ::: "memory")
__device__ __forceinline__ unsigned f2bf(float f) { return h_f2h(f); }
__device__ __forceinline__ unsigned pk2(float lo, float hi) { return h_pk2(lo, hi); }
__device__ __forceinline__ float bfl(unsigned w) { return h_lo(w); }
__device__ __forceinline__ float bfh(unsigned w) { return h_hi(w); }
__device__ __forceinline__ float sigmoidf_(float x) { return 1.0f / (1.0f + __expf(-x)); }
__device__ __forceinline__ float shfl_xor_f(float v, int o, int lane) { return __int_as_float(__builtin_amdgcn_ds_bpermute((lane ^ o) << 2, __float_as_int(v))); }
__device__ __forceinline__ float wave_sum(float v, int lane) {
#pragma unroll
    for (int o = 1; o < 64; o <<= 1) v += shfl_xor_f(v, o, lane);
    return v;
}
__device__ __forceinline__ unsigned char* opq(unsigned char* p) { asm volatile("" : "+s"(p)); return p; }
__device__ __forceinline__ float fsig(float x) { return __builtin_amdgcn_rcpf(1.0f + __builtin_amdgcn_exp2f(-LOG2E * x)); }
#define XB_TMO      128
#define XB_XCNT(j)  (256  + 64 * (j))
#define XB_XSUB(j)  (1280 + 64 * (j))
#define XB_XGEN(j)  (2304 + 64 * (j))
#define XB_TOP      3328
#define XB_TOPGEN   3392
#define XCD_BAR_WORDS 3456
#define XB_SPIN_CAP (1u << 25)

__device__ __forceinline__ unsigned xb_ld(unsigned* p)              { return __hip_atomic_load(p, __ATOMIC_RELAXED, __HIP_MEMORY_SCOPE_AGENT); }
__device__ __forceinline__ unsigned xb_add(unsigned* p, unsigned v) { return __hip_atomic_fetch_add(p, v, __ATOMIC_RELAXED, __HIP_MEMORY_SCOPE_AGENT); }
__device__ __forceinline__ unsigned xb_xcc_id() { return (unsigned)__builtin_amdgcn_s_getreg((3 << 11) | 20) & 0xFu; }
#define XB_SPIN(cond, bar) do { unsigned _sp = 0; while (cond) { __builtin_amdgcn_s_sleep(1); \
    if ((++_sp & 255u) == 0u) { if (xb_ld(&(bar)[XB_TMO])) break; if (_sp > XB_SPIN_CAP) { atomicAdd(&(bar)[XB_TMO], 1u); break; } } } } while (0)

struct XcdBarrier {
    unsigned* bar; unsigned x;
    volatile LAS unsigned* st;
};

__device__ __forceinline__ XcdBarrier xcd_barrier_post(unsigned* bar, volatile LAS unsigned* st) {
    XcdBarrier b; b.bar = bar; b.x = xb_xcc_id(); b.st = st;
    if (my_tid() == 0) (void)xb_add(&bar[XB_XCNT(b.x)], 1u);
    return b;
}
__device__ __forceinline__ void xcd_barrier_complete(unsigned* bar, unsigned x, unsigned& nloc, unsigned& nx) {
    const unsigned G = gridDim.x * gridDim.y * gridDim.z;
    unsigned sum, cnt, mine, sp = 0u;
    for (;;) {
        sum = 0u; cnt = 0u; mine = 0u;
#pragma unroll
        for (unsigned j = 0; j < 16; ++j) { const unsigned c = xb_ld(&bar[XB_XCNT(j)]); sum += c; cnt += (c > 0u) ? 1u : 0u; mine = (j == x) ? c : mine; }
        if (sum == G) break;
        __builtin_amdgcn_s_sleep(1);
        if ((++sp & 255u) == 0u) { if (xb_ld(&bar[XB_TMO])) break; if (sp > XB_SPIN_CAP) { atomicAdd(&bar[XB_TMO], 1u); break; } }
    }
    nloc = mine > 0u ? mine : 1u; nx = cnt > 0u ? cnt : 1u;
}

__device__ __forceinline__ void xcd_barrier(const XcdBarrier& b) {
    asm volatile("s_waitcnt vmcnt(0)" ::: "memory");
    __syncthreads();
    if (my_tid() == 0) {
        unsigned* bar = b.bar;
        __builtin_amdgcn_s_waitcnt(0);
        unsigned nloc = b.st[0], nx = b.st[1];
        if (nloc == 0u) { xcd_barrier_complete(bar, b.x, nloc, nx); b.st[0] = nloc; b.st[1] = nx; }
        const unsigned old = xb_add(&bar[XB_XSUB(b.x)], 1u);
        const unsigned gen = old / nloc;
        if (old + 1u == (gen + 1u) * nloc) {
            __builtin_amdgcn_fence(__ATOMIC_RELEASE, "agent");
            asm volatile("s_waitcnt vmcnt(0)" ::: "memory");
            const unsigned og = xb_add(&bar[XB_TOP], 1u);
            const unsigned tg = og / nx;
            if (og + 1u == (tg + 1u) * nx) xb_add(&bar[XB_TOPGEN], 1u);
            else XB_SPIN(xb_ld(&bar[XB_TOPGEN]) == tg, bar);
            __builtin_amdgcn_fence(__ATOMIC_ACQUIRE, "agent");
            xb_add(&bar[XB_XGEN(b.x)], 1u);
            asm volatile("s_waitcnt vmcnt(0)" ::: "memory");
        } else {
            XB_SPIN(xb_ld(&bar[XB_XGEN(b.x)]) == gen, bar);
            __builtin_amdgcn_fence(__ATOMIC_ACQUIRE, "agent");
            asm volatile("s_waitcnt vmcnt(0)" ::: "memory");
        }
    }
    __syncthreads();
}

__device__ __forceinline__ void sub_barrier(unsigned* bar, unsigned* ctr, unsigned n, bool arrive) {
    asm volatile("s_waitcnt vmcnt(0)" ::: "memory");
    __syncthreads();
    if (my_tid() == 0) {
        if (arrive) { __builtin_amdgcn_fence(__ATOMIC_RELEASE, "agent"); asm volatile("s_waitcnt vmcnt(0)" ::: "memory"); (void)xb_add(ctr, 1u); }
        XB_SPIN(xb_ld(ctr) < n, bar);
        __builtin_amdgcn_fence(__ATOMIC_ACQUIRE, "agent");
        asm volatile("s_waitcnt vmcnt(0)" ::: "memory");
    }
    __syncthreads();
}
namespace att {
__device__ __forceinline__ int crow(int r, int hi) { return (r & 3) + 8 * (r >> 2) + 4 * hi; }
__device__ __forceinline__ unsigned cvtpk(float lo, float hi) { return h_pk2(lo, hi); }
typedef short v4i16_t __attribute__((ext_vector_type(4)));
__device__ __forceinline__ s16x4 vtr(const LAS unsigned char* p) { return __builtin_bit_cast(s16x4, __builtin_amdgcn_ds_read_tr16_b64_v4i16((LAS v4i16_t*)p)); }
__device__ __forceinline__ float softmax_tile(f32x16& p0, f32x16& p1, float& m_reg, float& l_reg, bf16x8& pa0, bf16x8& pa1, bf16x8& pa2, bf16x8& pa3) {
    float pmax = p0[0];
#pragma unroll
    for (int r = 1; r < 16; ++r) pmax = fmaxf(pmax, p0[r]);
#pragma unroll
    for (int r = 0; r < 16; ++r) pmax = fmaxf(pmax, p1[r]);
    { auto rr = __builtin_amdgcn_permlane32_swap(__float_as_uint(pmax), __float_as_uint(pmax), false, false); pmax = fmaxf(__uint_as_float(rr[0]), __uint_as_float(rr[1])); }
    float alpha = 1.f;
    if (!__all(pmax - m_reg <= 8.f)) { const float mn = fmaxf(m_reg, pmax); alpha = __builtin_amdgcn_exp2f(m_reg - mn); m_reg = mn; }
    float ps = 0.f;
#pragma unroll
    for (int r = 0; r < 16; ++r) { p0[r] = __builtin_amdgcn_exp2f(p0[r] - m_reg); ps += p0[r]; }
#pragma unroll
    for (int r = 0; r < 16; ++r) { p1[r] = __builtin_amdgcn_exp2f(p1[r] - m_reg); ps += p1[r]; }
    { auto rr = __builtin_amdgcn_permlane32_swap(__float_as_uint(ps), __float_as_uint(ps), false, false); ps = __uint_as_float(rr[0]) + __uint_as_float(rr[1]); }
    l_reg = l_reg * alpha + ps;
#define PK4(P, BASE, OUT) do { unsigned a0 = cvtpk(P[BASE + 0], P[BASE + 1]), a1 = cvtpk(P[BASE + 2], P[BASE + 3]);   \
    unsigned b0 = cvtpk(P[BASE + 4], P[BASE + 5]), b1 = cvtpk(P[BASE + 6], P[BASE + 7]);                              \
    auto r0 = __builtin_amdgcn_permlane32_swap(a0, b0, false, false); auto r1 = __builtin_amdgcn_permlane32_swap(a1, b1, false, false); \
    v4u w = {r0[0], r1[0], r0[1], r1[1]}; OUT = __builtin_bit_cast(bf16x8, w); } while (0)
    PK4(p0, 0, pa0); PK4(p0, 8, pa1); PK4(p1, 0, pa2); PK4(p1, 8, pa3);
#undef PK4
    return alpha;
}
constexpr int MLA_KSTR = 400;
constexpr int MLA_KBUF = 64 * MLA_KSTR;
constexpr int ATT_SCR = 2 * MLA_KBUF;
__device__ __forceinline__ void mla_unit(LAS unsigned char* lds, const bf16* __restrict__ QP, const bf16* __restrict__ KV, bf16* __restrict__ OA, int b, int c) {
    int tid_ = my_tid(); asm volatile("" : "+v"(tid_));
    const int tid = tid_, lane = tid & 63, wid = __builtin_amdgcn_readfirstlane(tid >> 6), r32 = lane & 31, hi = lane >> 5;
    const int h = wid >> 1; const size_t qrow0 = (size_t)b * SEQ + c * 64 + (wid & 1) * 32;
    bf16x8 qr[12];
    { const bf16* qp = QP + (qrow0 + r32) * 768 + h * 192 + hi * 8;
#pragma unroll
      for (int d0 = 0; d0 < 12; ++d0) qr[d0] = *(const bf16x8*)(qp + d0 * 16); }
    float m_reg = -1e30f, l_reg = 0.f; f32x16 o[4];
#pragma unroll
    for (int d = 0; d < 4; ++d)
#pragma unroll
        for (int r = 0; r < 16; ++r) o[d][r] = 0.f;
    LAS float* scr = (LAS float*)(lds + ATT_SCR) + wid * 64;
    const bf16* kvb = KV + (size_t)b * SEQ * 192;
    int skey[3], sch[3];
#pragma unroll
    for (int i = 0; i < 3; ++i) { const int id = tid + 512 * i; skey[i] = id / 24; sch[i] = id % 24; }
    v4u st[3];
    const int NT = c + 1;
#pragma unroll
    for (int i = 0; i < 3; ++i) st[i] = *(const v4u*)(kvb + (size_t)skey[i] * 192 + sch[i] * 8);
#pragma unroll
    for (int i = 0; i < 3; ++i) *(LAS v4u*)(lds + skey[i] * MLA_KSTR + sch[i] * 16) = st[i];
    __syncthreads();
    const int troff = (((lane & 15) >> 2) + 8 * hi) * MLA_KSTR + (16 * ((lane >> 4) & 1) + 4 * (lane & 3)) * 2;
    for (int j = 0; j < NT; ++j) {
        const int buf = j & 1;
        if (j + 1 < NT) {
#pragma unroll
            for (int i = 0; i < 3; ++i) st[i] = *(const v4u*)(kvb + (size_t)(64 * (j + 1) + skey[i]) * 192 + sch[i] * 8);
        }
        const LAS unsigned char* kt = lds + buf * MLA_KBUF;
        f32x16 p0, p1;
#pragma unroll
        for (int r = 0; r < 16; ++r) { p0[r] = 0.f; p1[r] = 0.f; }
        { const LAS unsigned char* kb = kt + r32 * MLA_KSTR + hi * 16;
#pragma unroll
          for (int d0 = 0; d0 < 12; ++d0) { const bf16x8 a0 = *(const LAS bf16x8*)(kb + d0 * 32); const bf16x8 a1 = *(const LAS bf16x8*)(kb + 32 * MLA_KSTR + d0 * 32);
              p0 = MFMA32(a0, qr[d0], p0); p1 = MFMA32(a1, qr[d0], p1); } }
        bf16x8 pa0, pa1, pa2, pa3;
        const float alpha = softmax_tile(p0, p1, m_reg, l_reg, pa0, pa1, pa2, pa3);
        if (__any(alpha < 1.f)) { if (hi == 0) scr[r32] = alpha; LDS_WAIT();
#pragma unroll
            for (int r = 0; r < 16; ++r) { const float a = scr[crow(r, hi)];
#pragma unroll
                for (int d = 0; d < 4; ++d) o[d][r] *= a; } }
        const LAS unsigned char* vb = kt + troff;
#pragma unroll
        for (int d0 = 0; d0 < 4; ++d0) {
            s16x4 lo[4], hh[4];
#pragma unroll
            for (int ks = 0; ks < 4; ++ks) { lo[ks] = vtr(vb + (16 * ks) * MLA_KSTR + d0 * 64); hh[ks] = vtr(vb + (16 * ks + 4) * MLA_KSTR + d0 * 64); }
#define PK(k) (bf16x8){lo[k][0], lo[k][1], lo[k][2], lo[k][3], hh[k][0], hh[k][1], hh[k][2], hh[k][3]}
            o[d0] = MFMA32(pa0, PK(0), o[d0]);
            o[d0] = MFMA32(pa1, PK(1), o[d0]);
            o[d0] = MFMA32(pa2, PK(2), o[d0]);
            o[d0] = MFMA32(pa3, PK(3), o[d0]);
#undef PK
        }
        if (j + 1 < NT) {
#pragma unroll
            for (int i = 0; i < 3; ++i) *(LAS v4u*)(lds + (buf ^ 1) * MLA_KBUF + skey[i] * MLA_KSTR + sch[i] * 16) = st[i];
        }
        __syncthreads();
    }
    if (hi == 0) scr[r32] = l_reg; LDS_WAIT();
    bf16* ob = OA + qrow0 * 512 + h * 128 + r32;
#pragma unroll
    for (int r = 0; r < 16; ++r) { const int orow = crow(r, hi); const float rl = __builtin_amdgcn_rcpf(scr[orow]);
#pragma unroll
        for (int d0 = 0; d0 < 4; ++d0) ob[(size_t)orow * 512 + d0 * 32] = (bf16)f2bf(o[d0][r] * rl); }
    __syncthreads();
}
constexpr int CA_KSTR = 144;
constexpr int CA_TBUF = 64 * CA_KSTR;
constexpr int CA_BIAS = ATT_SCR + 8 * 256;
__device__ __forceinline__ void band_unit(LAS unsigned char* lds, const bf16* __restrict__ ZC, const float* __restrict__ relb, bf16* __restrict__ OC, int b, int h, int g) {
    int tid_ = my_tid(); asm volatile("" : "+v"(tid_));
    const int tid = tid_, lane = tid & 63, wid = __builtin_amdgcn_readfirstlane(tid >> 6), r32 = lane & 31, hi = lane >> 5;
    const int cw = 4 * g + (wid >> 1); const size_t qrow0 = (size_t)b * SEQ + cw * 64 + (wid & 1) * 32;
    LAS float* bias = (LAS float*)(lds + CA_BIAS);
    if (tid < 320) bias[tid] = relb[tid * 8 + h] * LOG2E;
    bf16x8 qr[4];
    { const bf16* qp = ZC + (qrow0 + r32) * 1536 + h * 64 + hi * 8;
#pragma unroll
      for (int d0 = 0; d0 < 4; ++d0) qr[d0] = *(const bf16x8*)(qp + d0 * 16); }
    float m_reg = -1e30f, l_reg = 0.f; f32x16 o[2];
#pragma unroll
    for (int d = 0; d < 2; ++d)
#pragma unroll
        for (int r = 0; r < 16; ++r) o[d][r] = 0.f;
    LAS float* scr = (LAS float*)(lds + ATT_SCR) + wid * 64;
    const int kc0 = (4 * g - 8) < 0 ? 0 : (4 * g - 8), kc1 = 4 * g + 3;
    const bf16* kbase = ZC + (size_t)b * SEQ * 1536 + 512 + h * 64; const bf16* vbase = kbase + 512;
    const int skey = tid >> 3, sch = tid & 7;
    v4u stk, stv;
    stk = *(const v4u*)(kbase + (size_t)(64 * kc0 + skey) * 1536 + sch * 8); stv = *(const v4u*)(vbase + (size_t)(64 * kc0 + skey) * 1536 + sch * 8);
    *(LAS v4u*)(lds + skey * CA_KSTR + sch * 16) = stk; *(LAS v4u*)(lds + CA_TBUF + skey * CA_KSTR + sch * 16) = stv;
    __syncthreads();
    const int troff = (((lane & 15) >> 2) + 8 * hi) * CA_KSTR + (16 * ((lane >> 4) & 1) + 4 * (lane & 3)) * 2;
    const int qin = (wid & 1) * 32 + r32;
    for (int kc = kc0; kc <= kc1; ++kc) {
        const int buf = (kc - kc0) & 1;
        if (kc < kc1) { stk = *(const v4u*)(kbase + (size_t)(64 * (kc + 1) + skey) * 1536 + sch * 8); stv = *(const v4u*)(vbase + (size_t)(64 * (kc + 1) + skey) * 1536 + sch * 8); }
        if (kc >= cw - 8 && kc <= cw) {
            const LAS unsigned char* kt = lds + buf * 2 * CA_TBUF;
            f32x16 p0, p1;
            const int dbase = (cw - kc) * 64 + qin + 63;
#pragma unroll
            for (int r = 0; r < 16; ++r) { int i0 = dbase - crow(r, hi), i1 = i0 - 32; i0 = i0 > 319 ? 319 : i0; i1 = i1 > 319 ? 319 : i1; p0[r] = bias[i0]; p1[r] = bias[i1]; }
            { const LAS unsigned char* kb = kt + r32 * CA_KSTR + hi * 16;
#pragma unroll
              for (int d0 = 0; d0 < 4; ++d0) { const bf16x8 a0 = *(const LAS bf16x8*)(kb + d0 * 32); const bf16x8 a1 = *(const LAS bf16x8*)(kb + 32 * CA_KSTR + d0 * 32);
                  p0 = MFMA32(a0, qr[d0], p0); p1 = MFMA32(a1, qr[d0], p1); } }
            bf16x8 pa0, pa1, pa2, pa3;
            const float alpha = softmax_tile(p0, p1, m_reg, l_reg, pa0, pa1, pa2, pa3);
            if (__any(alpha < 1.f)) { if (hi == 0) scr[r32] = alpha; LDS_WAIT();
#pragma unroll
                for (int r = 0; r < 16; ++r) { const float a = scr[crow(r, hi)]; o[0][r] *= a; o[1][r] *= a; } }
            const LAS unsigned char* vb = kt + CA_TBUF + troff;
#pragma unroll
            for (int d0 = 0; d0 < 2; ++d0) {
                s16x4 lo[4], hh[4];
#pragma unroll
                for (int ks = 0; ks < 4; ++ks) { lo[ks] = vtr(vb + (16 * ks) * CA_KSTR + d0 * 64); hh[ks] = vtr(vb + (16 * ks + 4) * CA_KSTR + d0 * 64); }
#define PK(k) (bf16x8){lo[k][0], lo[k][1], lo[k][2], lo[k][3], hh[k][0], hh[k][1], hh[k][2], hh[k][3]}
                o[d0] = MFMA32(pa0, PK(0), o[d0]);
                o[d0] = MFMA32(pa1, PK(1), o[d0]);
                o[d0] = MFMA32(pa2, PK(2), o[d0]);
                o[d0] = MFMA32(pa3, PK(3), o[d0]);
#undef PK
            }
        }
        if (kc < kc1) { *(LAS v4u*)(lds + (buf ^ 1) * 2 * CA_TBUF + skey * CA_KSTR + sch * 16) = stk; *(LAS v4u*)(lds + (buf ^ 1) * 2 * CA_TBUF + CA_TBUF + skey * CA_KSTR + sch * 16) = stv; }
        __syncthreads();
    }
    if (hi == 0) scr[r32] = l_reg; LDS_WAIT();
    bf16* ob = OC + qrow0 * 512 + h * 64 + r32;
#pragma unroll
    for (int r = 0; r < 16; ++r) { const int orow = crow(r, hi); const float rl = __builtin_amdgcn_rcpf(scr[orow]);
        ob[(size_t)orow * 512] = (bf16)f2bf(o[0][r] * rl); ob[(size_t)orow * 512 + 32] = (bf16)f2bf(o[1][r] * rl); }
    __syncthreads();
}
}
struct Args { const float* in[30]; float* out; unsigned char* ws; int start; int stop; };
#define KAS __attribute__((address_space(4)))
__device__ __forceinline__ const KAS unsigned char* kbase() { const KAS unsigned char* p = (const KAS unsigned char*)__builtin_amdgcn_kernarg_segment_ptr(); asm volatile("" : "+s"(p)); return p; }
__device__ __forceinline__ const float* kin(int i) { return *(const float* const KAS*)(kbase() + 8 * i); }
__device__ __forceinline__ float* kout() { return *(float* const KAS*)(kbase() + 240); }
__device__ __forceinline__ unsigned char* kws() { return *(unsigned char* const KAS*)(kbase() + 248); }
__device__ __forceinline__ int kstart() { return *(const int KAS*)(kbase() + 256); }
__device__ __forceinline__ int kstop() { return *(const int KAS*)(kbase() + 260); }
struct Frame { LAS unsigned char* lds; int tid, lane, wave, G, gw, NGW; };
__device__ __forceinline__ Frame make_frame(LAS unsigned char* lds) {
    Frame F; int tid = my_tid(); asm volatile("" : "+v"(tid)); int bx = blockIdx.x; asm volatile("" : "+s"(bx)); int G = gridDim.x; asm volatile("" : "+s"(G));
    F.lds = lds; F.tid = tid; F.lane = tid & 63; F.wave = __builtin_amdgcn_readfirstlane(tid >> 6); F.G = G; F.gw = bx * NWAVES + F.wave; F.NGW = G * NWAVES; return F;
}

__device__ const double ROPE_INV_FREQ[32] = {1, 0.74989420933245587, 0.56234132519034907, 0.42169650342858223, 0.31622776601683794, 0.23713737056616552, 0.17782794100389229, 0.1333521432163324, 0.10000000000000001, 0.074989420933245579, 0.056234132519034911, 0.042169650342858224, 0.031622776601683791, 0.023713737056616554, 0.017782794100389229, 0.013335214321633241, 0.01, 0.0074989420933245579, 0.005623413251903491, 0.0042169650342858229, 0.0031622776601683794, 0.0023713737056616554, 0.0017782794100389228, 0.0013335214321633241, 0.001, 0.00074989420933245586, 0.0005623413251903491, 0.00042169650342858224, 0.00031622776601683794, 0.00023713737056616554, 0.00017782794100389227, 0.0001333521432163324};
__device__ __forceinline__ void sincos_d(double a, float& s, float& c) {
    const double n = rint(a * 0.63661977236758134308);
    double r = fma(-n, 1.5707963267948966192, a); r = fma(-n, 6.123233995736766036e-17, r);
    const double r2 = r * r;
    double sp = -7.6471637318198164759e-13; sp = fma(sp, r2, 1.6059043836821614599e-10); sp = fma(sp, r2, -2.5052108385441718775e-08); sp = fma(sp, r2, 2.7557319223985890653e-06);
    sp = fma(sp, r2, -1.9841269841269841270e-04); sp = fma(sp, r2, 8.3333333333333333333e-03); sp = fma(sp, r2, -1.6666666666666666667e-01);
    const double sn = fma(sp * r2, r, r);
    double cp = 4.7794773323873852974e-14; cp = fma(cp, r2, -1.1470745597729724714e-11); cp = fma(cp, r2, 2.0876756987868098979e-09); cp = fma(cp, r2, -2.7557319223985890653e-07);
    cp = fma(cp, r2, 2.4801587301587301587e-05); cp = fma(cp, r2, -1.3888888888888888889e-03); cp = fma(cp, r2, 4.1666666666666666667e-02); cp = fma(cp, r2, -0.5);
    const double cs = fma(cp, r2, 1.0);
    const long long q = (long long)n & 3LL; double so, co;
    if (q == 0) { so = sn; co = cs; } else if (q == 1) { so = cs; co = -sn; } else if (q == 2) { so = -sn; co = -cs; } else { so = -cs; co = sn; }
    s = (float)so; c = (float)co;
}
__device__ __forceinline__ void transpose_item(const float* W, int ldw, int col0, int nblk, bf16* WT, int ldt, int row0, LAS float* scr, int item, int lane) {
    const int kb = item / nblk, nb = item % nblk, k0 = 64 * kb, n0 = 32 * nb;
#pragma unroll 8
    for (int i = 0; i < 32; ++i) { const int kk = 2 * i + (lane >> 5); scr[kk * 33 + (lane & 31)] = W[(size_t)(k0 + kk) * ldw + col0 + n0 + (lane & 31)]; }
    LDS_WAIT(); asm volatile("" ::: "memory");
    const int c = lane & 7;
#pragma unroll
    for (int j = 0; j < 4; ++j) { const int n = (lane >> 3) + 8 * j; const LAS float* s = scr + (8 * c) * 33 + n;
        v4u o; o.x = pk2(s[0 * 33], s[1 * 33]); o.y = pk2(s[2 * 33], s[3 * 33]); o.z = pk2(s[4 * 33], s[5 * 33]); o.w = pk2(s[6 * 33], s[7 * 33]);
        *(GAS v4u*)(WT + (size_t)(row0 + n0 + n) * ldt + k0 + 8 * c) = o; }
    LDS_WAIT(); asm volatile("" ::: "memory");
}
__device__ __forceinline__ void rope_table(LAS unsigned char* lds_) {
    const Frame F = make_frame(lds_); const int gt = F.gw * 64 + F.lane, NTH = F.NGW * 64;
    const int* pos = (const int*)kin(2); float* rope = (float*)(kws() + WS_ROPE);
    for (int i = gt; i < T * 32; i += NTH) { float s, c; sincos_d((double)pos[i >> 5] * ROPE_INV_FREQ[i & 31], s, c); rope[2 * (size_t)i] = c; rope[2 * (size_t)i + 1] = s; }
}
__device__ __forceinline__ void p0_prologue(LAS unsigned char* lds_, const Args& A, int l) {
    const Frame F = make_frame(lds_);
    LAS float* scr = (LAS float*)(F.lds + RING_OFF + F.wave * 16384);
    constexpr int I1 = 16 * 14, I2 = 16 * 48, I3 = 16 * 56, I4 = 16 * 96, I5 = 8 * 32, I6 = 8 * 32, I7 = 16 * 32, I8 = 16 * 128, I9 = 64 * 32, I10 = 16 * 32, I11 = 4 * 32;
    constexpr int NITEMS = I1 + I2 + I3 + I4 + I5 + I6 + I7 + I8 + I9 + I10 + I11;
#define WIN_ (kin(4) + (size_t)l * 1024 * IN_COLS)
#define WBR_ (kin(21) + (size_t)l * 1536 * 1024)
    for (int it = F.gw; it < NITEMS; it += F.NGW) {
        int r = it;
        if (r < I1) { transpose_item(WIN_, IN_COLS, 0, 14, (bf16*)(kws() + W_IN), 1024, 0, scr, r, F.lane); continue; } r -= I1;
        if (r < I2) { transpose_item(WIN_, IN_COLS, 2240, 48, (bf16*)(kws() + W_IN), 1024, 512, scr, r, F.lane); continue; } r -= I2;
        if (r < I3) { transpose_item(WIN_, IN_COLS, 448, 56, (bf16*)(kws() + W_IN), 1024, 2048, scr, r, F.lane); continue; } r -= I3;
        if (r < I4) { transpose_item(WIN_, IN_COLS, 3776, 96, (bf16*)(kws() + W_IN), 1024, 3840, scr, r, F.lane); continue; } r -= I4;
        if (r < I5) { transpose_item(WBR_ + (size_t)512 * 1024, 1024, 0, 32, (bf16*)(kws() + W_B) + (size_t)1024 * 512, 512, 0, scr, r, F.lane); continue; } r -= I5;
        if (r < I6) { transpose_item(WBR_ + (size_t)1024 * 1024, 1024, 0, 32, (bf16*)(kws() + W_B) + (size_t)2 * 1024 * 512, 512, 0, scr, r, F.lane); continue; } r -= I6;
        if (r < I7) { transpose_item(kin(22) + (size_t)l * 1024 * 1024, 1024, 0, 32, (bf16*)(kws() + W_OUT), 1024, 0, scr, r, F.lane); continue; } r -= I7;
        if (r < I8) { transpose_item(kin(25) + (size_t)l * 1024 * 4096, 4096, 0, 128, (bf16*)(kws() + W_1), 1024, 0, scr, r, F.lane); continue; } r -= I8;
        if (r < I9) { transpose_item(kin(26) + (size_t)l * 4096 * 1024, 1024, 0, 32, (bf16*)(kws() + W_2), 4096, 0, scr, r, F.lane); continue; } r -= I9;
        if (r < I10) { transpose_item(kin(28) + (size_t)l * 1024 * 1024, 1024, 0, 32, (bf16*)(kws() + W_G), 1024, 0, scr, r, F.lane); continue; } r -= I10;
        transpose_item(kin(29) + (size_t)l * 256 * 1024, 1024, 0, 32, (bf16*)(kws() + W_P), 256, 0, scr, r, F.lane);
    }
    const int gt = F.gw * 64 + F.lane, NTH = F.NGW * 64;
    { bf16* WinT = (bf16*)(kws() + W_IN); for (int i = gt; i < 64 * 1024; i += NTH) WinT[(size_t)448 * 1024 + i] = 0; }
    { const float* w_uq = kin(7) + (size_t)l * 256 * 768; const float* w_ukv = kin(8) + (size_t)l * 128 * 1024; bf16* WqT = (bf16*)(kws() + W_Q);
      for (int i = gt; i < 768 * 256; i += NTH) {
        const int n = i >> 8, kq = i & 255, h = n / 192, ii = n % 192; float s;
        if (ii < 128) { s = 0.f; const float* a = w_uq + (size_t)kq * 768 + h * 192; const float* b = w_ukv + (size_t)ii * 1024 + h * 256;
            for (int nn = 0; nn < 128; ++nn) s = fmaf(a[nn], b[nn], s); }
        else { const int jj = ii - 128, j = jj >> 1; s = w_uq[(size_t)kq * 768 + h * 192 + 128 + ((jj & 1) ? j + 32 : j)]; }
        WqT[i] = (bf16)f2bf(s);
      } }
    { const float* w_ukv = kin(8) + (size_t)l * 128 * 1024; const float* w_br = WBR_; bf16* WbT = (bf16*)(kws() + W_B);
      for (int i = gt; i < 512 * 1024; i += NTH) {
        const int dd = i & 1023, hl = i >> 10, h = hl >> 7, lat = hl & 127; float s = 0.f;
        const float* a = w_ukv + (size_t)lat * 1024 + h * 256 + 128; const float* b = w_br + (size_t)(h * 128) * 1024 + dd;
        for (int v = 0; v < 128; ++v) s = fmaf(a[v], b[(size_t)v * 1024], s);
        WbT[(size_t)dd * 512 + hl] = (bf16)f2bf(s);
      } }
    { const float* w_up = kin(11) + (size_t)l * 64 * 512; const float* a_up = kin(13) + (size_t)l * 64 * 512; const float* g_up = kin(14) + (size_t)l * 128 * 512; bf16* WloT = (bf16*)(kws() + W_LORA);
      for (int i = gt; i < 1536 * 256; i += NTH) {
        const int n = i >> 8, k = i & 255, blk = n >> 9, nn = n & 511; float s = 0.f;
        if (blk == 0) { if (k < 64) s = w_up[(size_t)k * 512 + nn]; } else if (blk == 1) { if (k >= 64 && k < 128) s = a_up[(size_t)(k - 64) * 512 + nn]; } else { if (k >= 128) s = g_up[(size_t)(k - 128) * 512 + nn]; }
        WloT[i] = (bf16)f2bf(s);
      } }
#undef WIN_
#undef WBR_
}
__device__ __forceinline__ void u_rowpass(LAS unsigned char* lds_, int l, bool from_x) {
    const Frame F = make_frame(lds_); unsigned char* ws = kws();
    const float* g = kin(3) + l * 1024; bf16* U = (bf16*)(ws + WS_U); bf16* H16 = (bf16*)((unsigned char*)kout() + DO_H16);
    f32x4 gv[4];
#pragma unroll
    for (int j = 0; j < 4; ++j) gv[j] = *(const f32x4*)(g + 4 * F.lane + 256 * j);
    for (int m = F.gw; m < T; m += F.NGW) {
        f32x4 v[4]; float s = 0.f;
        if (from_x) { const f32x4* xr = (const f32x4*)(kin(0) + (size_t)m * D) + F.lane; v2u* ho = (v2u*)(H16 + (size_t)m * D) + F.lane;
#pragma unroll
            for (int j = 0; j < 4; ++j) { v[j] = xr[64 * j]; v2u w; w.x = pk2(v[j].x, v[j].y); w.y = pk2(v[j].z, v[j].w); ho[64 * j] = w; } }
        else { const v2u* hr = (const v2u*)(H16 + (size_t)m * D) + F.lane;
#pragma unroll
            for (int j = 0; j < 4; ++j) { const v2u w = hr[64 * j]; v[j] = (f32x4){bfl(w.x), bfh(w.x), bfl(w.y), bfh(w.y)}; } }
#pragma unroll
        for (int j = 0; j < 4; ++j) s += (v[j].x * v[j].x + v[j].y * v[j].y) + (v[j].z * v[j].z + v[j].w * v[j].w);
        const float rs = rsqrtf(wave_sum(s, F.lane) * (1.f / D) + NORM_EPS);
        v2u* o8 = (v2u*)(U + (size_t)m * D) + F.lane;
#pragma unroll
        for (int j = 0; j < 4; ++j) { const f32x4 y = v[j] * rs * gv[j]; v2u w; w.x = pk2(y.x, y.y); w.y = pk2(y.z, y.w); o8[64 * j] = w; }
    }
}
__device__ __forceinline__ void p2_mla_prep(LAS unsigned char* lds_, int l, int wg0, int nwg) {
    const Frame F = make_frame(lds_); const int gw = F.gw - wg0 * NWAVES, NGW = nwg * NWAVES;
    const bf16* ZM = (const bf16*)(kws() + WS_OA); bf16* QN = (bf16*)(kws() + X_QN); bf16* KV = (bf16*)(kws() + X_KV); const float* rope = (const float*)(kws() + WS_ROPE);
    const f32x4 gq = *(const f32x4*)(kin(5) + l * 256 + 4 * F.lane); const float gk0 = kin(6)[l * 128 + 2 * F.lane], gk1 = kin(6)[l * 128 + 2 * F.lane + 1];
    for (int g = gw; g < T / 4; g += NGW) {
        v2u wq[4]; unsigned wk[4]; unsigned short wr[4]; float rc[4], rsn[4];
#pragma unroll
        for (int i = 0; i < 4; ++i) { const int t = 4 * g + i; const bf16* z = ZM + (size_t)t * 512;
            wq[i] = *(const GAS v2u*)(z + 4 * F.lane); wk[i] = *(const GAS unsigned*)(z + 256 + 2 * F.lane); wr[i] = *(const GAS unsigned short*)(z + 384 + F.lane);
            rc[i] = *(const GAS float*)(rope + ((size_t)t * 32 + (F.lane & 31)) * 2); rsn[i] = *(const GAS float*)(rope + ((size_t)t * 32 + (F.lane & 31)) * 2 + 1); }
        asm volatile("" : "+v"(wq[0]), "+v"(wq[1]), "+v"(wq[2]), "+v"(wq[3]), "+v"(wk[0]), "+v"(wk[1]), "+v"(wk[2]), "+v"(wk[3]));
#pragma unroll
        for (int i = 0; i < 4; ++i) { const int t = 4 * g + i;
            const float kr = bfl((unsigned)wr[i]);
            const float q0 = bfl(wq[i].x), q1 = bfh(wq[i].x), q2 = bfl(wq[i].y), q3 = bfh(wq[i].y), k0 = bfl(wk[i]), k1 = bfh(wk[i]);
            const float rq = rsqrtf(wave_sum(q0 * q0 + q1 * q1 + q2 * q2 + q3 * q3, F.lane) * (1.f / 256.f) + NORM_EPS);
            const float rk = rsqrtf(wave_sum(k0 * k0 + k1 * k1, F.lane) * (1.f / 128.f) + NORM_EPS);
            v2u o; o.x = pk2(q0 * rq * gq.x, q1 * rq * gq.y); o.y = pk2(q2 * rq * gq.z, q3 * rq * gq.w);
            *(GAS v2u*)(QN + (size_t)t * 256 + 4 * F.lane) = o;
            *(GAS unsigned*)(KV + (size_t)t * 192 + 2 * F.lane) = pk2(k0 * rk * gk0, k1 * rk * gk1);
            const float other = shfl_xor_f(kr, 32, F.lane);
            if (F.lane < 32) *(GAS unsigned*)(KV + (size_t)t * 192 + 128 + 2 * F.lane) = pk2(kr * rc[i] - other * rsn[i], other * rc[i] + kr * rsn[i]); }
    }
}
__device__ __forceinline__ void p6_rw_prep(LAS unsigned char* lds_, int l) {
    const Frame F = make_frame(lds_);
    const bf16* ZR = (const bf16*)(kws() + X_ZR); bf16* LA = (bf16*)(kws() + X_LA);
    const f32x4 mu = *(const f32x4*)(kin(9) + l * RW_COLS + 1536 + 4 * F.lane);
    for (int g = F.gw; g < T / 4; g += F.NGW) {
        const int t0 = 4 * g; v2u w[5];
        w[0].x = 0u; w[0].y = 0u;
        if ((t0 & (SEQ - 1)) != 0) w[0] = *(const GAS v2u*)(ZR + (size_t)(t0 - 1) * 1792 + 1536 + 4 * F.lane);
#pragma unroll
        for (int i = 0; i < 4; ++i) w[i + 1] = *(const GAS v2u*)(ZR + (size_t)(t0 + i) * 1792 + 1536 + 4 * F.lane);
        asm volatile("" : "+v"(w[0]), "+v"(w[1]), "+v"(w[2]), "+v"(w[3]), "+v"(w[4]));
#pragma unroll
        for (int i = 0; i < 4; ++i) { const v2u wc = w[i + 1], wp = w[i];
            float z[4] = {bfl(wc.x), bfh(wc.x), bfl(wc.y), bfh(wc.y)}; const float p[4] = {bfl(wp.x), bfh(wp.x), bfl(wp.y), bfh(wp.y)}; const float m[4] = {mu.x, mu.y, mu.z, mu.w};
#pragma unroll
            for (int e = 0; e < 4; ++e) { float v = z[e] + (p[e] - z[e]) * m[e]; if (F.lane < 16) v = 1.f - 2.f * __builtin_amdgcn_rcpf(1.f + __builtin_amdgcn_exp2f(2.f * LOG2E * v)); else if (F.lane >= 32) v = fsig(v); z[e] = v; }
            v2u o; o.x = pk2(z[0], z[1]); o.y = pk2(z[2], z[3]); *(GAS v2u*)(LA + (size_t)(t0 + i) * 256 + 4 * F.lane) = o; }
    }
}
template <int MODE>
__device__ __forceinline__ void rowpass(LAS unsigned char* lds_, const Args& A, const bf16* M, const float* g1, const float* g2, const float* pl) {
    const Frame F = make_frame(lds_);
    bf16* U = (bf16*)(kws() + WS_U); bf16* PB = (bf16*)(kws() + X_PB); bf16* H16 = (bf16*)((unsigned char*)kout() + DO_H16);
    f32x4 g1v[4], g2v[4];
#pragma unroll
    for (int j = 0; j < 4; ++j) { g1v[j] = *(const f32x4*)(g1 + 4 * F.lane + 256 * j); if (MODE == 0) g2v[j] = *(const f32x4*)(g2 + 4 * F.lane + 256 * j); }
    for (int m = F.gw; m < T; m += F.NGW) {
        const v2u* mr = (const v2u*)(M + (size_t)m * D) + F.lane; v2u* hr = (v2u*)(H16 + (size_t)m * D) + F.lane;
        f32x4 x[4], hv[4]; float s = 0.f;
#pragma unroll
        for (int j = 0; j < 4; ++j) { const v2u w = mr[64 * j]; x[j] = (f32x4){bfl(w.x), bfh(w.x), bfl(w.y), bfh(w.y)}; const v2u hw = hr[64 * j]; hv[j] = (f32x4){bfl(hw.x), bfh(hw.x), bfl(hw.y), bfh(hw.y)};
            s += (x[j].x * x[j].x + x[j].y * x[j].y) + (x[j].z * x[j].z + x[j].w * x[j].w); }
        const float rs = rsqrtf(wave_sum(s, F.lane) * (1.f / D) + NORM_EPS); float s2 = 0.f;
#pragma unroll
        for (int j = 0; j < 4; ++j) { hv[j] = hv[j] + x[j] * rs * g1v[j]; v2u w; w.x = pk2(hv[j].x, hv[j].y); w.y = pk2(hv[j].z, hv[j].w); hr[64 * j] = w;
            s2 += (hv[j].x * hv[j].x + hv[j].y * hv[j].y) + (hv[j].z * hv[j].z + hv[j].w * hv[j].w); }
        if (MODE == 0) { const float rs2 = rsqrtf(wave_sum(s2, F.lane) * (1.f / D) + NORM_EPS); v2u* o8 = (v2u*)(U + (size_t)m * D) + F.lane;
#pragma unroll
            for (int j = 0; j < 4; ++j) { const f32x4 y = hv[j] * rs2 * g2v[j]; v2u w; w.x = pk2(y.x, y.y); w.y = pk2(y.z, y.w); o8[64 * j] = w; } }
        else { v2u* o8 = (v2u*)(U + (size_t)m * D) + F.lane;
#pragma unroll
            for (int j = 0; j < 4; ++j) { v2u w; w.x = pk2(hv[j].x, hv[j].y); w.y = pk2(hv[j].z, hv[j].w); o8[64 * j] = w; }
            const f32x4 pv = *((const f32x4*)(pl + (size_t)m * DPLE) + F.lane); v2u w; w.x = pk2(pv.x, pv.y); w.y = pk2(pv.z, pv.w); *((v2u*)(PB + (size_t)m * DPLE) + F.lane) = w; }
    }
}
namespace rw {
typedef short v4i16_t __attribute__((ext_vector_type(4)));
constexpr int RS = 144;
constexpr int O_AT = 0, O_BT = 9216, O_KT = 18432, O_RT = 27648;
constexpr int O_UV = 36864;
constexpr int O_BK = O_UV + 4 * 32 * RS;
constexpr int O_SB = O_BK + 4 * 32 * RS;
constexpr int O_W1 = O_SB + 64 * RS;
constexpr int O_SM = O_W1 + 64 * RS;
constexpr int O_GC = O_SM + 16 * 1024;
constexpr int O_CB = O_GC + 1024;
constexpr int O_LM = O_CB + 256;
constexpr int O_YO = O_LM + 4096;
constexpr int O_PAR = O_YO + 64 * RS;
constexpr int LDS_END = O_PAR + 512;
static_assert(LDS_END <= RING_BYTES, "rwkv LDS map");
__device__ __forceinline__ bf16x8 trfrag(const LAS unsigned char* p) {
    const s16x4 lo = __builtin_bit_cast(s16x4, __builtin_amdgcn_ds_read_tr16_b64_v4i16((LAS v4i16_t*)p));
    const s16x4 hh = __builtin_bit_cast(s16x4, __builtin_amdgcn_ds_read_tr16_b64_v4i16((LAS v4i16_t*)(p + 4 * RS)));
    return (bf16x8){lo[0], lo[1], lo[2], lo[3], hh[0], hh[1], hh[2], hh[3]};
}
__device__ __forceinline__ unsigned pk_rtz(float lo, float hi) { typedef __fp16 hp2 __attribute__((ext_vector_type(2))); const hp2 v = __builtin_amdgcn_cvt_pkrtz(lo, hi); return __builtin_bit_cast(unsigned, v); }
typedef _Float16 h16x4_t __attribute__((ext_vector_type(4)));
__device__ __forceinline__ h16x4_t tr4(const LAS unsigned char* p) { return __builtin_bit_cast(h16x4_t, __builtin_amdgcn_ds_read_tr16_b64_v4i16((LAS v4i16_t*)p)); }
__device__ __forceinline__ h16x4_t ld4h(const LAS unsigned char* p) { return *(const LAS h16x4_t*)p; }
__device__ __forceinline__ h16x4_t acc2h(const f32x4 v) { typedef unsigned u2 __attribute__((ext_vector_type(2))); u2 w; w.x = pk_rtz(v[0], v[1]); w.y = pk_rtz(v[2], v[3]); return __builtin_bit_cast(h16x4_t, w); }
__device__ __forceinline__ f32x4 MFMA4(h16x4_t a, h16x4_t b, f32x4 c) { return __builtin_amdgcn_mfma_f32_16x16x16f16(a, b, c, 0, 0, 0); }
__device__ __forceinline__ void lbar() { asm volatile("s_waitcnt lgkmcnt(0)\n\ts_barrier" ::: "memory"); }
__device__ __forceinline__ void st_bf(LAS unsigned char* p, float x) { *(LAS unsigned short*)p = (unsigned short)h_f2h(__builtin_amdgcn_fmed3f(x, -60000.f, 60000.f)); }
__device__ __forceinline__ void st2(LAS unsigned char* p0, LAS unsigned char* p1, float x0, float x1) { const unsigned w = pk_rtz(x0, x1); *(LAS unsigned short*)p0 = (unsigned short)w; *(LAS unsigned short*)p1 = (unsigned short)(w >> 16); }
__device__ __forceinline__ void st4(LAS unsigned char* p, int stride, const f32x4 v) { st2(p, p + stride, v[0], v[1]); st2(p + 2 * stride, p + 3 * stride, v[2], v[3]); }
__device__ __forceinline__ float ld_bf(const LAS unsigned char* p) { return bfl((unsigned)*(const LAS unsigned short*)p); }
template <int CTRL> __device__ __forceinline__ float dpp_add(float v) { return v + __int_as_float(__builtin_amdgcn_update_dpp(0, __float_as_int(v), CTRL, 0xf, 0xf, true)); }
__device__ __forceinline__ void wsum8(float (&v)[8], int lane) {
#pragma unroll
    for (int e = 0; e < 8; ++e) { float x = v[e]; x = dpp_add<0xB1>(x); x = dpp_add<0x4E>(x); x = dpp_add<0x141>(x); x = dpp_add<0x140>(x); v[e] = x; }
#pragma unroll
    for (int e = 0; e < 8; ++e) v[e] += shfl_xor_f(v[e], 16, lane);
#pragma unroll
    for (int e = 0; e < 8; ++e) v[e] += shfl_xor_f(v[e], 32, lane);
}
__device__ __forceinline__ void wsum16(float (&a)[8], float (&b)[8], int lane) {
#pragma unroll
    for (int e = 0; e < 8; ++e) { float x = a[e]; x = dpp_add<0xB1>(x); x = dpp_add<0x4E>(x); x = dpp_add<0x141>(x); x = dpp_add<0x140>(x); a[e] = x;
                                  float y = b[e]; y = dpp_add<0xB1>(y); y = dpp_add<0x4E>(y); y = dpp_add<0x141>(y); y = dpp_add<0x140>(y); b[e] = y; }
    float ta[8], tb[8];
#pragma unroll
    for (int e = 0; e < 8; ++e) { ta[e] = shfl_xor_f(a[e], 16, lane); tb[e] = shfl_xor_f(b[e], 16, lane); }
#pragma unroll
    for (int e = 0; e < 8; ++e) { a[e] += ta[e]; b[e] += tb[e]; }
#pragma unroll
    for (int e = 0; e < 8; ++e) { ta[e] = shfl_xor_f(a[e], 32, lane); tb[e] = shfl_xor_f(b[e], 32, lane); }
#pragma unroll
    for (int e = 0; e < 8; ++e) { a[e] += ta[e]; b[e] += tb[e]; }
}
__device__ __forceinline__ void rw_unit(LAS unsigned char* lds, int l, int seq) {
    int tid_ = my_tid(); asm volatile("" : "+v"(tid_));
    const int tid = tid_, lane = tid & 63, w = __builtin_amdgcn_readfirstlane(tid >> 6), g4 = lane >> 4, l15 = lane & 15, q4 = l15 >> 2, p4 = lane & 3;
    const int b = seq >> 3, h = seq & 7;
    const bf16* ZRb = (const bf16*)(kws() + X_ZR) + (size_t)b * SEQ * 1792 + h * 64;
    const bf16* TWb = (const bf16*)(kws() + X_TW) + (size_t)b * SEQ * 512 + h * 64; const bf16* TAb = (const bf16*)((const unsigned char*)kout() + DO_TA) + (size_t)b * SEQ * 512 + h * 64; const bf16* Gb = (const bf16*)((const unsigned char*)kout() + DO_G) + (size_t)b * SEQ * 512 + h * 64;
    bf16* ORWb = (bf16*)(kws() + WS_ORW) + (size_t)b * SEQ * 512 + h * 64;
    LAS float* par = (LAS float*)(lds + O_PAR);
    const int pc = h * 64 + lane;
    const float mu_r = kin(9)[l * RW_COLS + pc], mu_k = kin(9)[l * RW_COLS + 512 + pc], mu_v = kin(9)[l * RW_COLS + 1024 + pc];
    const float k_k = kin(15)[l * 512 + pc], k_a = kin(16)[l * 512 + pc], r_k = kin(17)[l * 512 + pc];
    if (tid < 64) { par[tid] = kin(18)[l * 512 + pc]; par[64 + tid] = kin(19)[l * 512 + pc]; }
    for (int i = tid; i < (O_GC - O_UV) / 4; i += 512) ((LAS unsigned*)(lds + O_UV))[i] = 0u;
    f32x4 ST[4] = {{0.f, 0.f, 0.f, 0.f}, {0.f, 0.f, 0.f, 0.f}, {0.f, 0.f, 0.f, 0.f}, {0.f, 0.f, 0.f, 0.f}};
    __syncthreads();
    const int et = tid >> 3, ecg = tid & 7, ei = et >> 4, ett = et & 15;
    const int trrow = 8 * g4 + q4, trrow1 = 8 * (g4 & 1) + q4, trcol = 8 * p4;
    const int ei2 = w >> 1, ehf = w & 1;
    unsigned ptw[16], pcr[8], pck[8], pcv[8], pta[8], ppr, ppk, ppv; v4u pgg;
#define RW_LOADS(TOK0) do { const size_t r0_ = (size_t)(TOK0) + 16 * ei2, rA_ = r0_ + 8 * ehf; \
        _Pragma("unroll") for (int s = 0; s < 16; ++s) ptw[s] = (unsigned)TWb[(r0_ + s) * 512 + lane]; \
        _Pragma("unroll") for (int tt = 0; tt < 8; ++tt) { const bf16* zc_ = ZRb + (rA_ + tt) * 1792 + lane; pcr[tt] = (unsigned)zc_[0]; pck[tt] = (unsigned)zc_[512]; pcv[tt] = (unsigned)zc_[1024]; pta[tt] = (unsigned)TAb[(rA_ + tt) * 512 + lane]; } \
        { const bf16* zp_ = ZRb + (rA_ > 0 ? rA_ - 1 : 0) * 1792 + lane; ppr = (unsigned)zp_[0]; ppk = (unsigned)zp_[512]; ppv = (unsigned)zp_[1024]; if (rA_ == 0) { ppr = 0u; ppk = 0u; ppv = 0u; } } \
        pgg = *(const v4u*)(Gb + (size_t)((TOK0) + et) * 512 + 8 * ecg); } while (0)
    RW_LOADS(0);
    for (int sc = 0; sc < SEQ / 64; ++sc) {
        const int tok0 = sc * 64;
        unsigned twv[16], ucr[8], uck[8], ucv[8], uta[8], upr, upk, upv; v4u ugg;
        {
#pragma unroll
            for (int s = 0; s < 16; ++s) twv[s] = ptw[s];
#pragma unroll
            for (int tt = 0; tt < 8; ++tt) { ucr[tt] = pcr[tt]; uck[tt] = pck[tt]; ucv[tt] = pcv[tt]; uta[tt] = pta[tt]; }
            upr = ppr; upk = ppk; upv = ppv; ugg = pgg;
        }
        {   const int c = lane;
            float cumLo[8], cumHi[8];
            {   asm volatile("" : "+v"(twv[0]), "+v"(twv[1]), "+v"(twv[2]), "+v"(twv[3]), "+v"(twv[4]), "+v"(twv[5]), "+v"(twv[6]), "+v"(twv[7]), "+v"(twv[8]), "+v"(twv[9]), "+v"(twv[10]), "+v"(twv[11]), "+v"(twv[12]), "+v"(twv[13]), "+v"(twv[14]), "+v"(twv[15]));
                float run = 0.f;
#pragma unroll
                for (int s = 0; s < 16; ++s) { run += bfl(twv[s]); if (s < 8) cumLo[s] = run; else cumHi[s - 8] = run; } }
            const float tot = cumHi[7];
            const float fh = ehf ? 1.f : 0.f;
            const float gctot = __builtin_amdgcn_exp2f(LOG2E * tot);
            if (ehf == 0) ((LAS float*)(lds + O_GC))[ei2 * 64 + c] = gctot;
            float pr = bfl(upr), pk = bfl(upk), pv = bfl(upv);
            float rr[8], kkv[8], av[8], kmv[8], vv[8], ss[8], cbv[8];
            {   float cr[8], ck[8], cv[8], ta[8];
                asm volatile("" : "+v"(ucr[0]), "+v"(ucr[1]), "+v"(ucr[2]), "+v"(ucr[3]), "+v"(ucr[4]), "+v"(ucr[5]), "+v"(ucr[6]), "+v"(ucr[7]), "+v"(uck[0]), "+v"(uck[1]), "+v"(uck[2]), "+v"(uck[3]), "+v"(uck[4]), "+v"(uck[5]), "+v"(uck[6]), "+v"(uck[7]),
                                  "+v"(ucv[0]), "+v"(ucv[1]), "+v"(ucv[2]), "+v"(ucv[3]), "+v"(ucv[4]), "+v"(ucv[5]), "+v"(ucv[6]), "+v"(ucv[7]));
                asm volatile("" : "+v"(uta[0]), "+v"(uta[1]), "+v"(uta[2]), "+v"(uta[3]), "+v"(uta[4]), "+v"(uta[5]), "+v"(uta[6]), "+v"(uta[7]));
#pragma unroll
                for (int tt = 0; tt < 8; ++tt) { cr[tt] = bfl(ucr[tt]); ck[tt] = bfl(uck[tt]); cv[tt] = bfl(ucv[tt]); ta[tt] = bfl(uta[tt]); }
#pragma unroll
                for (int tt = 0; tt < 8; ++tt) {
                    const float r = cr[tt] + (pr - cr[tt]) * mu_r, k = ck[tt] + (pk - ck[tt]) * mu_k, v = cv[tt] + (pv - cv[tt]) * mu_v; pr = cr[tt]; pk = ck[tt]; pv = cv[tt];
                    const float a = ta[tt], kk = k * k_k, km = k * (1.f + (a - 1.f) * k_a);
                    rr[tt] = r; kkv[tt] = kk; av[tt] = a; kmv[tt] = km; vv[tt] = v; ss[tt] = kk * kk; cbv[tt] = r * km * r_k; } }
            wsum16(ss, cbv, lane);
            float ggprev = 1.f;
#pragma unroll
            for (int tt = 0; tt < 8; ++tt) { const int t = 8 * ehf + tt;
                const float cu = cumLo[tt] + fh * (cumHi[tt] - cumLo[tt]); const float pl = tt ? cumLo[tt - 1] : 0.f, ph = tt ? cumHi[tt - 1] : cumLo[7]; const float cprev = pl + fh * (ph - pl);
                const float gg = __builtin_amdgcn_exp2f(LOG2E * cu), gp = (tt == 0) ? __builtin_amdgcn_exp2f(LOG2E * cprev) : ggprev, gi = __builtin_amdgcn_exp2f(-LOG2E * cu), gh = gctot * gi; ggprev = gg;
                const float kn = kkv[tt] * rsqrtf(fmaxf(ss[tt], 1e-24f)), ka = kn * av[tt];
                const int ro = (16 * ei2 + t) * RS + 2 * c;
                st2(lds + O_BT + ro, lds + O_KT + ro, __builtin_amdgcn_fmed3f(ka * gi, -60000.f, 60000.f), __builtin_amdgcn_fmed3f(kmv[tt] * gi, -60000.f, 60000.f));
                st2(lds + O_AT + ro, lds + O_RT + ro, -kn * gp, rr[tt] * gg);
                st2(lds + O_BK + (ei2 * 32 + t) * RS + 2 * c, lds + O_BK + (ei2 * 32 + 16 + t) * RS + 2 * c, ka * gh, kmv[tt] * gh);
                *(LAS unsigned short*)(lds + O_UV + (ei2 * 32 + 16 + t) * RS + 2 * c) = (unsigned short)h_f2h(vv[tt]);
                if (c == 0) ((LAS float*)(lds + O_CB))[16 * ei2 + t] = cbv[tt]; }
        }
        { const int nxt = (sc + 1 < SEQ / 64) ? tok0 + 64 : tok0; RW_LOADS(nxt); }
        lbar();
        {   const int i = w & 3, hf = w >> 2;
            const LAS unsigned char* xa = lds + (hf ? O_RT : O_AT) + (16 * i + l15) * RS + 16 * g4;
            const LAS unsigned char* xb = lds + O_BT + (16 * i + l15) * RS + 16 * g4; const LAS unsigned char* xk = lds + O_KT + (16 * i + l15) * RS + 16 * g4;
            f32x4 c1 = {0.f, 0.f, 0.f, 0.f}, c2 = {0.f, 0.f, 0.f, 0.f};
#pragma unroll
            for (int ks = 0; ks < 2; ++ks) { const bf16x8 a = *(const LAS bf16x8*)(xa + 64 * ks);
                c1 = MFMA16(a, *(const LAS bf16x8*)(xb + 64 * ks), c1);
                c2 = MFMA16(a, *(const LAS bf16x8*)(xk + 64 * ks), c2); }
#pragma unroll
            for (int r = 0; r < 4; ++r) { const int t = 4 * g4 + r; const bool keep = hf ? (l15 <= t) : (l15 < t); const float v1 = keep ? c1[r] : 0.f, v2 = keep ? c2[r] : 0.f;
                if (hf == 0) { ((LAS float*)(lds + O_LM))[(i * 16 + t) * 16 + l15] = v1; *(LAS unsigned short*)(lds + O_SM + (4 + i) * 1024 + t * 64 + 2 * l15) = (unsigned short)h_f2h(v2); }
                else st2(lds + O_SM + (8 + i) * 1024 + t * 64 + 2 * l15, lds + O_SM + (12 + i) * 1024 + t * 64 + 2 * l15, v1, v2); }
        }
        lbar();
        if (w < 4) { if (lane < 16) { const LAS float* Lm = (const LAS float*)(lds + O_LM) + w * 256; float acc[16];
#pragma unroll
                for (int t = 0; t < 16; ++t) acc[t] = (t == lane) ? 1.f : 0.f;
#pragma unroll
                for (int s = 0; s < 15; ++s) { const float xs = acc[s];
#pragma unroll
                    for (int t = s + 1; t < 16; ++t) acc[t] = fmaf(Lm[t * 16 + s], xs, acc[t]); }
#pragma unroll
                for (int t = 0; t < 16; t += 2) st2(lds + O_SM + w * 1024 + t * 64 + 2 * lane, lds + O_SM + w * 1024 + (t + 1) * 64 + 2 * lane, acc[t], acc[t + 1]); } }
        else { const int i = w - 4; const bf16x8 am = *(const LAS bf16x8*)(lds + O_SM + (4 + i) * 1024 + l15 * 64 + 16 * g4);
#pragma unroll
            for (int ct = 0; ct < 4; ++ct) { f32x4 acc = {0.f, 0.f, 0.f, 0.f};
                acc = MFMA16(am, trfrag(lds + O_UV + (i * 32 + 16 + trrow1) * RS + 32 * ct + trcol), acc);
st4(lds + O_W1 + (16 * i + 4 * g4) * RS + 2 * (16 * ct + l15), RS, acc); } }
        lbar();
        f32x4 wy[4];
        {   const int ct = w & 3; const int base = (w < 4) ? O_W1 : O_AT;
            bf16x8 tm[4], fb[4];
#pragma unroll
            for (int i = 0; i < 4; ++i) { tm[i] = *(const LAS bf16x8*)(lds + O_SM + i * 1024 + l15 * 64 + 16 * g4); fb[i] = trfrag(lds + base + (16 * i + trrow1) * RS + 32 * ct + trcol); }
#pragma unroll
            for (int i = 0; i < 4; ++i) { f32x4 acc = {0.f, 0.f, 0.f, 0.f}; wy[i] = MFMA16(tm[i], fb[i], acc); }
#pragma unroll
            for (int i = 0; i < 4; ++i) st4(lds + base + (16 * i + 4 * g4) * RS + 2 * (16 * ct + l15), RS, wy[i]); }
        lbar();
        {   const int ct = w & 3;
#pragma unroll
            for (int ih = 0; ih < 4; ih += 2) {
                bf16x8 arb[2], f1[2], ark[2], f2[2]; f32x4 cacc[2];
#pragma unroll
                for (int ii = 0; ii < 2; ++ii) { const int i = ih + ii; arb[ii] = *(const LAS bf16x8*)(lds + O_SM + (8 + i) * 1024 + l15 * 64 + 16 * g4);
                    if (w >= 4) { ark[ii] = *(const LAS bf16x8*)(lds + O_SM + (12 + i) * 1024 + l15 * 64 + 16 * g4);
                        f1[ii] = trfrag(lds + O_W1 + (16 * i + trrow1) * RS + 32 * ct + trcol); f2[ii] = trfrag(lds + O_UV + (i * 32 + 16 + trrow1) * RS + 32 * ct + trcol); cacc[ii] = (f32x4){0.f, 0.f, 0.f, 0.f}; }
                    else { f1[ii] = trfrag(lds + O_AT + (16 * i + trrow1) * RS + 32 * ct + trcol);
#pragma unroll
                        for (int r = 0; r < 4; ++r) cacc[ii][r] = ld_bf(lds + O_RT + (16 * i + 4 * g4 + r) * RS + 2 * (16 * ct + l15)); } }
#pragma unroll
                for (int ii = 0; ii < 2; ++ii) { cacc[ii] = MFMA16(arb[ii], f1[ii], cacc[ii]); if (w >= 4) cacc[ii] = MFMA16(ark[ii], f2[ii], cacc[ii]); }
#pragma unroll
                for (int ii = 0; ii < 2; ++ii) st4(lds + ((w >= 4) ? O_YO : O_RT) + (16 * (ih + ii) + 4 * g4) * RS + 2 * (16 * ct + l15), RS, cacc[ii]);
            } }
        lbar();
        if (w < 4) {
            const int v0 = 16 * w;
#pragma unroll
            for (int i = 0; i < 4; ++i) {
                h16x4_t sb[4];
#pragma unroll
                for (int kt = 0; kt < 4; ++kt) sb[kt] = acc2h(ST[kt]);
                f32x4 u = wy[i], y;
#pragma unroll
                for (int r = 0; r < 4; ++r) y[r] = ld_bf(lds + O_YO + (16 * i + 4 * g4 + r) * RS + 2 * (v0 + l15));
                const LAS unsigned char* pa = lds + O_AT + (16 * i + l15) * RS + 8 * g4; const LAS unsigned char* pq = lds + O_RT + (16 * i + l15) * RS + 8 * g4;
#pragma unroll
                for (int kt = 0; kt < 4; ++kt) { u = MFMA4(ld4h(pa + 32 * kt), sb[kt], u); y = MFMA4(ld4h(pq + 32 * kt), sb[kt], y); }
                st4(lds + O_YO + (16 * i + 4 * g4) * RS + 2 * (v0 + l15), RS, y);
                const h16x4_t ub = acc2h(u), vb = tr4(lds + O_UV + (i * 32 + 16 + 4 * g4 + q4) * RS + 2 * v0 + trcol);
#pragma unroll
                for (int kt = 0; kt < 4; ++kt) { const f32x4 gc = *(const LAS f32x4*)(lds + O_GC + (i * 64 + 16 * kt + 4 * g4) * 4);
                    f32x4 acc = ST[kt] * gc;
                    acc = MFMA4(tr4(lds + O_BK + (i * 32 + 4 * g4 + q4) * RS + 32 * kt + trcol), ub, acc);
                    acc = MFMA4(tr4(lds + O_BK + (i * 32 + 16 + 4 * g4 + q4) * RS + 32 * kt + trcol), vb, acc);
                    ST[kt] = acc; }
            }
        }
        lbar();
        {   float y[8], vv[8], gg[8];
            pg8::unpack8(*(const LAS v4u*)(lds + O_YO + et * RS + 16 * ecg), y); pg8::unpack8(*(const LAS v4u*)(lds + O_UV + (ei * 32 + 16 + ett) * RS + 16 * ecg), vv);
            pg8::unpack8(ugg, gg);
            float s = 0.f;
#pragma unroll
            for (int e = 0; e < 8; ++e) s += y[e];
            s = dpp_add<0xB1>(s); s = dpp_add<0x4E>(s); s = dpp_add<0x141>(s);
            const float mean = s * (1.f / 64.f); float q = 0.f;
#pragma unroll
            for (int e = 0; e < 8; ++e) { y[e] -= mean; q += y[e] * y[e]; }
            q = dpp_add<0xB1>(q); q = dpp_add<0x4E>(q); q = dpp_add<0x141>(q);
            const float rstd = rsqrtf(q * (1.f / 64.f) + RW_LN_EPS), cb = ((const LAS float*)(lds + O_CB))[et];
            float o[8];
#pragma unroll
            for (int e = 0; e < 8; ++e) { const int c = 8 * ecg + e; o[e] = (y[e] * rstd * par[c] + par[64 + c] + cb * vv[e]) * gg[e]; }
            v4u wo; wo.x = pk2(o[0], o[1]); wo.y = pk2(o[2], o[3]); wo.z = pk2(o[4], o[5]); wo.w = pk2(o[6], o[7]);
            *(v4u*)(ORWb + (size_t)(tok0 + et) * 512 + 8 * ecg) = wo;
        }
        lbar();
    }
}
}
#ifndef PROBE_QREP
#define PROBE_QREP 1
#endif
#ifndef PROBE_MASK
#define PROBE_MASK 0
#endif
__global__ void __launch_bounds__(NWAVES * 64, 2) mk_fwd(Args args) {
    extern __shared__ __attribute__((aligned(16))) unsigned char lds[];
    LAS unsigned char* const L = (LAS unsigned char*)lds;
    for (int u = threadIdx.x; u < (LDS_BYTES - LDSCTL_OFF) / 4; u += NWAVES * 64) ((LAS unsigned*)(L + LDSCTL_OFF))[u] = 0u;
    __syncthreads();
    static_assert(LDSCTL_OFF == MK_WAVETAB_LDS, "wave table address");
    if ((threadIdx.x & 63) == 0) ((LAS unsigned*)(L + LDSCTL_OFF))[(unsigned)__builtin_amdgcn_s_getreg((5 << 11) | 4) & 63u] = threadIdx.x >> 6;
    __syncthreads();
    XcdBarrier bar = xcd_barrier_post((unsigned*)(kws() + WS_CTL) + CW_BAR, (volatile LAS unsigned*)(L + MISC_OFF) + 8);
#define GRID_BAR() xcd_barrier(bar)
#if defined(DBG_BISECT)
#define IN(k) (l > 0 || ((k) >= kstart() && (k) <= kstop()) || ((k) == 9 && kstop() == 99))
#define LAYER_END() do { if (kstop() < 100) return; } while (0)
#else
#define IN(k) true
#define LAYER_END() do { } while (0)
#endif
#define PTRS() unsigned char* ws = opq(kws()); \
    bf16* U = (bf16*)(ws + WS_U); bf16* OA = (bf16*)(ws + WS_OA); bf16* OC = (bf16*)(ws + WS_OC); bf16* ORW = (bf16*)(ws + WS_ORW); \
    bf16* WinT = (bf16*)(ws + W_IN); bf16* WqT = (bf16*)(ws + W_Q); bf16* WloT = (bf16*)(ws + W_LORA); bf16* WbT = (bf16*)(ws + W_B); bf16* WoT = (bf16*)(ws + W_OUT); \
    bf16* W1T = (bf16*)(ws + W_1); bf16* W2T = (bf16*)(ws + W_2); bf16* WgT = (bf16*)(ws + W_G); bf16* WpT = (bf16*)(ws + W_P); \
    bf16* ZC = (bf16*)(ws + X_ZC); bf16* QN = (bf16*)(ws + X_QN); bf16* QP = (bf16*)(ws + X_QP); bf16* KV = (bf16*)(ws + X_KV); \
    bf16* ZR = (bf16*)(ws + X_ZR); bf16* LA = (bf16*)(ws + X_LA); bf16* TW = (bf16*)(ws + X_TW); bf16* TA = (bf16*)((unsigned char*)kout() + DO_TA); bf16* GG = (bf16*)((unsigned char*)kout() + DO_G); bf16* H16 = (bf16*)((unsigned char*)kout() + DO_H16); \
    bf16* GT = (bf16*)(ws + X_GT); bf16* MG = (bf16*)(ws + X_MG); bf16* HID = (bf16*)(ws + X_HID); bf16* PB = (bf16*)(ws + X_PB); bf16* PP = (bf16*)(ws + X_PP); bf16* M2 = OA; \
    (void)U; (void)OA; (void)OC; (void)ORW; (void)WinT; (void)WqT; (void)WloT; (void)WbT; (void)WoT; (void)W1T; (void)W2T; (void)WgT; (void)WpT; (void)ZC; (void)QN; (void)QP; (void)KV; (void)ZR; (void)LA; (void)TW; (void)TA; (void)GG; (void)H16; (void)GT; (void)MG; (void)HID; (void)PB; (void)PP; (void)M2;
    typedef pg8::StaticOrder SO;
#define GEMM(EPI, Aptr, Bptr, N_, K_, Eobj) do { int bx_ = blockIdx.x; asm volatile("" : "+s"(bx_)); int G_ = gridDim.x; asm volatile("" : "+s"(G_)); pg8::Gemm g_{Aptr, Bptr, T, N_, K_}; SO S_; S_.init(T, N_, G_, bx_); pg8::gemm_phase<EPI, SO, true, true>(L + RING_OFF, g_, S_, Eobj); } while (0)
#define PH(n) for (int rep_ = 0; rep_ < (((PROBE_MASK >> (n)) & 1) ? 2 : 1); ++rep_) if (IN(n))
    typedef pg8::EpiRoute<0> ER0;
    rope_table(L);
    for (int l = 0; l < DEPTH; ++l) {
        PH(0) { p0_prologue(L, args, l); u_rowpass(L, l, l == 0); GRID_BAR(); }
        PH(1) { PTRS(); ER0 E{OA, 512, 2, ZC, 1536, 6, 2, CA_QSCALE, ZR, 1792}; GEMM(ER0, U, WinT, 3840, 1024, E); GRID_BAR(); }
        PH(2) { p6_rw_prep(L, l); GRID_BAR(); }
        PH(3) { PTRS(); pg8::EpiSig E2{TW, kin(10) + l * 512, -0.6065306597126334f, 512}; GEMM(pg8::EpiSig, LA, WloT, 512, 256, E2);
                pg8::EpiSig E3{TA, kin(12) + l * 512, 1.f, 512}; GEMM(pg8::EpiSig, LA, WloT + (size_t)512 * 256, 512, 256, E3);
                ER0 E4{GG, 512, 2, GG, 512, 0, 0, 1.f, GG, 512}; GEMM(ER0, LA, WloT + (size_t)1024 * 256, 512, 256, E4); GRID_BAR(); }
        if (IN(4)) { PTRS();
            unsigned* sb = (unsigned*)(ws + WS_CTL) + CW_SUB + 64 * l; unsigned* barw = (unsigned*)(ws + WS_CTL) + CW_BAR;
            int bx4_ = blockIdx.x; asm volatile("" : "+s"(bx4_)); int G4_ = gridDim.x; asm volatile("" : "+s"(G4_));
            const int NRW = (G4_ > 64) ? 64 : 0, NOTH = G4_ - NRW;
            if (bx4_ < 64) rw::rw_unit(L + RING_OFF, l, bx4_);
            if (G4_ <= 64) for (int u_ = bx4_ + 64; u_ < 64; u_ += G4_) rw::rw_unit(L + RING_OFF, l, u_);
            if (bx4_ >= NRW) {
                p2_mla_prep(L, l, NRW, NOTH);
                sub_barrier(barw, sb, (unsigned)NOTH, true);
                { pg8::EpiQRope E{QP, (const float*)(ws + WS_ROPE), MLA_QSCALE}; pg8::Gemm g_{QN, WqT, T, 768, 256}; SO S_; S_.init(T, 768, NOTH, bx4_ - NRW); pg8::gemm_phase<pg8::EpiQRope, SO, true, true>(L + RING_OFF, g_, S_, E); }
                sub_barrier(barw, sb + 16, (unsigned)NOTH, true);
            } else sub_barrier(barw, sb + 16, (unsigned)NOTH, false);
            volatile LAS unsigned* qs = (volatile LAS unsigned*)(L + MISC_OFF) + 12;
            unsigned* qhead = (unsigned*)(ws + WS_CTL) + CW_QUEUE + 64 * l;
            for (;;) {
                __syncthreads();
                if (my_tid() == 0) *qs = atomicAdd(qhead, 1u);
                __syncthreads();
                const unsigned u = *qs;
                if (u >= 1280u) break;
                if (u < 256u) { const int b = (int)u >> 5, cc = (int)u & 31; att::mla_unit(L + RING_OFF, QP, KV, OA, b, 63 - cc); att::mla_unit(L + RING_OFF, QP, KV, OA, b, cc); }
                else { const int bi = (int)u - 256; att::band_unit(L + RING_OFF, ZC, kin(20) + (size_t)l * 320 * 8, OC, bi >> 7, (bi >> 4) & 7, bi & 15); }
            }
            GRID_BAR(); }
        PH(9) { PTRS(); ER0 E{GT, 3072, 12, GT, 3072, 0, 0, 1.f, GT, 3072}; GEMM(ER0, U, WinT + (size_t)3840 * 1024, 3072, 1024, E); GRID_BAR(); }
        PH(10) { PTRS(); int bx_ = blockIdx.x; asm volatile("" : "+s"(bx_)); int G_ = gridDim.x; asm volatile("" : "+s"(G_));
                 pg8::Gemm g_{OA, WbT, 3 * T, 3072, 512}; pg8::MergeOrder S_{G_, bx_}; pg8::EpiMergeAll E{MG, GT};
                 pg8::gemm_phase<pg8::EpiMergeAll, pg8::MergeOrder, true, true>(L + RING_OFF, g_, S_, E); GRID_BAR(); }
        PH(11) { PTRS(); ER0 E{M2, 1024, 4, M2, 1024, 0, 0, 1.f, M2, 1024}; GEMM(ER0, MG, WoT, 1024, 1024, E); GRID_BAR(); }
        if (IN(12)) { PTRS(); rowpass<0>(L, args, M2, kin(23) + l * 1024, kin(24) + l * 1024, nullptr); GRID_BAR(); }
        PH(13) { PTRS(); pg8::EpiRoute<2> E{HID, 4096, 16, HID, 4096, 0, 0, 1.f, HID, 4096}; GEMM(pg8::EpiRoute<2>, U, W1T, 4096, 1024, E); GRID_BAR(); }
        PH(14) { PTRS(); ER0 E{M2, 1024, 4, M2, 1024, 0, 0, 1.f, M2, 1024}; GEMM(ER0, HID, W2T, 1024, 4096, E); GRID_BAR(); }
        if (IN(15)) { PTRS(); rowpass<1>(L, args, M2, kin(27) + l * 1024, nullptr, kin(1) + (size_t)l * T * DPLE); GRID_BAR(); }
        if (IN(17)) { PTRS(); ER0 E{PP, 1024, 4, PP, 1024, 0, 0, 1.f, PP, 1024}; GEMM(ER0, PB, WpT, 1024, 256, E);
                      pg8::EpiPle E2{H16, PP, kout(), (float*)(ws + X_STG), (l + 1 == DEPTH) ? 1 : 0}; GEMM(pg8::EpiPle, U, WgT, 1024, 1024, E2); }
        LAYER_END();
        if (l + 1 < DEPTH) GRID_BAR();
    }
    GRID_BAR();
    {   const Frame F = make_frame(L); const f32x4* src = (const f32x4*)(kws() + X_STG); f32x4* dst = (f32x4*)((unsigned char*)kout() + 64 * MiB);
        const size_t n = (size_t)16384 * 1024 / 4, gt = (size_t)F.gw * 64 + F.lane, NTH = (size_t)F.NGW * 64;
        for (size_t i = gt; i < n; i += NTH) dst[i] = src[i]; }
}

#if !defined(DBG_BISECT)
extern "C" void kernel_launch(void* const* d_in, const int* in_sizes, int n_in, void* d_out, int out_size, void* d_ws, size_t ws_size, hipStream_t stream) {
    static int grid = 0;
    if (grid == 0) {
        if (n_in != 30 || out_size != T * D || ws_size < (size_t)WS_END) { fprintf(stderr, "kernel_launch: unexpected shapes (n_in %d out %d ws %zu, need ws >= %zu)\n", n_in, out_size, ws_size, (size_t)WS_END); grid = -1; return; }
        int dev = 0, cus = 0, per_cu = 0;
        if (hipGetDevice(&dev) != hipSuccess || hipDeviceGetAttribute(&cus, hipDeviceAttributeMultiprocessorCount, dev) != hipSuccess) { grid = -1; return; }
        if (hipFuncSetAttribute((const void*)mk_fwd, hipFuncAttributeMaxDynamicSharedMemorySize, LDS_BYTES) != hipSuccess) { fprintf(stderr, "kernel_launch: hipFuncSetAttribute failed\n"); grid = -1; return; }
        if (hipOccupancyMaxActiveBlocksPerMultiprocessor(&per_cu, (const void*)mk_fwd, NWAVES * 64, LDS_BYTES) != hipSuccess || per_cu < 1) { fprintf(stderr, "kernel_launch: occupancy query says %d\n", per_cu); }
        (void)hipGetLastError();
        grid = cus;
    }
    if (grid < 0) return;
    if (hipMemsetAsync((char*)d_ws + WS_CTL, 0, CTL_ZERO_BYTES, stream) != hipSuccess) return;
    Args a{};
    for (int i = 0; i < 30; ++i) a.in[i] = (const float*)d_in[i];
    a.out = (float*)d_out; a.ws = (unsigned char*)d_ws; a.start = 0; a.stop = 1000;
    hipLaunchKernelGGL(mk_fwd, dim3(grid), dim3(NWAVES * 64), LDS_BYTES, stream, a);
}
#endif
```

```cpp
#include <hip/hip_runtime.h>
#include <cstdio>
#include <cstdint>
#include <cmath>
typedef _Float16 h16x8_t __attribute__((ext_vector_type(8)));
typedef _Float16 h16x2_t __attribute__((ext_vector_type(2)));
typedef short s16x8_t __attribute__((ext_vector_type(8)));
typedef float f32x4_t_ __attribute__((ext_vector_type(4)));
typedef float f32x16_t_ __attribute__((ext_vector_type(16)));
__device__ __forceinline__ unsigned h_pk2(float lo, float hi) { const h16x2_t v = {(_Float16)lo, (_Float16)hi}; return __builtin_bit_cast(unsigned, v); }
__device__ __forceinline__ unsigned h_f2h(float f) { return (unsigned)__builtin_bit_cast(unsigned short, (_Float16)f); }
__device__ __forceinline__ float h_lo(unsigned w) { return (float)__builtin_bit_cast(_Float16, (unsigned short)(w & 0xffffu)); }
__device__ __forceinline__ float h_hi(unsigned w) { return (float)__builtin_bit_cast(_Float16, (unsigned short)(w >> 16)); }
__device__ __forceinline__ f32x4_t_ MFMA16(s16x8_t a, s16x8_t b, f32x4_t_ c) { return __builtin_amdgcn_mfma_f32_16x16x32_f16(__builtin_bit_cast(h16x8_t, a), __builtin_bit_cast(h16x8_t, b), c, 0, 0, 0); }
__device__ __forceinline__ f32x16_t_ MFMA32(s16x8_t a, s16x8_t b, f32x16_t_ c) { return __builtin_amdgcn_mfma_f32_32x32x16_f16(__builtin_bit_cast(h16x8_t, a), __builtin_bit_cast(h16x8_t, b), c, 0, 0, 0); }
#define MK_WAVETAB_LDS 131072
__device__ __forceinline__ int my_tid() {
    const unsigned hw = (unsigned)__builtin_amdgcn_s_getreg((5 << 11) | 4) & 63u;
    const unsigned wv = (unsigned)__builtin_amdgcn_readfirstlane((int)((volatile __attribute__((address_space(3))) unsigned*)MK_WAVETAB_LDS)[hw]);
    unsigned lane; asm volatile("v_mbcnt_lo_u32_b32 %0, -1, 0\n\tv_mbcnt_hi_u32_b32 %0, -1, %0" : "=v"(lane));
    return (int)(wv * 64u + lane);
}
namespace pg8 {
#define PG8_LAS __attribute__((address_space(3)))
#define PG8_GAS __attribute__((address_space(1)))
typedef unsigned short bf16_t;
typedef short bf16x8 __attribute__((ext_vector_type(8)));
typedef float f32x4 __attribute__((ext_vector_type(4)));
typedef unsigned u32x4 __attribute__((ext_vector_type(4)));
constexpr int BM = 256, BK = 64, HALF = 128, HTB = HALF * BK * 2  , STAGE_BYTES = 8 * HTB, NXCD = 8, WGM = 8;

__host__ __device__ __forceinline__ int lds_byte(int r, int c) { const int st = (r >> 4) * 2 + (c >> 5), rr = r & 15, cc = c & 31, ob = rr * 64 + cc * 2; return st * 1024 + (ob ^ (((ob >> 9) & 1) << 5)); }
__host__ __device__ __forceinline__ void stage_rc(int b, int& R, int& C) { const int st = b / 1024, sb = b % 1024, swz = sb ^ (((sb >> 9) & 1) << 5); R = (st >> 1) * 16 + swz / 64; C = (st & 1) * 32 + (swz % 64) / 2; }
__host__ __device__ __forceinline__ int perm32(int rho) { const int n = rho >> 4, i = rho & 15; return 8 * (i >> 2) + 4 * n + (i & 3); }

struct Unit { int pm, pn; };
struct Gemm { const bf16_t* A; const bf16_t* Bt; int M, N, K; };

struct StaticOrder {
    int nM, nN, nwg, G, c;
    __host__ __device__ void init(int M, int N, int G_, int c_) { nM = M / BM; nN = N / BM; nwg = nM * nN; G = G_; c = c_; }
    __host__ __device__ bool next(int i, Unit& u) const {
        const long L = (long)i * G + c; if (L >= nwg) return false;
        int wgid = (int)L; { const int q = nwg / NXCD, r = nwg % NXCD, xcd = wgid % NXCD, off = wgid / NXCD; wgid = (xcd < r ? xcd * (q + 1) : r * (q + 1) + (xcd - r) * q) + off; }
        const int nig = WGM * nN, gid = wgid / nig, fm = gid * WGM, gsz = (nM - fm) < WGM ? (nM - fm) : WGM;
        u.pm = fm + ((wgid % nig) % gsz); u.pn = (wgid % nig) / gsz; return true;
    }
    __device__ __forceinline__ void a_ready(const Unit&) const {}
    __device__ __forceinline__ void done(const Unit&) const {}
};

__device__ __forceinline__ unsigned cvt_pk_bf16(float lo, float hi) { typedef __fp16 hp2 __attribute__((ext_vector_type(2))); const hp2 v = __builtin_amdgcn_cvt_pkrtz(lo, hi); return __builtin_bit_cast(unsigned, v); }
typedef float f32x2 __attribute__((ext_vector_type(2)));
__device__ __forceinline__ f32x2 gelu_pk(f32x2 v) {
    const f32x2 av = __builtin_elementwise_abs(v), d = av * 0.2316418882f + 1.0f;
    f32x2 t; t.x = __builtin_amdgcn_rcpf(d.x); t.y = __builtin_amdgcn_rcpf(d.y);
    f32x2 q = t * 0.5307027145f + (-0.7265760135f); q = q * t + 0.7107068705f; q = q * t + (-0.142248368f); q = q * t + 0.127414796f; q = q * t;
    const f32x2 s = (v * v) * (-0.72134752044f);
    f32x2 e; e.x = __builtin_amdgcn_exp2f(s.x); e.y = __builtin_amdgcn_exp2f(s.y);
    const f32x2 m = v * (q * e), r = v - m;
    f32x2 o; o.x = v.x < 0.f ? m.x : r.x; o.y = v.y < 0.f ? m.y : r.y; return o;
}

template <int ACT  > struct EpiBf16 {
    static constexpr bool PERM = true, AFTER_DRAIN = false; static_assert(ACT == 0 || ACT == 1, "EpiBf16: ACT is 0 (none) or 1 (gelu_pk)");
    bf16_t* O; int ldc; const float* bias; int split_cols; size_t split_stride; float scale0;
    __device__ __forceinline__ void operator()(const f32x4 (&acc)[2][2][4][2], const Unit& u, int wr, int wc, int fr, int fq) const {
        const int row0 = u.pm * BM + wr * 64 + fr; int colt = u.pn * BM; bf16_t* base = O;
        float sc = 1.f; if (split_cols) { const int t = colt / split_cols; base += (size_t)t * split_stride; colt -= t * split_cols; if (t == 0) sc = scale0; }
        const int col0 = colt + wc * 32 + 8 * fq, bcol0 = u.pn * BM + wc * 32 + 8 * fq;
        f32x4 bv[2][2];
#pragma unroll
        for (int bj = 0; bj < 2; ++bj)
#pragma unroll
            for (int n = 0; n < 2; ++n) bv[bj][n] = bias ? *(const f32x4*)(bias + bcol0 + bj * HALF + 4 * n) : (f32x4){0.f, 0.f, 0.f, 0.f};
#pragma unroll
        for (int ai = 0; ai < 2; ++ai)
#pragma unroll
            for (int m = 0; m < 4; ++m) { bf16_t* rowp = base + (size_t)(row0 + ai * HALF + m * 16) * ldc + col0;
#pragma unroll
                for (int bj = 0; bj < 2; ++bj) { f32x4 v0 = acc[ai][bj][m][0] + bv[bj][0], v1 = acc[ai][bj][m][1] + bv[bj][1];
                    if (ACT == 1) { f32x2 a = gelu_pk((f32x2){v0[0], v0[1]}), b = gelu_pk((f32x2){v0[2], v0[3]}), c = gelu_pk((f32x2){v1[0], v1[1]}), d = gelu_pk((f32x2){v1[2], v1[3]});
                        v0 = (f32x4){a.x, a.y, b.x, b.y}; v1 = (f32x4){c.x, c.y, d.x, d.y}; }
                    v0 = v0 * sc; v1 = v1 * sc; u32x4 w; w.x = cvt_pk_bf16(v0[0], v0[1]); w.y = cvt_pk_bf16(v0[2], v0[3]); w.z = cvt_pk_bf16(v1[0], v1[1]); w.w = cvt_pk_bf16(v1[2], v1[3]);
                    *(u32x4*)(rowp + bj * HALF) = w; } }
    }
};
__device__ __forceinline__ float bf2f(unsigned short b) { return h_lo((unsigned)b); }
__device__ __forceinline__ float sigm(float x) { return __builtin_amdgcn_rcpf(1.0f + __builtin_amdgcn_exp2f(-1.4426950408889634f * x)); }
__device__ __forceinline__ void unpack8(const u32x4 w, float (&f)[8]) {
    f[0] = h_lo(w.x); f[1] = h_hi(w.x); f[2] = h_lo(w.y); f[3] = h_hi(w.y); f[4] = h_lo(w.z); f[5] = h_hi(w.z); f[6] = h_lo(w.w); f[7] = h_hi(w.w);
}
template <int ACT> struct EpiRoute {
    static constexpr bool PERM = true, AFTER_DRAIN = false;
    bf16_t* O0; int ld0; int nt0;
    bf16_t* O1; int ld1; int nt1; int nts1; float sc1;
    bf16_t* O2; int ld2;
    const float* rsc;
    __device__ __forceinline__ void operator()(const f32x4 (&acc)[2][2][4][2], const Unit& u, int wr, int wc, int fr, int fq) const {
        const int row0 = u.pm * BM + wr * 64 + fr;
        float rsv[2][4];
#pragma unroll
        for (int ai = 0; ai < 2; ++ai)
#pragma unroll
            for (int m = 0; m < 4; ++m) rsv[ai][m] = rsc ? *(const PG8_GAS float*)(rsc + row0 + ai * HALF + m * 16) : 1.f;
        bf16_t* base; int ld, colt; float sc = 1.f;
        if (u.pn < nt0) { base = O0; ld = ld0; colt = u.pn * BM; }
        else if (u.pn < nt0 + nt1) { base = O1; ld = ld1; colt = (u.pn - nt0) * BM; if (u.pn - nt0 < nts1) sc = sc1; }
        else { base = O2; ld = ld2; colt = (u.pn - nt0 - nt1) * BM; }
        const int col0 = colt + wc * 32 + 8 * fq;
#pragma unroll
        for (int ai = 0; ai < 2; ++ai)
#pragma unroll
            for (int m = 0; m < 4; ++m) { bf16_t* rowp = base + (size_t)(row0 + ai * HALF + m * 16) * ld + col0;
#pragma unroll
                for (int bj = 0; bj < 2; ++bj) { f32x4 v0 = acc[ai][bj][m][0] * rsv[ai][m], v1 = acc[ai][bj][m][1] * rsv[ai][m];
                    if (ACT == 2) { for (int e = 0; e < 4; ++e) { const float a = fmaxf(v0[e], 0.f), b = fmaxf(v1[e], 0.f); v0[e] = a * a; v1[e] = b * b; } }
                    v0 = v0 * sc; v1 = v1 * sc; u32x4 w; w.x = cvt_pk_bf16(v0[0], v0[1]); w.y = cvt_pk_bf16(v0[2], v0[3]); w.z = cvt_pk_bf16(v1[0], v1[1]); w.w = cvt_pk_bf16(v1[2], v1[3]);
                    *(PG8_GAS u32x4*)(rowp + bj * HALF) = w; } }
    }
};
struct EpiSig {
    static constexpr bool PERM = true, AFTER_DRAIN = false;
    bf16_t* O; const float* p; float scale; int ld;
    __device__ __forceinline__ void operator()(const f32x4 (&acc)[2][2][4][2], const Unit& u, int wr, int wc, int fr, int fq) const {
        const int row0 = u.pm * BM + wr * 64 + fr; const int col0 = u.pn * BM + wc * 32 + 8 * fq;
        const f32x4 pA0 = *(const PG8_GAS f32x4*)(p + col0), pA1 = *(const PG8_GAS f32x4*)(p + col0 + 4), pB0 = *(const PG8_GAS f32x4*)(p + col0 + HALF), pB1 = *(const PG8_GAS f32x4*)(p + col0 + HALF + 4);
#pragma unroll
        for (int ai = 0; ai < 2; ++ai)
#pragma unroll
            for (int m = 0; m < 4; ++m) { bf16_t* rowp = O + (size_t)(row0 + ai * HALF + m * 16) * ld + col0;
#pragma unroll
                for (int bj = 0; bj < 2; ++bj) { f32x4 v0 = acc[ai][bj][m][0], v1 = acc[ai][bj][m][1]; const f32x4 p0 = bj ? pB0 : pA0, p1 = bj ? pB1 : pA1;
                    v0 = (f32x4){sigm(p0[0] + v0[0]), sigm(p0[1] + v0[1]), sigm(p0[2] + v0[2]), sigm(p0[3] + v0[3])} * scale; v1 = (f32x4){sigm(p1[0] + v1[0]), sigm(p1[1] + v1[1]), sigm(p1[2] + v1[2]), sigm(p1[3] + v1[3])} * scale;
                    u32x4 w; w.x = cvt_pk_bf16(v0[0], v0[1]); w.y = cvt_pk_bf16(v0[2], v0[3]); w.z = cvt_pk_bf16(v1[0], v1[1]); w.w = cvt_pk_bf16(v1[2], v1[3]);
                    *(PG8_GAS u32x4*)(rowp + bj * HALF) = w; } }
    }
};
struct EpiLora {
    static constexpr bool PERM = true, AFTER_DRAIN = false;
    bf16_t* TW; bf16_t* TA; bf16_t* G; const float* w0; const float* a0;
    __device__ __forceinline__ void operator()(const f32x4 (&acc)[2][2][4][2], const Unit& u, int wr, int wc, int fr, int fq) const {
        const int sel = u.pn >> 1;
        bf16_t* O = TW; const float* p = w0; float scale = -0.6065306597126334f;
        if (sel == 1) { O = TA; p = a0; scale = 1.f; } else if (sel == 2) { O = G; }
        asm volatile("" : "+s"(O), "+s"(p));
        const int row0 = u.pm * BM + wr * 64 + fr; const int col0 = (u.pn & 1) * BM + wc * 32 + 8 * fq;
        const f32x4 pA0 = *(const PG8_GAS f32x4*)(p + col0), pA1 = *(const PG8_GAS f32x4*)(p + col0 + 4), pB0 = *(const PG8_GAS f32x4*)(p + col0 + HALF), pB1 = *(const PG8_GAS f32x4*)(p + col0 + HALF + 4);
#pragma unroll
        for (int ai = 0; ai < 2; ++ai)
#pragma unroll
            for (int m = 0; m < 4; ++m) { bf16_t* rowp = O + (size_t)(row0 + ai * HALF + m * 16) * 512 + col0;
#pragma unroll
                for (int bj = 0; bj < 2; ++bj) { f32x4 v0 = acc[ai][bj][m][0], v1 = acc[ai][bj][m][1]; const f32x4 p0 = bj ? pB0 : pA0, p1 = bj ? pB1 : pA1;
                    if (sel < 2) { v0 = (f32x4){sigm(p0[0] + v0[0]), sigm(p0[1] + v0[1]), sigm(p0[2] + v0[2]), sigm(p0[3] + v0[3])} * scale; v1 = (f32x4){sigm(p1[0] + v1[0]), sigm(p1[1] + v1[1]), sigm(p1[2] + v1[2]), sigm(p1[3] + v1[3])} * scale; }
                    u32x4 w; w.x = cvt_pk_bf16(v0[0], v0[1]); w.y = cvt_pk_bf16(v0[2], v0[3]); w.z = cvt_pk_bf16(v1[0], v1[1]); w.w = cvt_pk_bf16(v1[2], v1[3]);
                    *(PG8_GAS u32x4*)(rowp + bj * HALF) = w; } }
    }
};
struct EpiQRope {
    static constexpr bool PERM = true, AFTER_DRAIN = false;
    bf16_t* O; const float* rope; float sc;
    __device__ __forceinline__ void operator()(const f32x4 (&acc)[2][2][4][2], const Unit& u, int wr, int wc, int fr, int fq) const {
        const int row0 = u.pm * BM + wr * 64 + fr; const int col0 = u.pn * BM + wc * 32 + 8 * fq;
#pragma unroll
        for (int ai = 0; ai < 2; ++ai)
#pragma unroll
            for (int m = 0; m < 4; ++m) { const int row = row0 + ai * HALF + m * 16;
#pragma unroll
                for (int bj = 0; bj < 2; ++bj) { const int cg = col0 + bj * HALF; const int cm = cg % 192; f32x4 v0 = acc[ai][bj][m][0], v1 = acc[ai][bj][m][1];
                    if (cm >= 128) { const int j0 = (cm - 128) >> 1; const PG8_GAS f32x4* rp = (const PG8_GAS f32x4*)(rope + ((size_t)row * 32 + j0) * 2); const f32x4 a = rp[0], b = rp[1];
                        f32x4 r0, r1;
                        r0[0] = v0[0] * a[0] - v0[1] * a[1]; r0[1] = v0[1] * a[0] + v0[0] * a[1]; r0[2] = v0[2] * a[2] - v0[3] * a[3]; r0[3] = v0[3] * a[2] + v0[2] * a[3];
                        r1[0] = v1[0] * b[0] - v1[1] * b[1]; r1[1] = v1[1] * b[0] + v1[0] * b[1]; r1[2] = v1[2] * b[2] - v1[3] * b[3]; r1[3] = v1[3] * b[2] + v1[2] * b[3];
                        v0 = r0; v1 = r1; }
                    v0 = v0 * sc; v1 = v1 * sc; u32x4 w; w.x = cvt_pk_bf16(v0[0], v0[1]); w.y = cvt_pk_bf16(v0[2], v0[3]); w.z = cvt_pk_bf16(v1[0], v1[1]); w.w = cvt_pk_bf16(v1[2], v1[3]);
                    *(PG8_GAS u32x4*)(O + (size_t)row * 768 + cg) = w; } }
    }
};
template <int NI> struct EpiMerge {
    static constexpr bool PERM = true, AFTER_DRAIN = false;
    bf16_t* MG; const bf16_t* GT;
    __device__ __forceinline__ void operator()(const f32x4 (&acc)[2][2][4][2], const Unit& u, int wr, int wc, int fr, int fq) const {
        const int row0 = u.pm * BM + wr * 64 + fr; const int col0 = u.pn * BM + wc * 32 + 8 * fq;
#pragma unroll
        for (int ai = 0; ai < 2; ++ai)
#pragma unroll
            for (int m = 0; m < 4; ++m) { const int row = row0 + ai * HALF + m * 16;
#pragma unroll
                for (int bj = 0; bj < 2; ++bj) { const int c = col0 + bj * HALF; const f32x4 v0 = acc[ai][bj][m][0], v1 = acc[ai][bj][m][1];
                    const u32x4 gw = *(const PG8_GAS u32x4*)(GT + (size_t)row * 3072 + NI * 1024 + c);
                    f32x4 o0 = {0.f, 0.f, 0.f, 0.f}, o1 = {0.f, 0.f, 0.f, 0.f};
                    if (NI > 0) { const u32x4 ow = *(const PG8_GAS u32x4*)(MG + (size_t)row * 1024 + c); o0 = (f32x4){h_lo(ow.x), h_hi(ow.x), h_lo(ow.y), h_hi(ow.y)}; o1 = (f32x4){h_lo(ow.z), h_hi(ow.z), h_lo(ow.w), h_hi(ow.w)}; }
                    o0[0] += sigm(h_lo(gw.x)) * v0[0]; o0[1] += sigm(h_hi(gw.x)) * v0[1]; o0[2] += sigm(h_lo(gw.y)) * v0[2]; o0[3] += sigm(h_hi(gw.y)) * v0[3];
                    o1[0] += sigm(h_lo(gw.z)) * v1[0]; o1[1] += sigm(h_hi(gw.z)) * v1[1]; o1[2] += sigm(h_lo(gw.w)) * v1[2]; o1[3] += sigm(h_hi(gw.w)) * v1[3];
                    u32x4 w; w.x = cvt_pk_bf16(o0[0], o0[1]); w.y = cvt_pk_bf16(o0[2], o0[3]); w.z = cvt_pk_bf16(o1[0], o1[1]); w.w = cvt_pk_bf16(o1[2], o1[3]);
                    *(PG8_GAS u32x4*)(MG + (size_t)row * 1024 + c) = w; } }
    }
};
__device__ __forceinline__ unsigned pk_fma_h(unsigned a, unsigned b, unsigned c) { unsigned r; asm("v_pk_fma_f16 %0, %1, %2, %3" : "=v"(r) : "v"(a), "v"(b), "v"(c)); return r; }
struct EpiMergeAll {
    static constexpr bool PERM = true, AFTER_DRAIN = false, CHAIN = true;
    bf16_t* MG; const bf16_t* GT;
    __device__ __forceinline__ bool chain(const Unit& u) const { return (u.pm >> 7) < 2; }
    static __device__ __forceinline__ float e2(unsigned short hbits) { return __builtin_amdgcn_exp2f(-1.4426950408889634f * __builtin_amdgcn_fmed3f(h_lo((unsigned)hbits), -30.f, 30.f)); }
    __device__ __forceinline__ void operator()(f32x4 (&acc)[2][2][4][2], const Unit& u, int wr, int wc, int fr, int fq) const {
        const int a = u.pm >> 7, p = u.pm & 127, br = u.pn >> 2, q = u.pn & 3;
        const int brn = (a == 0) ? 2 : 1;
        const int row0 = p * BM + wr * 64 + fr; const int col0 = q * BM + wc * 32 + 8 * fq;
#pragma unroll
        for (int ai = 0; ai < 2; ++ai) {
            u32x4 gw[4][2], gn[4][2];
#pragma unroll
            for (int m = 0; m < 4; ++m)
#pragma unroll
                for (int bj = 0; bj < 2; ++bj) { const int row = row0 + ai * HALF + m * 16, c = col0 + bj * HALF;
                    gw[m][bj] = *(const PG8_GAS u32x4*)(GT + (size_t)row * 3072 + br * 1024 + c);
                    if (a < 2) gn[m][bj] = *(const PG8_GAS u32x4*)(GT + (size_t)row * 3072 + brn * 1024 + c); else gn[m][bj] = (u32x4){0u, 0u, 0u, 0u}; }
            __builtin_amdgcn_sched_barrier(0);
#pragma unroll
            for (int m = 0; m < 4; ++m)
#pragma unroll
                for (int bj = 0; bj < 2; ++bj) { const int row = row0 + ai * HALF + m * 16, c = col0 + bj * HALF; const u32x4 g = gw[m][bj], n = gn[m][bj];
                    float f[8];
#pragma unroll
                    for (int e = 0; e < 4; ++e) { const unsigned gd = g[e], nd = n[e];
                        const float d0 = __builtin_amdgcn_rcpf(1.f + e2((unsigned short)gd)), d1 = __builtin_amdgcn_rcpf(1.f + e2((unsigned short)(gd >> 16)));
                        f[2 * e] = (a < 2) ? d0 * (1.f + e2((unsigned short)nd)) : d0; f[2 * e + 1] = (a < 2) ? d1 * (1.f + e2((unsigned short)(nd >> 16))) : d1; }
                    f32x4 v0 = acc[ai][bj][m][0], v1 = acc[ai][bj][m][1];
                    v0[0] *= f[0]; v0[1] *= f[1]; v0[2] *= f[2]; v0[3] *= f[3]; v1[0] *= f[4]; v1[1] *= f[5]; v1[2] *= f[6]; v1[3] *= f[7];
                    if (a < 2) { acc[ai][bj][m][0] = v0; acc[ai][bj][m][1] = v1; }
                    else { u32x4 w; w.x = cvt_pk_bf16(v0[0], v0[1]); w.y = cvt_pk_bf16(v0[2], v0[3]); w.z = cvt_pk_bf16(v1[0], v1[1]); w.w = cvt_pk_bf16(v1[2], v1[3]);
                        *(PG8_GAS u32x4*)(MG + (size_t)row * 1024 + c) = w; } }
            __builtin_amdgcn_sched_barrier(0);
        }
    }
};
struct MergeOrder {
    int G, c;
    __device__ __forceinline__ bool next(int i, Unit& u) const { if (i >= 6 || G != 256) { if (G == 256) return false; const int t = c + G * (i / 3), a = i % 3; if (t >= 512) return false;
            const int p = t >> 2, q = t & 3, br = (a == 0) ? 0 : (a == 1 ? 2 : 1); u.pm = a * 128 + p; u.pn = br * 4 + q; return true; }
        const int x = c & 7, s = c >> 3, p = x * 16 + (s >> 1), q = 2 * (s & 1) + i / 3, a = i % 3, br = (a == 0) ? 0 : (a == 1 ? 2 : 1);
        u.pm = a * 128 + p; u.pn = br * 4 + q; return true; }
    __device__ __forceinline__ void a_ready(const Unit&) const {}
    __device__ __forceinline__ void done(const Unit&) const {}
};
struct EpiPle {
    static constexpr bool PERM = true, AFTER_DRAIN = false;
    const bf16_t* Hin; bf16_t* Hout; const bf16_t* PP; float* outF; int last;
    __device__ __forceinline__ void operator()(const f32x4 (&acc)[2][2][4][2], const Unit& u, int wr, int wc, int fr, int fq) const {
        const int row0 = u.pm * BM + wr * 64 + fr; const int col0 = u.pn * BM + wc * 32 + 8 * fq;
#pragma unroll
        for (int ai = 0; ai < 2; ++ai) {
            u32x4 pw[4][2], hw[4][2];
#pragma unroll
            for (int m = 0; m < 4; ++m)
#pragma unroll
                for (int bj = 0; bj < 2; ++bj) { const int row = row0 + ai * HALF + m * 16, c = col0 + bj * HALF;
                    pw[m][bj] = *(const PG8_GAS u32x4*)(PP + (size_t)row * 1024 + c); hw[m][bj] = *(const PG8_GAS u32x4*)(Hin + (size_t)row * 1024 + c); }
            __builtin_amdgcn_sched_barrier(0);
#pragma unroll
            for (int m = 0; m < 4; ++m)
#pragma unroll
                for (int bj = 0; bj < 2; ++bj) { const int row = row0 + ai * HALF + m * 16, c = col0 + bj * HALF; const f32x4 v0 = acc[ai][bj][m][0], v1 = acc[ai][bj][m][1]; const u32x4 pq = pw[m][bj], hq = hw[m][bj];
                    f32x4 h0 = (f32x4){h_lo(hq.x), h_hi(hq.x), h_lo(hq.y), h_hi(hq.y)}, h1 = (f32x4){h_lo(hq.z), h_hi(hq.z), h_lo(hq.w), h_hi(hq.w)};
                    h0[0] += sigm(v0[0]) * h_lo(pq.x); h0[1] += sigm(v0[1]) * h_hi(pq.x); h0[2] += sigm(v0[2]) * h_lo(pq.y); h0[3] += sigm(v0[3]) * h_hi(pq.y);
                    h1[0] += sigm(v1[0]) * h_lo(pq.z); h1[1] += sigm(v1[1]) * h_hi(pq.z); h1[2] += sigm(v1[2]) * h_lo(pq.w); h1[3] += sigm(v1[3]) * h_hi(pq.w);
                    if (last) { float* op = outF + (size_t)row * 1024 + c; *(PG8_GAS f32x4*)op = h0; *(PG8_GAS f32x4*)(op + 4) = h1; }
                    else { u32x4 w; w.x = h_pk2(h0[0], h0[1]); w.y = h_pk2(h0[2], h0[3]); w.z = h_pk2(h1[0], h1[1]); w.w = h_pk2(h1[2], h1[3]); *(PG8_GAS u32x4*)(Hout + (size_t)row * 1024 + c) = w; } }
            __builtin_amdgcn_sched_barrier(0);
        }
    }
};
template <class E_, class = void> struct epi_chain { static constexpr bool value = false; };
template <class E_> struct epi_chain<E_, decltype((void)E_::CHAIN)> { static constexpr bool value = true; };
template <class Epi, class Sched, bool ALIGN_EPI = false, bool SP2 = false>
__device__ __forceinline__ void gemm_phase(PG8_LAS unsigned char* lds, const Gemm g, const Sched& S, const Epi& E) {
    int tid_ = my_tid(); asm volatile("" : "+v"(tid_));
    const int tid = tid_, wid = __builtin_amdgcn_readfirstlane(tid >> 6), lane = tid & 63, wr = wid >> 2, wc = wid & 3, fr = lane & 15, fq = lane >> 4;
    const int K = g.K, nt = K / BK;
    unsigned voffA[2], voffB[2];
#pragma unroll
    for (int i = 0; i < 2; ++i) { int R, C; stage_rc(tid * 16 + i * 8192, R, C); const int Rb = Epi::PERM ? ((R & ~31) + perm32(R & 31)) : R;
        voffA[i] = (unsigned)(R * K + C) * 2u; voffB[i] = (unsigned)(Rb * K + C) * 2u; }
    const size_t kstep = (size_t)(BK * 2);
    const size_t hstep = (size_t)HALF * K * 2;
    const size_t tstep = 2 * hstep;
    const unsigned ldsw = (unsigned)wid * 1024u;
    const int aoff = lds_byte(wr * 64 + fr, fq * 8), boff = lds_byte(wc * 32 + fr, fq * 8);
#define PG8_SA(b, h) (((b) * 2 + (h)) * HTB)
#define PG8_SB(b, h) ((4 + (b) * 2 + (h)) * HTB)
#define PG8_STAGE(bufoff, gbase, voff) do { _Pragma("unroll") for (int _i = 0; _i < 2; ++_i) \
        __builtin_amdgcn_global_load_lds((const unsigned*)((const char*)(gbase) + (voff)[_i]), (PG8_LAS unsigned*)(lds + (bufoff) + ldsw + _i * 8192), 16, 0, 0); } while (0)
#define PG8_LDA(dst, b, h) do { _Pragma("unroll") for (int m = 0; m < 4; ++m) _Pragma("unroll") for (int k = 0; k < 2; ++k) dst[m][k] = *(const PG8_LAS bf16x8*)(lds + PG8_SA(b, h) + aoff + m * 2048 + k * 1024); } while (0)
#define PG8_LDB(dst, b, h) do { _Pragma("unroll") for (int n = 0; n < 2; ++n) _Pragma("unroll") for (int k = 0; k < 2; ++k) dst[n][k] = *(const PG8_LAS bf16x8*)(lds + PG8_SB(b, h) + boff + n * 2048 + k * 1024); } while (0)
#define PG8_MMA(ai, bj, At, Bt) do { __builtin_amdgcn_s_setprio(1); _Pragma("unroll") for (int m = 0; m < 4; ++m) _Pragma("unroll") for (int n = 0; n < 2; ++n) _Pragma("unroll") for (int k = 0; k < 2; ++k) \
        acc[ai][bj][m][n] = MFMA16(Bt[n][k], At[m][k], acc[ai][bj][m][n]); __builtin_amdgcn_s_setprio(0); } while (0)
#define PG8_WAIT_V(n) asm volatile("s_waitcnt vmcnt(" #n ")" ::: "memory")
#define PG8_WAIT_L(n) asm volatile("s_waitcnt lgkmcnt(" #n ")" ::: "memory")
#define PG8_BAR __builtin_amdgcn_s_barrier()
#define PG8_SCHED __builtin_amdgcn_sched_barrier(0)
    Unit cur, nxt; int ui = 0;
    if (!S.next(0, cur)) return;
    f32x4 acc[2][2][4][2];
#pragma unroll
    for (int a = 0; a < 2; ++a)
#pragma unroll
        for (int b = 0; b < 2; ++b)
#pragma unroll
            for (int m = 0; m < 4; ++m)
#pragma unroll
                for (int n = 0; n < 2; ++n) acc[a][b][m][n] = (f32x4){0.f, 0.f, 0.f, 0.f};
    bf16x8 At[4][2], B0[2][2], B1[2][2];
    const char* cA = (const char*)g.A + (size_t)cur.pm * tstep; const char* cB = (const char*)g.Bt + (size_t)cur.pn * tstep;
    S.a_ready(cur);
    if constexpr (SP2) {
        PG8_STAGE(PG8_SB(0, 0), cB, voffB); PG8_STAGE(PG8_SB(0, 1), cB + hstep, voffB); PG8_STAGE(PG8_SA(0, 0), cA, voffA); PG8_STAGE(PG8_SA(0, 1), cA + hstep, voffA);
        if (wr == 1) PG8_BAR;
        PG8_WAIT_V(2); PG8_BAR;
        PG8_STAGE(PG8_SB(1, 0), cB + kstep, voffB); PG8_STAGE(PG8_SA(1, 0), cA + kstep, voffA); PG8_STAGE(PG8_SB(1, 1), cB + hstep + kstep, voffB);
        PG8_WAIT_V(6); PG8_BAR;
    } else {
        PG8_STAGE(PG8_SB(0, 0), cB, voffB); PG8_STAGE(PG8_SA(0, 0), cA, voffA); PG8_STAGE(PG8_SB(0, 1), cB + hstep, voffB); PG8_STAGE(PG8_SA(0, 1), cA + hstep, voffA);
        if (wr == 1) PG8_BAR;
        PG8_WAIT_V(4); PG8_BAR;
        PG8_STAGE(PG8_SB(1, 0), cB + kstep, voffB); PG8_STAGE(PG8_SA(1, 0), cA + kstep, voffA); PG8_STAGE(PG8_SB(1, 1), cB + hstep + kstep, voffB);
        PG8_WAIT_V(6); PG8_BAR;
    }
    for (;;) {
        const bool has_next = S.next(ui + 1, nxt);
        const char* nA = has_next ? (const char*)g.A + (size_t)nxt.pm * tstep : cA; const char* nB = has_next ? (const char*)g.Bt + (size_t)nxt.pn * tstep : cB;
        for (int t = 0; t < nt; t += 2) {
            const bool last = (t == nt - 2);
            const char* a1 = cA + (size_t)(t + 1) * kstep;
            const char* a2 = last ? nA : cA + (size_t)(t + 2) * kstep; const char* b2 = last ? nB : cB + (size_t)(t + 2) * kstep;
            const char* a3 = a2 + kstep; const char* b3 = b2 + kstep;
            if (last && has_next) S.a_ready(nxt);
            if constexpr (SP2) {
            PG8_LDB(B0, 0, 0); PG8_LDB(B1, 0, 1); PG8_SCHED; PG8_LDA(At, 0, 0); PG8_STAGE(PG8_SA(1, 1), a1 + hstep, voffA);
            PG8_WAIT_V(8); PG8_WAIT_L(0); PG8_BAR; PG8_MMA(0, 0, At, B0); PG8_MMA(0, 1, At, B1); PG8_BAR; PG8_SCHED;
            PG8_LDA(At, 0, 1); PG8_STAGE(PG8_SB(0, 0), b2, voffB); PG8_STAGE(PG8_SB(0, 1), b2 + hstep, voffB); PG8_STAGE(PG8_SA(0, 0), a2, voffA);
            PG8_WAIT_V(8); PG8_WAIT_L(0); PG8_BAR; PG8_MMA(1, 0, At, B0); PG8_MMA(1, 1, At, B1); PG8_BAR; PG8_SCHED;
            PG8_LDB(B0, 1, 0); PG8_LDB(B1, 1, 1); PG8_SCHED; PG8_LDA(At, 1, 0); PG8_STAGE(PG8_SA(0, 1), a2 + hstep, voffA);
            PG8_WAIT_V(8); PG8_WAIT_L(0); PG8_BAR; PG8_MMA(0, 0, At, B0); PG8_MMA(0, 1, At, B1); PG8_BAR; PG8_SCHED;
            PG8_LDA(At, 1, 1); PG8_STAGE(PG8_SB(1, 0), b3, voffB); PG8_STAGE(PG8_SB(1, 1), b3 + hstep, voffB); PG8_STAGE(PG8_SA(1, 0), a3, voffA);
            PG8_WAIT_V(8); PG8_WAIT_L(0); PG8_BAR; PG8_MMA(1, 0, At, B0); PG8_MMA(1, 1, At, B1); PG8_BAR; PG8_SCHED;
            } else {
            PG8_LDB(B0, 0, 0); PG8_SCHED; PG8_LDA(At, 0, 0); PG8_STAGE(PG8_SA(1, 1), a1 + hstep, voffA);
            PG8_WAIT_L(8); PG8_BAR; PG8_WAIT_L(0); PG8_MMA(0, 0, At, B0); PG8_BAR; PG8_SCHED;
            PG8_LDB(B1, 0, 1); PG8_STAGE(PG8_SB(0, 0), b2, voffB);
            PG8_BAR; PG8_WAIT_L(0); PG8_MMA(0, 1, At, B1); PG8_BAR;
            PG8_LDA(At, 0, 1); PG8_STAGE(PG8_SA(0, 0), a2, voffA);
            PG8_BAR; PG8_WAIT_L(0); PG8_MMA(1, 0, At, B0); PG8_BAR; PG8_SCHED;
            PG8_STAGE(PG8_SB(0, 1), b2 + hstep, voffB);
            PG8_WAIT_V(6); PG8_BAR; PG8_MMA(1, 1, At, B1); PG8_BAR;
            PG8_LDB(B0, 1, 0); PG8_SCHED; PG8_LDA(At, 1, 0); PG8_STAGE(PG8_SA(0, 1), a2 + hstep, voffA);
            PG8_WAIT_L(8); PG8_BAR; PG8_WAIT_L(0); PG8_MMA(0, 0, At, B0); PG8_BAR; PG8_SCHED;
            PG8_LDB(B1, 1, 1); PG8_STAGE(PG8_SB(1, 0), b3, voffB);
            PG8_BAR; PG8_WAIT_L(0); PG8_MMA(0, 1, At, B1); PG8_BAR;
            PG8_LDA(At, 1, 1); PG8_STAGE(PG8_SA(1, 0), a3, voffA);
            PG8_BAR; PG8_WAIT_L(0); PG8_MMA(1, 0, At, B0); PG8_BAR; PG8_SCHED;
            PG8_STAGE(PG8_SB(1, 1), b3 + hstep, voffB);
            PG8_WAIT_V(6); PG8_BAR; PG8_MMA(1, 1, At, B1); PG8_BAR;
            }
        }
        if constexpr (ALIGN_EPI) { if (wr == 0) PG8_BAR; }
        if constexpr (!Epi::AFTER_DRAIN) { int t2_ = my_tid(); asm volatile("" : "+v"(t2_)); const int l2_ = t2_ & 63, w2_ = __builtin_amdgcn_readfirstlane(t2_ >> 6);
            E(acc, cur, w2_ >> 2, w2_ & 3, l2_ & 15, l2_ >> 4); S.done(cur); }
        if (!has_next) break;
        bool keep_acc_ = false;
        if constexpr (epi_chain<Epi>::value) keep_acc_ = E.chain(cur);
        if (!keep_acc_) {
#pragma unroll
        for (int a = 0; a < 2; ++a)
#pragma unroll
            for (int b = 0; b < 2; ++b)
#pragma unroll
                for (int m = 0; m < 4; ++m)
#pragma unroll
                    for (int n = 0; n < 2; ++n) acc[a][b][m][n] = (f32x4){0.f, 0.f, 0.f, 0.f};
        }
        cur = nxt; cA = nA; cB = nB; ++ui;
        if constexpr (ALIGN_EPI) { if (wr == 1) PG8_BAR; }
    }
    PG8_WAIT_V(0);
    if constexpr (!ALIGN_EPI) { if (wr == 0) PG8_BAR; }
    PG8_BAR;
    if constexpr (Epi::AFTER_DRAIN) { E.fused(acc, cur, wr, wc, fr, fq, lds, wid, lane); S.done(cur); }
#undef PG8_SA
#undef PG8_SB
#undef PG8_STAGE
#undef PG8_LDA
#undef PG8_LDB
#undef PG8_MMA
#undef PG8_WAIT_V
#undef PG8_WAIT_L
#undef PG8_BAR
#undef PG8_SCHED
}
}
constexpr int NWAVES = 8;
constexpr int D = 1024, BATCH = 8, SEQ = 4096, T = BATCH * SEQ, DEPTH = 2, FF = 4096, DPLE = 256;
constexpr int IN_COLS = 6848, RW_COLS = 1792;
constexpr float NORM_EPS = 1e-6f, RW_LN_EPS = 64e-5f;
constexpr float LOG2E = 1.4426950408889634f;
constexpr float MLA_QSCALE = 0.07216878364870322f * LOG2E;
constexpr float CA_QSCALE = 0.125f * LOG2E;
constexpr size_t MiB = 1u << 20;
constexpr size_t WS_CTL = 0, CTL_ZERO_BYTES = 1 * MiB;
constexpr size_t WS_RS1 = 512 * 1024, WS_RS2 = 640 * 1024;
static_assert(DEPTH % 2 == 0, "the residual stream ping-pongs between d_out and WS_U: the last layer must read it from WS_U");
constexpr size_t WS_ROPE = 1 * MiB;
constexpr size_t WS_W = 9 * MiB;
constexpr size_t W_IN = WS_W, W_Q = W_IN + (size_t)6912 * 1024 * 2, W_LORA = W_Q + (size_t)768 * 256 * 2, W_B = W_LORA + (size_t)1536 * 256 * 2,
                 W_OUT = W_B + (size_t)3 * 1024 * 512 * 2, W_1 = W_OUT + (size_t)1024 * 1024 * 2, W_2 = W_1 + (size_t)4096 * 1024 * 2, W_G = W_2 + (size_t)4096 * 1024 * 2,
                 W_P = W_G + (size_t)1024 * 1024 * 2, W_END = W_P + (size_t)1024 * 256 * 2;
constexpr size_t WS_U = 49 * MiB;
constexpr size_t WS_OA = 113 * MiB, WS_OC = 145 * MiB, WS_ORW = 177 * MiB;
constexpr size_t WS_X = 209 * MiB, WS_END = 512 * MiB;
constexpr size_t X_ZC = WS_X, X_QP = X_ZC + (size_t)T * 1536 * 2, X_KV = X_QP + (size_t)T * 768 * 2, X_ZR = X_KV + (size_t)T * 192 * 2, X_TW = X_ZR + (size_t)T * 1792 * 2;
constexpr size_t X_GCT = X_TW + (size_t)T * 512 * 2, X_CBG = X_GCT + (size_t)(T / 16) * 512 * 2;
constexpr size_t X_BND = WS_OC;
constexpr size_t X_QN = WS_OC, X_LA = WS_OC + (size_t)T * 256 * 2;
constexpr size_t DO_G = 0, DO_TA = 32 * MiB, DO_H16 = 64 * MiB;
constexpr size_t X_STG = WS_X + 96 * MiB;
constexpr size_t X_GT = WS_X, X_MG = X_GT + (size_t)T * 3072 * 2;
constexpr size_t X_HID = WS_X, X_PB = WS_X, X_PP = X_PB + (size_t)T * 256 * 2;
static_assert(X_CBG + (size_t)T * 8 * 4 <= WS_END && X_TW + (size_t)T * 512 * 2 <= WS_END && X_MG + (size_t)T * 1024 * 2 <= WS_END && X_HID + (size_t)T * 4096 * 2 <= WS_END, "X map");
constexpr int CW_TMO = 0, CW_QUEUE = 1024  , CW_SUB = 2048  , CW_BAR = 4096;
constexpr int RING_OFF = 0, RING_BYTES = 131072;
constexpr int LDSCTL_OFF = RING_BYTES, MISC_OFF = LDSCTL_OFF + 320;
constexpr int LDS_BYTES = 147456;

#define GAS __attribute__((address_space(1)))
#define LAS __attribute__((address_space(3)))
typedef unsigned short bf16;
typedef unsigned v4u __attribute__((ext_vector_type(4)));
typedef unsigned v2u __attribute__((ext_vector_type(2)));
typedef float f32x4 __attribute__((ext_vector_type(4)));
typedef float f32x16 __attribute__((ext_vector_type(16)));
typedef short bf16x8 __attribute__((ext_vector_type(8)));
typedef short s16x4 __attribute__((ext_vector_type(4)));
#define LDS_WAIT() asm volatile("s_waitcnt lgkmcnt(0)" ::: "memory")
#define VM_WAIT() asm volatile("s_waitcnt vmcnt(0)" ::: "memory")
__device__ __forceinline__ unsigned f2bf(float f) { return h_f2h(f); }
__device__ __forceinline__ unsigned pk2(float lo, float hi) { return h_pk2(lo, hi); }
__device__ __forceinline__ float bfl(unsigned w) { return h_lo(w); }
__device__ __forceinline__ float bfh(unsigned w) { return h_hi(w); }
__device__ __forceinline__ float sigmoidf_(float x) { return 1.0f / (1.0f + __expf(-x)); }
__device__ __forceinline__ float shfl_xor_f(float v, int o, int lane) { return __int_as_float(__builtin_amdgcn_ds_bpermute((lane ^ o) << 2, __float_as_int(v))); }
template <int CTRL> __device__ __forceinline__ float dpp_add_(float v) { return v + __int_as_float(__builtin_amdgcn_update_dpp(0, __float_as_int(v), CTRL, 0xf, 0xf, true)); }
__device__ __forceinline__ float wave_sum(float v, int lane) {
    v = dpp_add_<0xB1>(v); v = dpp_add_<0x4E>(v); v = dpp_add_<0x141>(v); v = dpp_add_<0x140>(v);
    v += shfl_xor_f(v, 16, lane); v += shfl_xor_f(v, 32, lane);
    return v;
}
__device__ __forceinline__ unsigned char* opq(unsigned char* p) { asm volatile("" : "+s"(p)); return p; }
__device__ __forceinline__ float fsig(float x) { return __builtin_amdgcn_rcpf(1.0f + __builtin_amdgcn_exp2f(-LOG2E * x)); }
#define XB_TMO      128
#define XB_XCNT(j)  (256  + 64 * (j))
#define XB_XSUB(j)  (1280 + 64 * (j))
#define XB_XGEN(j)  (2304 + 64 * (j))
#define XB_TOP      3328
#define XB_TOPGEN   3392
#define XCD_BAR_WORDS 3456
#define XB_SPIN_CAP (1u << 25)

__device__ __forceinline__ unsigned xb_ld(unsigned* p)              { return __hip_atomic_load(p, __ATOMIC_RELAXED, __HIP_MEMORY_SCOPE_AGENT); }
__device__ __forceinline__ unsigned xb_add(unsigned* p, unsigned v) { return __hip_atomic_fetch_add(p, v, __ATOMIC_RELAXED, __HIP_MEMORY_SCOPE_AGENT); }
__device__ __forceinline__ unsigned xb_xcc_id() { return (unsigned)__builtin_amdgcn_s_getreg((3 << 11) | 20) & 0xFu; }
#define XB_SPIN(cond, bar) do { unsigned _sp = 0; while (cond) { __builtin_amdgcn_s_sleep(1); \
    if ((++_sp & 255u) == 0u) { if (xb_ld(&(bar)[XB_TMO])) break; if (_sp > XB_SPIN_CAP) { atomicAdd(&(bar)[XB_TMO], 1u); break; } } } } while (0)

struct XcdBarrier {
    unsigned* bar; unsigned x;
    volatile LAS unsigned* st;
};

__device__ __forceinline__ XcdBarrier xcd_barrier_post(unsigned* bar, volatile LAS unsigned* st) {
    XcdBarrier b; b.bar = bar; b.x = xb_xcc_id(); b.st = st;
    if (my_tid() == 0) (void)xb_add(&bar[XB_XCNT(b.x)], 1u);
    return b;
}
__device__ __forceinline__ void xcd_barrier_complete(unsigned* bar, unsigned x, unsigned& nloc, unsigned& nx) {
    const unsigned G = gridDim.x * gridDim.y * gridDim.z;
    unsigned sum, cnt, mine, sp = 0u;
    for (;;) {
        sum = 0u; cnt = 0u; mine = 0u;
#pragma unroll
        for (unsigned j = 0; j < 16; ++j) { const unsigned c = xb_ld(&bar[XB_XCNT(j)]); sum += c; cnt += (c > 0u) ? 1u : 0u; mine = (j == x) ? c : mine; }
        if (sum == G) break;
        __builtin_amdgcn_s_sleep(1);
        if ((++sp & 255u) == 0u) { if (xb_ld(&bar[XB_TMO])) break; if (sp > XB_SPIN_CAP) { atomicAdd(&bar[XB_TMO], 1u); break; } }
    }
    nloc = mine > 0u ? mine : 1u; nx = cnt > 0u ? cnt : 1u;
}

__device__ __forceinline__ void xcd_barrier(const XcdBarrier& b) {
    asm volatile("s_waitcnt vmcnt(0)" ::: "memory");
    __syncthreads();
    if (my_tid() == 0) {
        unsigned* bar = b.bar;
        __builtin_amdgcn_s_waitcnt(0);
        unsigned nloc = b.st[0], nx = b.st[1];
        if (nloc == 0u) { xcd_barrier_complete(bar, b.x, nloc, nx); b.st[0] = nloc; b.st[1] = nx; }
        const unsigned old = xb_add(&bar[XB_XSUB(b.x)], 1u);
        const unsigned gen = old / nloc;
        if (old + 1u == (gen + 1u) * nloc) {
            __builtin_amdgcn_fence(__ATOMIC_RELEASE, "agent");
            asm volatile("s_waitcnt vmcnt(0)" ::: "memory");
            const unsigned og = xb_add(&bar[XB_TOP], 1u);
            const unsigned tg = og / nx;
            if (og + 1u == (tg + 1u) * nx) xb_add(&bar[XB_TOPGEN], 1u);
            else XB_SPIN(xb_ld(&bar[XB_TOPGEN]) == tg, bar);
            __builtin_amdgcn_fence(__ATOMIC_ACQUIRE, "agent");
            xb_add(&bar[XB_XGEN(b.x)], 1u);
            asm volatile("s_waitcnt vmcnt(0)" ::: "memory");
        } else {
            XB_SPIN(xb_ld(&bar[XB_XGEN(b.x)]) == gen, bar);
            __builtin_amdgcn_fence(__ATOMIC_ACQUIRE, "agent");
            asm volatile("s_waitcnt vmcnt(0)" ::: "memory");
        }
    }
    __syncthreads();
}

__device__ __forceinline__ void sub_barrier(unsigned* bar, unsigned* ctr, unsigned n, bool arrive) {
    asm volatile("s_waitcnt vmcnt(0)" ::: "memory");
    __syncthreads();
    if (my_tid() == 0) {
        if (arrive) { __builtin_amdgcn_fence(__ATOMIC_RELEASE, "agent"); asm volatile("s_waitcnt vmcnt(0)" ::: "memory"); (void)xb_add(ctr, 1u); }
        XB_SPIN(xb_ld(ctr) < n, bar);
        __builtin_amdgcn_fence(__ATOMIC_ACQUIRE, "agent");
        asm volatile("s_waitcnt vmcnt(0)" ::: "memory");
    }
    __syncthreads();
}
namespace att {
__device__ __forceinline__ int crow(int r, int hi) { return (r & 3) + 8 * (r >> 2) + 4 * hi; }
__device__ __forceinline__ unsigned cvtpk(float lo, float hi) { return h_pk2(lo, hi); }
typedef short v4i16_t __attribute__((ext_vector_type(4)));
__device__ __forceinline__ s16x4 vtr(const LAS unsigned char* p) { return __builtin_bit_cast(s16x4, __builtin_amdgcn_ds_read_tr16_b64_v4i16((LAS v4i16_t*)p)); }
__device__ __forceinline__ float softmax_tile(f32x16& p0, f32x16& p1, float& m_reg, float& l_reg, bf16x8& pa0, bf16x8& pa1, bf16x8& pa2, bf16x8& pa3) {
    float pmax = p0[0];
#pragma unroll
    for (int r = 1; r < 16; ++r) pmax = fmaxf(pmax, p0[r]);
#pragma unroll
    for (int r = 0; r < 16; ++r) pmax = fmaxf(pmax, p1[r]);
    { auto rr = __builtin_amdgcn_permlane32_swap(__float_as_uint(pmax), __float_as_uint(pmax), false, false); pmax = fmaxf(__uint_as_float(rr[0]), __uint_as_float(rr[1])); }
    float alpha = 1.f;
    if (!__all(pmax - m_reg <= 8.f)) { const float mn = fmaxf(m_reg, pmax); alpha = __builtin_amdgcn_exp2f(m_reg - mn); m_reg = mn; }
    float ps = 0.f;
#pragma unroll
    for (int r = 0; r < 16; ++r) { p0[r] = __builtin_amdgcn_exp2f(p0[r] - m_reg); ps += p0[r]; }
#pragma unroll
    for (int r = 0; r < 16; ++r) { p1[r] = __builtin_amdgcn_exp2f(p1[r] - m_reg); ps += p1[r]; }
    { auto rr = __builtin_amdgcn_permlane32_swap(__float_as_uint(ps), __float_as_uint(ps), false, false); ps = __uint_as_float(rr[0]) + __uint_as_float(rr[1]); }
    l_reg = l_reg * alpha + ps;
#define PK4(P, BASE, OUT) do { unsigned a0 = cvtpk(P[BASE + 0], P[BASE + 1]), a1 = cvtpk(P[BASE + 2], P[BASE + 3]);   \
    unsigned b0 = cvtpk(P[BASE + 4], P[BASE + 5]), b1 = cvtpk(P[BASE + 6], P[BASE + 7]);                              \
    auto r0 = __builtin_amdgcn_permlane32_swap(a0, b0, false, false); auto r1 = __builtin_amdgcn_permlane32_swap(a1, b1, false, false); \
    v4u w = {r0[0], r1[0], r0[1], r1[1]}; OUT = __builtin_bit_cast(bf16x8, w); } while (0)
    PK4(p0, 0, pa0); PK4(p0, 8, pa1); PK4(p1, 0, pa2); PK4(p1, 8, pa3);
#undef PK4
    return alpha;
}
constexpr int MLA_KSTR = 400;
constexpr int MLA_KBUF = 64 * MLA_KSTR;
constexpr int ATT_SCR = 2 * MLA_KBUF;
__device__ __forceinline__ void mla_unit(LAS unsigned char* lds, const bf16* __restrict__ QP, const bf16* __restrict__ KV, bf16* __restrict__ OA, int b, int c) {
    int tid_ = my_tid(); asm volatile("" : "+v"(tid_));
    const int tid = tid_, lane = tid & 63, wid = __builtin_amdgcn_readfirstlane(tid >> 6), r32 = lane & 31, hi = lane >> 5;
    const int h = wid >> 1; const size_t qrow0 = (size_t)b * SEQ + c * 64 + (wid & 1) * 32;
    bf16x8 qr[12];
    { const bf16* qp = QP + (qrow0 + r32) * 768 + h * 192 + hi * 8;
#pragma unroll
      for (int d0 = 0; d0 < 12; ++d0) qr[d0] = *(const GAS bf16x8*)(qp + d0 * 16); }
    float m_reg = -1e30f, l_reg = 0.f; f32x16 o[4];
#pragma unroll
    for (int d = 0; d < 4; ++d)
#pragma unroll
        for (int r = 0; r < 16; ++r) o[d][r] = 0.f;
    LAS float* scr = (LAS float*)(lds + ATT_SCR) + wid * 64;
    const bf16* kvb = KV + (size_t)b * SEQ * 192;
    int skey[3], sch[3];
#pragma unroll
    for (int i = 0; i < 3; ++i) { const int id = tid + 512 * i; skey[i] = id / 24; sch[i] = id % 24; }
    v4u st[3];
    const int NT = c + 1;
#pragma unroll
    for (int i = 0; i < 3; ++i) st[i] = *(const GAS v4u*)(kvb + (size_t)skey[i] * 192 + sch[i] * 8);
#pragma unroll
    for (int i = 0; i < 3; ++i) *(LAS v4u*)(lds + skey[i] * MLA_KSTR + sch[i] * 16) = st[i];
    asm volatile("" : "+v"(qr[0]), "+v"(qr[1]), "+v"(qr[2]), "+v"(qr[3]), "+v"(qr[4]), "+v"(qr[5]), "+v"(qr[6]), "+v"(qr[7]), "+v"(qr[8]), "+v"(qr[9]), "+v"(qr[10]), "+v"(qr[11]));
    __syncthreads();
    const int troff = (((lane & 15) >> 2) + 8 * hi) * MLA_KSTR + (16 * ((lane >> 4) & 1) + 4 * (lane & 3)) * 2;
    for (int j = 0; j < NT; ++j) {
        const int buf = j & 1;
        if (j + 1 < NT) {
#pragma unroll
            for (int i = 0; i < 3; ++i) st[i] = *(const GAS v4u*)(kvb + (size_t)(64 * (j + 1) + skey[i]) * 192 + sch[i] * 8);
        }
        const LAS unsigned char* kt = lds + buf * MLA_KBUF;
        f32x16 p0, p1;
#pragma unroll
        for (int r = 0; r < 16; ++r) { p0[r] = 0.f; p1[r] = 0.f; }
        const LAS unsigned char* vb = kt + troff;
        s16x4 vlo[2][4], vhh[2][4];
#define MLA_LDV(G, B) do { _Pragma("unroll") for (int ks = 0; ks < 4; ++ks) { vlo[B][ks] = vtr(vb + (16 * ks) * MLA_KSTR + (G) * 64); vhh[B][ks] = vtr(vb + (16 * ks + 4) * MLA_KSTR + (G) * 64); } } while (0)
        {
            const LAS unsigned char* kb = kt + r32 * MLA_KSTR + hi * 16;
            bf16x8 fa[2][3], fb[2][3];
#define MLA_LDK(G, B) do { _Pragma("unroll") for (int i = 0; i < 3; ++i) { fa[B][i] = *(const LAS bf16x8*)(kb + (3 * (G) + i) * 32); fb[B][i] = *(const LAS bf16x8*)(kb + 32 * MLA_KSTR + (3 * (G) + i) * 32); } } while (0)
            MLA_LDK(0, 0);
            __builtin_amdgcn_sched_barrier(0);
#pragma unroll
            for (int g = 0; g < 4; ++g) {
                if (g < 3) MLA_LDK(g + 1, (g + 1) & 1); else MLA_LDV(0, 0);
                __builtin_amdgcn_sched_barrier(0);
#pragma unroll
                for (int i = 0; i < 3; ++i) { p0 = MFMA32(fa[g & 1][i], qr[3 * g + i], p0); p1 = MFMA32(fb[g & 1][i], qr[3 * g + i], p1); }
                __builtin_amdgcn_sched_barrier(0);
            }
#undef MLA_LDK
        }
        bf16x8 pa0, pa1, pa2, pa3;
        const float alpha = softmax_tile(p0, p1, m_reg, l_reg, pa0, pa1, pa2, pa3);
        if (__any(alpha < 1.f)) { if (hi == 0) scr[r32] = alpha; LDS_WAIT();
#pragma unroll
            for (int r = 0; r < 16; ++r) { const float a = scr[crow(r, hi)];
#pragma unroll
                for (int d = 0; d < 4; ++d) o[d][r] *= a; } }
        __builtin_amdgcn_sched_barrier(0);
#pragma unroll
        for (int d0 = 0; d0 < 4; ++d0) {
            if (d0 < 3) MLA_LDV(d0 + 1, (d0 + 1) & 1);
            __builtin_amdgcn_sched_barrier(0);
#define PK(k) (bf16x8){vlo[d0 & 1][k][0], vlo[d0 & 1][k][1], vlo[d0 & 1][k][2], vlo[d0 & 1][k][3], vhh[d0 & 1][k][0], vhh[d0 & 1][k][1], vhh[d0 & 1][k][2], vhh[d0 & 1][k][3]}
            o[d0] = MFMA32(pa0, PK(0), o[d0]);
            o[d0] = MFMA32(pa1, PK(1), o[d0]);
            o[d0] = MFMA32(pa2, PK(2), o[d0]);
            o[d0] = MFMA32(pa3, PK(3), o[d0]);
#undef PK
            __builtin_amdgcn_sched_barrier(0);
        }
#undef MLA_LDV
        if (j + 1 < NT) {
#pragma unroll
            for (int i = 0; i < 3; ++i) *(LAS v4u*)(lds + (buf ^ 1) * MLA_KBUF + skey[i] * MLA_KSTR + sch[i] * 16) = st[i];
        }
        __syncthreads();
    }
    if (hi == 0) scr[r32] = l_reg; LDS_WAIT();
    bf16* ob = OA + qrow0 * 512 + h * 128 + r32;
#pragma unroll
    for (int r = 0; r < 16; ++r) { const int orow = crow(r, hi); const float rl = __builtin_amdgcn_rcpf(scr[orow]);
#pragma unroll
        for (int d0 = 0; d0 < 4; ++d0) *(GAS bf16*)(ob + (size_t)orow * 512 + d0 * 32) = (bf16)f2bf(o[d0][r] * rl); }
    __syncthreads();
}
constexpr int CA_KSTR = 144;
constexpr int CA_TBUF = 64 * CA_KSTR;
constexpr int CA_BIAS = ATT_SCR + 8 * 256;
__device__ __forceinline__ void band_unit(LAS unsigned char* lds, const bf16* __restrict__ ZC, const float* __restrict__ relb, bf16* __restrict__ OC, int b, int h, int g) {
    int tid_ = my_tid(); asm volatile("" : "+v"(tid_));
    const int tid = tid_, lane = tid & 63, wid = __builtin_amdgcn_readfirstlane(tid >> 6), r32 = lane & 31, hi = lane >> 5;
    const int cw = 4 * g + (wid >> 1); const size_t qrow0 = (size_t)b * SEQ + cw * 64 + (wid & 1) * 32;
    LAS float* bias = (LAS float*)(lds + CA_BIAS);
    if (tid < 320) bias[tid] = *(const GAS float*)(relb + tid * 8 + h) * LOG2E;
    bf16x8 qr[4];
    { const bf16* qp = ZC + (qrow0 + r32) * 1536 + h * 64 + hi * 8;
#pragma unroll
      for (int d0 = 0; d0 < 4; ++d0) qr[d0] = *(const GAS bf16x8*)(qp + d0 * 16); }
    float m_reg = -1e30f, l_reg = 0.f; f32x16 o[2];
#pragma unroll
    for (int d = 0; d < 2; ++d)
#pragma unroll
        for (int r = 0; r < 16; ++r) o[d][r] = 0.f;
    LAS float* scr = (LAS float*)(lds + ATT_SCR) + wid * 64;
    const int kc0 = (4 * g - 8) < 0 ? 0 : (4 * g - 8), kc1 = 4 * g + 3;
    const bf16* kbase = ZC + (size_t)b * SEQ * 1536 + 512 + h * 64; const bf16* vbase = kbase + 512;
    const int skey = tid >> 3, sch = tid & 7;
    v4u stk, stv;
    stk = *(const GAS v4u*)(kbase + (size_t)(64 * kc0 + skey) * 1536 + sch * 8); stv = *(const GAS v4u*)(vbase + (size_t)(64 * kc0 + skey) * 1536 + sch * 8);
    *(LAS v4u*)(lds + skey * CA_KSTR + sch * 16) = stk; *(LAS v4u*)(lds + CA_TBUF + skey * CA_KSTR + sch * 16) = stv;
    asm volatile("" : "+v"(qr[0]), "+v"(qr[1]), "+v"(qr[2]), "+v"(qr[3]));
    __syncthreads();
    const int troff = (((lane & 15) >> 2) + 8 * hi) * CA_KSTR + (16 * ((lane >> 4) & 1) + 4 * (lane & 3)) * 2;
    const int qin = (wid & 1) * 32 + r32;
    for (int kc = kc0; kc <= kc1; ++kc) {
        const int buf = (kc - kc0) & 1;
        if (kc < kc1) { stk = *(const GAS v4u*)(kbase + (size_t)(64 * (kc + 1) + skey) * 1536 + sch * 8); stv = *(const GAS v4u*)(vbase + (size_t)(64 * (kc + 1) + skey) * 1536 + sch * 8); }
        if (kc >= cw - 8 && kc <= cw) {
            const LAS unsigned char* kt = lds + buf * 2 * CA_TBUF;
            f32x16 p0, p1;
            const int dbase = (cw - kc) * 64 + qin + 63;
#pragma unroll
            for (int r = 0; r < 16; ++r) { int i0 = dbase - crow(r, hi), i1 = i0 - 32; i0 = i0 > 319 ? 319 : i0; i1 = i1 > 319 ? 319 : i1; p0[r] = bias[i0]; p1[r] = bias[i1]; }
            const LAS unsigned char* vb = kt + CA_TBUF + troff;
            s16x4 vlo[2][4], vhh[2][4];
#define CA_LDV(G) do { _Pragma("unroll") for (int ks = 0; ks < 4; ++ks) { vlo[G][ks] = vtr(vb + (16 * ks) * CA_KSTR + (G) * 64); vhh[G][ks] = vtr(vb + (16 * ks + 4) * CA_KSTR + (G) * 64); } } while (0)
            {
                const LAS unsigned char* kb = kt + r32 * CA_KSTR + hi * 16;
                bf16x8 fa[4], fb[4];
#pragma unroll
                for (int d0 = 0; d0 < 4; ++d0) { fa[d0] = *(const LAS bf16x8*)(kb + d0 * 32); fb[d0] = *(const LAS bf16x8*)(kb + 32 * CA_KSTR + d0 * 32); }
                CA_LDV(0);
                __builtin_amdgcn_sched_barrier(0);
#pragma unroll
                for (int d0 = 0; d0 < 4; ++d0) { p0 = MFMA32(fa[d0], qr[d0], p0); p1 = MFMA32(fb[d0], qr[d0], p1); }
                __builtin_amdgcn_sched_barrier(0);
            }
            bf16x8 pa0, pa1, pa2, pa3;
            const float alpha = softmax_tile(p0, p1, m_reg, l_reg, pa0, pa1, pa2, pa3);
            if (__any(alpha < 1.f)) { if (hi == 0) scr[r32] = alpha; LDS_WAIT();
#pragma unroll
                for (int r = 0; r < 16; ++r) { const float a = scr[crow(r, hi)]; o[0][r] *= a; o[1][r] *= a; } }
            __builtin_amdgcn_sched_barrier(0);
            CA_LDV(1);
            __builtin_amdgcn_sched_barrier(0);
#pragma unroll
            for (int d0 = 0; d0 < 2; ++d0) {
#define PK(k) (bf16x8){vlo[d0][k][0], vlo[d0][k][1], vlo[d0][k][2], vlo[d0][k][3], vhh[d0][k][0], vhh[d0][k][1], vhh[d0][k][2], vhh[d0][k][3]}
                o[d0] = MFMA32(pa0, PK(0), o[d0]);
                o[d0] = MFMA32(pa1, PK(1), o[d0]);
                o[d0] = MFMA32(pa2, PK(2), o[d0]);
                o[d0] = MFMA32(pa3, PK(3), o[d0]);
#undef PK
            }
            __builtin_amdgcn_sched_barrier(0);
#undef CA_LDV
        }
        if (kc < kc1) { *(LAS v4u*)(lds + (buf ^ 1) * 2 * CA_TBUF + skey * CA_KSTR + sch * 16) = stk; *(LAS v4u*)(lds + (buf ^ 1) * 2 * CA_TBUF + CA_TBUF + skey * CA_KSTR + sch * 16) = stv; }
        __syncthreads();
    }
    if (hi == 0) scr[r32] = l_reg; LDS_WAIT();
    bf16* ob = OC + qrow0 * 512 + h * 64 + r32;
#pragma unroll
    for (int r = 0; r < 16; ++r) { const int orow = crow(r, hi); const float rl = __builtin_amdgcn_rcpf(scr[orow]);
        *(GAS bf16*)(ob + (size_t)orow * 512) = (bf16)f2bf(o[0][r] * rl); *(GAS bf16*)(ob + (size_t)orow * 512 + 32) = (bf16)f2bf(o[1][r] * rl); }
    __syncthreads();
}
}
struct Args { const float* in[30]; float* out; unsigned char* ws; int start; int stop; };
#define KAS __attribute__((address_space(4)))
__device__ __forceinline__ const KAS unsigned char* kbase() { const KAS unsigned char* p = (const KAS unsigned char*)__builtin_amdgcn_kernarg_segment_ptr(); asm volatile("" : "+s"(p)); return p; }
__device__ __forceinline__ const float* kin(int i) { return *(const float* const KAS*)(kbase() + 8 * i); }
__device__ __forceinline__ float* kout() { return *(float* const KAS*)(kbase() + 240); }
__device__ __forceinline__ unsigned char* kws() { return *(unsigned char* const KAS*)(kbase() + 248); }
__device__ __forceinline__ int kstart() { return *(const int KAS*)(kbase() + 256); }
__device__ __forceinline__ int kstop() { return *(const int KAS*)(kbase() + 260); }
struct Frame { LAS unsigned char* lds; int tid, lane, wave, G, gw, NGW; };
__device__ __forceinline__ Frame make_frame(LAS unsigned char* lds) {
    Frame F; int tid = my_tid(); asm volatile("" : "+v"(tid)); int bx = blockIdx.x; asm volatile("" : "+s"(bx)); int G = gridDim.x; asm volatile("" : "+s"(G));
    F.lds = lds; F.tid = tid; F.lane = tid & 63; F.wave = __builtin_amdgcn_readfirstlane(tid >> 6); F.G = G; F.gw = bx * NWAVES + F.wave; F.NGW = G * NWAVES; return F;
}

__device__ const double ROPE_INV_FREQ[32] = {1, 0.74989420933245587, 0.56234132519034907, 0.42169650342858223, 0.31622776601683794, 0.23713737056616552, 0.17782794100389229, 0.1333521432163324, 0.10000000000000001, 0.074989420933245579, 0.056234132519034911, 0.042169650342858224, 0.031622776601683791, 0.023713737056616554, 0.017782794100389229, 0.013335214321633241, 0.01, 0.0074989420933245579, 0.005623413251903491, 0.0042169650342858229, 0.0031622776601683794, 0.0023713737056616554, 0.0017782794100389228, 0.0013335214321633241, 0.001, 0.00074989420933245586, 0.0005623413251903491, 0.00042169650342858224, 0.00031622776601683794, 0.00023713737056616554, 0.00017782794100389227, 0.0001333521432163324};
__device__ __forceinline__ void sincos_d(double a, float& s, float& c) {
    const double n = rint(a * 0.63661977236758134308);
    double r = fma(-n, 1.5707963267948966192, a); r = fma(-n, 6.123233995736766036e-17, r);
    const double r2 = r * r;
    double sp = -7.6471637318198164759e-13; sp = fma(sp, r2, 1.6059043836821614599e-10); sp = fma(sp, r2, -2.5052108385441718775e-08); sp = fma(sp, r2, 2.7557319223985890653e-06);
    sp = fma(sp, r2, -1.9841269841269841270e-04); sp = fma(sp, r2, 8.3333333333333333333e-03); sp = fma(sp, r2, -1.6666666666666666667e-01);
    const double sn = fma(sp * r2, r, r);
    double cp = 4.7794773323873852974e-14; cp = fma(cp, r2, -1.1470745597729724714e-11); cp = fma(cp, r2, 2.0876756987868098979e-09); cp = fma(cp, r2, -2.7557319223985890653e-07);
    cp = fma(cp, r2, 2.4801587301587301587e-05); cp = fma(cp, r2, -1.3888888888888888889e-03); cp = fma(cp, r2, 4.1666666666666666667e-02); cp = fma(cp, r2, -0.5);
    const double cs = fma(cp, r2, 1.0);
    const long long q = (long long)n & 3LL; double so, co;
    if (q == 0) { so = sn; co = cs; } else if (q == 1) { so = cs; co = -sn; } else if (q == 2) { so = -sn; co = -cs; } else { so = -cs; co = sn; }
    s = (float)so; c = (float)co;
}
__device__ __forceinline__ void transpose_item(const float* W, int ldw, int col0, int nblk, bf16* WT, int ldt, int row0, LAS float* scr, int item, int lane, const float* gk = nullptr) {
    const int kb = item / nblk, nb = item % nblk, k0 = 64 * kb, n0 = 32 * nb;
    float tv[32];
#pragma unroll
    for (int i = 0; i < 32; ++i) tv[i] = *(const GAS float*)(W + (size_t)(k0 + 2 * i + (lane >> 5)) * ldw + col0 + n0 + (lane & 31));
#pragma unroll
    for (int i = 0; i < 32; ++i) scr[(2 * i + (lane >> 5)) * 33 + (lane & 31)] = tv[i];
    LDS_WAIT(); asm volatile("" ::: "memory");
    const int c = lane & 7;
    f32x4 ga = {1.f, 1.f, 1.f, 1.f}, gb = {1.f, 1.f, 1.f, 1.f};
    if (gk) { ga = *(const GAS f32x4*)(gk + k0 + 8 * c); gb = *(const GAS f32x4*)(gk + k0 + 8 * c + 4); }
#pragma unroll
    for (int j = 0; j < 4; ++j) { const int n = (lane >> 3) + 8 * j; const LAS float* s = scr + (8 * c) * 33 + n;
        v4u o; o.x = pk2(s[0 * 33] * ga[0], s[1 * 33] * ga[1]); o.y = pk2(s[2 * 33] * ga[2], s[3 * 33] * ga[3]); o.z = pk2(s[4 * 33] * gb[0], s[5 * 33] * gb[1]); o.w = pk2(s[6 * 33] * gb[2], s[7 * 33] * gb[3]);
        *(GAS v4u*)(WT + (size_t)(row0 + n0 + n) * ldt + k0 + 8 * c) = o; }
    LDS_WAIT(); asm volatile("" ::: "memory");
}
__device__ __forceinline__ void rope_table(LAS unsigned char* lds_) {
    const Frame F = make_frame(lds_); const int gt = F.gw * 64 + F.lane, NTH = F.NGW * 64;
    const int* pos = (const int*)kin(2); float* rope = (float*)(kws() + WS_ROPE);
    for (int i = gt; i < T * 32; i += NTH) { float s, c; sincos_d((double)pos[i >> 5] * ROPE_INV_FREQ[i & 31], s, c); rope[2 * (size_t)i] = c; rope[2 * (size_t)i + 1] = s; }
}
__device__ __forceinline__ void p0_prologue(LAS unsigned char* lds_, const Args& A, int l) {
    const Frame F = make_frame(lds_);
    LAS float* scr = (LAS float*)(F.lds + RING_OFF + F.wave * 16384);
    constexpr int I1 = 16 * 14, I2 = 16 * 48, I3 = 16 * 56, I4 = 16 * 96, I5 = 8 * 32, I6 = 8 * 32, I7 = 16 * 32, I8 = 16 * 128, I9 = 64 * 32, I10 = 16 * 32, I11 = 4 * 32;
    constexpr int NITEMS = I1 + I2 + I3 + I4 + I5 + I6 + I7 + I8 + I9 + I10 + I11;
#define WIN_ (kin(4) + (size_t)l * 1024 * IN_COLS)
#define WBR_ (kin(21) + (size_t)l * 1536 * 1024)
    for (int it = F.gw; it < NITEMS; it += F.NGW) {
        int r = it;
        if (r < I1) { transpose_item(WIN_, IN_COLS, 0, 14, (bf16*)(kws() + W_IN), 1024, 0, scr, r, F.lane, kin(3) + l * 1024); continue; } r -= I1;
        if (r < I2) { transpose_item(WIN_, IN_COLS, 2240, 48, (bf16*)(kws() + W_IN), 1024, 512, scr, r, F.lane, kin(3) + l * 1024); continue; } r -= I2;
        if (r < I3) { transpose_item(WIN_, IN_COLS, 448, 56, (bf16*)(kws() + W_IN), 1024, 2048, scr, r, F.lane, kin(3) + l * 1024); continue; } r -= I3;
        if (r < I4) { transpose_item(WIN_, IN_COLS, 3776, 96, (bf16*)(kws() + W_IN), 1024, 3840, scr, r, F.lane, kin(3) + l * 1024); continue; } r -= I4;
        if (r < I5) { transpose_item(WBR_ + (size_t)512 * 1024, 1024, 0, 32, (bf16*)(kws() + W_B) + (size_t)1024 * 512, 512, 0, scr, r, F.lane); continue; } r -= I5;
        if (r < I6) { transpose_item(WBR_ + (size_t)1024 * 1024, 1024, 0, 32, (bf16*)(kws() + W_B) + (size_t)2 * 1024 * 512, 512, 0, scr, r, F.lane); continue; } r -= I6;
        if (r < I7) { transpose_item(kin(22) + (size_t)l * 1024 * 1024, 1024, 0, 32, (bf16*)(kws() + W_OUT), 1024, 0, scr, r, F.lane); continue; } r -= I7;
        if (r < I8) { transpose_item(kin(25) + (size_t)l * 1024 * 4096, 4096, 0, 128, (bf16*)(kws() + W_1), 1024, 0, scr, r, F.lane, kin(24) + l * 1024); continue; } r -= I8;
        if (r < I9) { transpose_item(kin(26) + (size_t)l * 4096 * 1024, 1024, 0, 32, (bf16*)(kws() + W_2), 4096, 0, scr, r, F.lane); continue; } r -= I9;
        if (r < I10) { transpose_item(kin(28) + (size_t)l * 1024 * 1024, 1024, 0, 32, (bf16*)(kws() + W_G), 1024, 0, scr, r, F.lane); continue; } r -= I10;
        transpose_item(kin(29) + (size_t)l * 256 * 1024, 1024, 0, 32, (bf16*)(kws() + W_P), 256, 0, scr, r, F.lane);
    }
    const int gt = F.gw * 64 + F.lane, NTH = F.NGW * 64;
    { bf16* WinT = (bf16*)(kws() + W_IN); for (int i = gt; i < 64 * 1024; i += NTH) WinT[(size_t)448 * 1024 + i] = 0; }
    { const float* w_uq = kin(7) + (size_t)l * 256 * 768; const float* w_ukv = kin(8) + (size_t)l * 128 * 1024; bf16* WqT = (bf16*)(kws() + W_Q);
      if ((F.gw & 3) != 0) for (int it = (F.gw >> 2) * 3 + (F.gw & 3) - 1; it < 768 * 4; it += (F.NGW >> 2) * 3) {
        const int n = it >> 2, kq = 64 * (it & 3) + F.lane, h = n / 192, ii = n % 192; float s;
        if (ii < 128) { const GAS f32x4* a = (const GAS f32x4*)(w_uq + (size_t)kq * 768 + h * 192); const GAS f32x4* b = (const GAS f32x4*)(w_ukv + (size_t)ii * 1024 + h * 256);
            f32x4 acc = {0.f, 0.f, 0.f, 0.f};
#pragma unroll 8
            for (int q = 0; q < 32; ++q) { const f32x4 av = a[q], bv = b[q]; acc[0] = fmaf(av[0], bv[0], acc[0]); acc[1] = fmaf(av[1], bv[1], acc[1]); acc[2] = fmaf(av[2], bv[2], acc[2]); acc[3] = fmaf(av[3], bv[3], acc[3]); }
            s = (acc[0] + acc[1]) + (acc[2] + acc[3]); }
        else { const int jj = ii - 128, j = jj >> 1; s = w_uq[(size_t)kq * 768 + h * 192 + 128 + ((jj & 1) ? j + 32 : j)]; }
        WqT[(size_t)n * 256 + kq] = (bf16)f2bf(s);
      } }
    { const float* w_ukv = kin(8) + (size_t)l * 128 * 1024; const float* w_br = WBR_; bf16* WbT = (bf16*)(kws() + W_B);
      if ((F.gw & 3) == 0) for (int it = F.gw >> 2; it < 512; it += (F.NGW >> 2)) {
        const int h = it >> 7, lat0 = 4 * ((it >> 2) & 31), dd4 = 256 * (it & 3) + 4 * F.lane;
        const float* ab = w_ukv + (size_t)lat0 * 1024 + h * 256 + 128; const float* bb = w_br + (size_t)(h * 128) * 1024 + dd4;
        f32x4 acc[4] = {{0.f, 0.f, 0.f, 0.f}, {0.f, 0.f, 0.f, 0.f}, {0.f, 0.f, 0.f, 0.f}, {0.f, 0.f, 0.f, 0.f}};
#pragma unroll 4
        for (int v4 = 0; v4 < 128; v4 += 4) { f32x4 bv[4], av[4];
#pragma unroll
            for (int e = 0; e < 4; ++e) { bv[e] = *(const GAS f32x4*)(bb + (size_t)(v4 + e) * 1024); av[e] = *(const GAS f32x4*)(ab + (size_t)e * 1024 + v4); }
#pragma unroll
            for (int j = 0; j < 4; ++j)
#pragma unroll
                for (int e = 0; e < 4; ++e) acc[j] = acc[j] + bv[e] * av[j][e]; }
#pragma unroll
        for (int e = 0; e < 4; ++e) { v2u o; o.x = pk2(acc[0][e], acc[1][e]); o.y = pk2(acc[2][e], acc[3][e]); *(GAS v2u*)(WbT + (size_t)(dd4 + e) * 512 + h * 128 + lat0) = o; }
      } }
    { const float* w_up = kin(11) + (size_t)l * 64 * 512; const float* a_up = kin(13) + (size_t)l * 64 * 512; const float* g_up = kin(14) + (size_t)l * 128 * 512; bf16* WloT = (bf16*)(kws() + W_LORA);
      for (int i = gt; i < 1536 * 256; i += NTH) {
        const int n = i >> 8, k = i & 255, blk = n >> 9, nn = n & 511; float s = 0.f;
        if (blk == 0) { if (k < 64) s = w_up[(size_t)k * 512 + nn]; } else if (blk == 1) { if (k >= 64 && k < 128) s = a_up[(size_t)(k - 64) * 512 + nn]; } else { if (k >= 128) s = g_up[(size_t)(k - 128) * 512 + nn]; }
        WloT[i] = (bf16)f2bf(s);
      } }
#undef WIN_
#undef WBR_
}
__device__ __forceinline__ void h_rowpass(LAS unsigned char* lds_, bf16* Hc, bool from_x) {
    const Frame F = make_frame(lds_); float* RS = (float*)(kws() + WS_RS1);
    for (int m = F.gw; m < T; m += F.NGW) {
        f32x4 v[4]; float s = 0.f;
        if (from_x) { const GAS f32x4* xr = (const GAS f32x4*)(kin(0) + (size_t)m * D) + F.lane; GAS v2u* ho = (GAS v2u*)(Hc + (size_t)m * D) + F.lane;
#pragma unroll
            for (int j = 0; j < 4; ++j) { v[j] = xr[64 * j]; v2u w; w.x = pk2(v[j].x, v[j].y); w.y = pk2(v[j].z, v[j].w); ho[64 * j] = w; v[j] = (f32x4){bfl(w.x), bfh(w.x), bfl(w.y), bfh(w.y)}; } }
        else { const GAS v2u* hr = (const GAS v2u*)(Hc + (size_t)m * D) + F.lane;
#pragma unroll
            for (int j = 0; j < 4; ++j) { const v2u w = hr[64 * j]; v[j] = (f32x4){bfl(w.x), bfh(w.x), bfl(w.y), bfh(w.y)}; } }
#pragma unroll
        for (int j = 0; j < 4; ++j) s += (v[j].x * v[j].x + v[j].y * v[j].y) + (v[j].z * v[j].z + v[j].w * v[j].w);
        const float rs = rsqrtf(wave_sum(s, F.lane) * (1.f / D) + NORM_EPS);
        if (F.lane == 0) RS[m] = rs;
    }
}
__device__ __forceinline__ void p2_mla_prep(LAS unsigned char* lds_, int l, int wg0, int nwg) {
    const Frame F = make_frame(lds_); const int gw = F.gw - wg0 * NWAVES, NGW = nwg * NWAVES;
    const bf16* ZM = (const bf16*)(kws() + WS_OA); bf16* QN = (bf16*)(kws() + X_QN); bf16* KV = (bf16*)(kws() + X_KV); const float* rope = (const float*)(kws() + WS_ROPE);
    const f32x4 gq = *(const f32x4*)(kin(5) + l * 256 + 4 * F.lane); const float gk0 = kin(6)[l * 128 + 2 * F.lane], gk1 = kin(6)[l * 128 + 2 * F.lane + 1];
    for (int g = gw; g < T / 4; g += NGW) {
        v2u wq[4]; unsigned wk[4]; unsigned short wr[4]; float rc[4], rsn[4];
#pragma unroll
        for (int i = 0; i < 4; ++i) { const int t = 4 * g + i; const bf16* z = ZM + (size_t)t * 512;
            wq[i] = *(const GAS v2u*)(z + 4 * F.lane); wk[i] = *(const GAS unsigned*)(z + 256 + 2 * F.lane); wr[i] = *(const GAS unsigned short*)(z + 384 + F.lane);
            rc[i] = *(const GAS float*)(rope + ((size_t)t * 32 + (F.lane & 31)) * 2); rsn[i] = *(const GAS float*)(rope + ((size_t)t * 32 + (F.lane & 31)) * 2 + 1); }
        asm volatile("" : "+v"(wq[0]), "+v"(wq[1]), "+v"(wq[2]), "+v"(wq[3]), "+v"(wk[0]), "+v"(wk[1]), "+v"(wk[2]), "+v"(wk[3]));
#pragma unroll
        for (int i = 0; i < 4; ++i) { const int t = 4 * g + i;
            const float kr = bfl((unsigned)wr[i]);
            const float q0 = bfl(wq[i].x), q1 = bfh(wq[i].x), q2 = bfl(wq[i].y), q3 = bfh(wq[i].y), k0 = bfl(wk[i]), k1 = bfh(wk[i]);
            const float rq = rsqrtf(wave_sum(q0 * q0 + q1 * q1 + q2 * q2 + q3 * q3, F.lane) * (1.f / 256.f) + NORM_EPS);
            const float rk = rsqrtf(wave_sum(k0 * k0 + k1 * k1, F.lane) * (1.f / 128.f) + NORM_EPS);
            v2u o; o.x = pk2(q0 * rq * gq.x, q1 * rq * gq.y); o.y = pk2(q2 * rq * gq.z, q3 * rq * gq.w);
            *(GAS v2u*)(QN + (size_t)t * 256 + 4 * F.lane) = o;
            *(GAS unsigned*)(KV + (size_t)t * 192 + 2 * F.lane) = pk2(k0 * rk * gk0, k1 * rk * gk1);
            const float other = shfl_xor_f(kr, 32, F.lane);
            if (F.lane < 32) *(GAS unsigned*)(KV + (size_t)t * 192 + 128 + 2 * F.lane) = pk2(kr * rc[i] - other * rsn[i], other * rc[i] + kr * rsn[i]); }
    }
}
__device__ __forceinline__ void p6_rw_prep(LAS unsigned char* lds_, int l) {
    const Frame F = make_frame(lds_);
    const bf16* ZR = (const bf16*)(kws() + X_ZR); bf16* LA = (bf16*)(kws() + X_LA);
    const f32x4 mu = *(const f32x4*)(kin(9) + l * RW_COLS + 1536 + 4 * F.lane);
    { bf16* BND = (bf16*)(kws() + X_BND);
      for (int s = F.gw; s < T / 16; s += F.NGW) { if (((16 * s) & (SEQ - 1)) == 0) continue;
#pragma unroll
        for (int j = 0; j < 3; ++j) *(GAS v4u*)(BND + (size_t)s * 1536 + 8 * (F.lane + 64 * j)) = *(const GAS v4u*)(ZR + (size_t)(16 * s - 1) * 1792 + 8 * (F.lane + 64 * j)); } }
    for (int g = F.gw; g < T / 4; g += F.NGW) {
        const int t0 = 4 * g; v2u w[5];
        w[0].x = 0u; w[0].y = 0u;
        if ((t0 & (SEQ - 1)) != 0) w[0] = *(const GAS v2u*)(ZR + (size_t)(t0 - 1) * 1792 + 1536 + 4 * F.lane);
#pragma unroll
        for (int i = 0; i < 4; ++i) w[i + 1] = *(const GAS v2u*)(ZR + (size_t)(t0 + i) * 1792 + 1536 + 4 * F.lane);
        asm volatile("" : "+v"(w[0]), "+v"(w[1]), "+v"(w[2]), "+v"(w[3]), "+v"(w[4]));
#pragma unroll
        for (int i = 0; i < 4; ++i) { const v2u wc = w[i + 1], wp = w[i];
            float z[4] = {bfl(wc.x), bfh(wc.x), bfl(wc.y), bfh(wc.y)}; const float p[4] = {bfl(wp.x), bfh(wp.x), bfl(wp.y), bfh(wp.y)}; const float m[4] = {mu.x, mu.y, mu.z, mu.w};
#pragma unroll
            for (int e = 0; e < 4; ++e) { float v = z[e] + (p[e] - z[e]) * m[e]; if (F.lane < 16) v = 1.f - 2.f * __builtin_amdgcn_rcpf(1.f + __builtin_amdgcn_exp2f(2.f * LOG2E * v)); else if (F.lane >= 32) v = fsig(v); z[e] = v; }
            v2u o; o.x = pk2(z[0], z[1]); o.y = pk2(z[2], z[3]); *(GAS v2u*)(LA + (size_t)(t0 + i) * 256 + 4 * F.lane) = o; }
    }
}
template <int MODE>
__device__ __forceinline__ void rowpass(LAS unsigned char* lds_, bf16* Hc, const bf16* M, const float* g1, const float* pl) {
    const Frame F = make_frame(lds_);
    bf16* PB = (bf16*)(kws() + X_PB); float* RS = (float*)(kws() + WS_RS2);
    f32x4 g1v[4];
#pragma unroll
    for (int j = 0; j < 4; ++j) g1v[j] = *(const f32x4*)(g1 + 4 * F.lane + 256 * j);
    for (int m = F.gw; m < T; m += F.NGW) {
        const GAS v2u* mr = (const GAS v2u*)(M + (size_t)m * D) + F.lane; GAS v2u* hr = (GAS v2u*)(Hc + (size_t)m * D) + F.lane;
        f32x4 x[4], hv[4]; float s = 0.f;
#pragma unroll
        for (int j = 0; j < 4; ++j) { const v2u w = mr[64 * j]; x[j] = (f32x4){bfl(w.x), bfh(w.x), bfl(w.y), bfh(w.y)}; const v2u hw = hr[64 * j]; hv[j] = (f32x4){bfl(hw.x), bfh(hw.x), bfl(hw.y), bfh(hw.y)};
            s += (x[j].x * x[j].x + x[j].y * x[j].y) + (x[j].z * x[j].z + x[j].w * x[j].w); }
        const float rs = rsqrtf(wave_sum(s, F.lane) * (1.f / D) + NORM_EPS); float s2 = 0.f;
#pragma unroll
        for (int j = 0; j < 4; ++j) { hv[j] = hv[j] + x[j] * rs * g1v[j]; v2u w; w.x = pk2(hv[j].x, hv[j].y); w.y = pk2(hv[j].z, hv[j].w); hr[64 * j] = w;
            const f32x4 hq = (f32x4){bfl(w.x), bfh(w.x), bfl(w.y), bfh(w.y)};
            s2 += (hq.x * hq.x + hq.y * hq.y) + (hq.z * hq.z + hq.w * hq.w); }
        if (MODE == 0) { const float rs2 = rsqrtf(wave_sum(s2, F.lane) * (1.f / D) + NORM_EPS); if (F.lane == 0) RS[m] = rs2; }
        else { const f32x4 pv = *((const GAS f32x4*)(pl + (size_t)m * DPLE) + F.lane); v2u w; w.x = pk2(pv.x, pv.y); w.y = pk2(pv.z, pv.w); *((GAS v2u*)(PB + (size_t)m * DPLE) + F.lane) = w; }
    }
}
namespace rw {
typedef short v4i16_t __attribute__((ext_vector_type(4)));
constexpr int RS = 144;
constexpr int O_AT = 0, O_BT = 9216, O_KT = 18432, O_RT = 27648;
constexpr int O_UV = 36864;
constexpr int O_BK = O_UV + 4 * 32 * RS;
constexpr int O_SB = O_BK + 4 * 32 * RS;
constexpr int O_W1 = O_SB + 64 * RS;
constexpr int O_SM = O_W1 + 64 * RS;
constexpr int O_GC = O_SM + 16 * 1024;
constexpr int O_CB = O_GC + 1024;
constexpr int O_LM = O_CB + 256;
constexpr int O_YO = O_LM + 4096;
constexpr int O_PAR = O_YO + 64 * RS;
constexpr int LDS_END = O_PAR + 512;
static_assert(LDS_END <= RING_BYTES, "rwkv LDS map");
__device__ __forceinline__ bf16x8 trfrag(const LAS unsigned char* p) {
    const s16x4 lo = __builtin_bit_cast(s16x4, __builtin_amdgcn_ds_read_tr16_b64_v4i16((LAS v4i16_t*)p));
    const s16x4 hh = __builtin_bit_cast(s16x4, __builtin_amdgcn_ds_read_tr16_b64_v4i16((LAS v4i16_t*)(p + 4 * RS)));
    return (bf16x8){lo[0], lo[1], lo[2], lo[3], hh[0], hh[1], hh[2], hh[3]};
}
__device__ __forceinline__ unsigned pk_rtz(float lo, float hi) { typedef __fp16 hp2 __attribute__((ext_vector_type(2))); const hp2 v = __builtin_amdgcn_cvt_pkrtz(lo, hi); return __builtin_bit_cast(unsigned, v); }
typedef _Float16 h16x4_t __attribute__((ext_vector_type(4)));
__device__ __forceinline__ h16x4_t tr4(const LAS unsigned char* p) { return __builtin_bit_cast(h16x4_t, __builtin_amdgcn_ds_read_tr16_b64_v4i16((LAS v4i16_t*)p)); }
__device__ __forceinline__ h16x4_t ld4h(const LAS unsigned char* p) { return *(const LAS h16x4_t*)p; }
__device__ __forceinline__ h16x4_t acc2h(const f32x4 v) { typedef unsigned u2 __attribute__((ext_vector_type(2))); u2 w; w.x = pk_rtz(v[0], v[1]); w.y = pk_rtz(v[2], v[3]); return __builtin_bit_cast(h16x4_t, w); }
__device__ __forceinline__ f32x4 MFMA4(h16x4_t a, h16x4_t b, f32x4 c) { return __builtin_amdgcn_mfma_f32_16x16x16f16(a, b, c, 0, 0, 0); }
__device__ __forceinline__ void lbar() { asm volatile("s_waitcnt lgkmcnt(0)\n\ts_barrier" ::: "memory"); }
__device__ __forceinline__ void st_bf(LAS unsigned char* p, float x) { *(LAS unsigned short*)p = (unsigned short)h_f2h(__builtin_amdgcn_fmed3f(x, -60000.f, 60000.f)); }
__device__ __forceinline__ void st2(LAS unsigned char* p0, LAS unsigned char* p1, float x0, float x1) { const unsigned w = pk_rtz(x0, x1); *(LAS unsigned short*)p0 = (unsigned short)w; *(LAS unsigned short*)p1 = (unsigned short)(w >> 16); }
__device__ __forceinline__ void st4(LAS unsigned char* p, int stride, const f32x4 v) { st2(p, p + stride, v[0], v[1]); st2(p + 2 * stride, p + 3 * stride, v[2], v[3]); }
__device__ __forceinline__ float ld_bf(const LAS unsigned char* p) { return bfl((unsigned)*(const LAS unsigned short*)p); }
template <int CTRL> __device__ __forceinline__ float dpp_add(float v) { return v + __int_as_float(__builtin_amdgcn_update_dpp(0, __float_as_int(v), CTRL, 0xf, 0xf, true)); }
__device__ __forceinline__ void wsum8(float (&v)[8], int lane) {
#pragma unroll
    for (int e = 0; e < 8; ++e) { float x = v[e]; x = dpp_add<0xB1>(x); x = dpp_add<0x4E>(x); x = dpp_add<0x141>(x); x = dpp_add<0x140>(x); v[e] = x; }
#pragma unroll
    for (int e = 0; e < 8; ++e) v[e] += shfl_xor_f(v[e], 16, lane);
#pragma unroll
    for (int e = 0; e < 8; ++e) v[e] += shfl_xor_f(v[e], 32, lane);
}
__device__ __forceinline__ void wsum16(float (&a)[8], float (&b)[8], int lane) {
#pragma unroll
    for (int e = 0; e < 8; ++e) { float x = a[e]; x = dpp_add<0xB1>(x); x = dpp_add<0x4E>(x); x = dpp_add<0x141>(x); x = dpp_add<0x140>(x); a[e] = x;
                                  float y = b[e]; y = dpp_add<0xB1>(y); y = dpp_add<0x4E>(y); y = dpp_add<0x141>(y); y = dpp_add<0x140>(y); b[e] = y; }
    float ta[8], tb[8];
#pragma unroll
    for (int e = 0; e < 8; ++e) { ta[e] = shfl_xor_f(a[e], 16, lane); tb[e] = shfl_xor_f(b[e], 16, lane); }
#pragma unroll
    for (int e = 0; e < 8; ++e) { a[e] += ta[e]; b[e] += tb[e]; }
#pragma unroll
    for (int e = 0; e < 8; ++e) { ta[e] = shfl_xor_f(a[e], 32, lane); tb[e] = shfl_xor_f(b[e], 32, lane); }
#pragma unroll
    for (int e = 0; e < 8; ++e) { a[e] += ta[e]; b[e] += tb[e]; }
}
__device__ __forceinline__ void rw_prepass(LAS unsigned char* lds, int l) {
    int tid_ = my_tid(); asm volatile("" : "+v"(tid_));
    const int tid = tid_, lane = tid & 63, w = __builtin_amdgcn_readfirstlane(tid >> 6);
    int bx_ = blockIdx.x; asm volatile("" : "+s"(bx_)); int G_ = gridDim.x; asm volatile("" : "+s"(G_));
    const int gw = bx_ * NWAVES + w, NGW = G_ * NWAVES;
    bf16* ZR = (bf16*)(kws() + X_ZR); bf16* TWp = (bf16*)(kws() + X_TW); bf16* TAp = (bf16*)((unsigned char*)kout() + DO_TA);
    bf16* GCT = (bf16*)(kws() + X_GCT); float* CBG = (float*)(kws() + X_CBG); const bf16* BND = (const bf16*)(kws() + X_BND);
    LAS unsigned char* stg = lds + w * 16384; const LAS unsigned short* sr = (const LAS unsigned short*)(stg + 2 * lane); LAS unsigned short* sw = (LAS unsigned short*)(stg + 2 * lane);
    const int lr = lane >> 3, lc = lane & 7;
    constexpr int NIT = (T / 16) * 8;
    v4u q[4][2]; unsigned b0, b1;
#define RWP_PTRS(IT) const int s_ = (IT) >> 3, h_ = (IT) & 7; const size_t row0_ = (size_t)16 * s_; \
        bf16* gp0 = TWp + row0_ * 512 + 64 * h_; bf16* gp1 = ZR + row0_ * 1792 + 64 * h_; bf16* gp4 = TAp + row0_ * 512 + 64 * h_;
#define RWP_LOAD(IT) do { RWP_PTRS(IT); \
        q[0][0] = *(const GAS v4u*)(gp0 + (size_t)lr * 512 + 8 * lc); q[0][1] = *(const GAS v4u*)(gp0 + (size_t)(lr + 8) * 512 + 8 * lc); \
        _Pragma("unroll") for (int m = 0; m < 2; ++m) { q[1 + m][0] = *(const GAS v4u*)(gp1 + (size_t)lr * 1792 + 512 * m + 8 * lc); q[1 + m][1] = *(const GAS v4u*)(gp1 + (size_t)(lr + 8) * 1792 + 512 * m + 8 * lc); } \
        q[3][0] = *(const GAS v4u*)(gp4 + (size_t)lr * 512 + 8 * lc); q[3][1] = *(const GAS v4u*)(gp4 + (size_t)(lr + 8) * 512 + 8 * lc); \
        { const bf16* zb_ = BND + (size_t)s_ * 1536 + 64 * h_ + lane; b0 = (unsigned)*(const GAS bf16*)zb_; b1 = (unsigned)*(const GAS bf16*)(zb_ + 512); } } while (0)
    if (gw < NIT) RWP_LOAD(gw);
#pragma unroll 1
    for (int it = gw; it < NIT; it += NGW) {
        const int s = it >> 3, h = it & 7, row0 = 16 * s, pc = h * 64 + lane;
        const float mu_r = kin(9)[l * RW_COLS + pc], mu_k = kin(9)[l * RW_COLS + 512 + pc];
        const float k_k = kin(15)[l * 512 + pc], k_a = kin(16)[l * 512 + pc], r_k = kin(17)[l * 512 + pc];
#pragma unroll
        for (int m = 0; m < 4; ++m) { *(LAS v4u*)(stg + m * 2048 + lr * 128 + 16 * lc) = q[m][0]; *(LAS v4u*)(stg + m * 2048 + (lr + 8) * 128 + 16 * lc) = q[m][1]; }
        float pr = bfl(b0), pk = bfl(b1);
        if ((row0 & (SEQ - 1)) == 0) { pr = 0.f; pk = 0.f; }
        asm volatile("" ::: "memory");
        if (it + NGW < NIT) RWP_LOAD(it + NGW);
        float cum[16];
        { float run = 0.f;
#pragma unroll
          for (int t = 0; t < 16; ++t) { run += bfl((unsigned)sr[64 * t]); cum[t] = run; } }
        const float gctot = __builtin_amdgcn_exp2f(LOG2E * cum[15]);
        *(GAS bf16*)(GCT + (size_t)s * 512 + pc) = (bf16)h_f2h(gctot);
#pragma unroll
        for (int hf = 0; hf < 2; ++hf) {
            float cr[8], ck[8], ta[8];
#pragma unroll
            for (int tt = 0; tt < 8; ++tt) { const int t = 8 * hf + tt; cr[tt] = bfl((unsigned)sr[1024 + 64 * t]); ck[tt] = bfl((unsigned)sr[2048 + 64 * t]); ta[tt] = bfl((unsigned)sr[3072 + 64 * t]); }
            float rr[8], kkv[8], av[8], kmv[8], ss[8], cbv[8];
#pragma unroll
            for (int tt = 0; tt < 8; ++tt) {
                const float r = cr[tt] + (pr - cr[tt]) * mu_r, k = ck[tt] + (pk - ck[tt]) * mu_k; pr = cr[tt]; pk = ck[tt];
                const float a = ta[tt], kk = k * k_k, km = k * (1.f + (a - 1.f) * k_a);
                rr[tt] = r; kkv[tt] = kk; av[tt] = a; kmv[tt] = km; ss[tt] = kk * kk; cbv[tt] = r * km * r_k; }
            wsum16(ss, cbv, lane);
#pragma unroll
            for (int tt = 0; tt < 8; ++tt) { const int t = 8 * hf + tt;
                const float cu = cum[t], cprev = t ? cum[t - 1] : 0.f;
                const float gg = __builtin_amdgcn_exp2f(LOG2E * cu), gp_ = __builtin_amdgcn_exp2f(LOG2E * cprev), gi = __builtin_amdgcn_exp2f(-LOG2E * cu);
                const float kn = kkv[tt] * rsqrtf(fmaxf(ss[tt], 1e-24f)), ka = kn * av[tt];
                const unsigned w01 = pk_rtz(-kn * gp_, rr[tt] * gg), w23 = pk_rtz(__builtin_amdgcn_fmed3f(kmv[tt] * gi, -60000.f, 60000.f), __builtin_amdgcn_fmed3f(ka * gi, -60000.f, 60000.f));
                sw[64 * t] = (unsigned short)w01; sw[1024 + 64 * t] = (unsigned short)(w01 >> 16); sw[2048 + 64 * t] = (unsigned short)w23; sw[3072 + 64 * t] = (unsigned short)(w23 >> 16);
                if (lane == tt) *(GAS float*)(CBG + (size_t)(row0 + t) * 8 + h) = cbv[tt]; }
        }
        asm volatile("" ::: "memory");
        {   RWP_PTRS(it);
            v4u o[4][2];
#pragma unroll
            for (int m = 0; m < 4; ++m) { o[m][0] = *(const LAS v4u*)(stg + m * 2048 + lr * 128 + 16 * lc); o[m][1] = *(const LAS v4u*)(stg + m * 2048 + (lr + 8) * 128 + 16 * lc); }
            *(GAS v4u*)(gp0 + (size_t)lr * 512 + 8 * lc) = o[0][0]; *(GAS v4u*)(gp0 + (size_t)(lr + 8) * 512 + 8 * lc) = o[0][1];
#pragma unroll
            for (int m = 0; m < 2; ++m) { *(GAS v4u*)(gp1 + (size_t)lr * 1792 + 512 * m + 8 * lc) = o[1 + m][0]; *(GAS v4u*)(gp1 + (size_t)(lr + 8) * 1792 + 512 * m + 8 * lc) = o[1 + m][1]; }
            *(GAS v4u*)(gp4 + (size_t)lr * 512 + 8 * lc) = o[3][0]; *(GAS v4u*)(gp4 + (size_t)(lr + 8) * 512 + 8 * lc) = o[3][1]; }
        asm volatile("" ::: "memory");
    }
#undef RWP_LOAD
#undef RWP_PTRS
}
__device__ __forceinline__ void rw_unit(LAS unsigned char* lds, int l, int seq) {
    int tid_ = my_tid(); asm volatile("" : "+v"(tid_));
    const int tid = tid_, lane = tid & 63, w = __builtin_amdgcn_readfirstlane(tid >> 6), g4 = lane >> 4, l15 = lane & 15, q4 = l15 >> 2, p4 = lane & 3;
    const int b = seq >> 3, h = seq & 7;
    const bf16* ZRb = (const bf16*)(kws() + X_ZR) + (size_t)b * SEQ * 1792 + h * 64;
    const bf16* TWb = (const bf16*)(kws() + X_TW) + (size_t)b * SEQ * 512 + h * 64; const bf16* TAb = (const bf16*)((const unsigned char*)kout() + DO_TA) + (size_t)b * SEQ * 512 + h * 64; const bf16* Gb = (const bf16*)((const unsigned char*)kout() + DO_G) + (size_t)b * SEQ * 512 + h * 64;
    const bf16* GCTb = (const bf16*)(kws() + X_GCT) + (size_t)b * (SEQ / 16) * 512 + h * 64; const float* CBGb = (const float*)(kws() + X_CBG) + (size_t)b * SEQ * 8 + h;
    bf16* ORWb = (bf16*)(kws() + WS_ORW) + (size_t)b * SEQ * 512 + h * 64;
    LAS float* par = (LAS float*)(lds + O_PAR);
    const int pc = h * 64 + lane;
    if (tid < 64) { par[tid] = kin(18)[l * 512 + pc]; par[64 + tid] = kin(19)[l * 512 + pc]; }
    for (int i = tid; i < (O_GC - O_UV) / 4; i += 512) ((LAS unsigned*)(lds + O_UV))[i] = 0u;
    f32x4 ST[4] = {{0.f, 0.f, 0.f, 0.f}, {0.f, 0.f, 0.f, 0.f}, {0.f, 0.f, 0.f, 0.f}, {0.f, 0.f, 0.f, 0.f}};
    __syncthreads();
    const int et = tid >> 3, ecg = tid & 7, ei = et >> 4, ett = et & 15;
    const int trrow = 8 * g4 + q4, trrow1 = 8 * (g4 & 1) + q4, trcol = 8 * p4;
    (void)trrow;
    v4u qat, qbt, qkt, qrt, qv, qvp, pgg; unsigned pgc; float pcb;
    float muv[8];
#pragma unroll
    for (int e = 0; e < 8; ++e) muv[e] = kin(9)[l * RW_COLS + 1024 + h * 64 + 8 * ecg + e];
#define RW_LOADS(TOK0) do { const size_t row_ = (size_t)(TOK0) + et; \
        qat = *(const GAS v4u*)(TWb + row_ * 512 + 8 * ecg); qbt = *(const GAS v4u*)(TAb + row_ * 512 + 8 * ecg); \
        { const bf16* zc_ = ZRb + row_ * 1792 + 8 * ecg; qrt = *(const GAS v4u*)zc_; qkt = *(const GAS v4u*)(zc_ + 512); qv = *(const GAS v4u*)(zc_ + 1024); \
          qvp = *(const GAS v4u*)(zc_ + 1024 - (row_ > 0 ? 1792 : 0)); if (row_ == 0) qvp = (v4u){0u, 0u, 0u, 0u}; } \
        pgg = *(const GAS v4u*)(Gb + row_ * 512 + 8 * ecg); \
        pgc = (unsigned)*(const GAS bf16*)(GCTb + (size_t)((TOK0) / 16 + (tid >> 6 & 3)) * 512 + lane); pcb = *(const GAS float*)(CBGb + (size_t)((TOK0) + (tid & 63)) * 8); } while (0)
    RW_LOADS(0);
    for (int sc = 0; sc < SEQ / 64; ++sc) {
        const int tok0 = sc * 64;
        v4u ugg;
        {   asm volatile("" : "+v"(qat), "+v"(qbt), "+v"(qkt), "+v"(qrt), "+v"(qv), "+v"(qvp));
            { float vc[8], vp[8]; pg8::unpack8(qv, vc); pg8::unpack8(qvp, vp);
#pragma unroll
              for (int e = 0; e < 8; ++e) vc[e] = vc[e] + (vp[e] - vc[e]) * muv[e];
              qv.x = pk2(vc[0], vc[1]); qv.y = pk2(vc[2], vc[3]); qv.z = pk2(vc[4], vc[5]); qv.w = pk2(vc[6], vc[7]); }
            *(LAS v4u*)(lds + O_AT + et * RS + 16 * ecg) = qat; *(LAS v4u*)(lds + O_BT + et * RS + 16 * ecg) = qbt; *(LAS v4u*)(lds + O_KT + et * RS + 16 * ecg) = qkt; *(LAS v4u*)(lds + O_RT + et * RS + 16 * ecg) = qrt;
            *(LAS v4u*)(lds + O_UV + (ei * 32 + 16 + ett) * RS + 16 * ecg) = qv;
            if (tid < 256) ((LAS float*)(lds + O_GC))[tid] = bfl(pgc);
            if (tid < 64) ((LAS float*)(lds + O_CB))[tid] = pcb;
            ugg = pgg;
        }
        { const int nxt = (sc + 1 < SEQ / 64) ? tok0 + 64 : tok0; RW_LOADS(nxt); }
        lbar();
        {   const int i = w & 3, hf = w >> 2;
            const LAS unsigned char* xa = lds + (hf ? O_RT : O_AT) + (16 * i + l15) * RS + 16 * g4;
            const LAS unsigned char* xb = lds + O_BT + (16 * i + l15) * RS + 16 * g4; const LAS unsigned char* xk = lds + O_KT + (16 * i + l15) * RS + 16 * g4;
            f32x4 c1 = {0.f, 0.f, 0.f, 0.f}, c2 = {0.f, 0.f, 0.f, 0.f};
#pragma unroll
            for (int ks = 0; ks < 2; ++ks) { const bf16x8 a = *(const LAS bf16x8*)(xa + 64 * ks);
                c1 = MFMA16(a, *(const LAS bf16x8*)(xb + 64 * ks), c1);
                c2 = MFMA16(a, *(const LAS bf16x8*)(xk + 64 * ks), c2); }
#pragma unroll
            for (int r = 0; r < 4; ++r) { const int t = 4 * g4 + r; const bool keep = hf ? (l15 <= t) : (l15 < t); const float v1 = keep ? c1[r] : 0.f, v2 = keep ? c2[r] : 0.f;
                if (hf == 0) { ((LAS float*)(lds + O_LM))[(i * 16 + t) * 16 + l15] = v1; *(LAS unsigned short*)(lds + O_SM + (4 + i) * 1024 + t * 64 + 2 * l15) = (unsigned short)h_f2h(v2); }
                else st2(lds + O_SM + (8 + i) * 1024 + t * 64 + 2 * l15, lds + O_SM + (12 + i) * 1024 + t * 64 + 2 * l15, v1, v2); }
        }
        lbar();
        if (w < 4) { if (lane < 16) { const LAS float* Lm = (const LAS float*)(lds + O_LM) + w * 256; float acc[16];
#pragma unroll
                for (int t = 0; t < 16; ++t) acc[t] = (t == lane) ? 1.f : 0.f;
#pragma unroll
                for (int s = 0; s < 15; ++s) { const float xs = acc[s];
#pragma unroll
                    for (int t = s + 1; t < 16; ++t) acc[t] = fmaf(Lm[t * 16 + s], xs, acc[t]); }
#pragma unroll
                for (int t = 0; t < 16; t += 2) st2(lds + O_SM + w * 1024 + t * 64 + 2 * lane, lds + O_SM + w * 1024 + (t + 1) * 64 + 2 * lane, acc[t], acc[t + 1]); } }
        else { const int i = w - 4; const bf16x8 am = *(const LAS bf16x8*)(lds + O_SM + (4 + i) * 1024 + l15 * 64 + 16 * g4);
#pragma unroll
            for (int ct = 0; ct < 4; ++ct) { f32x4 acc = {0.f, 0.f, 0.f, 0.f};
                acc = MFMA16(am, trfrag(lds + O_UV + (i * 32 + 16 + trrow1) * RS + 32 * ct + trcol), acc);
st4(lds + O_W1 + (16 * i + 4 * g4) * RS + 2 * (16 * ct + l15), RS, acc); } }
        lbar();
        f32x4 wy[4];
        {   const int ct = w & 3; const int base = (w < 4) ? O_W1 : O_AT;
            bf16x8 tm[4], fb[4];
#pragma unroll
            for (int i = 0; i < 4; ++i) { tm[i] = *(const LAS bf16x8*)(lds + O_SM + i * 1024 + l15 * 64 + 16 * g4); fb[i] = trfrag(lds + base + (16 * i + trrow1) * RS + 32 * ct + trcol); }
#pragma unroll
            for (int i = 0; i < 4; ++i) { f32x4 acc = {0.f, 0.f, 0.f, 0.f}; wy[i] = MFMA16(tm[i], fb[i], acc); }
#pragma unroll
            for (int i = 0; i < 4; ++i) st4(lds + base + (16 * i + 4 * g4) * RS + 2 * (16 * ct + l15), RS, wy[i]); }
        lbar();
        {   const int ct = w & 3;
#pragma unroll
            for (int ih = 0; ih < 4; ih += 2) {
                bf16x8 arb[2], f1[2], ark[2], f2[2]; f32x4 cacc[2];
#pragma unroll
                for (int ii = 0; ii < 2; ++ii) { const int i = ih + ii; arb[ii] = *(const LAS bf16x8*)(lds + O_SM + (8 + i) * 1024 + l15 * 64 + 16 * g4);
                    if (w >= 4) { ark[ii] = *(const LAS bf16x8*)(lds + O_SM + (12 + i) * 1024 + l15 * 64 + 16 * g4);
                        f1[ii] = trfrag(lds + O_W1 + (16 * i + trrow1) * RS + 32 * ct + trcol); f2[ii] = trfrag(lds + O_UV + (i * 32 + 16 + trrow1) * RS + 32 * ct + trcol); cacc[ii] = (f32x4){0.f, 0.f, 0.f, 0.f}; }
                    else { f1[ii] = trfrag(lds + O_AT + (16 * i + trrow1) * RS + 32 * ct + trcol);
#pragma unroll
                        for (int r = 0; r < 4; ++r) cacc[ii][r] = ld_bf(lds + O_RT + (16 * i + 4 * g4 + r) * RS + 2 * (16 * ct + l15)); } }
#pragma unroll
                for (int ii = 0; ii < 2; ++ii) { cacc[ii] = MFMA16(arb[ii], f1[ii], cacc[ii]); if (w >= 4) cacc[ii] = MFMA16(ark[ii], f2[ii], cacc[ii]); }
#pragma unroll
                for (int ii = 0; ii < 2; ++ii) st4(lds + ((w >= 4) ? O_YO : O_RT) + (16 * (ih + ii) + 4 * g4) * RS + 2 * (16 * ct + l15), RS, cacc[ii]);
            } }
        lbar();
        if (w < 4) {
            const int v0 = 16 * w;
#pragma unroll
            for (int i = 0; i < 4; ++i) {
                h16x4_t sb[4];
#pragma unroll
                for (int kt = 0; kt < 4; ++kt) sb[kt] = acc2h(ST[kt]);
                f32x4 u = wy[i], y;
#pragma unroll
                for (int r = 0; r < 4; ++r) y[r] = ld_bf(lds + O_YO + (16 * i + 4 * g4 + r) * RS + 2 * (v0 + l15));
                const LAS unsigned char* pa = lds + O_AT + (16 * i + l15) * RS + 8 * g4; const LAS unsigned char* pq = lds + O_RT + (16 * i + l15) * RS + 8 * g4;
#pragma unroll
                for (int kt = 0; kt < 4; ++kt) { u = MFMA4(ld4h(pa + 32 * kt), sb[kt], u); y = MFMA4(ld4h(pq + 32 * kt), sb[kt], y); }
                st4(lds + O_YO + (16 * i + 4 * g4) * RS + 2 * (v0 + l15), RS, y);
                const h16x4_t ub = acc2h(u), vb = tr4(lds + O_UV + (i * 32 + 16 + 4 * g4 + q4) * RS + 2 * v0 + trcol);
#pragma unroll
                for (int kt = 0; kt < 4; ++kt) { const f32x4 gc = *(const LAS f32x4*)(lds + O_GC + (i * 64 + 16 * kt + 4 * g4) * 4);
                    f32x4 acc = ST[kt];
                    acc = MFMA4(tr4(lds + O_BT + (16 * i + 4 * g4 + q4) * RS + 32 * kt + trcol), ub, acc);
                    acc = MFMA4(tr4(lds + O_KT + (16 * i + 4 * g4 + q4) * RS + 32 * kt + trcol), vb, acc);
                    ST[kt] = acc * gc; }
            }
        }
        lbar();
        {   float y[8], vv[8], gg[8];
            pg8::unpack8(*(const LAS v4u*)(lds + O_YO + et * RS + 16 * ecg), y); pg8::unpack8(*(const LAS v4u*)(lds + O_UV + (ei * 32 + 16 + ett) * RS + 16 * ecg), vv);
            pg8::unpack8(ugg, gg);
            float s = 0.f;
#pragma unroll
            for (int e = 0; e < 8; ++e) s += y[e];
            s = dpp_add<0xB1>(s); s = dpp_add<0x4E>(s); s = dpp_add<0x141>(s);
            const float mean = s * (1.f / 64.f); float q = 0.f;
#pragma unroll
            for (int e = 0; e < 8; ++e) { y[e] -= mean; q += y[e] * y[e]; }
            q = dpp_add<0xB1>(q); q = dpp_add<0x4E>(q); q = dpp_add<0x141>(q);
            const float rstd = rsqrtf(q * (1.f / 64.f) + RW_LN_EPS), cb = ((const LAS float*)(lds + O_CB))[et];
            float o[8];
#pragma unroll
            for (int e = 0; e < 8; ++e) { const int c = 8 * ecg + e; o[e] = (y[e] * rstd * par[c] + par[64 + c] + cb * vv[e]) * gg[e]; }
            v4u wo; wo.x = pk2(o[0], o[1]); wo.y = pk2(o[2], o[3]); wo.z = pk2(o[4], o[5]); wo.w = pk2(o[6], o[7]);
            *(v4u*)(ORWb + (size_t)(tok0 + et) * 512 + 8 * ecg) = wo;
        }
        lbar();
    }
}
}
#ifndef PROBE_QREP
#define PROBE_QREP 1
#endif
#ifndef PROBE_MASK
#define PROBE_MASK 0
#endif
#if defined(TS_A)
#define TSTAMP(id) do { if (blockIdx.x == TS_BLK && my_tid() == 0) { LAS unsigned* sl_ = (LAS unsigned*)(L + LDSCTL_OFF + 320 + 1024); const unsigned now_ = (unsigned)__builtin_amdgcn_s_memrealtime(); if ((id) == TS_A) sl_[0] = now_; if ((id) == TS_B) sl_[1] += now_ - sl_[0]; } } while (0)
#else
#define TSTAMP(id) do { } while (0)
#endif
__global__ void __launch_bounds__(NWAVES * 64, 2) mk_fwd(Args args) {
    extern __shared__ __attribute__((aligned(16))) unsigned char lds[];
    LAS unsigned char* const L = (LAS unsigned char*)lds;
    for (int u = threadIdx.x; u < (LDS_BYTES - LDSCTL_OFF) / 4; u += NWAVES * 64) ((LAS unsigned*)(L + LDSCTL_OFF))[u] = 0u;
    __syncthreads();
    static_assert(LDSCTL_OFF == MK_WAVETAB_LDS, "wave table address");
    if ((threadIdx.x & 63) == 0) ((LAS unsigned*)(L + LDSCTL_OFF))[(unsigned)__builtin_amdgcn_s_getreg((5 << 11) | 4) & 63u] = threadIdx.x >> 6;
    __syncthreads();
    XcdBarrier bar = xcd_barrier_post((unsigned*)(kws() + WS_CTL) + CW_BAR, (volatile LAS unsigned*)(L + MISC_OFF) + 8);
#define GRID_BAR() xcd_barrier(bar)
#if defined(DBG_BISECT)
#define IN(k) (l > 0 || ((k) >= kstart() && (k) <= kstop()) || ((k) == 9 && kstop() == 99))
#define LAYER_END() do { if (kstop() < 100) return; } while (0)
#else
#define IN(k) true
#define LAYER_END() do { } while (0)
#endif
#define PTRS() unsigned char* ws = opq(kws()); \
    bf16* U = (bf16*)(ws + WS_U); bf16* OA = (bf16*)(ws + WS_OA); bf16* OC = (bf16*)(ws + WS_OC); bf16* ORW = (bf16*)(ws + WS_ORW); \
    bf16* WinT = (bf16*)(ws + W_IN); bf16* WqT = (bf16*)(ws + W_Q); bf16* WloT = (bf16*)(ws + W_LORA); bf16* WbT = (bf16*)(ws + W_B); bf16* WoT = (bf16*)(ws + W_OUT); \
    bf16* W1T = (bf16*)(ws + W_1); bf16* W2T = (bf16*)(ws + W_2); bf16* WgT = (bf16*)(ws + W_G); bf16* WpT = (bf16*)(ws + W_P); \
    bf16* ZC = (bf16*)(ws + X_ZC); bf16* QN = (bf16*)(ws + X_QN); bf16* QP = (bf16*)(ws + X_QP); bf16* KV = (bf16*)(ws + X_KV); \
    bf16* ZR = (bf16*)(ws + X_ZR); bf16* LA = (bf16*)(ws + X_LA); bf16* TW = (bf16*)(ws + X_TW); bf16* TA = (bf16*)((unsigned char*)kout() + DO_TA); bf16* GG = (bf16*)((unsigned char*)kout() + DO_G); bf16* H16 = (bf16*)((unsigned char*)kout() + DO_H16); \
    bf16* GT = (bf16*)(ws + X_GT); bf16* MG = (bf16*)(ws + X_MG); bf16* HID = (bf16*)(ws + X_HID); bf16* PB = (bf16*)(ws + X_PB); bf16* PP = (bf16*)(ws + X_PP); bf16* M2 = OA; \
    bf16* Hc = (l & 1) ? U : H16; bf16* Hn = (l & 1) ? H16 : U; const float* RS1 = (const float*)(ws + WS_RS1); const float* RS2 = (const float*)(ws + WS_RS2); (void)Hc; (void)Hn; (void)RS1; (void)RS2; \
    (void)U; (void)OA; (void)OC; (void)ORW; (void)WinT; (void)WqT; (void)WloT; (void)WbT; (void)WoT; (void)W1T; (void)W2T; (void)WgT; (void)WpT; (void)ZC; (void)QN; (void)QP; (void)KV; (void)ZR; (void)LA; (void)TW; (void)TA; (void)GG; (void)H16; (void)GT; (void)MG; (void)HID; (void)PB; (void)PP; (void)M2;
    typedef pg8::StaticOrder SO;
#define GEMM(EPI, Aptr, Bptr, N_, K_, Eobj) do { int bx_ = blockIdx.x; asm volatile("" : "+s"(bx_)); int G_ = gridDim.x; asm volatile("" : "+s"(G_)); pg8::Gemm g_{Aptr, Bptr, T, N_, K_}; SO S_; S_.init(T, N_, G_, bx_); pg8::gemm_phase<EPI, SO, true, true>(L + RING_OFF, g_, S_, Eobj); } while (0)
#define PH(n) for (int rep_ = 0; rep_ < (((PROBE_MASK >> (n)) & 1) ? 2 : 1); ++rep_) if (IN(n))
    typedef pg8::EpiRoute<0> ER0;
    rope_table(L);
    for (int l = 0; l < DEPTH; ++l) {
        PH(0) { PTRS(); p0_prologue(L, args, l); h_rowpass(L, Hc, l == 0); GRID_BAR(); }
        PH(1) { PTRS(); ER0 E{OA, 512, 2, ZC, 1536, 6, 2, CA_QSCALE, ZR, 1792, RS1}; GEMM(ER0, Hc, WinT, 3840, 1024, E); GRID_BAR(); }
        PH(2) { p6_rw_prep(L, l); GRID_BAR(); }
        PH(3) { PTRS(); pg8::EpiLora E2{TW, TA, GG, kin(10) + l * 512, kin(12) + l * 512}; GEMM(pg8::EpiLora, LA, WloT, 1536, 256, E2); GRID_BAR(); }
        if (IN(3)) { TSTAMP(7); rw::rw_prepass(L + RING_OFF, l); GRID_BAR(); TSTAMP(8); }
        if (IN(4)) { PTRS();
            unsigned* sb = (unsigned*)(ws + WS_CTL) + CW_SUB + 64 * l; unsigned* barw = (unsigned*)(ws + WS_CTL) + CW_BAR;
            int bx4_ = blockIdx.x; asm volatile("" : "+s"(bx4_)); int G4_ = gridDim.x; asm volatile("" : "+s"(G4_));
            TSTAMP(0);
            const int NRW = (G4_ > 64) ? 64 : 0, NOTH = G4_ - NRW;
            if (bx4_ < 64) rw::rw_unit(L + RING_OFF, l, bx4_);
            if (G4_ <= 64) for (int u_ = bx4_ + 64; u_ < 64; u_ += G4_) rw::rw_unit(L + RING_OFF, l, u_);
            if (bx4_ >= NRW) {
                p2_mla_prep(L, l, NRW, NOTH);
                TSTAMP(5); sub_barrier(barw, sb, (unsigned)NOTH, true); TSTAMP(6);
                { pg8::EpiQRope E{QP, (const float*)(ws + WS_ROPE), MLA_QSCALE}; pg8::Gemm g_{QN, WqT, T, 768, 256}; SO S_; S_.init(T, 768, NOTH, bx4_ - NRW); pg8::gemm_phase<pg8::EpiQRope, SO, true, true>(L + RING_OFF, g_, S_, E); }
                sub_barrier(barw, sb + 16, (unsigned)NOTH, true);
            } else { TSTAMP(4); sub_barrier(barw, sb + 16, (unsigned)NOTH, false); }
            TSTAMP(1);
            volatile LAS unsigned* qs = (volatile LAS unsigned*)(L + MISC_OFF) + 12;
            unsigned* qhead = (unsigned*)(ws + WS_CTL) + CW_QUEUE + 64 * l;
            for (;;) {
                __syncthreads();
                if (my_tid() == 0) *qs = atomicAdd(qhead, 1u);
                __syncthreads();
                const unsigned u = *qs;
                if (u >= 1536u) break;
                if (u < 512u) att::mla_unit(L + RING_OFF, QP, KV, OA, (int)u & 7, 63 - ((int)u >> 3));
                else { const int bi = (int)u - 512; att::band_unit(L + RING_OFF, ZC, kin(20) + (size_t)l * 320 * 8, OC, bi >> 7, (bi >> 4) & 7, bi & 15); }
            }
            TSTAMP(2); GRID_BAR(); TSTAMP(3); }
        PH(9) { PTRS(); ER0 E{GT, 3072, 12, GT, 3072, 0, 0, 1.f, GT, 3072, RS1}; GEMM(ER0, Hc, WinT + (size_t)3840 * 1024, 3072, 1024, E); GRID_BAR(); }
        PH(10) { PTRS(); int bx_ = blockIdx.x; asm volatile("" : "+s"(bx_)); int G_ = gridDim.x; asm volatile("" : "+s"(G_));
                 pg8::Gemm g_{OA, WbT, 3 * T, 3072, 512}; pg8::MergeOrder S_{G_, bx_}; pg8::EpiMergeAll E{MG, GT};
                 pg8::gemm_phase<pg8::EpiMergeAll, pg8::MergeOrder, true, true>(L + RING_OFF, g_, S_, E); GRID_BAR(); }
        PH(11) { PTRS(); ER0 E{M2, 1024, 4, M2, 1024, 0, 0, 1.f, M2, 1024, nullptr}; GEMM(ER0, MG, WoT, 1024, 1024, E); GRID_BAR(); }
        if (IN(12)) { PTRS(); rowpass<0>(L, Hc, M2, kin(23) + l * 1024, nullptr); GRID_BAR(); }
        PH(13) { PTRS(); pg8::EpiRoute<2> E{HID, 4096, 16, HID, 4096, 0, 0, 1.f, HID, 4096, RS2}; GEMM(pg8::EpiRoute<2>, Hc, W1T, 4096, 1024, E); GRID_BAR(); }
        PH(14) { PTRS(); ER0 E{M2, 1024, 4, M2, 1024, 0, 0, 1.f, M2, 1024, nullptr}; GEMM(ER0, HID, W2T, 1024, 4096, E); GRID_BAR(); }
        if (IN(15)) { PTRS(); rowpass<1>(L, Hc, M2, kin(27) + l * 1024, kin(1) + (size_t)l * T * DPLE); GRID_BAR(); }
        if (IN(17)) { PTRS(); ER0 E{PP, 1024, 4, PP, 1024, 0, 0, 1.f, PP, 1024, nullptr}; GEMM(ER0, PB, WpT, 1024, 256, E);
                      pg8::EpiPle E2{Hc, Hn, PP, kout(), (l + 1 == DEPTH) ? 1 : 0}; GEMM(pg8::EpiPle, Hc, WgT, 1024, 1024, E2); }
        LAYER_END();
        if (l + 1 < DEPTH) GRID_BAR();
    }
#if defined(TS_A)
    if (blockIdx.x == TS_BLK && my_tid() < 64) { const LAS unsigned* sl = (const LAS unsigned*)(L + LDSCTL_OFF + 320 + 1024);
        const unsigned want = __builtin_amdgcn_readfirstlane(sl[1]) * (unsigned)TS_AMP; const unsigned t0 = (unsigned)__builtin_amdgcn_s_memrealtime();
        while ((unsigned)__builtin_amdgcn_s_memrealtime() - t0 < want) __builtin_amdgcn_s_sleep(8); }
#endif
}

#if !defined(DBG_BISECT)
extern "C" void kernel_launch(void* const* d_in, const int* in_sizes, int n_in, void* d_out, int out_size, void* d_ws, size_t ws_size, hipStream_t stream) {
    static int grid = 0;
    if (grid == 0) {
        if (n_in != 30 || out_size != T * D || ws_size < (size_t)WS_END) { fprintf(stderr, "kernel_launch: unexpected shapes (n_in %d out %d ws %zu, need ws >= %zu)\n", n_in, out_size, ws_size, (size_t)WS_END); grid = -1; return; }
        int dev = 0, cus = 0, per_cu = 0;
        if (hipGetDevice(&dev) != hipSuccess || hipDeviceGetAttribute(&cus, hipDeviceAttributeMultiprocessorCount, dev) != hipSuccess) { grid = -1; return; }
        if (hipFuncSetAttribute((const void*)mk_fwd, hipFuncAttributeMaxDynamicSharedMemorySize, LDS_BYTES) != hipSuccess) { fprintf(stderr, "kernel_launch: hipFuncSetAttribute failed\n"); grid = -1; return; }
        if (hipOccupancyMaxActiveBlocksPerMultiprocessor(&per_cu, (const void*)mk_fwd, NWAVES * 64, LDS_BYTES) != hipSuccess || per_cu < 1) { fprintf(stderr, "kernel_launch: occupancy query says %d\n", per_cu); }
        (void)hipGetLastError();
        if (cus < 256) { fprintf(stderr, "kernel_launch: %d CUs, the RWKV pre-pass needs a grid of >= 256 workgroups\n", cus); grid = -1; return; }
        grid = cus;
    }
    if (grid < 0) return;
    if (hipMemsetAsync((char*)d_ws + WS_CTL, 0, CTL_ZERO_BYTES, stream) != hipSuccess) return;
    Args a{};
    for (int i = 0; i < 30; ++i) a.in[i] = (const float*)d_in[i];
    a.out = (float*)d_out; a.ws = (unsigned char*)d_ws; a.start = 0; a.stop = 1000;
    hipLaunchKernelGGL(mk_fwd, dim3(grid), dim3(NWAVES * 64), LDS_BYTES, stream, a);
}
#endif
```

```cpp
#include <hip/hip_runtime.h>
#include <cstdio>
#include <cstdint>
#include <cmath>
typedef _Float16 h16x8_t __attribute__((ext_vector_type(8)));
typedef _Float16 h16x2_t __attribute__((ext_vector_type(2)));
typedef short s16x8_t __attribute__((ext_vector_type(8)));
typedef float f32x4_t_ __attribute__((ext_vector_type(4)));
typedef float f32x16_t_ __attribute__((ext_vector_type(16)));
__device__ __forceinline__ unsigned h_pk2(float lo, float hi) { const h16x2_t v = {(_Float16)lo, (_Float16)hi}; return __builtin_bit_cast(unsigned, v); }
__device__ __forceinline__ unsigned h_f2h(float f) { return (unsigned)__builtin_bit_cast(unsigned short, (_Float16)f); }
__device__ __forceinline__ float h_lo(unsigned w) { return (float)__builtin_bit_cast(_Float16, (unsigned short)(w & 0xffffu)); }
__device__ __forceinline__ float h_hi(unsigned w) { return (float)__builtin_bit_cast(_Float16, (unsigned short)(w >> 16)); }
__device__ __forceinline__ f32x4_t_ MFMA16(s16x8_t a, s16x8_t b, f32x4_t_ c) { return __builtin_amdgcn_mfma_f32_16x16x32_f16(__builtin_bit_cast(h16x8_t, a), __builtin_bit_cast(h16x8_t, b), c, 0, 0, 0); }
__device__ __forceinline__ f32x16_t_ MFMA32(s16x8_t a, s16x8_t b, f32x16_t_ c) { return __builtin_amdgcn_mfma_f32_32x32x16_f16(__builtin_bit_cast(h16x8_t, a), __builtin_bit_cast(h16x8_t, b), c, 0, 0, 0); }
#define MK_WAVETAB_LDS 131072
__device__ __forceinline__ int my_tid() {
    const unsigned hw = (unsigned)__builtin_amdgcn_s_getreg((5 << 11) | 4) & 63u;
    const unsigned wv = (unsigned)__builtin_amdgcn_readfirstlane((int)((volatile __attribute__((address_space(3))) unsigned*)MK_WAVETAB_LDS)[hw]);
    unsigned lane; asm volatile("v_mbcnt_lo_u32_b32 %0, -1, 0\n\tv_mbcnt_hi_u32_b32 %0, -1, %0" : "=v"(lane));
    return (int)(wv * 64u + lane);
}
namespace pg8 {
#define PG8_LAS __attribute__((address_space(3)))
#define PG8_GAS __attribute__((address_space(1)))
typedef unsigned short bf16_t;
typedef short bf16x8 __attribute__((ext_vector_type(8)));
typedef float f32x4 __attribute__((ext_vector_type(4)));
typedef unsigned u32x4 __attribute__((ext_vector_type(4)));
constexpr int BM = 256, BK = 64, HALF = 128, HTB = HALF * BK * 2  , STAGE_BYTES = 8 * HTB, NXCD = 8, WGM = 8;

__host__ __device__ __forceinline__ int lds_byte(int r, int c) { const int st = (r >> 4) * 2 + (c >> 5), rr = r & 15, cc = c & 31, ob = rr * 64 + cc * 2; return st * 1024 + (ob ^ (((ob >> 9) & 1) << 5)); }
__host__ __device__ __forceinline__ void stage_rc(int b, int& R, int& C) { const int st = b / 1024, sb = b % 1024, swz = sb ^ (((sb >> 9) & 1) << 5); R = (st >> 1) * 16 + swz / 64; C = (st & 1) * 32 + (swz % 64) / 2; }
__host__ __device__ __forceinline__ int perm32(int rho) { const int n = rho >> 4, i = rho & 15; return 8 * (i >> 2) + 4 * n + (i & 3); }

struct Unit { int pm, pn; };
struct Gemm { const bf16_t* A; const bf16_t* Bt; int M, N, K; };

struct StaticOrder {
    int nM, nN, nwg, G, c;
    __host__ __device__ void init(int M, int N, int G_, int c_) { nM = M / BM; nN = N / BM; nwg = nM * nN; G = G_; c = c_; }
    __host__ __device__ bool next(int i, Unit& u) const {
        const long L = (long)i * G + c; if (L >= nwg) return false;
        int wgid = (int)L; { const int q = nwg / NXCD, r = nwg % NXCD, xcd = wgid % NXCD, off = wgid / NXCD; wgid = (xcd < r ? xcd * (q + 1) : r * (q + 1) + (xcd - r) * q) + off; }
        const int nig = WGM * nN, gid = wgid / nig, fm = gid * WGM, gsz = (nM - fm) < WGM ? (nM - fm) : WGM;
        u.pm = fm + ((wgid % nig) % gsz); u.pn = (wgid % nig) / gsz; return true;
    }
    __device__ __forceinline__ void a_ready(const Unit&) const {}
    __device__ __forceinline__ void done(const Unit&) const {}
};

__device__ __forceinline__ unsigned cvt_pk_bf16(float lo, float hi) { typedef __fp16 hp2 __attribute__((ext_vector_type(2))); const hp2 v = __builtin_amdgcn_cvt_pkrtz(lo, hi); return __builtin_bit_cast(unsigned, v); }
typedef float f32x2 __attribute__((ext_vector_type(2)));
__device__ __forceinline__ f32x2 gelu_pk(f32x2 v) {
    const f32x2 av = __builtin_elementwise_abs(v), d = av * 0.2316418882f + 1.0f;
    f32x2 t; t.x = __builtin_amdgcn_rcpf(d.x); t.y = __builtin_amdgcn_rcpf(d.y);
    f32x2 q = t * 0.5307027145f + (-0.7265760135f); q = q * t + 0.7107068705f; q = q * t + (-0.142248368f); q = q * t + 0.127414796f; q = q * t;
    const f32x2 s = (v * v) * (-0.72134752044f);
    f32x2 e; e.x = __builtin_amdgcn_exp2f(s.x); e.y = __builtin_amdgcn_exp2f(s.y);
    const f32x2 m = v * (q * e), r = v - m;
    f32x2 o; o.x = v.x < 0.f ? m.x : r.x; o.y = v.y < 0.f ? m.y : r.y; return o;
}

template <int ACT  > struct EpiBf16 {
    static constexpr bool PERM = true, AFTER_DRAIN = false; static_assert(ACT == 0 || ACT == 1, "EpiBf16: ACT is 0 (none) or 1 (gelu_pk)");
    bf16_t* O; int ldc; const float* bias; int split_cols; size_t split_stride; float scale0;
    __device__ __forceinline__ void operator()(const f32x4 (&acc)[2][2][4][2], const Unit& u, int wr, int wc, int fr, int fq) const {
        const int row0 = u.pm * BM + wr * 64 + fr; int colt = u.pn * BM; bf16_t* base = O;
        float sc = 1.f; if (split_cols) { const int t = colt / split_cols; base += (size_t)t * split_stride; colt -= t * split_cols; if (t == 0) sc = scale0; }
        const int col0 = colt + wc * 32 + 8 * fq, bcol0 = u.pn * BM + wc * 32 + 8 * fq;
        f32x4 bv[2][2];
#pragma unroll
        for (int bj = 0; bj < 2; ++bj)
#pragma unroll
            for (int n = 0; n < 2; ++n) bv[bj][n] = bias ? *(const f32x4*)(bias + bcol0 + bj * HALF + 4 * n) : (f32x4){0.f, 0.f, 0.f, 0.f};
#pragma unroll
        for (int ai = 0; ai < 2; ++ai)
#pragma unroll
            for (int m = 0; m < 4; ++m) { bf16_t* rowp = base + (size_t)(row0 + ai * HALF + m * 16) * ldc + col0;
#pragma unroll
                for (int bj = 0; bj < 2; ++bj) { f32x4 v0 = acc[ai][bj][m][0] + bv[bj][0], v1 = acc[ai][bj][m][1] + bv[bj][1];
                    if (ACT == 1) { f32x2 a = gelu_pk((f32x2){v0[0], v0[1]}), b = gelu_pk((f32x2){v0[2], v0[3]}), c = gelu_pk((f32x2){v1[0], v1[1]}), d = gelu_pk((f32x2){v1[2], v1[3]});
                        v0 = (f32x4){a.x, a.y, b.x, b.y}; v1 = (f32x4){c.x, c.y, d.x, d.y}; }
                    v0 = v0 * sc; v1 = v1 * sc; u32x4 w; w.x = cvt_pk_bf16(v0[0], v0[1]); w.y = cvt_pk_bf16(v0[2], v0[3]); w.z = cvt_pk_bf16(v1[0], v1[1]); w.w = cvt_pk_bf16(v1[2], v1[3]);
                    *(u32x4*)(rowp + bj * HALF) = w; } }
    }
};
__device__ __forceinline__ float bf2f(unsigned short b) { return h_lo((unsigned)b); }
__device__ __forceinline__ float sigm(float x) { return __builtin_amdgcn_rcpf(1.0f + __builtin_amdgcn_exp2f(-1.4426950408889634f * x)); }
__device__ __forceinline__ void unpack8(const u32x4 w, float (&f)[8]) {
    f[0] = h_lo(w.x); f[1] = h_hi(w.x); f[2] = h_lo(w.y); f[3] = h_hi(w.y); f[4] = h_lo(w.z); f[5] = h_hi(w.z); f[6] = h_lo(w.w); f[7] = h_hi(w.w);
}
template <int ACT> struct EpiRoute {
    static constexpr bool PERM = true, AFTER_DRAIN = false;
    bf16_t* O0; int ld0; int nt0;
    bf16_t* O1; int ld1; int nt1; int nts1; float sc1;
    bf16_t* O2; int ld2;
    const float* rsc;
    __device__ __forceinline__ void operator()(const f32x4 (&acc)[2][2][4][2], const Unit& u, int wr, int wc, int fr, int fq) const {
        const int row0 = u.pm * BM + wr * 64 + fr;
        float rsv[2][4];
#pragma unroll
        for (int ai = 0; ai < 2; ++ai)
#pragma unroll
            for (int m = 0; m < 4; ++m) rsv[ai][m] = rsc ? *(const PG8_GAS float*)(rsc + row0 + ai * HALF + m * 16) : 1.f;
        bf16_t* base; int ld, colt; float sc = 1.f;
        if (u.pn < nt0) { base = O0; ld = ld0; colt = u.pn * BM; }
        else if (u.pn < nt0 + nt1) { base = O1; ld = ld1; colt = (u.pn - nt0) * BM; if (u.pn - nt0 < nts1) sc = sc1; }
        else { base = O2; ld = ld2; colt = (u.pn - nt0 - nt1) * BM; }
        const int col0 = colt + wc * 32 + 8 * fq;
#pragma unroll
        for (int ai = 0; ai < 2; ++ai)
#pragma unroll
            for (int m = 0; m < 4; ++m) { bf16_t* rowp = base + (size_t)(row0 + ai * HALF + m * 16) * ld + col0;
#pragma unroll
                for (int bj = 0; bj < 2; ++bj) { f32x4 v0 = acc[ai][bj][m][0] * rsv[ai][m], v1 = acc[ai][bj][m][1] * rsv[ai][m];
                    if (ACT == 2) { for (int e = 0; e < 4; ++e) { const float a = fmaxf(v0[e], 0.f), b = fmaxf(v1[e], 0.f); v0[e] = a * a; v1[e] = b * b; } }
                    v0 = v0 * sc; v1 = v1 * sc; u32x4 w; w.x = cvt_pk_bf16(v0[0], v0[1]); w.y = cvt_pk_bf16(v0[2], v0[3]); w.z = cvt_pk_bf16(v1[0], v1[1]); w.w = cvt_pk_bf16(v1[2], v1[3]);
                    *(PG8_GAS u32x4*)(rowp + bj * HALF) = w; } }
    }
};
struct EpiSig {
    static constexpr bool PERM = true, AFTER_DRAIN = false;
    bf16_t* O; const float* p; float scale; int ld;
    __device__ __forceinline__ void operator()(const f32x4 (&acc)[2][2][4][2], const Unit& u, int wr, int wc, int fr, int fq) const {
        const int row0 = u.pm * BM + wr * 64 + fr; const int col0 = u.pn * BM + wc * 32 + 8 * fq;
        const f32x4 pA0 = *(const PG8_GAS f32x4*)(p + col0), pA1 = *(const PG8_GAS f32x4*)(p + col0 + 4), pB0 = *(const PG8_GAS f32x4*)(p + col0 + HALF), pB1 = *(const PG8_GAS f32x4*)(p + col0 + HALF + 4);
#pragma unroll
        for (int ai = 0; ai < 2; ++ai)
#pragma unroll
            for (int m = 0; m < 4; ++m) { bf16_t* rowp = O + (size_t)(row0 + ai * HALF + m * 16) * ld + col0;
#pragma unroll
                for (int bj = 0; bj < 2; ++bj) { f32x4 v0 = acc[ai][bj][m][0], v1 = acc[ai][bj][m][1]; const f32x4 p0 = bj ? pB0 : pA0, p1 = bj ? pB1 : pA1;
                    v0 = (f32x4){sigm(p0[0] + v0[0]), sigm(p0[1] + v0[1]), sigm(p0[2] + v0[2]), sigm(p0[3] + v0[3])} * scale; v1 = (f32x4){sigm(p1[0] + v1[0]), sigm(p1[1] + v1[1]), sigm(p1[2] + v1[2]), sigm(p1[3] + v1[3])} * scale;
                    u32x4 w; w.x = cvt_pk_bf16(v0[0], v0[1]); w.y = cvt_pk_bf16(v0[2], v0[3]); w.z = cvt_pk_bf16(v1[0], v1[1]); w.w = cvt_pk_bf16(v1[2], v1[3]);
                    *(PG8_GAS u32x4*)(rowp + bj * HALF) = w; } }
    }
};
struct EpiLora {
    static constexpr bool PERM = true, AFTER_DRAIN = false;
    bf16_t* TW; bf16_t* TA; bf16_t* G; const float* w0; const float* a0;
    __device__ __forceinline__ void operator()(const f32x4 (&acc)[2][2][4][2], const Unit& u, int wr, int wc, int fr, int fq) const {
        const int sel = u.pn >> 1;
        bf16_t* O = TW; const float* p = w0; float scale = -0.6065306597126334f;
        if (sel == 1) { O = TA; p = a0; scale = 1.f; } else if (sel == 2) { O = G; }
        asm volatile("" : "+s"(O), "+s"(p));
        const int row0 = u.pm * BM + wr * 64 + fr; const int col0 = (u.pn & 1) * BM + wc * 32 + 8 * fq;
        const f32x4 pA0 = *(const PG8_GAS f32x4*)(p + col0), pA1 = *(const PG8_GAS f32x4*)(p + col0 + 4), pB0 = *(const PG8_GAS f32x4*)(p + col0 + HALF), pB1 = *(const PG8_GAS f32x4*)(p + col0 + HALF + 4);
#pragma unroll
        for (int ai = 0; ai < 2; ++ai)
#pragma unroll
            for (int m = 0; m < 4; ++m) { bf16_t* rowp = O + (size_t)(row0 + ai * HALF + m * 16) * 512 + col0;
#pragma unroll
                for (int bj = 0; bj < 2; ++bj) { f32x4 v0 = acc[ai][bj][m][0], v1 = acc[ai][bj][m][1]; const f32x4 p0 = bj ? pB0 : pA0, p1 = bj ? pB1 : pA1;
                    if (sel < 2) { v0 = (f32x4){sigm(p0[0] + v0[0]), sigm(p0[1] + v0[1]), sigm(p0[2] + v0[2]), sigm(p0[3] + v0[3])} * scale; v1 = (f32x4){sigm(p1[0] + v1[0]), sigm(p1[1] + v1[1]), sigm(p1[2] + v1[2]), sigm(p1[3] + v1[3])} * scale; }
                    u32x4 w; w.x = cvt_pk_bf16(v0[0], v0[1]); w.y = cvt_pk_bf16(v0[2], v0[3]); w.z = cvt_pk_bf16(v1[0], v1[1]); w.w = cvt_pk_bf16(v1[2], v1[3]);
                    *(PG8_GAS u32x4*)(rowp + bj * HALF) = w; } }
    }
};
struct EpiQRope {
    static constexpr bool PERM = true, AFTER_DRAIN = false;
    bf16_t* O; const float* rope; float sc;
    __device__ __forceinline__ void operator()(const f32x4 (&acc)[2][2][4][2], const Unit& u, int wr, int wc, int fr, int fq) const {
        const int row0 = u.pm * BM + wr * 64 + fr; const int col0 = u.pn * BM + wc * 32 + 8 * fq;
#pragma unroll
        for (int ai = 0; ai < 2; ++ai)
#pragma unroll
            for (int m = 0; m < 4; ++m) { const int row = row0 + ai * HALF + m * 16;
#pragma unroll
                for (int bj = 0; bj < 2; ++bj) { const int cg = col0 + bj * HALF; const int cm = cg % 192; f32x4 v0 = acc[ai][bj][m][0], v1 = acc[ai][bj][m][1];
                    if (cm >= 128) { const int j0 = (cm - 128) >> 1; const PG8_GAS f32x4* rp = (const PG8_GAS f32x4*)(rope + ((size_t)row * 32 + j0) * 2); const f32x4 a = rp[0], b = rp[1];
                        f32x4 r0, r1;
                        r0[0] = v0[0] * a[0] - v0[1] * a[1]; r0[1] = v0[1] * a[0] + v0[0] * a[1]; r0[2] = v0[2] * a[2] - v0[3] * a[3]; r0[3] = v0[3] * a[2] + v0[2] * a[3];
                        r1[0] = v1[0] * b[0] - v1[1] * b[1]; r1[1] = v1[1] * b[0] + v1[0] * b[1]; r1[2] = v1[2] * b[2] - v1[3] * b[3]; r1[3] = v1[3] * b[2] + v1[2] * b[3];
                        v0 = r0; v1 = r1; }
                    v0 = v0 * sc; v1 = v1 * sc; u32x4 w; w.x = cvt_pk_bf16(v0[0], v0[1]); w.y = cvt_pk_bf16(v0[2], v0[3]); w.z = cvt_pk_bf16(v1[0], v1[1]); w.w = cvt_pk_bf16(v1[2], v1[3]);
                    *(PG8_GAS u32x4*)(O + (size_t)row * 768 + cg) = w; } }
    }
};
template <int NI> struct EpiMerge {
    static constexpr bool PERM = true, AFTER_DRAIN = false;
    bf16_t* MG; const bf16_t* GT;
    __device__ __forceinline__ void operator()(const f32x4 (&acc)[2][2][4][2], const Unit& u, int wr, int wc, int fr, int fq) const {
        const int row0 = u.pm * BM + wr * 64 + fr; const int col0 = u.pn * BM + wc * 32 + 8 * fq;
#pragma unroll
        for (int ai = 0; ai < 2; ++ai)
#pragma unroll
            for (int m = 0; m < 4; ++m) { const int row = row0 + ai * HALF + m * 16;
#pragma unroll
                for (int bj = 0; bj < 2; ++bj) { const int c = col0 + bj * HALF; const f32x4 v0 = acc[ai][bj][m][0], v1 = acc[ai][bj][m][1];
                    const u32x4 gw = *(const PG8_GAS u32x4*)(GT + (size_t)row * 3072 + NI * 1024 + c);
                    f32x4 o0 = {0.f, 0.f, 0.f, 0.f}, o1 = {0.f, 0.f, 0.f, 0.f};
                    if (NI > 0) { const u32x4 ow = *(const PG8_GAS u32x4*)(MG + (size_t)row * 1024 + c); o0 = (f32x4){h_lo(ow.x), h_hi(ow.x), h_lo(ow.y), h_hi(ow.y)}; o1 = (f32x4){h_lo(ow.z), h_hi(ow.z), h_lo(ow.w), h_hi(ow.w)}; }
                    o0[0] += sigm(h_lo(gw.x)) * v0[0]; o0[1] += sigm(h_hi(gw.x)) * v0[1]; o0[2] += sigm(h_lo(gw.y)) * v0[2]; o0[3] += sigm(h_hi(gw.y)) * v0[3];
                    o1[0] += sigm(h_lo(gw.z)) * v1[0]; o1[1] += sigm(h_hi(gw.z)) * v1[1]; o1[2] += sigm(h_lo(gw.w)) * v1[2]; o1[3] += sigm(h_hi(gw.w)) * v1[3];
                    u32x4 w; w.x = cvt_pk_bf16(o0[0], o0[1]); w.y = cvt_pk_bf16(o0[2], o0[3]); w.z = cvt_pk_bf16(o1[0], o1[1]); w.w = cvt_pk_bf16(o1[2], o1[3]);
                    *(PG8_GAS u32x4*)(MG + (size_t)row * 1024 + c) = w; } }
    }
};
__device__ __forceinline__ unsigned pk_fma_h(unsigned a, unsigned b, unsigned c) { unsigned r; asm("v_pk_fma_f16 %0, %1, %2, %3" : "=v"(r) : "v"(a), "v"(b), "v"(c)); return r; }
struct EpiMergeAll {
    static constexpr bool PERM = true, AFTER_DRAIN = false, CHAIN = true;
    bf16_t* MG; const bf16_t* GT;
    __device__ __forceinline__ bool chain(const Unit& u) const { return (u.pm >> 7) < 2; }
    static __device__ __forceinline__ float e2(unsigned short hbits) { return __builtin_amdgcn_exp2f(-1.4426950408889634f * __builtin_amdgcn_fmed3f(h_lo((unsigned)hbits), -30.f, 30.f)); }
    __device__ __forceinline__ void operator()(f32x4 (&acc)[2][2][4][2], const Unit& u, int wr, int wc, int fr, int fq) const {
        const int a = u.pm >> 7, p = u.pm & 127, br = u.pn >> 2, q = u.pn & 3;
        const int brn = (a == 0) ? 2 : 1;
        const int row0 = p * BM + wr * 64 + fr; const int col0 = q * BM + wc * 32 + 8 * fq;
#pragma unroll
        for (int ai = 0; ai < 2; ++ai) {
            u32x4 gw[4][2], gn[4][2];
#pragma unroll
            for (int m = 0; m < 4; ++m)
#pragma unroll
                for (int bj = 0; bj < 2; ++bj) { const int row = row0 + ai * HALF + m * 16, c = col0 + bj * HALF;
                    gw[m][bj] = *(const PG8_GAS u32x4*)(GT + (size_t)row * 3072 + br * 1024 + c);
                    if (a < 2) gn[m][bj] = *(const PG8_GAS u32x4*)(GT + (size_t)row * 3072 + brn * 1024 + c); else gn[m][bj] = (u32x4){0u, 0u, 0u, 0u}; }
            __builtin_amdgcn_sched_barrier(0);
#pragma unroll
            for (int m = 0; m < 4; ++m)
#pragma unroll
                for (int bj = 0; bj < 2; ++bj) { const int row = row0 + ai * HALF + m * 16, c = col0 + bj * HALF; const u32x4 g = gw[m][bj], n = gn[m][bj];
                    float f[8];
#pragma unroll
                    for (int e = 0; e < 4; ++e) { const unsigned gd = g[e], nd = n[e];
                        const float d0 = __builtin_amdgcn_rcpf(1.f + e2((unsigned short)gd)), d1 = __builtin_amdgcn_rcpf(1.f + e2((unsigned short)(gd >> 16)));
                        f[2 * e] = (a < 2) ? d0 * (1.f + e2((unsigned short)nd)) : d0; f[2 * e + 1] = (a < 2) ? d1 * (1.f + e2((unsigned short)(nd >> 16))) : d1; }
                    f32x4 v0 = acc[ai][bj][m][0], v1 = acc[ai][bj][m][1];
                    v0[0] *= f[0]; v0[1] *= f[1]; v0[2] *= f[2]; v0[3] *= f[3]; v1[0] *= f[4]; v1[1] *= f[5]; v1[2] *= f[6]; v1[3] *= f[7];
                    if (a < 2) { acc[ai][bj][m][0] = v0; acc[ai][bj][m][1] = v1; }
                    else { u32x4 w; w.x = cvt_pk_bf16(v0[0], v0[1]); w.y = cvt_pk_bf16(v0[2], v0[3]); w.z = cvt_pk_bf16(v1[0], v1[1]); w.w = cvt_pk_bf16(v1[2], v1[3]);
                        *(PG8_GAS u32x4*)(MG + (size_t)row * 1024 + c) = w; } }
            __builtin_amdgcn_sched_barrier(0);
        }
    }
};
struct MergeOrder {
    int G, c;
    __device__ __forceinline__ bool next(int i, Unit& u) const { if (i >= 6 || G != 256) { if (G == 256) return false; const int t = c + G * (i / 3), a = i % 3; if (t >= 512) return false;
            const int p = t >> 2, q = t & 3, br = (a == 0) ? 0 : (a == 1 ? 2 : 1); u.pm = a * 128 + p; u.pn = br * 4 + q; return true; }
        const int x = c & 7, s = c >> 3, p = x * 16 + (s >> 1), q = 2 * (s & 1) + i / 3, a = i % 3, br = (a == 0) ? 0 : (a == 1 ? 2 : 1);
        u.pm = a * 128 + p; u.pn = br * 4 + q; return true; }
    __device__ __forceinline__ void a_ready(const Unit&) const {}
    __device__ __forceinline__ void done(const Unit&) const {}
};
struct EpiPle {
    static constexpr bool PERM = true, AFTER_DRAIN = false;
    const bf16_t* Hin; bf16_t* Hout; const bf16_t* PP; float* outF; int last;
    __device__ __forceinline__ void operator()(const f32x4 (&acc)[2][2][4][2], const Unit& u, int wr, int wc, int fr, int fq) const {
        const int row0 = u.pm * BM + wr * 64 + fr; const int col0 = u.pn * BM + wc * 32 + 8 * fq;
#pragma unroll
        for (int ai = 0; ai < 2; ++ai) {
            u32x4 pw[4][2], hw[4][2];
#pragma unroll
            for (int m = 0; m < 4; ++m)
#pragma unroll
                for (int bj = 0; bj < 2; ++bj) { const int row = row0 + ai * HALF + m * 16, c = col0 + bj * HALF;
                    pw[m][bj] = *(const PG8_GAS u32x4*)(PP + (size_t)row * 1024 + c); hw[m][bj] = *(const PG8_GAS u32x4*)(Hin + (size_t)row * 1024 + c); }
            __builtin_amdgcn_sched_barrier(0);
#pragma unroll
            for (int m = 0; m < 4; ++m)
#pragma unroll
                for (int bj = 0; bj < 2; ++bj) { const int row = row0 + ai * HALF + m * 16, c = col0 + bj * HALF; const f32x4 v0 = acc[ai][bj][m][0], v1 = acc[ai][bj][m][1]; const u32x4 pq = pw[m][bj], hq = hw[m][bj];
                    f32x4 h0 = (f32x4){h_lo(hq.x), h_hi(hq.x), h_lo(hq.y), h_hi(hq.y)}, h1 = (f32x4){h_lo(hq.z), h_hi(hq.z), h_lo(hq.w), h_hi(hq.w)};
                    h0[0] += sigm(v0[0]) * h_lo(pq.x); h0[1] += sigm(v0[1]) * h_hi(pq.x); h0[2] += sigm(v0[2]) * h_lo(pq.y); h0[3] += sigm(v0[3]) * h_hi(pq.y);
                    h1[0] += sigm(v1[0]) * h_lo(pq.z); h1[1] += sigm(v1[1]) * h_hi(pq.z); h1[2] += sigm(v1[2]) * h_lo(pq.w); h1[3] += sigm(v1[3]) * h_hi(pq.w);
                    if (last) { float* op = outF + (size_t)row * 1024 + c; *(PG8_GAS f32x4*)op = h0; *(PG8_GAS f32x4*)(op + 4) = h1; }
                    else { u32x4 w; w.x = h_pk2(h0[0], h0[1]); w.y = h_pk2(h0[2], h0[3]); w.z = h_pk2(h1[0], h1[1]); w.w = h_pk2(h1[2], h1[3]); *(PG8_GAS u32x4*)(Hout + (size_t)row * 1024 + c) = w; } }
            __builtin_amdgcn_sched_barrier(0);
        }
    }
};
template <class E_, class = void> struct epi_chain { static constexpr bool value = false; };
template <class E_> struct epi_chain<E_, decltype((void)E_::CHAIN)> { static constexpr bool value = true; };
template <class Epi, class Sched, bool ALIGN_EPI = false, bool SP2 = false>
__device__ __forceinline__ void gemm_phase(PG8_LAS unsigned char* lds, const Gemm g, const Sched& S, const Epi& E) {
    int tid_ = my_tid(); asm volatile("" : "+v"(tid_));
    const int tid = tid_, wid = __builtin_amdgcn_readfirstlane(tid >> 6), lane = tid & 63, wr = wid >> 2, wc = wid & 3, fr = lane & 15, fq = lane >> 4;
    const int K = g.K, nt = K / BK;
    unsigned voffA[2], voffB[2];
#pragma unroll
    for (int i = 0; i < 2; ++i) { int R, C; stage_rc(tid * 16 + i * 8192, R, C); const int Rb = Epi::PERM ? ((R & ~31) + perm32(R & 31)) : R;
        voffA[i] = (unsigned)(R * K + C) * 2u; voffB[i] = (unsigned)(Rb * K + C) * 2u; }
    const size_t kstep = (size_t)(BK * 2);
    const size_t hstep = (size_t)HALF * K * 2;
    const size_t tstep = 2 * hstep;
    const unsigned ldsw = (unsigned)wid * 1024u;
    const int aoff = lds_byte(wr * 64 + fr, fq * 8), boff = lds_byte(wc * 32 + fr, fq * 8);
#define PG8_SA(b, h) (((b) * 2 + (h)) * HTB)
#define PG8_SB(b, h) ((4 + (b) * 2 + (h)) * HTB)
#define PG8_STAGE(bufoff, gbase, voff) do { _Pragma("unroll") for (int _i = 0; _i < 2; ++_i) \
        __builtin_amdgcn_global_load_lds((const unsigned*)((const char*)(gbase) + (voff)[_i]), (PG8_LAS unsigned*)(lds + (bufoff) + ldsw + _i * 8192), 16, 0, 0); } while (0)
#define PG8_LDA(dst, b, h) do { _Pragma("unroll") for (int m = 0; m < 4; ++m) _Pragma("unroll") for (int k = 0; k < 2; ++k) dst[m][k] = *(const PG8_LAS bf16x8*)(lds + PG8_SA(b, h) + aoff + m * 2048 + k * 1024); } while (0)
#define PG8_LDB(dst, b, h) do { _Pragma("unroll") for (int n = 0; n < 2; ++n) _Pragma("unroll") for (int k = 0; k < 2; ++k) dst[n][k] = *(const PG8_LAS bf16x8*)(lds + PG8_SB(b, h) + boff + n * 2048 + k * 1024); } while (0)
#define PG8_MMA(ai, bj, At, Bt) do { __builtin_amdgcn_s_setprio(1); _Pragma("unroll") for (int m = 0; m < 4; ++m) _Pragma("unroll") for (int n = 0; n < 2; ++n) _Pragma("unroll") for (int k = 0; k < 2; ++k) \
        acc[ai][bj][m][n] = MFMA16(Bt[n][k], At[m][k], acc[ai][bj][m][n]); __builtin_amdgcn_s_setprio(0); } while (0)
#define PG8_WAIT_V(n) asm volatile("s_waitcnt vmcnt(" #n ")" ::: "memory")
#define PG8_WAIT_L(n) asm volatile("s_waitcnt lgkmcnt(" #n ")" ::: "memory")
#define PG8_BAR __builtin_amdgcn_s_barrier()
#define PG8_SCHED __builtin_amdgcn_sched_barrier(0)
    Unit cur, nxt; int ui = 0;
    if (!S.next(0, cur)) return;
    f32x4 acc[2][2][4][2];
#pragma unroll
    for (int a = 0; a < 2; ++a)
#pragma unroll
        for (int b = 0; b < 2; ++b)
#pragma unroll
            for (int m = 0; m < 4; ++m)
#pragma unroll
                for (int n = 0; n < 2; ++n) acc[a][b][m][n] = (f32x4){0.f, 0.f, 0.f, 0.f};
    bf16x8 At[4][2], B0[2][2], B1[2][2];
    const char* cA = (const char*)g.A + (size_t)cur.pm * tstep; const char* cB = (const char*)g.Bt + (size_t)cur.pn * tstep;
    S.a_ready(cur);
    if constexpr (SP2) {
        PG8_STAGE(PG8_SB(0, 0), cB, voffB); PG8_STAGE(PG8_SB(0, 1), cB + hstep, voffB); PG8_STAGE(PG8_SA(0, 0), cA, voffA); PG8_STAGE(PG8_SA(0, 1), cA + hstep, voffA);
        if (wr == 1) PG8_BAR;
        PG8_WAIT_V(2); PG8_BAR;
        PG8_STAGE(PG8_SB(1, 0), cB + kstep, voffB); PG8_STAGE(PG8_SA(1, 0), cA + kstep, voffA); PG8_STAGE(PG8_SB(1, 1), cB + hstep + kstep, voffB);
        PG8_WAIT_V(6); PG8_BAR;
    } else {
        PG8_STAGE(PG8_SB(0, 0), cB, voffB); PG8_STAGE(PG8_SA(0, 0), cA, voffA); PG8_STAGE(PG8_SB(0, 1), cB + hstep, voffB); PG8_STAGE(PG8_SA(0, 1), cA + hstep, voffA);
        if (wr == 1) PG8_BAR;
        PG8_WAIT_V(4); PG8_BAR;
        PG8_STAGE(PG8_SB(1, 0), cB + kstep, voffB); PG8_STAGE(PG8_SA(1, 0), cA + kstep, voffA); PG8_STAGE(PG8_SB(1, 1), cB + hstep + kstep, voffB);
        PG8_WAIT_V(6); PG8_BAR;
    }
    for (;;) {
        const bool has_next = S.next(ui + 1, nxt);
        const char* nA = has_next ? (const char*)g.A + (size_t)nxt.pm * tstep : cA; const char* nB = has_next ? (const char*)g.Bt + (size_t)nxt.pn * tstep : cB;
        for (int t = 0; t < nt; t += 2) {
            const bool last = (t == nt - 2);
            const char* a1 = cA + (size_t)(t + 1) * kstep;
            const char* a2 = last ? nA : cA + (size_t)(t + 2) * kstep; const char* b2 = last ? nB : cB + (size_t)(t + 2) * kstep;
            const char* a3 = a2 + kstep; const char* b3 = b2 + kstep;
            if (last && has_next) S.a_ready(nxt);
            if constexpr (SP2) {
            PG8_LDB(B0, 0, 0); PG8_LDB(B1, 0, 1); PG8_SCHED; PG8_LDA(At, 0, 0); PG8_STAGE(PG8_SA(1, 1), a1 + hstep, voffA);
            PG8_WAIT_V(8); PG8_WAIT_L(0); PG8_BAR; PG8_MMA(0, 0, At, B0); PG8_MMA(0, 1, At, B1); PG8_BAR; PG8_SCHED;
            PG8_LDA(At, 0, 1); PG8_STAGE(PG8_SB(0, 0), b2, voffB); PG8_STAGE(PG8_SB(0, 1), b2 + hstep, voffB); PG8_STAGE(PG8_SA(0, 0), a2, voffA);
            PG8_WAIT_V(8); PG8_WAIT_L(0); PG8_BAR; PG8_MMA(1, 0, At, B0); PG8_MMA(1, 1, At, B1); PG8_BAR; PG8_SCHED;
            PG8_LDB(B0, 1, 0); PG8_LDB(B1, 1, 1); PG8_SCHED; PG8_LDA(At, 1, 0); PG8_STAGE(PG8_SA(0, 1), a2 + hstep, voffA);
            PG8_WAIT_V(8); PG8_WAIT_L(0); PG8_BAR; PG8_MMA(0, 0, At, B0); PG8_MMA(0, 1, At, B1); PG8_BAR; PG8_SCHED;
            PG8_LDA(At, 1, 1); PG8_STAGE(PG8_SB(1, 0), b3, voffB); PG8_STAGE(PG8_SB(1, 1), b3 + hstep, voffB); PG8_STAGE(PG8_SA(1, 0), a3, voffA);
            PG8_WAIT_V(8); PG8_WAIT_L(0); PG8_BAR; PG8_MMA(1, 0, At, B0); PG8_MMA(1, 1, At, B1); PG8_BAR; PG8_SCHED;
            } else {
            PG8_LDB(B0, 0, 0); PG8_SCHED; PG8_LDA(At, 0, 0); PG8_STAGE(PG8_SA(1, 1), a1 + hstep, voffA);
            PG8_WAIT_L(8); PG8_BAR; PG8_WAIT_L(0); PG8_MMA(0, 0, At, B0); PG8_BAR; PG8_SCHED;
            PG8_LDB(B1, 0, 1); PG8_STAGE(PG8_SB(0, 0), b2, voffB);
            PG8_BAR; PG8_WAIT_L(0); PG8_MMA(0, 1, At, B1); PG8_BAR;
            PG8_LDA(At, 0, 1); PG8_STAGE(PG8_SA(0, 0), a2, voffA);
            PG8_BAR; PG8_WAIT_L(0); PG8_MMA(1, 0, At, B0); PG8_BAR; PG8_SCHED;
            PG8_STAGE(PG8_SB(0, 1), b2 + hstep, voffB);
            PG8_WAIT_V(6); PG8_BAR; PG8_MMA(1, 1, At, B1); PG8_BAR;
            PG8_LDB(B0, 1, 0); PG8_SCHED; PG8_LDA(At, 1, 0); PG8_STAGE(PG8_SA(0, 1), a2 + hstep, voffA);
            PG8_WAIT_L(8); PG8_BAR; PG8_WAIT_L(0); PG8_MMA(0, 0, At, B0); PG8_BAR; PG8_SCHED;
            PG8_LDB(B1, 1, 1); PG8_STAGE(PG8_SB(1, 0), b3, voffB);
            PG8_BAR; PG8_WAIT_L(0); PG8_MMA(0, 1, At, B1); PG8_BAR;
            PG8_LDA(At, 1, 1); PG8_STAGE(PG8_SA(1, 0), a3, voffA);
            PG8_BAR; PG8_WAIT_L(0); PG8_MMA(1, 0, At, B0); PG8_BAR; PG8_SCHED;
            PG8_STAGE(PG8_SB(1, 1), b3 + hstep, voffB);
            PG8_WAIT_V(6); PG8_BAR; PG8_MMA(1, 1, At, B1); PG8_BAR;
            }
        }
        if constexpr (ALIGN_EPI) { if (wr == 0) PG8_BAR; }
        if constexpr (!Epi::AFTER_DRAIN) { int t2_ = my_tid(); asm volatile("" : "+v"(t2_)); const int l2_ = t2_ & 63, w2_ = __builtin_amdgcn_readfirstlane(t2_ >> 6);
            E(acc, cur, w2_ >> 2, w2_ & 3, l2_ & 15, l2_ >> 4); S.done(cur); }
        if (!has_next) break;
        bool keep_acc_ = false;
        if constexpr (epi_chain<Epi>::value) keep_acc_ = E.chain(cur);
        if (!keep_acc_) {
#pragma unroll
        for (int a = 0; a < 2; ++a)
#pragma unroll
            for (int b = 0; b < 2; ++b)
#pragma unroll
                for (int m = 0; m < 4; ++m)
#pragma unroll
                    for (int n = 0; n < 2; ++n) acc[a][b][m][n] = (f32x4){0.f, 0.f, 0.f, 0.f};
        }
        cur = nxt; cA = nA; cB = nB; ++ui;
        if constexpr (ALIGN_EPI) { if (wr == 1) PG8_BAR; }
    }
    PG8_WAIT_V(0);
    if constexpr (!ALIGN_EPI) { if (wr == 0) PG8_BAR; }
    PG8_BAR;
    if constexpr (Epi::AFTER_DRAIN) { E.fused(acc, cur, wr, wc, fr, fq, lds, wid, lane); S.done(cur); }
#undef PG8_SA
#undef PG8_SB
#undef PG8_STAGE
#undef PG8_LDA
#undef PG8_LDB
#undef PG8_MMA
#undef PG8_WAIT_V
#undef PG8_WAIT_L
#undef PG8_BAR
#undef PG8_SCHED
}
}
constexpr int NWAVES = 8;
constexpr int D = 1024, BATCH = 8, SEQ = 4096, T = BATCH * SEQ, DEPTH = 2, FF = 4096, DPLE = 256;
constexpr int IN_COLS = 6848, RW_COLS = 1792;
constexpr float NORM_EPS = 1e-6f, RW_LN_EPS = 64e-5f;
constexpr float LOG2E = 1.4426950408889634f;
constexpr float MLA_QSCALE = 0.07216878364870322f * LOG2E;
constexpr float CA_QSCALE = 0.125f * LOG2E;
constexpr size_t MiB = 1u << 20;
constexpr size_t WS_CTL = 0, CTL_ZERO_BYTES = 1 * MiB;
constexpr size_t WS_RS1 = 512 * 1024, WS_RS2 = 640 * 1024;
static_assert(DEPTH % 2 == 0, "the residual stream ping-pongs between d_out and WS_U: the last layer must read it from WS_U");
constexpr size_t WS_ROPE = 1 * MiB;
constexpr size_t WS_W = 9 * MiB;
constexpr size_t W_IN = WS_W, W_Q = W_IN + (size_t)6912 * 1024 * 2, W_LORA = W_Q + (size_t)768 * 256 * 2, W_B = W_LORA + (size_t)1536 * 256 * 2,
                 W_OUT = W_B + (size_t)3 * 1024 * 512 * 2, W_1 = W_OUT + (size_t)1024 * 1024 * 2, W_2 = W_1 + (size_t)4096 * 1024 * 2, W_G = W_2 + (size_t)4096 * 1024 * 2,
                 W_P = W_G + (size_t)1024 * 1024 * 2, W_END = W_P + (size_t)1024 * 256 * 2;
constexpr size_t WS_U = 49 * MiB;
constexpr size_t WS_OA = 113 * MiB, WS_OC = 145 * MiB, WS_ORW = 177 * MiB;
constexpr size_t WS_X = 209 * MiB, WS_END = 512 * MiB;
constexpr size_t X_ZC = WS_X, X_QP = X_ZC + (size_t)T * 1536 * 2, X_KV = X_QP + (size_t)T * 768 * 2, X_ZR = X_KV + (size_t)T * 192 * 2, X_TW = X_ZR + (size_t)T * 1792 * 2;
constexpr size_t X_GCT = X_TW + (size_t)T * 512 * 2, X_CBG = X_GCT + (size_t)(T / 16) * 512 * 2;
constexpr size_t X_BND = WS_OC;
constexpr size_t X_QN = WS_OC, X_LA = WS_OC + (size_t)T * 256 * 2;
constexpr size_t DO_G = 0, DO_TA = 32 * MiB, DO_H16 = 64 * MiB;
constexpr size_t X_STG = WS_X + 96 * MiB;
constexpr size_t X_GT = WS_X, X_MG = X_GT + (size_t)T * 3072 * 2;
constexpr size_t X_HID = WS_X, X_PB = WS_X, X_PP = X_PB + (size_t)T * 256 * 2;
static_assert(X_CBG + (size_t)T * 8 * 4 <= WS_END && X_TW + (size_t)T * 512 * 2 <= WS_END && X_MG + (size_t)T * 1024 * 2 <= WS_END && X_HID + (size_t)T * 4096 * 2 <= WS_END, "X map");
constexpr int CW_TMO = 0, CW_QUEUE = 1024  , CW_SUB = 2048  , CW_BAR = 4096;
constexpr int RING_OFF = 0, RING_BYTES = 131072;
constexpr int LDSCTL_OFF = RING_BYTES, MISC_OFF = LDSCTL_OFF + 320;
constexpr int LDS_BYTES = 147456;

#define GAS __attribute__((address_space(1)))
#define LAS __attribute__((address_space(3)))
typedef unsigned short bf16;
typedef unsigned v4u __attribute__((ext_vector_type(4)));
typedef unsigned v2u __attribute__((ext_vector_type(2)));
typedef float f32x4 __attribute__((ext_vector_type(4)));
typedef float f32x16 __attribute__((ext_vector_type(16)));
typedef short bf16x8 __attribute__((ext_vector_type(8)));
typedef short s16x4 __attribute__((ext_vector_type(4)));
#define LDS_WAIT() asm volatile("s_waitcnt lgkmcnt(0)" ::: "memory")
#define VM_WAIT() asm volatile("s_waitcnt vmcnt(0)" ::: "memory")
__device__ __forceinline__ unsigned f2bf(float f) { return h_f2h(f); }
__device__ __forceinline__ unsigned pk2(float lo, float hi) { return h_pk2(lo, hi); }
__device__ __forceinline__ float bfl(unsigned w) { return h_lo(w); }
__device__ __forceinline__ float bfh(unsigned w) { return h_hi(w); }
__device__ __forceinline__ float sigmoidf_(float x) { return 1.0f / (1.0f + __expf(-x)); }
__device__ __forceinline__ float shfl_xor_f(float v, int o, int lane) { return __int_as_float(__builtin_amdgcn_ds_bpermute((lane ^ o) << 2, __float_as_int(v))); }
template <int CTRL> __device__ __forceinline__ float dpp_add_(float v) { return v + __int_as_float(__builtin_amdgcn_update_dpp(0, __float_as_int(v), CTRL, 0xf, 0xf, true)); }
__device__ __forceinline__ float wave_sum(float v, int lane) {
    v = dpp_add_<0xB1>(v); v = dpp_add_<0x4E>(v); v = dpp_add_<0x141>(v); v = dpp_add_<0x140>(v);
    v += shfl_xor_f(v, 16, lane); v += shfl_xor_f(v, 32, lane);
    return v;
}
__device__ __forceinline__ unsigned char* opq(unsigned char* p) { asm volatile("" : "+s"(p)); return p; }
__device__ __forceinline__ float fsig(float x) { return __builtin_amdgcn_rcpf(1.0f + __builtin_amdgcn_exp2f(-LOG2E * x)); }
#define XB_TMO      128
#define XB_XCNT(j)  (256  + 64 * (j))
#define XB_XSUB(j)  (1280 + 64 * (j))
#define XB_XGEN(j)  (2304 + 64 * (j))
#define XB_TOP      3328
#define XB_TOPGEN   3392
#define XCD_BAR_WORDS 3456
#define XB_SPIN_CAP (1u << 25)

__device__ __forceinline__ unsigned xb_ld(unsigned* p)              { return __hip_atomic_load(p, __ATOMIC_RELAXED, __HIP_MEMORY_SCOPE_AGENT); }
__device__ __forceinline__ unsigned xb_add(unsigned* p, unsigned v) { return __hip_atomic_fetch_add(p, v, __ATOMIC_RELAXED, __HIP_MEMORY_SCOPE_AGENT); }
__device__ __forceinline__ unsigned xb_xcc_id() { return (unsigned)__builtin_amdgcn_s_getreg((3 << 11) | 20) & 0xFu; }
#define XB_SPIN(cond, bar) do { unsigned _sp = 0; while (cond) { __builtin_amdgcn_s_sleep(1); \
    if ((++_sp & 255u) == 0u) { if (xb_ld(&(bar)[XB_TMO])) break; if (_sp > XB_SPIN_CAP) { atomicAdd(&(bar)[XB_TMO], 1u); break; } } } } while (0)

struct XcdBarrier {
    unsigned* bar; unsigned x;
    volatile LAS unsigned* st;
};

__device__ __forceinline__ XcdBarrier xcd_barrier_post(unsigned* bar, volatile LAS unsigned* st) {
    XcdBarrier b; b.bar = bar; b.x = xb_xcc_id(); b.st = st;
    if (my_tid() == 0) (void)xb_add(&bar[XB_XCNT(b.x)], 1u);
    return b;
}
__device__ __forceinline__ void xcd_barrier_complete(unsigned* bar, unsigned x, unsigned& nloc, unsigned& nx) {
    const unsigned G = gridDim.x * gridDim.y * gridDim.z;
    unsigned sum, cnt, mine, sp = 0u;
    for (;;) {
        sum = 0u; cnt = 0u; mine = 0u;
#pragma unroll
        for (unsigned j = 0; j < 16; ++j) { const unsigned c = xb_ld(&bar[XB_XCNT(j)]); sum += c; cnt += (c > 0u) ? 1u : 0u; mine = (j == x) ? c : mine; }
        if (sum == G) break;
        __builtin_amdgcn_s_sleep(1);
        if ((++sp & 255u) == 0u) { if (xb_ld(&bar[XB_TMO])) break; if (sp > XB_SPIN_CAP) { atomicAdd(&bar[XB_TMO], 1u); break; } }
    }
    nloc = mine > 0u ? mine : 1u; nx = cnt > 0u ? cnt : 1u;
}

__device__ __forceinline__ void xcd_barrier(const XcdBarrier& b) {
    asm volatile("s_waitcnt vmcnt(0)" ::: "memory");
    __syncthreads();
    if (my_tid() == 0) {
        unsigned* bar = b.bar;
        __builtin_amdgcn_s_waitcnt(0);
        unsigned nloc = b.st[0], nx = b.st[1];
        if (nloc == 0u) { xcd_barrier_complete(bar, b.x, nloc, nx); b.st[0] = nloc; b.st[1] = nx; }
        const unsigned old = xb_add(&bar[XB_XSUB(b.x)], 1u);
        const unsigned gen = old / nloc;
        if (old + 1u == (gen + 1u) * nloc) {
            __builtin_amdgcn_fence(__ATOMIC_RELEASE, "agent");
            asm volatile("s_waitcnt vmcnt(0)" ::: "memory");
            const unsigned og = xb_add(&bar[XB_TOP], 1u);
            const unsigned tg = og / nx;
            if (og + 1u == (tg + 1u) * nx) xb_add(&bar[XB_TOPGEN], 1u);
            else XB_SPIN(xb_ld(&bar[XB_TOPGEN]) == tg, bar);
            __builtin_amdgcn_fence(__ATOMIC_ACQUIRE, "agent");
            xb_add(&bar[XB_XGEN(b.x)], 1u);
            asm volatile("s_waitcnt vmcnt(0)" ::: "memory");
        } else {
            XB_SPIN(xb_ld(&bar[XB_XGEN(b.x)]) == gen, bar);
            __builtin_amdgcn_fence(__ATOMIC_ACQUIRE, "agent");
            asm volatile("s_waitcnt vmcnt(0)" ::: "memory");
        }
    }
    __syncthreads();
}

__device__ __forceinline__ void sub_barrier(unsigned* bar, unsigned* ctr, unsigned n, bool arrive) {
    asm volatile("s_waitcnt vmcnt(0)" ::: "memory");
    __syncthreads();
    if (my_tid() == 0) {
        if (arrive) { __builtin_amdgcn_fence(__ATOMIC_RELEASE, "agent"); asm volatile("s_waitcnt vmcnt(0)" ::: "memory"); (void)xb_add(ctr, 1u); }
        XB_SPIN(xb_ld(ctr) < n, bar);
        __builtin_amdgcn_fence(__ATOMIC_ACQUIRE, "agent");
        asm volatile("s_waitcnt vmcnt(0)" ::: "memory");
    }
    __syncthreads();
}
namespace att {
__device__ __forceinline__ int crow(int r, int hi) { return (r & 3) + 8 * (r >> 2) + 4 * hi; }
__device__ __forceinline__ unsigned cvtpk(float lo, float hi) { return h_pk2(lo, hi); }
typedef short v4i16_t __attribute__((ext_vector_type(4)));
__device__ __forceinline__ s16x4 vtr(const LAS unsigned char* p) { return __builtin_bit_cast(s16x4, __builtin_amdgcn_ds_read_tr16_b64_v4i16((LAS v4i16_t*)p)); }
__device__ __forceinline__ float softmax_tile(f32x16& p0, f32x16& p1, float& m_reg, float& l_reg, bf16x8& pa0, bf16x8& pa1, bf16x8& pa2, bf16x8& pa3) {
    float pmax = p0[0];
#pragma unroll
    for (int r = 1; r < 16; ++r) pmax = fmaxf(pmax, p0[r]);
#pragma unroll
    for (int r = 0; r < 16; ++r) pmax = fmaxf(pmax, p1[r]);
    { auto rr = __builtin_amdgcn_permlane32_swap(__float_as_uint(pmax), __float_as_uint(pmax), false, false); pmax = fmaxf(__uint_as_float(rr[0]), __uint_as_float(rr[1])); }
    float alpha = 1.f;
    if (!__all(pmax - m_reg <= 8.f)) { const float mn = fmaxf(m_reg, pmax); alpha = __builtin_amdgcn_exp2f(m_reg - mn); m_reg = mn; }
    float ps = 0.f;
#pragma unroll
    for (int r = 0; r < 16; ++r) { p0[r] = __builtin_amdgcn_exp2f(p0[r] - m_reg); ps += p0[r]; }
#pragma unroll
    for (int r = 0; r < 16; ++r) { p1[r] = __builtin_amdgcn_exp2f(p1[r] - m_reg); ps += p1[r]; }
    { auto rr = __builtin_amdgcn_permlane32_swap(__float_as_uint(ps), __float_as_uint(ps), false, false); ps = __uint_as_float(rr[0]) + __uint_as_float(rr[1]); }
    l_reg = l_reg * alpha + ps;
#define PK4(P, BASE, OUT) do { unsigned a0 = cvtpk(P[BASE + 0], P[BASE + 1]), a1 = cvtpk(P[BASE + 2], P[BASE + 3]);   \
    unsigned b0 = cvtpk(P[BASE + 4], P[BASE + 5]), b1 = cvtpk(P[BASE + 6], P[BASE + 7]);                              \
    auto r0 = __builtin_amdgcn_permlane32_swap(a0, b0, false, false); auto r1 = __builtin_amdgcn_permlane32_swap(a1, b1, false, false); \
    v4u w = {r0[0], r1[0], r0[1], r1[1]}; OUT = __builtin_bit_cast(bf16x8, w); } while (0)
    PK4(p0, 0, pa0); PK4(p0, 8, pa1); PK4(p1, 0, pa2); PK4(p1, 8, pa3);
#undef PK4
    return alpha;
}
constexpr int MLA_KSTR = 400;
constexpr int MLA_KBUF = 64 * MLA_KSTR;
constexpr int ATT_SCR = 2 * MLA_KBUF;
__device__ __forceinline__ void mla_unit(LAS unsigned char* lds, const bf16* __restrict__ QP, const bf16* __restrict__ KV, bf16* __restrict__ OA, int b, int c) {
    int tid_ = my_tid(); asm volatile("" : "+v"(tid_));
    const int tid = tid_, lane = tid & 63, wid = __builtin_amdgcn_readfirstlane(tid >> 6), r32 = lane & 31, hi = lane >> 5;
    const int h = wid >> 1; const size_t qrow0 = (size_t)b * SEQ + c * 64 + (wid & 1) * 32;
    bf16x8 qr[12];
    { const bf16* qp = QP + (qrow0 + r32) * 768 + h * 192 + hi * 8;
#pragma unroll
      for (int d0 = 0; d0 < 12; ++d0) qr[d0] = *(const GAS bf16x8*)(qp + d0 * 16); }
    float m_reg = -1e30f, l_reg = 0.f; f32x16 o[4];
#pragma unroll
    for (int d = 0; d < 4; ++d)
#pragma unroll
        for (int r = 0; r < 16; ++r) o[d][r] = 0.f;
    LAS float* scr = (LAS float*)(lds + ATT_SCR) + wid * 64;
    const bf16* kvb = KV + (size_t)b * SEQ * 192;
    int skey[3], sch[3];
#pragma unroll
    for (int i = 0; i < 3; ++i) { const int id = tid + 512 * i; skey[i] = id / 24; sch[i] = id % 24; }
    v4u st[3], sn[3];
    const int NT = c + 1;
#pragma unroll
    for (int i = 0; i < 3; ++i) st[i] = *(const GAS v4u*)(kvb + (size_t)skey[i] * 192 + sch[i] * 8);
#pragma unroll
    for (int i = 0; i < 3; ++i) *(LAS v4u*)(lds + skey[i] * MLA_KSTR + sch[i] * 16) = st[i];
    if (NT > 1) {
#pragma unroll
        for (int i = 0; i < 3; ++i) st[i] = *(const GAS v4u*)(kvb + (size_t)(64 + skey[i]) * 192 + sch[i] * 8);
    }
#pragma unroll
    for (int i = 0; i < 3; ++i) sn[i] = st[i];
    asm volatile("" : "+v"(qr[0]), "+v"(qr[1]), "+v"(qr[2]), "+v"(qr[3]), "+v"(qr[4]), "+v"(qr[5]), "+v"(qr[6]), "+v"(qr[7]), "+v"(qr[8]), "+v"(qr[9]), "+v"(qr[10]), "+v"(qr[11]));
    __syncthreads();
    const int troff = (((lane & 15) >> 2) + 8 * hi) * MLA_KSTR + (16 * ((lane >> 4) & 1) + 4 * (lane & 3)) * 2;
    for (int j = 0; j < NT; ++j) {
        const int buf = j & 1;
        if (j + 2 < NT) {
#pragma unroll
            for (int i = 0; i < 3; ++i) sn[i] = *(const GAS v4u*)(kvb + (size_t)(64 * (j + 2) + skey[i]) * 192 + sch[i] * 8);
        }
        const LAS unsigned char* kt = lds + buf * MLA_KBUF;
        f32x16 p0, p1;
#pragma unroll
        for (int r = 0; r < 16; ++r) { p0[r] = 0.f; p1[r] = 0.f; }
        const LAS unsigned char* vb = kt + troff;
        s16x4 vlo[2][4], vhh[2][4];
#define MLA_LDV(G, B) do { _Pragma("unroll") for (int ks = 0; ks < 4; ++ks) { vlo[B][ks] = vtr(vb + (16 * ks) * MLA_KSTR + (G) * 64); vhh[B][ks] = vtr(vb + (16 * ks + 4) * MLA_KSTR + (G) * 64); } } while (0)
        {
            const LAS unsigned char* kb = kt + r32 * MLA_KSTR + hi * 16;
            bf16x8 fa[2][3], fb[2][3];
#define MLA_LDK(G, B) do { _Pragma("unroll") for (int i = 0; i < 3; ++i) { fa[B][i] = *(const LAS bf16x8*)(kb + (3 * (G) + i) * 32); fb[B][i] = *(const LAS bf16x8*)(kb + 32 * MLA_KSTR + (3 * (G) + i) * 32); } } while (0)
            MLA_LDK(0, 0);
            __builtin_amdgcn_sched_barrier(0);
#pragma unroll
            for (int g = 0; g < 4; ++g) {
                if (g < 3) MLA_LDK(g + 1, (g + 1) & 1); else MLA_LDV(0, 0);
                __builtin_amdgcn_sched_barrier(0);
#pragma unroll
                for (int i = 0; i < 3; ++i) { p0 = MFMA32(fa[g & 1][i], qr[3 * g + i], p0); p1 = MFMA32(fb[g & 1][i], qr[3 * g + i], p1); }
                __builtin_amdgcn_sched_barrier(0);
            }
#undef MLA_LDK
        }
        bf16x8 pa0, pa1, pa2, pa3;
        const float alpha = softmax_tile(p0, p1, m_reg, l_reg, pa0, pa1, pa2, pa3);
        if (__any(alpha < 1.f)) { if (hi == 0) scr[r32] = alpha; LDS_WAIT();
#pragma unroll
            for (int r = 0; r < 16; ++r) { const float a = scr[crow(r, hi)];
#pragma unroll
                for (int d = 0; d < 4; ++d) o[d][r] *= a; } }
        __builtin_amdgcn_sched_barrier(0);
#pragma unroll
        for (int d0 = 0; d0 < 4; ++d0) {
            if (d0 < 3) MLA_LDV(d0 + 1, (d0 + 1) & 1);
            __builtin_amdgcn_sched_barrier(0);
#define PK(k) (bf16x8){vlo[d0 & 1][k][0], vlo[d0 & 1][k][1], vlo[d0 & 1][k][2], vlo[d0 & 1][k][3], vhh[d0 & 1][k][0], vhh[d0 & 1][k][1], vhh[d0 & 1][k][2], vhh[d0 & 1][k][3]}
            o[d0] = MFMA32(pa0, PK(0), o[d0]);
            o[d0] = MFMA32(pa1, PK(1), o[d0]);
            o[d0] = MFMA32(pa2, PK(2), o[d0]);
            o[d0] = MFMA32(pa3, PK(3), o[d0]);
#undef PK
            __builtin_amdgcn_sched_barrier(0);
        }
#undef MLA_LDV
        if (j + 1 < NT) {
#pragma unroll
            for (int i = 0; i < 3; ++i) *(LAS v4u*)(lds + (buf ^ 1) * MLA_KBUF + skey[i] * MLA_KSTR + sch[i] * 16) = st[i];
        }
        asm volatile("s_waitcnt lgkmcnt(0)\n\ts_barrier" ::: "memory");
#pragma unroll
        for (int i = 0; i < 3; ++i) st[i] = sn[i];
    }
    if (hi == 0) scr[r32] = l_reg; LDS_WAIT();
    bf16* ob = OA + qrow0 * 512 + h * 128 + r32;
#pragma unroll
    for (int r = 0; r < 16; ++r) { const int orow = crow(r, hi); const float rl = __builtin_amdgcn_rcpf(scr[orow]);
#pragma unroll
        for (int d0 = 0; d0 < 4; ++d0) *(GAS bf16*)(ob + (size_t)orow * 512 + d0 * 32) = (bf16)f2bf(o[d0][r] * rl); }
    __syncthreads();
}
constexpr int CA_KSTR = 144;
constexpr int CA_TBUF = 64 * CA_KSTR;
constexpr int CA_BIAS = ATT_SCR + 8 * 256;
__device__ __forceinline__ void band_unit(LAS unsigned char* lds, const bf16* __restrict__ ZC, const float* __restrict__ relb, bf16* __restrict__ OC, int b, int h, int g) {
    int tid_ = my_tid(); asm volatile("" : "+v"(tid_));
    const int tid = tid_, lane = tid & 63, wid = __builtin_amdgcn_readfirstlane(tid >> 6), r32 = lane & 31, hi = lane >> 5;
    const int cw = 4 * g + (wid >> 1); const size_t qrow0 = (size_t)b * SEQ + cw * 64 + (wid & 1) * 32;
    LAS float* bias = (LAS float*)(lds + CA_BIAS);
    if (tid < 320) bias[tid] = *(const GAS float*)(relb + tid * 8 + h) * LOG2E;
    bf16x8 qr[4];
    { const bf16* qp = ZC + (qrow0 + r32) * 1536 + h * 64 + hi * 8;
#pragma unroll
      for (int d0 = 0; d0 < 4; ++d0) qr[d0] = *(const GAS bf16x8*)(qp + d0 * 16); }
    float m_reg = -1e30f, l_reg = 0.f; f32x16 o[2];
#pragma unroll
    for (int d = 0; d < 2; ++d)
#pragma unroll
        for (int r = 0; r < 16; ++r) o[d][r] = 0.f;
    LAS float* scr = (LAS float*)(lds + ATT_SCR) + wid * 64;
    const int kc0 = (4 * g - 8) < 0 ? 0 : (4 * g - 8), kc1 = 4 * g + 3;
    const bf16* kbase = ZC + (size_t)b * SEQ * 1536 + 512 + h * 64; const bf16* vbase = kbase + 512;
    const int skey = tid >> 3, sch = tid & 7;
    v4u stk, stv, snk, snv;
    stk = *(const GAS v4u*)(kbase + (size_t)(64 * kc0 + skey) * 1536 + sch * 8); stv = *(const GAS v4u*)(vbase + (size_t)(64 * kc0 + skey) * 1536 + sch * 8);
    *(LAS v4u*)(lds + skey * CA_KSTR + sch * 16) = stk; *(LAS v4u*)(lds + CA_TBUF + skey * CA_KSTR + sch * 16) = stv;
    if (kc0 < kc1) { stk = *(const GAS v4u*)(kbase + (size_t)(64 * (kc0 + 1) + skey) * 1536 + sch * 8); stv = *(const GAS v4u*)(vbase + (size_t)(64 * (kc0 + 1) + skey) * 1536 + sch * 8); }
    snk = stk; snv = stv;
    asm volatile("" : "+v"(qr[0]), "+v"(qr[1]), "+v"(qr[2]), "+v"(qr[3]));
    __syncthreads();
    const int troff = (((lane & 15) >> 2) + 8 * hi) * CA_KSTR + (16 * ((lane >> 4) & 1) + 4 * (lane & 3)) * 2;
    const int qin = (wid & 1) * 32 + r32;
    for (int kc = kc0; kc <= kc1; ++kc) {
        const int buf = (kc - kc0) & 1;
        if (kc + 1 < kc1) { snk = *(const GAS v4u*)(kbase + (size_t)(64 * (kc + 2) + skey) * 1536 + sch * 8); snv = *(const GAS v4u*)(vbase + (size_t)(64 * (kc + 2) + skey) * 1536 + sch * 8); }
        if (kc >= cw - 8 && kc <= cw) {
            const LAS unsigned char* kt = lds + buf * 2 * CA_TBUF;
            f32x16 p0, p1;
            const int dbase = (cw - kc) * 64 + qin + 63;
#pragma unroll
            for (int r = 0; r < 16; ++r) { int i0 = dbase - crow(r, hi), i1 = i0 - 32; i0 = i0 > 319 ? 319 : i0; i1 = i1 > 319 ? 319 : i1; p0[r] = bias[i0]; p1[r] = bias[i1]; }
            const LAS unsigned char* vb = kt + CA_TBUF + troff;
            s16x4 vlo[2][4], vhh[2][4];
#define CA_LDV(G) do { _Pragma("unroll") for (int ks = 0; ks < 4; ++ks) { vlo[G][ks] = vtr(vb + (16 * ks) * CA_KSTR + (G) * 64); vhh[G][ks] = vtr(vb + (16 * ks + 4) * CA_KSTR + (G) * 64); } } while (0)
            {
                const LAS unsigned char* kb = kt + r32 * CA_KSTR + hi * 16;
                bf16x8 fa[4], fb[4];
#pragma unroll
                for (int d0 = 0; d0 < 4; ++d0) { fa[d0] = *(const LAS bf16x8*)(kb + d0 * 32); fb[d0] = *(const LAS bf16x8*)(kb + 32 * CA_KSTR + d0 * 32); }
                CA_LDV(0);
                __builtin_amdgcn_sched_barrier(0);
#pragma unroll
                for (int d0 = 0; d0 < 4; ++d0) { p0 = MFMA32(fa[d0], qr[d0], p0); p1 = MFMA32(fb[d0], qr[d0], p1); }
                __builtin_amdgcn_sched_barrier(0);
            }
            bf16x8 pa0, pa1, pa2, pa3;
            const float alpha = softmax_tile(p0, p1, m_reg, l_reg, pa0, pa1, pa2, pa3);
            if (__any(alpha < 1.f)) { if (hi == 0) scr[r32] = alpha; LDS_WAIT();
#pragma unroll
                for (int r = 0; r < 16; ++r) { const float a = scr[crow(r, hi)]; o[0][r] *= a; o[1][r] *= a; } }
            __builtin_amdgcn_sched_barrier(0);
            CA_LDV(1);
            __builtin_amdgcn_sched_barrier(0);
#pragma unroll
            for (int d0 = 0; d0 < 2; ++d0) {
#define PK(k) (bf16x8){vlo[d0][k][0], vlo[d0][k][1], vlo[d0][k][2], vlo[d0][k][3], vhh[d0][k][0], vhh[d0][k][1], vhh[d0][k][2], vhh[d0][k][3]}
                o[d0] = MFMA32(pa0, PK(0), o[d0]);
                o[d0] = MFMA32(pa1, PK(1), o[d0]);
                o[d0] = MFMA32(pa2, PK(2), o[d0]);
                o[d0] = MFMA32(pa3, PK(3), o[d0]);
#undef PK
            }
            __builtin_amdgcn_sched_barrier(0);
#undef CA_LDV
        }
        if (kc < kc1) { *(LAS v4u*)(lds + (buf ^ 1) * 2 * CA_TBUF + skey * CA_KSTR + sch * 16) = stk; *(LAS v4u*)(lds + (buf ^ 1) * 2 * CA_TBUF + CA_TBUF + skey * CA_KSTR + sch * 16) = stv; }
        asm volatile("s_waitcnt lgkmcnt(0)\n\ts_barrier" ::: "memory");
        stk = snk; stv = snv;
    }
    if (hi == 0) scr[r32] = l_reg; LDS_WAIT();
    bf16* ob = OC + qrow0 * 512 + h * 64 + r32;
#pragma unroll
    for (int r = 0; r < 16; ++r) { const int orow = crow(r, hi); const float rl = __builtin_amdgcn_rcpf(scr[orow]);
        *(GAS bf16*)(ob + (size_t)orow * 512) = (bf16)f2bf(o[0][r] * rl); *(GAS bf16*)(ob + (size_t)orow * 512 + 32) = (bf16)f2bf(o[1][r] * rl); }
    __syncthreads();
}
}
struct Args { const float* in[30]; float* out; unsigned char* ws; int start; int stop; };
#define KAS __attribute__((address_space(4)))
__device__ __forceinline__ const KAS unsigned char* kbase() { const KAS unsigned char* p = (const KAS unsigned char*)__builtin_amdgcn_kernarg_segment_ptr(); asm volatile("" : "+s"(p)); return p; }
__device__ __forceinline__ const float* kin(int i) { return *(const float* const KAS*)(kbase() + 8 * i); }
__device__ __forceinline__ float* kout() { return *(float* const KAS*)(kbase() + 240); }
__device__ __forceinline__ unsigned char* kws() { return *(unsigned char* const KAS*)(kbase() + 248); }
__device__ __forceinline__ int kstart() { return *(const int KAS*)(kbase() + 256); }
__device__ __forceinline__ int kstop() { return *(const int KAS*)(kbase() + 260); }
struct Frame { LAS unsigned char* lds; int tid, lane, wave, G, gw, NGW; };
__device__ __forceinline__ Frame make_frame(LAS unsigned char* lds) {
    Frame F; int tid = my_tid(); asm volatile("" : "+v"(tid)); int bx = blockIdx.x; asm volatile("" : "+s"(bx)); int G = gridDim.x; asm volatile("" : "+s"(G));
    F.lds = lds; F.tid = tid; F.lane = tid & 63; F.wave = __builtin_amdgcn_readfirstlane(tid >> 6); F.G = G; F.gw = bx * NWAVES + F.wave; F.NGW = G * NWAVES; return F;
}

__device__ const double ROPE_INV_FREQ[32] = {1, 0.74989420933245587, 0.56234132519034907, 0.42169650342858223, 0.31622776601683794, 0.23713737056616552, 0.17782794100389229, 0.1333521432163324, 0.10000000000000001, 0.074989420933245579, 0.056234132519034911, 0.042169650342858224, 0.031622776601683791, 0.023713737056616554, 0.017782794100389229, 0.013335214321633241, 0.01, 0.0074989420933245579, 0.005623413251903491, 0.0042169650342858229, 0.0031622776601683794, 0.0023713737056616554, 0.0017782794100389228, 0.0013335214321633241, 0.001, 0.00074989420933245586, 0.0005623413251903491, 0.00042169650342858224, 0.00031622776601683794, 0.00023713737056616554, 0.00017782794100389227, 0.0001333521432163324};
__device__ __forceinline__ void sincos_d(double a, float& s, float& c) {
    const double n = rint(a * 0.63661977236758134308);
    double r = fma(-n, 1.5707963267948966192, a); r = fma(-n, 6.123233995736766036e-17, r);
    const double r2 = r * r;
    double sp = -7.6471637318198164759e-13; sp = fma(sp, r2, 1.6059043836821614599e-10); sp = fma(sp, r2, -2.5052108385441718775e-08); sp = fma(sp, r2, 2.7557319223985890653e-06);
    sp = fma(sp, r2, -1.9841269841269841270e-04); sp = fma(sp, r2, 8.3333333333333333333e-03); sp = fma(sp, r2, -1.6666666666666666667e-01);
    const double sn = fma(sp * r2, r, r);
    double cp = 4.7794773323873852974e-14; cp = fma(cp, r2, -1.1470745597729724714e-11); cp = fma(cp, r2, 2.0876756987868098979e-09); cp = fma(cp, r2, -2.7557319223985890653e-07);
    cp = fma(cp, r2, 2.4801587301587301587e-05); cp = fma(cp, r2, -1.3888888888888888889e-03); cp = fma(cp, r2, 4.1666666666666666667e-02); cp = fma(cp, r2, -0.5);
    const double cs = fma(cp, r2, 1.0);
    const long long q = (long long)n & 3LL; double so, co;
    if (q == 0) { so = sn; co = cs; } else if (q == 1) { so = cs; co = -sn; } else if (q == 2) { so = -sn; co = -cs; } else { so = -cs; co = sn; }
    s = (float)so; c = (float)co;
}
__device__ __forceinline__ void transpose_item(const float* W, int ldw, int col0, int nblk, bf16* WT, int ldt, int row0, LAS float* scr, int item, int lane, const float* gk = nullptr) {
    const int kb = item / nblk, nb = item % nblk, k0 = 64 * kb, n0 = 32 * nb;
    float tv[32];
#pragma unroll
    for (int i = 0; i < 32; ++i) tv[i] = *(const GAS float*)(W + (size_t)(k0 + 2 * i + (lane >> 5)) * ldw + col0 + n0 + (lane & 31));
#pragma unroll
    for (int i = 0; i < 32; ++i) scr[(2 * i + (lane >> 5)) * 33 + (lane & 31)] = tv[i];
    LDS_WAIT(); asm volatile("" ::: "memory");
    const int c = lane & 7;
    f32x4 ga = {1.f, 1.f, 1.f, 1.f}, gb = {1.f, 1.f, 1.f, 1.f};
    if (gk) { ga = *(const GAS f32x4*)(gk + k0 + 8 * c); gb = *(const GAS f32x4*)(gk + k0 + 8 * c + 4); }
#pragma unroll
    for (int j = 0; j < 4; ++j) { const int n = (lane >> 3) + 8 * j; const LAS float* s = scr + (8 * c) * 33 + n;
        v4u o; o.x = pk2(s[0 * 33] * ga[0], s[1 * 33] * ga[1]); o.y = pk2(s[2 * 33] * ga[2], s[3 * 33] * ga[3]); o.z = pk2(s[4 * 33] * gb[0], s[5 * 33] * gb[1]); o.w = pk2(s[6 * 33] * gb[2], s[7 * 33] * gb[3]);
        *(GAS v4u*)(WT + (size_t)(row0 + n0 + n) * ldt + k0 + 8 * c) = o; }
    LDS_WAIT(); asm volatile("" ::: "memory");
}
__device__ __forceinline__ void rope_table(LAS unsigned char* lds_) {
    const Frame F = make_frame(lds_); const int gt = F.gw * 64 + F.lane, NTH = F.NGW * 64;
    const int* pos = (const int*)kin(2); float* rope = (float*)(kws() + WS_ROPE);
    for (int i = gt; i < T * 32; i += NTH) { float s, c; sincos_d((double)pos[i >> 5] * ROPE_INV_FREQ[i & 31], s, c); rope[2 * (size_t)i] = c; rope[2 * (size_t)i + 1] = s; }
}
__device__ __forceinline__ void p0_prologue(LAS unsigned char* lds_, const Args& A, int l) {
    const Frame F = make_frame(lds_);
    LAS float* scr = (LAS float*)(F.lds + RING_OFF + F.wave * 16384);
    constexpr int I1 = 16 * 14, I2 = 16 * 48, I3 = 16 * 56, I4 = 16 * 96, I5 = 8 * 32, I6 = 8 * 32, I7 = 16 * 32, I8 = 16 * 128, I9 = 64 * 32, I10 = 16 * 32, I11 = 4 * 32;
    constexpr int NITEMS = I1 + I2 + I3 + I4 + I5 + I6 + I7 + I8 + I9 + I10 + I11;
#define WIN_ (kin(4) + (size_t)l * 1024 * IN_COLS)
#define WBR_ (kin(21) + (size_t)l * 1536 * 1024)
    for (int it = F.gw; it < NITEMS; it += F.NGW) {
        int r = it;
        if (r < I1) { transpose_item(WIN_, IN_COLS, 0, 14, (bf16*)(kws() + W_IN), 1024, 0, scr, r, F.lane, kin(3) + l * 1024); continue; } r -= I1;
        if (r < I2) { transpose_item(WIN_, IN_COLS, 2240, 48, (bf16*)(kws() + W_IN), 1024, 512, scr, r, F.lane, kin(3) + l * 1024); continue; } r -= I2;
        if (r < I3) { transpose_item(WIN_, IN_COLS, 448, 56, (bf16*)(kws() + W_IN), 1024, 2048, scr, r, F.lane, kin(3) + l * 1024); continue; } r -= I3;
        if (r < I4) { transpose_item(WIN_, IN_COLS, 3776, 96, (bf16*)(kws() + W_IN), 1024, 3840, scr, r, F.lane, kin(3) + l * 1024); continue; } r -= I4;
        if (r < I5) { transpose_item(WBR_ + (size_t)512 * 1024, 1024, 0, 32, (bf16*)(kws() + W_B) + (size_t)1024 * 512, 512, 0, scr, r, F.lane); continue; } r -= I5;
        if (r < I6) { transpose_item(WBR_ + (size_t)1024 * 1024, 1024, 0, 32, (bf16*)(kws() + W_B) + (size_t)2 * 1024 * 512, 512, 0, scr, r, F.lane); continue; } r -= I6;
        if (r < I7) { transpose_item(kin(22) + (size_t)l * 1024 * 1024, 1024, 0, 32, (bf16*)(kws() + W_OUT), 1024, 0, scr, r, F.lane); continue; } r -= I7;
        if (r < I8) { transpose_item(kin(25) + (size_t)l * 1024 * 4096, 4096, 0, 128, (bf16*)(kws() + W_1), 1024, 0, scr, r, F.lane, kin(24) + l * 1024); continue; } r -= I8;
        if (r < I9) { transpose_item(kin(26) + (size_t)l * 4096 * 1024, 1024, 0, 32, (bf16*)(kws() + W_2), 4096, 0, scr, r, F.lane); continue; } r -= I9;
        if (r < I10) { transpose_item(kin(28) + (size_t)l * 1024 * 1024, 1024, 0, 32, (bf16*)(kws() + W_G), 1024, 0, scr, r, F.lane); continue; } r -= I10;
        transpose_item(kin(29) + (size_t)l * 256 * 1024, 1024, 0, 32, (bf16*)(kws() + W_P), 256, 0, scr, r, F.lane);
    }
    const int gt = F.gw * 64 + F.lane, NTH = F.NGW * 64;
    { bf16* WinT = (bf16*)(kws() + W_IN); for (int i = gt; i < 64 * 1024; i += NTH) WinT[(size_t)448 * 1024 + i] = 0; }
    { const float* w_uq = kin(7) + (size_t)l * 256 * 768; const float* w_ukv = kin(8) + (size_t)l * 128 * 1024; bf16* WqT = (bf16*)(kws() + W_Q);
      if ((F.gw & 3) != 0) for (int it = (F.gw >> 2) * 3 + (F.gw & 3) - 1; it < 768 * 4; it += (F.NGW >> 2) * 3) {
        const int n = it >> 2, kq = 64 * (it & 3) + F.lane, h = n / 192, ii = n % 192; float s;
        if (ii < 128) { const GAS f32x4* a = (const GAS f32x4*)(w_uq + (size_t)kq * 768 + h * 192); const GAS f32x4* b = (const GAS f32x4*)(w_ukv + (size_t)ii * 1024 + h * 256);
            f32x4 acc = {0.f, 0.f, 0.f, 0.f};
#pragma unroll 8
            for (int q = 0; q < 32; ++q) { const f32x4 av = a[q], bv = b[q]; acc[0] = fmaf(av[0], bv[0], acc[0]); acc[1] = fmaf(av[1], bv[1], acc[1]); acc[2] = fmaf(av[2], bv[2], acc[2]); acc[3] = fmaf(av[3], bv[3], acc[3]); }
            s = (acc[0] + acc[1]) + (acc[2] + acc[3]); }
        else { const int jj = ii - 128, j = jj >> 1; s = w_uq[(size_t)kq * 768 + h * 192 + 128 + ((jj & 1) ? j + 32 : j)]; }
        WqT[(size_t)n * 256 + kq] = (bf16)f2bf(s);
      } }
    { const float* w_ukv = kin(8) + (size_t)l * 128 * 1024; const float* w_br = WBR_; bf16* WbT = (bf16*)(kws() + W_B);
      if ((F.gw & 3) == 0) for (int it = F.gw >> 2; it < 512; it += (F.NGW >> 2)) {
        const int h = it >> 7, lat0 = 4 * ((it >> 2) & 31), dd4 = 256 * (it & 3) + 4 * F.lane;
        const float* ab = w_ukv + (size_t)lat0 * 1024 + h * 256 + 128; const float* bb = w_br + (size_t)(h * 128) * 1024 + dd4;
        f32x4 acc[4] = {{0.f, 0.f, 0.f, 0.f}, {0.f, 0.f, 0.f, 0.f}, {0.f, 0.f, 0.f, 0.f}, {0.f, 0.f, 0.f, 0.f}};
#pragma unroll 4
        for (int v4 = 0; v4 < 128; v4 += 4) { f32x4 bv[4], av[4];
#pragma unroll
            for (int e = 0; e < 4; ++e) { bv[e] = *(const GAS f32x4*)(bb + (size_t)(v4 + e) * 1024); av[e] = *(const GAS f32x4*)(ab + (size_t)e * 1024 + v4); }
#pragma unroll
            for (int j = 0; j < 4; ++j)
#pragma unroll
                for (int e = 0; e < 4; ++e) acc[j] = acc[j] + bv[e] * av[j][e]; }
#pragma unroll
        for (int e = 0; e < 4; ++e) { v2u o; o.x = pk2(acc[0][e], acc[1][e]); o.y = pk2(acc[2][e], acc[3][e]); *(GAS v2u*)(WbT + (size_t)(dd4 + e) * 512 + h * 128 + lat0) = o; }
      } }
    { const float* w_up = kin(11) + (size_t)l * 64 * 512; const float* a_up = kin(13) + (size_t)l * 64 * 512; const float* g_up = kin(14) + (size_t)l * 128 * 512; bf16* WloT = (bf16*)(kws() + W_LORA);
      for (int i = gt; i < 1536 * 256; i += NTH) {
        const int n = i >> 8, k = i & 255, blk = n >> 9, nn = n & 511; float s = 0.f;
        if (blk == 0) { if (k < 64) s = w_up[(size_t)k * 512 + nn]; } else if (blk == 1) { if (k >= 64 && k < 128) s = a_up[(size_t)(k - 64) * 512 + nn]; } else { if (k >= 128) s = g_up[(size_t)(k - 128) * 512 + nn]; }
        WloT[i] = (bf16)f2bf(s);
      } }
#undef WIN_
#undef WBR_
}
__device__ __forceinline__ void h_rowpass(LAS unsigned char* lds_, bf16* Hc, bool from_x) {
    const Frame F = make_frame(lds_); float* RS = (float*)(kws() + WS_RS1);
    for (int m = F.gw; m < T; m += F.NGW) {
        f32x4 v[4]; float s = 0.f;
        if (from_x) { const GAS f32x4* xr = (const GAS f32x4*)(kin(0) + (size_t)m * D) + F.lane; GAS v2u* ho = (GAS v2u*)(Hc + (size_t)m * D) + F.lane;
#pragma unroll
            for (int j = 0; j < 4; ++j) { v[j] = xr[64 * j]; v2u w; w.x = pk2(v[j].x, v[j].y); w.y = pk2(v[j].z, v[j].w); ho[64 * j] = w; v[j] = (f32x4){bfl(w.x), bfh(w.x), bfl(w.y), bfh(w.y)}; } }
        else { const GAS v2u* hr = (const GAS v2u*)(Hc + (size_t)m * D) + F.lane;
#pragma unroll
            for (int j = 0; j < 4; ++j) { const v2u w = hr[64 * j]; v[j] = (f32x4){bfl(w.x), bfh(w.x), bfl(w.y), bfh(w.y)}; } }
#pragma unroll
        for (int j = 0; j < 4; ++j) s += (v[j].x * v[j].x + v[j].y * v[j].y) + (v[j].z * v[j].z + v[j].w * v[j].w);
        const float rs = rsqrtf(wave_sum(s, F.lane) * (1.f / D) + NORM_EPS);
        if (F.lane == 0) RS[m] = rs;
    }
}
__device__ __forceinline__ void p2_mla_prep(LAS unsigned char* lds_, int l, int wg0, int nwg) {
    const Frame F = make_frame(lds_); const int gw = F.gw - wg0 * NWAVES, NGW = nwg * NWAVES;
    const bf16* ZM = (const bf16*)(kws() + WS_OA); bf16* QN = (bf16*)(kws() + X_QN); bf16* KV = (bf16*)(kws() + X_KV); const float* rope = (const float*)(kws() + WS_ROPE);
    const f32x4 gq = *(const f32x4*)(kin(5) + l * 256 + 4 * F.lane); const float gk0 = kin(6)[l * 128 + 2 * F.lane], gk1 = kin(6)[l * 128 + 2 * F.lane + 1];
    for (int g = gw; g < T / 4; g += NGW) {
        v2u wq[4]; unsigned wk[4]; unsigned short wr[4]; float rc[4], rsn[4];
#pragma unroll
        for (int i = 0; i < 4; ++i) { const int t = 4 * g + i; const bf16* z = ZM + (size_t)t * 512;
            wq[i] = *(const GAS v2u*)(z + 4 * F.lane); wk[i] = *(const GAS unsigned*)(z + 256 + 2 * F.lane); wr[i] = *(const GAS unsigned short*)(z + 384 + F.lane);
            rc[i] = *(const GAS float*)(rope + ((size_t)t * 32 + (F.lane & 31)) * 2); rsn[i] = *(const GAS float*)(rope + ((size_t)t * 32 + (F.lane & 31)) * 2 + 1); }
        asm volatile("" : "+v"(wq[0]), "+v"(wq[1]), "+v"(wq[2]), "+v"(wq[3]), "+v"(wk[0]), "+v"(wk[1]), "+v"(wk[2]), "+v"(wk[3]));
#pragma unroll
        for (int i = 0; i < 4; ++i) { const int t = 4 * g + i;
            const float kr = bfl((unsigned)wr[i]);
            const float q0 = bfl(wq[i].x), q1 = bfh(wq[i].x), q2 = bfl(wq[i].y), q3 = bfh(wq[i].y), k0 = bfl(wk[i]), k1 = bfh(wk[i]);
            const float rq = rsqrtf(wave_sum(q0 * q0 + q1 * q1 + q2 * q2 + q3 * q3, F.lane) * (1.f / 256.f) + NORM_EPS);
            const float rk = rsqrtf(wave_sum(k0 * k0 + k1 * k1, F.lane) * (1.f / 128.f) + NORM_EPS);
            v2u o; o.x = pk2(q0 * rq * gq.x, q1 * rq * gq.y); o.y = pk2(q2 * rq * gq.z, q3 * rq * gq.w);
            *(GAS v2u*)(QN + (size_t)t * 256 + 4 * F.lane) = o;
            *(GAS unsigned*)(KV + (size_t)t * 192 + 2 * F.lane) = pk2(k0 * rk * gk0, k1 * rk * gk1);
            const float other = shfl_xor_f(kr, 32, F.lane);
            if (F.lane < 32) *(GAS unsigned*)(KV + (size_t)t * 192 + 128 + 2 * F.lane) = pk2(kr * rc[i] - other * rsn[i], other * rc[i] + kr * rsn[i]); }
    }
}
__device__ __forceinline__ void p6_rw_prep(LAS unsigned char* lds_, int l) {
    const Frame F = make_frame(lds_);
    const bf16* ZR = (const bf16*)(kws() + X_ZR); bf16* LA = (bf16*)(kws() + X_LA);
    const f32x4 mu = *(const f32x4*)(kin(9) + l * RW_COLS + 1536 + 4 * F.lane);
    { bf16* BND = (bf16*)(kws() + X_BND);
      for (int s = F.gw; s < T / 16; s += F.NGW) { if (((16 * s) & (SEQ - 1)) == 0) continue;
#pragma unroll
        for (int j = 0; j < 3; ++j) *(GAS v4u*)(BND + (size_t)s * 1536 + 8 * (F.lane + 64 * j)) = *(const GAS v4u*)(ZR + (size_t)(16 * s - 1) * 1792 + 8 * (F.lane + 64 * j)); } }
    for (int g = F.gw; g < T / 4; g += F.NGW) {
        const int t0 = 4 * g; v2u w[5];
        w[0].x = 0u; w[0].y = 0u;
        if ((t0 & (SEQ - 1)) != 0) w[0] = *(const GAS v2u*)(ZR + (size_t)(t0 - 1) * 1792 + 1536 + 4 * F.lane);
#pragma unroll
        for (int i = 0; i < 4; ++i) w[i + 1] = *(const GAS v2u*)(ZR + (size_t)(t0 + i) * 1792 + 1536 + 4 * F.lane);
        asm volatile("" : "+v"(w[0]), "+v"(w[1]), "+v"(w[2]), "+v"(w[3]), "+v"(w[4]));
#pragma unroll
        for (int i = 0; i < 4; ++i) { const v2u wc = w[i + 1], wp = w[i];
            float z[4] = {bfl(wc.x), bfh(wc.x), bfl(wc.y), bfh(wc.y)}; const float p[4] = {bfl(wp.x), bfh(wp.x), bfl(wp.y), bfh(wp.y)}; const float m[4] = {mu.x, mu.y, mu.z, mu.w};
#pragma unroll
            for (int e = 0; e < 4; ++e) { float v = z[e] + (p[e] - z[e]) * m[e]; if (F.lane < 16) v = 1.f - 2.f * __builtin_amdgcn_rcpf(1.f + __builtin_amdgcn_exp2f(2.f * LOG2E * v)); else if (F.lane >= 32) v = fsig(v); z[e] = v; }
            v2u o; o.x = pk2(z[0], z[1]); o.y = pk2(z[2], z[3]); *(GAS v2u*)(LA + (size_t)(t0 + i) * 256 + 4 * F.lane) = o; }
    }
}
template <int MODE>
__device__ __forceinline__ void rowpass(LAS unsigned char* lds_, bf16* Hc, const bf16* M, const float* g1, const float* pl) {
    const Frame F = make_frame(lds_);
    bf16* PB = (bf16*)(kws() + X_PB); float* RS = (float*)(kws() + WS_RS2);
    f32x4 g1v[4];
#pragma unroll
    for (int j = 0; j < 4; ++j) g1v[j] = *(const f32x4*)(g1 + 4 * F.lane + 256 * j);
    for (int m = F.gw; m < T; m += F.NGW) {
        const GAS v2u* mr = (const GAS v2u*)(M + (size_t)m * D) + F.lane; GAS v2u* hr = (GAS v2u*)(Hc + (size_t)m * D) + F.lane;
        f32x4 x[4], hv[4]; float s = 0.f;
#pragma unroll
        for (int j = 0; j < 4; ++j) { const v2u w = mr[64 * j]; x[j] = (f32x4){bfl(w.x), bfh(w.x), bfl(w.y), bfh(w.y)}; const v2u hw = hr[64 * j]; hv[j] = (f32x4){bfl(hw.x), bfh(hw.x), bfl(hw.y), bfh(hw.y)};
            s += (x[j].x * x[j].x + x[j].y * x[j].y) + (x[j].z * x[j].z + x[j].w * x[j].w); }
        const float rs = rsqrtf(wave_sum(s, F.lane) * (1.f / D) + NORM_EPS); float s2 = 0.f;
#pragma unroll
        for (int j = 0; j < 4; ++j) { hv[j] = hv[j] + x[j] * rs * g1v[j]; v2u w; w.x = pk2(hv[j].x, hv[j].y); w.y = pk2(hv[j].z, hv[j].w); hr[64 * j] = w;
            const f32x4 hq = (f32x4){bfl(w.x), bfh(w.x), bfl(w.y), bfh(w.y)};
            s2 += (hq.x * hq.x + hq.y * hq.y) + (hq.z * hq.z + hq.w * hq.w); }
        if (MODE == 0) { const float rs2 = rsqrtf(wave_sum(s2, F.lane) * (1.f / D) + NORM_EPS); if (F.lane == 0) RS[m] = rs2; }
        else { const f32x4 pv = *((const GAS f32x4*)(pl + (size_t)m * DPLE) + F.lane); v2u w; w.x = pk2(pv.x, pv.y); w.y = pk2(pv.z, pv.w); *((GAS v2u*)(PB + (size_t)m * DPLE) + F.lane) = w; }
    }
}
namespace rw {
typedef short v4i16_t __attribute__((ext_vector_type(4)));
constexpr int RS = 144;
constexpr int O_AT = 0, O_BT = 9216, O_KT = 18432, O_RT = 27648;
constexpr int O_UV = 36864;
constexpr int O_BK = O_UV + 4 * 32 * RS;
constexpr int O_SB = O_BK + 4 * 32 * RS;
constexpr int O_W1 = O_SB + 64 * RS;
constexpr int O_SM = O_W1 + 64 * RS;
constexpr int O_GC = O_SM + 16 * 1024;
constexpr int O_CB = O_GC + 1024;
constexpr int O_LM = O_CB + 256;
constexpr int O_YO = O_LM + 4096;
constexpr int O_PAR = O_YO + 64 * RS;
constexpr int LDS_END = O_PAR + 512;
static_assert(LDS_END <= RING_BYTES, "rwkv LDS map");
__device__ __forceinline__ bf16x8 trfrag(const LAS unsigned char* p) {
    const s16x4 lo = __builtin_bit_cast(s16x4, __builtin_amdgcn_ds_read_tr16_b64_v4i16((LAS v4i16_t*)p));
    const s16x4 hh = __builtin_bit_cast(s16x4, __builtin_amdgcn_ds_read_tr16_b64_v4i16((LAS v4i16_t*)(p + 4 * RS)));
    return (bf16x8){lo[0], lo[1], lo[2], lo[3], hh[0], hh[1], hh[2], hh[3]};
}
__device__ __forceinline__ unsigned pk_rtz(float lo, float hi) { typedef __fp16 hp2 __attribute__((ext_vector_type(2))); const hp2 v = __builtin_amdgcn_cvt_pkrtz(lo, hi); return __builtin_bit_cast(unsigned, v); }
typedef _Float16 h16x4_t __attribute__((ext_vector_type(4)));
__device__ __forceinline__ h16x4_t tr4(const LAS unsigned char* p) { return __builtin_bit_cast(h16x4_t, __builtin_amdgcn_ds_read_tr16_b64_v4i16((LAS v4i16_t*)p)); }
__device__ __forceinline__ h16x4_t ld4h(const LAS unsigned char* p) { return *(const LAS h16x4_t*)p; }
__device__ __forceinline__ h16x4_t acc2h(const f32x4 v) { typedef unsigned u2 __attribute__((ext_vector_type(2))); u2 w; w.x = pk_rtz(v[0], v[1]); w.y = pk_rtz(v[2], v[3]); return __builtin_bit_cast(h16x4_t, w); }
__device__ __forceinline__ f32x4 MFMA4(h16x4_t a, h16x4_t b, f32x4 c) { return __builtin_amdgcn_mfma_f32_16x16x16f16(a, b, c, 0, 0, 0); }
__device__ __forceinline__ void lbar() { asm volatile("s_waitcnt lgkmcnt(0)\n\ts_barrier" ::: "memory"); }
__device__ __forceinline__ void st_bf(LAS unsigned char* p, float x) { *(LAS unsigned short*)p = (unsigned short)h_f2h(__builtin_amdgcn_fmed3f(x, -60000.f, 60000.f)); }
__device__ __forceinline__ void st2(LAS unsigned char* p0, LAS unsigned char* p1, float x0, float x1) { const unsigned w = pk_rtz(x0, x1); *(LAS unsigned short*)p0 = (unsigned short)w; *(LAS unsigned short*)p1 = (unsigned short)(w >> 16); }
__device__ __forceinline__ void st4(LAS unsigned char* p, int stride, const f32x4 v) { st2(p, p + stride, v[0], v[1]); st2(p + 2 * stride, p + 3 * stride, v[2], v[3]); }
__device__ __forceinline__ float ld_bf(const LAS unsigned char* p) { return bfl((unsigned)*(const LAS unsigned short*)p); }
template <int CTRL> __device__ __forceinline__ float dpp_add(float v) { return v + __int_as_float(__builtin_amdgcn_update_dpp(0, __float_as_int(v), CTRL, 0xf, 0xf, true)); }
__device__ __forceinline__ void wsum8(float (&v)[8], int lane) {
#pragma unroll
    for (int e = 0; e < 8; ++e) { float x = v[e]; x = dpp_add<0xB1>(x); x = dpp_add<0x4E>(x); x = dpp_add<0x141>(x); x = dpp_add<0x140>(x); v[e] = x; }
#pragma unroll
    for (int e = 0; e < 8; ++e) v[e] += shfl_xor_f(v[e], 16, lane);
#pragma unroll
    for (int e = 0; e < 8; ++e) v[e] += shfl_xor_f(v[e], 32, lane);
}
__device__ __forceinline__ void wsum16(float (&a)[8], float (&b)[8], int lane) {
#pragma unroll
    for (int e = 0; e < 8; ++e) { float x = a[e]; x = dpp_add<0xB1>(x); x = dpp_add<0x4E>(x); x = dpp_add<0x141>(x); x = dpp_add<0x140>(x); a[e] = x;
                                  float y = b[e]; y = dpp_add<0xB1>(y); y = dpp_add<0x4E>(y); y = dpp_add<0x141>(y); y = dpp_add<0x140>(y); b[e] = y; }
    float ta[8], tb[8];
#pragma unroll
    for (int e = 0; e < 8; ++e) { ta[e] = shfl_xor_f(a[e], 16, lane); tb[e] = shfl_xor_f(b[e], 16, lane); }
#pragma unroll
    for (int e = 0; e < 8; ++e) { a[e] += ta[e]; b[e] += tb[e]; }
#pragma unroll
    for (int e = 0; e < 8; ++e) { ta[e] = shfl_xor_f(a[e], 32, lane); tb[e] = shfl_xor_f(b[e], 32, lane); }
#pragma unroll
    for (int e = 0; e < 8; ++e) { a[e] += ta[e]; b[e] += tb[e]; }
}
__device__ __forceinline__ void rw_prepass(LAS unsigned char* lds, int l) {
    int tid_ = my_tid(); asm volatile("" : "+v"(tid_));
    const int tid = tid_, lane = tid & 63, w = __builtin_amdgcn_readfirstlane(tid >> 6);
    int bx_ = blockIdx.x; asm volatile("" : "+s"(bx_)); int G_ = gridDim.x; asm volatile("" : "+s"(G_));
    const int gw = bx_ * NWAVES + w, NGW = G_ * NWAVES;
    bf16* ZR = (bf16*)(kws() + X_ZR); bf16* TWp = (bf16*)(kws() + X_TW); bf16* TAp = (bf16*)((unsigned char*)kout() + DO_TA);
    bf16* GCT = (bf16*)(kws() + X_GCT); float* CBG = (float*)(kws() + X_CBG); const bf16* BND = (const bf16*)(kws() + X_BND);
    LAS unsigned char* stg = lds + w * 16384; const LAS unsigned short* sr = (const LAS unsigned short*)(stg + 2 * lane); LAS unsigned short* sw = (LAS unsigned short*)(stg + 2 * lane);
    const int lr = lane >> 3, lc = lane & 7;
    constexpr int NIT = (T / 16) * 8;
    v4u q[4][2]; unsigned b0, b1;
#define RWP_PTRS(IT) const int s_ = (IT) >> 3, h_ = (IT) & 7; const size_t row0_ = (size_t)16 * s_; \
        bf16* gp0 = TWp + row0_ * 512 + 64 * h_; bf16* gp1 = ZR + row0_ * 1792 + 64 * h_; bf16* gp4 = TAp + row0_ * 512 + 64 * h_;
#define RWP_LOAD(IT) do { RWP_PTRS(IT); \
        q[0][0] = *(const GAS v4u*)(gp0 + (size_t)lr * 512 + 8 * lc); q[0][1] = *(const GAS v4u*)(gp0 + (size_t)(lr + 8) * 512 + 8 * lc); \
        _Pragma("unroll") for (int m = 0; m < 2; ++m) { q[1 + m][0] = *(const GAS v4u*)(gp1 + (size_t)lr * 1792 + 512 * m + 8 * lc); q[1 + m][1] = *(const GAS v4u*)(gp1 + (size_t)(lr + 8) * 1792 + 512 * m + 8 * lc); } \
        q[3][0] = *(const GAS v4u*)(gp4 + (size_t)lr * 512 + 8 * lc); q[3][1] = *(const GAS v4u*)(gp4 + (size_t)(lr + 8) * 512 + 8 * lc); \
        { const bf16* zb_ = BND + (size_t)s_ * 1536 + 64 * h_ + lane; b0 = (unsigned)*(const GAS bf16*)zb_; b1 = (unsigned)*(const GAS bf16*)(zb_ + 512); } } while (0)
    if (gw < NIT) RWP_LOAD(gw);
#pragma unroll 1
    for (int it = gw; it < NIT; it += NGW) {
        const int s = it >> 3, h = it & 7, row0 = 16 * s, pc = h * 64 + lane;
        const float mu_r = kin(9)[l * RW_COLS + pc], mu_k = kin(9)[l * RW_COLS + 512 + pc];
        const float k_k = kin(15)[l * 512 + pc], k_a = kin(16)[l * 512 + pc], r_k = kin(17)[l * 512 + pc];
#pragma unroll
        for (int m = 0; m < 4; ++m) { *(LAS v4u*)(stg + m * 2048 + lr * 128 + 16 * lc) = q[m][0]; *(LAS v4u*)(stg + m * 2048 + (lr + 8) * 128 + 16 * lc) = q[m][1]; }
        float pr = bfl(b0), pk = bfl(b1);
        if ((row0 & (SEQ - 1)) == 0) { pr = 0.f; pk = 0.f; }
        asm volatile("" ::: "memory");
        if (it + NGW < NIT) RWP_LOAD(it + NGW);
        float cum[16];
        { float run = 0.f;
#pragma unroll
          for (int t = 0; t < 16; ++t) { run += bfl((unsigned)sr[64 * t]); cum[t] = run; } }
        const float gctot = __builtin_amdgcn_exp2f(LOG2E * cum[15]);
        *(GAS bf16*)(GCT + (size_t)s * 512 + pc) = (bf16)h_f2h(gctot);
#pragma unroll
        for (int hf = 0; hf < 2; ++hf) {
            float cr[8], ck[8], ta[8];
#pragma unroll
            for (int tt = 0; tt < 8; ++tt) { const int t = 8 * hf + tt; cr[tt] = bfl((unsigned)sr[1024 + 64 * t]); ck[tt] = bfl((unsigned)sr[2048 + 64 * t]); ta[tt] = bfl((unsigned)sr[3072 + 64 * t]); }
            float rr[8], kkv[8], av[8], kmv[8], ss[8], cbv[8];
#pragma unroll
            for (int tt = 0; tt < 8; ++tt) {
                const float r = cr[tt] + (pr - cr[tt]) * mu_r, k = ck[tt] + (pk - ck[tt]) * mu_k; pr = cr[tt]; pk = ck[tt];
                const float a = ta[tt], kk = k * k_k, km = k * (1.f + (a - 1.f) * k_a);
                rr[tt] = r; kkv[tt] = kk; av[tt] = a; kmv[tt] = km; ss[tt] = kk * kk; cbv[tt] = r * km * r_k; }
            wsum16(ss, cbv, lane);
#pragma unroll
            for (int tt = 0; tt < 8; ++tt) { const int t = 8 * hf + tt;
                const float cu = cum[t], cprev = t ? cum[t - 1] : 0.f;
                const float gg = __builtin_amdgcn_exp2f(LOG2E * cu), gp_ = __builtin_amdgcn_exp2f(LOG2E * cprev), gi = __builtin_amdgcn_exp2f(-LOG2E * cu);
                const float kn = kkv[tt] * rsqrtf(fmaxf(ss[tt], 1e-24f)), ka = kn * av[tt];
                const unsigned w01 = pk_rtz(-kn * gp_, rr[tt] * gg), w23 = pk_rtz(__builtin_amdgcn_fmed3f(kmv[tt] * gi, -60000.f, 60000.f), __builtin_amdgcn_fmed3f(ka * gi, -60000.f, 60000.f));
                sw[64 * t] = (unsigned short)w01; sw[1024 + 64 * t] = (unsigned short)(w01 >> 16); sw[2048 + 64 * t] = (unsigned short)w23; sw[3072 + 64 * t] = (unsigned short)(w23 >> 16);
                if (lane == tt) *(GAS float*)(CBG + (size_t)(row0 + t) * 8 + h) = cbv[tt]; }
        }
        asm volatile("" ::: "memory");
        {   RWP_PTRS(it);
            v4u o[4][2];
#pragma unroll
            for (int m = 0; m < 4; ++m) { o[m][0] = *(const LAS v4u*)(stg + m * 2048 + lr * 128 + 16 * lc); o[m][1] = *(const LAS v4u*)(stg + m * 2048 + (lr + 8) * 128 + 16 * lc); }
            *(GAS v4u*)(gp0 + (size_t)lr * 512 + 8 * lc) = o[0][0]; *(GAS v4u*)(gp0 + (size_t)(lr + 8) * 512 + 8 * lc) = o[0][1];
#pragma unroll
            for (int m = 0; m < 2; ++m) { *(GAS v4u*)(gp1 + (size_t)lr * 1792 + 512 * m + 8 * lc) = o[1 + m][0]; *(GAS v4u*)(gp1 + (size_t)(lr + 8) * 1792 + 512 * m + 8 * lc) = o[1 + m][1]; }
            *(GAS v4u*)(gp4 + (size_t)lr * 512 + 8 * lc) = o[3][0]; *(GAS v4u*)(gp4 + (size_t)(lr + 8) * 512 + 8 * lc) = o[3][1]; }
        asm volatile("" ::: "memory");
    }
#undef RWP_LOAD
#undef RWP_PTRS
}
__device__ __forceinline__ void rw_unit(LAS unsigned char* lds, int l, int seq) {
    int tid_ = my_tid(); asm volatile("" : "+v"(tid_));
    const int tid = tid_, lane = tid & 63, w = __builtin_amdgcn_readfirstlane(tid >> 6), g4 = lane >> 4, l15 = lane & 15, q4 = l15 >> 2, p4 = lane & 3;
    const int b = seq >> 3, h = seq & 7;
    const bf16* ZRb = (const bf16*)(kws() + X_ZR) + (size_t)b * SEQ * 1792 + h * 64;
    const bf16* TWb = (const bf16*)(kws() + X_TW) + (size_t)b * SEQ * 512 + h * 64; const bf16* TAb = (const bf16*)((const unsigned char*)kout() + DO_TA) + (size_t)b * SEQ * 512 + h * 64; const bf16* Gb = (const bf16*)((const unsigned char*)kout() + DO_G) + (size_t)b * SEQ * 512 + h * 64;
    const bf16* GCTb = (const bf16*)(kws() + X_GCT) + (size_t)b * (SEQ / 16) * 512 + h * 64; const float* CBGb = (const float*)(kws() + X_CBG) + (size_t)b * SEQ * 8 + h;
    bf16* ORWb = (bf16*)(kws() + WS_ORW) + (size_t)b * SEQ * 512 + h * 64;
    LAS float* par = (LAS float*)(lds + O_PAR);
    const int pc = h * 64 + lane;
    if (tid < 64) { par[tid] = kin(18)[l * 512 + pc]; par[64 + tid] = kin(19)[l * 512 + pc]; }
    for (int i = tid; i < (O_GC - O_UV) / 4; i += 512) ((LAS unsigned*)(lds + O_UV))[i] = 0u;
    f32x4 ST[4] = {{0.f, 0.f, 0.f, 0.f}, {0.f, 0.f, 0.f, 0.f}, {0.f, 0.f, 0.f, 0.f}, {0.f, 0.f, 0.f, 0.f}};
    __syncthreads();
    const int et = tid >> 3, ecg = tid & 7, ei = et >> 4, ett = et & 15;
    const int trrow = 8 * g4 + q4, trrow1 = 8 * (g4 & 1) + q4, trcol = 8 * p4;
    (void)trrow;
    v4u qat, qbt, qkt, qrt, qv, qvp, pgg; unsigned pgc; float pcb;
    float muv[8];
#pragma unroll
    for (int e = 0; e < 8; ++e) muv[e] = kin(9)[l * RW_COLS + 1024 + h * 64 + 8 * ecg + e];
#define RW_LOADS(TOK0) do { const size_t row_ = (size_t)(TOK0) + et; \
        qat = *(const GAS v4u*)(TWb + row_ * 512 + 8 * ecg); qbt = *(const GAS v4u*)(TAb + row_ * 512 + 8 * ecg); \
        { const bf16* zc_ = ZRb + row_ * 1792 + 8 * ecg; qrt = *(const GAS v4u*)zc_; qkt = *(const GAS v4u*)(zc_ + 512); qv = *(const GAS v4u*)(zc_ + 1024); \
          qvp = *(const GAS v4u*)(zc_ + 1024 - (row_ > 0 ? 1792 : 0)); if (row_ == 0) qvp = (v4u){0u, 0u, 0u, 0u}; } \
        pgg = *(const GAS v4u*)(Gb + row_ * 512 + 8 * ecg); \
        pgc = (unsigned)*(const GAS bf16*)(GCTb + (size_t)((TOK0) / 16 + (tid >> 6 & 3)) * 512 + lane); pcb = *(const GAS float*)(CBGb + (size_t)((TOK0) + (tid & 63)) * 8); } while (0)
    RW_LOADS(0);
    for (int sc = 0; sc < SEQ / 64; ++sc) {
        const int tok0 = sc * 64;
        v4u ugg;
        {   asm volatile("" : "+v"(qat), "+v"(qbt), "+v"(qkt), "+v"(qrt), "+v"(qv), "+v"(qvp));
            { float vc[8], vp[8]; pg8::unpack8(qv, vc); pg8::unpack8(qvp, vp);
#pragma unroll
              for (int e = 0; e < 8; ++e) vc[e] = vc[e] + (vp[e] - vc[e]) * muv[e];
              qv.x = pk2(vc[0], vc[1]); qv.y = pk2(vc[2], vc[3]); qv.z = pk2(vc[4], vc[5]); qv.w = pk2(vc[6], vc[7]); }
            *(LAS v4u*)(lds + O_AT + et * RS + 16 * ecg) = qat; *(LAS v4u*)(lds + O_BT + et * RS + 16 * ecg) = qbt; *(LAS v4u*)(lds + O_KT + et * RS + 16 * ecg) = qkt; *(LAS v4u*)(lds + O_RT + et * RS + 16 * ecg) = qrt;
            *(LAS v4u*)(lds + O_UV + (ei * 32 + 16 + ett) * RS + 16 * ecg) = qv;
            if (tid < 256) ((LAS float*)(lds + O_GC))[tid] = bfl(pgc);
            if (tid < 64) ((LAS float*)(lds + O_CB))[tid] = pcb;
            ugg = pgg;
        }
        { const int nxt = (sc + 1 < SEQ / 64) ? tok0 + 64 : tok0; RW_LOADS(nxt); }
        lbar();
        {   const int i = w & 3, hf = w >> 2;
            const LAS unsigned char* xa = lds + (hf ? O_RT : O_AT) + (16 * i + l15) * RS + 16 * g4;
            const LAS unsigned char* xb = lds + O_BT + (16 * i + l15) * RS + 16 * g4; const LAS unsigned char* xk = lds + O_KT + (16 * i + l15) * RS + 16 * g4;
            f32x4 c1 = {0.f, 0.f, 0.f, 0.f}, c2 = {0.f, 0.f, 0.f, 0.f};
#pragma unroll
            for (int ks = 0; ks < 2; ++ks) { const bf16x8 a = *(const LAS bf16x8*)(xa + 64 * ks);
                c1 = MFMA16(a, *(const LAS bf16x8*)(xb + 64 * ks), c1);
                c2 = MFMA16(a, *(const LAS bf16x8*)(xk + 64 * ks), c2); }
#pragma unroll
            for (int r = 0; r < 4; ++r) { const int t = 4 * g4 + r; const bool keep = hf ? (l15 <= t) : (l15 < t); const float v1 = keep ? c1[r] : 0.f, v2 = keep ? c2[r] : 0.f;
                if (hf == 0) { ((LAS float*)(lds + O_LM))[(i * 16 + t) * 16 + l15] = v1; *(LAS unsigned short*)(lds + O_SM + (4 + i) * 1024 + t * 64 + 2 * l15) = (unsigned short)h_f2h(v2); }
                else st2(lds + O_SM + (8 + i) * 1024 + t * 64 + 2 * l15, lds + O_SM + (12 + i) * 1024 + t * 64 + 2 * l15, v1, v2); }
        }
        lbar();
        if (w < 4) { if (lane < 16) { const LAS float* Lm = (const LAS float*)(lds + O_LM) + w * 256; float acc[16];
#pragma unroll
                for (int t = 0; t < 16; ++t) acc[t] = (t == lane) ? 1.f : 0.f;
#pragma unroll
                for (int s = 0; s < 15; ++s) { const float xs = acc[s];
#pragma unroll
                    for (int t = s + 1; t < 16; ++t) acc[t] = fmaf(Lm[t * 16 + s], xs, acc[t]); }
#pragma unroll
                for (int t = 0; t < 16; t += 2) st2(lds + O_SM + w * 1024 + t * 64 + 2 * lane, lds + O_SM + w * 1024 + (t + 1) * 64 + 2 * lane, acc[t], acc[t + 1]); } }
        else { const int i = w - 4; const bf16x8 am = *(const LAS bf16x8*)(lds + O_SM + (4 + i) * 1024 + l15 * 64 + 16 * g4);
#pragma unroll
            for (int ct = 0; ct < 4; ++ct) { f32x4 acc = {0.f, 0.f, 0.f, 0.f};
                acc = MFMA16(am, trfrag(lds + O_UV + (i * 32 + 16 + trrow1) * RS + 32 * ct + trcol), acc);
st4(lds + O_W1 + (16 * i + 4 * g4) * RS + 2 * (16 * ct + l15), RS, acc); } }
        lbar();
        f32x4 wy[4];
        {   const int ct = w & 3; const int base = (w < 4) ? O_W1 : O_AT;
            bf16x8 tm[4], fb[4];
#pragma unroll
            for (int i = 0; i < 4; ++i) { tm[i] = *(const LAS bf16x8*)(lds + O_SM + i * 1024 + l15 * 64 + 16 * g4); fb[i] = trfrag(lds + base + (16 * i + trrow1) * RS + 32 * ct + trcol); }
#pragma unroll
            for (int i = 0; i < 4; ++i) { f32x4 acc = {0.f, 0.f, 0.f, 0.f}; wy[i] = MFMA16(tm[i], fb[i], acc); }
#pragma unroll
            for (int i = 0; i < 4; ++i) st4(lds + base + (16 * i + 4 * g4) * RS + 2 * (16 * ct + l15), RS, wy[i]); }
        lbar();
        {   const int ct = w & 3;
#pragma unroll
            for (int ih = 0; ih < 4; ih += 2) {
                bf16x8 arb[2], f1[2], ark[2], f2[2]; f32x4 cacc[2];
#pragma unroll
                for (int ii = 0; ii < 2; ++ii) { const int i = ih + ii; arb[ii] = *(const LAS bf16x8*)(lds + O_SM + (8 + i) * 1024 + l15 * 64 + 16 * g4);
                    if (w >= 4) { ark[ii] = *(const LAS bf16x8*)(lds + O_SM + (12 + i) * 1024 + l15 * 64 + 16 * g4);
                        f1[ii] = trfrag(lds + O_W1 + (16 * i + trrow1) * RS + 32 * ct + trcol); f2[ii] = trfrag(lds + O_UV + (i * 32 + 16 + trrow1) * RS + 32 * ct + trcol); cacc[ii] = (f32x4){0.f, 0.f, 0.f, 0.f}; }
                    else { f1[ii] = trfrag(lds + O_AT + (16 * i + trrow1) * RS + 32 * ct + trcol);
#pragma unroll
                        for (int r = 0; r < 4; ++r) cacc[ii][r] = ld_bf(lds + O_RT + (16 * i + 4 * g4 + r) * RS + 2 * (16 * ct + l15)); } }
#pragma unroll
                for (int ii = 0; ii < 2; ++ii) { cacc[ii] = MFMA16(arb[ii], f1[ii], cacc[ii]); if (w >= 4) cacc[ii] = MFMA16(ark[ii], f2[ii], cacc[ii]); }
#pragma unroll
                for (int ii = 0; ii < 2; ++ii) st4(lds + ((w >= 4) ? O_YO : O_RT) + (16 * (ih + ii) + 4 * g4) * RS + 2 * (16 * ct + l15), RS, cacc[ii]);
            } }
        lbar();
        if (w < 4) {
            const int v0 = 16 * w;
#pragma unroll
            for (int i = 0; i < 4; ++i) {
                h16x4_t sb[4];
#pragma unroll
                for (int kt = 0; kt < 4; ++kt) sb[kt] = acc2h(ST[kt]);
                f32x4 u = wy[i], y;
#pragma unroll
                for (int r = 0; r < 4; ++r) y[r] = ld_bf(lds + O_YO + (16 * i + 4 * g4 + r) * RS + 2 * (v0 + l15));
                const LAS unsigned char* pa = lds + O_AT + (16 * i + l15) * RS + 8 * g4; const LAS unsigned char* pq = lds + O_RT + (16 * i + l15) * RS + 8 * g4;
#pragma unroll
                for (int kt = 0; kt < 4; ++kt) { u = MFMA4(ld4h(pa + 32 * kt), sb[kt], u); y = MFMA4(ld4h(pq + 32 * kt), sb[kt], y); }
                st4(lds + O_YO + (16 * i + 4 * g4) * RS + 2 * (v0 + l15), RS, y);
                const h16x4_t ub = acc2h(u), vb = tr4(lds + O_UV + (i * 32 + 16 + 4 * g4 + q4) * RS + 2 * v0 + trcol);
#pragma unroll
                for (int kt = 0; kt < 4; ++kt) { const f32x4 gc = *(const LAS f32x4*)(lds + O_GC + (i * 64 + 16 * kt + 4 * g4) * 4);
                    f32x4 acc = ST[kt];
                    acc = MFMA4(tr4(lds + O_BT + (16 * i + 4 * g4 + q4) * RS + 32 * kt + trcol), ub, acc);
                    acc = MFMA4(tr4(lds + O_KT + (16 * i + 4 * g4 + q4) * RS + 32 * kt + trcol), vb, acc);
                    ST[kt] = acc * gc; }
            }
        }
        lbar();
        {   float y[8], vv[8], gg[8];
            pg8::unpack8(*(const LAS v4u*)(lds + O_YO + et * RS + 16 * ecg), y); pg8::unpack8(*(const LAS v4u*)(lds + O_UV + (ei * 32 + 16 + ett) * RS + 16 * ecg), vv);
            pg8::unpack8(ugg, gg);
            float s = 0.f;
#pragma unroll
            for (int e = 0; e < 8; ++e) s += y[e];
            s = dpp_add<0xB1>(s); s = dpp_add<0x4E>(s); s = dpp_add<0x141>(s);
            const float mean = s * (1.f / 64.f); float q = 0.f;
#pragma unroll
            for (int e = 0; e < 8; ++e) { y[e] -= mean; q += y[e] * y[e]; }
            q = dpp_add<0xB1>(q); q = dpp_add<0x4E>(q); q = dpp_add<0x141>(q);
            const float rstd = rsqrtf(q * (1.f / 64.f) + RW_LN_EPS), cb = ((const LAS float*)(lds + O_CB))[et];
            float o[8];
#pragma unroll
            for (int e = 0; e < 8; ++e) { const int c = 8 * ecg + e; o[e] = (y[e] * rstd * par[c] + par[64 + c] + cb * vv[e]) * gg[e]; }
            v4u wo; wo.x = pk2(o[0], o[1]); wo.y = pk2(o[2], o[3]); wo.z = pk2(o[4], o[5]); wo.w = pk2(o[6], o[7]);
            *(v4u*)(ORWb + (size_t)(tok0 + et) * 512 + 8 * ecg) = wo;
        }
        lbar();
    }
}
}
#ifndef PROBE_QREP
#define PROBE_QREP 1
#endif
#ifndef PROBE_MASK
#define PROBE_MASK 0
#endif
#if defined(TS_A)
#define TSTAMP(id) do { if (blockIdx.x == TS_BLK && my_tid() == 0) { LAS unsigned* sl_ = (LAS unsigned*)(L + LDSCTL_OFF + 320 + 1024); const unsigned now_ = (unsigned)__builtin_amdgcn_s_memrealtime(); if ((id) == TS_A) sl_[0] = now_; if ((id) == TS_B) sl_[1] += now_ - sl_[0]; } } while (0)
#else
#define TSTAMP(id) do { } while (0)
#endif
__global__ void __launch_bounds__(NWAVES * 64, 2) mk_fwd(Args args) {
    extern __shared__ __attribute__((aligned(16))) unsigned char lds[];
    LAS unsigned char* const L = (LAS unsigned char*)lds;
    for (int u = threadIdx.x; u < (LDS_BYTES - LDSCTL_OFF) / 4; u += NWAVES * 64) ((LAS unsigned*)(L + LDSCTL_OFF))[u] = 0u;
    __syncthreads();
    static_assert(LDSCTL_OFF == MK_WAVETAB_LDS, "wave table address");
    if ((threadIdx.x & 63) == 0) ((LAS unsigned*)(L + LDSCTL_OFF))[(unsigned)__builtin_amdgcn_s_getreg((5 << 11) | 4) & 63u] = threadIdx.x >> 6;
    __syncthreads();
    XcdBarrier bar = xcd_barrier_post((unsigned*)(kws() + WS_CTL) + CW_BAR, (volatile LAS unsigned*)(L + MISC_OFF) + 8);
#define GRID_BAR() xcd_barrier(bar)
#if defined(DBG_BISECT)
#define IN(k) (l > 0 || ((k) >= kstart() && (k) <= kstop()) || ((k) == 9 && kstop() == 99))
#define LAYER_END() do { if (kstop() < 100) return; } while (0)
#else
#define IN(k) true
#define LAYER_END() do { } while (0)
#endif
#define PTRS() unsigned char* ws = opq(kws()); \
    bf16* U = (bf16*)(ws + WS_U); bf16* OA = (bf16*)(ws + WS_OA); bf16* OC = (bf16*)(ws + WS_OC); bf16* ORW = (bf16*)(ws + WS_ORW); \
    bf16* WinT = (bf16*)(ws + W_IN); bf16* WqT = (bf16*)(ws + W_Q); bf16* WloT = (bf16*)(ws + W_LORA); bf16* WbT = (bf16*)(ws + W_B); bf16* WoT = (bf16*)(ws + W_OUT); \
    bf16* W1T = (bf16*)(ws + W_1); bf16* W2T = (bf16*)(ws + W_2); bf16* WgT = (bf16*)(ws + W_G); bf16* WpT = (bf16*)(ws + W_P); \
    bf16* ZC = (bf16*)(ws + X_ZC); bf16* QN = (bf16*)(ws + X_QN); bf16* QP = (bf16*)(ws + X_QP); bf16* KV = (bf16*)(ws + X_KV); \
    bf16* ZR = (bf16*)(ws + X_ZR); bf16* LA = (bf16*)(ws + X_LA); bf16* TW = (bf16*)(ws + X_TW); bf16* TA = (bf16*)((unsigned char*)kout() + DO_TA); bf16* GG = (bf16*)((unsigned char*)kout() + DO_G); bf16* H16 = (bf16*)((unsigned char*)kout() + DO_H16); \
    bf16* GT = (bf16*)(ws + X_GT); bf16* MG = (bf16*)(ws + X_MG); bf16* HID = (bf16*)(ws + X_HID); bf16* PB = (bf16*)(ws + X_PB); bf16* PP = (bf16*)(ws + X_PP); bf16* M2 = OA; \
    bf16* Hc = (l & 1) ? U : H16; bf16* Hn = (l & 1) ? H16 : U; const float* RS1 = (const float*)(ws + WS_RS1); const float* RS2 = (const float*)(ws + WS_RS2); (void)Hc; (void)Hn; (void)RS1; (void)RS2; \
    (void)U; (void)OA; (void)OC; (void)ORW; (void)WinT; (void)WqT; (void)WloT; (void)WbT; (void)WoT; (void)W1T; (void)W2T; (void)WgT; (void)WpT; (void)ZC; (void)QN; (void)QP; (void)KV; (void)ZR; (void)LA; (void)TW; (void)TA; (void)GG; (void)H16; (void)GT; (void)MG; (void)HID; (void)PB; (void)PP; (void)M2;
    typedef pg8::StaticOrder SO;
#define GEMM(EPI, Aptr, Bptr, N_, K_, Eobj) do { int bx_ = blockIdx.x; asm volatile("" : "+s"(bx_)); int G_ = gridDim.x; asm volatile("" : "+s"(G_)); pg8::Gemm g_{Aptr, Bptr, T, N_, K_}; SO S_; S_.init(T, N_, G_, bx_); pg8::gemm_phase<EPI, SO, true, true>(L + RING_OFF, g_, S_, Eobj); } while (0)
#define PH(n) for (int rep_ = 0; rep_ < (((PROBE_MASK >> (n)) & 1) ? 2 : 1); ++rep_) if (IN(n))
    typedef pg8::EpiRoute<0> ER0;
    rope_table(L);
    for (int l = 0; l < DEPTH; ++l) {
        PH(0) { PTRS(); p0_prologue(L, args, l); h_rowpass(L, Hc, l == 0); GRID_BAR(); }
        PH(1) { PTRS(); ER0 E{OA, 512, 2, ZC, 1536, 6, 2, CA_QSCALE, ZR, 1792, RS1}; GEMM(ER0, Hc, WinT, 3840, 1024, E); GRID_BAR(); }
        PH(2) { p6_rw_prep(L, l); GRID_BAR(); }
        PH(3) { PTRS(); pg8::EpiLora E2{TW, TA, GG, kin(10) + l * 512, kin(12) + l * 512}; GEMM(pg8::EpiLora, LA, WloT, 1536, 256, E2); GRID_BAR(); }
        if (IN(3)) { TSTAMP(7); rw::rw_prepass(L + RING_OFF, l); GRID_BAR(); TSTAMP(8); }
        if (IN(4)) { PTRS();
            unsigned* sb = (unsigned*)(ws + WS_CTL) + CW_SUB + 64 * l; unsigned* barw = (unsigned*)(ws + WS_CTL) + CW_BAR;
            int bx4_ = blockIdx.x; asm volatile("" : "+s"(bx4_)); int G4_ = gridDim.x; asm volatile("" : "+s"(G4_));
            TSTAMP(0);
            const int NRW = (G4_ > 64) ? 64 : 0, NOTH = G4_ - NRW;
            if (bx4_ < 64) rw::rw_unit(L + RING_OFF, l, bx4_);
            if (G4_ <= 64) for (int u_ = bx4_ + 64; u_ < 64; u_ += G4_) rw::rw_unit(L + RING_OFF, l, u_);
            if (bx4_ >= NRW) {
                p2_mla_prep(L, l, NRW, NOTH);
                TSTAMP(5); sub_barrier(barw, sb, (unsigned)NOTH, true); TSTAMP(6);
                { pg8::EpiQRope E{QP, (const float*)(ws + WS_ROPE), MLA_QSCALE}; pg8::Gemm g_{QN, WqT, T, 768, 256}; SO S_; S_.init(T, 768, NOTH, bx4_ - NRW); pg8::gemm_phase<pg8::EpiQRope, SO, true, true>(L + RING_OFF, g_, S_, E); }
                sub_barrier(barw, sb + 16, (unsigned)NOTH, true);
            } else { TSTAMP(4); sub_barrier(barw, sb + 16, (unsigned)NOTH, false); }
            TSTAMP(1);
            volatile LAS unsigned* qs = (volatile LAS unsigned*)(L + MISC_OFF) + 12;
            unsigned* qhead = (unsigned*)(ws + WS_CTL) + CW_QUEUE + 64 * l;
            for (;;) {
                __syncthreads();
                if (my_tid() == 0) *qs = atomicAdd(qhead, 1u);
                __syncthreads();
                const unsigned u = *qs;
                if (u >= 1536u) break;
                if (u < 512u) att::mla_unit(L + RING_OFF, QP, KV, OA, (int)u & 7, 63 - ((int)u >> 3));
                else { const int bi = (int)u - 512; att::band_unit(L + RING_OFF, ZC, kin(20) + (size_t)l * 320 * 8, OC, bi >> 7, (bi >> 4) & 7, bi & 15); }
            }
            TSTAMP(2); GRID_BAR(); TSTAMP(3); }
        PH(9) { PTRS(); ER0 E{GT, 3072, 12, GT, 3072, 0, 0, 1.f, GT, 3072, RS1}; GEMM(ER0, Hc, WinT + (size_t)3840 * 1024, 3072, 1024, E); GRID_BAR(); }
        PH(10) { PTRS(); int bx_ = blockIdx.x; asm volatile("" : "+s"(bx_)); int G_ = gridDim.x; asm volatile("" : "+s"(G_));
                 pg8::Gemm g_{OA, WbT, 3 * T, 3072, 512}; pg8::MergeOrder S_{G_, bx_}; pg8::EpiMergeAll E{MG, GT};
                 pg8::gemm_phase<pg8::EpiMergeAll, pg8::MergeOrder, true, true>(L + RING_OFF, g_, S_, E); GRID_BAR(); }
        PH(11) { PTRS(); ER0 E{M2, 1024, 4, M2, 1024, 0, 0, 1.f, M2, 1024, nullptr}; GEMM(ER0, MG, WoT, 1024, 1024, E); GRID_BAR(); }
        if (IN(12)) { PTRS(); rowpass<0>(L, Hc, M2, kin(23) + l * 1024, nullptr); GRID_BAR(); }
        PH(13) { PTRS(); pg8::EpiRoute<2> E{HID, 4096, 16, HID, 4096, 0, 0, 1.f, HID, 4096, RS2}; GEMM(pg8::EpiRoute<2>, Hc, W1T, 4096, 1024, E); GRID_BAR(); }
        PH(14) { PTRS(); ER0 E{M2, 1024, 4, M2, 1024, 0, 0, 1.f, M2, 1024, nullptr}; GEMM(ER0, HID, W2T, 1024, 4096, E); GRID_BAR(); }
        if (IN(15)) { PTRS(); rowpass<1>(L, Hc, M2, kin(27) + l * 1024, kin(1) + (size_t)l * T * DPLE); GRID_BAR(); }
        if (IN(17)) { PTRS(); ER0 E{PP, 1024, 4, PP, 1024, 0, 0, 1.f, PP, 1024, nullptr}; GEMM(ER0, PB, WpT, 1024, 256, E);
                      pg8::EpiPle E2{Hc, Hn, PP, kout(), (l + 1 == DEPTH) ? 1 : 0}; GEMM(pg8::EpiPle, Hc, WgT, 1024, 1024, E2); }
        LAYER_END();
        if (l + 1 < DEPTH) GRID_BAR();
    }
#if defined(TS_A)
    if (blockIdx.x == TS_BLK && my_tid() < 64) { const LAS unsigned* sl = (const LAS unsigned*)(L + LDSCTL_OFF + 320 + 1024);
        const unsigned want = __builtin_amdgcn_readfirstlane(sl[1]) * (unsigned)TS_AMP; const unsigned t0 = (unsigned)__builtin_amdgcn_s_memrealtime();
        while ((unsigned)__builtin_amdgcn_s_memrealtime() - t0 < want) __builtin_amdgcn_s_sleep(8); }
#endif
}

#if !defined(DBG_BISECT)
extern "C" void kernel_launch(void* const* d_in, const int* in_sizes, int n_in, void* d_out, int out_size, void* d_ws, size_t ws_size, hipStream_t stream) {
    static int grid = 0;
    if (grid == 0) {
        if (n_in != 30 || out_size != T * D || ws_size < (size_t)WS_END) { fprintf(stderr, "kernel_launch: unexpected shapes (n_in %d out %d ws %zu, need ws >= %zu)\n", n_in, out_size, ws_size, (size_t)WS_END); grid = -1; return; }
        int dev = 0, cus = 0, per_cu = 0;
        if (hipGetDevice(&dev) != hipSuccess || hipDeviceGetAttribute(&cus, hipDeviceAttributeMultiprocessorCount, dev) != hipSuccess) { grid = -1; return; }
        if (hipFuncSetAttribute((const void*)mk_fwd, hipFuncAttributeMaxDynamicSharedMemorySize, LDS_BYTES) != hipSuccess) { fprintf(stderr, "kernel_launch: hipFuncSetAttribute failed\n"); grid = -1; return; }
        if (hipOccupancyMaxActiveBlocksPerMultiprocessor(&per_cu, (const void*)mk_fwd, NWAVES * 64, LDS_BYTES) != hipSuccess || per_cu < 1) { fprintf(stderr, "kernel_launch: occupancy query says %d\n", per_cu); }
        (void)hipGetLastError();
        if (cus < 256) { fprintf(stderr, "kernel_launch: %d CUs, the RWKV pre-pass needs a grid of >= 256 workgroups\n", cus); grid = -1; return; }
        grid = cus;
    }
    if (grid < 0) return;
    if (hipMemsetAsync((char*)d_ws + WS_CTL, 0, CTL_ZERO_BYTES, stream) != hipSuccess) return;
    Args a{};
    for (int i = 0; i < 30; ++i) a.in[i] = (const float*)d_in[i];
    a.out = (float*)d_out; a.ws = (unsigned char*)d_ws; a.start = 0; a.stop = 1000;
    hipLaunchKernelGGL(mk_fwd, dim3(grid), dim3(NWAVES * 64), LDS_BYTES, stream, a);
}
#endif
```

```cpp
#include <hip/hip_runtime.h>
#include <cstdio>
#include <cstdint>
#include <cmath>
typedef _Float16 h16x8_t __attribute__((ext_vector_type(8)));
typedef _Float16 h16x2_t __attribute__((ext_vector_type(2)));
typedef short s16x8_t __attribute__((ext_vector_type(8)));
typedef float f32x4_t_ __attribute__((ext_vector_type(4)));
typedef float f32x16_t_ __attribute__((ext_vector_type(16)));
__device__ __forceinline__ unsigned h_pk2(float lo, float hi) { const h16x2_t v = {(_Float16)lo, (_Float16)hi}; return __builtin_bit_cast(unsigned, v); }
__device__ __forceinline__ unsigned h_f2h(float f) { return (unsigned)__builtin_bit_cast(unsigned short, (_Float16)f); }
__device__ __forceinline__ float h_lo(unsigned w) { return (float)__builtin_bit_cast(_Float16, (unsigned short)(w & 0xffffu)); }
__device__ __forceinline__ float h_hi(unsigned w) { return (float)__builtin_bit_cast(_Float16, (unsigned short)(w >> 16)); }
__device__ __forceinline__ f32x4_t_ MFMA16(s16x8_t a, s16x8_t b, f32x4_t_ c) { return __builtin_amdgcn_mfma_f32_16x16x32_f16(__builtin_bit_cast(h16x8_t, a), __builtin_bit_cast(h16x8_t, b), c, 0, 0, 0); }
__device__ __forceinline__ f32x16_t_ MFMA32(s16x8_t a, s16x8_t b, f32x16_t_ c) { return __builtin_amdgcn_mfma_f32_32x32x16_f16(__builtin_bit_cast(h16x8_t, a), __builtin_bit_cast(h16x8_t, b), c, 0, 0, 0); }
#define MK_WAVETAB_LDS 131072
__device__ __forceinline__ int my_tid() {
    const unsigned hw = (unsigned)__builtin_amdgcn_s_getreg((5 << 11) | 4) & 63u;
    const unsigned wv = (unsigned)__builtin_amdgcn_readfirstlane((int)((volatile __attribute__((address_space(3))) unsigned*)MK_WAVETAB_LDS)[hw]);
    unsigned lane; asm volatile("v_mbcnt_lo_u32_b32 %0, -1, 0\n\tv_mbcnt_hi_u32_b32 %0, -1, %0" : "=v"(lane));
    return (int)(wv * 64u + lane);
}
namespace pg8 {
#define PG8_LAS __attribute__((address_space(3)))
#define PG8_GAS __attribute__((address_space(1)))
typedef unsigned short bf16_t;
typedef short bf16x8 __attribute__((ext_vector_type(8)));
typedef float f32x4 __attribute__((ext_vector_type(4)));
typedef unsigned u32x4 __attribute__((ext_vector_type(4)));
constexpr int BM = 256, BK = 64, HALF = 128, HTB = HALF * BK * 2  , STAGE_BYTES = 8 * HTB, NXCD = 8, WGM = 8;

__host__ __device__ __forceinline__ int lds_byte(int r, int c) { const int st = (r >> 4) * 2 + (c >> 5), rr = r & 15, cc = c & 31, ob = rr * 64 + cc * 2; return st * 1024 + (ob ^ (((ob >> 9) & 1) << 5)); }
__host__ __device__ __forceinline__ void stage_rc(int b, int& R, int& C) { const int st = b / 1024, sb = b % 1024, swz = sb ^ (((sb >> 9) & 1) << 5); R = (st >> 1) * 16 + swz / 64; C = (st & 1) * 32 + (swz % 64) / 2; }
__host__ __device__ __forceinline__ int perm32(int rho) { const int n = rho >> 4, i = rho & 15; return 8 * (i >> 2) + 4 * n + (i & 3); }

struct Unit { int pm, pn; };
struct Gemm { const bf16_t* A; const bf16_t* Bt; int M, N, K; };

struct StaticOrder {
    int nM, nN, nwg, G, c;
    __host__ __device__ void init(int M, int N, int G_, int c_) { nM = M / BM; nN = N / BM; nwg = nM * nN; G = G_; c = c_; }
    __host__ __device__ bool next(int i, Unit& u) const {
        const long L = (long)i * G + c; if (L >= nwg) return false;
        int wgid = (int)L; { const int q = nwg / NXCD, r = nwg % NXCD, xcd = wgid % NXCD, off = wgid / NXCD; wgid = (xcd < r ? xcd * (q + 1) : r * (q + 1) + (xcd - r) * q) + off; }
        const int nig = WGM * nN, gid = wgid / nig, fm = gid * WGM, gsz = (nM - fm) < WGM ? (nM - fm) : WGM;
        u.pm = fm + ((wgid % nig) % gsz); u.pn = (wgid % nig) / gsz; return true;
    }
    __device__ __forceinline__ void a_ready(const Unit&) const {}
    __device__ __forceinline__ void done(const Unit&) const {}
};

__device__ __forceinline__ unsigned cvt_pk_bf16(float lo, float hi) { typedef __fp16 hp2 __attribute__((ext_vector_type(2))); const hp2 v = __builtin_amdgcn_cvt_pkrtz(lo, hi); return __builtin_bit_cast(unsigned, v); }
typedef float f32x2 __attribute__((ext_vector_type(2)));
__device__ __forceinline__ f32x2 gelu_pk(f32x2 v) {
    const f32x2 av = __builtin_elementwise_abs(v), d = av * 0.2316418882f + 1.0f;
    f32x2 t; t.x = __builtin_amdgcn_rcpf(d.x); t.y = __builtin_amdgcn_rcpf(d.y);
    f32x2 q = t * 0.5307027145f + (-0.7265760135f); q = q * t + 0.7107068705f; q = q * t + (-0.142248368f); q = q * t + 0.127414796f; q = q * t;
    const f32x2 s = (v * v) * (-0.72134752044f);
    f32x2 e; e.x = __builtin_amdgcn_exp2f(s.x); e.y = __builtin_amdgcn_exp2f(s.y);
    const f32x2 m = v * (q * e), r = v - m;
    f32x2 o; o.x = v.x < 0.f ? m.x : r.x; o.y = v.y < 0.f ? m.y : r.y; return o;
}

template <int ACT  > struct EpiBf16 {
    static constexpr bool PERM = true, AFTER_DRAIN = false; static_assert(ACT == 0 || ACT == 1, "EpiBf16: ACT is 0 (none) or 1 (gelu_pk)");
    bf16_t* O; int ldc; const float* bias; int split_cols; size_t split_stride; float scale0;
    __device__ __forceinline__ void operator()(const f32x4 (&acc)[2][2][4][2], const Unit& u, int wr, int wc, int fr, int fq) const {
        const int row0 = u.pm * BM + wr * 64 + fr; int colt = u.pn * BM; bf16_t* base = O;
        float sc = 1.f; if (split_cols) { const int t = colt / split_cols; base += (size_t)t * split_stride; colt -= t * split_cols; if (t == 0) sc = scale0; }
        const int col0 = colt + wc * 32 + 8 * fq, bcol0 = u.pn * BM + wc * 32 + 8 * fq;
        f32x4 bv[2][2];
#pragma unroll
        for (int bj = 0; bj < 2; ++bj)
#pragma unroll
            for (int n = 0; n < 2; ++n) bv[bj][n] = bias ? *(const f32x4*)(bias + bcol0 + bj * HALF + 4 * n) : (f32x4){0.f, 0.f, 0.f, 0.f};
#pragma unroll
        for (int ai = 0; ai < 2; ++ai)
#pragma unroll
            for (int m = 0; m < 4; ++m) { bf16_t* rowp = base + (size_t)(row0 + ai * HALF + m * 16) * ldc + col0;
#pragma unroll
                for (int bj = 0; bj < 2; ++bj) { f32x4 v0 = acc[ai][bj][m][0] + bv[bj][0], v1 = acc[ai][bj][m][1] + bv[bj][1];
                    if (ACT == 1) { f32x2 a = gelu_pk((f32x2){v0[0], v0[1]}), b = gelu_pk((f32x2){v0[2], v0[3]}), c = gelu_pk((f32x2){v1[0], v1[1]}), d = gelu_pk((f32x2){v1[2], v1[3]});
                        v0 = (f32x4){a.x, a.y, b.x, b.y}; v1 = (f32x4){c.x, c.y, d.x, d.y}; }
                    v0 = v0 * sc; v1 = v1 * sc; u32x4 w; w.x = cvt_pk_bf16(v0[0], v0[1]); w.y = cvt_pk_bf16(v0[2], v0[3]); w.z = cvt_pk_bf16(v1[0], v1[1]); w.w = cvt_pk_bf16(v1[2], v1[3]);
                    *(u32x4*)(rowp + bj * HALF) = w; } }
    }
};
__device__ __forceinline__ float bf2f(unsigned short b) { return h_lo((unsigned)b); }
__device__ __forceinline__ float sigm(float x) { return __builtin_amdgcn_rcpf(1.0f + __builtin_amdgcn_exp2f(-1.4426950408889634f * x)); }
__device__ __forceinline__ void unpack8(const u32x4 w, float (&f)[8]) {
    f[0] = h_lo(w.x); f[1] = h_hi(w.x); f[2] = h_lo(w.y); f[3] = h_hi(w.y); f[4] = h_lo(w.z); f[5] = h_hi(w.z); f[6] = h_lo(w.w); f[7] = h_hi(w.w);
}
template <int ACT> struct EpiRoute {
    static constexpr bool PERM = true, AFTER_DRAIN = false;
    bf16_t* O0; int ld0; int nt0;
    bf16_t* O1; int ld1; int nt1; int nts1; float sc1;
    bf16_t* O2; int ld2;
    const float* rsc;
    __device__ __forceinline__ void operator()(const f32x4 (&acc)[2][2][4][2], const Unit& u, int wr, int wc, int fr, int fq) const {
        const int row0 = u.pm * BM + wr * 64 + fr;
        float rsv[2][4];
#pragma unroll
        for (int ai = 0; ai < 2; ++ai)
#pragma unroll
            for (int m = 0; m < 4; ++m) rsv[ai][m] = rsc ? *(const PG8_GAS float*)(rsc + row0 + ai * HALF + m * 16) : 1.f;
        bf16_t* base; int ld, colt; float sc = 1.f;
        if (u.pn < nt0) { base = O0; ld = ld0; colt = u.pn * BM; }
        else if (u.pn < nt0 + nt1) { base = O1; ld = ld1; colt = (u.pn - nt0) * BM; if (u.pn - nt0 < nts1) sc = sc1; }
        else { base = O2; ld = ld2; colt = (u.pn - nt0 - nt1) * BM; }
        const int col0 = colt + wc * 32 + 8 * fq;
#pragma unroll
        for (int ai = 0; ai < 2; ++ai)
#pragma unroll
            for (int m = 0; m < 4; ++m) { bf16_t* rowp = base + (size_t)(row0 + ai * HALF + m * 16) * ld + col0;
#pragma unroll
                for (int bj = 0; bj < 2; ++bj) { f32x4 v0 = acc[ai][bj][m][0] * rsv[ai][m], v1 = acc[ai][bj][m][1] * rsv[ai][m];
                    if (ACT == 2) { for (int e = 0; e < 4; ++e) { const float a = fmaxf(v0[e], 0.f), b = fmaxf(v1[e], 0.f); v0[e] = a * a; v1[e] = b * b; } }
                    v0 = v0 * sc; v1 = v1 * sc; u32x4 w; w.x = cvt_pk_bf16(v0[0], v0[1]); w.y = cvt_pk_bf16(v0[2], v0[3]); w.z = cvt_pk_bf16(v1[0], v1[1]); w.w = cvt_pk_bf16(v1[2], v1[3]);
                    *(PG8_GAS u32x4*)(rowp + bj * HALF) = w; } }
    }
};
struct EpiSig {
    static constexpr bool PERM = true, AFTER_DRAIN = false;
    bf16_t* O; const float* p; float scale; int ld;
    __device__ __forceinline__ void operator()(const f32x4 (&acc)[2][2][4][2], const Unit& u, int wr, int wc, int fr, int fq) const {
        const int row0 = u.pm * BM + wr * 64 + fr; const int col0 = u.pn * BM + wc * 32 + 8 * fq;
        const f32x4 pA0 = *(const PG8_GAS f32x4*)(p + col0), pA1 = *(const PG8_GAS f32x4*)(p + col0 + 4), pB0 = *(const PG8_GAS f32x4*)(p + col0 + HALF), pB1 = *(const PG8_GAS f32x4*)(p + col0 + HALF + 4);
#pragma unroll
        for (int ai = 0; ai < 2; ++ai)
#pragma unroll
            for (int m = 0; m < 4; ++m) { bf16_t* rowp = O + (size_t)(row0 + ai * HALF + m * 16) * ld + col0;
#pragma unroll
                for (int bj = 0; bj < 2; ++bj) { f32x4 v0 = acc[ai][bj][m][0], v1 = acc[ai][bj][m][1]; const f32x4 p0 = bj ? pB0 : pA0, p1 = bj ? pB1 : pA1;
                    v0 = (f32x4){sigm(p0[0] + v0[0]), sigm(p0[1] + v0[1]), sigm(p0[2] + v0[2]), sigm(p0[3] + v0[3])} * scale; v1 = (f32x4){sigm(p1[0] + v1[0]), sigm(p1[1] + v1[1]), sigm(p1[2] + v1[2]), sigm(p1[3] + v1[3])} * scale;
                    u32x4 w; w.x = cvt_pk_bf16(v0[0], v0[1]); w.y = cvt_pk_bf16(v0[2], v0[3]); w.z = cvt_pk_bf16(v1[0], v1[1]); w.w = cvt_pk_bf16(v1[2], v1[3]);
                    *(PG8_GAS u32x4*)(rowp + bj * HALF) = w; } }
    }
};
struct EpiLora {
    static constexpr bool PERM = true, AFTER_DRAIN = false;
    bf16_t* TW; bf16_t* TA; bf16_t* G; const float* w0; const float* a0;
    __device__ __forceinline__ void operator()(const f32x4 (&acc)[2][2][4][2], const Unit& u, int wr, int wc, int fr, int fq) const {
        const int sel = u.pn >> 1;
        bf16_t* O = TW; const float* p = w0; float scale = -0.6065306597126334f;
        if (sel == 1) { O = TA; p = a0; scale = 1.f; } else if (sel == 2) { O = G; }
        asm volatile("" : "+s"(O), "+s"(p));
        const int row0 = u.pm * BM + wr * 64 + fr; const int col0 = (u.pn & 1) * BM + wc * 32 + 8 * fq;
        const f32x4 pA0 = *(const PG8_GAS f32x4*)(p + col0), pA1 = *(const PG8_GAS f32x4*)(p + col0 + 4), pB0 = *(const PG8_GAS f32x4*)(p + col0 + HALF), pB1 = *(const PG8_GAS f32x4*)(p + col0 + HALF + 4);
#pragma unroll
        for (int ai = 0; ai < 2; ++ai)
#pragma unroll
            for (int m = 0; m < 4; ++m) { bf16_t* rowp = O + (size_t)(row0 + ai * HALF + m * 16) * 512 + col0;
#pragma unroll
                for (int bj = 0; bj < 2; ++bj) { f32x4 v0 = acc[ai][bj][m][0], v1 = acc[ai][bj][m][1]; const f32x4 p0 = bj ? pB0 : pA0, p1 = bj ? pB1 : pA1;
                    if (sel < 2) { v0 = (f32x4){sigm(p0[0] + v0[0]), sigm(p0[1] + v0[1]), sigm(p0[2] + v0[2]), sigm(p0[3] + v0[3])} * scale; v1 = (f32x4){sigm(p1[0] + v1[0]), sigm(p1[1] + v1[1]), sigm(p1[2] + v1[2]), sigm(p1[3] + v1[3])} * scale; }
                    u32x4 w; w.x = cvt_pk_bf16(v0[0], v0[1]); w.y = cvt_pk_bf16(v0[2], v0[3]); w.z = cvt_pk_bf16(v1[0], v1[1]); w.w = cvt_pk_bf16(v1[2], v1[3]);
                    *(PG8_GAS u32x4*)(rowp + bj * HALF) = w; } }
    }
};
struct EpiQRope {
    static constexpr bool PERM = true, AFTER_DRAIN = false;
    bf16_t* O; const float* rope; float sc;
    __device__ __forceinline__ void operator()(const f32x4 (&acc)[2][2][4][2], const Unit& u, int wr, int wc, int fr, int fq) const {
        const int row0 = u.pm * BM + wr * 64 + fr; const int col0 = u.pn * BM + wc * 32 + 8 * fq;
#pragma unroll
        for (int ai = 0; ai < 2; ++ai)
#pragma unroll
            for (int m = 0; m < 4; ++m) { const int row = row0 + ai * HALF + m * 16;
#pragma unroll
                for (int bj = 0; bj < 2; ++bj) { const int cg = col0 + bj * HALF; const int cm = cg % 192; f32x4 v0 = acc[ai][bj][m][0], v1 = acc[ai][bj][m][1];
                    if (cm >= 128) { const int j0 = (cm - 128) >> 1; const PG8_GAS f32x4* rp = (const PG8_GAS f32x4*)(rope + ((size_t)row * 32 + j0) * 2); const f32x4 a = rp[0], b = rp[1];
                        f32x4 r0, r1;
                        r0[0] = v0[0] * a[0] - v0[1] * a[1]; r0[1] = v0[1] * a[0] + v0[0] * a[1]; r0[2] = v0[2] * a[2] - v0[3] * a[3]; r0[3] = v0[3] * a[2] + v0[2] * a[3];
                        r1[0] = v1[0] * b[0] - v1[1] * b[1]; r1[1] = v1[1] * b[0] + v1[0] * b[1]; r1[2] = v1[2] * b[2] - v1[3] * b[3]; r1[3] = v1[3] * b[2] + v1[2] * b[3];
                        v0 = r0; v1 = r1; }
                    v0 = v0 * sc; v1 = v1 * sc; u32x4 w; w.x = cvt_pk_bf16(v0[0], v0[1]); w.y = cvt_pk_bf16(v0[2], v0[3]); w.z = cvt_pk_bf16(v1[0], v1[1]); w.w = cvt_pk_bf16(v1[2], v1[3]);
                    *(PG8_GAS u32x4*)(O + (size_t)row * 768 + cg) = w; } }
    }
};
template <int NI> struct EpiMerge {
    static constexpr bool PERM = true, AFTER_DRAIN = false;
    bf16_t* MG; const bf16_t* GT;
    __device__ __forceinline__ void operator()(const f32x4 (&acc)[2][2][4][2], const Unit& u, int wr, int wc, int fr, int fq) const {
        const int row0 = u.pm * BM + wr * 64 + fr; const int col0 = u.pn * BM + wc * 32 + 8 * fq;
#pragma unroll
        for (int ai = 0; ai < 2; ++ai)
#pragma unroll
            for (int m = 0; m < 4; ++m) { const int row = row0 + ai * HALF + m * 16;
#pragma unroll
                for (int bj = 0; bj < 2; ++bj) { const int c = col0 + bj * HALF; const f32x4 v0 = acc[ai][bj][m][0], v1 = acc[ai][bj][m][1];
                    const u32x4 gw = *(const PG8_GAS u32x4*)(GT + (size_t)row * 3072 + NI * 1024 + c);
                    f32x4 o0 = {0.f, 0.f, 0.f, 0.f}, o1 = {0.f, 0.f, 0.f, 0.f};
                    if (NI > 0) { const u32x4 ow = *(const PG8_GAS u32x4*)(MG + (size_t)row * 1024 + c); o0 = (f32x4){h_lo(ow.x), h_hi(ow.x), h_lo(ow.y), h_hi(ow.y)}; o1 = (f32x4){h_lo(ow.z), h_hi(ow.z), h_lo(ow.w), h_hi(ow.w)}; }
                    o0[0] += sigm(h_lo(gw.x)) * v0[0]; o0[1] += sigm(h_hi(gw.x)) * v0[1]; o0[2] += sigm(h_lo(gw.y)) * v0[2]; o0[3] += sigm(h_hi(gw.y)) * v0[3];
                    o1[0] += sigm(h_lo(gw.z)) * v1[0]; o1[1] += sigm(h_hi(gw.z)) * v1[1]; o1[2] += sigm(h_lo(gw.w)) * v1[2]; o1[3] += sigm(h_hi(gw.w)) * v1[3];
                    u32x4 w; w.x = cvt_pk_bf16(o0[0], o0[1]); w.y = cvt_pk_bf16(o0[2], o0[3]); w.z = cvt_pk_bf16(o1[0], o1[1]); w.w = cvt_pk_bf16(o1[2], o1[3]);
                    *(PG8_GAS u32x4*)(MG + (size_t)row * 1024 + c) = w; } }
    }
};
__device__ __forceinline__ unsigned pk_fma_h(unsigned a, unsigned b, unsigned c) { unsigned r; asm("v_pk_fma_f16 %0, %1, %2, %3" : "=v"(r) : "v"(a), "v"(b), "v"(c)); return r; }
struct EpiGate8 {
    static constexpr bool PERM = true, AFTER_DRAIN = false;
    unsigned char* O; int ld; const float* rsc;
    __device__ __forceinline__ void operator()(const f32x4 (&acc)[2][2][4][2], const Unit& u, int wr, int wc, int fr, int fq) const {
        const int row0 = u.pm * BM + wr * 64 + fr; const int col0 = u.pn * BM + wc * 32 + 8 * fq;
        float rsv[2][4];
#pragma unroll
        for (int ai = 0; ai < 2; ++ai)
#pragma unroll
            for (int m = 0; m < 4; ++m) rsv[ai][m] = rsc ? *(const PG8_GAS float*)(rsc + row0 + ai * HALF + m * 16) : 1.f;
#pragma unroll
        for (int ai = 0; ai < 2; ++ai)
#pragma unroll
            for (int m = 0; m < 4; ++m) { unsigned char* rowp = O + (size_t)(row0 + ai * HALF + m * 16) * ld + col0;
#pragma unroll
                for (int bj = 0; bj < 2; ++bj) { const f32x4 v0 = acc[ai][bj][m][0] * rsv[ai][m], v1 = acc[ai][bj][m][1] * rsv[ai][m];
                    unsigned q[8];
#pragma unroll
                    for (int e2_ = 0; e2_ < 4; ++e2_) { q[e2_] = (unsigned)fminf(256.f * sigm(v0[e2_]), 255.f); q[4 + e2_] = (unsigned)fminf(256.f * sigm(v1[e2_]), 255.f); }
                    typedef unsigned u32x2 __attribute__((ext_vector_type(2)));
                    u32x2 w; w.x = q[0] | (q[1] << 8) | (q[2] << 16) | (q[3] << 24); w.y = q[4] | (q[5] << 8) | (q[6] << 16) | (q[7] << 24);
                    *(PG8_GAS u32x2*)(rowp + bj * HALF) = w; } }
    }
};
struct EpiMergeAll {
    static constexpr bool PERM = true, AFTER_DRAIN = false, CHAIN = true;
    bf16_t* MG; const unsigned char* GT;
    __device__ __forceinline__ bool chain(const Unit& u) const { return (u.pm >> 7) < 2; }
    __device__ __forceinline__ void operator()(f32x4 (&acc)[2][2][4][2], const Unit& u, int wr, int wc, int fr, int fq) const {
        typedef unsigned u32x2 __attribute__((ext_vector_type(2)));
        const int a = u.pm >> 7, p = u.pm & 127, br = u.pn >> 2, q = u.pn & 3;
        const int brn = (a == 0) ? 2 : 1;
        const int row0 = p * BM + wr * 64 + fr; const int col0 = q * BM + wc * 32 + 8 * fq;
#pragma unroll
        for (int ai = 0; ai < 2; ++ai) {
            u32x2 gw[4][2], gn[4][2];
#pragma unroll
            for (int m = 0; m < 4; ++m)
#pragma unroll
                for (int bj = 0; bj < 2; ++bj) { const int row = row0 + ai * HALF + m * 16, c = col0 + bj * HALF;
                    gw[m][bj] = *(const PG8_GAS u32x2*)(GT + (size_t)row * 3072 + br * 1024 + c);
                    if (a < 2) gn[m][bj] = *(const PG8_GAS u32x2*)(GT + (size_t)row * 3072 + brn * 1024 + c); else gn[m][bj] = (u32x2){0u, 0u}; }
            __builtin_amdgcn_sched_barrier(0);
#pragma unroll
            for (int m = 0; m < 4; ++m)
#pragma unroll
                for (int bj = 0; bj < 2; ++bj) { const int row = row0 + ai * HALF + m * 16, c = col0 + bj * HALF; const u32x2 g = gw[m][bj], n = gn[m][bj];
                    float f[8];
#pragma unroll
                    for (int e = 0; e < 8; ++e) { const unsigned gb = (g[e >> 2] >> (8 * (e & 3))) & 255u, nb = (n[e >> 2] >> (8 * (e & 3))) & 255u;
                        const float gc = ((float)gb + 0.5f) * (1.f / 256.f);
                        f[e] = (a < 2) ? gc * __builtin_amdgcn_rcpf(((float)nb + 0.5f) * (1.f / 256.f)) : gc; }
                    f32x4 v0 = acc[ai][bj][m][0], v1 = acc[ai][bj][m][1];
                    v0[0] *= f[0]; v0[1] *= f[1]; v0[2] *= f[2]; v0[3] *= f[3]; v1[0] *= f[4]; v1[1] *= f[5]; v1[2] *= f[6]; v1[3] *= f[7];
                    if (a < 2) { acc[ai][bj][m][0] = v0; acc[ai][bj][m][1] = v1; }
                    else { u32x4 w; w.x = cvt_pk_bf16(v0[0], v0[1]); w.y = cvt_pk_bf16(v0[2], v0[3]); w.z = cvt_pk_bf16(v1[0], v1[1]); w.w = cvt_pk_bf16(v1[2], v1[3]);
                        *(PG8_GAS u32x4*)(MG + (size_t)row * 1024 + c) = w; } }
            __builtin_amdgcn_sched_barrier(0);
        }
    }
};
struct MergeOrder {
    int G, c;
    __device__ __forceinline__ bool next(int i, Unit& u) const { if (i >= 6 || G != 256) { if (G == 256) return false; const int t = c + G * (i / 3), a = i % 3; if (t >= 512) return false;
            const int p = t >> 2, q = t & 3, br = (a == 0) ? 0 : (a == 1 ? 2 : 1); u.pm = a * 128 + p; u.pn = br * 4 + q; return true; }
        const int x = c & 7, s = c >> 3, p = x * 16 + (s >> 1), q = 2 * (s & 1) + i / 3, a = i % 3, br = (a == 0) ? 0 : (a == 1 ? 2 : 1);
        u.pm = a * 128 + p; u.pn = br * 4 + q; return true; }
    __device__ __forceinline__ void a_ready(const Unit&) const {}
    __device__ __forceinline__ void done(const Unit&) const {}
};
struct EpiPle {
    static constexpr bool PERM = true, AFTER_DRAIN = false;
    const bf16_t* Hin; bf16_t* Hout; const bf16_t* PP; float* outF; int last;
    __device__ __forceinline__ void operator()(const f32x4 (&acc)[2][2][4][2], const Unit& u, int wr, int wc, int fr, int fq) const {
        const int row0 = u.pm * BM + wr * 64 + fr; const int col0 = u.pn * BM + wc * 32 + 8 * fq;
#pragma unroll
        for (int ai = 0; ai < 2; ++ai) {
            u32x4 pw[4][2], hw[4][2];
#pragma unroll
            for (int m = 0; m < 4; ++m)
#pragma unroll
                for (int bj = 0; bj < 2; ++bj) { const int row = row0 + ai * HALF + m * 16, c = col0 + bj * HALF;
                    pw[m][bj] = *(const PG8_GAS u32x4*)(PP + (size_t)row * 1024 + c); hw[m][bj] = *(const PG8_GAS u32x4*)(Hin + (size_t)row * 1024 + c); }
            __builtin_amdgcn_sched_barrier(0);
#pragma unroll
            for (int m = 0; m < 4; ++m)
#pragma unroll
                for (int bj = 0; bj < 2; ++bj) { const int row = row0 + ai * HALF + m * 16, c = col0 + bj * HALF; const f32x4 v0 = acc[ai][bj][m][0], v1 = acc[ai][bj][m][1]; const u32x4 pq = pw[m][bj], hq = hw[m][bj];
                    f32x4 h0 = (f32x4){h_lo(hq.x), h_hi(hq.x), h_lo(hq.y), h_hi(hq.y)}, h1 = (f32x4){h_lo(hq.z), h_hi(hq.z), h_lo(hq.w), h_hi(hq.w)};
                    h0[0] += sigm(v0[0]) * h_lo(pq.x); h0[1] += sigm(v0[1]) * h_hi(pq.x); h0[2] += sigm(v0[2]) * h_lo(pq.y); h0[3] += sigm(v0[3]) * h_hi(pq.y);
                    h1[0] += sigm(v1[0]) * h_lo(pq.z); h1[1] += sigm(v1[1]) * h_hi(pq.z); h1[2] += sigm(v1[2]) * h_lo(pq.w); h1[3] += sigm(v1[3]) * h_hi(pq.w);
                    if (last) { float* op = outF + (size_t)row * 1024 + c; *(PG8_GAS f32x4*)op = h0; *(PG8_GAS f32x4*)(op + 4) = h1; }
                    else { u32x4 w; w.x = h_pk2(h0[0], h0[1]); w.y = h_pk2(h0[2], h0[3]); w.z = h_pk2(h1[0], h1[1]); w.w = h_pk2(h1[2], h1[3]); *(PG8_GAS u32x4*)(Hout + (size_t)row * 1024 + c) = w; } }
            __builtin_amdgcn_sched_barrier(0);
        }
    }
};
struct EpiPle2 {
    static constexpr bool PERM = true, AFTER_DRAIN = false;
    const bf16_t* Hin; bf16_t* Hout; const unsigned char* G8; float* outF; int last;
    __device__ __forceinline__ void operator()(const f32x4 (&acc)[2][2][4][2], const Unit& u, int wr, int wc, int fr, int fq) const {
        typedef unsigned u32x2 __attribute__((ext_vector_type(2)));
        const int row0 = u.pm * BM + wr * 64 + fr; const int col0 = u.pn * BM + wc * 32 + 8 * fq;
#pragma unroll
        for (int ai = 0; ai < 2; ++ai) {
            u32x2 gw[4][2]; u32x4 hw[4][2];
#pragma unroll
            for (int m = 0; m < 4; ++m)
#pragma unroll
                for (int bj = 0; bj < 2; ++bj) { const int row = row0 + ai * HALF + m * 16, c = col0 + bj * HALF;
                    gw[m][bj] = *(const PG8_GAS u32x2*)(G8 + (size_t)row * 1024 + c); hw[m][bj] = *(const PG8_GAS u32x4*)(Hin + (size_t)row * 1024 + c); }
            __builtin_amdgcn_sched_barrier(0);
#pragma unroll
            for (int m = 0; m < 4; ++m)
#pragma unroll
                for (int bj = 0; bj < 2; ++bj) { const int row = row0 + ai * HALF + m * 16, c = col0 + bj * HALF; const f32x4 v0 = acc[ai][bj][m][0], v1 = acc[ai][bj][m][1]; const u32x2 g = gw[m][bj]; const u32x4 hq = hw[m][bj];
                    float gf[8];
#pragma unroll
                    for (int e2_ = 0; e2_ < 8; ++e2_) gf[e2_] = ((float)((g[e2_ >> 2] >> (8 * (e2_ & 3))) & 255u) + 0.5f) * (1.f / 256.f);
                    f32x4 h0 = (f32x4){h_lo(hq.x), h_hi(hq.x), h_lo(hq.y), h_hi(hq.y)}, h1 = (f32x4){h_lo(hq.z), h_hi(hq.z), h_lo(hq.w), h_hi(hq.w)};
                    h0[0] += gf[0] * v0[0]; h0[1] += gf[1] * v0[1]; h0[2] += gf[2] * v0[2]; h0[3] += gf[3] * v0[3];
                    h1[0] += gf[4] * v1[0]; h1[1] += gf[5] * v1[1]; h1[2] += gf[6] * v1[2]; h1[3] += gf[7] * v1[3];
                    if (last) { float* op = outF + (size_t)row * 1024 + c; *(PG8_GAS f32x4*)op = h0; *(PG8_GAS f32x4*)(op + 4) = h1; }
                    else { u32x4 w; w.x = h_pk2(h0[0], h0[1]); w.y = h_pk2(h0[2], h0[3]); w.z = h_pk2(h1[0], h1[1]); w.w = h_pk2(h1[2], h1[3]); *(PG8_GAS u32x4*)(Hout + (size_t)row * 1024 + c) = w; } }
            __builtin_amdgcn_sched_barrier(0);
        }
    }
};
template <class E_, class = void> struct epi_chain { static constexpr bool value = false; };
template <class E_> struct epi_chain<E_, decltype((void)E_::CHAIN)> { static constexpr bool value = true; };
template <class Epi, class Sched, bool ALIGN_EPI = false, bool SP2 = false>
__device__ __forceinline__ void gemm_phase(PG8_LAS unsigned char* lds, const Gemm g, const Sched& S, const Epi& E) {
    int tid_ = my_tid(); asm volatile("" : "+v"(tid_));
    const int tid = tid_, wid = __builtin_amdgcn_readfirstlane(tid >> 6), lane = tid & 63, wr = wid >> 2, wc = wid & 3, fr = lane & 15, fq = lane >> 4;
    const int K = g.K, nt = K / BK;
    unsigned voffA[2], voffB[2];
#pragma unroll
    for (int i = 0; i < 2; ++i) { int R, C; stage_rc(tid * 16 + i * 8192, R, C); const int Rb = Epi::PERM ? ((R & ~31) + perm32(R & 31)) : R;
        voffA[i] = (unsigned)(R * K + C) * 2u; voffB[i] = (unsigned)(Rb * K + C) * 2u; }
    const size_t kstep = (size_t)(BK * 2);
    const size_t hstep = (size_t)HALF * K * 2;
    const size_t tstep = 2 * hstep;
    const unsigned ldsw = (unsigned)wid * 1024u;
    const int aoff = lds_byte(wr * 64 + fr, fq * 8), boff = lds_byte(wc * 32 + fr, fq * 8);
#define PG8_SA(b, h) (((b) * 2 + (h)) * HTB)
#define PG8_SB(b, h) ((4 + (b) * 2 + (h)) * HTB)
#define PG8_STAGE(bufoff, gbase, voff) do { _Pragma("unroll") for (int _i = 0; _i < 2; ++_i) \
        __builtin_amdgcn_global_load_lds((const unsigned*)((const char*)(gbase) + (voff)[_i]), (PG8_LAS unsigned*)(lds + (bufoff) + ldsw + _i * 8192), 16, 0, 0); } while (0)
#define PG8_LDA(dst, b, h) do { _Pragma("unroll") for (int m = 0; m < 4; ++m) _Pragma("unroll") for (int k = 0; k < 2; ++k) dst[m][k] = *(const PG8_LAS bf16x8*)(lds + PG8_SA(b, h) + aoff + m * 2048 + k * 1024); } while (0)
#define PG8_LDB(dst, b, h) do { _Pragma("unroll") for (int n = 0; n < 2; ++n) _Pragma("unroll") for (int k = 0; k < 2; ++k) dst[n][k] = *(const PG8_LAS bf16x8*)(lds + PG8_SB(b, h) + boff + n * 2048 + k * 1024); } while (0)
#define PG8_MMA(ai, bj, At, Bt) do { __builtin_amdgcn_s_setprio(1); _Pragma("unroll") for (int m = 0; m < 4; ++m) _Pragma("unroll") for (int n = 0; n < 2; ++n) _Pragma("unroll") for (int k = 0; k < 2; ++k) \
        acc[ai][bj][m][n] = MFMA16(Bt[n][k], At[m][k], acc[ai][bj][m][n]); __builtin_amdgcn_s_setprio(0); } while (0)
#define PG8_WAIT_V(n) asm volatile("s_waitcnt vmcnt(" #n ")" ::: "memory")
#define PG8_WAIT_L(n) asm volatile("s_waitcnt lgkmcnt(" #n ")" ::: "memory")
#define PG8_BAR __builtin_amdgcn_s_barrier()
#define PG8_SCHED __builtin_amdgcn_sched_barrier(0)
    Unit cur, nxt; int ui = 0;
    if (!S.next(0, cur)) return;
    f32x4 acc[2][2][4][2];
#pragma unroll
    for (int a = 0; a < 2; ++a)
#pragma unroll
        for (int b = 0; b < 2; ++b)
#pragma unroll
            for (int m = 0; m < 4; ++m)
#pragma unroll
                for (int n = 0; n < 2; ++n) acc[a][b][m][n] = (f32x4){0.f, 0.f, 0.f, 0.f};
    bf16x8 At[4][2], B0[2][2], B1[2][2];
    const char* cA = (const char*)g.A + (size_t)cur.pm * tstep; const char* cB = (const char*)g.Bt + (size_t)cur.pn * tstep;
    S.a_ready(cur);
    if constexpr (SP2) {
        PG8_STAGE(PG8_SB(0, 0), cB, voffB); PG8_STAGE(PG8_SB(0, 1), cB + hstep, voffB); PG8_STAGE(PG8_SA(0, 0), cA, voffA); PG8_STAGE(PG8_SA(0, 1), cA + hstep, voffA);
        if (wr == 1) PG8_BAR;
        PG8_WAIT_V(2); PG8_BAR;
        PG8_STAGE(PG8_SB(1, 0), cB + kstep, voffB); PG8_STAGE(PG8_SA(1, 0), cA + kstep, voffA); PG8_STAGE(PG8_SB(1, 1), cB + hstep + kstep, voffB);
        PG8_WAIT_V(6); PG8_BAR;
    } else {
        PG8_STAGE(PG8_SB(0, 0), cB, voffB); PG8_STAGE(PG8_SA(0, 0), cA, voffA); PG8_STAGE(PG8_SB(0, 1), cB + hstep, voffB); PG8_STAGE(PG8_SA(0, 1), cA + hstep, voffA);
        if (wr == 1) PG8_BAR;
        PG8_WAIT_V(4); PG8_BAR;
        PG8_STAGE(PG8_SB(1, 0), cB + kstep, voffB); PG8_STAGE(PG8_SA(1, 0), cA + kstep, voffA); PG8_STAGE(PG8_SB(1, 1), cB + hstep + kstep, voffB);
        PG8_WAIT_V(6); PG8_BAR;
    }
    for (;;) {
        const bool has_next = S.next(ui + 1, nxt);
        const char* nA = has_next ? (const char*)g.A + (size_t)nxt.pm * tstep : cA; const char* nB = has_next ? (const char*)g.Bt + (size_t)nxt.pn * tstep : cB;
        for (int t = 0; t < nt; t += 2) {
            const bool last = (t == nt - 2);
            const char* a1 = cA + (size_t)(t + 1) * kstep;
            const char* a2 = last ? nA : cA + (size_t)(t + 2) * kstep; const char* b2 = last ? nB : cB + (size_t)(t + 2) * kstep;
            const char* a3 = a2 + kstep; const char* b3 = b2 + kstep;
            if (last && has_next) S.a_ready(nxt);
            if constexpr (SP2) {
            PG8_LDB(B0, 0, 0); PG8_LDB(B1, 0, 1); PG8_SCHED; PG8_LDA(At, 0, 0); PG8_STAGE(PG8_SA(1, 1), a1 + hstep, voffA);
            PG8_WAIT_V(8); PG8_WAIT_L(0); PG8_BAR; PG8_MMA(0, 0, At, B0); PG8_MMA(0, 1, At, B1); PG8_BAR; PG8_SCHED;
            PG8_LDA(At, 0, 1); PG8_STAGE(PG8_SB(0, 0), b2, voffB); PG8_STAGE(PG8_SB(0, 1), b2 + hstep, voffB); PG8_STAGE(PG8_SA(0, 0), a2, voffA);
            PG8_WAIT_V(8); PG8_WAIT_L(0); PG8_BAR; PG8_MMA(1, 0, At, B0); PG8_MMA(1, 1, At, B1); PG8_BAR; PG8_SCHED;
            PG8_LDB(B0, 1, 0); PG8_LDB(B1, 1, 1); PG8_SCHED; PG8_LDA(At, 1, 0); PG8_STAGE(PG8_SA(0, 1), a2 + hstep, voffA);
            PG8_WAIT_V(8); PG8_WAIT_L(0); PG8_BAR; PG8_MMA(0, 0, At, B0); PG8_MMA(0, 1, At, B1); PG8_BAR; PG8_SCHED;
            PG8_LDA(At, 1, 1); PG8_STAGE(PG8_SB(1, 0), b3, voffB); PG8_STAGE(PG8_SB(1, 1), b3 + hstep, voffB); PG8_STAGE(PG8_SA(1, 0), a3, voffA);
            PG8_WAIT_V(8); PG8_WAIT_L(0); PG8_BAR; PG8_MMA(1, 0, At, B0); PG8_MMA(1, 1, At, B1); PG8_BAR; PG8_SCHED;
            } else {
            PG8_LDB(B0, 0, 0); PG8_SCHED; PG8_LDA(At, 0, 0); PG8_STAGE(PG8_SA(1, 1), a1 + hstep, voffA);
            PG8_WAIT_L(8); PG8_BAR; PG8_WAIT_L(0); PG8_MMA(0, 0, At, B0); PG8_BAR; PG8_SCHED;
            PG8_LDB(B1, 0, 1); PG8_STAGE(PG8_SB(0, 0), b2, voffB);
            PG8_BAR; PG8_WAIT_L(0); PG8_MMA(0, 1, At, B1); PG8_BAR;
            PG8_LDA(At, 0, 1); PG8_STAGE(PG8_SA(0, 0), a2, voffA);
            PG8_BAR; PG8_WAIT_L(0); PG8_MMA(1, 0, At, B0); PG8_BAR; PG8_SCHED;
            PG8_STAGE(PG8_SB(0, 1), b2 + hstep, voffB);
            PG8_WAIT_V(6); PG8_BAR; PG8_MMA(1, 1, At, B1); PG8_BAR;
            PG8_LDB(B0, 1, 0); PG8_SCHED; PG8_LDA(At, 1, 0); PG8_STAGE(PG8_SA(0, 1), a2 + hstep, voffA);
            PG8_WAIT_L(8); PG8_BAR; PG8_WAIT_L(0); PG8_MMA(0, 0, At, B0); PG8_BAR; PG8_SCHED;
            PG8_LDB(B1, 1, 1); PG8_STAGE(PG8_SB(1, 0), b3, voffB);
            PG8_BAR; PG8_WAIT_L(0); PG8_MMA(0, 1, At, B1); PG8_BAR;
            PG8_LDA(At, 1, 1); PG8_STAGE(PG8_SA(1, 0), a3, voffA);
            PG8_BAR; PG8_WAIT_L(0); PG8_MMA(1, 0, At, B0); PG8_BAR; PG8_SCHED;
            PG8_STAGE(PG8_SB(1, 1), b3 + hstep, voffB);
            PG8_WAIT_V(6); PG8_BAR; PG8_MMA(1, 1, At, B1); PG8_BAR;
            }
        }
        if constexpr (ALIGN_EPI) { if (wr == 0) PG8_BAR; }
        if constexpr (!Epi::AFTER_DRAIN) { int t2_ = my_tid(); asm volatile("" : "+v"(t2_)); const int l2_ = t2_ & 63, w2_ = __builtin_amdgcn_readfirstlane(t2_ >> 6);
            E(acc, cur, w2_ >> 2, w2_ & 3, l2_ & 15, l2_ >> 4); S.done(cur); }
        if (!has_next) break;
        bool keep_acc_ = false;
        if constexpr (epi_chain<Epi>::value) keep_acc_ = E.chain(cur);
        if (!keep_acc_) {
#pragma unroll
        for (int a = 0; a < 2; ++a)
#pragma unroll
            for (int b = 0; b < 2; ++b)
#pragma unroll
                for (int m = 0; m < 4; ++m)
#pragma unroll
                    for (int n = 0; n < 2; ++n) acc[a][b][m][n] = (f32x4){0.f, 0.f, 0.f, 0.f};
        }
        cur = nxt; cA = nA; cB = nB; ++ui;
        if constexpr (ALIGN_EPI) { if (wr == 1) PG8_BAR; }
    }
    PG8_WAIT_V(0);
    if constexpr (!ALIGN_EPI) { if (wr == 0) PG8_BAR; }
    PG8_BAR;
    if constexpr (Epi::AFTER_DRAIN) { E.fused(acc, cur, wr, wc, fr, fq, lds, wid, lane); S.done(cur); }
#undef PG8_SA
#undef PG8_SB
#undef PG8_STAGE
#undef PG8_LDA
#undef PG8_LDB
#undef PG8_MMA
#undef PG8_WAIT_V
#undef PG8_WAIT_L
#undef PG8_BAR
#undef PG8_SCHED
}
}
constexpr int NWAVES = 8;
constexpr int D = 1024, BATCH = 8, SEQ = 4096, T = BATCH * SEQ, DEPTH = 2, FF = 4096, DPLE = 256;
constexpr int IN_COLS = 6848, RW_COLS = 1792;
constexpr float NORM_EPS = 1e-6f, RW_LN_EPS = 64e-5f;
constexpr float LOG2E = 1.4426950408889634f;
constexpr float MLA_QSCALE = 0.07216878364870322f * LOG2E;
constexpr float CA_QSCALE = 0.125f * LOG2E;
constexpr size_t MiB = 1u << 20;
constexpr size_t WS_CTL = 0, CTL_ZERO_BYTES = 1 * MiB;
constexpr size_t WS_RS1 = 512 * 1024, WS_RS2 = 640 * 1024;
static_assert(DEPTH % 2 == 0, "the residual stream ping-pongs between d_out and WS_U: the last layer must read it from WS_U");
constexpr size_t WS_ROPE = 1 * MiB;
constexpr size_t WS_W = 9 * MiB;
constexpr size_t W_IN = WS_W, W_Q = W_IN + (size_t)6912 * 1024 * 2, W_LORA = W_Q + (size_t)768 * 256 * 2, W_B = W_LORA + (size_t)1536 * 256 * 2,
                 W_OUT = W_B + (size_t)3 * 1024 * 512 * 2, W_1 = W_OUT + (size_t)1024 * 1024 * 2, W_2 = W_1 + (size_t)4096 * 1024 * 2, W_G = W_2 + (size_t)4096 * 1024 * 2,
                 W_P = W_G + (size_t)1024 * 1024 * 2, W_END = W_P + (size_t)1024 * 256 * 2;
constexpr size_t WS_U = 49 * MiB;
constexpr size_t WS_OA = 113 * MiB, WS_OC = 145 * MiB, WS_ORW = 177 * MiB;
constexpr size_t WS_X = 209 * MiB, WS_END = 512 * MiB;
constexpr size_t X_ZC = WS_X, X_QP = X_ZC + (size_t)T * 1536 * 2, X_KV = X_QP + (size_t)T * 768 * 2, X_ZR = X_KV + (size_t)T * 192 * 2, X_TW = X_ZR + (size_t)T * 1792 * 2;
constexpr size_t X_GCT = X_TW + (size_t)T * 512 * 2, X_CBG = X_GCT + (size_t)(T / 16) * 512 * 2;
constexpr size_t X_BND = WS_OC;
constexpr size_t X_QN = WS_OC, X_LA = WS_OC + (size_t)T * 256 * 2;
constexpr size_t DO_G = 0, DO_TA = 32 * MiB, DO_H16 = 64 * MiB;
constexpr size_t X_STG = WS_X + 96 * MiB;
constexpr size_t X_GT = WS_X, X_MG = X_GT + (size_t)T * 3072 * 2;
constexpr size_t X_HID = WS_X, X_PB = WS_X, X_PP = X_PB + (size_t)T * 256 * 2;
static_assert(X_CBG + (size_t)T * 8 * 4 <= WS_END && X_TW + (size_t)T * 512 * 2 <= WS_END && X_MG + (size_t)T * 1024 * 2 <= WS_END && X_HID + (size_t)T * 4096 * 2 <= WS_END, "X map");
constexpr int CW_TMO = 0, CW_QUEUE = 1024  , CW_SUB = 2048  , CW_BAR = 4096;
constexpr int RING_OFF = 0, RING_BYTES = 131072;
constexpr int LDSCTL_OFF = RING_BYTES, MISC_OFF = LDSCTL_OFF + 320;
constexpr int LDS_BYTES = 147456;

#define GAS __attribute__((address_space(1)))
#define LAS __attribute__((address_space(3)))
typedef unsigned short bf16;
typedef unsigned v4u __attribute__((ext_vector_type(4)));
typedef unsigned v2u __attribute__((ext_vector_type(2)));
typedef float f32x4 __attribute__((ext_vector_type(4)));
typedef float f32x16 __attribute__((ext_vector_type(16)));
typedef short bf16x8 __attribute__((ext_vector_type(8)));
typedef short s16x4 __attribute__((ext_vector_type(4)));
#define LDS_WAIT() asm volatile("s_waitcnt lgkmcnt(0)" ::: "memory")
#define VM_WAIT() asm volatile("s_waitcnt vmcnt(0)" ::: "memory")
__device__ __forceinline__ unsigned f2bf(float f) { return h_f2h(f); }
__device__ __forceinline__ unsigned pk2(float lo, float hi) { return h_pk2(lo, hi); }
__device__ __forceinline__ float bfl(unsigned w) { return h_lo(w); }
__device__ __forceinline__ float bfh(unsigned w) { return h_hi(w); }
__device__ __forceinline__ float sigmoidf_(float x) { return 1.0f / (1.0f + __expf(-x)); }
__device__ __forceinline__ float shfl_xor_f(float v, int o, int lane) { return __int_as_float(__builtin_amdgcn_ds_bpermute((lane ^ o) << 2, __float_as_int(v))); }
template <int CTRL> __device__ __forceinline__ float dpp_add_(float v) { return v + __int_as_float(__builtin_amdgcn_update_dpp(0, __float_as_int(v), CTRL, 0xf, 0xf, true)); }
__device__ __forceinline__ float wave_sum(float v, int lane) {
    v = dpp_add_<0xB1>(v); v = dpp_add_<0x4E>(v); v = dpp_add_<0x141>(v); v = dpp_add_<0x140>(v);
    v += shfl_xor_f(v, 16, lane); v += shfl_xor_f(v, 32, lane);
    return v;
}
__device__ __forceinline__ unsigned char* opq(unsigned char* p) { asm volatile("" : "+s"(p)); return p; }
__device__ __forceinline__ float fsig(float x) { return __builtin_amdgcn_rcpf(1.0f + __builtin_amdgcn_exp2f(-LOG2E * x)); }
#define XB_TMO      128
#define XB_XCNT(j)  (256  + 64 * (j))
#define XB_XSUB(j)  (1280 + 64 * (j))
#define XB_XGEN(j)  (2304 + 64 * (j))
#define XB_TOP      3328
#define XB_TOPGEN   3392
#define XCD_BAR_WORDS 3456
#define XB_SPIN_CAP (1u << 25)

__device__ __forceinline__ unsigned xb_ld(unsigned* p)              { return __hip_atomic_load(p, __ATOMIC_RELAXED, __HIP_MEMORY_SCOPE_AGENT); }
__device__ __forceinline__ unsigned xb_add(unsigned* p, unsigned v) { return __hip_atomic_fetch_add(p, v, __ATOMIC_RELAXED, __HIP_MEMORY_SCOPE_AGENT); }
__device__ __forceinline__ unsigned xb_xcc_id() { return (unsigned)__builtin_amdgcn_s_getreg((3 << 11) | 20) & 0xFu; }
#define XB_SPIN(cond, bar) do { unsigned _sp = 0; while (cond) { __builtin_amdgcn_s_sleep(1); \
    if ((++_sp & 255u) == 0u) { if (xb_ld(&(bar)[XB_TMO])) break; if (_sp > XB_SPIN_CAP) { atomicAdd(&(bar)[XB_TMO], 1u); break; } } } } while (0)

struct XcdBarrier {
    unsigned* bar; unsigned x;
    volatile LAS unsigned* st;
};

__device__ __forceinline__ XcdBarrier xcd_barrier_post(unsigned* bar, volatile LAS unsigned* st) {
    XcdBarrier b; b.bar = bar; b.x = xb_xcc_id(); b.st = st;
    if (my_tid() == 0) (void)xb_add(&bar[XB_XCNT(b.x)], 1u);
    return b;
}
__device__ __forceinline__ void xcd_barrier_complete(unsigned* bar, unsigned x, unsigned& nloc, unsigned& nx) {
    const unsigned G = gridDim.x * gridDim.y * gridDim.z;
    unsigned sum, cnt, mine, sp = 0u;
    for (;;) {
        sum = 0u; cnt = 0u; mine = 0u;
#pragma unroll
        for (unsigned j = 0; j < 16; ++j) { const unsigned c = xb_ld(&bar[XB_XCNT(j)]); sum += c; cnt += (c > 0u) ? 1u : 0u; mine = (j == x) ? c : mine; }
        if (sum == G) break;
        __builtin_amdgcn_s_sleep(1);
        if ((++sp & 255u) == 0u) { if (xb_ld(&bar[XB_TMO])) break; if (sp > XB_SPIN_CAP) { atomicAdd(&bar[XB_TMO], 1u); break; } }
    }
    nloc = mine > 0u ? mine : 1u; nx = cnt > 0u ? cnt : 1u;
}

__device__ __forceinline__ void xcd_barrier(const XcdBarrier& b) {
    asm volatile("s_waitcnt vmcnt(0)" ::: "memory");
    __syncthreads();
    if (my_tid() == 0) {
        unsigned* bar = b.bar;
        __builtin_amdgcn_s_waitcnt(0);
        unsigned nloc = b.st[0], nx = b.st[1];
        if (nloc == 0u) { xcd_barrier_complete(bar, b.x, nloc, nx); b.st[0] = nloc; b.st[1] = nx; }
        const unsigned old = xb_add(&bar[XB_XSUB(b.x)], 1u);
        const unsigned gen = old / nloc;
        if (old + 1u == (gen + 1u) * nloc) {
            __builtin_amdgcn_fence(__ATOMIC_RELEASE, "agent");
            asm volatile("s_waitcnt vmcnt(0)" ::: "memory");
            const unsigned og = xb_add(&bar[XB_TOP], 1u);
            const unsigned tg = og / nx;
            if (og + 1u == (tg + 1u) * nx) xb_add(&bar[XB_TOPGEN], 1u);
            else XB_SPIN(xb_ld(&bar[XB_TOPGEN]) == tg, bar);
            __builtin_amdgcn_fence(__ATOMIC_ACQUIRE, "agent");
            xb_add(&bar[XB_XGEN(b.x)], 1u);
            asm volatile("s_waitcnt vmcnt(0)" ::: "memory");
        } else {
            XB_SPIN(xb_ld(&bar[XB_XGEN(b.x)]) == gen, bar);
            __builtin_amdgcn_fence(__ATOMIC_ACQUIRE, "agent");
            asm volatile("s_waitcnt vmcnt(0)" ::: "memory");
        }
    }
    __syncthreads();
}

__device__ __forceinline__ void sub_barrier(unsigned* bar, unsigned* ctr, unsigned n, bool arrive) {
    asm volatile("s_waitcnt vmcnt(0)" ::: "memory");
    __syncthreads();
    if (my_tid() == 0) {
        if (arrive) { __builtin_amdgcn_fence(__ATOMIC_RELEASE, "agent"); asm volatile("s_waitcnt vmcnt(0)" ::: "memory"); (void)xb_add(ctr, 1u); }
        XB_SPIN(xb_ld(ctr) < n, bar);
        __builtin_amdgcn_fence(__ATOMIC_ACQUIRE, "agent");
        asm volatile("s_waitcnt vmcnt(0)" ::: "memory");
    }
    __syncthreads();
}
namespace att {
__device__ __forceinline__ int crow(int r, int hi) { return (r & 3) + 8 * (r >> 2) + 4 * hi; }
__device__ __forceinline__ unsigned cvtpk(float lo, float hi) { return h_pk2(lo, hi); }
typedef short v4i16_t __attribute__((ext_vector_type(4)));
__device__ __forceinline__ s16x4 vtr(const LAS unsigned char* p) { return __builtin_bit_cast(s16x4, __builtin_amdgcn_ds_read_tr16_b64_v4i16((LAS v4i16_t*)p)); }
__device__ __forceinline__ float softmax_tile(f32x16& p0, f32x16& p1, float& m_reg, float& l_reg, bf16x8& pa0, bf16x8& pa1, bf16x8& pa2, bf16x8& pa3) {
    float pmax = p0[0];
#pragma unroll
    for (int r = 1; r < 16; ++r) pmax = fmaxf(pmax, p0[r]);
#pragma unroll
    for (int r = 0; r < 16; ++r) pmax = fmaxf(pmax, p1[r]);
    { auto rr = __builtin_amdgcn_permlane32_swap(__float_as_uint(pmax), __float_as_uint(pmax), false, false); pmax = fmaxf(__uint_as_float(rr[0]), __uint_as_float(rr[1])); }
    float alpha = 1.f;
    if (!__all(pmax - m_reg <= 8.f)) { const float mn = fmaxf(m_reg, pmax); alpha = __builtin_amdgcn_exp2f(m_reg - mn); m_reg = mn; }
    float ps = 0.f;
#pragma unroll
    for (int r = 0; r < 16; ++r) { p0[r] = __builtin_amdgcn_exp2f(p0[r] - m_reg); ps += p0[r]; }
#pragma unroll
    for (int r = 0; r < 16; ++r) { p1[r] = __builtin_amdgcn_exp2f(p1[r] - m_reg); ps += p1[r]; }
    { auto rr = __builtin_amdgcn_permlane32_swap(__float_as_uint(ps), __float_as_uint(ps), false, false); ps = __uint_as_float(rr[0]) + __uint_as_float(rr[1]); }
    l_reg = l_reg * alpha + ps;
#define PK4(P, BASE, OUT) do { unsigned a0 = cvtpk(P[BASE + 0], P[BASE + 1]), a1 = cvtpk(P[BASE + 2], P[BASE + 3]);   \
    unsigned b0 = cvtpk(P[BASE + 4], P[BASE + 5]), b1 = cvtpk(P[BASE + 6], P[BASE + 7]);                              \
    auto r0 = __builtin_amdgcn_permlane32_swap(a0, b0, false, false); auto r1 = __builtin_amdgcn_permlane32_swap(a1, b1, false, false); \
    v4u w = {r0[0], r1[0], r0[1], r1[1]}; OUT = __builtin_bit_cast(bf16x8, w); } while (0)
    PK4(p0, 0, pa0); PK4(p0, 8, pa1); PK4(p1, 0, pa2); PK4(p1, 8, pa3);
#undef PK4
    return alpha;
}
constexpr int MLA_KSTR = 400;
constexpr int MLA_KBUF = 64 * MLA_KSTR;
constexpr int ATT_SCR = 2 * MLA_KBUF;
__device__ __forceinline__ void mla_unit(LAS unsigned char* lds, const bf16* __restrict__ QP, const bf16* __restrict__ KV, bf16* __restrict__ OA, int b, int c) {
    int tid_ = my_tid(); asm volatile("" : "+v"(tid_));
    const int tid = tid_, lane = tid & 63, wid = __builtin_amdgcn_readfirstlane(tid >> 6), r32 = lane & 31, hi = lane >> 5;
    const int h = wid >> 1; const size_t qrow0 = (size_t)b * SEQ + c * 64 + (wid & 1) * 32;
    bf16x8 qr[12];
    { const bf16* qp = QP + (qrow0 + r32) * 768 + h * 192 + hi * 8;
#pragma unroll
      for (int d0 = 0; d0 < 12; ++d0) qr[d0] = *(const GAS bf16x8*)(qp + d0 * 16); }
    float m_reg = -1e30f, l_reg = 0.f; f32x16 o[4];
#pragma unroll
    for (int d = 0; d < 4; ++d)
#pragma unroll
        for (int r = 0; r < 16; ++r) o[d][r] = 0.f;
    LAS float* scr = (LAS float*)(lds + ATT_SCR) + wid * 64;
    const bf16* kvb = KV + (size_t)b * SEQ * 192;
    int skey[3], sch[3];
#pragma unroll
    for (int i = 0; i < 3; ++i) { const int id = tid + 512 * i; skey[i] = id / 24; sch[i] = id % 24; }
    v4u st[3];
    const int NT = c + 1;
#pragma unroll
    for (int i = 0; i < 3; ++i) st[i] = *(const GAS v4u*)(kvb + (size_t)skey[i] * 192 + sch[i] * 8);
#pragma unroll
    for (int i = 0; i < 3; ++i) *(LAS v4u*)(lds + skey[i] * MLA_KSTR + sch[i] * 16) = st[i];
    asm volatile("" : "+v"(qr[0]), "+v"(qr[1]), "+v"(qr[2]), "+v"(qr[3]), "+v"(qr[4]), "+v"(qr[5]), "+v"(qr[6]), "+v"(qr[7]), "+v"(qr[8]), "+v"(qr[9]), "+v"(qr[10]), "+v"(qr[11]));
    __syncthreads();
    const int troff = (((lane & 15) >> 2) + 8 * hi) * MLA_KSTR + (16 * ((lane >> 4) & 1) + 4 * (lane & 3)) * 2;
    for (int j = 0; j < NT; ++j) {
        const int buf = j & 1;
        if (j + 1 < NT) {
#pragma unroll
            for (int i = 0; i < 3; ++i) st[i] = *(const GAS v4u*)(kvb + (size_t)(64 * (j + 1) + skey[i]) * 192 + sch[i] * 8);
        }
        const LAS unsigned char* kt = lds + buf * MLA_KBUF;
        f32x16 p0, p1;
#pragma unroll
        for (int r = 0; r < 16; ++r) { p0[r] = 0.f; p1[r] = 0.f; }
        const LAS unsigned char* vb = kt + troff;
        s16x4 vlo[2][4], vhh[2][4];
#define MLA_LDV(G, B) do { _Pragma("unroll") for (int ks = 0; ks < 4; ++ks) { vlo[B][ks] = vtr(vb + (16 * ks) * MLA_KSTR + (G) * 64); vhh[B][ks] = vtr(vb + (16 * ks + 4) * MLA_KSTR + (G) * 64); } } while (0)
        {
            const LAS unsigned char* kb = kt + r32 * MLA_KSTR + hi * 16;
            bf16x8 fa[2][3], fb[2][3];
#define MLA_LDK(G, B) do { _Pragma("unroll") for (int i = 0; i < 3; ++i) { fa[B][i] = *(const LAS bf16x8*)(kb + (3 * (G) + i) * 32); fb[B][i] = *(const LAS bf16x8*)(kb + 32 * MLA_KSTR + (3 * (G) + i) * 32); } } while (0)
            MLA_LDK(0, 0);
            __builtin_amdgcn_sched_barrier(0);
#pragma unroll
            for (int g = 0; g < 4; ++g) {
                if (g < 3) MLA_LDK(g + 1, (g + 1) & 1); else MLA_LDV(0, 0);
                __builtin_amdgcn_sched_barrier(0);
#pragma unroll
                for (int i = 0; i < 3; ++i) { p0 = MFMA32(fa[g & 1][i], qr[3 * g + i], p0); p1 = MFMA32(fb[g & 1][i], qr[3 * g + i], p1); }
                __builtin_amdgcn_sched_barrier(0);
            }
#undef MLA_LDK
        }
        bf16x8 pa0, pa1, pa2, pa3;
        const float alpha = softmax_tile(p0, p1, m_reg, l_reg, pa0, pa1, pa2, pa3);
        if (__any(alpha < 1.f)) { if (hi == 0) scr[r32] = alpha; LDS_WAIT();
#pragma unroll
            for (int r = 0; r < 16; ++r) { const float a = scr[crow(r, hi)];
#pragma unroll
                for (int d = 0; d < 4; ++d) o[d][r] *= a; } }
        __builtin_amdgcn_sched_barrier(0);
#pragma unroll
        for (int d0 = 0; d0 < 4; ++d0) {
            if (d0 < 3) MLA_LDV(d0 + 1, (d0 + 1) & 1);
            __builtin_amdgcn_sched_barrier(0);
#define PK(k) (bf16x8){vlo[d0 & 1][k][0], vlo[d0 & 1][k][1], vlo[d0 & 1][k][2], vlo[d0 & 1][k][3], vhh[d0 & 1][k][0], vhh[d0 & 1][k][1], vhh[d0 & 1][k][2], vhh[d0 & 1][k][3]}
            o[d0] = MFMA32(pa0, PK(0), o[d0]);
            o[d0] = MFMA32(pa1, PK(1), o[d0]);
            o[d0] = MFMA32(pa2, PK(2), o[d0]);
            o[d0] = MFMA32(pa3, PK(3), o[d0]);
#undef PK
            __builtin_amdgcn_sched_barrier(0);
        }
#undef MLA_LDV
        if (j + 1 < NT) {
#pragma unroll
            for (int i = 0; i < 3; ++i) *(LAS v4u*)(lds + (buf ^ 1) * MLA_KBUF + skey[i] * MLA_KSTR + sch[i] * 16) = st[i];
        }
        __syncthreads();
    }
    if (hi == 0) scr[r32] = l_reg; LDS_WAIT();
    bf16* ob = OA + qrow0 * 512 + h * 128 + r32;
#pragma unroll
    for (int r = 0; r < 16; ++r) { const int orow = crow(r, hi); const float rl = __builtin_amdgcn_rcpf(scr[orow]);
#pragma unroll
        for (int d0 = 0; d0 < 4; ++d0) *(GAS bf16*)(ob + (size_t)orow * 512 + d0 * 32) = (bf16)f2bf(o[d0][r] * rl); }
    __syncthreads();
}
constexpr int CA_KSTR = 144;
constexpr int CA_TBUF = 64 * CA_KSTR;
constexpr int CA_BIAS = ATT_SCR + 8 * 256;
__device__ __forceinline__ void band_unit(LAS unsigned char* lds, const bf16* __restrict__ ZC, const float* __restrict__ relb, bf16* __restrict__ OC, int b, int h, int g) {
    int tid_ = my_tid(); asm volatile("" : "+v"(tid_));
    const int tid = tid_, lane = tid & 63, wid = __builtin_amdgcn_readfirstlane(tid >> 6), r32 = lane & 31, hi = lane >> 5;
    const int cw = 4 * g + (wid >> 1); const size_t qrow0 = (size_t)b * SEQ + cw * 64 + (wid & 1) * 32;
    LAS float* bias = (LAS float*)(lds + CA_BIAS);
    if (tid < 320) bias[tid] = *(const GAS float*)(relb + tid * 8 + h) * LOG2E;
    bf16x8 qr[4];
    { const bf16* qp = ZC + (qrow0 + r32) * 1536 + h * 64 + hi * 8;
#pragma unroll
      for (int d0 = 0; d0 < 4; ++d0) qr[d0] = *(const GAS bf16x8*)(qp + d0 * 16); }
    float m_reg = -1e30f, l_reg = 0.f; f32x16 o[2];
#pragma unroll
    for (int d = 0; d < 2; ++d)
#pragma unroll
        for (int r = 0; r < 16; ++r) o[d][r] = 0.f;
    LAS float* scr = (LAS float*)(lds + ATT_SCR) + wid * 64;
    const int kc0 = (4 * g - 8) < 0 ? 0 : (4 * g - 8), kc1 = 4 * g + 3;
    const bf16* kbase = ZC + (size_t)b * SEQ * 1536 + 512 + h * 64; const bf16* vbase = kbase + 512;
    const int skey = tid >> 3, sch = tid & 7;
    v4u stk, stv;
    stk = *(const GAS v4u*)(kbase + (size_t)(64 * kc0 + skey) * 1536 + sch * 8); stv = *(const GAS v4u*)(vbase + (size_t)(64 * kc0 + skey) * 1536 + sch * 8);
    *(LAS v4u*)(lds + skey * CA_KSTR + sch * 16) = stk; *(LAS v4u*)(lds + CA_TBUF + skey * CA_KSTR + sch * 16) = stv;
    asm volatile("" : "+v"(qr[0]), "+v"(qr[1]), "+v"(qr[2]), "+v"(qr[3]));
    __syncthreads();
    const int troff = (((lane & 15) >> 2) + 8 * hi) * CA_KSTR + (16 * ((lane >> 4) & 1) + 4 * (lane & 3)) * 2;
    const int qin = (wid & 1) * 32 + r32;
    for (int kc = kc0; kc <= kc1; ++kc) {
        const int buf = (kc - kc0) & 1;
        if (kc < kc1) { stk = *(const GAS v4u*)(kbase + (size_t)(64 * (kc + 1) + skey) * 1536 + sch * 8); stv = *(const GAS v4u*)(vbase + (size_t)(64 * (kc + 1) + skey) * 1536 + sch * 8); }
        if (kc >= cw - 8 && kc <= cw) {
            const LAS unsigned char* kt = lds + buf * 2 * CA_TBUF;
            f32x16 p0, p1;
            const int dbase = (cw - kc) * 64 + qin + 63;
#pragma unroll
            for (int r = 0; r < 16; ++r) { int i0 = dbase - crow(r, hi), i1 = i0 - 32; i0 = i0 > 319 ? 319 : i0; i1 = i1 > 319 ? 319 : i1; p0[r] = bias[i0]; p1[r] = bias[i1]; }
            const LAS unsigned char* vb = kt + CA_TBUF + troff;
            s16x4 vlo[2][4], vhh[2][4];
#define CA_LDV(G) do { _Pragma("unroll") for (int ks = 0; ks < 4; ++ks) { vlo[G][ks] = vtr(vb + (16 * ks) * CA_KSTR + (G) * 64); vhh[G][ks] = vtr(vb + (16 * ks + 4) * CA_KSTR + (G) * 64); } } while (0)
            {
                const LAS unsigned char* kb = kt + r32 * CA_KSTR + hi * 16;
                bf16x8 fa[4], fb[4];
#pragma unroll
                for (int d0 = 0; d0 < 4; ++d0) { fa[d0] = *(const LAS bf16x8*)(kb + d0 * 32); fb[d0] = *(const LAS bf16x8*)(kb + 32 * CA_KSTR + d0 * 32); }
                CA_LDV(0);
                __builtin_amdgcn_sched_barrier(0);
#pragma unroll
                for (int d0 = 0; d0 < 4; ++d0) { p0 = MFMA32(fa[d0], qr[d0], p0); p1 = MFMA32(fb[d0], qr[d0], p1); }
                __builtin_amdgcn_sched_barrier(0);
            }
            bf16x8 pa0, pa1, pa2, pa3;
            const float alpha = softmax_tile(p0, p1, m_reg, l_reg, pa0, pa1, pa2, pa3);
            if (__any(alpha < 1.f)) { if (hi == 0) scr[r32] = alpha; LDS_WAIT();
#pragma unroll
                for (int r = 0; r < 16; ++r) { const float a = scr[crow(r, hi)]; o[0][r] *= a; o[1][r] *= a; } }
            __builtin_amdgcn_sched_barrier(0);
            CA_LDV(1);
            __builtin_amdgcn_sched_barrier(0);
#pragma unroll
            for (int d0 = 0; d0 < 2; ++d0) {
#define PK(k) (bf16x8){vlo[d0][k][0], vlo[d0][k][1], vlo[d0][k][2], vlo[d0][k][3], vhh[d0][k][0], vhh[d0][k][1], vhh[d0][k][2], vhh[d0][k][3]}
                o[d0] = MFMA32(pa0, PK(0), o[d0]);
                o[d0] = MFMA32(pa1, PK(1), o[d0]);
                o[d0] = MFMA32(pa2, PK(2), o[d0]);
                o[d0] = MFMA32(pa3, PK(3), o[d0]);
#undef PK
            }
            __builtin_amdgcn_sched_barrier(0);
#undef CA_LDV
        }
        if (kc < kc1) { *(LAS v4u*)(lds + (buf ^ 1) * 2 * CA_TBUF + skey * CA_KSTR + sch * 16) = stk; *(LAS v4u*)(lds + (buf ^ 1) * 2 * CA_TBUF + CA_TBUF + skey * CA_KSTR + sch * 16) = stv; }
        __syncthreads();
    }
    if (hi == 0) scr[r32] = l_reg; LDS_WAIT();
    bf16* ob = OC + qrow0 * 512 + h * 64 + r32;
#pragma unroll
    for (int r = 0; r < 16; ++r) { const int orow = crow(r, hi); const float rl = __builtin_amdgcn_rcpf(scr[orow]);
        *(GAS bf16*)(ob + (size_t)orow * 512) = (bf16)f2bf(o[0][r] * rl); *(GAS bf16*)(ob + (size_t)orow * 512 + 32) = (bf16)f2bf(o[1][r] * rl); }
    __syncthreads();
}
}
struct Args { const float* in[30]; float* out; unsigned char* ws; int start; int stop; };
#define KAS __attribute__((address_space(4)))
__device__ __forceinline__ const KAS unsigned char* kbase() { const KAS unsigned char* p = (const KAS unsigned char*)__builtin_amdgcn_kernarg_segment_ptr(); asm volatile("" : "+s"(p)); return p; }
__device__ __forceinline__ const float* kin(int i) { return *(const float* const KAS*)(kbase() + 8 * i); }
__device__ __forceinline__ float* kout() { return *(float* const KAS*)(kbase() + 240); }
__device__ __forceinline__ unsigned char* kws() { return *(unsigned char* const KAS*)(kbase() + 248); }
__device__ __forceinline__ int kstart() { return *(const int KAS*)(kbase() + 256); }
__device__ __forceinline__ int kstop() { return *(const int KAS*)(kbase() + 260); }
struct Frame { LAS unsigned char* lds; int tid, lane, wave, G, gw, NGW; };
__device__ __forceinline__ Frame make_frame(LAS unsigned char* lds) {
    Frame F; int tid = my_tid(); asm volatile("" : "+v"(tid)); int bx = blockIdx.x; asm volatile("" : "+s"(bx)); int G = gridDim.x; asm volatile("" : "+s"(G));
    F.lds = lds; F.tid = tid; F.lane = tid & 63; F.wave = __builtin_amdgcn_readfirstlane(tid >> 6); F.G = G; F.gw = bx * NWAVES + F.wave; F.NGW = G * NWAVES; return F;
}

__device__ const double ROPE_INV_FREQ[32] = {1, 0.74989420933245587, 0.56234132519034907, 0.42169650342858223, 0.31622776601683794, 0.23713737056616552, 0.17782794100389229, 0.1333521432163324, 0.10000000000000001, 0.074989420933245579, 0.056234132519034911, 0.042169650342858224, 0.031622776601683791, 0.023713737056616554, 0.017782794100389229, 0.013335214321633241, 0.01, 0.0074989420933245579, 0.005623413251903491, 0.0042169650342858229, 0.0031622776601683794, 0.0023713737056616554, 0.0017782794100389228, 0.0013335214321633241, 0.001, 0.00074989420933245586, 0.0005623413251903491, 0.00042169650342858224, 0.00031622776601683794, 0.00023713737056616554, 0.00017782794100389227, 0.0001333521432163324};
__device__ __forceinline__ void sincos_d(double a, float& s, float& c) {
    const double n = rint(a * 0.63661977236758134308);
    double r = fma(-n, 1.5707963267948966192, a); r = fma(-n, 6.123233995736766036e-17, r);
    const double r2 = r * r;
    double sp = -7.6471637318198164759e-13; sp = fma(sp, r2, 1.6059043836821614599e-10); sp = fma(sp, r2, -2.5052108385441718775e-08); sp = fma(sp, r2, 2.7557319223985890653e-06);
    sp = fma(sp, r2, -1.9841269841269841270e-04); sp = fma(sp, r2, 8.3333333333333333333e-03); sp = fma(sp, r2, -1.6666666666666666667e-01);
    const double sn = fma(sp * r2, r, r);
    double cp = 4.7794773323873852974e-14; cp = fma(cp, r2, -1.1470745597729724714e-11); cp = fma(cp, r2, 2.0876756987868098979e-09); cp = fma(cp, r2, -2.7557319223985890653e-07);
    cp = fma(cp, r2, 2.4801587301587301587e-05); cp = fma(cp, r2, -1.3888888888888888889e-03); cp = fma(cp, r2, 4.1666666666666666667e-02); cp = fma(cp, r2, -0.5);
    const double cs = fma(cp, r2, 1.0);
    const long long q = (long long)n & 3LL; double so, co;
    if (q == 0) { so = sn; co = cs; } else if (q == 1) { so = cs; co = -sn; } else if (q == 2) { so = -sn; co = -cs; } else { so = -cs; co = sn; }
    s = (float)so; c = (float)co;
}
struct TrDesc { const float* W; int ldw, col0, nblk; bf16* WT; int ldt, row0; const float* gk; int item; };
__device__ __forceinline__ void tr_load(const TrDesc& d, int lane, float (&tv)[32]) {
    const int kb = d.item / d.nblk, nb = d.item % d.nblk, k0 = 64 * kb, n0 = 32 * nb;
#pragma unroll
    for (int i = 0; i < 32; ++i) tv[i] = *(const GAS float*)(d.W + (size_t)(k0 + 2 * i + (lane >> 5)) * d.ldw + d.col0 + n0 + (lane & 31));
}
__device__ __forceinline__ void tr_finish(const TrDesc& d, int lane, const float (&tv)[32], LAS float* scr) {
    const int kb = d.item / d.nblk, nb = d.item % d.nblk, k0 = 64 * kb, n0 = 32 * nb;
#pragma unroll
    for (int i = 0; i < 32; ++i) scr[(2 * i + (lane >> 5)) * 33 + (lane & 31)] = tv[i];
    LDS_WAIT(); asm volatile("" ::: "memory");
    const int c = lane & 7;
    f32x4 ga = {1.f, 1.f, 1.f, 1.f}, gb = {1.f, 1.f, 1.f, 1.f};
    if (d.gk) { ga = *(const GAS f32x4*)(d.gk + k0 + 8 * c); gb = *(const GAS f32x4*)(d.gk + k0 + 8 * c + 4); }
#pragma unroll
    for (int j = 0; j < 4; ++j) { const int n = (lane >> 3) + 8 * j; const LAS float* s = scr + (8 * c) * 33 + n;
        v4u o; o.x = pk2(s[0 * 33] * ga[0], s[1 * 33] * ga[1]); o.y = pk2(s[2 * 33] * ga[2], s[3 * 33] * ga[3]); o.z = pk2(s[4 * 33] * gb[0], s[5 * 33] * gb[1]); o.w = pk2(s[6 * 33] * gb[2], s[7 * 33] * gb[3]);
        *(GAS v4u*)(d.WT + (size_t)(d.row0 + n0 + n) * d.ldt + k0 + 8 * c) = o; }
    LDS_WAIT(); asm volatile("" ::: "memory");
}
__device__ __forceinline__ void rope_table(LAS unsigned char* lds_) {
    const Frame F = make_frame(lds_); const int gt = F.gw * 64 + F.lane, NTH = F.NGW * 64;
    const int* pos = (const int*)kin(2); float* rope = (float*)(kws() + WS_ROPE);
    for (int i = gt; i < T * 32; i += NTH) { float s, c; sincos_d((double)pos[i >> 5] * ROPE_INV_FREQ[i & 31], s, c); rope[2 * (size_t)i] = c; rope[2 * (size_t)i + 1] = s; }
}
__device__ __forceinline__ void p0_prologue(LAS unsigned char* lds_, const Args& A, int l) {
    const Frame F = make_frame(lds_);
    LAS float* scr = (LAS float*)(F.lds + RING_OFF + F.wave * 16384);
    constexpr int I1 = 16 * 14, I2 = 16 * 48, I3 = 16 * 56, I4 = 16 * 96, I5 = 8 * 32, I6 = 8 * 32, I7 = 16 * 32, I8 = 16 * 128, I9 = 64 * 32, I10 = 16 * 32, I11 = 4 * 32;
    constexpr int NITEMS = I1 + I2 + I3 + I4 + I5 + I6 + I7 + I8 + I9 + I10 + I11;
#define WIN_ (kin(4) + (size_t)l * 1024 * IN_COLS)
#define WBR_ (kin(21) + (size_t)l * 1536 * 1024)
    auto desc = [&](int it) __attribute__((always_inline)) { TrDesc d; int r = it; unsigned char* ws_ = kws(); const float* g1_ = kin(3) + l * 1024;
        if (r < I1) { d = TrDesc{WIN_, IN_COLS, 0, 14, (bf16*)(ws_ + W_IN), 1024, 0, g1_, r}; return d; } r -= I1;
        if (r < I2) { d = TrDesc{WIN_, IN_COLS, 2240, 48, (bf16*)(ws_ + W_IN), 1024, 512, g1_, r}; return d; } r -= I2;
        if (r < I3) { d = TrDesc{WIN_, IN_COLS, 448, 56, (bf16*)(ws_ + W_IN), 1024, 2048, g1_, r}; return d; } r -= I3;
        if (r < I4) { d = TrDesc{WIN_, IN_COLS, 3776, 96, (bf16*)(ws_ + W_IN), 1024, 3840, g1_, r}; return d; } r -= I4;
        if (r < I5) { d = TrDesc{WBR_ + (size_t)512 * 1024, 1024, 0, 32, (bf16*)(ws_ + W_B) + (size_t)1024 * 512, 512, 0, nullptr, r}; return d; } r -= I5;
        if (r < I6) { d = TrDesc{WBR_ + (size_t)1024 * 1024, 1024, 0, 32, (bf16*)(ws_ + W_B) + (size_t)2 * 1024 * 512, 512, 0, nullptr, r}; return d; } r -= I6;
        if (r < I7) { d = TrDesc{kin(22) + (size_t)l * 1024 * 1024, 1024, 0, 32, (bf16*)(ws_ + W_OUT), 1024, 0, nullptr, r}; return d; } r -= I7;
        if (r < I8) { d = TrDesc{kin(25) + (size_t)l * 1024 * 4096, 4096, 0, 128, (bf16*)(ws_ + W_1), 1024, 0, kin(24) + l * 1024, r}; return d; } r -= I8;
        if (r < I9) { d = TrDesc{kin(26) + (size_t)l * 4096 * 1024, 1024, 0, 32, (bf16*)(ws_ + W_2), 4096, 0, nullptr, r}; return d; } r -= I9;
        if (r < I10) { d = TrDesc{kin(28) + (size_t)l * 1024 * 1024, 1024, 0, 32, (bf16*)(ws_ + W_G), 1024, 0, nullptr, r}; return d; } r -= I10;
        d = TrDesc{kin(29) + (size_t)l * 256 * 1024, 1024, 0, 32, (bf16*)(ws_ + W_P), 256, 0, nullptr, r}; return d; };
    if (F.gw < NITEMS) { float ta[32], tb[32]; TrDesc da = desc(F.gw), db = da; tr_load(da, F.lane, ta);
        for (int it = F.gw; it < NITEMS; it += 2 * F.NGW) {
            const bool hb = it + F.NGW < NITEMS; if (hb) { db = desc(it + F.NGW); tr_load(db, F.lane, tb); }
            tr_finish(da, F.lane, ta, scr);
            if (!hb) break;
            const bool ha = it + 2 * F.NGW < NITEMS; if (ha) { da = desc(it + 2 * F.NGW); tr_load(da, F.lane, ta); }
            tr_finish(db, F.lane, tb, scr);
        } }
    const int gt = F.gw * 64 + F.lane, NTH = F.NGW * 64;
    { bf16* WinT = (bf16*)(kws() + W_IN); for (int i = gt; i < 64 * 1024; i += NTH) WinT[(size_t)448 * 1024 + i] = 0; }
    { const float* w_uq = kin(7) + (size_t)l * 256 * 768; const float* w_ukv = kin(8) + (size_t)l * 128 * 1024; bf16* WqT = (bf16*)(kws() + W_Q);
      if ((F.gw & 3) != 0) for (int it = (F.gw >> 2) * 3 + (F.gw & 3) - 1; it < 768 * 4; it += (F.NGW >> 2) * 3) {
        const int n = it >> 2, kq = 64 * (it & 3) + F.lane, h = n / 192, ii = n % 192; float s;
        if (ii < 128) { const GAS f32x4* a = (const GAS f32x4*)(w_uq + (size_t)kq * 768 + h * 192); const GAS f32x4* b = (const GAS f32x4*)(w_ukv + (size_t)ii * 1024 + h * 256);
            f32x4 acc = {0.f, 0.f, 0.f, 0.f};
#pragma unroll 8
            for (int q = 0; q < 32; ++q) { const f32x4 av = a[q], bv = b[q]; acc[0] = fmaf(av[0], bv[0], acc[0]); acc[1] = fmaf(av[1], bv[1], acc[1]); acc[2] = fmaf(av[2], bv[2], acc[2]); acc[3] = fmaf(av[3], bv[3], acc[3]); }
            s = (acc[0] + acc[1]) + (acc[2] + acc[3]); }
        else { const int jj = ii - 128, j = jj >> 1; s = w_uq[(size_t)kq * 768 + h * 192 + 128 + ((jj & 1) ? j + 32 : j)]; }
        WqT[(size_t)n * 256 + kq] = (bf16)f2bf(s);
      } }
    { const float* w_ukv = kin(8) + (size_t)l * 128 * 1024; const float* w_br = WBR_; bf16* WbT = (bf16*)(kws() + W_B);
      if ((F.gw & 3) == 0) for (int it = F.gw >> 2; it < 512; it += (F.NGW >> 2)) {
        const int h = it >> 7, lat0 = 4 * ((it >> 2) & 31), dd4 = 256 * (it & 3) + 4 * F.lane;
        const float* ab = w_ukv + (size_t)lat0 * 1024 + h * 256 + 128; const float* bb = w_br + (size_t)(h * 128) * 1024 + dd4;
        f32x4 acc[4] = {{0.f, 0.f, 0.f, 0.f}, {0.f, 0.f, 0.f, 0.f}, {0.f, 0.f, 0.f, 0.f}, {0.f, 0.f, 0.f, 0.f}};
#pragma unroll 4
        for (int v4 = 0; v4 < 128; v4 += 4) { f32x4 bv[4], av[4];
#pragma unroll
            for (int e = 0; e < 4; ++e) { bv[e] = *(const GAS f32x4*)(bb + (size_t)(v4 + e) * 1024); av[e] = *(const GAS f32x4*)(ab + (size_t)e * 1024 + v4); }
#pragma unroll
            for (int j = 0; j < 4; ++j)
#pragma unroll
                for (int e = 0; e < 4; ++e) acc[j] = acc[j] + bv[e] * av[j][e]; }
#pragma unroll
        for (int e = 0; e < 4; ++e) { v2u o; o.x = pk2(acc[0][e], acc[1][e]); o.y = pk2(acc[2][e], acc[3][e]); *(GAS v2u*)(WbT + (size_t)(dd4 + e) * 512 + h * 128 + lat0) = o; }
      } }
    { const float* w_up = kin(11) + (size_t)l * 64 * 512; const float* a_up = kin(13) + (size_t)l * 64 * 512; const float* g_up = kin(14) + (size_t)l * 128 * 512; bf16* WloT = (bf16*)(kws() + W_LORA);
      for (int i = gt; i < 1536 * 256; i += NTH) {
        const int n = i >> 8, k = i & 255, blk = n >> 9, nn = n & 511; float s = 0.f;
        if (blk == 0) { if (k < 64) s = w_up[(size_t)k * 512 + nn]; } else if (blk == 1) { if (k >= 64 && k < 128) s = a_up[(size_t)(k - 64) * 512 + nn]; } else { if (k >= 128) s = g_up[(size_t)(k - 128) * 512 + nn]; }
        WloT[i] = (bf16)f2bf(s);
      } }
#undef WIN_
#undef WBR_
}
__device__ __forceinline__ void h_rowpass(LAS unsigned char* lds_, bf16* Hc, bool from_x) {
    const Frame F = make_frame(lds_); float* RS = (float*)(kws() + WS_RS1); const float* xin = kin(0);
    constexpr int RB = 4;
    if (from_x) {
        for (int m0 = F.gw; m0 < T; m0 += RB * F.NGW) {
            f32x4 xv[RB][4];
#pragma unroll
            for (int q = 0; q < RB; ++q) { const GAS f32x4* xr = (const GAS f32x4*)(xin + (size_t)(m0 + q * F.NGW) * D) + F.lane;
#pragma unroll
                for (int j = 0; j < 4; ++j) xv[q][j] = xr[64 * j]; }
#pragma unroll
            for (int q = 0; q < RB; ++q) asm volatile("" : "+v"(xv[q][0]), "+v"(xv[q][1]), "+v"(xv[q][2]), "+v"(xv[q][3]));
            __builtin_amdgcn_sched_barrier(0);
#pragma unroll
            for (int q = 0; q < RB; ++q) { const int m = m0 + q * F.NGW; GAS v2u* ho = (GAS v2u*)(Hc + (size_t)m * D) + F.lane; float s = 0.f;
#pragma unroll
                for (int j = 0; j < 4; ++j) { const f32x4 v = xv[q][j]; v2u w; w.x = pk2(v.x, v.y); w.y = pk2(v.z, v.w); ho[64 * j] = w; const f32x4 r = (f32x4){bfl(w.x), bfh(w.x), bfl(w.y), bfh(w.y)};
                    s += (r.x * r.x + r.y * r.y) + (r.z * r.z + r.w * r.w); }
                const float rs = rsqrtf(wave_sum(s, F.lane) * (1.f / D) + NORM_EPS);
                if (F.lane == 0) RS[m] = rs; }
        }
    } else {
        for (int m0 = F.gw; m0 < T; m0 += RB * F.NGW) {
            v2u hw[RB][4];
#pragma unroll
            for (int q = 0; q < RB; ++q) { const GAS v2u* hr = (const GAS v2u*)(Hc + (size_t)(m0 + q * F.NGW) * D) + F.lane;
#pragma unroll
                for (int j = 0; j < 4; ++j) hw[q][j] = hr[64 * j]; }
#pragma unroll
            for (int q = 0; q < RB; ++q) asm volatile("" : "+v"(hw[q][0]), "+v"(hw[q][1]), "+v"(hw[q][2]), "+v"(hw[q][3]));
#pragma unroll
            for (int q = 0; q < RB; ++q) { const int m = m0 + q * F.NGW; float s = 0.f;
#pragma unroll
                for (int j = 0; j < 4; ++j) { const v2u w = hw[q][j]; const f32x4 r = (f32x4){bfl(w.x), bfh(w.x), bfl(w.y), bfh(w.y)}; s += (r.x * r.x + r.y * r.y) + (r.z * r.z + r.w * r.w); }
                const float rs = rsqrtf(wave_sum(s, F.lane) * (1.f / D) + NORM_EPS);
                if (F.lane == 0) RS[m] = rs; }
        }
    }
}
__device__ __forceinline__ void p2_mla_prep(LAS unsigned char* lds_, int l, int wg0, int nwg) {
    const Frame F = make_frame(lds_); const int gw = F.gw - wg0 * NWAVES, NGW = nwg * NWAVES;
    const bf16* ZM = (const bf16*)(kws() + WS_OA); bf16* QN = (bf16*)(kws() + X_QN); bf16* KV = (bf16*)(kws() + X_KV); const float* rope = (const float*)(kws() + WS_ROPE);
    const f32x4 gq = *(const f32x4*)(kin(5) + l * 256 + 4 * F.lane); const float gk0 = kin(6)[l * 128 + 2 * F.lane], gk1 = kin(6)[l * 128 + 2 * F.lane + 1];
    for (int g0 = gw; g0 < T / 4; g0 += 2 * NGW) {
        v2u wq[8]; unsigned wk[8]; unsigned short wr[8]; float rc[8], rsn[8];
        const bool two = g0 + NGW < T / 4;
#pragma unroll
        for (int i = 0; i < 8; ++i) { const int g = g0 + ((i >= 4 && two) ? NGW : 0); const int t = 4 * g + (i & 3); const bf16* z = ZM + (size_t)t * 512;
            wq[i] = *(const GAS v2u*)(z + 4 * F.lane); wk[i] = *(const GAS unsigned*)(z + 256 + 2 * F.lane); wr[i] = *(const GAS unsigned short*)(z + 384 + F.lane);
            rc[i] = *(const GAS float*)(rope + ((size_t)t * 32 + (F.lane & 31)) * 2); rsn[i] = *(const GAS float*)(rope + ((size_t)t * 32 + (F.lane & 31)) * 2 + 1); }
        asm volatile("" : "+v"(wq[0]), "+v"(wq[1]), "+v"(wq[2]), "+v"(wq[3]), "+v"(wq[4]), "+v"(wq[5]), "+v"(wq[6]), "+v"(wq[7]), "+v"(wk[0]), "+v"(wk[1]), "+v"(wk[2]), "+v"(wk[3]), "+v"(wk[4]), "+v"(wk[5]), "+v"(wk[6]), "+v"(wk[7]));
#pragma unroll
        for (int i = 0; i < 8; ++i) { if (i >= 4 && !two) break; const int g = g0 + (i >= 4 ? NGW : 0); const int t = 4 * g + (i & 3);
            const float kr = bfl((unsigned)wr[i]);
            const float q0 = bfl(wq[i].x), q1 = bfh(wq[i].x), q2 = bfl(wq[i].y), q3 = bfh(wq[i].y), k0 = bfl(wk[i]), k1 = bfh(wk[i]);
            const float rq = rsqrtf(wave_sum(q0 * q0 + q1 * q1 + q2 * q2 + q3 * q3, F.lane) * (1.f / 256.f) + NORM_EPS);
            const float rk = rsqrtf(wave_sum(k0 * k0 + k1 * k1, F.lane) * (1.f / 128.f) + NORM_EPS);
            v2u o; o.x = pk2(q0 * rq * gq.x, q1 * rq * gq.y); o.y = pk2(q2 * rq * gq.z, q3 * rq * gq.w);
            *(GAS v2u*)(QN + (size_t)t * 256 + 4 * F.lane) = o;
            *(GAS unsigned*)(KV + (size_t)t * 192 + 2 * F.lane) = pk2(k0 * rk * gk0, k1 * rk * gk1);
            const float other = shfl_xor_f(kr, 32, F.lane);
            if (F.lane < 32) *(GAS unsigned*)(KV + (size_t)t * 192 + 128 + 2 * F.lane) = pk2(kr * rc[i] - other * rsn[i], other * rc[i] + kr * rsn[i]); }
    }
}
__device__ __forceinline__ void p6_rw_prep(LAS unsigned char* lds_, int l) {
    const Frame F = make_frame(lds_);
    const bf16* ZR = (const bf16*)(kws() + X_ZR); bf16* LA = (bf16*)(kws() + X_LA);
    const f32x4 mu = *(const f32x4*)(kin(9) + l * RW_COLS + 1536 + 4 * F.lane);
    { bf16* BND = (bf16*)(kws() + X_BND);
      for (int s = F.gw; s < T / 16; s += F.NGW) { if (((16 * s) & (SEQ - 1)) == 0) continue;
#pragma unroll
        for (int j = 0; j < 3; ++j) *(GAS v4u*)(BND + (size_t)s * 1536 + 8 * (F.lane + 64 * j)) = *(const GAS v4u*)(ZR + (size_t)(16 * s - 1) * 1792 + 8 * (F.lane + 64 * j)); } }
    for (int g0 = F.gw; g0 < T / 4; g0 += 2 * F.NGW) {
        const bool two = g0 + F.NGW < T / 4; v2u w[2][5];
#pragma unroll
        for (int q = 0; q < 2; ++q) { const int t0 = 4 * (g0 + ((q && two) ? F.NGW : 0));
            w[q][0].x = 0u; w[q][0].y = 0u;
            if ((t0 & (SEQ - 1)) != 0) w[q][0] = *(const GAS v2u*)(ZR + (size_t)(t0 - 1) * 1792 + 1536 + 4 * F.lane);
#pragma unroll
            for (int i = 0; i < 4; ++i) w[q][i + 1] = *(const GAS v2u*)(ZR + (size_t)(t0 + i) * 1792 + 1536 + 4 * F.lane); }
        asm volatile("" : "+v"(w[0][0]), "+v"(w[0][1]), "+v"(w[0][2]), "+v"(w[0][3]), "+v"(w[0][4]), "+v"(w[1][0]), "+v"(w[1][1]), "+v"(w[1][2]), "+v"(w[1][3]), "+v"(w[1][4]));
#pragma unroll
        for (int q = 0; q < 2; ++q) { if (q && !two) break; const int t0 = 4 * (g0 + (q ? F.NGW : 0));
#pragma unroll
            for (int i = 0; i < 4; ++i) { const v2u wc = w[q][i + 1], wp = w[q][i];
                float z[4] = {bfl(wc.x), bfh(wc.x), bfl(wc.y), bfh(wc.y)}; const float pz[4] = {bfl(wp.x), bfh(wp.x), bfl(wp.y), bfh(wp.y)}; const float mm[4] = {mu.x, mu.y, mu.z, mu.w};
#pragma unroll
                for (int e = 0; e < 4; ++e) { float v = z[e] + (pz[e] - z[e]) * mm[e]; if (F.lane < 16) v = 1.f - 2.f * __builtin_amdgcn_rcpf(1.f + __builtin_amdgcn_exp2f(2.f * LOG2E * v)); else if (F.lane >= 32) v = fsig(v); z[e] = v; }
                v2u o; o.x = pk2(z[0], z[1]); o.y = pk2(z[2], z[3]); *(GAS v2u*)(LA + (size_t)(t0 + i) * 256 + 4 * F.lane) = o; } }
    }
}
template <int MODE>
__device__ __forceinline__ void rowpass(LAS unsigned char* lds_, bf16* Hc, const bf16* M, const float* g1, const float* pl) {
    const Frame F = make_frame(lds_);
    bf16* PB = (bf16*)(kws() + X_PB); float* RS = (float*)(kws() + WS_RS2);
    f32x4 g1v[4];
#pragma unroll
    for (int j = 0; j < 4; ++j) g1v[j] = *(const f32x4*)(g1 + 4 * F.lane + 256 * j);
    constexpr int RB = 4;
    for (int m0 = F.gw; m0 < T; m0 += RB * F.NGW) {
        v2u mw[RB][4], hw[RB][4]; f32x4 pv[RB];
#pragma unroll
        for (int q = 0; q < RB; ++q) { const int m = m0 + q * F.NGW; const GAS v2u* mr = (const GAS v2u*)(M + (size_t)m * D) + F.lane; const GAS v2u* hr = (const GAS v2u*)(Hc + (size_t)m * D) + F.lane;
#pragma unroll
            for (int j = 0; j < 4; ++j) { mw[q][j] = mr[64 * j]; hw[q][j] = hr[64 * j]; }
            if (MODE == 1) pv[q] = *((const GAS f32x4*)(pl + (size_t)m * DPLE) + F.lane); }
#pragma unroll
        for (int q = 0; q < RB; ++q) asm volatile("" : "+v"(mw[q][0]), "+v"(mw[q][1]), "+v"(mw[q][2]), "+v"(mw[q][3]), "+v"(hw[q][0]), "+v"(hw[q][1]), "+v"(hw[q][2]), "+v"(hw[q][3]));
        __builtin_amdgcn_sched_barrier(0);
#pragma unroll
        for (int q = 0; q < RB; ++q) { const int m = m0 + q * F.NGW; GAS v2u* hr = (GAS v2u*)(Hc + (size_t)m * D) + F.lane;
            f32x4 x[4], hv[4]; float s = 0.f;
#pragma unroll
            for (int j = 0; j < 4; ++j) { const v2u w = mw[q][j]; x[j] = (f32x4){bfl(w.x), bfh(w.x), bfl(w.y), bfh(w.y)}; const v2u hq_ = hw[q][j]; hv[j] = (f32x4){bfl(hq_.x), bfh(hq_.x), bfl(hq_.y), bfh(hq_.y)};
                s += (x[j].x * x[j].x + x[j].y * x[j].y) + (x[j].z * x[j].z + x[j].w * x[j].w); }
            const float rs = rsqrtf(wave_sum(s, F.lane) * (1.f / D) + NORM_EPS); float s2 = 0.f;
#pragma unroll
            for (int j = 0; j < 4; ++j) { hv[j] = hv[j] + x[j] * rs * g1v[j]; v2u w; w.x = pk2(hv[j].x, hv[j].y); w.y = pk2(hv[j].z, hv[j].w); hr[64 * j] = w;
                const f32x4 hq = (f32x4){bfl(w.x), bfh(w.x), bfl(w.y), bfh(w.y)};
                s2 += (hq.x * hq.x + hq.y * hq.y) + (hq.z * hq.z + hq.w * hq.w); }
            if (MODE == 0) { const float rs2 = rsqrtf(wave_sum(s2, F.lane) * (1.f / D) + NORM_EPS); if (F.lane == 0) RS[m] = rs2; }
            else { v2u w; w.x = pk2(pv[q].x, pv[q].y); w.y = pk2(pv[q].z, pv[q].w); *((GAS v2u*)(PB + (size_t)m * DPLE) + F.lane) = w; }
        }
    }
}
namespace rw {
typedef short v4i16_t __attribute__((ext_vector_type(4)));
constexpr int RS = 144;
constexpr int O_AT = 0, O_BT = 9216, O_KT = 18432, O_RT = 27648;
constexpr int O_UV = 36864;
constexpr int O_BK = O_UV + 4 * 32 * RS;
constexpr int O_SB = O_BK + 4 * 32 * RS;
constexpr int O_W1 = O_SB + 64 * RS;
constexpr int O_SM = O_W1 + 64 * RS;
constexpr int O_GC = O_SM + 16 * 1024;
constexpr int O_CB = O_GC + 1024;
constexpr int O_LM = O_CB + 256;
constexpr int O_YO = O_LM + 4096;
constexpr int O_PAR = O_YO + 64 * RS;
constexpr int LDS_END = O_PAR + 512;
static_assert(LDS_END <= RING_BYTES, "rwkv LDS map");
__device__ __forceinline__ bf16x8 trfrag(const LAS unsigned char* p) {
    const s16x4 lo = __builtin_bit_cast(s16x4, __builtin_amdgcn_ds_read_tr16_b64_v4i16((LAS v4i16_t*)p));
    const s16x4 hh = __builtin_bit_cast(s16x4, __builtin_amdgcn_ds_read_tr16_b64_v4i16((LAS v4i16_t*)(p + 4 * RS)));
    return (bf16x8){lo[0], lo[1], lo[2], lo[3], hh[0], hh[1], hh[2], hh[3]};
}
__device__ __forceinline__ unsigned pk_rtz(float lo, float hi) { typedef __fp16 hp2 __attribute__((ext_vector_type(2))); const hp2 v = __builtin_amdgcn_cvt_pkrtz(lo, hi); return __builtin_bit_cast(unsigned, v); }
typedef _Float16 h16x4_t __attribute__((ext_vector_type(4)));
__device__ __forceinline__ h16x4_t tr4(const LAS unsigned char* p) { return __builtin_bit_cast(h16x4_t, __builtin_amdgcn_ds_read_tr16_b64_v4i16((LAS v4i16_t*)p)); }
__device__ __forceinline__ h16x4_t ld4h(const LAS unsigned char* p) { return *(const LAS h16x4_t*)p; }
__device__ __forceinline__ h16x4_t acc2h(const f32x4 v) { typedef unsigned u2 __attribute__((ext_vector_type(2))); u2 w; w.x = pk_rtz(v[0], v[1]); w.y = pk_rtz(v[2], v[3]); return __builtin_bit_cast(h16x4_t, w); }
__device__ __forceinline__ f32x4 MFMA4(h16x4_t a, h16x4_t b, f32x4 c) { return __builtin_amdgcn_mfma_f32_16x16x16f16(a, b, c, 0, 0, 0); }
__device__ __forceinline__ void lbar() { asm volatile("s_waitcnt lgkmcnt(0)\n\ts_barrier" ::: "memory"); }
__device__ __forceinline__ void st_bf(LAS unsigned char* p, float x) { *(LAS unsigned short*)p = (unsigned short)h_f2h(__builtin_amdgcn_fmed3f(x, -60000.f, 60000.f)); }
__device__ __forceinline__ void st2(LAS unsigned char* p0, LAS unsigned char* p1, float x0, float x1) { const unsigned w = pk_rtz(x0, x1); *(LAS unsigned short*)p0 = (unsigned short)w; *(LAS unsigned short*)p1 = (unsigned short)(w >> 16); }
__device__ __forceinline__ void st4(LAS unsigned char* p, int stride, const f32x4 v) { st2(p, p + stride, v[0], v[1]); st2(p + 2 * stride, p + 3 * stride, v[2], v[3]); }
__device__ __forceinline__ float ld_bf(const LAS unsigned char* p) { return bfl((unsigned)*(const LAS unsigned short*)p); }
template <int CTRL> __device__ __forceinline__ float dpp_add(float v) { return v + __int_as_float(__builtin_amdgcn_update_dpp(0, __float_as_int(v), CTRL, 0xf, 0xf, true)); }
__device__ __forceinline__ void wsum8(float (&v)[8], int lane) {
#pragma unroll
    for (int e = 0; e < 8; ++e) { float x = v[e]; x = dpp_add<0xB1>(x); x = dpp_add<0x4E>(x); x = dpp_add<0x141>(x); x = dpp_add<0x140>(x); v[e] = x; }
#pragma unroll
    for (int e = 0; e < 8; ++e) v[e] += shfl_xor_f(v[e], 16, lane);
#pragma unroll
    for (int e = 0; e < 8; ++e) v[e] += shfl_xor_f(v[e], 32, lane);
}
__device__ __forceinline__ void wsum16(float (&a)[8], float (&b)[8], int lane) {
#pragma unroll
    for (int e = 0; e < 8; ++e) { float x = a[e]; x = dpp_add<0xB1>(x); x = dpp_add<0x4E>(x); x = dpp_add<0x141>(x); x = dpp_add<0x140>(x); a[e] = x;
                                  float y = b[e]; y = dpp_add<0xB1>(y); y = dpp_add<0x4E>(y); y = dpp_add<0x141>(y); y = dpp_add<0x140>(y); b[e] = y; }
    float ta[8], tb[8];
#pragma unroll
    for (int e = 0; e < 8; ++e) { ta[e] = shfl_xor_f(a[e], 16, lane); tb[e] = shfl_xor_f(b[e], 16, lane); }
#pragma unroll
    for (int e = 0; e < 8; ++e) { a[e] += ta[e]; b[e] += tb[e]; }
#pragma unroll
    for (int e = 0; e < 8; ++e) { ta[e] = shfl_xor_f(a[e], 32, lane); tb[e] = shfl_xor_f(b[e], 32, lane); }
#pragma unroll
    for (int e = 0; e < 8; ++e) { a[e] += ta[e]; b[e] += tb[e]; }
}
__device__ __forceinline__ void rw_prepass(LAS unsigned char* lds, int l) {
    int tid_ = my_tid(); asm volatile("" : "+v"(tid_));
    const int tid = tid_, lane = tid & 63, w = __builtin_amdgcn_readfirstlane(tid >> 6);
    int bx_ = blockIdx.x; asm volatile("" : "+s"(bx_)); int G_ = gridDim.x; asm volatile("" : "+s"(G_));
    const int gw = bx_ * NWAVES + w, NGW = G_ * NWAVES;
    bf16* ZR = (bf16*)(kws() + X_ZR); bf16* TWp = (bf16*)(kws() + X_TW); bf16* TAp = (bf16*)((unsigned char*)kout() + DO_TA);
    bf16* GCT = (bf16*)(kws() + X_GCT); float* CBG = (float*)(kws() + X_CBG); const bf16* BND = (const bf16*)(kws() + X_BND);
    LAS unsigned char* stg = lds + w * 12288; const LAS unsigned short* sr = (const LAS unsigned short*)(stg + 2 * lane); LAS unsigned short* sw = (LAS unsigned short*)(stg + 2 * lane);
    LAS unsigned char* wimg = lds + 98304;
    const int lr = lane >> 3, lc = lane & 7;
    constexpr int NIT = (T / 16) * 8;
    const bf16* LAp = (const bf16*)(kws() + X_LA); const bf16* WloT = (const bf16*)(kws() + W_LORA); bf16* Gp = (bf16*)((unsigned char*)kout() + DO_G);
    const int l15 = lane & 15, g4 = lane >> 4, hh_ = bx_ & 7;
    const int sidx = (bx_ >> 3) * NWAVES + w, sstride = (G_ >> 3) * NWAVES;
    {   const bf16* wb0 = WloT + (size_t)(64 * hh_ + l15) * 256 + 8 * g4;
#pragma unroll
        for (int i = 0; i < 4; ++i) { const int f = w + 8 * i, ct = f >> 3, K = f & 7; const bf16* w_ = wb0 + (size_t)(16 * ct) * 256;
            const bf16* src = (K < 2) ? (w_ + 32 * K) : ((K < 4) ? (w_ + (size_t)512 * 256 + 64 + 32 * (K - 2)) : (w_ + (size_t)1024 * 256 + 128 + 32 * (K - 4)));
            *(LAS v4u*)(wimg + ((ct * 8 + K) * 64 + lane) * 16) = *(const GAS v4u*)src; }
        __syncthreads(); }
    float w0v[4], a0v[4];
#pragma unroll
    for (int ct = 0; ct < 4; ++ct) { w0v[ct] = kin(10)[l * 512 + 64 * hh_ + 16 * ct + l15]; a0v[ct] = kin(12)[l * 512 + 64 * hh_ + 16 * ct + l15]; }
    const int pc0 = hh_ * 64 + lane;
    float mu_r = kin(9)[l * RW_COLS + pc0], mu_k = kin(9)[l * RW_COLS + 512 + pc0];
    float k_k = kin(15)[l * 512 + pc0], k_a = kin(16)[l * 512 + pc0], r_k = kin(17)[l * 512 + pc0];
    asm volatile("" : "+v"(mu_r), "+v"(mu_k), "+v"(k_k), "+v"(k_a), "+v"(r_k), "+v"(w0v[0]), "+v"(w0v[1]), "+v"(w0v[2]), "+v"(w0v[3]), "+v"(a0v[0]), "+v"(a0v[1]), "+v"(a0v[2]), "+v"(a0v[3]));
    v4u q[2][2], af[8]; unsigned b0, b1;
#define RWP_PTRS(S) const int s_ = (S), h_ = hh_; const size_t row0_ = (size_t)16 * s_; \
        bf16* gp0 = TWp + row0_ * 512 + 64 * h_; bf16* gp1 = ZR + row0_ * 1792 + 64 * h_; bf16* gp4 = TAp + row0_ * 512 + 64 * h_; bf16* gp5 = Gp + row0_ * 512 + 64 * h_;
#define RWP_LOAD(IT) do { RWP_PTRS(IT); (void)gp0; (void)gp4; (void)gp5; \
        _Pragma("unroll") for (int m = 0; m < 2; ++m) { q[m][0] = *(const GAS v4u*)(gp1 + (size_t)lr * 1792 + 512 * m + 8 * lc); q[m][1] = *(const GAS v4u*)(gp1 + (size_t)(lr + 8) * 1792 + 512 * m + 8 * lc); } \
        _Pragma("unroll") for (int ks = 0; ks < 8; ++ks) af[ks] = *(const GAS v4u*)(LAp + (row0_ + l15) * 256 + 32 * ks + 8 * g4); \
        { const bf16* zb_ = BND + (size_t)s_ * 1536 + 64 * h_ + lane; b0 = (unsigned)*(const GAS bf16*)zb_; b1 = (unsigned)*(const GAS bf16*)(zb_ + 512); } } while (0)
    if (sidx < T / 16) RWP_LOAD(sidx);
#pragma unroll 1
    for (int s = sidx; s < T / 16; s += sstride) {
        const int h = hh_, row0 = 16 * s, pc = h * 64 + lane;
#pragma unroll
        for (int m = 0; m < 2; ++m) { *(LAS v4u*)(stg + (1 + m) * 2048 + lr * 128 + 16 * lc) = q[m][0]; *(LAS v4u*)(stg + (1 + m) * 2048 + (lr + 8) * 128 + 16 * lc) = q[m][1]; }
        float pr = bfl(b0), pk = bfl(b1);
        if ((row0 & (SEQ - 1)) == 0) { pr = 0.f; pk = 0.f; }
        {
            bf16x8 fa[8];
#pragma unroll
            for (int ks = 0; ks < 8; ++ks) fa[ks] = __builtin_bit_cast(bf16x8, af[ks]);
            bf16x8 fb[2][8];
#define RWP_LDB(CT, B) do { _Pragma("unroll") for (int K = 0; K < 8; ++K) fb[B][K] = *(const LAS bf16x8*)(wimg + (((CT) * 8 + K) * 64 + lane) * 16); } while (0)
            RWP_LDB(0, 0);
            __builtin_amdgcn_sched_barrier(0);
#pragma unroll
            for (int ct = 0; ct < 4; ++ct) {
                if (ct < 3) RWP_LDB(ct + 1, (ct + 1) & 1);
                __builtin_amdgcn_sched_barrier(0);
                f32x4 cw = {0.f, 0.f, 0.f, 0.f}, ca = {0.f, 0.f, 0.f, 0.f}, cg = {0.f, 0.f, 0.f, 0.f};
                cw = MFMA16(fa[0], fb[ct & 1][0], cw); ca = MFMA16(fa[2], fb[ct & 1][2], ca); cg = MFMA16(fa[4], fb[ct & 1][4], cg);
                cw = MFMA16(fa[1], fb[ct & 1][1], cw); ca = MFMA16(fa[3], fb[ct & 1][3], ca); cg = MFMA16(fa[5], fb[ct & 1][5], cg);
                cg = MFMA16(fa[6], fb[ct & 1][6], cg); cg = MFMA16(fa[7], fb[ct & 1][7], cg);
                __builtin_amdgcn_sched_barrier(0);
#pragma unroll
                for (int r = 0; r < 4; ++r) { const int tok = 4 * g4 + r; LAS unsigned short* d = (LAS unsigned short*)(stg + tok * 128 + 2 * (16 * ct + l15));
                    const unsigned wt = pk_rtz(-0.6065306597126334f * pg8::sigm(w0v[ct] + cw[r]), pg8::sigm(a0v[ct] + ca[r]));
                    d[0] = (unsigned short)wt; d[3 * 1024] = (unsigned short)(wt >> 16); d[4 * 1024] = (unsigned short)pk_rtz(cg[r], 0.f); }
                __builtin_amdgcn_sched_barrier(0);
            }
#undef RWP_LDB
        }
        asm volatile("" ::: "memory");
        if (s + sstride < T / 16) RWP_LOAD(s + sstride);
        float cum[16];
        { float run = 0.f;
#pragma unroll
          for (int t = 0; t < 16; ++t) { run += bfl((unsigned)sr[64 * t]); cum[t] = run; } }
        const float gctot = __builtin_amdgcn_exp2f(LOG2E * cum[15]);
        *(GAS bf16*)(GCT + (size_t)s * 512 + pc) = (bf16)h_f2h(gctot);
#pragma unroll
        for (int hf = 0; hf < 2; ++hf) {
            float cr[8], ck[8], ta[8];
#pragma unroll
            for (int tt = 0; tt < 8; ++tt) { const int t = 8 * hf + tt; cr[tt] = bfl((unsigned)sr[1024 + 64 * t]); ck[tt] = bfl((unsigned)sr[2048 + 64 * t]); ta[tt] = bfl((unsigned)sr[3072 + 64 * t]); }
            float rr[8], kkv[8], av[8], kmv[8], ss[8], cbv[8];
#pragma unroll
            for (int tt = 0; tt < 8; ++tt) {
                const float r = cr[tt] + (pr - cr[tt]) * mu_r, k = ck[tt] + (pk - ck[tt]) * mu_k; pr = cr[tt]; pk = ck[tt];
                const float a = ta[tt], kk = k * k_k, km = k * (1.f + (a - 1.f) * k_a);
                rr[tt] = r; kkv[tt] = kk; av[tt] = a; kmv[tt] = km; ss[tt] = kk * kk; cbv[tt] = r * km * r_k; }
            wsum16(ss, cbv, lane);
#pragma unroll
            for (int tt = 0; tt < 8; ++tt) { const int t = 8 * hf + tt;
                const float cu = cum[t], cprev = t ? cum[t - 1] : 0.f;
                const float gg = __builtin_amdgcn_exp2f(LOG2E * cu), gp_ = __builtin_amdgcn_exp2f(LOG2E * cprev), gi = __builtin_amdgcn_exp2f(-LOG2E * cu);
                const float kn = kkv[tt] * rsqrtf(fmaxf(ss[tt], 1e-24f)), ka = kn * av[tt];
                const unsigned w01 = pk_rtz(-kn * gp_, rr[tt] * gg), w23 = pk_rtz(__builtin_amdgcn_fmed3f(kmv[tt] * gi, -60000.f, 60000.f), __builtin_amdgcn_fmed3f(ka * gi, -60000.f, 60000.f));
                sw[64 * t] = (unsigned short)w01; sw[1024 + 64 * t] = (unsigned short)(w01 >> 16); sw[2048 + 64 * t] = (unsigned short)w23; sw[3072 + 64 * t] = (unsigned short)(w23 >> 16);
                if (lane == tt) *(GAS float*)(CBG + (size_t)(row0 + t) * 8 + h) = cbv[tt]; }
        }
        asm volatile("" ::: "memory");
        {   RWP_PTRS(s);
            v4u o[4][2];
#pragma unroll
            for (int m = 0; m < 4; ++m) { o[m][0] = *(const LAS v4u*)(stg + m * 2048 + lr * 128 + 16 * lc); o[m][1] = *(const LAS v4u*)(stg + m * 2048 + (lr + 8) * 128 + 16 * lc); }
            *(GAS v4u*)(gp0 + (size_t)lr * 512 + 8 * lc) = o[0][0]; *(GAS v4u*)(gp0 + (size_t)(lr + 8) * 512 + 8 * lc) = o[0][1];
#pragma unroll
            for (int m = 0; m < 2; ++m) { *(GAS v4u*)(gp1 + (size_t)lr * 1792 + 512 * m + 8 * lc) = o[1 + m][0]; *(GAS v4u*)(gp1 + (size_t)(lr + 8) * 1792 + 512 * m + 8 * lc) = o[1 + m][1]; }
            *(GAS v4u*)(gp4 + (size_t)lr * 512 + 8 * lc) = o[3][0]; *(GAS v4u*)(gp4 + (size_t)(lr + 8) * 512 + 8 * lc) = o[3][1];
            const v4u og0 = *(const LAS v4u*)(stg + 4 * 2048 + lr * 128 + 16 * lc), og1 = *(const LAS v4u*)(stg + 4 * 2048 + (lr + 8) * 128 + 16 * lc);
            *(GAS v4u*)(gp5 + (size_t)lr * 512 + 8 * lc) = og0; *(GAS v4u*)(gp5 + (size_t)(lr + 8) * 512 + 8 * lc) = og1; }
        asm volatile("" ::: "memory");
    }
#undef RWP_LOAD
#undef RWP_PTRS
}
__device__ __forceinline__ void rw_unit(LAS unsigned char* lds, int l, int seq) {
    int tid_ = my_tid(); asm volatile("" : "+v"(tid_));
    const int tid = tid_, lane = tid & 63, w = __builtin_amdgcn_readfirstlane(tid >> 6), g4 = lane >> 4, l15 = lane & 15, q4 = l15 >> 2, p4 = lane & 3;
    const int b = seq >> 3, h = seq & 7;
    const bf16* ZRb = (const bf16*)(kws() + X_ZR) + (size_t)b * SEQ * 1792 + h * 64;
    const bf16* TWb = (const bf16*)(kws() + X_TW) + (size_t)b * SEQ * 512 + h * 64; const bf16* TAb = (const bf16*)((const unsigned char*)kout() + DO_TA) + (size_t)b * SEQ * 512 + h * 64; const bf16* Gb = (const bf16*)((const unsigned char*)kout() + DO_G) + (size_t)b * SEQ * 512 + h * 64;
    const bf16* GCTb = (const bf16*)(kws() + X_GCT) + (size_t)b * (SEQ / 16) * 512 + h * 64; const float* CBGb = (const float*)(kws() + X_CBG) + (size_t)b * SEQ * 8 + h;
    bf16* ORWb = (bf16*)(kws() + WS_ORW) + (size_t)b * SEQ * 512 + h * 64;
    LAS float* par = (LAS float*)(lds + O_PAR);
    const int pc = h * 64 + lane;
    if (tid < 64) { par[tid] = kin(18)[l * 512 + pc]; par[64 + tid] = kin(19)[l * 512 + pc]; }
    for (int i = tid; i < (O_GC - O_UV) / 4; i += 512) ((LAS unsigned*)(lds + O_UV))[i] = 0u;
    f32x4 ST[4] = {{0.f, 0.f, 0.f, 0.f}, {0.f, 0.f, 0.f, 0.f}, {0.f, 0.f, 0.f, 0.f}, {0.f, 0.f, 0.f, 0.f}};
    __syncthreads();
    const int et = tid >> 3, ecg = tid & 7, ei = et >> 4, ett = et & 15;
    const int trrow = 8 * g4 + q4, trrow1 = 8 * (g4 & 1) + q4, trcol = 8 * p4;
    (void)trrow;
    v4u qat, qbt, qkt, qrt, qv, qvp, pgg; unsigned pgc; float pcb;
    float muv[8];
#pragma unroll
    for (int e = 0; e < 8; ++e) muv[e] = kin(9)[l * RW_COLS + 1024 + h * 64 + 8 * ecg + e];
#define RW_LOADS(TOK0) do { const size_t row_ = (size_t)(TOK0) + et; \
        qat = *(const GAS v4u*)(TWb + row_ * 512 + 8 * ecg); qbt = *(const GAS v4u*)(TAb + row_ * 512 + 8 * ecg); \
        { const bf16* zc_ = ZRb + row_ * 1792 + 8 * ecg; qrt = *(const GAS v4u*)zc_; qkt = *(const GAS v4u*)(zc_ + 512); qv = *(const GAS v4u*)(zc_ + 1024); \
          qvp = *(const GAS v4u*)(zc_ + 1024 - (row_ > 0 ? 1792 : 0)); if (row_ == 0) qvp = (v4u){0u, 0u, 0u, 0u}; } \
        pgg = *(const GAS v4u*)(Gb + row_ * 512 + 8 * ecg); \
        pgc = (unsigned)*(const GAS bf16*)(GCTb + (size_t)((TOK0) / 16 + (tid >> 6 & 3)) * 512 + lane); pcb = *(const GAS float*)(CBGb + (size_t)((TOK0) + (tid & 63)) * 8); } while (0)
    RW_LOADS(0);
    for (int sc = 0; sc < SEQ / 64; ++sc) {
        const int tok0 = sc * 64;
        v4u ugg;
        {   asm volatile("" : "+v"(qat), "+v"(qbt), "+v"(qkt), "+v"(qrt), "+v"(qv), "+v"(qvp));
            { float vc[8], vp[8]; pg8::unpack8(qv, vc); pg8::unpack8(qvp, vp);
#pragma unroll
              for (int e = 0; e < 8; ++e) vc[e] = vc[e] + (vp[e] - vc[e]) * muv[e];
              qv.x = pk2(vc[0], vc[1]); qv.y = pk2(vc[2], vc[3]); qv.z = pk2(vc[4], vc[5]); qv.w = pk2(vc[6], vc[7]); }
            *(LAS v4u*)(lds + O_AT + et * RS + 16 * ecg) = qat; *(LAS v4u*)(lds + O_BT + et * RS + 16 * ecg) = qbt; *(LAS v4u*)(lds + O_KT + et * RS + 16 * ecg) = qkt; *(LAS v4u*)(lds + O_RT + et * RS + 16 * ecg) = qrt;
            *(LAS v4u*)(lds + O_UV + (ei * 32 + 16 + ett) * RS + 16 * ecg) = qv;
            if (tid < 256) ((LAS float*)(lds + O_GC))[tid] = bfl(pgc);
            if (tid < 64) ((LAS float*)(lds + O_CB))[tid] = pcb;
            ugg = pgg;
        }
        { const int nxt = (sc + 1 < SEQ / 64) ? tok0 + 64 : tok0; RW_LOADS(nxt); }
        lbar();
        {   const int i = w & 3, hf = w >> 2;
            const LAS unsigned char* xa = lds + (hf ? O_RT : O_AT) + (16 * i + l15) * RS + 16 * g4;
            const LAS unsigned char* xb = lds + O_BT + (16 * i + l15) * RS + 16 * g4; const LAS unsigned char* xk = lds + O_KT + (16 * i + l15) * RS + 16 * g4;
            f32x4 c1 = {0.f, 0.f, 0.f, 0.f}, c2 = {0.f, 0.f, 0.f, 0.f};
#pragma unroll
            for (int ks = 0; ks < 2; ++ks) { const bf16x8 a = *(const LAS bf16x8*)(xa + 64 * ks);
                c1 = MFMA16(a, *(const LAS bf16x8*)(xb + 64 * ks), c1);
                c2 = MFMA16(a, *(const LAS bf16x8*)(xk + 64 * ks), c2); }
#pragma unroll
            for (int r = 0; r < 4; ++r) { const int t = 4 * g4 + r; const bool keep = hf ? (l15 <= t) : (l15 < t); const float v1 = keep ? c1[r] : 0.f, v2 = keep ? c2[r] : 0.f;
                if (hf == 0) { ((LAS float*)(lds + O_LM))[(i * 16 + t) * 16 + l15] = v1; *(LAS unsigned short*)(lds + O_SM + (4 + i) * 1024 + t * 64 + 2 * l15) = (unsigned short)h_f2h(v2); }
                else st2(lds + O_SM + (8 + i) * 1024 + t * 64 + 2 * l15, lds + O_SM + (12 + i) * 1024 + t * 64 + 2 * l15, v1, v2); }
        }
        lbar();
        if (w < 4) { if (lane < 16) { const LAS float* Lm = (const LAS float*)(lds + O_LM) + w * 256; float acc[16];
#pragma unroll
                for (int t = 0; t < 16; ++t) acc[t] = (t == lane) ? 1.f : 0.f;
#pragma unroll
                for (int s = 0; s < 15; ++s) { const float xs = acc[s];
#pragma unroll
                    for (int t = s + 1; t < 16; ++t) acc[t] = fmaf(Lm[t * 16 + s], xs, acc[t]); }
#pragma unroll
                for (int t = 0; t < 16; t += 2) st2(lds + O_SM + w * 1024 + t * 64 + 2 * lane, lds + O_SM + w * 1024 + (t + 1) * 64 + 2 * lane, acc[t], acc[t + 1]); } }
        else { const int i = w - 4; const bf16x8 am = *(const LAS bf16x8*)(lds + O_SM + (4 + i) * 1024 + l15 * 64 + 16 * g4);
#pragma unroll
            for (int ct = 0; ct < 4; ++ct) { f32x4 acc = {0.f, 0.f, 0.f, 0.f};
                acc = MFMA16(am, trfrag(lds + O_UV + (i * 32 + 16 + trrow1) * RS + 32 * ct + trcol), acc);
st4(lds + O_W1 + (16 * i + 4 * g4) * RS + 2 * (16 * ct + l15), RS, acc); } }
        lbar();
        f32x4 wy[4];
        {   const int ct = w & 3; const int base = (w < 4) ? O_W1 : O_AT;
            bf16x8 tm[4], fb[4];
#pragma unroll
            for (int i = 0; i < 4; ++i) { tm[i] = *(const LAS bf16x8*)(lds + O_SM + i * 1024 + l15 * 64 + 16 * g4); fb[i] = trfrag(lds + base + (16 * i + trrow1) * RS + 32 * ct + trcol); }
#pragma unroll
            for (int i = 0; i < 4; ++i) { f32x4 acc = {0.f, 0.f, 0.f, 0.f}; wy[i] = MFMA16(tm[i], fb[i], acc); }
#pragma unroll
            for (int i = 0; i < 4; ++i) st4(lds + base + (16 * i + 4 * g4) * RS + 2 * (16 * ct + l15), RS, wy[i]); }
        lbar();
        {   const int ct = w & 3;
#pragma unroll
            for (int ih = 0; ih < 4; ih += 2) {
                bf16x8 arb[2], f1[2], ark[2], f2[2]; f32x4 cacc[2];
#pragma unroll
                for (int ii = 0; ii < 2; ++ii) { const int i = ih + ii; arb[ii] = *(const LAS bf16x8*)(lds + O_SM + (8 + i) * 1024 + l15 * 64 + 16 * g4);
                    if (w >= 4) { ark[ii] = *(const LAS bf16x8*)(lds + O_SM + (12 + i) * 1024 + l15 * 64 + 16 * g4);
                        f1[ii] = trfrag(lds + O_W1 + (16 * i + trrow1) * RS + 32 * ct + trcol); f2[ii] = trfrag(lds + O_UV + (i * 32 + 16 + trrow1) * RS + 32 * ct + trcol); cacc[ii] = (f32x4){0.f, 0.f, 0.f, 0.f}; }
                    else { f1[ii] = trfrag(lds + O_AT + (16 * i + trrow1) * RS + 32 * ct + trcol);
#pragma unroll
                        for (int r = 0; r < 4; ++r) cacc[ii][r] = ld_bf(lds + O_RT + (16 * i + 4 * g4 + r) * RS + 2 * (16 * ct + l15)); } }
#pragma unroll
                for (int ii = 0; ii < 2; ++ii) { cacc[ii] = MFMA16(arb[ii], f1[ii], cacc[ii]); if (w >= 4) cacc[ii] = MFMA16(ark[ii], f2[ii], cacc[ii]); }
#pragma unroll
                for (int ii = 0; ii < 2; ++ii) st4(lds + ((w >= 4) ? O_YO : O_RT) + (16 * (ih + ii) + 4 * g4) * RS + 2 * (16 * ct + l15), RS, cacc[ii]);
            } }
        lbar();
        if (w < 4) {
            const int v0 = 16 * w;
#pragma unroll
            for (int i = 0; i < 4; ++i) {
                h16x4_t sb[4];
#pragma unroll
                for (int kt = 0; kt < 4; ++kt) sb[kt] = acc2h(ST[kt]);
                f32x4 u = wy[i], y;
#pragma unroll
                for (int r = 0; r < 4; ++r) y[r] = ld_bf(lds + O_YO + (16 * i + 4 * g4 + r) * RS + 2 * (v0 + l15));
                const LAS unsigned char* pa = lds + O_AT + (16 * i + l15) * RS + 8 * g4; const LAS unsigned char* pq = lds + O_RT + (16 * i + l15) * RS + 8 * g4;
#pragma unroll
                for (int kt = 0; kt < 4; ++kt) { u = MFMA4(ld4h(pa + 32 * kt), sb[kt], u); y = MFMA4(ld4h(pq + 32 * kt), sb[kt], y); }
                st4(lds + O_YO + (16 * i + 4 * g4) * RS + 2 * (v0 + l15), RS, y);
                const h16x4_t ub = acc2h(u), vb = tr4(lds + O_UV + (i * 32 + 16 + 4 * g4 + q4) * RS + 2 * v0 + trcol);
#pragma unroll
                for (int kt = 0; kt < 4; ++kt) { const f32x4 gc = *(const LAS f32x4*)(lds + O_GC + (i * 64 + 16 * kt + 4 * g4) * 4);
                    f32x4 acc = ST[kt];
                    acc = MFMA4(tr4(lds + O_BT + (16 * i + 4 * g4 + q4) * RS + 32 * kt + trcol), ub, acc);
                    acc = MFMA4(tr4(lds + O_KT + (16 * i + 4 * g4 + q4) * RS + 32 * kt + trcol), vb, acc);
                    ST[kt] = acc * gc; }
            }
        }
        lbar();
        {   float y[8], vv[8], gg[8];
            pg8::unpack8(*(const LAS v4u*)(lds + O_YO + et * RS + 16 * ecg), y); pg8::unpack8(*(const LAS v4u*)(lds + O_UV + (ei * 32 + 16 + ett) * RS + 16 * ecg), vv);
            pg8::unpack8(ugg, gg);
            float s = 0.f;
#pragma unroll
            for (int e = 0; e < 8; ++e) s += y[e];
            s = dpp_add<0xB1>(s); s = dpp_add<0x4E>(s); s = dpp_add<0x141>(s);
            const float mean = s * (1.f / 64.f); float q = 0.f;
#pragma unroll
            for (int e = 0; e < 8; ++e) { y[e] -= mean; q += y[e] * y[e]; }
            q = dpp_add<0xB1>(q); q = dpp_add<0x4E>(q); q = dpp_add<0x141>(q);
            const float rstd = rsqrtf(q * (1.f / 64.f) + RW_LN_EPS), cb = ((const LAS float*)(lds + O_CB))[et];
            float o[8];
#pragma unroll
            for (int e = 0; e < 8; ++e) { const int c = 8 * ecg + e; o[e] = (y[e] * rstd * par[c] + par[64 + c] + cb * vv[e]) * gg[e]; }
            v4u wo; wo.x = pk2(o[0], o[1]); wo.y = pk2(o[2], o[3]); wo.z = pk2(o[4], o[5]); wo.w = pk2(o[6], o[7]);
            *(v4u*)(ORWb + (size_t)(tok0 + et) * 512 + 8 * ecg) = wo;
        }
        lbar();
    }
}
}
#ifndef PROBE_QREP
#define PROBE_QREP 1
#endif
#ifndef PROBE_MASK
#define PROBE_MASK 0
#endif
#if defined(TS_A)
#define TSTAMP(id) do { if (blockIdx.x == TS_BLK && my_tid() == 0) { LAS unsigned* sl_ = (LAS unsigned*)(L + LDSCTL_OFF + 320 + 1024); const unsigned now_ = (unsigned)__builtin_amdgcn_s_memrealtime(); if ((id) == TS_A) sl_[0] = now_; if ((id) == TS_B) sl_[1] += now_ - sl_[0]; } } while (0)
#else
#define TSTAMP(id) do { } while (0)
#endif
__global__ void __launch_bounds__(NWAVES * 64, 2) mk_fwd(Args args) {
    extern __shared__ __attribute__((aligned(16))) unsigned char lds[];
    LAS unsigned char* const L = (LAS unsigned char*)lds;
    for (int u = threadIdx.x; u < (LDS_BYTES - LDSCTL_OFF) / 4; u += NWAVES * 64) ((LAS unsigned*)(L + LDSCTL_OFF))[u] = 0u;
    __syncthreads();
    static_assert(LDSCTL_OFF == MK_WAVETAB_LDS, "wave table address");
    if ((threadIdx.x & 63) == 0) ((LAS unsigned*)(L + LDSCTL_OFF))[(unsigned)__builtin_amdgcn_s_getreg((5 << 11) | 4) & 63u] = threadIdx.x >> 6;
    __syncthreads();
    XcdBarrier bar = xcd_barrier_post((unsigned*)(kws() + WS_CTL) + CW_BAR, (volatile LAS unsigned*)(L + MISC_OFF) + 8);
#define GRID_BAR() xcd_barrier(bar)
#if defined(DBG_BISECT)
#define IN(k) (l > 0 || ((k) >= kstart() && (k) <= kstop()) || ((k) == 9 && kstop() == 99))
#define LAYER_END() do { if (kstop() < 100) return; } while (0)
#else
#define IN(k) true
#define LAYER_END() do { } while (0)
#endif
#define PTRS() unsigned char* ws = opq(kws()); \
    bf16* U = (bf16*)(ws + WS_U); bf16* OA = (bf16*)(ws + WS_OA); bf16* OC = (bf16*)(ws + WS_OC); bf16* ORW = (bf16*)(ws + WS_ORW); \
    bf16* WinT = (bf16*)(ws + W_IN); bf16* WqT = (bf16*)(ws + W_Q); bf16* WloT = (bf16*)(ws + W_LORA); bf16* WbT = (bf16*)(ws + W_B); bf16* WoT = (bf16*)(ws + W_OUT); \
    bf16* W1T = (bf16*)(ws + W_1); bf16* W2T = (bf16*)(ws + W_2); bf16* WgT = (bf16*)(ws + W_G); bf16* WpT = (bf16*)(ws + W_P); \
    bf16* ZC = (bf16*)(ws + X_ZC); bf16* QN = (bf16*)(ws + X_QN); bf16* QP = (bf16*)(ws + X_QP); bf16* KV = (bf16*)(ws + X_KV); \
    bf16* ZR = (bf16*)(ws + X_ZR); bf16* LA = (bf16*)(ws + X_LA); bf16* TW = (bf16*)(ws + X_TW); bf16* TA = (bf16*)((unsigned char*)kout() + DO_TA); bf16* GG = (bf16*)((unsigned char*)kout() + DO_G); bf16* H16 = (bf16*)((unsigned char*)kout() + DO_H16); \
    bf16* GT = (bf16*)(ws + X_GT); bf16* MG = (bf16*)(ws + X_MG); bf16* HID = (bf16*)(ws + X_HID); bf16* PB = (bf16*)(ws + X_PB); bf16* PP = (bf16*)(ws + X_PP); bf16* M2 = OA; \
    bf16* Hc = (l & 1) ? U : H16; bf16* Hn = (l & 1) ? H16 : U; const float* RS1 = (const float*)(ws + WS_RS1); const float* RS2 = (const float*)(ws + WS_RS2); (void)Hc; (void)Hn; (void)RS1; (void)RS2; \
    (void)U; (void)OA; (void)OC; (void)ORW; (void)WinT; (void)WqT; (void)WloT; (void)WbT; (void)WoT; (void)W1T; (void)W2T; (void)WgT; (void)WpT; (void)ZC; (void)QN; (void)QP; (void)KV; (void)ZR; (void)LA; (void)TW; (void)TA; (void)GG; (void)H16; (void)GT; (void)MG; (void)HID; (void)PB; (void)PP; (void)M2;
    typedef pg8::StaticOrder SO;
#define GEMM(EPI, Aptr, Bptr, N_, K_, Eobj) do { int bx_ = blockIdx.x; asm volatile("" : "+s"(bx_)); int G_ = gridDim.x; asm volatile("" : "+s"(G_)); pg8::Gemm g_{Aptr, Bptr, T, N_, K_}; SO S_; S_.init(T, N_, G_, bx_); pg8::gemm_phase<EPI, SO, true, true>(L + RING_OFF, g_, S_, Eobj); } while (0)
#define PH(n) for (int rep_ = 0; rep_ < (((PROBE_MASK >> (n)) & 1) ? 2 : 1); ++rep_) if (IN(n))
    typedef pg8::EpiRoute<0> ER0;
    rope_table(L);
    for (int l = 0; l < DEPTH; ++l) {
        PH(0) { PTRS(); p0_prologue(L, args, l); h_rowpass(L, Hc, l == 0); GRID_BAR(); }
        PH(1) { PTRS(); ER0 E{OA, 512, 2, ZC, 1536, 6, 2, CA_QSCALE, ZR, 1792, RS1}; GEMM(ER0, Hc, WinT, 3840, 1024, E); GRID_BAR(); }
        PH(2) { p6_rw_prep(L, l); GRID_BAR(); }
        if (IN(3)) { TSTAMP(7); rw::rw_prepass(L + RING_OFF, l); GRID_BAR(); TSTAMP(8); }
        if (IN(4)) { PTRS();
            unsigned* sb = (unsigned*)(ws + WS_CTL) + CW_SUB + 64 * l; unsigned* barw = (unsigned*)(ws + WS_CTL) + CW_BAR;
            int bx4_ = blockIdx.x; asm volatile("" : "+s"(bx4_)); int G4_ = gridDim.x; asm volatile("" : "+s"(G4_));
            TSTAMP(0);
            const int NRW = (G4_ > 64) ? 64 : 0, NOTH = G4_ - NRW;
            if (bx4_ < 64) rw::rw_unit(L + RING_OFF, l, bx4_);
            if (G4_ <= 64) for (int u_ = bx4_ + 64; u_ < 64; u_ += G4_) rw::rw_unit(L + RING_OFF, l, u_);
            if (bx4_ >= NRW) {
                p2_mla_prep(L, l, NRW, NOTH);
                TSTAMP(5); sub_barrier(barw, sb, (unsigned)NOTH, true); TSTAMP(6);
                { pg8::EpiQRope E{QP, (const float*)(ws + WS_ROPE), MLA_QSCALE}; pg8::Gemm g_{QN, WqT, T, 768, 256}; SO S_; S_.init(T, 768, NOTH, bx4_ - NRW); pg8::gemm_phase<pg8::EpiQRope, SO, true, true>(L + RING_OFF, g_, S_, E); }
                sub_barrier(barw, sb + 16, (unsigned)NOTH, true);
            } else { TSTAMP(4); sub_barrier(barw, sb + 16, (unsigned)NOTH, false); }
            TSTAMP(1);
            volatile LAS unsigned* qs = (volatile LAS unsigned*)(L + MISC_OFF) + 12;
            unsigned* qhead = (unsigned*)(ws + WS_CTL) + CW_QUEUE + 64 * l;
            for (;;) {
                __syncthreads();
                if (my_tid() == 0) *qs = atomicAdd(qhead, 1u);
                __syncthreads();
                const unsigned u = *qs;
                if (u >= 1536u) break;
                if (u < 512u) att::mla_unit(L + RING_OFF, QP, KV, OA, (int)u & 7, 63 - ((int)u >> 3));
                else { const int bi = (int)u - 512; att::band_unit(L + RING_OFF, ZC, kin(20) + (size_t)l * 320 * 8, OC, bi >> 7, (bi >> 4) & 7, bi & 15); }
            }
            TSTAMP(2); GRID_BAR(); TSTAMP(3); }
        PH(9) { PTRS(); pg8::EpiGate8 E{(unsigned char*)GT, 3072, RS1}; GEMM(pg8::EpiGate8, Hc, WinT + (size_t)3840 * 1024, 3072, 1024, E); GRID_BAR(); }
        PH(10) { PTRS(); int bx_ = blockIdx.x; asm volatile("" : "+s"(bx_)); int G_ = gridDim.x; asm volatile("" : "+s"(G_));
                 pg8::Gemm g_{OA, WbT, 3 * T, 3072, 512}; pg8::MergeOrder S_{G_, bx_}; pg8::EpiMergeAll E{MG, (const unsigned char*)GT};
                 pg8::gemm_phase<pg8::EpiMergeAll, pg8::MergeOrder, true, true>(L + RING_OFF, g_, S_, E); GRID_BAR(); }
        PH(11) { PTRS(); ER0 E{M2, 1024, 4, M2, 1024, 0, 0, 1.f, M2, 1024, nullptr}; GEMM(ER0, MG, WoT, 1024, 1024, E); GRID_BAR(); }
        if (IN(12)) { PTRS(); rowpass<0>(L, Hc, M2, kin(23) + l * 1024, nullptr); GRID_BAR(); }
        PH(13) { PTRS(); pg8::EpiRoute<2> E{HID, 4096, 16, HID, 4096, 0, 0, 1.f, HID, 4096, RS2}; GEMM(pg8::EpiRoute<2>, Hc, W1T, 4096, 1024, E); GRID_BAR(); }
        PH(14) { PTRS(); ER0 E{M2, 1024, 4, M2, 1024, 0, 0, 1.f, M2, 1024, nullptr}; GEMM(ER0, HID, W2T, 1024, 4096, E); GRID_BAR(); }
        if (IN(15)) { PTRS(); rowpass<1>(L, Hc, M2, kin(27) + l * 1024, kin(1) + (size_t)l * T * DPLE); GRID_BAR(); }
        if (IN(17)) { PTRS(); pg8::EpiGate8 E{(unsigned char*)PP, 1024, nullptr}; GEMM(pg8::EpiGate8, Hc, WgT, 1024, 1024, E);
                      pg8::EpiPle2 E2{Hc, Hn, (const unsigned char*)PP, kout(), (l + 1 == DEPTH) ? 1 : 0}; GEMM(pg8::EpiPle2, PB, WpT, 1024, 256, E2); }
        LAYER_END();
        if (l + 1 < DEPTH) GRID_BAR();
    }
#if defined(TS_A)
    if (blockIdx.x == TS_BLK && my_tid() < 64) { const LAS unsigned* sl = (const LAS unsigned*)(L + LDSCTL_OFF + 320 + 1024);
        const unsigned want = __builtin_amdgcn_readfirstlane(sl[1]) * (unsigned)TS_AMP; const unsigned t0 = (unsigned)__builtin_amdgcn_s_memrealtime();
        while ((unsigned)__builtin_amdgcn_s_memrealtime() - t0 < want) __builtin_amdgcn_s_sleep(8); }
#endif
}

#if !defined(DBG_BISECT)
extern "C" void kernel_launch(void* const* d_in, const int* in_sizes, int n_in, void* d_out, int out_size, void* d_ws, size_t ws_size, hipStream_t stream) {
    static int grid = 0;
    if (grid == 0) {
        if (n_in != 30 || out_size != T * D || ws_size < (size_t)WS_END) { fprintf(stderr, "kernel_launch: unexpected shapes (n_in %d out %d ws %zu, need ws >= %zu)\n", n_in, out_size, ws_size, (size_t)WS_END); grid = -1; return; }
        int dev = 0, cus = 0, per_cu = 0;
        if (hipGetDevice(&dev) != hipSuccess || hipDeviceGetAttribute(&cus, hipDeviceAttributeMultiprocessorCount, dev) != hipSuccess) { grid = -1; return; }
        if (hipFuncSetAttribute((const void*)mk_fwd, hipFuncAttributeMaxDynamicSharedMemorySize, LDS_BYTES) != hipSuccess) { fprintf(stderr, "kernel_launch: hipFuncSetAttribute failed\n"); grid = -1; return; }
        if (hipOccupancyMaxActiveBlocksPerMultiprocessor(&per_cu, (const void*)mk_fwd, NWAVES * 64, LDS_BYTES) != hipSuccess || per_cu < 1) { fprintf(stderr, "kernel_launch: occupancy query says %d\n", per_cu); }
        (void)hipGetLastError();
        if (cus < 256) { fprintf(stderr, "kernel_launch: %d CUs, the RWKV pre-pass needs a grid of >= 256 workgroups\n", cus); grid = -1; return; }
        grid = cus;
    }
    if (grid < 0) return;
    if (hipMemsetAsync((char*)d_ws + WS_CTL, 0, CTL_ZERO_BYTES, stream) != hipSuccess) return;
    Args a{};
    for (int i = 0; i < 30; ++i) a.in[i] = (const float*)d_in[i];
    a.out = (float*)d_out; a.ws = (unsigned char*)d_ws; a.start = 0; a.stop = 1000;
    hipLaunchKernelGGL(mk_fwd, dim3(grid), dim3(NWAVES * 64), LDS_BYTES, stream, a);
}
#endif
```
